# Optimizing an MI355X kernel written in HIP

```python
import math
import jax, jax.numpy as jnp
from jax import lax
import numpy as np

D_MODEL = 1024
BATCH = 16
SEQ = 2048
DEPTH = 1

CHUNK = 64
Q_BLOCK = 128

MLA_HEADS = 8
QK_NOPE = 64
QK_ROPE = 32
V_DIM = 64
Q_RANK = 256
KV_RANK = 128
ROPE_THETA = 10000.0
MLA_WIDTH = MLA_HEADS * V_DIM

SSM_GROUP = 16
SSM_STATE = 64
SSM_WIDTH = D_MODEL // 2
SSM_GROUPS = SSM_WIDTH // SSM_GROUP
DT_MIN = 1e-3
DT_MAX = 1e-1

MIX_WIDTH = MLA_WIDTH + SSM_WIDTH
IN_WIDTH = Q_RANK + KV_RANK + QK_ROPE + SSM_WIDTH

N_EXPERTS = 64
TOP_K = 8
N_GROUPS = 8
TOP_GROUPS = 4
EXPERT_FF = 256
ROUTED_SCALE = 2.5
MOE_BLOCK = 128

ALPHA = (2.0 * DEPTH) ** 0.25
BETA = (8.0 * DEPTH) ** -0.25
EPS = 1e-5

kernel_name = "hybrid_mla_s5_moe_deepnorm_block"


def layer_norm(x, g, b):
    xf = x.astype(jnp.float32)
    mu = jnp.mean(xf, axis=-1, keepdims=True)
    var = jnp.mean(jnp.square(xf - mu), axis=-1, keepdims=True)
    return ((xf - mu) * lax.rsqrt(var + EPS) * g.astype(jnp.float32) + b.astype(jnp.float32)).astype(x.dtype)


def rms_norm(x, g):
    xf = x.astype(jnp.float32)
    return (xf * lax.rsqrt(jnp.mean(xf * xf, axis=-1, keepdims=True) + EPS) * g.astype(jnp.float32)).astype(x.dtype)


def rope(x, positions):
    half = QK_ROPE // 2
    inv_freq = ROPE_THETA ** (-jnp.arange(half, dtype=jnp.float32) / half)
    ang = positions.astype(jnp.float32)[..., None] * inv_freq
    ang = ang.reshape(ang.shape[:2] + (1,) * (x.ndim - 3) + (half,))
    cos, sin = jnp.cos(ang), jnp.sin(ang)
    xf = x.astype(jnp.float32)
    x1, x2 = xf[..., :half], xf[..., half:]
    return jnp.concatenate([x1 * cos - x2 * sin, x2 * cos + x1 * sin], axis=-1).astype(x.dtype)


def mla(c_q, c_kv, k_rope_raw, positions, q_norm_g, kv_norm_g, w_uq, w_ukv):
    B, S, _ = c_q.shape
    q = jnp.einsum('bsr,rhd->bshd', rms_norm(c_q, q_norm_g), w_uq)
    q_nope, q_rope = q[..., :QK_NOPE], rope(q[..., QK_NOPE:], positions)
    kv = jnp.einsum('bsr,rhd->bshd', rms_norm(c_kv, kv_norm_g), w_ukv)
    k_nope, v = kv[..., :QK_NOPE], kv[..., QK_NOPE:]
    k_rope = rope(k_rope_raw, positions)
    scale = (QK_NOPE + QK_ROPE) ** -0.5
    chunk_id = jnp.arange(S) // CHUNK
    outs = []
    for i in range(S // Q_BLOCK):
        q0, q1 = i * Q_BLOCK, (i + 1) * Q_BLOCK
        s = (jnp.einsum('bqhn,bkhn->bhqk', q_nope[:, q0:q1], k_nope[:, :q1]).astype(jnp.float32)
             + jnp.einsum('bqhr,bkr->bhqk', q_rope[:, q0:q1], k_rope[:, :q1]).astype(jnp.float32)) * scale
        mask = chunk_id[q0:q1, None] >= chunk_id[None, :q1]
        s = jnp.where(mask, s, -jnp.inf)
        p = jax.nn.softmax(s, axis=-1).astype(v.dtype)
        outs.append(jnp.einsum('bhqk,bkhd->bqhd', p, v[:, :q1]))
    return jnp.concatenate(outs, axis=1).reshape(B, S, MLA_WIDTH)


def s5(u, lambda_re, lambda_im, log_step, b_re, b_im, c_re, c_im, d_skip, w_glu, b_glu):
    B, S, _ = u.shape
    uf = u.astype(jnp.float32).reshape(B, S, SSM_GROUPS, SSM_GROUP)
    lam = lax.complex(jnp.minimum(lambda_re.astype(jnp.float32), -1e-4),
                      lambda_im.astype(jnp.float32))
    step = jnp.exp(log_step.astype(jnp.float32))[:, None]
    lam_bar = jnp.exp(lam * step)
    b_mat = lax.complex(b_re.astype(jnp.float32), b_im.astype(jnp.float32))
    b_bar = ((lam_bar - 1.0) / lam)[..., None] * b_mat
    bu = jnp.einsum('gpc,bsgc->sbgp', b_bar, uf.astype(jnp.complex64))
    a = jnp.broadcast_to(lam_bar, (S, 1) + lam_bar.shape)

    def combine(left, right):
        a_l, b_l = left
        a_r, b_r = right
        return a_r * a_l, a_r * b_l + b_r

    _, states = lax.associative_scan(combine, (a, bu), axis=0)
    c_mat = lax.complex(c_re.astype(jnp.float32), c_im.astype(jnp.float32))
    y = jnp.einsum('gcp,sbgp->bsgc', c_mat, states).real + d_skip.astype(jnp.float32) * uf
    y = jax.nn.gelu(y.reshape(B, S, SSM_WIDTH))
    return y * jax.nn.sigmoid(y @ w_glu.astype(jnp.float32) + b_glu.astype(jnp.float32))


def moe(x, w_router, router_bias, w_gate, w_up, w_down, ws_gate, ws_up, ws_down):
    B, S, D = x.shape
    xt = x.reshape(-1, D)
    T = xt.shape[0]
    scores = jax.nn.sigmoid((xt @ w_router).astype(jnp.float32))
    sel = scores + router_bias.astype(jnp.float32)
    grp_score = lax.top_k(sel.reshape(T, N_GROUPS, N_EXPERTS // N_GROUPS), 2)[0].sum(-1)
    _, top_g = lax.top_k(grp_score, TOP_GROUPS)
    gmask = jax.nn.one_hot(top_g, N_GROUPS, dtype=jnp.float32).sum(1)
    emask = jnp.repeat(gmask, N_EXPERTS // N_GROUPS, axis=1) > 0
    _, idx = lax.top_k(jnp.where(emask, sel, -jnp.inf), TOP_K)
    w = jnp.take_along_axis(scores, idx, axis=1)
    w = w / jnp.sum(w, axis=-1, keepdims=True) * ROUTED_SCALE
    gates = jnp.einsum('tk,tke->te', w, jax.nn.one_hot(idx, N_EXPERTS, dtype=jnp.float32))

    def expert_block(args):
        xb, gb = args
        h = jax.nn.silu(jnp.einsum('td,edf->tef', xb, w_gate)) * jnp.einsum('td,edf->tef', xb, w_up)
        return jnp.einsum('tef,efd->td', h * gb[..., None].astype(h.dtype), w_down)

    routed = lax.map(expert_block, (xt.reshape(-1, MOE_BLOCK, D),
                                    gates.reshape(-1, MOE_BLOCK, N_EXPERTS)))
    shared = (jax.nn.silu(xt @ ws_gate) * (xt @ ws_up)) @ ws_down
    return (routed.reshape(T, D) + shared).reshape(B, S, D)


def setup_inputs(seed: int = 0) -> dict:
    key = jax.random.key(seed)
    ks = iter(jax.random.split(key, 40))
    nrm = lambda shape, s: jax.random.normal(next(ks), shape, jnp.float32) * s
    L = DEPTH
    x = nrm((BATCH, SEQ, D_MODEL), 1.0)
    offset = jax.random.randint(next(ks), (BATCH, 1), 0, 4096, dtype=jnp.int32)
    positions = (offset + jnp.arange(SEQ, dtype=jnp.int32)[None, :]).astype(jnp.int32)
    ln_in_g = 1.0 + nrm((D_MODEL,), 0.01)
    ln_in_b = nrm((D_MODEL,), 0.01)
    w_in = nrm((L, D_MODEL, IN_WIDTH), D_MODEL ** -0.5)
    q_norm_g = 1.0 + nrm((L, Q_RANK), 0.01)
    kv_norm_g = 1.0 + nrm((L, KV_RANK), 0.01)
    w_uq = nrm((L, Q_RANK, MLA_HEADS, QK_NOPE + QK_ROPE), Q_RANK ** -0.5)
    w_ukv = nrm((L, KV_RANK, MLA_HEADS, QK_NOPE + V_DIM), KV_RANK ** -0.5)
    w_ukv = w_ukv.at[..., QK_NOPE:].multiply(BETA)
    lambda_re = -0.5 + nrm((L, SSM_GROUPS, SSM_STATE), 0.01)
    lambda_im = math.pi * jnp.arange(SSM_STATE, dtype=jnp.float32) + nrm((L, SSM_GROUPS, SSM_STATE), 0.01)
    log_step = jax.random.uniform(next(ks), (L, SSM_GROUPS), jnp.float32,
                                  math.log(DT_MIN), math.log(DT_MAX))
    b_scale = (2.0 * SSM_GROUP) ** -0.5
    b_re = nrm((L, SSM_GROUPS, SSM_STATE, SSM_GROUP), b_scale)
    b_im = nrm((L, SSM_GROUPS, SSM_STATE, SSM_GROUP), b_scale)
    c_scale = (2.0 * SSM_STATE) ** -0.5
    c_re = nrm((L, SSM_GROUPS, SSM_GROUP, SSM_STATE), c_scale)
    c_im = nrm((L, SSM_GROUPS, SSM_GROUP, SSM_STATE), c_scale)
    d_skip = nrm((L, SSM_GROUPS, SSM_GROUP), 1.0)
    w_glu = nrm((L, SSM_WIDTH, SSM_WIDTH), SSM_WIDTH ** -0.5)
    b_glu = nrm((L, SSM_WIDTH), 0.01)
    attn_out_g = 1.0 + nrm((L, MLA_WIDTH), 0.01)
    ssm_out_g = 1.0 + nrm((L, SSM_WIDTH), 0.01)
    w_o = nrm((L, MIX_WIDTH, D_MODEL), MIX_WIDTH ** -0.5 * BETA)
    ln1_g = 1.0 + nrm((L, D_MODEL), 0.01)
    ln1_b = nrm((L, D_MODEL), 0.01)
    w_router = nrm((L, D_MODEL, N_EXPERTS), D_MODEL ** -0.5)
    router_bias = nrm((L, N_EXPERTS), 0.01)
    w_gate = nrm((L, N_EXPERTS, D_MODEL, EXPERT_FF), D_MODEL ** -0.5)
    w_up = nrm((L, N_EXPERTS, D_MODEL, EXPERT_FF), D_MODEL ** -0.5)
    w_down = nrm((L, N_EXPERTS, EXPERT_FF, D_MODEL), EXPERT_FF ** -0.5 * BETA)
    ws_gate = nrm((L, D_MODEL, EXPERT_FF), D_MODEL ** -0.5)
    ws_up = nrm((L, D_MODEL, EXPERT_FF), D_MODEL ** -0.5)
    ws_down = nrm((L, EXPERT_FF, D_MODEL), EXPERT_FF ** -0.5 * BETA)
    ln2_g = 1.0 + nrm((L, D_MODEL), 0.01)
    ln2_b = nrm((L, D_MODEL), 0.01)
    return {"x": x, "positions": positions, "ln_in_g": ln_in_g, "ln_in_b": ln_in_b,
            "w_in": w_in, "q_norm_g": q_norm_g, "kv_norm_g": kv_norm_g, "w_uq": w_uq, "w_ukv": w_ukv,
            "lambda_re": lambda_re, "lambda_im": lambda_im, "log_step": log_step,
            "b_re": b_re, "b_im": b_im, "c_re": c_re, "c_im": c_im, "d_skip": d_skip,
            "w_glu": w_glu, "b_glu": b_glu, "attn_out_g": attn_out_g, "ssm_out_g": ssm_out_g,
            "w_o": w_o, "ln1_g": ln1_g, "ln1_b": ln1_b, "w_router": w_router, "router_bias": router_bias,
            "w_gate": w_gate, "w_up": w_up, "w_down": w_down,
            "ws_gate": ws_gate, "ws_up": ws_up, "ws_down": ws_down, "ln2_g": ln2_g, "ln2_b": ln2_b}


def reference(x, positions, ln_in_g, ln_in_b, w_in, q_norm_g, kv_norm_g, w_uq, w_ukv,
              lambda_re, lambda_im, log_step, b_re, b_im, c_re, c_im, d_skip, w_glu, b_glu,
              attn_out_g, ssm_out_g, w_o, ln1_g, ln1_b, w_router, router_bias,
              w_gate, w_up, w_down, ws_gate, ws_up, ws_down, ln2_g, ln2_b):
    x = layer_norm(x, ln_in_g, ln_in_b)
    s1 = Q_RANK
    s2 = s1 + KV_RANK
    s3 = s2 + QK_ROPE
    for l in range(DEPTH):
        h = x @ w_in[l]
        c_q, c_kv, k_rope_raw, u = h[..., :s1], h[..., s1:s2], h[..., s2:s3], h[..., s3:]
        att = mla(c_q, c_kv, k_rope_raw, positions, q_norm_g[l], kv_norm_g[l], w_uq[l], w_ukv[l])
        ssm = s5(u, lambda_re[l], lambda_im[l], log_step[l], b_re[l], b_im[l], c_re[l], c_im[l],
                 d_skip[l], w_glu[l], b_glu[l]).astype(att.dtype)
        mix = jnp.concatenate([rms_norm(att, attn_out_g[l]), rms_norm(ssm, ssm_out_g[l])], axis=-1) @ w_o[l]
        x = layer_norm(ALPHA * x + mix, ln1_g[l], ln1_b[l])
        ffn = moe(x, w_router[l], router_bias[l], w_gate[l], w_up[l], w_down[l],
                  ws_gate[l], ws_up[l], ws_down[l])
        x = layer_norm(ALPHA * x + ffn, ln2_g[l], ln2_b[l])
    return x
```

```cpp
#include <hip/hip_runtime.h>
#include <stdint.h>
#include <string.h>

typedef unsigned short bf16_t;
typedef short bf16x8 __attribute__((ext_vector_type(8)));
typedef float f32x16 __attribute__((ext_vector_type(16)));
typedef float f32x4 __attribute__((ext_vector_type(4)));
typedef unsigned u32x4 __attribute__((ext_vector_type(4)));

constexpr int T = 32768, D = 1024, SEQ = 2048, NB = 16;
constexpr int NH = 8, QKD = 96, VD = 64;
constexpr int QRANK = 256, KVRANK = 128, ROPE = 32;
constexpr int SSMW = 512, SG = 32, SC = 16, SP = 64, CH = 64, NCH = SEQ / CH;
constexpr int NE = 64, TOPK = 8, FF = 256;
constexpr float ALPHA = 1.189207115002721f;
constexpr float EPS = 1e-5f;
constexpr float QSCALE = 0.10206207261596577f * 1.4426950408889634f;
constexpr float SLOT_SCALE = 64.0f;
constexpr int RROUT = 278528;
constexpr int SH_ROW0 = RROUT;
constexpr int RTOT = RROUT + T;

constexpr size_t MiB = 1ull << 20;
constexpr size_t WS_CTL = 0;
constexpr size_t WS_TOPI = 1 * MiB, WS_TOPW = 2 * MiB, WS_ROWTOK = 3 * MiB, WS_ROWW = 4 * MiB + MiB / 2;
constexpr size_t WS_CNT = 6 * MiB, WS_TOFF = 6 * MiB + 65536, WS_EOFF = 6 * MiB + 131072, WS_ECNT = 6 * MiB + 131072 + 1024;
constexpr size_t WS_WD = 7 * MiB;
constexpr size_t WS_X1 = 40 * MiB;
constexpr size_t WS_XN = WS_X1, WS_AS = WS_X1;
constexpr size_t WS_H = 104 * MiB;
constexpr size_t WS_CQ = 104 * MiB, WS_CKV = 120 * MiB, WS_U = 136 * MiB, WS_YINTRA = 168 * MiB, WS_Y = 200 * MiB;
constexpr size_t WS_QRRAW = 200 * MiB;
constexpr size_t WS_XLOC = 232 * MiB, WS_XPREV = 240 * MiB, WS_LOGITS = 248 * MiB, WS_KRRAW = 248 * MiB;
constexpr size_t WS_X1LO = 104 * MiB;
constexpr size_t WS_YSLOT = 256 * MiB;
constexpr size_t WS_WGU = 256 * MiB;
constexpr size_t WS_WIN = 321 * MiB, WS_WO = 323 * MiB, WS_WUQ = 325 * MiB, WS_WUKV = 325 * MiB + MiB / 2, WS_WGLU = 326 * MiB;
constexpr size_t WS_BLOC = 327 * MiB, WS_CLAM = 343 * MiB, WS_KTAB = 359 * MiB, WS_LAMPOW = 361 * MiB, WS_BBAR = 363 * MiB;
constexpr size_t WS_ROPE = 364 * MiB, WS_XSTAT = 368 * MiB, WS_RSQ = 368 * MiB + MiB / 2, WS_RSKV = WS_RSQ + 131072;
constexpr size_t WS_Q = 370 * MiB, WS_K = 418 * MiB, WS_V = 466 * MiB;
constexpr size_t WS_NEED = 512 * MiB;

__device__ __forceinline__ bf16_t f2bf(float f) { unsigned u = __float_as_uint(f); u += 0x7fffu + ((u >> 16) & 1u); return (bf16_t)(u >> 16); }
__device__ __forceinline__ float bf2f(bf16_t b) { return __uint_as_float(((unsigned)b) << 16); }
__device__ __forceinline__ int crow(int i, int h) { return (i & 3) + 8 * (i >> 2) + 4 * h; }
__device__ __forceinline__ float wave_sum(float v) {
#pragma unroll
    for (int o = 32; o > 0; o >>= 1) v += __shfl_xor(v, o);
    return v;
}
__device__ __forceinline__ float wave_max(float v) {
#pragma unroll
    for (int o = 32; o > 0; o >>= 1) v = fmaxf(v, __shfl_xor(v, o));
    return v;
}
__device__ __forceinline__ float sigmoidf_(float z) { return 1.0f / (1.0f + __expf(-z)); }
__device__ __forceinline__ float gelu_tanh(float y) {
    const float z = 0.7978845608028654f * (y + 0.044715f * y * y * y);
    const float th = 1.0f - 2.0f / (1.0f + __expf(2.0f * z));
    return 0.5f * y * (1.0f + th);
}
__host__ __device__ __forceinline__ int ropeperm(int q) { return 16 * ((q >> 2) & 1) + 4 * (q >> 3) + (q & 3); }
__host__ __device__ __forceinline__ int ropepos(int j) { const int n = j >> 4, r = j & 15; return 8 * (r >> 2) + 4 * n + (r & 3); }

__device__ __forceinline__ void cexp_d(double re, double im, double& ore, double& oim) {
    const double s = 1.0 / 1048576.0;
    const double a = re * s, b = im * s;
    double tr = 1.0, ti = 0.0, sr = 1.0, si = 0.0;
#pragma unroll
    for (int n = 1; n <= 8; ++n) {
        const double nr = (tr * a - ti * b) / n, ni = (tr * b + ti * a) / n;
        tr = nr; ti = ni; sr += tr; si += ti;
    }
#pragma unroll
    for (int i = 0; i < 20; ++i) { const double nr = sr * sr - si * si, ni = 2.0 * sr * si; sr = nr; si = ni; }
    ore = sr; oim = si;
}

template <bool DUAL, class AF, class BF, class EPI>
__device__ __forceinline__ void sg_tile(int m0, int n0, int K, AF arow, BF bptr, EPI epi) {
    const int lane = threadIdx.x & 63, r = lane & 31, h = lane >> 5;
    f32x16 acc, acc2;
#pragma unroll
    for (int i = 0; i < 16; ++i) { acc[i] = 0.f; acc2[i] = 0.f; }
    const bf16_t* ap = arow(m0 + r);
    for (int k0 = 0; k0 < K; k0 += 16) {
        const bf16x8 a = *(const bf16x8*)(ap + k0 + 8 * h);
        const bf16x8 b = *(const bf16x8*)(bptr(n0 + r, k0 + 8 * h, 0));
        acc = __builtin_amdgcn_mfma_f32_32x32x16_bf16(a, b, acc, 0, 0, 0);
        if (DUAL) {
            const bf16x8 b2 = *(const bf16x8*)(bptr(n0 + r, k0 + 8 * h, 1));
            acc2 = __builtin_amdgcn_mfma_f32_32x32x16_bf16(a, b2, acc2, 0, 0, 0);
        }
    }
#pragma unroll
    for (int i = 0; i < 16; ++i) epi(m0 + crow(i, h), n0 + r, acc[i], acc2[i]);
}

__global__ void __launch_bounds__(256) k_ln_in(const float* __restrict__ x, const float* __restrict__ g, const float* __restrict__ b,
                                               bf16_t* __restrict__ xn, float* __restrict__ xstat) {
    const int lane = threadIdx.x & 63, w = threadIdx.x >> 6;
    for (int t = blockIdx.x * 4 + w; t < T; t += gridDim.x * 4) {
        const float* xr = x + (size_t)t * D;
        float v[16]; float s = 0.f;
#pragma unroll
        for (int i = 0; i < 4; ++i) { const f32x4 q = *(const f32x4*)(xr + i * 256 + lane * 4); v[4 * i] = q[0]; v[4 * i + 1] = q[1]; v[4 * i + 2] = q[2]; v[4 * i + 3] = q[3]; s += q[0] + q[1] + q[2] + q[3]; }
        const float mu = wave_sum(s) * (1.0f / D);
        float ss = 0.f;
#pragma unroll
        for (int i = 0; i < 16; ++i) { const float d = v[i] - mu; ss += d * d; }
        const float rstd = rsqrtf(wave_sum(ss) * (1.0f / D) + EPS);
        if (lane == 0) { xstat[2 * t] = mu; xstat[2 * t + 1] = rstd; }
#pragma unroll
        for (int i = 0; i < 4; ++i) {
            const int c = i * 256 + lane * 4;
            const f32x4 gg = *(const f32x4*)(g + c), bb = *(const f32x4*)(b + c);
            ushort4 o;
            o.x = f2bf((v[4 * i] - mu) * rstd * gg[0] + bb[0]); o.y = f2bf((v[4 * i + 1] - mu) * rstd * gg[1] + bb[1]);
            o.z = f2bf((v[4 * i + 2] - mu) * rstd * gg[2] + bb[2]); o.w = f2bf((v[4 * i + 3] - mu) * rstd * gg[3] + bb[3]);
            *(ushort4*)(xn + (size_t)t * D + c) = o;
        }
    }
}

struct WPrep {
    const float* src; const float* src2; const float* ks; const float* ks2;
    bf16_t* dst; int mode, Nd, Kd, ldsrc, Ksrc, pad0; size_t src_estride, dst_estride; float kmul; int pad1;
};
static WPrep mk_wprep(const float* src, const float* src2, const float* ks, const float* ks2, bf16_t* dst, int mode, int Nd, int Kd, int ldsrc, int Ksrc, size_t se, size_t de, float kmul) {
    WPrep p; memset(&p, 0, sizeof(p));
    p.src = src; p.src2 = src2; p.ks = ks; p.ks2 = ks2; p.dst = dst; p.mode = mode; p.Nd = Nd; p.Kd = Kd; p.ldsrc = ldsrc; p.Ksrc = Ksrc; p.src_estride = se; p.dst_estride = de; p.kmul = kmul;
    return p;
}
__device__ __forceinline__ int wprep_srccol(int mode, int n, int& which) {
    which = 0;
    switch (mode) {
    case 0: if (n < 256) return n; if (n < 768) return 416 + (n - 256); if (n < 896) return 256 + (n - 768); if (n < 928) return 384 + ropeperm(n - 896); return -1;
    case 1: if (n < 512) return (n >> 6) * 96 + (n & 63); { const int m = n - 512; return (m >> 5) * 96 + 64 + ropeperm(m & 31); }
    case 2: if (n < 512) return (n >> 6) * 128 + (n & 63); { const int m = n - 512; return (m >> 6) * 128 + 64 + (m & 63); }
    case 5: { const int pn = n >> 8, w = n & 255; which = w >> 7; return pn * 128 + (w & 127); }
    default: return n;
    }
}
__global__ void __launch_bounds__(256) k_wprep(WPrep p) {
    __shared__ float tile[64][65];
    const int ntn = p.Nd / 64, ntk = p.Kd / 64;
    const int e = blockIdx.y;
    const float* s1 = p.src + (size_t)e * p.src_estride;
    const float* s2 = p.src2 ? p.src2 + (size_t)e * p.src_estride : nullptr;
    bf16_t* dst = p.dst + (size_t)e * p.dst_estride;
    for (int tl = blockIdx.x; tl < ntn * ntk; tl += gridDim.x) {
        const int n0 = (tl / ntk) * 64, k0 = (tl % ntk) * 64;
        const int nn = threadIdx.x & 63, ksub = threadIdx.x >> 6;
        int which; const int sc = wprep_srccol(p.mode, n0 + nn, which);
        const float* s = which ? s2 : s1;
#pragma unroll
        for (int i = 0; i < 16; ++i) {
            const int kk = ksub + 4 * i, k = k0 + kk;
            float v = 0.f;
            if (sc >= 0 && k < p.Ksrc) {
                v = s[(size_t)k * p.ldsrc + sc];
                if (p.ks) v *= (p.ks2 && k >= 512) ? p.ks2[k - 512] : p.ks[k];
                v *= p.kmul;
            }
            tile[kk][nn] = v;
        }
        __syncthreads();
        const int kk = threadIdx.x & 63, nsub = threadIdx.x >> 6;
#pragma unroll
        for (int i = 0; i < 16; ++i) { const int n = nsub + 4 * i; dst[(size_t)(n0 + n) * p.Kd + k0 + kk] = f2bf(tile[kk][n]); }
        __syncthreads();
    }
}

__global__ void __launch_bounds__(64) k_s5tab1(const float* __restrict__ lre, const float* __restrict__ lim, const float* __restrict__ lstep,
                                               const float* __restrict__ bre, const float* __restrict__ bim, float2* __restrict__ lampow, float2* __restrict__ bbar) {
    const int g = blockIdx.x, p = threadIdx.x;
    double lr = (double)lre[g * SP + p]; if (lr > -1e-4) lr = -1e-4;
    const double li = (double)lim[g * SP + p];
    double st, dummy; cexp_d((double)lstep[g], 0.0, st, dummy);
    double br, bi; cexp_d(lr * st, li * st, br, bi);
    const double nr = br - 1.0, ni = bi, den = lr * lr + li * li;
    const double cr = (nr * lr + ni * li) / den, ci = (ni * lr - nr * li) / den;
    double pr = 1.0, pi = 0.0;
    for (int tau = 0; tau <= 64; ++tau) {
        lampow[(g * SP + p) * 65 + tau] = make_float2((float)pr, (float)pi);
        const double tr = pr * br - pi * bi, ti = pr * bi + pi * br; pr = tr; pi = ti;
    }
    for (int c = 0; c < SC; ++c) {
        const double xr = (double)bre[(g * SP + p) * SC + c], xi = (double)bim[(g * SP + p) * SC + c];
        bbar[(g * SP + p) * SC + c] = make_float2((float)(cr * xr - ci * xi), (float)(cr * xi + ci * xr));
    }
}
__global__ void __launch_bounds__(256) k_s5tab2(const float2* __restrict__ lampow, const float2* __restrict__ bbar, const float* __restrict__ cre, const float* __restrict__ cim,
                                                const float* __restrict__ dskip, bf16_t* __restrict__ ktab, bf16_t* __restrict__ bloc, bf16_t* __restrict__ clam) {
    const size_t nk = (size_t)SG * 127 * 256, nb = (size_t)SG * 256 * 1024, nc = (size_t)SG * 1024 * 256;
    const size_t stride = (size_t)gridDim.x * blockDim.x;
    for (size_t i = (size_t)blockIdx.x * blockDim.x + threadIdx.x; i < nk + nb + nc; i += stride) {
        if (i < nk) {
            const int cp = (int)(i & 15), c = (int)((i >> 4) & 15), ti = (int)((i >> 8) % 127), g = (int)((i >> 8) / 127);
            const int tau = ti - 63;
            float v = 0.f;
            if (tau >= 0) {
                for (int p = 0; p < SP; ++p) {
                    const float2 l = lampow[(g * SP + p) * 65 + tau], bb = bbar[(g * SP + p) * SC + cp];
                    const float cr = cre[(g * SC + c) * SP + p], ci = cim[(g * SC + c) * SP + p];
                    const float mr = l.x * bb.x - l.y * bb.y, mi = l.x * bb.y + l.y * bb.x;
                    v += cr * mr - ci * mi;
                }
                if (tau == 0 && c == cp) v += dskip[g * SC + c];
            }
            ktab[i] = f2bf(v);
        } else if (i < nk + nb) {
            const size_t j = i - nk;
            const int k = (int)(j & 1023), n = (int)((j >> 10) & 255), g = (int)(j >> 18);
            float v = 0.f;
            if (n < 128) {
                const int p = n & 63, s = k >> 4, c = k & 15;
                const float2 l = lampow[(g * SP + p) * 65 + (63 - s)], bb = bbar[(g * SP + p) * SC + c];
                v = (n < 64) ? (l.x * bb.x - l.y * bb.y) : (l.x * bb.y + l.y * bb.x);
            }
            bloc[j] = f2bf(v);
        } else {
            const size_t j = i - nk - nb;
            const int k = (int)(j & 255), n = (int)((j >> 8) & 1023), g = (int)(j >> 18);
            float v = 0.f;
            if (k < 128) {
                const int p = k & 63, t = n >> 4, c = n & 15;
                const float2 l = lampow[(g * SP + p) * 65 + (t + 1)];
                const float cr = cre[(g * SC + c) * SP + p], ci = cim[(g * SC + c) * SP + p];
                v = (k < 64) ? (cr * l.x - ci * l.y) : -(cr * l.y + ci * l.x);
            }
            clam[j] = f2bf(v);
        }
    }
}
__global__ void __launch_bounds__(256) k_ropetab(const int* __restrict__ pos, float2* __restrict__ rope) {
    const int i = blockIdx.x * blockDim.x + threadIdx.x;
    if (i >= T * 16) return;
    const int t = i >> 4, j = i & 15;
    double invf, dm; cexp_d(-(double)j / 16.0 * 9.210340371976184, 0.0, invf, dm);
    const float ang = (float)pos[t] * (float)invf;
    double c, s; cexp_d(0.0, (double)ang, c, s);
    rope[i] = make_float2((float)c, (float)s);
}

__global__ void __launch_bounds__(256) k_gemm_win(const bf16_t* __restrict__ xn, const bf16_t* __restrict__ wt, bf16_t* __restrict__ cq, bf16_t* __restrict__ ckv,
                                                  bf16_t* __restrict__ u, float* __restrict__ krraw) {
    const int gw = blockIdx.x * 4 + (threadIdx.x >> 6), nw = gridDim.x * 4;
    for (int tl = gw; tl < (T / 32) * 32; tl += nw) {
        const int m0 = (tl >> 5) * 32, n0 = (tl & 31) * 32;
        sg_tile<false>(m0, n0, D,
            [&](int row) { return xn + (size_t)row * D; },
            [&](int n, int k, int) { return wt + (size_t)n * D + k; },
            [&](int t, int n, float v, float) {
                if (n < 256) cq[(size_t)t * 256 + n] = f2bf(v);
                else if (n < 768) {
                    const int ch = n - 256, g = ch >> 4, c = ch & 15, b = t >> 11, s = t & 2047, j = s >> 6, sl = s & 63;
                    u[((size_t)g * 512 + b * 32 + j) * 1024 + sl * 16 + c] = f2bf(v);
                } else if (n < 896) ckv[(size_t)t * 256 + (n - 768)] = f2bf(v);
                else {
                    ckv[(size_t)t * 256 + (n - 768)] = 0;
                    if (n < 928) krraw[(size_t)t * 32 + ropeperm(n - 896)] = v;
                }
            });
    }
}
__global__ void __launch_bounds__(256) k_rstat(const bf16_t* __restrict__ cq, const bf16_t* __restrict__ ckv, float* __restrict__ rsq, float* __restrict__ rskv) {
    const int lane = threadIdx.x & 63, w = threadIdx.x >> 6;
    for (int t = blockIdx.x * 4 + w; t < T; t += gridDim.x * 4) {
        float s = 0.f, s2 = 0.f;
#pragma unroll
        for (int i = 0; i < 4; ++i) { const float v = bf2f(cq[(size_t)t * 256 + i * 64 + lane]); s += v * v; }
#pragma unroll
        for (int i = 0; i < 2; ++i) { const float v = bf2f(ckv[(size_t)t * 256 + i * 64 + lane]); s2 += v * v; }
        s = wave_sum(s); s2 = wave_sum(s2);
        if (lane == 0) { rsq[t] = rsqrtf(s * (1.0f / 256) + EPS); rskv[t] = rsqrtf(s2 * (1.0f / 128) + EPS); }
    }
}
__global__ void __launch_bounds__(256) k_gemm_q(const bf16_t* __restrict__ cq, const bf16_t* __restrict__ wt, const float* __restrict__ rsq, bf16_t* __restrict__ Q, float* __restrict__ qrraw) {
    const int gw = blockIdx.x * 4 + (threadIdx.x >> 6), nw = gridDim.x * 4;
    for (int tl = gw; tl < (T / 32) * 24; tl += nw) {
        const int m0 = (tl / 24) * 32, n0 = (tl % 24) * 32;
        sg_tile<false>(m0, n0, 256,
            [&](int row) { return cq + (size_t)row * 256; },
            [&](int n, int k, int) { return wt + (size_t)n * 256 + k; },
            [&](int t, int n, float v, float) {
                v *= rsq[t];
                const int b = t >> 11, s = t & 2047;
                if (n < 512) Q[(((size_t)b * NH + (n >> 6)) * SEQ + s) * QKD + (n & 63)] = f2bf(v);
                else { const int m = n - 512; qrraw[(size_t)t * 256 + (m >> 5) * 32 + ropeperm(m & 31)] = v; }
            });
    }
}
__global__ void __launch_bounds__(256) k_gemm_kv(const bf16_t* __restrict__ ckv, const bf16_t* __restrict__ wt, const float* __restrict__ rskv, bf16_t* __restrict__ Kc, bf16_t* __restrict__ V) {
    const int gw = blockIdx.x * 4 + (threadIdx.x >> 6), nw = gridDim.x * 4;
    for (int tl = gw; tl < (T / 32) * 32; tl += nw) {
        const int m0 = (tl >> 5) * 32, n0 = (tl & 31) * 32;
        sg_tile<false>(m0, n0, 256,
            [&](int row) { return ckv + (size_t)row * 256; },
            [&](int n, int k, int) { return wt + (size_t)n * 256 + k; },
            [&](int t, int n, float v, float) {
                v *= rskv[t];
                const int b = t >> 11, s = t & 2047;
                if (n < 512) Kc[(((size_t)b * NH + (n >> 6)) * SEQ + s) * QKD + (n & 63)] = f2bf(v);
                else { const int m = n - 512; V[(((size_t)b * NH + (m >> 6)) * SEQ + s) * VD + (m & 63)] = f2bf(v); }
            });
    }
}
__global__ void __launch_bounds__(256) k_rope_apply(const float* __restrict__ qrraw, const float* __restrict__ krraw, const float2* __restrict__ rope, bf16_t* __restrict__ Q, bf16_t* __restrict__ Kc) {
    const int i = blockIdx.x * blockDim.x + threadIdx.x;
    if (i >= T * 9 * 16) return;
    const int j = i & 15, hh = (i >> 4) % 9, t = (i >> 4) / 9;
    const float2 cs = rope[t * 16 + j];
    const int b = t >> 11, s = t & 2047;
    if (hh < 8) {
        const float x1 = qrraw[(size_t)t * 256 + hh * 32 + j], x2 = qrraw[(size_t)t * 256 + hh * 32 + 16 + j];
        bf16_t* q = Q + (((size_t)b * NH + hh) * SEQ + s) * QKD + 64;
        q[j] = f2bf(x1 * cs.x - x2 * cs.y); q[16 + j] = f2bf(x2 * cs.x + x1 * cs.y);
    } else {
        const float x1 = krraw[(size_t)t * 32 + j], x2 = krraw[(size_t)t * 32 + 16 + j];
        const bf16_t o1 = f2bf(x1 * cs.x - x2 * cs.y), o2 = f2bf(x2 * cs.x + x1 * cs.y);
        for (int h = 0; h < NH; ++h) { bf16_t* k = Kc + (((size_t)b * NH + h) * SEQ + s) * QKD + 64; k[j] = o1; k[16 + j] = o2; }
    }
}
__global__ void __launch_bounds__(256) k_gemm_s5b(const bf16_t* __restrict__ u, const bf16_t* __restrict__ bloc, float* __restrict__ xloc) {
    const int gw = blockIdx.x * 4 + (threadIdx.x >> 6), nw = gridDim.x * 4;
    for (int tl = gw; tl < SG * 16 * 4; tl += nw) {
        const int g = tl >> 6, m0 = ((tl >> 2) & 15) * 32, n0 = (tl & 3) * 32;
        sg_tile<false>(m0, n0, 1024,
            [&](int row) { return u + ((size_t)g * 512 + row) * 1024; },
            [&](int n, int k, int) { return bloc + ((size_t)g * 256 + n) * 1024 + k; },
            [&](int row, int n, float v, float) { xloc[((size_t)g * 512 + row) * 128 + n] = v; });
    }
}
__global__ void __launch_bounds__(256) k_gemm_s5a(const bf16_t* __restrict__ u, const bf16_t* __restrict__ ktab, bf16_t* __restrict__ yintra) {
    const int gw = blockIdx.x * 4 + (threadIdx.x >> 6), nw = gridDim.x * 4;
    for (int tl = gw; tl < SG * 16 * 32; tl += nw) {
        const int g = tl >> 9, m0 = ((tl >> 5) & 15) * 32, n0 = (tl & 31) * 32;
        sg_tile<false>(m0, n0, 1024,
            [&](int row) { return u + ((size_t)g * 512 + row) * 1024; },
            [&](int n, int k, int) { const int t = n >> 4, c = n & 15, s = k >> 4, c0 = k & 15; return ktab + (((size_t)g * 127 + (t - s + 63)) * 16 + c) * 16 + c0; },
            [&](int row, int n, float v, float) {
                const int b = row >> 5, j = row & 31, t = n >> 4, c = n & 15;
                yintra[((size_t)b * SEQ + j * CH + t) * SSMW + g * SC + c] = f2bf(v);
            });
    }
}
__global__ void __launch_bounds__(64) k_attn_simple(const bf16_t* __restrict__ Q, const bf16_t* __restrict__ Kc, const bf16_t* __restrict__ V, bf16_t* __restrict__ AS) {
    __shared__ float qs[QKD];
    __shared__ float ps[SEQ];
    const int lane = threadIdx.x;
    for (int row = blockIdx.x; row < T * NH; row += gridDim.x) {
        const int bh = row >> 11, q = row & 2047, b = bh >> 3, h = bh & 7;
        __syncthreads();
        qs[lane] = bf2f(Q[(size_t)row * QKD + lane]);
        if (lane < 32) qs[64 + lane] = bf2f(Q[(size_t)row * QKD + 64 + lane]);
        __syncthreads();
        const int nk = ((q >> 6) + 1) * 64;
        float m = -INFINITY;
        for (int kb = 0; kb < nk; kb += 64) {
            const bf16_t* kp = Kc + ((size_t)bh * SEQ + kb + lane) * QKD;
            float s = 0.f;
#pragma unroll
            for (int c = 0; c < 12; ++c) {
                const bf16x8 kv = *(const bf16x8*)(kp + c * 8);
#pragma unroll
                for (int e = 0; e < 8; ++e) s += qs[c * 8 + e] * bf2f((bf16_t)kv[e]);
            }
            ps[kb + lane] = s; m = fmaxf(m, s);
        }
        m = wave_max(m);
        float l = 0.f;
        for (int kb = 0; kb < nk; kb += 64) { const float p = exp2f(ps[kb + lane] - m); ps[kb + lane] = p; l += p; }
        l = wave_sum(l);
        __syncthreads();
        float o = 0.f;
        const bf16_t* vp = V + (size_t)bh * SEQ * VD + lane;
        for (int k = 0; k < nk; ++k) o += ps[k] * bf2f(vp[(size_t)k * VD]);
        AS[((size_t)b * SEQ + q) * 1024 + h * 64 + lane] = f2bf(o / l);
    }
}
__global__ void __launch_bounds__(256) k_s5scan(const float* __restrict__ xloc, const float2* __restrict__ lampow, bf16_t* __restrict__ xprev) {
    const int i = blockIdx.x * blockDim.x + threadIdx.x;
    if (i >= SG * NB * SP) return;
    const int p = i & 63, b = (i >> 6) & 15, g = i >> 10;
    const float2 l64 = lampow[(g * SP + p) * 65 + 64];
    float xr = 0.f, xi = 0.f;
    for (int j = 0; j < NCH; ++j) {
        const size_t row = (size_t)g * 512 + b * 32 + j;
        bf16_t* xp = xprev + row * 256;
        xp[p] = f2bf(xr); xp[64 + p] = f2bf(xi); xp[128 + p] = 0; xp[192 + p] = 0;
        const float lr = xloc[row * 128 + p], li = xloc[row * 128 + 64 + p];
        const float nr = l64.x * xr - l64.y * xi + lr, ni = l64.x * xi + l64.y * xr + li;
        xr = nr; xi = ni;
    }
}
__global__ void __launch_bounds__(256) k_gemm_s5d(const bf16_t* __restrict__ xprev, const bf16_t* __restrict__ clam, const bf16_t* __restrict__ yintra, bf16_t* __restrict__ Y) {
    const int gw = blockIdx.x * 4 + (threadIdx.x >> 6), nw = gridDim.x * 4;
    for (int tl = gw; tl < SG * 16 * 32; tl += nw) {
        const int g = tl >> 9, m0 = ((tl >> 5) & 15) * 32, n0 = (tl & 31) * 32;
        sg_tile<false>(m0, n0, 256,
            [&](int row) { return xprev + ((size_t)g * 512 + row) * 256; },
            [&](int n, int k, int) { return clam + ((size_t)g * 1024 + n) * 256 + k; },
            [&](int row, int n, float v, float) {
                const int b = row >> 5, j = row & 31, t = n >> 4, c = n & 15;
                const size_t o = ((size_t)b * SEQ + j * CH + t) * SSMW + g * SC + c;
                Y[o] = f2bf(gelu_tanh(v + bf2f(yintra[o])));
            });
    }
}
__global__ void __launch_bounds__(256) k_gemm_glu(const bf16_t* __restrict__ Y, const bf16_t* __restrict__ wt, const float* __restrict__ bglu, bf16_t* __restrict__ AS) {
    const int gw = blockIdx.x * 4 + (threadIdx.x >> 6), nw = gridDim.x * 4;
    for (int tl = gw; tl < (T / 32) * 16; tl += nw) {
        const int m0 = (tl >> 4) * 32, n0 = (tl & 15) * 32;
        sg_tile<false>(m0, n0, 512,
            [&](int row) { return Y + (size_t)row * 512; },
            [&](int n, int k, int) { return wt + (size_t)n * 512 + k; },
            [&](int t, int n, float v, float) {
                const float yv = bf2f(Y[(size_t)t * 512 + n]);
                AS[(size_t)t * 1024 + 512 + n] = f2bf(yv * sigmoidf_(v + bglu[n]));
            });
    }
}
__global__ void __launch_bounds__(256) k_asnorm(bf16_t* __restrict__ AS) {
    const int lane = threadIdx.x & 63, w = threadIdx.x >> 6;
    for (int t = blockIdx.x * 4 + w; t < T; t += gridDim.x * 4) {
        bf16_t* r = AS + (size_t)t * 1024;
        float va[8], vs[8]; float sa = 0.f, ss = 0.f;
        const bf16x8 a = *(const bf16x8*)(r + lane * 8), s = *(const bf16x8*)(r + 512 + lane * 8);
#pragma unroll
        for (int i = 0; i < 8; ++i) { va[i] = bf2f((bf16_t)a[i]); vs[i] = bf2f((bf16_t)s[i]); sa += va[i] * va[i]; ss += vs[i] * vs[i]; }
        const float ra = rsqrtf(wave_sum(sa) * (1.0f / 512) + EPS), rs = rsqrtf(wave_sum(ss) * (1.0f / 512) + EPS);
        bf16x8 oa, os;
#pragma unroll
        for (int i = 0; i < 8; ++i) { oa[i] = (short)f2bf(va[i] * ra); os[i] = (short)f2bf(vs[i] * rs); }
        *(bf16x8*)(r + lane * 8) = oa; *(bf16x8*)(r + 512 + lane * 8) = os;
    }
}
__global__ void __launch_bounds__(256) k_gemm_wo(const bf16_t* __restrict__ AS, const bf16_t* __restrict__ wt, const float* __restrict__ x, const float* __restrict__ xstat,
                                                 const float* __restrict__ g, const float* __restrict__ bta, float* __restrict__ pre1) {
    const int gw = blockIdx.x * 4 + (threadIdx.x >> 6), nw = gridDim.x * 4;
    for (int tl = gw; tl < (T / 32) * 32; tl += nw) {
        const int m0 = (tl >> 5) * 32, n0 = (tl & 31) * 32;
        sg_tile<false>(m0, n0, 1024,
            [&](int row) { return AS + (size_t)row * 1024; },
            [&](int n, int k, int) { return wt + (size_t)n * 1024 + k; },
            [&](int t, int n, float v, float) {
                const float xn = (x[(size_t)t * D + n] - xstat[2 * t]) * xstat[2 * t + 1] * g[n] + bta[n];
                pre1[(size_t)t * D + n] = v + ALPHA * xn;
            });
    }
}
__global__ void __launch_bounds__(256) k_ln1(const float* __restrict__ pre1, const float* __restrict__ g, const float* __restrict__ b, bf16_t* __restrict__ x1, bf16_t* __restrict__ x1lo) {
    const int lane = threadIdx.x & 63, w = threadIdx.x >> 6;
    for (int t = blockIdx.x * 4 + w; t < T; t += gridDim.x * 4) {
        const float* xr = pre1 + (size_t)t * D;
        float v[16]; float s = 0.f;
#pragma unroll
        for (int i = 0; i < 4; ++i) { const f32x4 q = *(const f32x4*)(xr + i * 256 + lane * 4); v[4 * i] = q[0]; v[4 * i + 1] = q[1]; v[4 * i + 2] = q[2]; v[4 * i + 3] = q[3]; s += q[0] + q[1] + q[2] + q[3]; }
        const float mu = wave_sum(s) * (1.0f / D);
        float ss = 0.f;
#pragma unroll
        for (int i = 0; i < 16; ++i) { const float d = v[i] - mu; ss += d * d; }
        const float rstd = rsqrtf(wave_sum(ss) * (1.0f / D) + EPS);
#pragma unroll
        for (int i = 0; i < 4; ++i) {
            const int c = i * 256 + lane * 4;
            const f32x4 gg = *(const f32x4*)(g + c), bb = *(const f32x4*)(b + c);
            ushort4 o, ol;
            float y;
            y = (v[4 * i] - mu) * rstd * gg[0] + bb[0];     o.x = f2bf(y); ol.x = f2bf(y - bf2f(o.x));
            y = (v[4 * i + 1] - mu) * rstd * gg[1] + bb[1]; o.y = f2bf(y); ol.y = f2bf(y - bf2f(o.y));
            y = (v[4 * i + 2] - mu) * rstd * gg[2] + bb[2]; o.z = f2bf(y); ol.z = f2bf(y - bf2f(o.z));
            y = (v[4 * i + 3] - mu) * rstd * gg[3] + bb[3]; o.w = f2bf(y); ol.w = f2bf(y - bf2f(o.w));
            *(ushort4*)(x1 + (size_t)t * D + c) = o; *(ushort4*)(x1lo + (size_t)t * D + c) = ol;
        }
    }
}
__global__ void __launch_bounds__(256) k_router(const bf16_t* __restrict__ x1, const bf16_t* __restrict__ x1lo, const float* __restrict__ wr, float* __restrict__ logits) {
    const int e = threadIdx.x & 63, w = threadIdx.x >> 6;
    for (int t = blockIdx.x * 4 + w; t < T; t += gridDim.x * 4) {
        const bf16_t* a = x1 + (size_t)t * D; const bf16_t* al = x1lo + (size_t)t * D;
        float s = 0.f;
        for (int k = 0; k < D; k += 8) {
            const bf16x8 hi = *(const bf16x8*)(a + k), lo = *(const bf16x8*)(al + k);
#pragma unroll
            for (int i = 0; i < 8; ++i) s += (bf2f((bf16_t)hi[i]) + bf2f((bf16_t)lo[i])) * wr[(size_t)(k + i) * NE + e];
        }
        logits[(size_t)t * NE + e] = s;
    }
}
__global__ void __launch_bounds__(256) k_topk(const float* __restrict__ logits, const float* __restrict__ rbias, int* __restrict__ topi, float* __restrict__ topw) {
    const int lane = threadIdx.x & 63, w = threadIdx.x >> 6;
    for (int t = blockIdx.x * 4 + w; t < T; t += gridDim.x * 4) {
        const float sc = sigmoidf_(logits[(size_t)t * NE + lane]);
        const float sel = sc + rbias[lane];
        const int grp = lane >> 3;
        float m1 = sel;
        m1 = fmaxf(m1, __shfl_xor(m1, 1)); m1 = fmaxf(m1, __shfl_xor(m1, 2)); m1 = fmaxf(m1, __shfl_xor(m1, 4));
        const unsigned long long bal = __ballot(sel == m1) & (0xFFull << (8 * grp));
        const int first = __ffsll((long long)bal) - 1;
        float m2 = (lane == first) ? -INFINITY : sel;
        m2 = fmaxf(m2, __shfl_xor(m2, 1)); m2 = fmaxf(m2, __shfl_xor(m2, 2)); m2 = fmaxf(m2, __shfl_xor(m2, 4));
        const float gs = m1 + m2;
        int cg = 0;
#pragma unroll
        for (int gj = 0; gj < 8; ++gj) { const float sj = __shfl(gs, gj * 8); cg += (sj > gs || (sj == gs && gj < grp)) ? 1 : 0; }
        const bool gsel = cg < 4;
        const float v = gsel ? sel : -INFINITY;
        int rank = 0;
        for (int e2 = 0; e2 < 64; ++e2) { const float ve = __shfl(v, e2); rank += (ve > v || (ve == v && e2 < lane)) ? 1 : 0; }
        const bool chosen = gsel && rank < TOPK;
        const float wsum = wave_sum(chosen ? sc : 0.f);
        if (chosen) { topi[(size_t)t * TOPK + rank] = lane; topw[(size_t)t * TOPK + rank] = sc / wsum * 2.5f; }
    }
}
__global__ void __launch_bounds__(64) k_cnt(const int* __restrict__ topi, int* __restrict__ cnt) {
    const int tile = blockIdx.x, e = threadIdx.x;
    int c = 0;
    for (int i = 0; i < 1024; ++i) c += (topi[tile * 1024 + i] == e) ? 1 : 0;
    cnt[tile * 64 + e] = c;
}
__global__ void __launch_bounds__(64) k_off(const int* __restrict__ cnt, int* __restrict__ toff, int* __restrict__ eoff, int* __restrict__ ecnt) {
    __shared__ int tot[64], off[65];
    const int e = threadIdx.x;
    int s = 0;
    for (int tile = 0; tile < 256; ++tile) s += cnt[tile * 64 + e];
    tot[e] = s; ecnt[e] = s;
    __syncthreads();
    if (e == 0) { int o = 0; for (int i = 0; i < 64; ++i) { off[i] = o; o += (tot[i] + 255) & ~255; } off[64] = o; }
    __syncthreads();
    eoff[e] = off[e]; if (e == 0) eoff[64] = off[64];
    int run = off[e];
    for (int tile = 0; tile < 256; ++tile) { toff[tile * 64 + e] = run; run += cnt[tile * 64 + e]; }
}
__global__ void __launch_bounds__(64) k_lists(const int* __restrict__ topi, const float* __restrict__ topw, const int* __restrict__ toff, const int* __restrict__ eoff,
                                              int* __restrict__ rowtok, float* __restrict__ roww) {
    const int tile = blockIdx.x, e = threadIdx.x;
    int pos = toff[tile * 64 + e];
    for (int i = 0; i < 1024; ++i) {
        if (topi[tile * 1024 + i] == e) { rowtok[pos] = tile * 1024 + i; roww[pos] = topw[tile * 1024 + i]; ++pos; }
    }
    if (tile == 255) { const int end = eoff[e + 1]; for (; pos < end; ++pos) { rowtok[pos] = -1; roww[pos] = 0.f; } }
}
__global__ void __launch_bounds__(256) k_gemm_gu(const bf16_t* __restrict__ x1, const bf16_t* __restrict__ wgu, const int* __restrict__ rowtok, const float* __restrict__ roww,
                                                 const int* __restrict__ eoff, bf16_t* __restrict__ H) {
    const int gw = blockIdx.x * 4 + (threadIdx.x >> 6), nw = gridDim.x * 4;
    const int nrt = eoff[64] / 32;
    const int ntl = (nrt + T / 32) * 8;
    for (int tl = gw; tl < ntl; tl += nw) {
        const int rt = tl >> 3, n0 = (tl & 7) * 32;
        if (rt < nrt) {
            const int m0 = rt * 32;
            int e = 0; while (e < 63 && eoff[e + 1] <= m0) ++e;
            const bf16_t* w = wgu + (size_t)e * 512 * 1024;
            sg_tile<true>(m0, n0, 1024,
                [&](int row) { const int s = rowtok[row]; return x1 + (size_t)(s >= 0 ? (s >> 3) : 0) * D; },
                [&](int f, int k, int which) { return w + (size_t)((f >> 7) * 256 + (f & 127) + which * 128) * 1024 + k; },
                [&](int row, int f, float gv, float uv) { H[(size_t)row * FF + f] = f2bf(gv * sigmoidf_(gv) * uv * roww[row]); });
        } else {
            const int m0 = (rt - nrt) * 32;
            const bf16_t* w = wgu + (size_t)64 * 512 * 1024;
            sg_tile<true>(m0, n0, 1024,
                [&](int row) { return x1 + (size_t)row * D; },
                [&](int f, int k, int which) { return w + (size_t)((f >> 7) * 256 + (f & 127) + which * 128) * 1024 + k; },
                [&](int row, int f, float gv, float uv) { H[(size_t)(SH_ROW0 + row) * FF + f] = f2bf(gv * sigmoidf_(gv) * uv); });
        }
    }
}
__device__ __forceinline__ unsigned char f2fp8(float v) { const int p = __builtin_amdgcn_cvt_pk_fp8_f32(v, v, 0, false); return (unsigned char)(p & 0xff); }
__global__ void __launch_bounds__(256) k_gemm_down(const bf16_t* __restrict__ H, const bf16_t* __restrict__ wd, const int* __restrict__ rowtok, const int* __restrict__ eoff,
                                                   const bf16_t* __restrict__ x1, unsigned char* __restrict__ yslot, float* __restrict__ out) {
    const int gw = blockIdx.x * 4 + (threadIdx.x >> 6), nw = gridDim.x * 4;
    const int nrt = eoff[64] / 32;
    const int ntl = (nrt + T / 32) * 32;
    for (int tl = gw; tl < ntl; tl += nw) {
        const int rt = tl >> 5, n0 = (tl & 31) * 32;
        if (rt < nrt) {
            const int m0 = rt * 32;
            int e = 0; while (e < 63 && eoff[e + 1] <= m0) ++e;
            const bf16_t* w = wd + (size_t)e * 1024 * 256;
            sg_tile<false>(m0, n0, 256,
                [&](int row) { return H + (size_t)row * FF; },
                [&](int n, int k, int) { return w + (size_t)n * 256 + k; },
                [&](int row, int n, float v, float) { const int s = rowtok[row]; if (s >= 0) yslot[(size_t)s * D + n] = f2fp8(v * SLOT_SCALE); });
        } else {
            const int m0 = (rt - nrt) * 32;
            const bf16_t* w = wd + (size_t)64 * 1024 * 256;
            sg_tile<false>(m0, n0, 256,
                [&](int row) { return H + (size_t)(SH_ROW0 + row) * FF; },
                [&](int n, int k, int) { return w + (size_t)n * 256 + k; },
                [&](int t, int n, float v, float) { out[(size_t)t * D + n] = v + ALPHA * bf2f(x1[(size_t)t * D + n]); });
        }
    }
}
__global__ void __launch_bounds__(256) k_combine(const unsigned char* __restrict__ yslot, const float* __restrict__ g, const float* __restrict__ b, float* __restrict__ out) {
    const int lane = threadIdx.x & 63, w = threadIdx.x >> 6;
    for (int t = blockIdx.x * 4 + w; t < T; t += gridDim.x * 4) {
        float* orow = out + (size_t)t * D + lane * 16;
        float v[16];
#pragma unroll
        for (int i = 0; i < 4; ++i) { const f32x4 q = *(const f32x4*)(orow + 4 * i); v[4 * i] = q[0]; v[4 * i + 1] = q[1]; v[4 * i + 2] = q[2]; v[4 * i + 3] = q[3]; }
#pragma unroll
        for (int k = 0; k < TOPK; ++k) {
            const u32x4 q = *(const u32x4*)(yslot + ((size_t)t * TOPK + k) * D + lane * 16);
#pragma unroll
            for (int i = 0; i < 4; ++i) {
                v[4 * i]     += __builtin_amdgcn_cvt_f32_fp8((int)q[i], 0) * (1.0f / SLOT_SCALE);
                v[4 * i + 1] += __builtin_amdgcn_cvt_f32_fp8((int)q[i], 1) * (1.0f / SLOT_SCALE);
                v[4 * i + 2] += __builtin_amdgcn_cvt_f32_fp8((int)q[i], 2) * (1.0f / SLOT_SCALE);
                v[4 * i + 3] += __builtin_amdgcn_cvt_f32_fp8((int)q[i], 3) * (1.0f / SLOT_SCALE);
            }
        }
        float s = 0.f;
#pragma unroll
        for (int i = 0; i < 16; ++i) s += v[i];
        const float mu = wave_sum(s) * (1.0f / D);
        float ss = 0.f;
#pragma unroll
        for (int i = 0; i < 16; ++i) { const float d = v[i] - mu; ss += d * d; }
        const float rstd = rsqrtf(wave_sum(ss) * (1.0f / D) + EPS);
#pragma unroll
        for (int i = 0; i < 4; ++i) {
            const int c = lane * 16 + 4 * i;
            const f32x4 gg = *(const f32x4*)(g + c), bb = *(const f32x4*)(b + c);
            f32x4 o;
            o[0] = (v[4 * i] - mu) * rstd * gg[0] + bb[0]; o[1] = (v[4 * i + 1] - mu) * rstd * gg[1] + bb[1];
            o[2] = (v[4 * i + 2] - mu) * rstd * gg[2] + bb[2]; o[3] = (v[4 * i + 3] - mu) * rstd * gg[3] + bb[3];
            *(f32x4*)(orow + 4 * i) = o;
        }
    }
}

extern "C" void kernel_launch(void* const* d_in, const int* in_sizes, int n_in, void* d_out, int out_size, void* d_ws, size_t ws_size, hipStream_t stream) {
    (void)in_sizes; (void)n_in; (void)out_size;
    if (ws_size < WS_NEED) return;
    char* ws = (char*)d_ws;
    const float* x = (const float*)d_in[0]; const int* positions = (const int*)d_in[1];
    const float* ln_in_g = (const float*)d_in[2]; const float* ln_in_b = (const float*)d_in[3];
    const float* w_in = (const float*)d_in[4]; const float* q_norm_g = (const float*)d_in[5]; const float* kv_norm_g = (const float*)d_in[6];
    const float* w_uq = (const float*)d_in[7]; const float* w_ukv = (const float*)d_in[8];
    const float* lambda_re = (const float*)d_in[9]; const float* lambda_im = (const float*)d_in[10]; const float* log_step = (const float*)d_in[11];
    const float* b_re = (const float*)d_in[12]; const float* b_im = (const float*)d_in[13]; const float* c_re = (const float*)d_in[14]; const float* c_im = (const float*)d_in[15];
    const float* d_skip = (const float*)d_in[16]; const float* w_glu = (const float*)d_in[17]; const float* b_glu = (const float*)d_in[18];
    const float* attn_out_g = (const float*)d_in[19]; const float* ssm_out_g = (const float*)d_in[20]; const float* w_o = (const float*)d_in[21];
    const float* ln1_g = (const float*)d_in[22]; const float* ln1_b = (const float*)d_in[23]; const float* w_router = (const float*)d_in[24]; const float* router_bias = (const float*)d_in[25];
    const float* w_gate = (const float*)d_in[26]; const float* w_up = (const float*)d_in[27]; const float* w_down = (const float*)d_in[28];
    const float* ws_gate = (const float*)d_in[29]; const float* ws_up = (const float*)d_in[30]; const float* ws_down = (const float*)d_in[31];
    const float* ln2_g = (const float*)d_in[32]; const float* ln2_b = (const float*)d_in[33];
    float* out = (float*)d_out;

    bf16_t* XN = (bf16_t*)(ws + WS_XN); bf16_t* AS = (bf16_t*)(ws + WS_AS); bf16_t* X1 = (bf16_t*)(ws + WS_X1); bf16_t* X1LO = (bf16_t*)(ws + WS_X1LO);
    float* XSTAT = (float*)(ws + WS_XSTAT); float* RSQ = (float*)(ws + WS_RSQ); float* RSKV = (float*)(ws + WS_RSKV);
    bf16_t* WIN = (bf16_t*)(ws + WS_WIN); bf16_t* WO = (bf16_t*)(ws + WS_WO); bf16_t* WUQ = (bf16_t*)(ws + WS_WUQ); bf16_t* WUKV = (bf16_t*)(ws + WS_WUKV); bf16_t* WGLU = (bf16_t*)(ws + WS_WGLU);
    bf16_t* WGU = (bf16_t*)(ws + WS_WGU); bf16_t* WD = (bf16_t*)(ws + WS_WD);
    bf16_t* BLOC = (bf16_t*)(ws + WS_BLOC); bf16_t* CLAM = (bf16_t*)(ws + WS_CLAM); bf16_t* KTAB = (bf16_t*)(ws + WS_KTAB);
    float2* LAMPOW = (float2*)(ws + WS_LAMPOW); float2* BBAR = (float2*)(ws + WS_BBAR); float2* ROPET = (float2*)(ws + WS_ROPE);
    bf16_t* CQ = (bf16_t*)(ws + WS_CQ); bf16_t* CKV = (bf16_t*)(ws + WS_CKV); bf16_t* U = (bf16_t*)(ws + WS_U);
    bf16_t* YINTRA = (bf16_t*)(ws + WS_YINTRA); bf16_t* Y = (bf16_t*)(ws + WS_Y); float* QRRAW = (float*)(ws + WS_QRRAW); float* KRRAW = (float*)(ws + WS_KRRAW);
    float* XLOC = (float*)(ws + WS_XLOC); bf16_t* XPREV = (bf16_t*)(ws + WS_XPREV); float* LOGITS = (float*)(ws + WS_LOGITS);
    bf16_t* Q = (bf16_t*)(ws + WS_Q); bf16_t* Kc = (bf16_t*)(ws + WS_K); bf16_t* V = (bf16_t*)(ws + WS_V);
    int* TOPI = (int*)(ws + WS_TOPI); float* TOPW = (float*)(ws + WS_TOPW); int* ROWTOK = (int*)(ws + WS_ROWTOK); float* ROWW = (float*)(ws + WS_ROWW);
    int* CNT = (int*)(ws + WS_CNT); int* TOFF = (int*)(ws + WS_TOFF); int* EOFF = (int*)(ws + WS_EOFF); int* ECNT = (int*)(ws + WS_ECNT);
    bf16_t* H = (bf16_t*)(ws + WS_H); unsigned char* YSLOT = (unsigned char*)(ws + WS_YSLOT);

    k_ln_in<<<2048, 256, 0, stream>>>(x, ln_in_g, ln_in_b, XN, XSTAT);
    {
        WPrep p;
        p = mk_wprep(w_in, nullptr, nullptr, nullptr, WIN, 0, 1024, 1024, 928, 1024, 0, 0, 1.0f);                 k_wprep<<<dim3(256, 1), 256, 0, stream>>>(p);
        p = mk_wprep(w_uq, nullptr, q_norm_g, nullptr, WUQ, 1, 768, 256, 768, 256, 0, 0, QSCALE);                  k_wprep<<<dim3(48, 1), 256, 0, stream>>>(p);
        p = mk_wprep(w_ukv, nullptr, kv_norm_g, nullptr, WUKV, 2, 1024, 256, 1024, 128, 0, 0, 1.0f);               k_wprep<<<dim3(64, 1), 256, 0, stream>>>(p);
        p = mk_wprep(w_glu, nullptr, nullptr, nullptr, WGLU, 3, 512, 512, 512, 512, 0, 0, 1.0f);                   k_wprep<<<dim3(64, 1), 256, 0, stream>>>(p);
        p = mk_wprep(w_o, nullptr, attn_out_g, ssm_out_g, WO, 4, 1024, 1024, 1024, 1024, 0, 0, 1.0f);              k_wprep<<<dim3(256, 1), 256, 0, stream>>>(p);
        p = mk_wprep(w_gate, w_up, nullptr, nullptr, WGU, 5, 512, 1024, 256, 1024, (size_t)1024 * 256, (size_t)512 * 1024, 1.0f);   k_wprep<<<dim3(128, 64), 256, 0, stream>>>(p);
        p = mk_wprep(ws_gate, ws_up, nullptr, nullptr, WGU + (size_t)64 * 512 * 1024, 5, 512, 1024, 256, 1024, 0, 0, 1.0f);         k_wprep<<<dim3(128, 1), 256, 0, stream>>>(p);
        p = mk_wprep(w_down, nullptr, nullptr, nullptr, WD, 6, 1024, 256, 1024, 256, (size_t)256 * 1024, (size_t)1024 * 256, 1.0f); k_wprep<<<dim3(64, 64), 256, 0, stream>>>(p);
        p = mk_wprep(ws_down, nullptr, nullptr, nullptr, WD + (size_t)64 * 1024 * 256, 6, 1024, 256, 1024, 256, 0, 0, 1.0f);       k_wprep<<<dim3(64, 1), 256, 0, stream>>>(p);
    }
    k_s5tab1<<<SG, 64, 0, stream>>>(lambda_re, lambda_im, log_step, b_re, b_im, LAMPOW, BBAR);
    k_s5tab2<<<2048, 256, 0, stream>>>(LAMPOW, BBAR, c_re, c_im, d_skip, KTAB, BLOC, CLAM);
    k_ropetab<<<T * 16 / 256, 256, 0, stream>>>(positions, ROPET);
    k_gemm_win<<<2048, 256, 0, stream>>>(XN, WIN, CQ, CKV, U, KRRAW);
    k_rstat<<<2048, 256, 0, stream>>>(CQ, CKV, RSQ, RSKV);
    k_gemm_q<<<2048, 256, 0, stream>>>(CQ, WUQ, RSQ, Q, QRRAW);
    k_gemm_kv<<<2048, 256, 0, stream>>>(CKV, WUKV, RSKV, Kc, V);
    k_rope_apply<<<(T * 9 * 16 + 255) / 256, 256, 0, stream>>>(QRRAW, KRRAW, ROPET, Q, Kc);
    k_gemm_s5b<<<512, 256, 0, stream>>>(U, BLOC, XLOC);
    k_gemm_s5a<<<2048, 256, 0, stream>>>(U, KTAB, YINTRA);
    k_attn_simple<<<8192, 64, 0, stream>>>(Q, Kc, V, AS);
    k_s5scan<<<SG * NB * SP / 256, 256, 0, stream>>>(XLOC, LAMPOW, XPREV);
    k_gemm_s5d<<<2048, 256, 0, stream>>>(XPREV, CLAM, YINTRA, Y);
    k_gemm_glu<<<2048, 256, 0, stream>>>(Y, WGLU, b_glu, AS);
    k_asnorm<<<2048, 256, 0, stream>>>(AS);
    k_gemm_wo<<<2048, 256, 0, stream>>>(AS, WO, x, XSTAT, ln_in_g, ln_in_b, out);
    k_ln1<<<2048, 256, 0, stream>>>(out, ln1_g, ln1_b, X1, X1LO);
    k_router<<<2048, 256, 0, stream>>>(X1, X1LO, w_router, LOGITS);
    k_topk<<<2048, 256, 0, stream>>>(LOGITS, router_bias, TOPI, TOPW);
    k_cnt<<<256, 64, 0, stream>>>(TOPI, CNT);
    k_off<<<1, 64, 0, stream>>>(CNT, TOFF, EOFF, ECNT);
    k_lists<<<256, 64, 0, stream>>>(TOPI, TOPW, TOFF, EOFF, ROWTOK, ROWW);
    k_gemm_gu<<<2048, 256, 0, stream>>>(X1, WGU, ROWTOK, ROWW, EOFF, H);
    k_gemm_down<<<2048, 256, 0, stream>>>(H, WD, ROWTOK, EOFF, X1, YSLOT, out);
    k_combine<<<2048, 256, 0, stream>>>(YSLOT, ln2_g, ln2_b, out);
}
```

```cpp
#include <hip/hip_runtime.h>
#include <stdint.h>
#include <string.h>

typedef unsigned short bf16_t;
typedef short bf16x8 __attribute__((ext_vector_type(8)));
typedef float f32x16 __attribute__((ext_vector_type(16)));
typedef float f32x4 __attribute__((ext_vector_type(4)));
typedef unsigned u32x4 __attribute__((ext_vector_type(4)));

constexpr int T = 32768, D = 1024, SEQ = 2048, NB = 16;
constexpr int NH = 8, QKD = 96, VD = 64;
constexpr int QRANK = 256, KVRANK = 128, ROPE = 32;
constexpr int SSMW = 512, SG = 32, SC = 16, SP = 64, CH = 64, NCH = SEQ / CH;
constexpr int NE = 64, TOPK = 8, FF = 256;
constexpr float ALPHA = 1.189207115002721f;
constexpr float EPS = 1e-5f;
constexpr float QSCALE = 0.10206207261596577f * 1.4426950408889634f;
constexpr float SLOT_SCALE = 64.0f;
constexpr int RROUT = 278528;
constexpr int SH_ROW0 = RROUT;
constexpr int RTOT = RROUT + T;

constexpr size_t MiB = 1ull << 20;
constexpr size_t WS_CTL = 0;
constexpr size_t WS_TOPI = 1 * MiB, WS_TOPW = 2 * MiB, WS_ROWTOK = 3 * MiB, WS_ROWW = 4 * MiB + MiB / 2;
constexpr size_t WS_CNT = 6 * MiB, WS_TOFF = 6 * MiB + 65536, WS_EOFF = 6 * MiB + 131072, WS_ECNT = 6 * MiB + 131072 + 1024;
constexpr size_t WS_WD = 7 * MiB;
constexpr size_t WS_X1 = 40 * MiB;
constexpr size_t WS_XN = WS_X1, WS_AS = WS_X1;
constexpr size_t WS_H = 104 * MiB;
constexpr size_t WS_CQ = 104 * MiB, WS_CKV = 120 * MiB, WS_U = 136 * MiB, WS_YINTRA = 168 * MiB, WS_Y = 200 * MiB;
constexpr size_t WS_QRRAW = 200 * MiB;
constexpr size_t WS_XLOC = 232 * MiB, WS_XPREV = 240 * MiB, WS_LOGITS = 248 * MiB, WS_KRRAW = 248 * MiB;
constexpr size_t WS_X1LO = 104 * MiB;
constexpr size_t WS_YSLOT = 256 * MiB;
constexpr size_t WS_WGU = 256 * MiB;
constexpr size_t WS_WIN = 321 * MiB, WS_WO = 323 * MiB, WS_WUQ = 325 * MiB, WS_WUKV = 325 * MiB + MiB / 2, WS_WGLU = 326 * MiB;
constexpr size_t WS_BLOC = 327 * MiB, WS_CLAM = 343 * MiB, WS_KTAB = 359 * MiB, WS_LAMPOW = 361 * MiB, WS_BBAR = 363 * MiB;
constexpr size_t WS_ROPE = 364 * MiB, WS_XSTAT = 368 * MiB, WS_RSQ = 368 * MiB + MiB / 2, WS_RSKV = WS_RSQ + 131072;
constexpr size_t WS_Q = 370 * MiB, WS_K = 418 * MiB, WS_V = 466 * MiB;
constexpr size_t WS_NEED = 512 * MiB;

__device__ __forceinline__ bf16_t f2bf(float f) { unsigned u = __float_as_uint(f); u += 0x7fffu + ((u >> 16) & 1u); return (bf16_t)(u >> 16); }
__device__ __forceinline__ float bf2f(bf16_t b) { return __uint_as_float(((unsigned)b) << 16); }
__device__ __forceinline__ int crow(int i, int h) { return (i & 3) + 8 * (i >> 2) + 4 * h; }
__device__ __forceinline__ float wave_sum(float v) {
#pragma unroll
    for (int o = 32; o > 0; o >>= 1) v += __shfl_xor(v, o);
    return v;
}
__device__ __forceinline__ float wave_max(float v) {
#pragma unroll
    for (int o = 32; o > 0; o >>= 1) v = fmaxf(v, __shfl_xor(v, o));
    return v;
}
__device__ __forceinline__ float sigmoidf_(float z) { return 1.0f / (1.0f + __expf(-z)); }
__device__ __forceinline__ float gelu_tanh(float y) {
    const float z = 0.7978845608028654f * (y + 0.044715f * y * y * y);
    const float th = 1.0f - 2.0f / (1.0f + __expf(2.0f * z));
    return 0.5f * y * (1.0f + th);
}
__host__ __device__ __forceinline__ int ropeperm(int q) { return 16 * ((q >> 2) & 1) + 4 * (q >> 3) + (q & 3); }
__host__ __device__ __forceinline__ int ropepos(int j) { const int n = j >> 4, r = j & 15; return 8 * (r >> 2) + 4 * n + (r & 3); }

__device__ __forceinline__ void cexp_d(double re, double im, double& ore, double& oim) {
    const double s = 1.0 / 1048576.0;
    const double a = re * s, b = im * s;
    double tr = 1.0, ti = 0.0, sr = 1.0, si = 0.0;
#pragma unroll
    for (int n = 1; n <= 8; ++n) {
        const double nr = (tr * a - ti * b) / n, ni = (tr * b + ti * a) / n;
        tr = nr; ti = ni; sr += tr; si += ti;
    }
#pragma unroll
    for (int i = 0; i < 20; ++i) { const double nr = sr * sr - si * si, ni = 2.0 * sr * si; sr = nr; si = ni; }
    ore = sr; oim = si;
}

template <bool DUAL, class AF, class BF, class EPI>
__device__ __forceinline__ void sg_tile(int m0, int n0, int K, AF arow, BF bptr, EPI epi) {
    const int lane = threadIdx.x & 63, r = lane & 31, h = lane >> 5;
    f32x16 acc, acc2;
#pragma unroll
    for (int i = 0; i < 16; ++i) { acc[i] = 0.f; acc2[i] = 0.f; }
    const bf16_t* ap = arow(m0 + r);
    for (int k0 = 0; k0 < K; k0 += 16) {
        const bf16x8 a = *(const bf16x8*)(ap + k0 + 8 * h);
        const bf16x8 b = *(const bf16x8*)(bptr(n0 + r, k0 + 8 * h, 0));
        acc = __builtin_amdgcn_mfma_f32_32x32x16_bf16(a, b, acc, 0, 0, 0);
        if (DUAL) {
            const bf16x8 b2 = *(const bf16x8*)(bptr(n0 + r, k0 + 8 * h, 1));
            acc2 = __builtin_amdgcn_mfma_f32_32x32x16_bf16(a, b2, acc2, 0, 0, 0);
        }
    }
#pragma unroll
    for (int i = 0; i < 16; ++i) epi(m0 + crow(i, h), n0 + r, acc[i], acc2[i]);
}

#define LAS __attribute__((address_space(3)))
#define XB_TMO      128
#define XB_XCNT(j)  (256  + 64 * (j))
#define XB_XSUB(j)  (1280 + 64 * (j))
#define XB_XGEN(j)  (2304 + 64 * (j))
#define XB_TOP      3328
#define XB_TOPGEN   3392
#define XCD_BAR_WORDS 3456
#define XB_SPIN_CAP (1u << 18)
__device__ __forceinline__ unsigned xb_ld(unsigned* p)              { return __hip_atomic_load(p, __ATOMIC_RELAXED, __HIP_MEMORY_SCOPE_AGENT); }
__device__ __forceinline__ unsigned xb_add(unsigned* p, unsigned v) { return __hip_atomic_fetch_add(p, v, __ATOMIC_RELAXED, __HIP_MEMORY_SCOPE_AGENT); }
__device__ __forceinline__ unsigned xb_xcc_id() { return (unsigned)__builtin_amdgcn_s_getreg((3 << 11) | 20) & 0xFu; }
#define XB_SPIN(cond, bar) do { unsigned _sp = 0; while (cond) { __builtin_amdgcn_s_sleep(1); \
    if ((++_sp & 255u) == 0u) { if (xb_ld(&(bar)[XB_TMO])) break; if (_sp > XB_SPIN_CAP) { atomicAdd(&(bar)[XB_TMO], 1u); break; } } } } while (0)
struct XcdBarrier { unsigned* bar; unsigned x; volatile LAS unsigned* st; };
__device__ __forceinline__ XcdBarrier xcd_barrier_post(unsigned* bar, volatile LAS unsigned* st) {
    XcdBarrier b; b.bar = bar; b.x = xb_xcc_id(); b.st = st;
    if (threadIdx.x == 0) (void)xb_add(&bar[XB_XCNT(b.x)], 1u);
    return b;
}
__device__ __forceinline__ void xcd_barrier_complete(unsigned* bar, unsigned x, unsigned& nloc, unsigned& nx) {
    const unsigned G = gridDim.x * gridDim.y * gridDim.z;
    unsigned sum, cnt, mine, sp = 0u;
    for (;;) {
        sum = 0u; cnt = 0u; mine = 0u;
#pragma unroll
        for (unsigned j = 0; j < 16; ++j) { const unsigned c = xb_ld(&bar[XB_XCNT(j)]); sum += c; cnt += (c > 0u) ? 1u : 0u; mine = (j == x) ? c : mine; }
        if (sum == G) break;
        __builtin_amdgcn_s_sleep(1);
        if ((++sp & 255u) == 0u) { if (xb_ld(&bar[XB_TMO])) break; if (sp > XB_SPIN_CAP) { atomicAdd(&bar[XB_TMO], 1u); break; } }
    }
    nloc = mine > 0u ? mine : 1u; nx = cnt > 0u ? cnt : 1u;
}
__device__ __forceinline__ void xcd_barrier(const XcdBarrier& b) {
    asm volatile("s_waitcnt vmcnt(0)" ::: "memory");
    __syncthreads();
    if (threadIdx.x == 0) {
        unsigned* bar = b.bar;
        __builtin_amdgcn_s_waitcnt(0);
        unsigned nloc = b.st[0], nx = b.st[1];
        if (nloc == 0u) { xcd_barrier_complete(bar, b.x, nloc, nx); b.st[0] = nloc; b.st[1] = nx; }
        const unsigned old = xb_add(&bar[XB_XSUB(b.x)], 1u);
        const unsigned gen = old / nloc;
        if (old + 1u == (gen + 1u) * nloc) {
            __builtin_amdgcn_fence(__ATOMIC_RELEASE, "agent");
            asm volatile("s_waitcnt vmcnt(0)" ::: "memory");
            const unsigned og = xb_add(&bar[XB_TOP], 1u);
            const unsigned tg = og / nx;
            if (og + 1u == (tg + 1u) * nx) xb_add(&bar[XB_TOPGEN], 1u);
            else XB_SPIN(xb_ld(&bar[XB_TOPGEN]) == tg, bar);
            __builtin_amdgcn_fence(__ATOMIC_ACQUIRE, "agent");
            xb_add(&bar[XB_XGEN(b.x)], 1u);
            asm volatile("s_waitcnt vmcnt(0)" ::: "memory");
        } else {
            XB_SPIN(xb_ld(&bar[XB_XGEN(b.x)]) == gen, bar);
            __builtin_amdgcn_fence(__ATOMIC_ACQUIRE, "agent");
            asm volatile("s_waitcnt vmcnt(0)" ::: "memory");
        }
    }
    __syncthreads();
}

constexpr int NTHR = 512, NWAVE = 8;
constexpr int LDS_BYTES = 147456;
constexpr int LDS_MISC = 147456 - 256;
struct Args { const void* in[34]; float* out; unsigned char* ws; };
struct Ptrs {
    const float *x, *ln_in_g, *ln_in_b, *w_in, *q_norm_g, *kv_norm_g, *w_uq, *w_ukv, *lambda_re, *lambda_im, *log_step, *b_re, *b_im, *c_re, *c_im, *d_skip, *w_glu, *b_glu;
    const float *attn_out_g, *ssm_out_g, *w_o, *ln1_g, *ln1_b, *w_router, *router_bias, *w_gate, *w_up, *w_down, *ws_gate, *ws_up, *ws_down, *ln2_g, *ln2_b;
    const int* positions; float* out; unsigned char* ws;
};
#define WSP(T_, off) ((T_*)(P.ws + (off)))

__device__ __forceinline__ void ph_ln_in(const Ptrs& P, int bid, int nb) {
    const int lane = threadIdx.x & 63, w = threadIdx.x >> 6;
    bf16_t* xn = WSP(bf16_t, WS_XN); float* xstat = WSP(float, WS_XSTAT);
    for (int t = bid * NWAVE + w; t < T; t += nb * NWAVE) {
        const float* xr = P.x + (size_t)t * D;
        float v[16]; float s = 0.f;
#pragma unroll
        for (int i = 0; i < 4; ++i) { const f32x4 q = *(const f32x4*)(xr + i * 256 + lane * 4); v[4 * i] = q[0]; v[4 * i + 1] = q[1]; v[4 * i + 2] = q[2]; v[4 * i + 3] = q[3]; s += q[0] + q[1] + q[2] + q[3]; }
        const float mu = wave_sum(s) * (1.0f / D);
        float ss = 0.f;
#pragma unroll
        for (int i = 0; i < 16; ++i) { const float d = v[i] - mu; ss += d * d; }
        const float rstd = rsqrtf(wave_sum(ss) * (1.0f / D) + EPS);
        if (lane == 0) { xstat[2 * t] = mu; xstat[2 * t + 1] = rstd; }
#pragma unroll
        for (int i = 0; i < 4; ++i) {
            const int c = i * 256 + lane * 4;
            const f32x4 gg = *(const f32x4*)(P.ln_in_g + c), bb = *(const f32x4*)(P.ln_in_b + c);
            ushort4 o;
            o.x = f2bf((v[4 * i] - mu) * rstd * gg[0] + bb[0]); o.y = f2bf((v[4 * i + 1] - mu) * rstd * gg[1] + bb[1]);
            o.z = f2bf((v[4 * i + 2] - mu) * rstd * gg[2] + bb[2]); o.w = f2bf((v[4 * i + 3] - mu) * rstd * gg[3] + bb[3]);
            *(ushort4*)(xn + (size_t)t * D + c) = o;
        }
    }
}
__device__ __forceinline__ int wprep_srccol(int mode, int n, int& which) {
    which = 0;
    switch (mode) {
    case 0: if (n < 256) return n; if (n < 768) return 416 + (n - 256); if (n < 896) return 256 + (n - 768); if (n < 928) return 384 + ropeperm(n - 896); return -1;
    case 1: if (n < 512) return (n >> 6) * 96 + (n & 63); { const int m = n - 512; return (m >> 5) * 96 + 64 + ropeperm(m & 31); }
    case 2: if (n < 512) return (n >> 6) * 128 + (n & 63); { const int m = n - 512; return (m >> 6) * 128 + 64 + (m & 63); }
    case 5: { const int pn = n >> 8, w = n & 255; which = w >> 7; return pn * 128 + (w & 127); }
    default: return n;
    }
}
__device__ __forceinline__ void wprep_tile(LAS float* tile  , const float* s1, const float* s2, const float* ks, const float* ks2, bf16_t* dst,
                                           int mode, int Kd, int ldsrc, int Ksrc, float kmul, int n0, int k0) {
    const int tid = threadIdx.x;
    {
        const int nn = tid & 63, ksub = tid >> 6;
        int which; const int sc = wprep_srccol(mode, n0 + nn, which);
        const float* s = which ? s2 : s1;
#pragma unroll
        for (int i = 0; i < 8; ++i) {
            const int kk = ksub + 8 * i, k = k0 + kk;
            float v = 0.f;
            if (sc >= 0 && k < Ksrc) {
                v = s[(size_t)k * ldsrc + sc];
                if (ks) v *= (ks2 && k >= 512) ? ks2[k - 512] : ks[k];
                v *= kmul;
            }
            tile[kk * 65 + nn] = v;
        }
    }
    __syncthreads();
    {
        const int kk = tid & 63, nsub = tid >> 6;
#pragma unroll
        for (int i = 0; i < 8; ++i) { const int n = nsub + 8 * i; dst[(size_t)(n0 + n) * Kd + k0 + kk] = f2bf(tile[kk * 65 + n]); }
    }
    __syncthreads();
}
__device__ __forceinline__ void ph_wprep(const Ptrs& P, LAS unsigned char* lds, int bid, int nb) {
    LAS float* tile = (LAS float*)lds;
    constexpr int J0 = 256, J1 = J0 + 48, J2 = J1 + 64, J3 = J2 + 64, J4 = J3 + 256, J5 = J4 + 65 * 128, J6 = J5 + 65 * 64;
    for (int j = bid; j < J6; j += nb) {
        if (j < J0)      { const int tl = j;      wprep_tile(tile, P.w_in, nullptr, nullptr, nullptr, WSP(bf16_t, WS_WIN), 0, 1024, 928, 1024, 1.0f, (tl / 16) * 64, (tl % 16) * 64); }
        else if (j < J1) { const int tl = j - J0; wprep_tile(tile, P.w_uq, nullptr, P.q_norm_g, nullptr, WSP(bf16_t, WS_WUQ), 1, 256, 768, 256, QSCALE, (tl / 4) * 64, (tl % 4) * 64); }
        else if (j < J2) { const int tl = j - J1; wprep_tile(tile, P.w_ukv, nullptr, P.kv_norm_g, nullptr, WSP(bf16_t, WS_WUKV), 2, 256, 1024, 128, 1.0f, (tl / 4) * 64, (tl % 4) * 64); }
        else if (j < J3) { const int tl = j - J2; wprep_tile(tile, P.w_glu, nullptr, nullptr, nullptr, WSP(bf16_t, WS_WGLU), 3, 512, 512, 512, 1.0f, (tl / 8) * 64, (tl % 8) * 64); }
        else if (j < J4) { const int tl = j - J3; wprep_tile(tile, P.w_o, nullptr, P.attn_out_g, P.ssm_out_g, WSP(bf16_t, WS_WO), 4, 1024, 1024, 1024, 1.0f, (tl / 16) * 64, (tl % 16) * 64); }
        else if (j < J5) { const int q = j - J4, e = q / 128, tl = q % 128;
            const float* g = e < 64 ? P.w_gate + (size_t)e * 1024 * 256 : P.ws_gate; const float* u = e < 64 ? P.w_up + (size_t)e * 1024 * 256 : P.ws_up;
            wprep_tile(tile, g, u, nullptr, nullptr, WSP(bf16_t, WS_WGU) + (size_t)e * 512 * 1024, 5, 1024, 256, 1024, 1.0f, (tl / 16) * 64, (tl % 16) * 64); }
        else             { const int q = j - J5, e = q / 64, tl = q % 64;
            const float* d = e < 64 ? P.w_down + (size_t)e * 256 * 1024 : P.ws_down;
            wprep_tile(tile, d, nullptr, nullptr, nullptr, WSP(bf16_t, WS_WD) + (size_t)e * 1024 * 256, 6, 256, 1024, 256, 1.0f, (tl / 4) * 64, (tl % 4) * 64); }
    }
}
__device__ __forceinline__ void ph_s5tab1(const Ptrs& P, int bid, int nb) {
    float2* lampow = WSP(float2, WS_LAMPOW); float2* bbar = WSP(float2, WS_BBAR);
    for (int i = bid * NTHR + threadIdx.x; i < SG * SP; i += nb * NTHR) {
        const int g = i >> 6, p = i & 63;
        double lr = (double)P.lambda_re[g * SP + p]; if (lr > -1e-4) lr = -1e-4;
        const double li = (double)P.lambda_im[g * SP + p];
        double st, dummy; cexp_d((double)P.log_step[g], 0.0, st, dummy);
        double br, bi; cexp_d(lr * st, li * st, br, bi);
        const double nr = br - 1.0, ni = bi, den = lr * lr + li * li;
        const double cr = (nr * lr + ni * li) / den, ci = (ni * lr - nr * li) / den;
        double pr = 1.0, pi = 0.0;
        for (int tau = 0; tau <= 64; ++tau) {
            lampow[(g * SP + p) * 65 + tau] = make_float2((float)pr, (float)pi);
            const double tr = pr * br - pi * bi, ti = pr * bi + pi * br; pr = tr; pi = ti;
        }
        for (int c = 0; c < SC; ++c) {
            const double xr = (double)P.b_re[(g * SP + p) * SC + c], xi = (double)P.b_im[(g * SP + p) * SC + c];
            bbar[(g * SP + p) * SC + c] = make_float2((float)(cr * xr - ci * xi), (float)(cr * xi + ci * xr));
        }
    }
}
__device__ __forceinline__ void ph_s5tab2(const Ptrs& P, int bid, int nb) {
    const float2* lampow = WSP(float2, WS_LAMPOW); const float2* bbar = WSP(float2, WS_BBAR);
    bf16_t* ktab = WSP(bf16_t, WS_KTAB); bf16_t* bloc = WSP(bf16_t, WS_BLOC); bf16_t* clam = WSP(bf16_t, WS_CLAM);
    const float* cre = P.c_re; const float* cim = P.c_im;
    const size_t nk = (size_t)SG * 127 * 256, nbl = (size_t)SG * 256 * 1024, nc = (size_t)SG * 1024 * 256;
    const size_t stride = (size_t)nb * NTHR;
    for (size_t i = (size_t)bid * NTHR + threadIdx.x; i < nk + nbl + nc; i += stride) {
        if (i < nk) {
            const int cp = (int)(i & 15), c = (int)((i >> 4) & 15), ti = (int)((i >> 8) % 127), g = (int)((i >> 8) / 127);
            const int tau = ti - 63;
            float v = 0.f;
            if (tau >= 0) {
                for (int p = 0; p < SP; ++p) {
                    const float2 l = lampow[(g * SP + p) * 65 + tau], bb = bbar[(g * SP + p) * SC + cp];
                    const float cr = cre[(g * SC + c) * SP + p], ci = cim[(g * SC + c) * SP + p];
                    const float mr = l.x * bb.x - l.y * bb.y, mi = l.x * bb.y + l.y * bb.x;
                    v += cr * mr - ci * mi;
                }
                if (tau == 0 && c == cp) v += P.d_skip[g * SC + c];
            }
            ktab[i] = f2bf(v);
        } else if (i < nk + nbl) {
            const size_t j = i - nk;
            const int k = (int)(j & 1023), n = (int)((j >> 10) & 255), g = (int)(j >> 18);
            float v = 0.f;
            if (n < 128) {
                const int p = n & 63, s = k >> 4, c = k & 15;
                const float2 l = lampow[(g * SP + p) * 65 + (63 - s)], bb = bbar[(g * SP + p) * SC + c];
                v = (n < 64) ? (l.x * bb.x - l.y * bb.y) : (l.x * bb.y + l.y * bb.x);
            }
            bloc[j] = f2bf(v);
        } else {
            const size_t j = i - nk - nbl;
            const int k = (int)(j & 255), n = (int)((j >> 8) & 1023), g = (int)(j >> 18);
            float v = 0.f;
            if (k < 128) {
                const int p = k & 63, t = n >> 4, c = n & 15;
                const float2 l = lampow[(g * SP + p) * 65 + (t + 1)];
                const float cr = cre[(g * SC + c) * SP + p], ci = cim[(g * SC + c) * SP + p];
                v = (k < 64) ? (cr * l.x - ci * l.y) : -(cr * l.y + ci * l.x);
            }
            clam[j] = f2bf(v);
        }
    }
}
__device__ __forceinline__ void ph_ropetab(const Ptrs& P, int bid, int nb) {
    float2* rope = WSP(float2, WS_ROPE);
    for (int i = bid * NTHR + threadIdx.x; i < T * 16; i += nb * NTHR) {
        const int t = i >> 4, j = i & 15;
        double invf, dm; cexp_d(-(double)j / 16.0 * 9.210340371976184, 0.0, invf, dm);
        const float ang = (float)P.positions[t] * (float)invf;
        double c, s; cexp_d(0.0, (double)ang, c, s);
        rope[i] = make_float2((float)c, (float)s);
    }
}

#define GW_LOOP(ntiles) for (int tl = bid * NWAVE + (threadIdx.x >> 6); tl < (ntiles); tl += nb * NWAVE)
__device__ __forceinline__ void ph_gemm_win(const Ptrs& P, int bid, int nb) {
    const bf16_t* xn = WSP(bf16_t, WS_XN); const bf16_t* wt = WSP(bf16_t, WS_WIN);
    bf16_t* cq = WSP(bf16_t, WS_CQ); bf16_t* ckv = WSP(bf16_t, WS_CKV); bf16_t* u = WSP(bf16_t, WS_U); float* krraw = WSP(float, WS_KRRAW);
    GW_LOOP((T / 32) * 32) {
        const int m0 = (tl >> 5) * 32, n0 = (tl & 31) * 32;
        sg_tile<false>(m0, n0, D,
            [&](int row) { return xn + (size_t)row * D; },
            [&](int n, int k, int) { return wt + (size_t)n * D + k; },
            [&](int t, int n, float v, float) {
                if (n < 256) cq[(size_t)t * 256 + n] = f2bf(v);
                else if (n < 768) {
                    const int ch = n - 256, g = ch >> 4, c = ch & 15, b = t >> 11, s = t & 2047, j = s >> 6, sl = s & 63;
                    u[((size_t)g * 512 + b * 32 + j) * 1024 + sl * 16 + c] = f2bf(v);
                } else if (n < 896) ckv[(size_t)t * 256 + (n - 768)] = f2bf(v);
                else {
                    ckv[(size_t)t * 256 + (n - 768)] = 0;
                    if (n < 928) krraw[(size_t)t * 32 + ropeperm(n - 896)] = v;
                }
            });
    }
}
__device__ __forceinline__ void ph_rstat(const Ptrs& P, int bid, int nb) {
    const bf16_t* cq = WSP(bf16_t, WS_CQ); const bf16_t* ckv = WSP(bf16_t, WS_CKV); float* rsq = WSP(float, WS_RSQ); float* rskv = WSP(float, WS_RSKV);
    const int lane = threadIdx.x & 63, w = threadIdx.x >> 6;
    for (int t = bid * NWAVE + w; t < T; t += nb * NWAVE) {
        float s = 0.f, s2 = 0.f;
#pragma unroll
        for (int i = 0; i < 4; ++i) { const float v = bf2f(cq[(size_t)t * 256 + i * 64 + lane]); s += v * v; }
#pragma unroll
        for (int i = 0; i < 2; ++i) { const float v = bf2f(ckv[(size_t)t * 256 + i * 64 + lane]); s2 += v * v; }
        s = wave_sum(s); s2 = wave_sum(s2);
        if (lane == 0) { rsq[t] = rsqrtf(s * (1.0f / 256) + EPS); rskv[t] = rsqrtf(s2 * (1.0f / 128) + EPS); }
    }
}
__device__ __forceinline__ void ph_gemm_q(const Ptrs& P, int bid, int nb) {
    const bf16_t* cq = WSP(bf16_t, WS_CQ); const bf16_t* wt = WSP(bf16_t, WS_WUQ); const float* rsq = WSP(float, WS_RSQ); bf16_t* Q = WSP(bf16_t, WS_Q); float* qrraw = WSP(float, WS_QRRAW);
    GW_LOOP((T / 32) * 24) {
        const int m0 = (tl / 24) * 32, n0 = (tl % 24) * 32;
        sg_tile<false>(m0, n0, 256,
            [&](int row) { return cq + (size_t)row * 256; },
            [&](int n, int k, int) { return wt + (size_t)n * 256 + k; },
            [&](int t, int n, float v, float) {
                v *= rsq[t];
                const int b = t >> 11, s = t & 2047;
                if (n < 512) Q[(((size_t)b * NH + (n >> 6)) * SEQ + s) * QKD + (n & 63)] = f2bf(v);
                else { const int m = n - 512; qrraw[(size_t)t * 256 + (m >> 5) * 32 + ropeperm(m & 31)] = v; }
            });
    }
}
__device__ __forceinline__ void ph_gemm_kv(const Ptrs& P, int bid, int nb) {
    const bf16_t* ckv = WSP(bf16_t, WS_CKV); const bf16_t* wt = WSP(bf16_t, WS_WUKV); const float* rskv = WSP(float, WS_RSKV); bf16_t* Kc = WSP(bf16_t, WS_K); bf16_t* V = WSP(bf16_t, WS_V);
    GW_LOOP((T / 32) * 32) {
        const int m0 = (tl >> 5) * 32, n0 = (tl & 31) * 32;
        sg_tile<false>(m0, n0, 256,
            [&](int row) { return ckv + (size_t)row * 256; },
            [&](int n, int k, int) { return wt + (size_t)n * 256 + k; },
            [&](int t, int n, float v, float) {
                v *= rskv[t];
                const int b = t >> 11, s = t & 2047;
                if (n < 512) Kc[(((size_t)b * NH + (n >> 6)) * SEQ + s) * QKD + (n & 63)] = f2bf(v);
                else { const int m = n - 512; V[(((size_t)b * NH + (m >> 6)) * SEQ + s) * VD + (m & 63)] = f2bf(v); }
            });
    }
}
__device__ __forceinline__ void ph_rope_apply(const Ptrs& P, int bid, int nb) {
    const float* qrraw = WSP(float, WS_QRRAW); const float* krraw = WSP(float, WS_KRRAW); const float2* rope = WSP(float2, WS_ROPE); bf16_t* Q = WSP(bf16_t, WS_Q); bf16_t* Kc = WSP(bf16_t, WS_K);
    for (int i = bid * NTHR + threadIdx.x; i < T * 9 * 16; i += nb * NTHR) {
        const int j = i & 15, hh = (i >> 4) % 9, t = (i >> 4) / 9;
        const float2 cs = rope[t * 16 + j];
        const int b = t >> 11, s = t & 2047;
        if (hh < 8) {
            const float x1 = qrraw[(size_t)t * 256 + hh * 32 + j], x2 = qrraw[(size_t)t * 256 + hh * 32 + 16 + j];
            bf16_t* q = Q + (((size_t)b * NH + hh) * SEQ + s) * QKD + 64;
            q[j] = f2bf(x1 * cs.x - x2 * cs.y); q[16 + j] = f2bf(x2 * cs.x + x1 * cs.y);
        } else {
            const float x1 = krraw[(size_t)t * 32 + j], x2 = krraw[(size_t)t * 32 + 16 + j];
            const bf16_t o1 = f2bf(x1 * cs.x - x2 * cs.y), o2 = f2bf(x2 * cs.x + x1 * cs.y);
            for (int h = 0; h < NH; ++h) { bf16_t* k = Kc + (((size_t)b * NH + h) * SEQ + s) * QKD + 64; k[j] = o1; k[16 + j] = o2; }
        }
    }
}
__device__ __forceinline__ void ph_gemm_s5b(const Ptrs& P, int bid, int nb) {
    const bf16_t* u = WSP(bf16_t, WS_U); const bf16_t* bloc = WSP(bf16_t, WS_BLOC); float* xloc = WSP(float, WS_XLOC);
    GW_LOOP(SG * 16 * 4) {
        const int g = tl >> 6, m0 = ((tl >> 2) & 15) * 32, n0 = (tl & 3) * 32;
        sg_tile<false>(m0, n0, 1024,
            [&](int row) { return u + ((size_t)g * 512 + row) * 1024; },
            [&](int n, int k, int) { return bloc + ((size_t)g * 256 + n) * 1024 + k; },
            [&](int row, int n, float v, float) { xloc[((size_t)g * 512 + row) * 128 + n] = v; });
    }
}
__device__ __forceinline__ void ph_gemm_s5a(const Ptrs& P, int bid, int nb) {
    const bf16_t* u = WSP(bf16_t, WS_U); const bf16_t* ktab = WSP(bf16_t, WS_KTAB); bf16_t* yintra = WSP(bf16_t, WS_YINTRA);
    GW_LOOP(SG * 16 * 32) {
        const int g = tl >> 9, m0 = ((tl >> 5) & 15) * 32, n0 = (tl & 31) * 32;
        sg_tile<false>(m0, n0, 1024,
            [&](int row) { return u + ((size_t)g * 512 + row) * 1024; },
            [&](int n, int k, int) { const int t = n >> 4, c = n & 15, s = k >> 4, c0 = k & 15; return ktab + (((size_t)g * 127 + (t - s + 63)) * 16 + c) * 16 + c0; },
            [&](int row, int n, float v, float) {
                const int b = row >> 5, j = row & 31, t = n >> 4, c = n & 15;
                yintra[((size_t)b * SEQ + j * CH + t) * SSMW + g * SC + c] = f2bf(v);
            });
    }
}
__device__ __forceinline__ void ph_attn_simple(const Ptrs& P, LAS unsigned char* lds, int bid, int nb) {
    const bf16_t* Q = WSP(bf16_t, WS_Q); const bf16_t* Kc = WSP(bf16_t, WS_K); const bf16_t* V = WSP(bf16_t, WS_V); bf16_t* AS = WSP(bf16_t, WS_AS);
    const int lane = threadIdx.x & 63, w = threadIdx.x >> 6;
    LAS float* qs = (LAS float*)lds + w * (QKD + SEQ);
    LAS float* ps = qs + QKD;
    for (int row = bid * NWAVE + w; row < T * NH; row += nb * NWAVE) {
        const int bh = row >> 11, q = row & 2047, b = bh >> 3, h = bh & 7;
        asm volatile("s_waitcnt lgkmcnt(0)" ::: "memory");
        qs[lane] = bf2f(Q[(size_t)row * QKD + lane]);
        if (lane < 32) qs[64 + lane] = bf2f(Q[(size_t)row * QKD + 64 + lane]);
        asm volatile("s_waitcnt lgkmcnt(0)" ::: "memory");
        const int nk = ((q >> 6) + 1) * 64;
        float m = -INFINITY;
        for (int kb = 0; kb < nk; kb += 64) {
            const bf16_t* kp = Kc + ((size_t)bh * SEQ + kb + lane) * QKD;
            float s = 0.f;
#pragma unroll
            for (int c = 0; c < 12; ++c) {
                const bf16x8 kv = *(const bf16x8*)(kp + c * 8);
#pragma unroll
                for (int e = 0; e < 8; ++e) s += qs[c * 8 + e] * bf2f((bf16_t)kv[e]);
            }
            ps[kb + lane] = s; m = fmaxf(m, s);
        }
        m = wave_max(m);
        float l = 0.f;
        for (int kb = 0; kb < nk; kb += 64) { const float p = exp2f(ps[kb + lane] - m); ps[kb + lane] = p; l += p; }
        l = wave_sum(l);
        asm volatile("s_waitcnt lgkmcnt(0)" ::: "memory");
        float o = 0.f;
        const bf16_t* vp = V + (size_t)bh * SEQ * VD + lane;
        for (int k = 0; k < nk; ++k) o += ps[k] * bf2f(vp[(size_t)k * VD]);
        AS[((size_t)b * SEQ + q) * 1024 + h * 64 + lane] = f2bf(o / l);
    }
}
__device__ __forceinline__ void ph_s5scan(const Ptrs& P, int bid, int nb) {
    const float* xloc = WSP(float, WS_XLOC); const float2* lampow = WSP(float2, WS_LAMPOW); bf16_t* xprev = WSP(bf16_t, WS_XPREV);
    for (int i = bid * NTHR + threadIdx.x; i < SG * NB * SP; i += nb * NTHR) {
        const int p = i & 63, b = (i >> 6) & 15, g = i >> 10;
        const float2 l64 = lampow[(g * SP + p) * 65 + 64];
        float xr = 0.f, xi = 0.f;
        for (int j = 0; j < NCH; ++j) {
            const size_t row = (size_t)g * 512 + b * 32 + j;
            bf16_t* xp = xprev + row * 256;
            xp[p] = f2bf(xr); xp[64 + p] = f2bf(xi); xp[128 + p] = 0; xp[192 + p] = 0;
            const float lr = xloc[row * 128 + p], li = xloc[row * 128 + 64 + p];
            const float nr = l64.x * xr - l64.y * xi + lr, ni = l64.x * xi + l64.y * xr + li;
            xr = nr; xi = ni;
        }
    }
}
__device__ __forceinline__ void ph_gemm_s5d(const Ptrs& P, int bid, int nb) {
    const bf16_t* xprev = WSP(bf16_t, WS_XPREV); const bf16_t* clam = WSP(bf16_t, WS_CLAM); const bf16_t* yintra = WSP(bf16_t, WS_YINTRA); bf16_t* Y = WSP(bf16_t, WS_Y);
    GW_LOOP(SG * 16 * 32) {
        const int g = tl >> 9, m0 = ((tl >> 5) & 15) * 32, n0 = (tl & 31) * 32;
        sg_tile<false>(m0, n0, 256,
            [&](int row) { return xprev + ((size_t)g * 512 + row) * 256; },
            [&](int n, int k, int) { return clam + ((size_t)g * 1024 + n) * 256 + k; },
            [&](int row, int n, float v, float) {
                const int b = row >> 5, j = row & 31, t = n >> 4, c = n & 15;
                const size_t o = ((size_t)b * SEQ + j * CH + t) * SSMW + g * SC + c;
                Y[o] = f2bf(gelu_tanh(v + bf2f(yintra[o])));
            });
    }
}
__device__ __forceinline__ void ph_gemm_glu(const Ptrs& P, int bid, int nb) {
    const bf16_t* Y = WSP(bf16_t, WS_Y); const bf16_t* wt = WSP(bf16_t, WS_WGLU); bf16_t* AS = WSP(bf16_t, WS_AS);
    GW_LOOP((T / 32) * 16) {
        const int m0 = (tl >> 4) * 32, n0 = (tl & 15) * 32;
        sg_tile<false>(m0, n0, 512,
            [&](int row) { return Y + (size_t)row * 512; },
            [&](int n, int k, int) { return wt + (size_t)n * 512 + k; },
            [&](int t, int n, float v, float) {
                const float yv = bf2f(Y[(size_t)t * 512 + n]);
                AS[(size_t)t * 1024 + 512 + n] = f2bf(yv * sigmoidf_(v + P.b_glu[n]));
            });
    }
}
__device__ __forceinline__ void ph_asnorm(const Ptrs& P, int bid, int nb) {
    bf16_t* AS = WSP(bf16_t, WS_AS);
    const int lane = threadIdx.x & 63, w = threadIdx.x >> 6;
    for (int t = bid * NWAVE + w; t < T; t += nb * NWAVE) {
        bf16_t* r = AS + (size_t)t * 1024;
        float va[8], vs[8]; float sa = 0.f, ss = 0.f;
        const bf16x8 a = *(const bf16x8*)(r + lane * 8), s = *(const bf16x8*)(r + 512 + lane * 8);
#pragma unroll
        for (int i = 0; i < 8; ++i) { va[i] = bf2f((bf16_t)a[i]); vs[i] = bf2f((bf16_t)s[i]); sa += va[i] * va[i]; ss += vs[i] * vs[i]; }
        const float ra = rsqrtf(wave_sum(sa) * (1.0f / 512) + EPS), rs = rsqrtf(wave_sum(ss) * (1.0f / 512) + EPS);
        bf16x8 oa, os;
#pragma unroll
        for (int i = 0; i < 8; ++i) { oa[i] = (short)f2bf(va[i] * ra); os[i] = (short)f2bf(vs[i] * rs); }
        *(bf16x8*)(r + lane * 8) = oa; *(bf16x8*)(r + 512 + lane * 8) = os;
    }
}
__device__ __forceinline__ void ph_gemm_wo(const Ptrs& P, int bid, int nb) {
    const bf16_t* AS = WSP(bf16_t, WS_AS); const bf16_t* wt = WSP(bf16_t, WS_WO); const float* xstat = WSP(float, WS_XSTAT); float* pre1 = P.out;
    GW_LOOP((T / 32) * 32) {
        const int m0 = (tl >> 5) * 32, n0 = (tl & 31) * 32;
        sg_tile<false>(m0, n0, 1024,
            [&](int row) { return AS + (size_t)row * 1024; },
            [&](int n, int k, int) { return wt + (size_t)n * 1024 + k; },
            [&](int t, int n, float v, float) {
                const float xn = (P.x[(size_t)t * D + n] - xstat[2 * t]) * xstat[2 * t + 1] * P.ln_in_g[n] + P.ln_in_b[n];
                pre1[(size_t)t * D + n] = v + ALPHA * xn;
            });
    }
}
__device__ __forceinline__ void ph_ln1(const Ptrs& P, int bid, int nb) {
    const float* pre1 = P.out; bf16_t* x1 = WSP(bf16_t, WS_X1); bf16_t* x1lo = WSP(bf16_t, WS_X1LO);
    const int lane = threadIdx.x & 63, w = threadIdx.x >> 6;
    for (int t = bid * NWAVE + w; t < T; t += nb * NWAVE) {
        const float* xr = pre1 + (size_t)t * D;
        float v[16]; float s = 0.f;
#pragma unroll
        for (int i = 0; i < 4; ++i) { const f32x4 q = *(const f32x4*)(xr + i * 256 + lane * 4); v[4 * i] = q[0]; v[4 * i + 1] = q[1]; v[4 * i + 2] = q[2]; v[4 * i + 3] = q[3]; s += q[0] + q[1] + q[2] + q[3]; }
        const float mu = wave_sum(s) * (1.0f / D);
        float ss = 0.f;
#pragma unroll
        for (int i = 0; i < 16; ++i) { const float d = v[i] - mu; ss += d * d; }
        const float rstd = rsqrtf(wave_sum(ss) * (1.0f / D) + EPS);
#pragma unroll
        for (int i = 0; i < 4; ++i) {
            const int c = i * 256 + lane * 4;
            const f32x4 gg = *(const f32x4*)(P.ln1_g + c), bb = *(const f32x4*)(P.ln1_b + c);
            ushort4 o, ol;
            float y;
            y = (v[4 * i] - mu) * rstd * gg[0] + bb[0];     o.x = f2bf(y); ol.x = f2bf(y - bf2f(o.x));
            y = (v[4 * i + 1] - mu) * rstd * gg[1] + bb[1]; o.y = f2bf(y); ol.y = f2bf(y - bf2f(o.y));
            y = (v[4 * i + 2] - mu) * rstd * gg[2] + bb[2]; o.z = f2bf(y); ol.z = f2bf(y - bf2f(o.z));
            y = (v[4 * i + 3] - mu) * rstd * gg[3] + bb[3]; o.w = f2bf(y); ol.w = f2bf(y - bf2f(o.w));
            *(ushort4*)(x1 + (size_t)t * D + c) = o; *(ushort4*)(x1lo + (size_t)t * D + c) = ol;
        }
    }
}
__device__ __forceinline__ void ph_router(const Ptrs& P, int bid, int nb) {
    const bf16_t* x1 = WSP(bf16_t, WS_X1); const bf16_t* x1lo = WSP(bf16_t, WS_X1LO); float* logits = WSP(float, WS_LOGITS);
    const int e = threadIdx.x & 63, w = threadIdx.x >> 6;
    for (int t = bid * NWAVE + w; t < T; t += nb * NWAVE) {
        const bf16_t* a = x1 + (size_t)t * D; const bf16_t* al = x1lo + (size_t)t * D;
        float s = 0.f;
        for (int k = 0; k < D; k += 8) {
            const bf16x8 hi = *(const bf16x8*)(a + k), lo = *(const bf16x8*)(al + k);
#pragma unroll
            for (int i = 0; i < 8; ++i) s += (bf2f((bf16_t)hi[i]) + bf2f((bf16_t)lo[i])) * P.w_router[(size_t)(k + i) * NE + e];
        }
        logits[(size_t)t * NE + e] = s;
    }
}
__device__ __forceinline__ void ph_topk(const Ptrs& P, int bid, int nb) {
    const float* logits = WSP(float, WS_LOGITS); int* topi = WSP(int, WS_TOPI); float* topw = WSP(float, WS_TOPW);
    const int lane = threadIdx.x & 63, w = threadIdx.x >> 6;
    for (int t = bid * NWAVE + w; t < T; t += nb * NWAVE) {
        const float sc = sigmoidf_(logits[(size_t)t * NE + lane]);
        const float sel = sc + P.router_bias[lane];
        const int grp = lane >> 3;
        float m1 = sel;
        m1 = fmaxf(m1, __shfl_xor(m1, 1)); m1 = fmaxf(m1, __shfl_xor(m1, 2)); m1 = fmaxf(m1, __shfl_xor(m1, 4));
        const unsigned long long bal = __ballot(sel == m1) & (0xFFull << (8 * grp));
        const int first = __ffsll((long long)bal) - 1;
        float m2 = (lane == first) ? -INFINITY : sel;
        m2 = fmaxf(m2, __shfl_xor(m2, 1)); m2 = fmaxf(m2, __shfl_xor(m2, 2)); m2 = fmaxf(m2, __shfl_xor(m2, 4));
        const float gs = m1 + m2;
        int cg = 0;
#pragma unroll
        for (int gj = 0; gj < 8; ++gj) { const float sj = __shfl(gs, gj * 8); cg += (sj > gs || (sj == gs && gj < grp)) ? 1 : 0; }
        const bool gsel = cg < 4;
        const float v = gsel ? sel : -INFINITY;
        int rank = 0;
        for (int e2 = 0; e2 < 64; ++e2) { const float ve = __shfl(v, e2); rank += (ve > v || (ve == v && e2 < lane)) ? 1 : 0; }
        const bool chosen = gsel && rank < TOPK;
        const float wsum = wave_sum(chosen ? sc : 0.f);
        if (chosen) { topi[(size_t)t * TOPK + rank] = lane; topw[(size_t)t * TOPK + rank] = sc / wsum * 2.5f; }
    }
}
__device__ __forceinline__ void ph_cnt(const Ptrs& P, int bid, int nb) {
    const int* topi = WSP(int, WS_TOPI); int* cnt = WSP(int, WS_CNT);
    for (int i = bid * NTHR + threadIdx.x; i < 256 * 64; i += nb * NTHR) {
        const int tile = i >> 6, e = i & 63;
        int c = 0;
        for (int k = 0; k < 1024; ++k) c += (topi[tile * 1024 + k] == e) ? 1 : 0;
        cnt[i] = c;
    }
}
__device__ __forceinline__ void ph_off(const Ptrs& P, LAS unsigned char* lds, int bid) {
    if (bid != 0) return;
    const int* cnt = WSP(int, WS_CNT); int* toff = WSP(int, WS_TOFF); int* eoff = WSP(int, WS_EOFF); int* ecnt = WSP(int, WS_ECNT);
    LAS int* tot = (LAS int*)lds; LAS int* off = tot + 64;
    const int e = threadIdx.x;
    if (e < 64) { int s = 0; for (int tile = 0; tile < 256; ++tile) s += cnt[tile * 64 + e]; tot[e] = s; ecnt[e] = s; }
    __syncthreads();
    if (e == 0) { int o = 0; for (int i = 0; i < 64; ++i) { off[i] = o; o += (tot[i] + 255) & ~255; } off[64] = o; }
    __syncthreads();
    if (e < 64) {
        eoff[e] = off[e]; if (e == 0) eoff[64] = off[64];
        int run = off[e];
        for (int tile = 0; tile < 256; ++tile) { toff[tile * 64 + e] = run; run += cnt[tile * 64 + e]; }
    }
}
__device__ __forceinline__ void ph_lists(const Ptrs& P, int bid, int nb) {
    const int* topi = WSP(int, WS_TOPI); const float* topw = WSP(float, WS_TOPW); const int* toff = WSP(int, WS_TOFF); const int* eoff = WSP(int, WS_EOFF);
    int* rowtok = WSP(int, WS_ROWTOK); float* roww = WSP(float, WS_ROWW);
    for (int i = bid * NTHR + threadIdx.x; i < 256 * 64; i += nb * NTHR) {
        const int tile = i >> 6, e = i & 63;
        int pos = toff[tile * 64 + e];
        for (int k = 0; k < 1024; ++k) {
            if (topi[tile * 1024 + k] == e) { rowtok[pos] = tile * 1024 + k; roww[pos] = topw[tile * 1024 + k]; ++pos; }
        }
        if (tile == 255) { const int end = eoff[e + 1]; for (; pos < end; ++pos) { rowtok[pos] = -1; roww[pos] = 0.f; } }
    }
}
__device__ __forceinline__ void ph_gemm_gu(const Ptrs& P, int bid, int nb) {
    const bf16_t* x1 = WSP(bf16_t, WS_X1); const bf16_t* wgu = WSP(bf16_t, WS_WGU); const int* rowtok = WSP(int, WS_ROWTOK); const float* roww = WSP(float, WS_ROWW);
    const int* eoff = WSP(int, WS_EOFF); bf16_t* H = WSP(bf16_t, WS_H);
    const int nrt = eoff[64] / 32;
    const int ntl = (nrt + T / 32) * 8;
    GW_LOOP(ntl) {
        const int rt = tl >> 3, n0 = (tl & 7) * 32;
        if (rt < nrt) {
            const int m0 = rt * 32;
            int e = 0; while (e < 63 && eoff[e + 1] <= m0) ++e;
            const bf16_t* w = wgu + (size_t)e * 512 * 1024;
            sg_tile<true>(m0, n0, 1024,
                [&](int row) { const int s = rowtok[row]; return x1 + (size_t)(s >= 0 ? (s >> 3) : 0) * D; },
                [&](int f, int k, int which) { return w + (size_t)((f >> 7) * 256 + (f & 127) + which * 128) * 1024 + k; },
                [&](int row, int f, float gv, float uv) { H[(size_t)row * FF + f] = f2bf(gv * sigmoidf_(gv) * uv * roww[row]); });
        } else {
            const int m0 = (rt - nrt) * 32;
            const bf16_t* w = wgu + (size_t)64 * 512 * 1024;
            sg_tile<true>(m0, n0, 1024,
                [&](int row) { return x1 + (size_t)row * D; },
                [&](int f, int k, int which) { return w + (size_t)((f >> 7) * 256 + (f & 127) + which * 128) * 1024 + k; },
                [&](int row, int f, float gv, float uv) { H[(size_t)(SH_ROW0 + row) * FF + f] = f2bf(gv * sigmoidf_(gv) * uv); });
        }
    }
}
__device__ __forceinline__ unsigned char f2fp8(float v) { const int p = __builtin_amdgcn_cvt_pk_fp8_f32(v, v, 0, false); return (unsigned char)(p & 0xff); }
__device__ __forceinline__ void ph_gemm_down(const Ptrs& P, int bid, int nb) {
    const bf16_t* H = WSP(bf16_t, WS_H); const bf16_t* wd = WSP(bf16_t, WS_WD); const int* rowtok = WSP(int, WS_ROWTOK); const int* eoff = WSP(int, WS_EOFF);
    const bf16_t* x1 = WSP(bf16_t, WS_X1); unsigned char* yslot = WSP(unsigned char, WS_YSLOT); float* out = P.out;
    const int nrt = eoff[64] / 32;
    const int ntl = (nrt + T / 32) * 32;
    GW_LOOP(ntl) {
        const int rt = tl >> 5, n0 = (tl & 31) * 32;
        if (rt < nrt) {
            const int m0 = rt * 32;
            int e = 0; while (e < 63 && eoff[e + 1] <= m0) ++e;
            const bf16_t* w = wd + (size_t)e * 1024 * 256;
            sg_tile<false>(m0, n0, 256,
                [&](int row) { return H + (size_t)row * FF; },
                [&](int n, int k, int) { return w + (size_t)n * 256 + k; },
                [&](int row, int n, float v, float) { const int s = rowtok[row]; if (s >= 0) yslot[(size_t)s * D + n] = f2fp8(v * SLOT_SCALE); });
        } else {
            const int m0 = (rt - nrt) * 32;
            const bf16_t* w = wd + (size_t)64 * 1024 * 256;
            sg_tile<false>(m0, n0, 256,
                [&](int row) { return H + (size_t)(SH_ROW0 + row) * FF; },
                [&](int n, int k, int) { return w + (size_t)n * 256 + k; },
                [&](int t, int n, float v, float) { out[(size_t)t * D + n] = v + ALPHA * bf2f(x1[(size_t)t * D + n]); });
        }
    }
}
__device__ __forceinline__ void ph_combine(const Ptrs& P, int bid, int nb) {
    const unsigned char* yslot = WSP(unsigned char, WS_YSLOT); float* out = P.out;
    const int lane = threadIdx.x & 63, w = threadIdx.x >> 6;
    for (int t = bid * NWAVE + w; t < T; t += nb * NWAVE) {
        float* orow = out + (size_t)t * D + lane * 16;
        float v[16];
#pragma unroll
        for (int i = 0; i < 4; ++i) { const f32x4 q = *(const f32x4*)(orow + 4 * i); v[4 * i] = q[0]; v[4 * i + 1] = q[1]; v[4 * i + 2] = q[2]; v[4 * i + 3] = q[3]; }
#pragma unroll
        for (int k = 0; k < TOPK; ++k) {
            const u32x4 q = *(const u32x4*)(yslot + ((size_t)t * TOPK + k) * D + lane * 16);
#pragma unroll
            for (int i = 0; i < 4; ++i) {
                v[4 * i]     += __builtin_amdgcn_cvt_f32_fp8((int)q[i], 0) * (1.0f / SLOT_SCALE);
                v[4 * i + 1] += __builtin_amdgcn_cvt_f32_fp8((int)q[i], 1) * (1.0f / SLOT_SCALE);
                v[4 * i + 2] += __builtin_amdgcn_cvt_f32_fp8((int)q[i], 2) * (1.0f / SLOT_SCALE);
                v[4 * i + 3] += __builtin_amdgcn_cvt_f32_fp8((int)q[i], 3) * (1.0f / SLOT_SCALE);
            }
        }
        float s = 0.f;
#pragma unroll
        for (int i = 0; i < 16; ++i) s += v[i];
        const float mu = wave_sum(s) * (1.0f / D);
        float ss = 0.f;
#pragma unroll
        for (int i = 0; i < 16; ++i) { const float d = v[i] - mu; ss += d * d; }
        const float rstd = rsqrtf(wave_sum(ss) * (1.0f / D) + EPS);
#pragma unroll
        for (int i = 0; i < 4; ++i) {
            const int c = lane * 16 + 4 * i;
            const f32x4 gg = *(const f32x4*)(P.ln2_g + c), bb = *(const f32x4*)(P.ln2_b + c);
            f32x4 o;
            o[0] = (v[4 * i] - mu) * rstd * gg[0] + bb[0]; o[1] = (v[4 * i + 1] - mu) * rstd * gg[1] + bb[1];
            o[2] = (v[4 * i + 2] - mu) * rstd * gg[2] + bb[2]; o[3] = (v[4 * i + 3] - mu) * rstd * gg[3] + bb[3];
            *(f32x4*)(orow + 4 * i) = o;
        }
    }
}

__global__ void __launch_bounds__(NTHR, 2) mega(Args a) {
    extern __shared__ __attribute__((aligned(16))) unsigned char lds_raw[];
    LAS unsigned char* lds = (LAS unsigned char*)lds_raw;
    Ptrs P;
    P.x = (const float*)a.in[0]; P.positions = (const int*)a.in[1]; P.ln_in_g = (const float*)a.in[2]; P.ln_in_b = (const float*)a.in[3];
    P.w_in = (const float*)a.in[4]; P.q_norm_g = (const float*)a.in[5]; P.kv_norm_g = (const float*)a.in[6]; P.w_uq = (const float*)a.in[7]; P.w_ukv = (const float*)a.in[8];
    P.lambda_re = (const float*)a.in[9]; P.lambda_im = (const float*)a.in[10]; P.log_step = (const float*)a.in[11]; P.b_re = (const float*)a.in[12]; P.b_im = (const float*)a.in[13];
    P.c_re = (const float*)a.in[14]; P.c_im = (const float*)a.in[15]; P.d_skip = (const float*)a.in[16]; P.w_glu = (const float*)a.in[17]; P.b_glu = (const float*)a.in[18];
    P.attn_out_g = (const float*)a.in[19]; P.ssm_out_g = (const float*)a.in[20]; P.w_o = (const float*)a.in[21]; P.ln1_g = (const float*)a.in[22]; P.ln1_b = (const float*)a.in[23];
    P.w_router = (const float*)a.in[24]; P.router_bias = (const float*)a.in[25]; P.w_gate = (const float*)a.in[26]; P.w_up = (const float*)a.in[27]; P.w_down = (const float*)a.in[28];
    P.ws_gate = (const float*)a.in[29]; P.ws_up = (const float*)a.in[30]; P.ws_down = (const float*)a.in[31]; P.ln2_g = (const float*)a.in[32]; P.ln2_b = (const float*)a.in[33];
    P.out = a.out; P.ws = a.ws;
    const int bid = blockIdx.x, nb = gridDim.x;
    volatile LAS unsigned* misc = (volatile LAS unsigned*)(lds + LDS_MISC);
    if (threadIdx.x < 64) misc[threadIdx.x] = 0u;
    __syncthreads();
    XcdBarrier bar = xcd_barrier_post((unsigned*)(P.ws + WS_CTL) + 4096, misc);
#define GRID_BAR() xcd_barrier(bar)

    ph_ln_in(P, bid, nb); ph_wprep(P, lds, bid, nb); ph_s5tab1(P, bid, nb); ph_ropetab(P, bid, nb);
    GRID_BAR();
    ph_s5tab2(P, bid, nb); ph_gemm_win(P, bid, nb);
    GRID_BAR();
    ph_rstat(P, bid, nb);
    GRID_BAR();
    ph_gemm_q(P, bid, nb); ph_gemm_kv(P, bid, nb); ph_gemm_s5b(P, bid, nb); ph_gemm_s5a(P, bid, nb);
    GRID_BAR();
    ph_rope_apply(P, bid, nb); ph_s5scan(P, bid, nb);
    GRID_BAR();
    ph_attn_simple(P, lds, bid, nb); ph_gemm_s5d(P, bid, nb);
    GRID_BAR();
    ph_gemm_glu(P, bid, nb);
    GRID_BAR();
    ph_asnorm(P, bid, nb);
    GRID_BAR();
    ph_gemm_wo(P, bid, nb);
    GRID_BAR();
    ph_ln1(P, bid, nb);
    GRID_BAR();
    ph_router(P, bid, nb);
    GRID_BAR();
    ph_topk(P, bid, nb);
    GRID_BAR();
    ph_cnt(P, bid, nb);
    GRID_BAR();
    ph_off(P, lds, bid);
    GRID_BAR();
    ph_lists(P, bid, nb);
    GRID_BAR();
    ph_gemm_gu(P, bid, nb);
    GRID_BAR();
    ph_gemm_down(P, bid, nb);
    GRID_BAR();
    ph_combine(P, bid, nb);
}

extern "C" void kernel_launch(void* const* d_in, const int* in_sizes, int n_in, void* d_out, int out_size, void* d_ws, size_t ws_size, hipStream_t stream) {
    (void)in_sizes; (void)out_size;
    if (ws_size < WS_NEED || n_in != 34) return;
    static int grid = 0;
    if (grid == 0) {
        int dev = 0, cus = 0;
        if (hipGetDevice(&dev) != hipSuccess || hipDeviceGetAttribute(&cus, hipDeviceAttributeMultiprocessorCount, dev) != hipSuccess) { grid = -1; return; }
        if (hipFuncSetAttribute((const void*)mega, hipFuncAttributeMaxDynamicSharedMemorySize, LDS_BYTES) != hipSuccess) { grid = -1; return; }
        int per_cu = 0;
        if (hipOccupancyMaxActiveBlocksPerMultiprocessor(&per_cu, (const void*)mega, NTHR, LDS_BYTES) != hipSuccess || per_cu < 1) { (void)hipGetLastError(); }
        grid = cus;
    }
    if (grid < 0) return;
    (void)hipMemsetAsync((char*)d_ws + WS_CTL, 0, 1 << 20, stream);
    Args a; memset(&a, 0, sizeof(a));
    for (int i = 0; i < 34; ++i) a.in[i] = d_in[i];
    a.out = (float*)d_out; a.ws = (unsigned char*)d_ws;
    hipLaunchKernelGGL(mega, dim3(grid), dim3(NTHR), LDS_BYTES, stream, a);
}
```

```cpp
#include <hip/hip_runtime.h>
#include <stdint.h>
#include <string.h>

typedef unsigned short bf16_t;
typedef short bf16x8 __attribute__((ext_vector_type(8)));
typedef float f32x16 __attribute__((ext_vector_type(16)));
typedef float f32x4 __attribute__((ext_vector_type(4)));
typedef unsigned u32x4 __attribute__((ext_vector_type(4)));

#ifndef FAST_WIN
#define FAST_WIN 1
#endif
#ifndef FAST_QKV
#define FAST_QKV 1
#endif
#ifndef FAST_S5
#define FAST_S5 1
#endif
#ifndef FAST_GLU
#define FAST_GLU 1
#endif
#ifndef FAST_WO
#define FAST_WO 1
#endif
#ifndef FAST_MOE
#define FAST_MOE 1
#endif
constexpr int T = 32768, D = 1024, SEQ = 2048, NB = 16;
constexpr int NH = 8, QKD = 96, VD = 64;
constexpr int QRANK = 256, KVRANK = 128, ROPE = 32;
constexpr int SSMW = 512, SG = 32, SC = 16, SP = 64, CH = 64, NCH = SEQ / CH;
constexpr int NE = 64, TOPK = 8, FF = 256;
constexpr float ALPHA = 1.189207115002721f;
constexpr float EPS = 1e-5f;
constexpr float QSCALE = 0.10206207261596577f * 1.4426950408889634f;
constexpr float SLOT_SCALE = 64.0f;
constexpr int RROUT = 278528;
constexpr int SH_ROW0 = RROUT;
constexpr int RTOT = RROUT + T;

constexpr size_t MiB = 1ull << 20;
constexpr size_t WS_CTL = 0;
constexpr size_t WS_TOPI = 1 * MiB, WS_TOPW = 2 * MiB, WS_ROWTOK = 3 * MiB, WS_ROWW = 4 * MiB + MiB / 2;
constexpr size_t WS_CNT = 6 * MiB, WS_TOFF = 6 * MiB + 65536, WS_EOFF = 6 * MiB + 131072, WS_ECNT = 6 * MiB + 131072 + 1024;
constexpr size_t WS_WD = 7 * MiB;
constexpr size_t WS_X1 = 40 * MiB;
constexpr size_t WS_XN = WS_X1, WS_AS = WS_X1;
constexpr size_t WS_H = 104 * MiB;
constexpr size_t WS_CQ = 104 * MiB, WS_CKV = 120 * MiB, WS_U = 136 * MiB, WS_YINTRA = 168 * MiB, WS_Y = 200 * MiB;
constexpr size_t WS_QRRAW = 200 * MiB;
constexpr size_t WS_XLOC = 232 * MiB, WS_XPREV = 240 * MiB, WS_LOGITS = 248 * MiB, WS_KRRAW = 248 * MiB;
constexpr size_t WS_X1LO = 104 * MiB;
constexpr size_t WS_YSLOT = 256 * MiB;
constexpr size_t WS_WGU = 256 * MiB;
constexpr size_t WS_WIN = 321 * MiB, WS_WO = 323 * MiB, WS_WUQ = 325 * MiB, WS_WUKV = 325 * MiB + MiB / 2, WS_WGLU = 326 * MiB;
constexpr size_t WS_BLOC = 327 * MiB, WS_CLAM = 343 * MiB, WS_KTAB = 359 * MiB, WS_LAMPOW = 361 * MiB, WS_BBAR = 363 * MiB;
constexpr size_t WS_ROPE = 364 * MiB, WS_XSTAT = 368 * MiB, WS_RSQ = 368 * MiB + MiB / 2, WS_RSKV = 369 * MiB;
constexpr size_t WS_Q = 370 * MiB, WS_K = 418 * MiB, WS_V = 466 * MiB;
constexpr size_t WS_NEED = 512 * MiB;

__device__ __forceinline__ bf16_t f2bf(float f) { unsigned u = __float_as_uint(f); u += 0x7fffu + ((u >> 16) & 1u); return (bf16_t)(u >> 16); }
__device__ __forceinline__ float bf2f(bf16_t b) { return __uint_as_float(((unsigned)b) << 16); }
__device__ __forceinline__ int crow(int i, int h) { return (i & 3) + 8 * (i >> 2) + 4 * h; }
__device__ __forceinline__ float wave_sum(float v) {
#pragma unroll
    for (int o = 32; o > 0; o >>= 1) v += __shfl_xor(v, o);
    return v;
}
__device__ __forceinline__ float wave_max(float v) {
#pragma unroll
    for (int o = 32; o > 0; o >>= 1) v = fmaxf(v, __shfl_xor(v, o));
    return v;
}
__device__ __forceinline__ float sigmoidf_(float z) { return 1.0f / (1.0f + __expf(-z)); }
__device__ __forceinline__ float gelu_tanh(float y) {
    const float z = 0.7978845608028654f * (y + 0.044715f * y * y * y);
    const float th = 1.0f - 2.0f / (1.0f + __expf(2.0f * z));
    return 0.5f * y * (1.0f + th);
}
__host__ __device__ __forceinline__ int ropeperm(int q) { return 16 * ((q >> 2) & 1) + 4 * (q >> 3) + (q & 3); }
__host__ __device__ __forceinline__ int ropepos(int j) { const int n = j >> 4, r = j & 15; return 8 * (r >> 2) + 4 * n + (r & 3); }

__device__ __forceinline__ void cexp_d(double re, double im, double& ore, double& oim) {
    const double s = 1.0 / 1048576.0;
    const double a = re * s, b = im * s;
    double tr = 1.0, ti = 0.0, sr = 1.0, si = 0.0;
#pragma unroll
    for (int n = 1; n <= 8; ++n) {
        const double nr = (tr * a - ti * b) / n, ni = (tr * b + ti * a) / n;
        tr = nr; ti = ni; sr += tr; si += ti;
    }
#pragma unroll
    for (int i = 0; i < 20; ++i) { const double nr = sr * sr - si * si, ni = 2.0 * sr * si; sr = nr; si = ni; }
    ore = sr; oim = si;
}

__device__ __forceinline__ int opaque_tid() { int t = threadIdx.x; asm volatile("" : "+v"(t)); return t; }
template <bool DUAL, class AF, class BF, class EPI>
__device__ __forceinline__ void sg_tile(int m0, int n0, int K, AF arow, BF bptr, EPI epi) {
    const int tidx = opaque_tid();
    const int lane = tidx & 63, r = lane & 31, h = lane >> 5;
    f32x16 acc, acc2;
#pragma unroll
    for (int i = 0; i < 16; ++i) { acc[i] = 0.f; acc2[i] = 0.f; }
    const bf16_t* ap = arow(m0 + r);
    for (int k0 = 0; k0 < K; k0 += 16) {
        const bf16x8 a = *(const bf16x8*)(ap + k0 + 8 * h);
        const bf16x8 b = *(const bf16x8*)(bptr(n0 + r, k0 + 8 * h, 0));
        acc = __builtin_amdgcn_mfma_f32_32x32x16_bf16(a, b, acc, 0, 0, 0);
        if (DUAL) {
            const bf16x8 b2 = *(const bf16x8*)(bptr(n0 + r, k0 + 8 * h, 1));
            acc2 = __builtin_amdgcn_mfma_f32_32x32x16_bf16(a, b2, acc2, 0, 0, 0);
        }
    }
#pragma unroll
    for (int i = 0; i < 16; ++i) epi(m0 + crow(i, h), n0 + r, acc[i], acc2[i]);
}

#define LAS __attribute__((address_space(3)))
#define XB_TMO      128
#define XB_XCNT(j)  (256  + 64 * (j))
#define XB_XSUB(j)  (1280 + 64 * (j))
#define XB_XGEN(j)  (2304 + 64 * (j))
#define XB_TOP      3328
#define XB_TOPGEN   3392
#define XCD_BAR_WORDS 3456
#define XB_SPIN_CAP (1u << 18)
__device__ __forceinline__ unsigned xb_ld(unsigned* p)              { return __hip_atomic_load(p, __ATOMIC_RELAXED, __HIP_MEMORY_SCOPE_AGENT); }
__device__ __forceinline__ unsigned xb_add(unsigned* p, unsigned v) { return __hip_atomic_fetch_add(p, v, __ATOMIC_RELAXED, __HIP_MEMORY_SCOPE_AGENT); }
__device__ __forceinline__ unsigned xb_xcc_id() { return (unsigned)__builtin_amdgcn_s_getreg((3 << 11) | 20) & 0xFu; }
#define XB_SPIN(cond, bar) do { unsigned _sp = 0; while (cond) { __builtin_amdgcn_s_sleep(1); \
    if ((++_sp & 255u) == 0u) { if (xb_ld(&(bar)[XB_TMO])) break; if (_sp > XB_SPIN_CAP) { atomicAdd(&(bar)[XB_TMO], 1u); break; } } } } while (0)
struct XcdBarrier { unsigned* bar; unsigned x; volatile LAS unsigned* st; };
__device__ __forceinline__ XcdBarrier xcd_barrier_post(unsigned* bar, volatile LAS unsigned* st) {
    XcdBarrier b; b.bar = bar; b.x = xb_xcc_id(); b.st = st;
    if (threadIdx.x == 0) (void)xb_add(&bar[XB_XCNT(b.x)], 1u);
    return b;
}
__device__ __forceinline__ void xcd_barrier_complete(unsigned* bar, unsigned x, unsigned& nloc, unsigned& nx) {
    const unsigned G = gridDim.x * gridDim.y * gridDim.z;
    unsigned sum, cnt, mine, sp = 0u;
    for (;;) {
        sum = 0u; cnt = 0u; mine = 0u;
#pragma unroll
        for (unsigned j = 0; j < 16; ++j) { const unsigned c = xb_ld(&bar[XB_XCNT(j)]); sum += c; cnt += (c > 0u) ? 1u : 0u; mine = (j == x) ? c : mine; }
        if (sum == G) break;
        __builtin_amdgcn_s_sleep(1);
        if ((++sp & 255u) == 0u) { if (xb_ld(&bar[XB_TMO])) break; if (sp > XB_SPIN_CAP) { atomicAdd(&bar[XB_TMO], 1u); break; } }
    }
    nloc = mine > 0u ? mine : 1u; nx = cnt > 0u ? cnt : 1u;
}
__device__ __forceinline__ void xcd_barrier(const XcdBarrier& b) {
    asm volatile("s_waitcnt vmcnt(0)" ::: "memory");
    __syncthreads();
    if (threadIdx.x == 0) {
        unsigned* bar = b.bar;
        __builtin_amdgcn_s_waitcnt(0);
        unsigned nloc = b.st[0], nx = b.st[1];
        if (nloc == 0u) { xcd_barrier_complete(bar, b.x, nloc, nx); b.st[0] = nloc; b.st[1] = nx; }
        const unsigned old = xb_add(&bar[XB_XSUB(b.x)], 1u);
        const unsigned gen = old / nloc;
        if (old + 1u == (gen + 1u) * nloc) {
            __builtin_amdgcn_fence(__ATOMIC_RELEASE, "agent");
            asm volatile("s_waitcnt vmcnt(0)" ::: "memory");
            const unsigned og = xb_add(&bar[XB_TOP], 1u);
            const unsigned tg = og / nx;
            if (og + 1u == (tg + 1u) * nx) xb_add(&bar[XB_TOPGEN], 1u);
            else XB_SPIN(xb_ld(&bar[XB_TOPGEN]) == tg, bar);
            __builtin_amdgcn_fence(__ATOMIC_ACQUIRE, "agent");
            xb_add(&bar[XB_XGEN(b.x)], 1u);
            asm volatile("s_waitcnt vmcnt(0)" ::: "memory");
        } else {
            XB_SPIN(xb_ld(&bar[XB_XGEN(b.x)]) == gen, bar);
            __builtin_amdgcn_fence(__ATOMIC_ACQUIRE, "agent");
            asm volatile("s_waitcnt vmcnt(0)" ::: "memory");
        }
    }
    __syncthreads();
}

constexpr int NTHR = 512, NWAVE = 8;
constexpr int LDS_BYTES = 147456;
constexpr int LDS_MISC = 147456 - 256;
struct Args { const void* in[34]; float* out; unsigned char* ws; };
struct Ptrs {
    const float *x, *ln_in_g, *ln_in_b, *w_in, *q_norm_g, *kv_norm_g, *w_uq, *w_ukv, *lambda_re, *lambda_im, *log_step, *b_re, *b_im, *c_re, *c_im, *d_skip, *w_glu, *b_glu;
    const float *attn_out_g, *ssm_out_g, *w_o, *ln1_g, *ln1_b, *w_router, *router_bias, *w_gate, *w_up, *w_down, *ws_gate, *ws_up, *ws_down, *ln2_g, *ln2_b;
    const int* positions; float* out; unsigned char* ws;
};
#define WSP(T_, off) ((T_*)(P.ws + (off)))

__device__ __forceinline__ void ph_ln_in(const Ptrs& P, int bid, int nb) {
    const int tidx = opaque_tid();
    const int lane = tidx & 63, w = tidx >> 6;
    bf16_t* xn = WSP(bf16_t, WS_XN); float* xstat = WSP(float, WS_XSTAT);
    for (int t = bid * NWAVE + w; t < T; t += nb * NWAVE) {
        const float* xr = P.x + (size_t)t * D;
        float v[16]; float s = 0.f;
#pragma unroll
        for (int i = 0; i < 4; ++i) { const f32x4 q = *(const f32x4*)(xr + i * 256 + lane * 4); v[4 * i] = q[0]; v[4 * i + 1] = q[1]; v[4 * i + 2] = q[2]; v[4 * i + 3] = q[3]; s += q[0] + q[1] + q[2] + q[3]; }
        const float mu = wave_sum(s) * (1.0f / D);
        float ss = 0.f;
#pragma unroll
        for (int i = 0; i < 16; ++i) { const float d = v[i] - mu; ss += d * d; }
        const float rstd = rsqrtf(wave_sum(ss) * (1.0f / D) + EPS);
        if (lane == 0) { xstat[2 * t] = mu; xstat[2 * t + 1] = rstd; }
#pragma unroll
        for (int i = 0; i < 4; ++i) {
            const int c = i * 256 + lane * 4;
            const f32x4 gg = *(const f32x4*)(P.ln_in_g + c), bb = *(const f32x4*)(P.ln_in_b + c);
            ushort4 o;
            o.x = f2bf((v[4 * i] - mu) * rstd * gg[0] + bb[0]); o.y = f2bf((v[4 * i + 1] - mu) * rstd * gg[1] + bb[1]);
            o.z = f2bf((v[4 * i + 2] - mu) * rstd * gg[2] + bb[2]); o.w = f2bf((v[4 * i + 3] - mu) * rstd * gg[3] + bb[3]);
            *(ushort4*)(xn + (size_t)t * D + c) = o;
        }
    }
}
__device__ __forceinline__ int wprep_srccol(int mode, int n, int& which) {
    which = 0;
    switch (mode) {
    case 0: if (n < 256) return n; if (n < 768) return 416 + (n - 256); if (n < 896) return 256 + (n - 768); if (n < 928) return 384 + ropeperm(n - 896); return -1;
    case 1: if (n < 512) return (n >> 6) * 96 + (n & 63); { const int m = n - 512; return (m >> 5) * 96 + 64 + ropeperm(m & 31); }
    case 2: if (n < 512) return (n >> 6) * 128 + (n & 63); { const int m = n - 512; return (m >> 6) * 128 + 64 + (m & 63); }
    case 5: { const int pn = n >> 8, w = n & 255; which = w >> 7; return pn * 128 + (w & 127); }
    default: return n;
    }
}
__device__ __forceinline__ void wprep_tile(LAS float* tile  , const float* s1, const float* s2, const float* ks, const float* ks2, bf16_t* dst,
                                           int mode, int Kd, int ldsrc, int Ksrc, float kmul, int n0, int k0) {
    const int tidx = opaque_tid();
    const int tid = tidx;
    {
        const int nn = tid & 63, ksub = tid >> 6;
        int which; const int sc = wprep_srccol(mode, n0 + nn, which);
        const float* s = which ? s2 : s1;
#pragma unroll
        for (int i = 0; i < 8; ++i) {
            const int kk = ksub + 8 * i, k = k0 + kk;
            float v = 0.f;
            if (sc >= 0 && k < Ksrc) {
                v = s[(size_t)k * ldsrc + sc];
                if (ks) v *= (ks2 && k >= 512) ? ks2[k - 512] : ks[k];
                v *= kmul;
            }
            tile[kk * 65 + nn] = v;
        }
    }
    __syncthreads();
    {
        const int kk = tid & 63, nsub = tid >> 6;
#pragma unroll
        for (int i = 0; i < 8; ++i) { const int n = nsub + 8 * i; dst[(size_t)(n0 + n) * Kd + k0 + kk] = f2bf(tile[kk * 65 + n]); }
    }
    __syncthreads();
}
__device__ __forceinline__ void ph_wprep(const Ptrs& P, LAS unsigned char* lds, int bid, int nb) {
    LAS float* tile = (LAS float*)lds;
    constexpr int J0 = 256, J1 = J0 + 48, J2 = J1 + 64, J3 = J2 + 64, J4 = J3 + 256, J5 = J4 + 65 * 128, J6 = J5 + 65 * 64;
    for (int j = bid; j < J6; j += nb) {
        if (j < J0)      { const int tl = j;      wprep_tile(tile, P.w_in, nullptr, nullptr, nullptr, WSP(bf16_t, WS_WIN), 0, 1024, 928, 1024, 1.0f, (tl / 16) * 64, (tl % 16) * 64); }
        else if (j < J1) { const int tl = j - J0; wprep_tile(tile, P.w_uq, nullptr, P.q_norm_g, nullptr, WSP(bf16_t, WS_WUQ), 1, 256, 768, 256, QSCALE, (tl / 4) * 64, (tl % 4) * 64); }
        else if (j < J2) { const int tl = j - J1; wprep_tile(tile, P.w_ukv, nullptr, P.kv_norm_g, nullptr, WSP(bf16_t, WS_WUKV), 2, 256, 1024, 128, 1.0f, (tl / 4) * 64, (tl % 4) * 64); }
        else if (j < J3) { const int tl = j - J2; wprep_tile(tile, P.w_glu, nullptr, nullptr, nullptr, WSP(bf16_t, WS_WGLU), 3, 512, 512, 512, 1.0f, (tl / 8) * 64, (tl % 8) * 64); }
        else if (j < J4) { const int tl = j - J3; wprep_tile(tile, P.w_o, nullptr, P.attn_out_g, P.ssm_out_g, WSP(bf16_t, WS_WO), 4, 1024, 1024, 1024, 1.0f, (tl / 16) * 64, (tl % 16) * 64); }
        else if (j < J5) { const int q = j - J4, e = q / 128, tl = q % 128;
            const float* g = e < 64 ? P.w_gate + (size_t)e * 1024 * 256 : P.ws_gate; const float* u = e < 64 ? P.w_up + (size_t)e * 1024 * 256 : P.ws_up;
            wprep_tile(tile, g, u, nullptr, nullptr, WSP(bf16_t, WS_WGU) + (size_t)e * 512 * 1024, 5, 1024, 256, 1024, 1.0f, (tl / 16) * 64, (tl % 16) * 64); }
        else             { const int q = j - J5, e = q / 64, tl = q % 64;
            const float* d = e < 64 ? P.w_down + (size_t)e * 256 * 1024 : P.ws_down;
            wprep_tile(tile, d, nullptr, nullptr, nullptr, WSP(bf16_t, WS_WD) + (size_t)e * 1024 * 256, 6, 256, 1024, 256, 1.0f, (tl / 4) * 64, (tl % 4) * 64); }
    }
}
__device__ __forceinline__ void ph_s5tab1(const Ptrs& P, int bid, int nb) {
    const int tidx = opaque_tid();
    float2* lampow = WSP(float2, WS_LAMPOW); float2* bbar = WSP(float2, WS_BBAR);
    for (int i = bid * NTHR + tidx; i < SG * SP; i += nb * NTHR) {
        const int g = i >> 6, p = i & 63;
        double lr = (double)P.lambda_re[g * SP + p]; if (lr > -1e-4) lr = -1e-4;
        const double li = (double)P.lambda_im[g * SP + p];
        double st, dummy; cexp_d((double)P.log_step[g], 0.0, st, dummy);
        double br, bi; cexp_d(lr * st, li * st, br, bi);
        const double nr = br - 1.0, ni = bi, den = lr * lr + li * li;
        const double cr = (nr * lr + ni * li) / den, ci = (ni * lr - nr * li) / den;
        double pr = 1.0, pi = 0.0;
        for (int tau = 0; tau <= 64; ++tau) {
            lampow[(g * SP + p) * 65 + tau] = make_float2((float)pr, (float)pi);
            const double tr = pr * br - pi * bi, ti = pr * bi + pi * br; pr = tr; pi = ti;
        }
        for (int c = 0; c < SC; ++c) {
            const double xr = (double)P.b_re[(g * SP + p) * SC + c], xi = (double)P.b_im[(g * SP + p) * SC + c];
            bbar[(g * SP + p) * SC + c] = make_float2((float)(cr * xr - ci * xi), (float)(cr * xi + ci * xr));
        }
    }
}
__device__ __forceinline__ void ph_s5tab2(const Ptrs& P, int bid, int nb) {
    const int tidx = opaque_tid();
    const float2* lampow = WSP(float2, WS_LAMPOW); const float2* bbar = WSP(float2, WS_BBAR);
    bf16_t* ktab = WSP(bf16_t, WS_KTAB); bf16_t* bloc = WSP(bf16_t, WS_BLOC); bf16_t* clam = WSP(bf16_t, WS_CLAM);
    const float* cre = P.c_re; const float* cim = P.c_im;
    const size_t nk = (size_t)SG * 127 * 256, nbl = (size_t)SG * 256 * 1024, nc = (size_t)SG * 1024 * 256;
    const size_t stride = (size_t)nb * NTHR;
    for (size_t i = (size_t)bid * NTHR + tidx; i < nk + nbl + nc; i += stride) {
        if (i < nk) {
            const int cp = (int)(i & 15), c = (int)((i >> 4) & 15), ti = (int)((i >> 8) % 127), g = (int)((i >> 8) / 127);
            const int tau = ti - 63;
            float v = 0.f;
            if (tau >= 0) {
                for (int p = 0; p < SP; ++p) {
                    const float2 l = lampow[(g * SP + p) * 65 + tau], bb = bbar[(g * SP + p) * SC + cp];
                    const float cr = cre[(g * SC + c) * SP + p], ci = cim[(g * SC + c) * SP + p];
                    const float mr = l.x * bb.x - l.y * bb.y, mi = l.x * bb.y + l.y * bb.x;
                    v += cr * mr - ci * mi;
                }
                if (tau == 0 && c == cp) v += P.d_skip[g * SC + c];
            }
            ktab[i] = f2bf(v);
        } else if (i < nk + nbl) {
            const size_t j = i - nk;
            const int k = (int)(j & 1023), n = (int)((j >> 10) & 255), g = (int)(j >> 18);
            float v = 0.f;
            if (n < 128) {
                const int p = n & 63, s = k >> 4, c = k & 15;
                const float2 l = lampow[(g * SP + p) * 65 + (63 - s)], bb = bbar[(g * SP + p) * SC + c];
                v = (n < 64) ? (l.x * bb.x - l.y * bb.y) : (l.x * bb.y + l.y * bb.x);
            }
            bloc[j] = f2bf(v);
        } else {
            const size_t j = i - nk - nbl;
            const int k = (int)(j & 255), n = (int)((j >> 8) & 1023), g = (int)(j >> 18);
            float v = 0.f;
            if (k < 128) {
                const int p = k & 63, t = n >> 4, c = n & 15;
                const float2 l = lampow[(g * SP + p) * 65 + (t + 1)];
                const float cr = cre[(g * SC + c) * SP + p], ci = cim[(g * SC + c) * SP + p];
                v = (k < 64) ? (cr * l.x - ci * l.y) : -(cr * l.y + ci * l.x);
            }
            clam[j] = f2bf(v);
        }
    }
}
__device__ __forceinline__ void ph_ropetab(const Ptrs& P, int bid, int nb) {
    const int tidx = opaque_tid();
    float2* rope = WSP(float2, WS_ROPE);
    for (int i = bid * NTHR + tidx; i < T * 16; i += nb * NTHR) {
        const int t = i >> 4, j = i & 15;
        double invf, dm; cexp_d(-(double)j / 16.0 * 9.210340371976184, 0.0, invf, dm);
        const float ang = (float)P.positions[t] * (float)invf;
        double c, s; cexp_d(0.0, (double)ang, c, s);
        rope[i] = make_float2((float)c, (float)s);
    }
}

#define GW_LOOP(ntiles) for (int tl = bid * NWAVE + (tidx >> 6); tl < (ntiles); tl += nb * NWAVE)
__device__ __forceinline__ void ph_gemm_win(const Ptrs& P, int bid, int nb) {
    const int tidx = opaque_tid();
    const bf16_t* xn = WSP(bf16_t, WS_XN); const bf16_t* wt = WSP(bf16_t, WS_WIN);
    bf16_t* cq = WSP(bf16_t, WS_CQ); bf16_t* ckv = WSP(bf16_t, WS_CKV); bf16_t* u = WSP(bf16_t, WS_U); float* krraw = WSP(float, WS_KRRAW);
    GW_LOOP((T / 32) * 32) {
        const int m0 = (tl >> 5) * 32, n0 = (tl & 31) * 32;
        sg_tile<false>(m0, n0, D,
            [&](int row) { return xn + (size_t)row * D; },
            [&](int n, int k, int) { return wt + (size_t)n * D + k; },
            [&](int t, int n, float v, float) {
                if (n < 256) cq[(size_t)t * 256 + n] = f2bf(v);
                else if (n < 768) {
                    const int ch = n - 256, g = ch >> 4, c = ch & 15, b = t >> 11, s = t & 2047, j = s >> 6, sl = s & 63;
                    u[((size_t)g * 512 + b * 32 + j) * 1024 + sl * 16 + c] = f2bf(v);
                } else if (n < 896) ckv[(size_t)t * 256 + (n - 768)] = f2bf(v);
                else {
                    ckv[(size_t)t * 256 + (n - 768)] = 0;
                    if (n < 928) krraw[(size_t)t * 32 + ropeperm(n - 896)] = v;
                }
            });
    }
}
__device__ __forceinline__ void ph_rstat(const Ptrs& P, int bid, int nb) {
    const int tidx = opaque_tid();
    const bf16_t* cq = WSP(bf16_t, WS_CQ); const bf16_t* ckv = WSP(bf16_t, WS_CKV); float* rsq = WSP(float, WS_RSQ); float* rskv = WSP(float, WS_RSKV);
    const int lane = tidx & 63, w = tidx >> 6;
    for (int t = bid * NWAVE + w; t < T; t += nb * NWAVE) {
        float s = 0.f, s2 = 0.f;
#pragma unroll
        for (int i = 0; i < 4; ++i) { const float v = bf2f(cq[(size_t)t * 256 + i * 64 + lane]); s += v * v; }
#pragma unroll
        for (int i = 0; i < 2; ++i) { const float v = bf2f(ckv[(size_t)t * 256 + i * 64 + lane]); s2 += v * v; }
        s = wave_sum(s); s2 = wave_sum(s2);
        if (lane == 0) { rsq[t] = rsqrtf(s * (1.0f / 256) + EPS); rskv[t] = rsqrtf(s2 * (1.0f / 128) + EPS); }
    }
}
__device__ __forceinline__ void ph_gemm_q(const Ptrs& P, int bid, int nb) {
    const int tidx = opaque_tid();
    const bf16_t* cq = WSP(bf16_t, WS_CQ); const bf16_t* wt = WSP(bf16_t, WS_WUQ); const float* rsq = WSP(float, WS_RSQ); bf16_t* Q = WSP(bf16_t, WS_Q); float* qrraw = WSP(float, WS_QRRAW);
    GW_LOOP((T / 32) * 24) {
        const int m0 = (tl / 24) * 32, n0 = (tl % 24) * 32;
        sg_tile<false>(m0, n0, 256,
            [&](int row) { return cq + (size_t)row * 256; },
            [&](int n, int k, int) { return wt + (size_t)n * 256 + k; },
            [&](int t, int n, float v, float) {
                v *= rsq[t];
                const int b = t >> 11, s = t & 2047;
                if (n < 512) Q[(((size_t)b * NH + (n >> 6)) * SEQ + s) * QKD + (n & 63)] = f2bf(v);
                else { const int m = n - 512; qrraw[(size_t)t * 256 + (m >> 5) * 32 + ropeperm(m & 31)] = v; }
            });
    }
}
__device__ __forceinline__ void ph_gemm_kv(const Ptrs& P, int bid, int nb) {
    const int tidx = opaque_tid();
    const bf16_t* ckv = WSP(bf16_t, WS_CKV); const bf16_t* wt = WSP(bf16_t, WS_WUKV); const float* rskv = WSP(float, WS_RSKV); bf16_t* Kc = WSP(bf16_t, WS_K); bf16_t* V = WSP(bf16_t, WS_V);
    GW_LOOP((T / 32) * 32) {
        const int m0 = (tl >> 5) * 32, n0 = (tl & 31) * 32;
        sg_tile<false>(m0, n0, 256,
            [&](int row) { return ckv + (size_t)row * 256; },
            [&](int n, int k, int) { return wt + (size_t)n * 256 + k; },
            [&](int t, int n, float v, float) {
                v *= rskv[t];
                const int b = t >> 11, s = t & 2047;
                if (n < 512) Kc[(((size_t)b * NH + (n >> 6)) * SEQ + s) * QKD + (n & 63)] = f2bf(v);
                else { const int m = n - 512; V[(((size_t)b * NH + (m >> 6)) * SEQ + s) * VD + (m & 63)] = f2bf(v); }
            });
    }
}
__device__ __forceinline__ void ph_rope_apply(const Ptrs& P, int bid, int nb) {
    const int tidx = opaque_tid();
    const float* qrraw = WSP(float, WS_QRRAW); const float* krraw = WSP(float, WS_KRRAW); const float2* rope = WSP(float2, WS_ROPE); bf16_t* Q = WSP(bf16_t, WS_Q); bf16_t* Kc = WSP(bf16_t, WS_K);
    for (int i = bid * NTHR + tidx; i < T * 9 * 16; i += nb * NTHR) {
        const int j = i & 15, hh = (i >> 4) % 9, t = (i >> 4) / 9;
        const float2 cs = rope[t * 16 + j];
        const int b = t >> 11, s = t & 2047;
        if (hh < 8) {
            const float x1 = qrraw[(size_t)t * 256 + hh * 32 + j], x2 = qrraw[(size_t)t * 256 + hh * 32 + 16 + j];
            bf16_t* q = Q + (((size_t)b * NH + hh) * SEQ + s) * QKD + 64;
            q[j] = f2bf(x1 * cs.x - x2 * cs.y); q[16 + j] = f2bf(x2 * cs.x + x1 * cs.y);
        } else {
            const float x1 = krraw[(size_t)t * 32 + j], x2 = krraw[(size_t)t * 32 + 16 + j];
            const bf16_t o1 = f2bf(x1 * cs.x - x2 * cs.y), o2 = f2bf(x2 * cs.x + x1 * cs.y);
            for (int h = 0; h < NH; ++h) { bf16_t* k = Kc + (((size_t)b * NH + h) * SEQ + s) * QKD + 64; k[j] = o1; k[16 + j] = o2; }
        }
    }
}
__device__ __forceinline__ void ph_gemm_s5b(const Ptrs& P, int bid, int nb) {
    const int tidx = opaque_tid();
    const bf16_t* u = WSP(bf16_t, WS_U); const bf16_t* bloc = WSP(bf16_t, WS_BLOC); float* xloc = WSP(float, WS_XLOC);
    GW_LOOP(SG * 16 * 4) {
        const int g = tl >> 6, m0 = ((tl >> 2) & 15) * 32, n0 = (tl & 3) * 32;
        sg_tile<false>(m0, n0, 1024,
            [&](int row) { return u + ((size_t)g * 512 + row) * 1024; },
            [&](int n, int k, int) { return bloc + ((size_t)g * 256 + n) * 1024 + k; },
            [&](int row, int n, float v, float) { xloc[((size_t)g * 512 + row) * 128 + n] = v; });
    }
}
__device__ __forceinline__ void ph_gemm_s5a(const Ptrs& P, int bid, int nb) {
    const int tidx = opaque_tid();
    const bf16_t* u = WSP(bf16_t, WS_U); const bf16_t* ktab = WSP(bf16_t, WS_KTAB); bf16_t* yintra = WSP(bf16_t, WS_YINTRA);
    GW_LOOP(SG * 16 * 32) {
        const int g = tl >> 9, m0 = ((tl >> 5) & 15) * 32, n0 = (tl & 31) * 32;
        sg_tile<false>(m0, n0, 1024,
            [&](int row) { return u + ((size_t)g * 512 + row) * 1024; },
            [&](int n, int k, int) { const int t = n >> 4, c = n & 15, s = k >> 4, c0 = k & 15; return ktab + (((size_t)g * 127 + (t - s + 63)) * 16 + c) * 16 + c0; },
            [&](int row, int n, float v, float) {
                const int b = row >> 5, j = row & 31, t = n >> 4, c = n & 15;
                yintra[((size_t)b * SEQ + j * CH + t) * SSMW + g * SC + c] = f2bf(v);
            });
    }
}
__device__ __forceinline__ void ph_attn_simple(const Ptrs& P, LAS unsigned char* lds, int bid, int nb) {
    const int tidx = opaque_tid();
    const bf16_t* Q = WSP(bf16_t, WS_Q); const bf16_t* Kc = WSP(bf16_t, WS_K); const bf16_t* V = WSP(bf16_t, WS_V); bf16_t* AS = WSP(bf16_t, WS_AS);
    const int lane = tidx & 63, w = tidx >> 6;
    LAS float* qs = (LAS float*)lds + w * (QKD + SEQ);
    LAS float* ps = qs + QKD;
    for (int row = bid * NWAVE + w; row < T * NH; row += nb * NWAVE) {
        const int bh = row >> 11, q = row & 2047, b = bh >> 3, h = bh & 7;
        asm volatile("s_waitcnt lgkmcnt(0)" ::: "memory");
        qs[lane] = bf2f(Q[(size_t)row * QKD + lane]);
        if (lane < 32) qs[64 + lane] = bf2f(Q[(size_t)row * QKD + 64 + lane]);
        asm volatile("s_waitcnt lgkmcnt(0)" ::: "memory");
        const int nk = ((q >> 6) + 1) * 64;
        float m = -INFINITY;
        for (int kb = 0; kb < nk; kb += 64) {
            const bf16_t* kp = Kc + ((size_t)bh * SEQ + kb + lane) * QKD;
            float s = 0.f;
#pragma unroll
            for (int c = 0; c < 12; ++c) {
                const bf16x8 kv = *(const bf16x8*)(kp + c * 8);
#pragma unroll
                for (int e = 0; e < 8; ++e) s += qs[c * 8 + e] * bf2f((bf16_t)kv[e]);
            }
            ps[kb + lane] = s; m = fmaxf(m, s);
        }
        m = wave_max(m);
        float l = 0.f;
        for (int kb = 0; kb < nk; kb += 64) { const float p = exp2f(ps[kb + lane] - m); ps[kb + lane] = p; l += p; }
        l = wave_sum(l);
        asm volatile("s_waitcnt lgkmcnt(0)" ::: "memory");
        float o = 0.f;
        const bf16_t* vp = V + (size_t)bh * SEQ * VD + lane;
        for (int k = 0; k < nk; ++k) o += ps[k] * bf2f(vp[(size_t)k * VD]);
        AS[((size_t)b * SEQ + q) * 1024 + h * 64 + lane] = f2bf(o / l);
    }
}
__device__ __forceinline__ void ph_s5scan(const Ptrs& P, int bid, int nb) {
    const int tidx = opaque_tid();
    const float* xloc = WSP(float, WS_XLOC); const float2* lampow = WSP(float2, WS_LAMPOW); bf16_t* xprev = WSP(bf16_t, WS_XPREV);
    for (int i = bid * NTHR + tidx; i < SG * NB * SP; i += nb * NTHR) {
        const int p = i & 63, b = (i >> 6) & 15, g = i >> 10;
        const float2 l64 = lampow[(g * SP + p) * 65 + 64];
        float xr = 0.f, xi = 0.f;
        for (int j = 0; j < NCH; ++j) {
            const size_t row = (size_t)g * 512 + b * 32 + j;
            bf16_t* xp = xprev + row * 256;
            xp[p] = f2bf(xr); xp[64 + p] = f2bf(xi); xp[128 + p] = 0; xp[192 + p] = 0;
            const float lr = xloc[row * 128 + p], li = xloc[row * 128 + 64 + p];
            const float nr = l64.x * xr - l64.y * xi + lr, ni = l64.x * xi + l64.y * xr + li;
            xr = nr; xi = ni;
        }
    }
}
__device__ __forceinline__ void ph_gemm_s5d(const Ptrs& P, int bid, int nb) {
    const int tidx = opaque_tid();
    const bf16_t* xprev = WSP(bf16_t, WS_XPREV); const bf16_t* clam = WSP(bf16_t, WS_CLAM); const bf16_t* yintra = WSP(bf16_t, WS_YINTRA); bf16_t* Y = WSP(bf16_t, WS_Y);
    GW_LOOP(SG * 16 * 32) {
        const int g = tl >> 9, m0 = ((tl >> 5) & 15) * 32, n0 = (tl & 31) * 32;
        sg_tile<false>(m0, n0, 256,
            [&](int row) { return xprev + ((size_t)g * 512 + row) * 256; },
            [&](int n, int k, int) { return clam + ((size_t)g * 1024 + n) * 256 + k; },
            [&](int row, int n, float v, float) {
                const int b = row >> 5, j = row & 31, t = n >> 4, c = n & 15;
                const size_t o = ((size_t)b * SEQ + j * CH + t) * SSMW + g * SC + c;
                Y[o] = f2bf(gelu_tanh(v + bf2f(yintra[o])));
            });
    }
}
__device__ __forceinline__ void ph_gemm_glu(const Ptrs& P, int bid, int nb) {
    const int tidx = opaque_tid();
    const bf16_t* Y = WSP(bf16_t, WS_Y); const bf16_t* wt = WSP(bf16_t, WS_WGLU); bf16_t* AS = WSP(bf16_t, WS_AS);
    GW_LOOP((T / 32) * 16) {
        const int m0 = (tl >> 4) * 32, n0 = (tl & 15) * 32;
        sg_tile<false>(m0, n0, 512,
            [&](int row) { return Y + (size_t)row * 512; },
            [&](int n, int k, int) { return wt + (size_t)n * 512 + k; },
            [&](int t, int n, float v, float) {
                const float yv = bf2f(Y[(size_t)t * 512 + n]);
                AS[(size_t)t * 1024 + 512 + n] = f2bf(yv * sigmoidf_(v + P.b_glu[n]));
            });
    }
}
__device__ __forceinline__ void ph_asnorm(const Ptrs& P, int bid, int nb) {
    const int tidx = opaque_tid();
    bf16_t* AS = WSP(bf16_t, WS_AS);
    const int lane = tidx & 63, w = tidx >> 6;
    for (int t = bid * NWAVE + w; t < T; t += nb * NWAVE) {
        bf16_t* r = AS + (size_t)t * 1024;
        float va[8], vs[8]; float sa = 0.f, ss = 0.f;
        const bf16x8 a = *(const bf16x8*)(r + lane * 8), s = *(const bf16x8*)(r + 512 + lane * 8);
#pragma unroll
        for (int i = 0; i < 8; ++i) { va[i] = bf2f((bf16_t)a[i]); vs[i] = bf2f((bf16_t)s[i]); sa += va[i] * va[i]; ss += vs[i] * vs[i]; }
        const float ra = rsqrtf(wave_sum(sa) * (1.0f / 512) + EPS), rs = rsqrtf(wave_sum(ss) * (1.0f / 512) + EPS);
        bf16x8 oa, os;
#pragma unroll
        for (int i = 0; i < 8; ++i) { oa[i] = (short)f2bf(va[i] * ra); os[i] = (short)f2bf(vs[i] * rs); }
        *(bf16x8*)(r + lane * 8) = oa; *(bf16x8*)(r + 512 + lane * 8) = os;
    }
}
__device__ __forceinline__ void ph_gemm_wo(const Ptrs& P, int bid, int nb) {
    const int tidx = opaque_tid();
    const bf16_t* AS = WSP(bf16_t, WS_AS); const bf16_t* wt = WSP(bf16_t, WS_WO); const float* xstat = WSP(float, WS_XSTAT); float* pre1 = P.out;
    GW_LOOP((T / 32) * 32) {
        const int m0 = (tl >> 5) * 32, n0 = (tl & 31) * 32;
        sg_tile<false>(m0, n0, 1024,
            [&](int row) { return AS + (size_t)row * 1024; },
            [&](int n, int k, int) { return wt + (size_t)n * 1024 + k; },
            [&](int t, int n, float v, float) {
                const float xn = (P.x[(size_t)t * D + n] - xstat[2 * t]) * xstat[2 * t + 1] * P.ln_in_g[n] + P.ln_in_b[n];
                pre1[(size_t)t * D + n] = v + ALPHA * xn;
            });
    }
}
__device__ __forceinline__ void ph_ln1(const Ptrs& P, int bid, int nb) {
    const int tidx = opaque_tid();
    const float* pre1 = P.out; bf16_t* x1 = WSP(bf16_t, WS_X1); bf16_t* x1lo = WSP(bf16_t, WS_X1LO);
    const int lane = tidx & 63, w = tidx >> 6;
    for (int t = bid * NWAVE + w; t < T; t += nb * NWAVE) {
        const float* xr = pre1 + (size_t)t * D;
        float v[16]; float s = 0.f;
#pragma unroll
        for (int i = 0; i < 4; ++i) { const f32x4 q = *(const f32x4*)(xr + i * 256 + lane * 4); v[4 * i] = q[0]; v[4 * i + 1] = q[1]; v[4 * i + 2] = q[2]; v[4 * i + 3] = q[3]; s += q[0] + q[1] + q[2] + q[3]; }
        const float mu = wave_sum(s) * (1.0f / D);
        float ss = 0.f;
#pragma unroll
        for (int i = 0; i < 16; ++i) { const float d = v[i] - mu; ss += d * d; }
        const float rstd = rsqrtf(wave_sum(ss) * (1.0f / D) + EPS);
#pragma unroll
        for (int i = 0; i < 4; ++i) {
            const int c = i * 256 + lane * 4;
            const f32x4 gg = *(const f32x4*)(P.ln1_g + c), bb = *(const f32x4*)(P.ln1_b + c);
            ushort4 o, ol;
            float y;
            y = (v[4 * i] - mu) * rstd * gg[0] + bb[0];     o.x = f2bf(y); ol.x = f2bf(y - bf2f(o.x));
            y = (v[4 * i + 1] - mu) * rstd * gg[1] + bb[1]; o.y = f2bf(y); ol.y = f2bf(y - bf2f(o.y));
            y = (v[4 * i + 2] - mu) * rstd * gg[2] + bb[2]; o.z = f2bf(y); ol.z = f2bf(y - bf2f(o.z));
            y = (v[4 * i + 3] - mu) * rstd * gg[3] + bb[3]; o.w = f2bf(y); ol.w = f2bf(y - bf2f(o.w));
            *(ushort4*)(x1 + (size_t)t * D + c) = o; *(ushort4*)(x1lo + (size_t)t * D + c) = ol;
        }
    }
}
__device__ __forceinline__ void ph_router(const Ptrs& P, int bid, int nb) {
    const int tidx = opaque_tid();
    const bf16_t* x1 = WSP(bf16_t, WS_X1); const bf16_t* x1lo = WSP(bf16_t, WS_X1LO); float* logits = WSP(float, WS_LOGITS);
    const int e = tidx & 63, w = tidx >> 6;
    for (int t = bid * NWAVE + w; t < T; t += nb * NWAVE) {
        const bf16_t* a = x1 + (size_t)t * D; const bf16_t* al = x1lo + (size_t)t * D;
        float s = 0.f;
        for (int k = 0; k < D; k += 8) {
            const bf16x8 hi = *(const bf16x8*)(a + k), lo = *(const bf16x8*)(al + k);
#pragma unroll
            for (int i = 0; i < 8; ++i) s += (bf2f((bf16_t)hi[i]) + bf2f((bf16_t)lo[i])) * P.w_router[(size_t)(k + i) * NE + e];
        }
        logits[(size_t)t * NE + e] = s;
    }
}
__device__ __forceinline__ void ph_topk(const Ptrs& P, int bid, int nb) {
    const int tidx = opaque_tid();
    const float* logits = WSP(float, WS_LOGITS); int* topi = WSP(int, WS_TOPI); float* topw = WSP(float, WS_TOPW);
    const int lane = tidx & 63, w = tidx >> 6;
    for (int t = bid * NWAVE + w; t < T; t += nb * NWAVE) {
        const float sc = sigmoidf_(logits[(size_t)t * NE + lane]);
        const float sel = sc + P.router_bias[lane];
        const int grp = lane >> 3;
        float m1 = sel;
        m1 = fmaxf(m1, __shfl_xor(m1, 1)); m1 = fmaxf(m1, __shfl_xor(m1, 2)); m1 = fmaxf(m1, __shfl_xor(m1, 4));
        const unsigned long long bal = __ballot(sel == m1) & (0xFFull << (8 * grp));
        const int first = __ffsll((long long)bal) - 1;
        float m2 = (lane == first) ? -INFINITY : sel;
        m2 = fmaxf(m2, __shfl_xor(m2, 1)); m2 = fmaxf(m2, __shfl_xor(m2, 2)); m2 = fmaxf(m2, __shfl_xor(m2, 4));
        const float gs = m1 + m2;
        int cg = 0;
#pragma unroll
        for (int gj = 0; gj < 8; ++gj) { const float sj = __shfl(gs, gj * 8); cg += (sj > gs || (sj == gs && gj < grp)) ? 1 : 0; }
        const bool gsel = cg < 4;
        const float v = gsel ? sel : -INFINITY;
        int rank = 0;
        for (int e2 = 0; e2 < 64; ++e2) { const float ve = __shfl(v, e2); rank += (ve > v || (ve == v && e2 < lane)) ? 1 : 0; }
        const bool chosen = gsel && rank < TOPK;
        const float wsum = wave_sum(chosen ? sc : 0.f);
        if (chosen) { topi[(size_t)t * TOPK + rank] = lane; topw[(size_t)t * TOPK + rank] = sc / wsum * 2.5f; }
    }
}
__device__ __forceinline__ void ph_cnt(const Ptrs& P, int bid, int nb) {
    const int tidx = opaque_tid();
    const int* topi = WSP(int, WS_TOPI); int* cnt = WSP(int, WS_CNT);
    for (int i = bid * NTHR + tidx; i < 256 * 64; i += nb * NTHR) {
        const int tile = i >> 6, e = i & 63;
        int c = 0;
        for (int k = 0; k < 1024; ++k) c += (topi[tile * 1024 + k] == e) ? 1 : 0;
        cnt[i] = c;
    }
}
__device__ __forceinline__ void ph_off(const Ptrs& P, LAS unsigned char* lds, int bid) {
    const int tidx = opaque_tid();
    if (bid != 0) return;
    const int* cnt = WSP(int, WS_CNT); int* toff = WSP(int, WS_TOFF); int* eoff = WSP(int, WS_EOFF); int* ecnt = WSP(int, WS_ECNT);
    LAS int* tot = (LAS int*)lds; LAS int* off = tot + 64;
    const int e = tidx;
    if (e < 64) { int s = 0; for (int tile = 0; tile < 256; ++tile) s += cnt[tile * 64 + e]; tot[e] = s; ecnt[e] = s; }
    __syncthreads();
    if (e == 0) { int o = 0; for (int i = 0; i < 64; ++i) { off[i] = o; o += (tot[i] + 255) & ~255; } off[64] = o; }
    __syncthreads();
    if (e < 64) {
        eoff[e] = off[e]; if (e == 0) eoff[64] = off[64];
        int run = off[e];
        for (int tile = 0; tile < 256; ++tile) { toff[tile * 64 + e] = run; run += cnt[tile * 64 + e]; }
    }
}
__device__ __forceinline__ void ph_lists(const Ptrs& P, int bid, int nb) {
    const int tidx = opaque_tid();
    const int* topi = WSP(int, WS_TOPI); const float* topw = WSP(float, WS_TOPW); const int* toff = WSP(int, WS_TOFF); const int* eoff = WSP(int, WS_EOFF);
    int* rowtok = WSP(int, WS_ROWTOK); float* roww = WSP(float, WS_ROWW);
    for (int i = bid * NTHR + tidx; i < 256 * 64; i += nb * NTHR) {
        const int tile = i >> 6, e = i & 63;
        int pos = toff[tile * 64 + e];
        for (int k = 0; k < 1024; ++k) {
            if (topi[tile * 1024 + k] == e) { rowtok[pos] = tile * 1024 + k; roww[pos] = topw[tile * 1024 + k]; ++pos; }
        }
        if (tile == 255) { const int end = eoff[e + 1]; for (; pos < end; ++pos) { rowtok[pos] = -1; roww[pos] = 0.f; } }
    }
    for (int i = bid * NTHR + tidx; i < T; i += nb * NTHR) rowtok[SH_ROW0 + i] = i * 8;
}
__device__ __forceinline__ void ph_gemm_gu(const Ptrs& P, int bid, int nb) {
    const int tidx = opaque_tid();
    const bf16_t* x1 = WSP(bf16_t, WS_X1); const bf16_t* wgu = WSP(bf16_t, WS_WGU); const int* rowtok = WSP(int, WS_ROWTOK); const float* roww = WSP(float, WS_ROWW);
    const int* eoff = WSP(int, WS_EOFF); bf16_t* H = WSP(bf16_t, WS_H);
    const int nrt = eoff[64] / 32;
    const int ntl = (nrt + T / 32) * 8;
    GW_LOOP(ntl) {
        const int rt = tl >> 3, n0 = (tl & 7) * 32;
        if (rt < nrt) {
            const int m0 = rt * 32;
            int e = 0; while (e < 63 && eoff[e + 1] <= m0) ++e;
            const bf16_t* w = wgu + (size_t)e * 512 * 1024;
            sg_tile<true>(m0, n0, 1024,
                [&](int row) { const int s = rowtok[row]; return x1 + (size_t)(s >= 0 ? (s >> 3) : 0) * D; },
                [&](int f, int k, int which) { return w + (size_t)((f >> 7) * 256 + (f & 127) + which * 128) * 1024 + k; },
                [&](int row, int f, float gv, float uv) { H[(size_t)row * FF + f] = f2bf(gv * sigmoidf_(gv) * uv * roww[row]); });
        } else {
            const int m0 = (rt - nrt) * 32;
            const bf16_t* w = wgu + (size_t)64 * 512 * 1024;
            sg_tile<true>(m0, n0, 1024,
                [&](int row) { return x1 + (size_t)row * D; },
                [&](int f, int k, int which) { return w + (size_t)((f >> 7) * 256 + (f & 127) + which * 128) * 1024 + k; },
                [&](int row, int f, float gv, float uv) { H[(size_t)(SH_ROW0 + row) * FF + f] = f2bf(gv * sigmoidf_(gv) * uv); });
        }
    }
}
__device__ __forceinline__ unsigned char f2fp8(float v) { const int p = __builtin_amdgcn_cvt_pk_fp8_f32(v, v, 0, false); return (unsigned char)(p & 0xff); }
__device__ __forceinline__ void ph_gemm_down(const Ptrs& P, int bid, int nb) {
    const int tidx = opaque_tid();
    const bf16_t* H = WSP(bf16_t, WS_H); const bf16_t* wd = WSP(bf16_t, WS_WD); const int* rowtok = WSP(int, WS_ROWTOK); const int* eoff = WSP(int, WS_EOFF);
    const bf16_t* x1 = WSP(bf16_t, WS_X1); unsigned char* yslot = WSP(unsigned char, WS_YSLOT); float* out = P.out;
    const int nrt = eoff[64] / 32;
    const int ntl = (nrt + T / 32) * 32;
    GW_LOOP(ntl) {
        const int rt = tl >> 5, n0 = (tl & 31) * 32;
        if (rt < nrt) {
            const int m0 = rt * 32;
            int e = 0; while (e < 63 && eoff[e + 1] <= m0) ++e;
            const bf16_t* w = wd + (size_t)e * 1024 * 256;
            sg_tile<false>(m0, n0, 256,
                [&](int row) { return H + (size_t)row * FF; },
                [&](int n, int k, int) { return w + (size_t)n * 256 + k; },
                [&](int row, int n, float v, float) { const int s = rowtok[row]; if (s >= 0) yslot[(size_t)s * D + n] = f2fp8(v * SLOT_SCALE); });
        } else {
            const int m0 = (rt - nrt) * 32;
            const bf16_t* w = wd + (size_t)64 * 1024 * 256;
            sg_tile<false>(m0, n0, 256,
                [&](int row) { return H + (size_t)(SH_ROW0 + row) * FF; },
                [&](int n, int k, int) { return w + (size_t)n * 256 + k; },
                [&](int t, int n, float v, float) { out[(size_t)t * D + n] = v + ALPHA * bf2f(x1[(size_t)t * D + n]); });
        }
    }
}
__device__ __forceinline__ void ph_combine(const Ptrs& P, int bid, int nb) {
    const int tidx = opaque_tid();
    const unsigned char* yslot = WSP(unsigned char, WS_YSLOT); float* out = P.out;
    const int lane = tidx & 63, w = tidx >> 6;
    for (int t = bid * NWAVE + w; t < T; t += nb * NWAVE) {
        float* orow = out + (size_t)t * D + lane * 16;
        float v[16];
#pragma unroll
        for (int i = 0; i < 4; ++i) { const f32x4 q = *(const f32x4*)(orow + 4 * i); v[4 * i] = q[0]; v[4 * i + 1] = q[1]; v[4 * i + 2] = q[2]; v[4 * i + 3] = q[3]; }
#pragma unroll
        for (int k = 0; k < TOPK; ++k) {
            const u32x4 q = *(const u32x4*)(yslot + ((size_t)t * TOPK + k) * D + lane * 16);
#pragma unroll
            for (int i = 0; i < 4; ++i) {
                v[4 * i]     += __builtin_amdgcn_cvt_f32_fp8((int)q[i], 0) * (1.0f / SLOT_SCALE);
                v[4 * i + 1] += __builtin_amdgcn_cvt_f32_fp8((int)q[i], 1) * (1.0f / SLOT_SCALE);
                v[4 * i + 2] += __builtin_amdgcn_cvt_f32_fp8((int)q[i], 2) * (1.0f / SLOT_SCALE);
                v[4 * i + 3] += __builtin_amdgcn_cvt_f32_fp8((int)q[i], 3) * (1.0f / SLOT_SCALE);
            }
        }
        float s = 0.f;
#pragma unroll
        for (int i = 0; i < 16; ++i) s += v[i];
        const float mu = wave_sum(s) * (1.0f / D);
        float ss = 0.f;
#pragma unroll
        for (int i = 0; i < 16; ++i) { const float d = v[i] - mu; ss += d * d; }
        const float rstd = rsqrtf(wave_sum(ss) * (1.0f / D) + EPS);
#pragma unroll
        for (int i = 0; i < 4; ++i) {
            const int c = lane * 16 + 4 * i;
            const f32x4 gg = *(const f32x4*)(P.ln2_g + c), bb = *(const f32x4*)(P.ln2_b + c);
            f32x4 o;
            o[0] = (v[4 * i] - mu) * rstd * gg[0] + bb[0]; o[1] = (v[4 * i + 1] - mu) * rstd * gg[1] + bb[1];
            o[2] = (v[4 * i + 2] - mu) * rstd * gg[2] + bb[2]; o[3] = (v[4 * i + 3] - mu) * rstd * gg[3] + bb[3];
            *(f32x4*)(orow + 4 * i) = o;
        }
    }
}

namespace g8 {
constexpr int BM = 256, BK = 64, HALF = 128, HTB = HALF * BK * 2, STAGE_BYTES = 8 * HTB;
__device__ __forceinline__ int lds_byte(int r, int c) { const int st = (r >> 4) * 2 + (c >> 5), rr = r & 15, cc = c & 31, ob = rr * 64 + cc * 2; return st * 1024 + (ob ^ (((ob >> 9) & 1) << 5)); }
__device__ __forceinline__ void stage_rc(int b, int& R, int& C) { const int st = b / 1024, sb = b % 1024, swz = sb ^ (((sb >> 9) & 1) << 5); R = (st >> 1) * 16 + swz / 64; C = (st & 1) * 32 + (swz % 64) / 2; }
__device__ __forceinline__ int perm32(int rho) { const int n = rho >> 4, i = rho & 15; return 8 * (i >> 2) + 4 * n + (i & 3); }

struct Unit { const char* A; const char* B; const int* rows; int pm, pn, e, nt; };
struct Geo { int lda_b, ldb_b; long kstepA, kstepB; int toep; };

typedef float f32x4 __attribute__((ext_vector_type(4)));
typedef f32x4 Acc[2][2][4][2];

template <class Epi, class Sched, bool GATHER>
__device__ __forceinline__ void gemm_body(LAS unsigned char* lds, const Geo g, const Sched& S, const Epi& E) {
    const int tid = opaque_tid(), wid = __builtin_amdgcn_readfirstlane(tid >> 6), lane = tid & 63, wr = wid >> 2, wc = wid & 3, fr = lane & 15, fq = lane >> 4;
    int sR[2], sC[2];
    unsigned voffB[2], vA[2][2], vN[2][2];
#pragma unroll
    for (int i = 0; i < 2; ++i) { int R, C; stage_rc(tid * 16 + i * 8192, R, C); sR[i] = R; sC[i] = C; const int Rb = (R & ~31) + perm32(R & 31);
        voffB[i] = g.toep ? (unsigned)(Rb * 32 + 1536 - (C >> 4) * 512 + (C & 15) * 2) : (unsigned)(Rb * g.ldb_b + C * 2);
#pragma unroll
        for (int h = 0; h < 2; ++h) { vA[h][i] = (unsigned)((h * HALF + R) * g.lda_b + C * 2); vN[h][i] = vA[h][i]; } }
    const long kA = g.kstepA, kB = g.kstepB;
    const long hB = (long)HALF * g.ldb_b;
    const unsigned ldsw = (unsigned)wid * 1024u;
    const int aoff = lds_byte(wr * 64 + fr, fq * 8), boff = lds_byte(wc * 32 + fr, fq * 8);
#define G8_SA(b, h) (((b) * 2 + (h)) * HTB)
#define G8_SB(b, h) ((4 + (b) * 2 + (h)) * HTB)
#define G8_STAGE(bufoff, gbase, v0, v1) do { \
        __builtin_amdgcn_global_load_lds((const unsigned*)((const char*)(gbase) + (v0)), (LAS unsigned*)(lds + (bufoff) + ldsw), 16, 0, 0); \
        __builtin_amdgcn_global_load_lds((const unsigned*)((const char*)(gbase) + (v1)), (LAS unsigned*)(lds + (bufoff) + ldsw + 8192), 16, 0, 0); } while (0)
#define G8_STB(bufoff, gbase) G8_STAGE(bufoff, gbase, voffB[0], voffB[1])
#define G8_LDA(dst, b, h) do { _Pragma("unroll") for (int m = 0; m < 4; ++m) _Pragma("unroll") for (int k = 0; k < 2; ++k) dst[m][k] = *(const LAS bf16x8*)(lds + G8_SA(b, h) + aoff + m * 2048 + k * 1024); } while (0)
#define G8_LDB(dst, b, h) do { _Pragma("unroll") for (int n = 0; n < 2; ++n) _Pragma("unroll") for (int k = 0; k < 2; ++k) dst[n][k] = *(const LAS bf16x8*)(lds + G8_SB(b, h) + boff + n * 2048 + k * 1024); } while (0)
#define G8_MMA(ai, bj, At, Bt) do { __builtin_amdgcn_s_setprio(1); _Pragma("unroll") for (int m = 0; m < 4; ++m) _Pragma("unroll") for (int n = 0; n < 2; ++n) _Pragma("unroll") for (int k = 0; k < 2; ++k) \
        acc[ai][bj][m][n] = __builtin_amdgcn_mfma_f32_16x16x32_bf16(Bt[n][k], At[m][k], acc[ai][bj][m][n], 0, 0, 0); __builtin_amdgcn_s_setprio(0); } while (0)
#define G8_WAIT_V(n) asm volatile("s_waitcnt vmcnt(" #n ")" ::: "memory")
#define G8_WAIT_L(n) asm volatile("s_waitcnt lgkmcnt(" #n ")" ::: "memory")
#define G8_BAR __builtin_amdgcn_s_barrier()
#define G8_SCHED __builtin_amdgcn_sched_barrier(0)
#define G8_ROWOFF(u_, h_, i_) ((unsigned)((unsigned)(((u_).rows[(h_) * HALF + sR[i_]] < 0 ? 0 : (u_).rows[(h_) * HALF + sR[i_]] >> 3)) * (unsigned)g.lda_b + (unsigned)(sC[i_] * 2)))
    Unit cur, nxt; int ui = 0;
    if (!S.next(0, cur)) return;
    Acc acc;
#pragma unroll
    for (int a = 0; a < 2; ++a)
#pragma unroll
        for (int b = 0; b < 2; ++b)
#pragma unroll
            for (int m = 0; m < 4; ++m)
#pragma unroll
                for (int n = 0; n < 2; ++n) acc[a][b][m][n] = (f32x4){0.f, 0.f, 0.f, 0.f};
    bf16x8 At[4][2], B0[2][2], B1[2][2];
    const char* cA = cur.A; const char* cB = cur.B;
    if (GATHER) {
#pragma unroll
        for (int h = 0; h < 2; ++h)
#pragma unroll
            for (int i = 0; i < 2; ++i) vA[h][i] = G8_ROWOFF(cur, h, i);
        asm volatile("" : "+v"(vA[0][0]), "+v"(vA[0][1]), "+v"(vA[1][0]), "+v"(vA[1][1]));
    }
    const long hA = GATHER ? 0 : 0;
    (void)hA;
    G8_STB(G8_SB(0, 0), cB); G8_STB(G8_SB(0, 1), cB + hB); G8_STAGE(G8_SA(0, 0), cA, vA[0][0], vA[0][1]); G8_STAGE(G8_SA(0, 1), cA, vA[1][0], vA[1][1]);
    if (wr == 1) G8_BAR;
    G8_WAIT_V(2); G8_BAR;
    G8_STB(G8_SB(1, 0), cB + kB); G8_STAGE(G8_SA(1, 0), cA + kA, vA[0][0], vA[0][1]); G8_STB(G8_SB(1, 1), cB + hB + kB);
    G8_WAIT_V(6); G8_BAR;
    for (;;) {
        const bool has_next = S.next(ui + 1, nxt);
        const char* nA = has_next ? nxt.A : cA; const char* nB = has_next ? nxt.B : cB;
        if (GATHER) {
            if (has_next) {
#pragma unroll
                for (int h = 0; h < 2; ++h)
#pragma unroll
                    for (int i = 0; i < 2; ++i) vN[h][i] = G8_ROWOFF(nxt, h, i);
            } else {
#pragma unroll
                for (int h = 0; h < 2; ++h)
#pragma unroll
                    for (int i = 0; i < 2; ++i) vN[h][i] = vA[h][i];
            }
            asm volatile("" : "+v"(vN[0][0]), "+v"(vN[0][1]), "+v"(vN[1][0]), "+v"(vN[1][1]));
        }
        const int nt = cur.nt;
        for (int t = 0; t < nt; t += 2) {
            const bool last = (t == nt - 2);
            const char* a1 = cA + (long)(t + 1) * kA;
            const char* a2 = last ? nA : cA + (long)(t + 2) * kA; const char* b2 = last ? nB : cB + (long)(t + 2) * kB;
            const char* a3 = a2 + kA; const char* b3 = b2 + kB;
            unsigned w00 = vA[0][0], w01 = vA[0][1], w10 = vA[1][0], w11 = vA[1][1];
            if (GATHER && last) { w00 = vN[0][0]; w01 = vN[0][1]; w10 = vN[1][0]; w11 = vN[1][1]; }
            G8_LDB(B0, 0, 0); G8_LDB(B1, 0, 1); G8_SCHED; G8_LDA(At, 0, 0); G8_STAGE(G8_SA(1, 1), a1, vA[1][0], vA[1][1]);
            G8_WAIT_V(8); G8_WAIT_L(0); G8_BAR; G8_MMA(0, 0, At, B0); G8_MMA(0, 1, At, B1); G8_BAR; G8_SCHED;
            G8_LDA(At, 0, 1); G8_STB(G8_SB(0, 0), b2); G8_STB(G8_SB(0, 1), b2 + hB); G8_STAGE(G8_SA(0, 0), a2, w00, w01);
            G8_WAIT_V(8); G8_WAIT_L(0); G8_BAR; G8_MMA(1, 0, At, B0); G8_MMA(1, 1, At, B1); G8_BAR; G8_SCHED;
            G8_LDB(B0, 1, 0); G8_LDB(B1, 1, 1); G8_SCHED; G8_LDA(At, 1, 0); G8_STAGE(G8_SA(0, 1), a2, w10, w11);
            G8_WAIT_V(8); G8_WAIT_L(0); G8_BAR; G8_MMA(0, 0, At, B0); G8_MMA(0, 1, At, B1); G8_BAR; G8_SCHED;
            G8_LDA(At, 1, 1); G8_STB(G8_SB(1, 0), b3); G8_STB(G8_SB(1, 1), b3 + hB); G8_STAGE(G8_SA(1, 0), a3, w00, w01);
            G8_WAIT_V(8); G8_WAIT_L(0); G8_BAR; G8_MMA(1, 0, At, B0); G8_MMA(1, 1, At, B1); G8_BAR; G8_SCHED;
        }
        if (wr == 0) G8_BAR;
        { int fr_ = fr, fq_ = fq; asm volatile("" : "+v"(fr_), "+v"(fq_)); E(acc, cur, wr, wc, fr_, fq_); }
        if (!has_next) break;
#pragma unroll
        for (int a = 0; a < 2; ++a)
#pragma unroll
            for (int b = 0; b < 2; ++b)
#pragma unroll
                for (int m = 0; m < 4; ++m)
#pragma unroll
                    for (int n = 0; n < 2; ++n) acc[a][b][m][n] = (f32x4){0.f, 0.f, 0.f, 0.f};
        cur = nxt; cA = nA; cB = nB; ++ui;
        if (GATHER) {
#pragma unroll
            for (int h = 0; h < 2; ++h)
#pragma unroll
                for (int i = 0; i < 2; ++i) vA[h][i] = vN[h][i];
        }
        if (wr == 1) G8_BAR;
    }
    G8_WAIT_V(0);
    G8_BAR;
#undef G8_SA
#undef G8_SB
#undef G8_STAGE
#undef G8_STB
#undef G8_LDA
#undef G8_LDB
#undef G8_MMA
#undef G8_WAIT_V
#undef G8_WAIT_L
#undef G8_BAR
#undef G8_SCHED
#undef G8_ROWOFF
}
}
namespace g8 {
__device__ __forceinline__ unsigned pk_bf16(float lo, float hi) { return (unsigned)f2bf(lo) | ((unsigned)f2bf(hi) << 16); }
__device__ __forceinline__ u32x4 pack8(const f32x4 a, const f32x4 b) { u32x4 w; w[0] = pk_bf16(a[0], a[1]); w[1] = pk_bf16(a[2], a[3]); w[2] = pk_bf16(b[0], b[1]); w[3] = pk_bf16(b[2], b[3]); return w; }
__device__ __forceinline__ int unit_index(int i, int nunits) {
    const int G = gridDim.x, c = blockIdx.x;
    if ((G & 7) != 0) { const long L = (long)i * G + c; return L < nunits ? (int)L : -1; }
    const int x = c & 7, r = c >> 3, GX = G >> 3;
    const int lo = (int)(((long)nunits * x) >> 3), hi = (int)(((long)nunits * (x + 1)) >> 3);
    const int L = lo + i * GX + r;
    return L < hi ? L : -1;
}
struct SchedReg {
    const char* A; const char* B; int lda_b, ldb_b, nM, nN, nt;
    __device__ __forceinline__ bool next(int i, Unit& u) const {
        const int L = unit_index(i, nM * nN); if (L < 0) return false;
        u.pm = L / nN; u.pn = L % nN; u.e = 0; u.nt = nt; u.rows = nullptr;
        u.A = A + (size_t)u.pm * 256 * lda_b; u.B = B + (size_t)u.pn * 256 * ldb_b; return true;
    }
};
struct SchedS5 {
    const char* A; const char* B; int lda_b, ldb_b, nN, nt; size_t a_gstride, b_gstride; int toep;
    __device__ __forceinline__ bool next(int i, Unit& u) const {
        const int L = unit_index(i, SG * 2 * nN); if (L < 0) return false;
        const int g = L / (2 * nN), r = L % (2 * nN);
        u.pm = r / nN; u.pn = r % nN; u.e = g; u.rows = nullptr;
        u.A = A + (size_t)g * a_gstride + (size_t)u.pm * 256 * lda_b;
        if (toep) { u.B = B + (size_t)g * 127 * 512 + 63 * 512 + (size_t)u.pn * 256 * 32 - 1536; u.nt = 4 * (u.pn + 1); }
        else { u.B = B + (size_t)g * b_gstride + (size_t)u.pn * 256 * ldb_b; u.nt = nt; }
        return true;
    }
};
struct SchedMoe {
    const char* A; const char* B; const int* eoff; const int* rowtok; int lda_b, npn, nt; size_t b_estride; int ldb_b; int gather;
    __device__ __forceinline__ bool next(int i, Unit& u) const {
        const int nrt = eoff[64] >> 8;
        const int L = unit_index(i, (nrt + T / 256) * npn); if (L < 0) return false;
        const int rt = L / npn; u.pn = L % npn; u.nt = nt;
        int e = 64;
        if (rt < nrt) { e = 0; while (e < 63 && eoff[e + 1] <= rt * 256) ++e; }
        u.e = e; u.pm = rt;
        u.B = B + (size_t)e * b_estride + (size_t)u.pn * 256 * ldb_b;
        if (gather) {
            u.A = A; u.rows = rowtok + ((e < 64) ? rt * 256 : SH_ROW0 + (rt - nrt) * 256);
        } else {
            const int row0 = (e < 64) ? rt * 256 : SH_ROW0 + (rt - nrt) * 256;
            u.A = A + (size_t)row0 * lda_b; u.rows = nullptr;
        }
        return true;
    }
};

#define EPI_ROWS_BEGIN _Pragma("unroll") for (int ai = 0; ai < 2; ++ai) _Pragma("unroll") for (int m = 0; m < 4; ++m) { const int rloc = ai * 128 + wr * 64 + m * 16 + fr;
#define EPI_ROWS_END }

struct EpiWin {
    bf16_t* cq; bf16_t* ckv; bf16_t* u; bf16_t* Kc; const float2* rope; float* rsqp; float* rskvp;
    __device__ __forceinline__ void operator()(const Acc& acc, const Unit& un, int wr, int wc, int fr, int fq) const {
        const int pn = un.pn;
        if (pn == 0) {
            EPI_ROWS_BEGIN
                const int t = un.pm * 256 + rloc;
                float ss = 0.f;
#pragma unroll
                for (int bj = 0; bj < 2; ++bj) { const f32x4 v0 = acc[ai][bj][m][0], v1 = acc[ai][bj][m][1];
                    *(u32x4*)(cq + (size_t)t * 256 + bj * 128 + wc * 32 + fq * 8) = pack8(v0, v1);
                    ss += v0[0] * v0[0] + v0[1] * v0[1] + v0[2] * v0[2] + v0[3] * v0[3] + v1[0] * v1[0] + v1[1] * v1[1] + v1[2] * v1[2] + v1[3] * v1[3]; }
                ss += __shfl_xor(ss, 16); ss += __shfl_xor(ss, 32);
                if (fq == 0) rsqp[(size_t)t * 4 + wc] = ss;
            EPI_ROWS_END
        } else if (pn <= 2) {
            EPI_ROWS_BEGIN
                const int t = un.pm * 256 + rloc;
                const int b = t >> 11, s = t & 2047, j = s >> 6, sl = s & 63;
#pragma unroll
                for (int bj = 0; bj < 2; ++bj) { const int ch0 = (pn - 1) * 256 + bj * 128 + wc * 32 + fq * 8, gi = ch0 >> 4, c0 = ch0 & 15;
                    *(u32x4*)(u + ((size_t)gi * 512 + b * 32 + j) * 1024 + sl * 16 + c0) = pack8(acc[ai][bj][m][0], acc[ai][bj][m][1]); }
            EPI_ROWS_END
        } else {
            EPI_ROWS_BEGIN
                const int t = un.pm * 256 + rloc;
                const f32x4 v0 = acc[ai][0][m][0], v1 = acc[ai][0][m][1];
                *(u32x4*)(ckv + (size_t)t * 256 + wc * 32 + fq * 8) = pack8(v0, v1);
                float ss = v0[0] * v0[0] + v0[1] * v0[1] + v0[2] * v0[2] + v0[3] * v0[3] + v1[0] * v1[0] + v1[1] * v1[1] + v1[2] * v1[2] + v1[3] * v1[3];
                ss += __shfl_xor(ss, 16); ss += __shfl_xor(ss, 32);
                if (fq == 0) rskvp[(size_t)t * 4 + wc] = ss;
                *(u32x4*)(ckv + (size_t)t * 256 + 128 + wc * 32 + fq * 8) = (u32x4){0u, 0u, 0u, 0u};
            EPI_ROWS_END
            if (wc == 0) {
                EPI_ROWS_BEGIN
                    const int t = un.pm * 256 + rloc;
                    const f32x4 x1 = acc[ai][1][m][0], x2 = acc[ai][1][m][1];
                    const f32x4 ca = *(const f32x4*)(rope + (size_t)t * 16 + fq * 4), cb = *(const f32x4*)(rope + (size_t)t * 16 + fq * 4 + 2);
                    const float o10 = x1[0] * ca[0] - x2[0] * ca[1], o11 = x1[1] * ca[2] - x2[1] * ca[3], o12 = x1[2] * cb[0] - x2[2] * cb[1], o13 = x1[3] * cb[2] - x2[3] * cb[3];
                    const float o20 = x2[0] * ca[0] + x1[0] * ca[1], o21 = x2[1] * ca[2] + x1[1] * ca[3], o22 = x2[2] * cb[0] + x1[2] * cb[1], o23 = x2[3] * cb[2] + x1[3] * cb[3];
                    uint2 w1, w2; w1.x = pk_bf16(o10, o11); w1.y = pk_bf16(o12, o13); w2.x = pk_bf16(o20, o21); w2.y = pk_bf16(o22, o23);
                    const int b = t >> 11, s = t & 2047;
                    bf16_t* kp = Kc + (((size_t)b * NH) * SEQ + s) * QKD + 64 + fq * 4;
#pragma unroll 1
                    for (int h = 0; h < NH; ++h) { *(uint2*)kp = w1; *(uint2*)(kp + 16) = w2; kp += (size_t)SEQ * QKD; }
                EPI_ROWS_END
            }
        }
    }
};
struct EpiQ {
    bf16_t* Q; const float* rsqp; const float2* rope;
    __device__ __forceinline__ void operator()(const Acc& acc, const Unit& un, int wr, int wc, int fr, int fq) const {
        EPI_ROWS_BEGIN
            const int t = un.pm * 256 + rloc, b = t >> 11, s = t & 2047;
            const f32x4 pp = *(const f32x4*)(rsqp + (size_t)t * 4);
            const float rs = rsqrtf((pp[0] + pp[1] + pp[2] + pp[3]) * (1.0f / 256) + EPS);
            if (un.pn < 2) {
#pragma unroll
                for (int bj = 0; bj < 2; ++bj) { const int col = un.pn * 256 + bj * 128 + wc * 32 + fq * 8;
                    *(u32x4*)(Q + (((size_t)b * NH + (col >> 6)) * SEQ + s) * QKD + (col & 63)) = pack8(acc[ai][bj][m][0] * rs, acc[ai][bj][m][1] * rs); }
            } else {
                const f32x4 ca = *(const f32x4*)(rope + (size_t)t * 16 + fq * 4), cb = *(const f32x4*)(rope + (size_t)t * 16 + fq * 4 + 2);
#pragma unroll
                for (int bj = 0; bj < 2; ++bj) { const f32x4 x1 = acc[ai][bj][m][0] * rs, x2 = acc[ai][bj][m][1] * rs;
                    const float o10 = x1[0] * ca[0] - x2[0] * ca[1], o11 = x1[1] * ca[2] - x2[1] * ca[3], o12 = x1[2] * cb[0] - x2[2] * cb[1], o13 = x1[3] * cb[2] - x2[3] * cb[3];
                    const float o20 = x2[0] * ca[0] + x1[0] * ca[1], o21 = x2[1] * ca[2] + x1[1] * ca[3], o22 = x2[2] * cb[0] + x1[2] * cb[1], o23 = x2[3] * cb[2] + x1[3] * cb[3];
                    uint2 w1, w2; w1.x = pk_bf16(o10, o11); w1.y = pk_bf16(o12, o13); w2.x = pk_bf16(o20, o21); w2.y = pk_bf16(o22, o23);
                    bf16_t* qp = Q + (((size_t)b * NH + (bj * 4 + wc)) * SEQ + s) * QKD + 64 + fq * 4; *(uint2*)qp = w1; *(uint2*)(qp + 16) = w2; }
            }
        EPI_ROWS_END
    }
};
struct EpiKV {
    bf16_t* Kc; bf16_t* V; const float* rskvp;
    __device__ __forceinline__ void operator()(const Acc& acc, const Unit& un, int wr, int wc, int fr, int fq) const {
        EPI_ROWS_BEGIN
            const int t = un.pm * 256 + rloc, b = t >> 11, s = t & 2047;
            const f32x4 pp = *(const f32x4*)(rskvp + (size_t)t * 4);
            const float rs = rsqrtf((pp[0] + pp[1] + pp[2] + pp[3]) * (1.0f / 128) + EPS);
#pragma unroll
            for (int bj = 0; bj < 2; ++bj) { const int col = (un.pn & 1) * 256 + bj * 128 + wc * 32 + fq * 8;
                const u32x4 w = pack8(acc[ai][bj][m][0] * rs, acc[ai][bj][m][1] * rs);
                if (un.pn < 2) *(u32x4*)(Kc + (((size_t)b * NH + (col >> 6)) * SEQ + s) * QKD + (col & 63)) = w;
                else *(u32x4*)(V + (((size_t)b * NH + (col >> 6)) * SEQ + s) * VD + (col & 63)) = w; }
        EPI_ROWS_END
    }
};
struct EpiS5b {
    float* xloc;
    __device__ __forceinline__ void operator()(const Acc& acc, const Unit& un, int wr, int wc, int fr, int fq) const {
        EPI_ROWS_BEGIN
            float* o = xloc + ((size_t)un.e * 512 + un.pm * 256 + rloc) * 128 + wc * 32 + fq * 8;
            *(f32x4*)o = acc[ai][0][m][0]; *(f32x4*)(o + 4) = acc[ai][0][m][1];
        EPI_ROWS_END
    }
};
template <int MODE> struct EpiS5y {
    bf16_t* dst; const bf16_t* yintra;
    __device__ __forceinline__ void operator()(const Acc& acc, const Unit& un, int wr, int wc, int fr, int fq) const {
        EPI_ROWS_BEGIN
            const int row = un.pm * 256 + rloc, b = row >> 5, j = row & 31;
#pragma unroll
            for (int bj = 0; bj < 2; ++bj) { const int n = un.pn * 256 + bj * 128 + wc * 32 + fq * 8, tt = n >> 4, c0 = n & 15;
                const size_t o = ((size_t)b * SEQ + j * CH + tt) * SSMW + un.e * SC + c0;
                f32x4 v0 = acc[ai][bj][m][0], v1 = acc[ai][bj][m][1];
                if (MODE == 1) { const bf16x8 yi = *(const bf16x8*)(yintra + o);
#pragma unroll
                    for (int q = 0; q < 4; ++q) { v0[q] = gelu_tanh(v0[q] + bf2f((bf16_t)yi[q])); v1[q] = gelu_tanh(v1[q] + bf2f((bf16_t)yi[4 + q])); } }
                *(u32x4*)(dst + o) = pack8(v0, v1); }
        EPI_ROWS_END
    }
};
struct EpiGlu {
    const bf16_t* Y; const float* bglu; bf16_t* AS;
    __device__ __forceinline__ void operator()(const Acc& acc, const Unit& un, int wr, int wc, int fr, int fq) const {
        EPI_ROWS_BEGIN
            const int t = un.pm * 256 + rloc;
#pragma unroll
            for (int bj = 0; bj < 2; ++bj) { const int col = un.pn * 256 + bj * 128 + wc * 32 + fq * 8;
                const bf16x8 yv = *(const bf16x8*)(Y + (size_t)t * 512 + col);
                const f32x4 b0 = *(const f32x4*)(bglu + col), b1 = *(const f32x4*)(bglu + col + 4);
                f32x4 v0 = acc[ai][bj][m][0], v1 = acc[ai][bj][m][1];
#pragma unroll
                for (int q = 0; q < 4; ++q) { v0[q] = bf2f((bf16_t)yv[q]) * sigmoidf_(v0[q] + b0[q]); v1[q] = bf2f((bf16_t)yv[4 + q]) * sigmoidf_(v1[q] + b1[q]); }
                *(u32x4*)(AS + (size_t)t * 1024 + 512 + col) = pack8(v0, v1); }
        EPI_ROWS_END
    }
};
struct EpiWo {
    const float* x; const float* xstat; const float* g; const float* bt; float* pre1;
    __device__ __forceinline__ void operator()(const Acc& acc, const Unit& un, int wr, int wc, int fr, int fq) const {
        EPI_ROWS_BEGIN
            const int t = un.pm * 256 + rloc;
            const float mu = xstat[2 * t], rstd = xstat[2 * t + 1];
#pragma unroll
            for (int bj = 0; bj < 2; ++bj) { const int col = un.pn * 256 + bj * 128 + wc * 32 + fq * 8;
#pragma unroll
                for (int n = 0; n < 2; ++n) { const f32x4 xv = *(const f32x4*)(x + (size_t)t * D + col + 4 * n), gg = *(const f32x4*)(g + col + 4 * n), bb = *(const f32x4*)(bt + col + 4 * n);
                    f32x4 o;
#pragma unroll
                    for (int q = 0; q < 4; ++q) o[q] = acc[ai][bj][m][n][q] + ALPHA * ((xv[q] - mu) * rstd * gg[q] + bb[q]);
                    *(f32x4*)(pre1 + (size_t)t * D + col + 4 * n) = o; } }
        EPI_ROWS_END
    }
};
struct EpiGU {
    bf16_t* H; const float* roww; const int* eoff;
    __device__ __forceinline__ void operator()(const Acc& acc, const Unit& un, int wr, int wc, int fr, int fq) const {
        const int nrt = eoff[64] >> 8;
        const bool shared = un.e == 64;
        const int row0 = shared ? SH_ROW0 + (un.pm - nrt) * 256 : un.pm * 256;
        EPI_ROWS_BEGIN
            const int row = row0 + rloc;
            const float w = shared ? 1.0f : roww[row];
            const f32x4 g0 = acc[ai][0][m][0], g1 = acc[ai][0][m][1], u0 = acc[ai][1][m][0], u1 = acc[ai][1][m][1];
            f32x4 h0, h1;
#pragma unroll
            for (int q = 0; q < 4; ++q) { h0[q] = g0[q] * sigmoidf_(g0[q]) * u0[q] * w; h1[q] = g1[q] * sigmoidf_(g1[q]) * u1[q] * w; }
            *(u32x4*)(H + (size_t)row * FF + un.pn * 128 + wc * 32 + fq * 8) = pack8(h0, h1);
        EPI_ROWS_END
    }
};
struct EpiDown {
    unsigned char* yslot; float* out; const bf16_t* x1; const int* rowtok; const int* eoff;
    __device__ __forceinline__ void operator()(const Acc& acc, const Unit& un, int wr, int wc, int fr, int fq) const {
        const int nrt = eoff[64] >> 8;
        if (un.e < 64) {
            EPI_ROWS_BEGIN
                const int slot = rowtok[un.pm * 256 + rloc];
                if (slot >= 0) {
#pragma unroll
                    for (int bj = 0; bj < 2; ++bj) { const int col = un.pn * 256 + bj * 128 + wc * 32 + fq * 8;
                        const f32x4 v0 = acc[ai][bj][m][0] * SLOT_SCALE, v1 = acc[ai][bj][m][1] * SLOT_SCALE;
                        int p0 = __builtin_amdgcn_cvt_pk_fp8_f32(v0[0], v0[1], 0, false); p0 = __builtin_amdgcn_cvt_pk_fp8_f32(v0[2], v0[3], p0, true);
                        int p1 = __builtin_amdgcn_cvt_pk_fp8_f32(v1[0], v1[1], 0, false); p1 = __builtin_amdgcn_cvt_pk_fp8_f32(v1[2], v1[3], p1, true);
                        uint2 w; w.x = (unsigned)p0; w.y = (unsigned)p1;
                        *(uint2*)(yslot + (size_t)slot * D + col) = w; }
                }
            EPI_ROWS_END
        } else {
            EPI_ROWS_BEGIN
                const int t = (un.pm - nrt) * 256 + rloc;
#pragma unroll
                for (int bj = 0; bj < 2; ++bj) { const int col = un.pn * 256 + bj * 128 + wc * 32 + fq * 8;
                    const bf16x8 xv = *(const bf16x8*)(x1 + (size_t)t * D + col);
                    f32x4 o0, o1;
#pragma unroll
                    for (int q = 0; q < 4; ++q) { o0[q] = acc[ai][bj][m][0][q] + ALPHA * bf2f((bf16_t)xv[q]); o1[q] = acc[ai][bj][m][1][q] + ALPHA * bf2f((bf16_t)xv[4 + q]); }
                    *(f32x4*)(out + (size_t)t * D + col) = o0; *(f32x4*)(out + (size_t)t * D + col + 4) = o1; }
            EPI_ROWS_END
        }
    }
};
}
__device__ __forceinline__ void fp_gemm_win(const Ptrs& P, LAS unsigned char* lds) {
    g8::Geo g{2048, 2048, 128, 128, 0};
    g8::SchedReg S{(const char*)WSP(bf16_t, WS_XN), (const char*)WSP(bf16_t, WS_WIN), 2048, 2048, T / 256, 4, 16};
    g8::EpiWin E{WSP(bf16_t, WS_CQ), WSP(bf16_t, WS_CKV), WSP(bf16_t, WS_U), WSP(bf16_t, WS_K), WSP(float2, WS_ROPE), WSP(float, WS_RSQ), WSP(float, WS_RSKV)};
    g8::gemm_body<g8::EpiWin, g8::SchedReg, false>(lds, g, S, E);
}
__device__ __forceinline__ void fp_gemm_q(const Ptrs& P, LAS unsigned char* lds) {
    g8::Geo g{512, 512, 128, 128, 0};
    g8::SchedReg S{(const char*)WSP(bf16_t, WS_CQ), (const char*)WSP(bf16_t, WS_WUQ), 512, 512, T / 256, 3, 4};
    g8::EpiQ E{WSP(bf16_t, WS_Q), WSP(float, WS_RSQ), WSP(float2, WS_ROPE)};
    g8::gemm_body<g8::EpiQ, g8::SchedReg, false>(lds, g, S, E);
}
__device__ __forceinline__ void fp_gemm_kv(const Ptrs& P, LAS unsigned char* lds) {
    g8::Geo g{512, 512, 128, 128, 0};
    g8::SchedReg S{(const char*)WSP(bf16_t, WS_CKV), (const char*)WSP(bf16_t, WS_WUKV), 512, 512, T / 256, 4, 4};
    g8::EpiKV E{WSP(bf16_t, WS_K), WSP(bf16_t, WS_V), WSP(float, WS_RSKV)};
    g8::gemm_body<g8::EpiKV, g8::SchedReg, false>(lds, g, S, E);
}
__device__ __forceinline__ void fp_gemm_s5b(const Ptrs& P, LAS unsigned char* lds) {
    g8::Geo g{2048, 2048, 128, 128, 0};
    g8::SchedS5 S{(const char*)WSP(bf16_t, WS_U), (const char*)WSP(bf16_t, WS_BLOC), 2048, 2048, 1, 16, (size_t)512 * 2048, (size_t)256 * 2048, 0};
    g8::EpiS5b E{WSP(float, WS_XLOC)};
    g8::gemm_body<g8::EpiS5b, g8::SchedS5, false>(lds, g, S, E);
}
__device__ __forceinline__ void fp_gemm_s5a(const Ptrs& P, LAS unsigned char* lds) {
    g8::Geo g{2048, 32, 128, -2048, 1};
    g8::SchedS5 S{(const char*)WSP(bf16_t, WS_U), (const char*)WSP(bf16_t, WS_KTAB), 2048, 32, 4, 16, (size_t)512 * 2048, 0, 1};
    g8::EpiS5y<0> E{WSP(bf16_t, WS_YINTRA), nullptr};
    g8::gemm_body<g8::EpiS5y<0>, g8::SchedS5, false>(lds, g, S, E);
}
__device__ __forceinline__ void fp_gemm_s5d(const Ptrs& P, LAS unsigned char* lds) {
    g8::Geo g{512, 512, 128, 128, 0};
    g8::SchedS5 S{(const char*)WSP(bf16_t, WS_XPREV), (const char*)WSP(bf16_t, WS_CLAM), 512, 512, 4, 4, (size_t)512 * 512, (size_t)1024 * 512, 0};
    g8::EpiS5y<1> E{WSP(bf16_t, WS_Y), WSP(bf16_t, WS_YINTRA)};
    g8::gemm_body<g8::EpiS5y<1>, g8::SchedS5, false>(lds, g, S, E);
}
__device__ __forceinline__ void fp_gemm_glu(const Ptrs& P, LAS unsigned char* lds) {
    g8::Geo g{1024, 1024, 128, 128, 0};
    g8::SchedReg S{(const char*)WSP(bf16_t, WS_Y), (const char*)WSP(bf16_t, WS_WGLU), 1024, 1024, T / 256, 2, 8};
    g8::EpiGlu E{WSP(bf16_t, WS_Y), P.b_glu, WSP(bf16_t, WS_AS)};
    g8::gemm_body<g8::EpiGlu, g8::SchedReg, false>(lds, g, S, E);
}
__device__ __forceinline__ void fp_gemm_wo(const Ptrs& P, LAS unsigned char* lds) {
    g8::Geo g{2048, 2048, 128, 128, 0};
    g8::SchedReg S{(const char*)WSP(bf16_t, WS_AS), (const char*)WSP(bf16_t, WS_WO), 2048, 2048, T / 256, 4, 16};
    g8::EpiWo E{P.x, WSP(float, WS_XSTAT), P.ln_in_g, P.ln_in_b, P.out};
    g8::gemm_body<g8::EpiWo, g8::SchedReg, false>(lds, g, S, E);
}
__device__ __forceinline__ void fp_gemm_gu(const Ptrs& P, LAS unsigned char* lds) {
    g8::Geo g{2048, 2048, 128, 128, 0};
    g8::SchedMoe S{(const char*)WSP(bf16_t, WS_X1), (const char*)WSP(bf16_t, WS_WGU), WSP(int, WS_EOFF), WSP(int, WS_ROWTOK), 2048, 2, 16, (size_t)512 * 2048, 2048, 1};
    g8::EpiGU E{WSP(bf16_t, WS_H), WSP(float, WS_ROWW), WSP(int, WS_EOFF)};
    g8::gemm_body<g8::EpiGU, g8::SchedMoe, true>(lds, g, S, E);
}
__device__ __forceinline__ void fp_gemm_down(const Ptrs& P, LAS unsigned char* lds) {
    g8::Geo g{512, 512, 128, 128, 0};
    g8::SchedMoe S{(const char*)WSP(bf16_t, WS_H), (const char*)WSP(bf16_t, WS_WD), WSP(int, WS_EOFF), WSP(int, WS_ROWTOK), 512, 4, 4, (size_t)1024 * 512, 512, 0};
    g8::EpiDown E{WSP(unsigned char, WS_YSLOT), P.out, WSP(bf16_t, WS_X1), WSP(int, WS_ROWTOK), WSP(int, WS_EOFF)};
    g8::gemm_body<g8::EpiDown, g8::SchedMoe, false>(lds, g, S, E);
}
__global__ void __launch_bounds__(NTHR, 2) mega(Args a) {
    extern __shared__ __attribute__((aligned(16))) unsigned char lds_raw[];
    LAS unsigned char* lds = (LAS unsigned char*)lds_raw;
    Ptrs P;
    P.x = (const float*)a.in[0]; P.positions = (const int*)a.in[1]; P.ln_in_g = (const float*)a.in[2]; P.ln_in_b = (const float*)a.in[3];
    P.w_in = (const float*)a.in[4]; P.q_norm_g = (const float*)a.in[5]; P.kv_norm_g = (const float*)a.in[6]; P.w_uq = (const float*)a.in[7]; P.w_ukv = (const float*)a.in[8];
    P.lambda_re = (const float*)a.in[9]; P.lambda_im = (const float*)a.in[10]; P.log_step = (const float*)a.in[11]; P.b_re = (const float*)a.in[12]; P.b_im = (const float*)a.in[13];
    P.c_re = (const float*)a.in[14]; P.c_im = (const float*)a.in[15]; P.d_skip = (const float*)a.in[16]; P.w_glu = (const float*)a.in[17]; P.b_glu = (const float*)a.in[18];
    P.attn_out_g = (const float*)a.in[19]; P.ssm_out_g = (const float*)a.in[20]; P.w_o = (const float*)a.in[21]; P.ln1_g = (const float*)a.in[22]; P.ln1_b = (const float*)a.in[23];
    P.w_router = (const float*)a.in[24]; P.router_bias = (const float*)a.in[25]; P.w_gate = (const float*)a.in[26]; P.w_up = (const float*)a.in[27]; P.w_down = (const float*)a.in[28];
    P.ws_gate = (const float*)a.in[29]; P.ws_up = (const float*)a.in[30]; P.ws_down = (const float*)a.in[31]; P.ln2_g = (const float*)a.in[32]; P.ln2_b = (const float*)a.in[33];
    P.out = a.out; P.ws = a.ws;
    const int bid = blockIdx.x, nb = gridDim.x;
    volatile LAS unsigned* misc = (volatile LAS unsigned*)(lds + LDS_MISC);
    if (threadIdx.x < 64) misc[threadIdx.x] = 0u;
    __syncthreads();
    XcdBarrier bar = xcd_barrier_post((unsigned*)(P.ws + WS_CTL) + 4096, misc);
#define GRID_BAR() xcd_barrier(bar)

    ph_ln_in(P, bid, nb); ph_wprep(P, lds, bid, nb); ph_s5tab1(P, bid, nb); ph_ropetab(P, bid, nb);
    GRID_BAR();
    ph_s5tab2(P, bid, nb);
#if FAST_WIN
    fp_gemm_win(P, lds);
    GRID_BAR();
#else
    ph_gemm_win(P, bid, nb);
    GRID_BAR();
    ph_rstat(P, bid, nb);
    GRID_BAR();
#endif
#if FAST_QKV
    fp_gemm_q(P, lds); fp_gemm_kv(P, lds);
#else
    ph_gemm_q(P, bid, nb); ph_gemm_kv(P, bid, nb);
#endif
#if FAST_S5
    fp_gemm_s5b(P, lds); fp_gemm_s5a(P, lds);
#else
    ph_gemm_s5b(P, bid, nb); ph_gemm_s5a(P, bid, nb);
#endif
    GRID_BAR();
#if !FAST_QKV || !FAST_WIN
    ph_rope_apply(P, bid, nb);
#endif
    ph_s5scan(P, bid, nb);
#if !FAST_QKV || !FAST_WIN
    GRID_BAR();
#endif
    ph_attn_simple(P, lds, bid, nb);
    GRID_BAR();
#if FAST_S5
    fp_gemm_s5d(P, lds);
#else
    ph_gemm_s5d(P, bid, nb);
#endif
    GRID_BAR();
#if FAST_GLU
    fp_gemm_glu(P, lds);
#else
    ph_gemm_glu(P, bid, nb);
#endif
    GRID_BAR();
    ph_asnorm(P, bid, nb);
    GRID_BAR();
#if FAST_WO
    fp_gemm_wo(P, lds);
#else
    ph_gemm_wo(P, bid, nb);
#endif
    GRID_BAR();
    ph_ln1(P, bid, nb);
    GRID_BAR();
    ph_router(P, bid, nb);
    GRID_BAR();
    ph_topk(P, bid, nb);
    GRID_BAR();
    ph_cnt(P, bid, nb);
    GRID_BAR();
    ph_off(P, lds, bid);
    GRID_BAR();
    ph_lists(P, bid, nb);
    GRID_BAR();
#if FAST_MOE
    fp_gemm_gu(P, lds);
    GRID_BAR();
    fp_gemm_down(P, lds);
#else
    ph_gemm_gu(P, bid, nb);
    GRID_BAR();
    ph_gemm_down(P, bid, nb);
#endif
    GRID_BAR();
    ph_combine(P, bid, nb);
}

extern "C" void kernel_launch(void* const* d_in, const int* in_sizes, int n_in, void* d_out, int out_size, void* d_ws, size_t ws_size, hipStream_t stream) {
    (void)in_sizes; (void)out_size;
    if (ws_size < WS_NEED || n_in != 34) return;
    static int grid = 0;
    if (grid == 0) {
        int dev = 0, cus = 0;
        if (hipGetDevice(&dev) != hipSuccess || hipDeviceGetAttribute(&cus, hipDeviceAttributeMultiprocessorCount, dev) != hipSuccess) { grid = -1; return; }
        if (hipFuncSetAttribute((const void*)mega, hipFuncAttributeMaxDynamicSharedMemorySize, LDS_BYTES) != hipSuccess) { grid = -1; return; }
        int per_cu = 0;
        if (hipOccupancyMaxActiveBlocksPerMultiprocessor(&per_cu, (const void*)mega, NTHR, LDS_BYTES) != hipSuccess || per_cu < 1) { (void)hipGetLastError(); }
        grid = cus;
    }
    if (grid < 0) return;
    (void)hipMemsetAsync((char*)d_ws + WS_CTL, 0, 1 << 20, stream);
    Args a; memset(&a, 0, sizeof(a));
    for (int i = 0; i < 34; ++i) a.in[i] = d_in[i];
    a.out = (float*)d_out; a.ws = (unsigned char*)d_ws;
    hipLaunchKernelGGL(mega, dim3(grid), dim3(NTHR), LDS_BYTES, stream, a);
}
```

```cpp
#include <hip/hip_runtime.h>
#include <stdint.h>
#include <string.h>

typedef unsigned short bf16_t;
typedef short bf16x8 __attribute__((ext_vector_type(8)));
typedef float f32x16 __attribute__((ext_vector_type(16)));
typedef float f32x4 __attribute__((ext_vector_type(4)));
typedef unsigned u32x4 __attribute__((ext_vector_type(4)));

#ifndef FAST_WIN
#define FAST_WIN 1
#endif
#ifndef FAST_QKV
#define FAST_QKV 1
#endif
#ifndef FAST_S5
#define FAST_S5 1
#endif
#ifndef FAST_GLU
#define FAST_GLU 1
#endif
#ifndef FAST_WO
#define FAST_WO 1
#endif
#ifndef FAST_ATTN
#define FAST_ATTN 1
#endif
#ifndef FAST_MOE
#define FAST_MOE 1
#endif
constexpr int T = 32768, D = 1024, SEQ = 2048, NB = 16;
constexpr int NH = 8, QKD = 96, VD = 64;
constexpr int QRANK = 256, KVRANK = 128, ROPE = 32;
constexpr int SSMW = 512, SG = 32, SC = 16, SP = 64, CH = 64, NCH = SEQ / CH;
constexpr int NE = 64, TOPK = 8, FF = 256;
constexpr float ALPHA = 1.189207115002721f;
constexpr float EPS = 1e-5f;
constexpr float QSCALE = 0.10206207261596577f * 1.4426950408889634f;
constexpr float SLOT_SCALE = 64.0f;
constexpr int RROUT = 278528;
constexpr int SH_ROW0 = RROUT;
constexpr int RTOT = RROUT + T;

constexpr size_t MiB = 1ull << 20;
constexpr size_t WS_CTL = 0;
constexpr size_t WS_TOPI = 1 * MiB, WS_TOPW = 2 * MiB, WS_ROWTOK = 3 * MiB, WS_ROWW = 4 * MiB + MiB / 2;
constexpr size_t WS_CNT = 6 * MiB, WS_TOFF = 6 * MiB + 65536, WS_EOFF = 6 * MiB + 131072, WS_ECNT = 6 * MiB + 131072 + 1024;
constexpr size_t WS_WD = 7 * MiB;
constexpr size_t WS_X1 = 40 * MiB;
constexpr size_t WS_XN = WS_X1, WS_AS = WS_X1;
constexpr size_t WS_H = 104 * MiB;
constexpr size_t WS_CQ = 104 * MiB, WS_CKV = 120 * MiB, WS_U = 136 * MiB, WS_YINTRA = 168 * MiB, WS_Y = 200 * MiB;
constexpr size_t WS_QRRAW = 200 * MiB;
constexpr size_t WS_XLOC = 232 * MiB, WS_XPREV = 240 * MiB, WS_LOGITS = 248 * MiB, WS_KRRAW = 248 * MiB;
constexpr size_t WS_X1LO = 104 * MiB;
constexpr size_t WS_YSLOT = 256 * MiB;
constexpr size_t WS_WGU = 256 * MiB;
constexpr size_t WS_WIN = 321 * MiB, WS_WO = 323 * MiB, WS_WUQ = 325 * MiB, WS_WUKV = 325 * MiB + MiB / 2, WS_WGLU = 326 * MiB;
constexpr size_t WS_BLOC = 327 * MiB, WS_CLAM = 343 * MiB, WS_KTAB = 359 * MiB, WS_LAMPOW = 361 * MiB, WS_BBAR = 363 * MiB;
constexpr size_t WS_ROPE = 364 * MiB, WS_XSTAT = 368 * MiB, WS_RSQ = 368 * MiB + MiB / 2, WS_RSKV = 369 * MiB;
constexpr size_t WS_Q = 370 * MiB, WS_K = 418 * MiB, WS_V = 466 * MiB;
constexpr size_t WS_NEED = 512 * MiB;

__device__ __forceinline__ bf16_t f2bf(float f) { unsigned u = __float_as_uint(f); u += 0x7fffu + ((u >> 16) & 1u); return (bf16_t)(u >> 16); }
__device__ __forceinline__ float bf2f(bf16_t b) { return __uint_as_float(((unsigned)b) << 16); }
__device__ __forceinline__ int crow(int i, int h) { return (i & 3) + 8 * (i >> 2) + 4 * h; }
__device__ __forceinline__ float wave_sum(float v) {
#pragma unroll
    for (int o = 32; o > 0; o >>= 1) v += __shfl_xor(v, o);
    return v;
}
__device__ __forceinline__ float wave_max(float v) {
#pragma unroll
    for (int o = 32; o > 0; o >>= 1) v = fmaxf(v, __shfl_xor(v, o));
    return v;
}
__device__ __forceinline__ float sigmoidf_(float z) { return 1.0f / (1.0f + __expf(-z)); }
__device__ __forceinline__ float gelu_tanh(float y) {
    const float z = 0.7978845608028654f * (y + 0.044715f * y * y * y);
    const float th = 1.0f - 2.0f / (1.0f + __expf(2.0f * z));
    return 0.5f * y * (1.0f + th);
}
__host__ __device__ __forceinline__ int ropeperm(int q) { return 16 * ((q >> 2) & 1) + 4 * (q >> 3) + (q & 3); }
__host__ __device__ __forceinline__ int ropepos(int j) { const int n = j >> 4, r = j & 15; return 8 * (r >> 2) + 4 * n + (r & 3); }

__device__ __forceinline__ void cexp_d(double re, double im, double& ore, double& oim) {
    const double s = 1.0 / 1048576.0;
    const double a = re * s, b = im * s;
    double tr = 1.0, ti = 0.0, sr = 1.0, si = 0.0;
#pragma unroll
    for (int n = 1; n <= 8; ++n) {
        const double nr = (tr * a - ti * b) / n, ni = (tr * b + ti * a) / n;
        tr = nr; ti = ni; sr += tr; si += ti;
    }
#pragma unroll
    for (int i = 0; i < 20; ++i) { const double nr = sr * sr - si * si, ni = 2.0 * sr * si; sr = nr; si = ni; }
    ore = sr; oim = si;
}

__device__ __forceinline__ int opaque_tid() { int t = threadIdx.x; asm volatile("" : "+v"(t)); return t; }
template <bool DUAL, class AF, class BF, class EPI>
__device__ __forceinline__ void sg_tile(int m0, int n0, int K, AF arow, BF bptr, EPI epi) {
    const int tidx = opaque_tid();
    const int lane = tidx & 63, r = lane & 31, h = lane >> 5;
    f32x16 acc, acc2;
#pragma unroll
    for (int i = 0; i < 16; ++i) { acc[i] = 0.f; acc2[i] = 0.f; }
    const bf16_t* ap = arow(m0 + r);
    for (int k0 = 0; k0 < K; k0 += 16) {
        const bf16x8 a = *(const bf16x8*)(ap + k0 + 8 * h);
        const bf16x8 b = *(const bf16x8*)(bptr(n0 + r, k0 + 8 * h, 0));
        acc = __builtin_amdgcn_mfma_f32_32x32x16_bf16(a, b, acc, 0, 0, 0);
        if (DUAL) {
            const bf16x8 b2 = *(const bf16x8*)(bptr(n0 + r, k0 + 8 * h, 1));
            acc2 = __builtin_amdgcn_mfma_f32_32x32x16_bf16(a, b2, acc2, 0, 0, 0);
        }
    }
#pragma unroll
    for (int i = 0; i < 16; ++i) epi(m0 + crow(i, h), n0 + r, acc[i], acc2[i]);
}

#define LAS __attribute__((address_space(3)))
#define XB_TMO      128
#define XB_XCNT(j)  (256  + 64 * (j))
#define XB_XSUB(j)  (1280 + 64 * (j))
#define XB_XGEN(j)  (2304 + 64 * (j))
#define XB_TOP      3328
#define XB_TOPGEN   3392
#define XCD_BAR_WORDS 3456
#define XB_SPIN_CAP (1u << 18)
__device__ __forceinline__ unsigned xb_ld(unsigned* p)              { return __hip_atomic_load(p, __ATOMIC_RELAXED, __HIP_MEMORY_SCOPE_AGENT); }
__device__ __forceinline__ unsigned xb_add(unsigned* p, unsigned v) { return __hip_atomic_fetch_add(p, v, __ATOMIC_RELAXED, __HIP_MEMORY_SCOPE_AGENT); }
__device__ __forceinline__ unsigned xb_xcc_id() { return (unsigned)__builtin_amdgcn_s_getreg((3 << 11) | 20) & 0xFu; }
#define XB_SPIN(cond, bar) do { unsigned _sp = 0; while (cond) { __builtin_amdgcn_s_sleep(1); \
    if ((++_sp & 255u) == 0u) { if (xb_ld(&(bar)[XB_TMO])) break; if (_sp > XB_SPIN_CAP) { atomicAdd(&(bar)[XB_TMO], 1u); break; } } } } while (0)
struct XcdBarrier { unsigned* bar; unsigned x; volatile LAS unsigned* st; };
__device__ __forceinline__ XcdBarrier xcd_barrier_post(unsigned* bar, volatile LAS unsigned* st) {
    XcdBarrier b; b.bar = bar; b.x = xb_xcc_id(); b.st = st;
    if (threadIdx.x == 0) (void)xb_add(&bar[XB_XCNT(b.x)], 1u);
    return b;
}
__device__ __forceinline__ void xcd_barrier_complete(unsigned* bar, unsigned x, unsigned& nloc, unsigned& nx) {
    const unsigned G = gridDim.x * gridDim.y * gridDim.z;
    unsigned sum, cnt, mine, sp = 0u;
    for (;;) {
        sum = 0u; cnt = 0u; mine = 0u;
#pragma unroll
        for (unsigned j = 0; j < 16; ++j) { const unsigned c = xb_ld(&bar[XB_XCNT(j)]); sum += c; cnt += (c > 0u) ? 1u : 0u; mine = (j == x) ? c : mine; }
        if (sum == G) break;
        __builtin_amdgcn_s_sleep(1);
        if ((++sp & 255u) == 0u) { if (xb_ld(&bar[XB_TMO])) break; if (sp > XB_SPIN_CAP) { atomicAdd(&bar[XB_TMO], 1u); break; } }
    }
    nloc = mine > 0u ? mine : 1u; nx = cnt > 0u ? cnt : 1u;
}
__device__ __forceinline__ void xcd_barrier(const XcdBarrier& b) {
    asm volatile("s_waitcnt vmcnt(0)" ::: "memory");
    __syncthreads();
    if (threadIdx.x == 0) {
        unsigned* bar = b.bar;
        __builtin_amdgcn_s_waitcnt(0);
        unsigned nloc = b.st[0], nx = b.st[1];
        if (nloc == 0u) { xcd_barrier_complete(bar, b.x, nloc, nx); b.st[0] = nloc; b.st[1] = nx; }
        const unsigned old = xb_add(&bar[XB_XSUB(b.x)], 1u);
        const unsigned gen = old / nloc;
        if (old + 1u == (gen + 1u) * nloc) {
            __builtin_amdgcn_fence(__ATOMIC_RELEASE, "agent");
            asm volatile("s_waitcnt vmcnt(0)" ::: "memory");
            const unsigned og = xb_add(&bar[XB_TOP], 1u);
            const unsigned tg = og / nx;
            if (og + 1u == (tg + 1u) * nx) xb_add(&bar[XB_TOPGEN], 1u);
            else XB_SPIN(xb_ld(&bar[XB_TOPGEN]) == tg, bar);
            __builtin_amdgcn_fence(__ATOMIC_ACQUIRE, "agent");
            xb_add(&bar[XB_XGEN(b.x)], 1u);
            asm volatile("s_waitcnt vmcnt(0)" ::: "memory");
        } else {
            XB_SPIN(xb_ld(&bar[XB_XGEN(b.x)]) == gen, bar);
            __builtin_amdgcn_fence(__ATOMIC_ACQUIRE, "agent");
            asm volatile("s_waitcnt vmcnt(0)" ::: "memory");
        }
    }
    __syncthreads();
}

constexpr int NTHR = 512, NWAVE = 8;
constexpr int LDS_BYTES = 147456;
constexpr int LDS_MISC = 147456 - 256;
struct Args { const void* in[34]; float* out; unsigned char* ws; };
struct Ptrs {
    const float *x, *ln_in_g, *ln_in_b, *w_in, *q_norm_g, *kv_norm_g, *w_uq, *w_ukv, *lambda_re, *lambda_im, *log_step, *b_re, *b_im, *c_re, *c_im, *d_skip, *w_glu, *b_glu;
    const float *attn_out_g, *ssm_out_g, *w_o, *ln1_g, *ln1_b, *w_router, *router_bias, *w_gate, *w_up, *w_down, *ws_gate, *ws_up, *ws_down, *ln2_g, *ln2_b;
    const int* positions; float* out; unsigned char* ws;
};
#define WSP(T_, off) ((T_*)(P.ws + (off)))

__device__ __forceinline__ void ph_ln_in(const Ptrs& P, int bid, int nb) {
    const int tidx = opaque_tid();
    const int lane = tidx & 63, w = tidx >> 6;
    bf16_t* xn = WSP(bf16_t, WS_XN); float* xstat = WSP(float, WS_XSTAT);
    for (int t = bid * NWAVE + w; t < T; t += nb * NWAVE) {
        const float* xr = P.x + (size_t)t * D;
        float v[16]; float s = 0.f;
#pragma unroll
        for (int i = 0; i < 4; ++i) { const f32x4 q = *(const f32x4*)(xr + i * 256 + lane * 4); v[4 * i] = q[0]; v[4 * i + 1] = q[1]; v[4 * i + 2] = q[2]; v[4 * i + 3] = q[3]; s += q[0] + q[1] + q[2] + q[3]; }
        const float mu = wave_sum(s) * (1.0f / D);
        float ss = 0.f;
#pragma unroll
        for (int i = 0; i < 16; ++i) { const float d = v[i] - mu; ss += d * d; }
        const float rstd = rsqrtf(wave_sum(ss) * (1.0f / D) + EPS);
        if (lane == 0) { xstat[2 * t] = mu; xstat[2 * t + 1] = rstd; }
#pragma unroll
        for (int i = 0; i < 4; ++i) {
            const int c = i * 256 + lane * 4;
            const f32x4 gg = *(const f32x4*)(P.ln_in_g + c), bb = *(const f32x4*)(P.ln_in_b + c);
            ushort4 o;
            o.x = f2bf((v[4 * i] - mu) * rstd * gg[0] + bb[0]); o.y = f2bf((v[4 * i + 1] - mu) * rstd * gg[1] + bb[1]);
            o.z = f2bf((v[4 * i + 2] - mu) * rstd * gg[2] + bb[2]); o.w = f2bf((v[4 * i + 3] - mu) * rstd * gg[3] + bb[3]);
            *(ushort4*)(xn + (size_t)t * D + c) = o;
        }
    }
}
__device__ __forceinline__ int wprep_srccol(int mode, int n, int& which) {
    which = 0;
    switch (mode) {
    case 0: if (n < 256) return n; if (n < 768) return 416 + (n - 256); if (n < 896) return 256 + (n - 768); if (n < 928) return 384 + ropeperm(n - 896); return -1;
    case 1: if (n < 512) return (n >> 6) * 96 + (n & 63); { const int m = n - 512; return (m >> 5) * 96 + 64 + ropeperm(m & 31); }
    case 2: if (n < 512) return (n >> 6) * 128 + (n & 63); { const int m = n - 512; return (m >> 6) * 128 + 64 + (m & 63); }
    case 5: { const int pn = n >> 8, w = n & 255; which = w >> 7; return pn * 128 + (w & 127); }
    default: return n;
    }
}
__device__ __forceinline__ void wprep_tile(LAS float* tile  , const float* s1, const float* s2, const float* ks, const float* ks2, bf16_t* dst,
                                           int mode, int Kd, int ldsrc, int Ksrc, float kmul, int n0, int k0) {
    const int tidx = opaque_tid();
    const int tid = tidx;
    {
        const int nn = tid & 63, ksub = tid >> 6;
        int which; const int sc = wprep_srccol(mode, n0 + nn, which);
        const float* s = which ? s2 : s1;
#pragma unroll
        for (int i = 0; i < 8; ++i) {
            const int kk = ksub + 8 * i, k = k0 + kk;
            float v = 0.f;
            if (sc >= 0 && k < Ksrc) {
                v = s[(size_t)k * ldsrc + sc];
                if (ks) v *= (ks2 && k >= 512) ? ks2[k - 512] : ks[k];
                v *= kmul;
            }
            tile[kk * 65 + nn] = v;
        }
    }
    __syncthreads();
    {
        const int kk = tid & 63, nsub = tid >> 6;
#pragma unroll
        for (int i = 0; i < 8; ++i) { const int n = nsub + 8 * i; dst[(size_t)(n0 + n) * Kd + k0 + kk] = f2bf(tile[kk * 65 + n]); }
    }
    __syncthreads();
}
__device__ __forceinline__ void ph_wprep(const Ptrs& P, LAS unsigned char* lds, int bid, int nb) {
    LAS float* tile = (LAS float*)lds;
    constexpr int J0 = 256, J1 = J0 + 48, J2 = J1 + 64, J3 = J2 + 64, J4 = J3 + 256, J5 = J4 + 65 * 128, J6 = J5 + 65 * 64;
    for (int j = bid; j < J6; j += nb) {
        if (j < J0)      { const int tl = j;      wprep_tile(tile, P.w_in, nullptr, nullptr, nullptr, WSP(bf16_t, WS_WIN), 0, 1024, 928, 1024, 1.0f, (tl / 16) * 64, (tl % 16) * 64); }
        else if (j < J1) { const int tl = j - J0; wprep_tile(tile, P.w_uq, nullptr, P.q_norm_g, nullptr, WSP(bf16_t, WS_WUQ), 1, 256, 768, 256, QSCALE, (tl / 4) * 64, (tl % 4) * 64); }
        else if (j < J2) { const int tl = j - J1; wprep_tile(tile, P.w_ukv, nullptr, P.kv_norm_g, nullptr, WSP(bf16_t, WS_WUKV), 2, 256, 1024, 128, 1.0f, (tl / 4) * 64, (tl % 4) * 64); }
        else if (j < J3) { const int tl = j - J2; wprep_tile(tile, P.w_glu, nullptr, nullptr, nullptr, WSP(bf16_t, WS_WGLU), 3, 512, 512, 512, 1.0f, (tl / 8) * 64, (tl % 8) * 64); }
        else if (j < J4) { const int tl = j - J3; wprep_tile(tile, P.w_o, nullptr, P.attn_out_g, P.ssm_out_g, WSP(bf16_t, WS_WO), 4, 1024, 1024, 1024, 1.0f, (tl / 16) * 64, (tl % 16) * 64); }
        else if (j < J5) { const int q = j - J4, e = q / 128, tl = q % 128;
            const float* g = e < 64 ? P.w_gate + (size_t)e * 1024 * 256 : P.ws_gate; const float* u = e < 64 ? P.w_up + (size_t)e * 1024 * 256 : P.ws_up;
            wprep_tile(tile, g, u, nullptr, nullptr, WSP(bf16_t, WS_WGU) + (size_t)e * 512 * 1024, 5, 1024, 256, 1024, 1.0f, (tl / 16) * 64, (tl % 16) * 64); }
        else             { const int q = j - J5, e = q / 64, tl = q % 64;
            const float* d = e < 64 ? P.w_down + (size_t)e * 256 * 1024 : P.ws_down;
            wprep_tile(tile, d, nullptr, nullptr, nullptr, WSP(bf16_t, WS_WD) + (size_t)e * 1024 * 256, 6, 256, 1024, 256, 1.0f, (tl / 4) * 64, (tl % 4) * 64); }
    }
}
__device__ __forceinline__ void ph_s5tab1(const Ptrs& P, int bid, int nb) {
    const int tidx = opaque_tid();
    float2* lampow = WSP(float2, WS_LAMPOW); float2* bbar = WSP(float2, WS_BBAR);
    for (int i = bid * NTHR + tidx; i < SG * SP; i += nb * NTHR) {
        const int g = i >> 6, p = i & 63;
        double lr = (double)P.lambda_re[g * SP + p]; if (lr > -1e-4) lr = -1e-4;
        const double li = (double)P.lambda_im[g * SP + p];
        double st, dummy; cexp_d((double)P.log_step[g], 0.0, st, dummy);
        double br, bi; cexp_d(lr * st, li * st, br, bi);
        const double nr = br - 1.0, ni = bi, den = lr * lr + li * li;
        const double cr = (nr * lr + ni * li) / den, ci = (ni * lr - nr * li) / den;
        double pr = 1.0, pi = 0.0;
        for (int tau = 0; tau <= 64; ++tau) {
            lampow[(g * SP + p) * 65 + tau] = make_float2((float)pr, (float)pi);
            const double tr = pr * br - pi * bi, ti = pr * bi + pi * br; pr = tr; pi = ti;
        }
        for (int c = 0; c < SC; ++c) {
            const double xr = (double)P.b_re[(g * SP + p) * SC + c], xi = (double)P.b_im[(g * SP + p) * SC + c];
            bbar[(g * SP + p) * SC + c] = make_float2((float)(cr * xr - ci * xi), (float)(cr * xi + ci * xr));
        }
    }
}
__device__ __forceinline__ void ph_s5tab2(const Ptrs& P, int bid, int nb) {
    const int tidx = opaque_tid();
    const float2* lampow = WSP(float2, WS_LAMPOW); const float2* bbar = WSP(float2, WS_BBAR);
    bf16_t* ktab = WSP(bf16_t, WS_KTAB); bf16_t* bloc = WSP(bf16_t, WS_BLOC); bf16_t* clam = WSP(bf16_t, WS_CLAM);
    const float* cre = P.c_re; const float* cim = P.c_im;
    const size_t nk = (size_t)SG * 127 * 256, nbl = (size_t)SG * 256 * 1024, nc = (size_t)SG * 1024 * 256;
    const size_t stride = (size_t)nb * NTHR;
    for (size_t i = (size_t)bid * NTHR + tidx; i < nk + nbl + nc; i += stride) {
        if (i < nk) {
            const int cp = (int)(i & 15), c = (int)((i >> 4) & 15), ti = (int)((i >> 8) % 127), g = (int)((i >> 8) / 127);
            const int tau = ti - 63;
            float v = 0.f;
            if (tau >= 0) {
                for (int p = 0; p < SP; ++p) {
                    const float2 l = lampow[(g * SP + p) * 65 + tau], bb = bbar[(g * SP + p) * SC + cp];
                    const float cr = cre[(g * SC + c) * SP + p], ci = cim[(g * SC + c) * SP + p];
                    const float mr = l.x * bb.x - l.y * bb.y, mi = l.x * bb.y + l.y * bb.x;
                    v += cr * mr - ci * mi;
                }
                if (tau == 0 && c == cp) v += P.d_skip[g * SC + c];
            }
            ktab[i] = f2bf(v);
        } else if (i < nk + nbl) {
            const size_t j = i - nk;
            const int k = (int)(j & 1023), n = (int)((j >> 10) & 255), g = (int)(j >> 18);
            float v = 0.f;
            if (n < 128) {
                const int p = n & 63, s = k >> 4, c = k & 15;
                const float2 l = lampow[(g * SP + p) * 65 + (63 - s)], bb = bbar[(g * SP + p) * SC + c];
                v = (n < 64) ? (l.x * bb.x - l.y * bb.y) : (l.x * bb.y + l.y * bb.x);
            }
            bloc[j] = f2bf(v);
        } else {
            const size_t j = i - nk - nbl;
            const int k = (int)(j & 255), n = (int)((j >> 8) & 1023), g = (int)(j >> 18);
            float v = 0.f;
            if (k < 128) {
                const int p = k & 63, t = n >> 4, c = n & 15;
                const float2 l = lampow[(g * SP + p) * 65 + (t + 1)];
                const float cr = cre[(g * SC + c) * SP + p], ci = cim[(g * SC + c) * SP + p];
                v = (k < 64) ? (cr * l.x - ci * l.y) : -(cr * l.y + ci * l.x);
            }
            clam[j] = f2bf(v);
        }
    }
}
__device__ __forceinline__ void ph_ropetab(const Ptrs& P, int bid, int nb) {
    const int tidx = opaque_tid();
    float2* rope = WSP(float2, WS_ROPE);
    for (int i = bid * NTHR + tidx; i < T * 16; i += nb * NTHR) {
        const int t = i >> 4, j = i & 15;
        double invf, dm; cexp_d(-(double)j / 16.0 * 9.210340371976184, 0.0, invf, dm);
        const float ang = (float)P.positions[t] * (float)invf;
        double c, s; cexp_d(0.0, (double)ang, c, s);
        rope[i] = make_float2((float)c, (float)s);
    }
}

#define GW_LOOP(ntiles) for (int tl = bid * NWAVE + (tidx >> 6); tl < (ntiles); tl += nb * NWAVE)
__device__ __forceinline__ void ph_gemm_win(const Ptrs& P, int bid, int nb) {
    const int tidx = opaque_tid();
    const bf16_t* xn = WSP(bf16_t, WS_XN); const bf16_t* wt = WSP(bf16_t, WS_WIN);
    bf16_t* cq = WSP(bf16_t, WS_CQ); bf16_t* ckv = WSP(bf16_t, WS_CKV); bf16_t* u = WSP(bf16_t, WS_U); float* krraw = WSP(float, WS_KRRAW);
    GW_LOOP((T / 32) * 32) {
        const int m0 = (tl >> 5) * 32, n0 = (tl & 31) * 32;
        sg_tile<false>(m0, n0, D,
            [&](int row) { return xn + (size_t)row * D; },
            [&](int n, int k, int) { return wt + (size_t)n * D + k; },
            [&](int t, int n, float v, float) {
                if (n < 256) cq[(size_t)t * 256 + n] = f2bf(v);
                else if (n < 768) {
                    const int ch = n - 256, g = ch >> 4, c = ch & 15, b = t >> 11, s = t & 2047, j = s >> 6, sl = s & 63;
                    u[((size_t)g * 512 + b * 32 + j) * 1024 + sl * 16 + c] = f2bf(v);
                } else if (n < 896) ckv[(size_t)t * 256 + (n - 768)] = f2bf(v);
                else {
                    ckv[(size_t)t * 256 + (n - 768)] = 0;
                    if (n < 928) krraw[(size_t)t * 32 + ropeperm(n - 896)] = v;
                }
            });
    }
}
__device__ __forceinline__ void ph_rstat(const Ptrs& P, int bid, int nb) {
    const int tidx = opaque_tid();
    const bf16_t* cq = WSP(bf16_t, WS_CQ); const bf16_t* ckv = WSP(bf16_t, WS_CKV); float* rsq = WSP(float, WS_RSQ); float* rskv = WSP(float, WS_RSKV);
    const int lane = tidx & 63, w = tidx >> 6;
    for (int t = bid * NWAVE + w; t < T; t += nb * NWAVE) {
        float s = 0.f, s2 = 0.f;
#pragma unroll
        for (int i = 0; i < 4; ++i) { const float v = bf2f(cq[(size_t)t * 256 + i * 64 + lane]); s += v * v; }
#pragma unroll
        for (int i = 0; i < 2; ++i) { const float v = bf2f(ckv[(size_t)t * 256 + i * 64 + lane]); s2 += v * v; }
        s = wave_sum(s); s2 = wave_sum(s2);
        if (lane == 0) { rsq[t] = rsqrtf(s * (1.0f / 256) + EPS); rskv[t] = rsqrtf(s2 * (1.0f / 128) + EPS); }
    }
}
__device__ __forceinline__ void ph_gemm_q(const Ptrs& P, int bid, int nb) {
    const int tidx = opaque_tid();
    const bf16_t* cq = WSP(bf16_t, WS_CQ); const bf16_t* wt = WSP(bf16_t, WS_WUQ); const float* rsq = WSP(float, WS_RSQ); bf16_t* Q = WSP(bf16_t, WS_Q); float* qrraw = WSP(float, WS_QRRAW);
    GW_LOOP((T / 32) * 24) {
        const int m0 = (tl / 24) * 32, n0 = (tl % 24) * 32;
        sg_tile<false>(m0, n0, 256,
            [&](int row) { return cq + (size_t)row * 256; },
            [&](int n, int k, int) { return wt + (size_t)n * 256 + k; },
            [&](int t, int n, float v, float) {
                v *= rsq[t];
                const int b = t >> 11, s = t & 2047;
                if (n < 512) Q[(((size_t)b * NH + (n >> 6)) * SEQ + s) * QKD + (n & 63)] = f2bf(v);
                else { const int m = n - 512; qrraw[(size_t)t * 256 + (m >> 5) * 32 + ropeperm(m & 31)] = v; }
            });
    }
}
__device__ __forceinline__ void ph_gemm_kv(const Ptrs& P, int bid, int nb) {
    const int tidx = opaque_tid();
    const bf16_t* ckv = WSP(bf16_t, WS_CKV); const bf16_t* wt = WSP(bf16_t, WS_WUKV); const float* rskv = WSP(float, WS_RSKV); bf16_t* Kc = WSP(bf16_t, WS_K); bf16_t* V = WSP(bf16_t, WS_V);
    GW_LOOP((T / 32) * 32) {
        const int m0 = (tl >> 5) * 32, n0 = (tl & 31) * 32;
        sg_tile<false>(m0, n0, 256,
            [&](int row) { return ckv + (size_t)row * 256; },
            [&](int n, int k, int) { return wt + (size_t)n * 256 + k; },
            [&](int t, int n, float v, float) {
                v *= rskv[t];
                const int b = t >> 11, s = t & 2047;
                if (n < 512) Kc[(((size_t)b * NH + (n >> 6)) * SEQ + s) * QKD + (n & 63)] = f2bf(v);
                else { const int m = n - 512; V[(((size_t)b * NH + (m >> 6)) * SEQ + s) * VD + (m & 63)] = f2bf(v); }
            });
    }
}
__device__ __forceinline__ void ph_rope_apply(const Ptrs& P, int bid, int nb) {
    const int tidx = opaque_tid();
    const float* qrraw = WSP(float, WS_QRRAW); const float* krraw = WSP(float, WS_KRRAW); const float2* rope = WSP(float2, WS_ROPE); bf16_t* Q = WSP(bf16_t, WS_Q); bf16_t* Kc = WSP(bf16_t, WS_K);
    for (int i = bid * NTHR + tidx; i < T * 9 * 16; i += nb * NTHR) {
        const int j = i & 15, hh = (i >> 4) % 9, t = (i >> 4) / 9;
        const float2 cs = rope[t * 16 + j];
        const int b = t >> 11, s = t & 2047;
        if (hh < 8) {
            const float x1 = qrraw[(size_t)t * 256 + hh * 32 + j], x2 = qrraw[(size_t)t * 256 + hh * 32 + 16 + j];
            bf16_t* q = Q + (((size_t)b * NH + hh) * SEQ + s) * QKD + 64;
            q[j] = f2bf(x1 * cs.x - x2 * cs.y); q[16 + j] = f2bf(x2 * cs.x + x1 * cs.y);
        } else {
            const float x1 = krraw[(size_t)t * 32 + j], x2 = krraw[(size_t)t * 32 + 16 + j];
            const bf16_t o1 = f2bf(x1 * cs.x - x2 * cs.y), o2 = f2bf(x2 * cs.x + x1 * cs.y);
            for (int h = 0; h < NH; ++h) { bf16_t* k = Kc + (((size_t)b * NH + h) * SEQ + s) * QKD + 64; k[j] = o1; k[16 + j] = o2; }
        }
    }
}
__device__ __forceinline__ void ph_gemm_s5b(const Ptrs& P, int bid, int nb) {
    const int tidx = opaque_tid();
    const bf16_t* u = WSP(bf16_t, WS_U); const bf16_t* bloc = WSP(bf16_t, WS_BLOC); float* xloc = WSP(float, WS_XLOC);
    GW_LOOP(SG * 16 * 4) {
        const int g = tl >> 6, m0 = ((tl >> 2) & 15) * 32, n0 = (tl & 3) * 32;
        sg_tile<false>(m0, n0, 1024,
            [&](int row) { return u + ((size_t)g * 512 + row) * 1024; },
            [&](int n, int k, int) { return bloc + ((size_t)g * 256 + n) * 1024 + k; },
            [&](int row, int n, float v, float) { xloc[((size_t)g * 512 + row) * 128 + n] = v; });
    }
}
__device__ __forceinline__ void ph_gemm_s5a(const Ptrs& P, int bid, int nb) {
    const int tidx = opaque_tid();
    const bf16_t* u = WSP(bf16_t, WS_U); const bf16_t* ktab = WSP(bf16_t, WS_KTAB); bf16_t* yintra = WSP(bf16_t, WS_YINTRA);
    GW_LOOP(SG * 16 * 32) {
        const int g = tl >> 9, m0 = ((tl >> 5) & 15) * 32, n0 = (tl & 31) * 32;
        sg_tile<false>(m0, n0, 1024,
            [&](int row) { return u + ((size_t)g * 512 + row) * 1024; },
            [&](int n, int k, int) { const int t = n >> 4, c = n & 15, s = k >> 4, c0 = k & 15; return ktab + (((size_t)g * 127 + (t - s + 63)) * 16 + c) * 16 + c0; },
            [&](int row, int n, float v, float) {
                const int b = row >> 5, j = row & 31, t = n >> 4, c = n & 15;
                yintra[((size_t)b * SEQ + j * CH + t) * SSMW + g * SC + c] = f2bf(v);
            });
    }
}
__device__ __forceinline__ void ph_attn_simple(const Ptrs& P, LAS unsigned char* lds, int bid, int nb) {
    const int tidx = opaque_tid();
    const bf16_t* Q = WSP(bf16_t, WS_Q); const bf16_t* Kc = WSP(bf16_t, WS_K); const bf16_t* V = WSP(bf16_t, WS_V); bf16_t* AS = WSP(bf16_t, WS_AS);
    const int lane = tidx & 63, w = tidx >> 6;
    LAS float* qs = (LAS float*)lds + w * (QKD + SEQ);
    LAS float* ps = qs + QKD;
    for (int row = bid * NWAVE + w; row < T * NH; row += nb * NWAVE) {
        const int bh = row >> 11, q = row & 2047, b = bh >> 3, h = bh & 7;
        asm volatile("s_waitcnt lgkmcnt(0)" ::: "memory");
        qs[lane] = bf2f(Q[(size_t)row * QKD + lane]);
        if (lane < 32) qs[64 + lane] = bf2f(Q[(size_t)row * QKD + 64 + lane]);
        asm volatile("s_waitcnt lgkmcnt(0)" ::: "memory");
        const int nk = ((q >> 6) + 1) * 64;
        float m = -INFINITY;
        for (int kb = 0; kb < nk; kb += 64) {
            const bf16_t* kp = Kc + ((size_t)bh * SEQ + kb + lane) * QKD;
            float s = 0.f;
#pragma unroll
            for (int c = 0; c < 12; ++c) {
                const bf16x8 kv = *(const bf16x8*)(kp + c * 8);
#pragma unroll
                for (int e = 0; e < 8; ++e) s += qs[c * 8 + e] * bf2f((bf16_t)kv[e]);
            }
            ps[kb + lane] = s; m = fmaxf(m, s);
        }
        m = wave_max(m);
        float l = 0.f;
        for (int kb = 0; kb < nk; kb += 64) { const float p = exp2f(ps[kb + lane] - m); ps[kb + lane] = p; l += p; }
        l = wave_sum(l);
        asm volatile("s_waitcnt lgkmcnt(0)" ::: "memory");
        float o = 0.f;
        const bf16_t* vp = V + (size_t)bh * SEQ * VD + lane;
        for (int k = 0; k < nk; ++k) o += ps[k] * bf2f(vp[(size_t)k * VD]);
        AS[((size_t)b * SEQ + q) * 1024 + h * 64 + lane] = f2bf(o / l);
    }
}
__device__ __forceinline__ void ph_s5scan(const Ptrs& P, int bid, int nb) {
    const int tidx = opaque_tid();
    const float* xloc = WSP(float, WS_XLOC); const float2* lampow = WSP(float2, WS_LAMPOW); bf16_t* xprev = WSP(bf16_t, WS_XPREV);
    for (int i = bid * NTHR + tidx; i < SG * NB * SP; i += nb * NTHR) {
        const int p = i & 63, b = (i >> 6) & 15, g = i >> 10;
        const float2 l64 = lampow[(g * SP + p) * 65 + 64];
        float xr = 0.f, xi = 0.f;
        for (int j = 0; j < NCH; ++j) {
            const size_t row = (size_t)g * 512 + b * 32 + j;
            bf16_t* xp = xprev + row * 256;
            xp[p] = f2bf(xr); xp[64 + p] = f2bf(xi); xp[128 + p] = 0; xp[192 + p] = 0;
            const float lr = xloc[row * 128 + p], li = xloc[row * 128 + 64 + p];
            const float nr = l64.x * xr - l64.y * xi + lr, ni = l64.x * xi + l64.y * xr + li;
            xr = nr; xi = ni;
        }
    }
}
__device__ __forceinline__ void ph_gemm_s5d(const Ptrs& P, int bid, int nb) {
    const int tidx = opaque_tid();
    const bf16_t* xprev = WSP(bf16_t, WS_XPREV); const bf16_t* clam = WSP(bf16_t, WS_CLAM); const bf16_t* yintra = WSP(bf16_t, WS_YINTRA); bf16_t* Y = WSP(bf16_t, WS_Y);
    GW_LOOP(SG * 16 * 32) {
        const int g = tl >> 9, m0 = ((tl >> 5) & 15) * 32, n0 = (tl & 31) * 32;
        sg_tile<false>(m0, n0, 256,
            [&](int row) { return xprev + ((size_t)g * 512 + row) * 256; },
            [&](int n, int k, int) { return clam + ((size_t)g * 1024 + n) * 256 + k; },
            [&](int row, int n, float v, float) {
                const int b = row >> 5, j = row & 31, t = n >> 4, c = n & 15;
                const size_t o = ((size_t)b * SEQ + j * CH + t) * SSMW + g * SC + c;
                Y[o] = f2bf(gelu_tanh(v + bf2f(yintra[o])));
            });
    }
}
__device__ __forceinline__ void ph_gemm_glu(const Ptrs& P, int bid, int nb) {
    const int tidx = opaque_tid();
    const bf16_t* Y = WSP(bf16_t, WS_Y); const bf16_t* wt = WSP(bf16_t, WS_WGLU); bf16_t* AS = WSP(bf16_t, WS_AS);
    GW_LOOP((T / 32) * 16) {
        const int m0 = (tl >> 4) * 32, n0 = (tl & 15) * 32;
        sg_tile<false>(m0, n0, 512,
            [&](int row) { return Y + (size_t)row * 512; },
            [&](int n, int k, int) { return wt + (size_t)n * 512 + k; },
            [&](int t, int n, float v, float) {
                const float yv = bf2f(Y[(size_t)t * 512 + n]);
                AS[(size_t)t * 1024 + 512 + n] = f2bf(yv * sigmoidf_(v + P.b_glu[n]));
            });
    }
}
__device__ __forceinline__ void ph_asnorm(const Ptrs& P, int bid, int nb) {
    const int tidx = opaque_tid();
    bf16_t* AS = WSP(bf16_t, WS_AS);
    const int lane = tidx & 63, w = tidx >> 6;
    for (int t = bid * NWAVE + w; t < T; t += nb * NWAVE) {
        bf16_t* r = AS + (size_t)t * 1024;
        float va[8], vs[8]; float sa = 0.f, ss = 0.f;
        const bf16x8 a = *(const bf16x8*)(r + lane * 8), s = *(const bf16x8*)(r + 512 + lane * 8);
#pragma unroll
        for (int i = 0; i < 8; ++i) { va[i] = bf2f((bf16_t)a[i]); vs[i] = bf2f((bf16_t)s[i]); sa += va[i] * va[i]; ss += vs[i] * vs[i]; }
        const float ra = rsqrtf(wave_sum(sa) * (1.0f / 512) + EPS), rs = rsqrtf(wave_sum(ss) * (1.0f / 512) + EPS);
        bf16x8 oa, os;
#pragma unroll
        for (int i = 0; i < 8; ++i) { oa[i] = (short)f2bf(va[i] * ra); os[i] = (short)f2bf(vs[i] * rs); }
        *(bf16x8*)(r + lane * 8) = oa; *(bf16x8*)(r + 512 + lane * 8) = os;
    }
}
__device__ __forceinline__ void ph_gemm_wo(const Ptrs& P, int bid, int nb) {
    const int tidx = opaque_tid();
    const bf16_t* AS = WSP(bf16_t, WS_AS); const bf16_t* wt = WSP(bf16_t, WS_WO); const float* xstat = WSP(float, WS_XSTAT); float* pre1 = P.out;
    GW_LOOP((T / 32) * 32) {
        const int m0 = (tl >> 5) * 32, n0 = (tl & 31) * 32;
        sg_tile<false>(m0, n0, 1024,
            [&](int row) { return AS + (size_t)row * 1024; },
            [&](int n, int k, int) { return wt + (size_t)n * 1024 + k; },
            [&](int t, int n, float v, float) {
                const float xn = (P.x[(size_t)t * D + n] - xstat[2 * t]) * xstat[2 * t + 1] * P.ln_in_g[n] + P.ln_in_b[n];
                pre1[(size_t)t * D + n] = v + ALPHA * xn;
            });
    }
}
__device__ __forceinline__ void ph_ln1(const Ptrs& P, int bid, int nb) {
    const int tidx = opaque_tid();
    const float* pre1 = P.out; bf16_t* x1 = WSP(bf16_t, WS_X1); bf16_t* x1lo = WSP(bf16_t, WS_X1LO);
    const int lane = tidx & 63, w = tidx >> 6;
    for (int t = bid * NWAVE + w; t < T; t += nb * NWAVE) {
        const float* xr = pre1 + (size_t)t * D;
        float v[16]; float s = 0.f;
#pragma unroll
        for (int i = 0; i < 4; ++i) { const f32x4 q = *(const f32x4*)(xr + i * 256 + lane * 4); v[4 * i] = q[0]; v[4 * i + 1] = q[1]; v[4 * i + 2] = q[2]; v[4 * i + 3] = q[3]; s += q[0] + q[1] + q[2] + q[3]; }
        const float mu = wave_sum(s) * (1.0f / D);
        float ss = 0.f;
#pragma unroll
        for (int i = 0; i < 16; ++i) { const float d = v[i] - mu; ss += d * d; }
        const float rstd = rsqrtf(wave_sum(ss) * (1.0f / D) + EPS);
#pragma unroll
        for (int i = 0; i < 4; ++i) {
            const int c = i * 256 + lane * 4;
            const f32x4 gg = *(const f32x4*)(P.ln1_g + c), bb = *(const f32x4*)(P.ln1_b + c);
            ushort4 o, ol;
            float y;
            y = (v[4 * i] - mu) * rstd * gg[0] + bb[0];     o.x = f2bf(y); ol.x = f2bf(y - bf2f(o.x));
            y = (v[4 * i + 1] - mu) * rstd * gg[1] + bb[1]; o.y = f2bf(y); ol.y = f2bf(y - bf2f(o.y));
            y = (v[4 * i + 2] - mu) * rstd * gg[2] + bb[2]; o.z = f2bf(y); ol.z = f2bf(y - bf2f(o.z));
            y = (v[4 * i + 3] - mu) * rstd * gg[3] + bb[3]; o.w = f2bf(y); ol.w = f2bf(y - bf2f(o.w));
            *(ushort4*)(x1 + (size_t)t * D + c) = o; *(ushort4*)(x1lo + (size_t)t * D + c) = ol;
        }
    }
}
__device__ __forceinline__ void ph_router(const Ptrs& P, int bid, int nb) {
    const int tidx = opaque_tid();
    const bf16_t* x1 = WSP(bf16_t, WS_X1); const bf16_t* x1lo = WSP(bf16_t, WS_X1LO); float* logits = WSP(float, WS_LOGITS);
    const int e = tidx & 63, w = tidx >> 6;
    for (int t = bid * NWAVE + w; t < T; t += nb * NWAVE) {
        const bf16_t* a = x1 + (size_t)t * D; const bf16_t* al = x1lo + (size_t)t * D;
        float s = 0.f;
        for (int k = 0; k < D; k += 8) {
            const bf16x8 hi = *(const bf16x8*)(a + k), lo = *(const bf16x8*)(al + k);
#pragma unroll
            for (int i = 0; i < 8; ++i) s += (bf2f((bf16_t)hi[i]) + bf2f((bf16_t)lo[i])) * P.w_router[(size_t)(k + i) * NE + e];
        }
        logits[(size_t)t * NE + e] = s;
    }
}
__device__ __forceinline__ void ph_topk(const Ptrs& P, int bid, int nb) {
    const int tidx = opaque_tid();
    const float* logits = WSP(float, WS_LOGITS); int* topi = WSP(int, WS_TOPI); float* topw = WSP(float, WS_TOPW);
    const int lane = tidx & 63, w = tidx >> 6;
    for (int t = bid * NWAVE + w; t < T; t += nb * NWAVE) {
        const float sc = sigmoidf_(logits[(size_t)t * NE + lane]);
        const float sel = sc + P.router_bias[lane];
        const int grp = lane >> 3;
        float m1 = sel;
        m1 = fmaxf(m1, __shfl_xor(m1, 1)); m1 = fmaxf(m1, __shfl_xor(m1, 2)); m1 = fmaxf(m1, __shfl_xor(m1, 4));
        const unsigned long long bal = __ballot(sel == m1) & (0xFFull << (8 * grp));
        const int first = __ffsll((long long)bal) - 1;
        float m2 = (lane == first) ? -INFINITY : sel;
        m2 = fmaxf(m2, __shfl_xor(m2, 1)); m2 = fmaxf(m2, __shfl_xor(m2, 2)); m2 = fmaxf(m2, __shfl_xor(m2, 4));
        const float gs = m1 + m2;
        int cg = 0;
#pragma unroll
        for (int gj = 0; gj < 8; ++gj) { const float sj = __shfl(gs, gj * 8); cg += (sj > gs || (sj == gs && gj < grp)) ? 1 : 0; }
        const bool gsel = cg < 4;
        const float v = gsel ? sel : -INFINITY;
        int rank = 0;
        for (int e2 = 0; e2 < 64; ++e2) { const float ve = __shfl(v, e2); rank += (ve > v || (ve == v && e2 < lane)) ? 1 : 0; }
        const bool chosen = gsel && rank < TOPK;
        const float wsum = wave_sum(chosen ? sc : 0.f);
        if (chosen) { topi[(size_t)t * TOPK + rank] = lane; topw[(size_t)t * TOPK + rank] = sc / wsum * 2.5f; }
    }
}
__device__ __forceinline__ void ph_cnt(const Ptrs& P, int bid, int nb) {
    const int tidx = opaque_tid();
    const int* topi = WSP(int, WS_TOPI); int* cnt = WSP(int, WS_CNT);
    for (int i = bid * NTHR + tidx; i < 256 * 64; i += nb * NTHR) {
        const int tile = i >> 6, e = i & 63;
        int c = 0;
        for (int k = 0; k < 1024; ++k) c += (topi[tile * 1024 + k] == e) ? 1 : 0;
        cnt[i] = c;
    }
}
__device__ __forceinline__ void ph_off(const Ptrs& P, LAS unsigned char* lds, int bid) {
    const int tidx = opaque_tid();
    if (bid != 0) return;
    const int* cnt = WSP(int, WS_CNT); int* toff = WSP(int, WS_TOFF); int* eoff = WSP(int, WS_EOFF); int* ecnt = WSP(int, WS_ECNT);
    LAS int* tot = (LAS int*)lds; LAS int* off = tot + 64;
    const int e = tidx;
    if (e < 64) { int s = 0; for (int tile = 0; tile < 256; ++tile) s += cnt[tile * 64 + e]; tot[e] = s; ecnt[e] = s; }
    __syncthreads();
    if (e == 0) { int o = 0; for (int i = 0; i < 64; ++i) { off[i] = o; o += (tot[i] + 255) & ~255; } off[64] = o; }
    __syncthreads();
    if (e < 64) {
        eoff[e] = off[e]; if (e == 0) eoff[64] = off[64];
        int run = off[e];
        for (int tile = 0; tile < 256; ++tile) { toff[tile * 64 + e] = run; run += cnt[tile * 64 + e]; }
    }
}
__device__ __forceinline__ void ph_lists(const Ptrs& P, int bid, int nb) {
    const int tidx = opaque_tid();
    const int* topi = WSP(int, WS_TOPI); const float* topw = WSP(float, WS_TOPW); const int* toff = WSP(int, WS_TOFF); const int* eoff = WSP(int, WS_EOFF);
    int* rowtok = WSP(int, WS_ROWTOK); float* roww = WSP(float, WS_ROWW);
    for (int i = bid * NTHR + tidx; i < 256 * 64; i += nb * NTHR) {
        const int tile = i >> 6, e = i & 63;
        int pos = toff[tile * 64 + e];
        for (int k = 0; k < 1024; ++k) {
            if (topi[tile * 1024 + k] == e) { rowtok[pos] = tile * 1024 + k; roww[pos] = topw[tile * 1024 + k]; ++pos; }
        }
        if (tile == 255) { const int end = eoff[e + 1]; for (; pos < end; ++pos) { rowtok[pos] = -1; roww[pos] = 0.f; } }
    }
    for (int i = bid * NTHR + tidx; i < T; i += nb * NTHR) rowtok[SH_ROW0 + i] = i * 8;
}
__device__ __forceinline__ void ph_gemm_gu(const Ptrs& P, int bid, int nb) {
    const int tidx = opaque_tid();
    const bf16_t* x1 = WSP(bf16_t, WS_X1); const bf16_t* wgu = WSP(bf16_t, WS_WGU); const int* rowtok = WSP(int, WS_ROWTOK); const float* roww = WSP(float, WS_ROWW);
    const int* eoff = WSP(int, WS_EOFF); bf16_t* H = WSP(bf16_t, WS_H);
    const int nrt = eoff[64] / 32;
    const int ntl = (nrt + T / 32) * 8;
    GW_LOOP(ntl) {
        const int rt = tl >> 3, n0 = (tl & 7) * 32;
        if (rt < nrt) {
            const int m0 = rt * 32;
            int e = 0; while (e < 63 && eoff[e + 1] <= m0) ++e;
            const bf16_t* w = wgu + (size_t)e * 512 * 1024;
            sg_tile<true>(m0, n0, 1024,
                [&](int row) { const int s = rowtok[row]; return x1 + (size_t)(s >= 0 ? (s >> 3) : 0) * D; },
                [&](int f, int k, int which) { return w + (size_t)((f >> 7) * 256 + (f & 127) + which * 128) * 1024 + k; },
                [&](int row, int f, float gv, float uv) { H[(size_t)row * FF + f] = f2bf(gv * sigmoidf_(gv) * uv * roww[row]); });
        } else {
            const int m0 = (rt - nrt) * 32;
            const bf16_t* w = wgu + (size_t)64 * 512 * 1024;
            sg_tile<true>(m0, n0, 1024,
                [&](int row) { return x1 + (size_t)row * D; },
                [&](int f, int k, int which) { return w + (size_t)((f >> 7) * 256 + (f & 127) + which * 128) * 1024 + k; },
                [&](int row, int f, float gv, float uv) { H[(size_t)(SH_ROW0 + row) * FF + f] = f2bf(gv * sigmoidf_(gv) * uv); });
        }
    }
}
__device__ __forceinline__ unsigned char f2fp8(float v) { const int p = __builtin_amdgcn_cvt_pk_fp8_f32(v, v, 0, false); return (unsigned char)(p & 0xff); }
__device__ __forceinline__ void ph_gemm_down(const Ptrs& P, int bid, int nb) {
    const int tidx = opaque_tid();
    const bf16_t* H = WSP(bf16_t, WS_H); const bf16_t* wd = WSP(bf16_t, WS_WD); const int* rowtok = WSP(int, WS_ROWTOK); const int* eoff = WSP(int, WS_EOFF);
    const bf16_t* x1 = WSP(bf16_t, WS_X1); unsigned char* yslot = WSP(unsigned char, WS_YSLOT); float* out = P.out;
    const int nrt = eoff[64] / 32;
    const int ntl = (nrt + T / 32) * 32;
    GW_LOOP(ntl) {
        const int rt = tl >> 5, n0 = (tl & 31) * 32;
        if (rt < nrt) {
            const int m0 = rt * 32;
            int e = 0; while (e < 63 && eoff[e + 1] <= m0) ++e;
            const bf16_t* w = wd + (size_t)e * 1024 * 256;
            sg_tile<false>(m0, n0, 256,
                [&](int row) { return H + (size_t)row * FF; },
                [&](int n, int k, int) { return w + (size_t)n * 256 + k; },
                [&](int row, int n, float v, float) { const int s = rowtok[row]; if (s >= 0) yslot[(size_t)s * D + n] = f2fp8(v * SLOT_SCALE); });
        } else {
            const int m0 = (rt - nrt) * 32;
            const bf16_t* w = wd + (size_t)64 * 1024 * 256;
            sg_tile<false>(m0, n0, 256,
                [&](int row) { return H + (size_t)(SH_ROW0 + row) * FF; },
                [&](int n, int k, int) { return w + (size_t)n * 256 + k; },
                [&](int t, int n, float v, float) { out[(size_t)t * D + n] = v + ALPHA * bf2f(x1[(size_t)t * D + n]); });
        }
    }
}
__device__ __forceinline__ void ph_combine(const Ptrs& P, int bid, int nb) {
    const int tidx = opaque_tid();
    const unsigned char* yslot = WSP(unsigned char, WS_YSLOT); float* out = P.out;
    const int lane = tidx & 63, w = tidx >> 6;
    for (int t = bid * NWAVE + w; t < T; t += nb * NWAVE) {
        float* orow = out + (size_t)t * D + lane * 16;
        float v[16];
#pragma unroll
        for (int i = 0; i < 4; ++i) { const f32x4 q = *(const f32x4*)(orow + 4 * i); v[4 * i] = q[0]; v[4 * i + 1] = q[1]; v[4 * i + 2] = q[2]; v[4 * i + 3] = q[3]; }
#pragma unroll
        for (int k = 0; k < TOPK; ++k) {
            const u32x4 q = *(const u32x4*)(yslot + ((size_t)t * TOPK + k) * D + lane * 16);
#pragma unroll
            for (int i = 0; i < 4; ++i) {
                v[4 * i]     += __builtin_amdgcn_cvt_f32_fp8((int)q[i], 0) * (1.0f / SLOT_SCALE);
                v[4 * i + 1] += __builtin_amdgcn_cvt_f32_fp8((int)q[i], 1) * (1.0f / SLOT_SCALE);
                v[4 * i + 2] += __builtin_amdgcn_cvt_f32_fp8((int)q[i], 2) * (1.0f / SLOT_SCALE);
                v[4 * i + 3] += __builtin_amdgcn_cvt_f32_fp8((int)q[i], 3) * (1.0f / SLOT_SCALE);
            }
        }
        float s = 0.f;
#pragma unroll
        for (int i = 0; i < 16; ++i) s += v[i];
        const float mu = wave_sum(s) * (1.0f / D);
        float ss = 0.f;
#pragma unroll
        for (int i = 0; i < 16; ++i) { const float d = v[i] - mu; ss += d * d; }
        const float rstd = rsqrtf(wave_sum(ss) * (1.0f / D) + EPS);
#pragma unroll
        for (int i = 0; i < 4; ++i) {
            const int c = lane * 16 + 4 * i;
            const f32x4 gg = *(const f32x4*)(P.ln2_g + c), bb = *(const f32x4*)(P.ln2_b + c);
            f32x4 o;
            o[0] = (v[4 * i] - mu) * rstd * gg[0] + bb[0]; o[1] = (v[4 * i + 1] - mu) * rstd * gg[1] + bb[1];
            o[2] = (v[4 * i + 2] - mu) * rstd * gg[2] + bb[2]; o[3] = (v[4 * i + 3] - mu) * rstd * gg[3] + bb[3];
            *(f32x4*)(orow + 4 * i) = o;
        }
    }
}

namespace g8 {
constexpr int BM = 256, BK = 64, HALF = 128, HTB = HALF * BK * 2, STAGE_BYTES = 8 * HTB;
__device__ __forceinline__ int lds_byte(int r, int c) { const int st = (r >> 4) * 2 + (c >> 5), rr = r & 15, cc = c & 31, ob = rr * 64 + cc * 2; return st * 1024 + (ob ^ (((ob >> 9) & 1) << 5)); }
__device__ __forceinline__ void stage_rc(int b, int& R, int& C) { const int st = b / 1024, sb = b % 1024, swz = sb ^ (((sb >> 9) & 1) << 5); R = (st >> 1) * 16 + swz / 64; C = (st & 1) * 32 + (swz % 64) / 2; }
__device__ __forceinline__ int perm32(int rho) { const int n = rho >> 4, i = rho & 15; return 8 * (i >> 2) + 4 * n + (i & 3); }

struct Unit { const char* A; const char* B; const int* rows; int pm, pn, e, nt; };
struct Geo { int lda_b, ldb_b; long kstepA, kstepB; int toep; };

typedef float f32x4 __attribute__((ext_vector_type(4)));
typedef f32x4 Acc[2][2][4][2];

template <class Epi, class Sched, bool GATHER>
__device__ __forceinline__ void gemm_body(LAS unsigned char* lds, const Geo g, const Sched& S, const Epi& E) {
    const int tid = opaque_tid(), wid = __builtin_amdgcn_readfirstlane(tid >> 6), lane = tid & 63, wr = wid >> 2, wc = wid & 3, fr = lane & 15, fq = lane >> 4;
    int sR[2], sC[2];
    unsigned voffB[2], vA[2][2], vN[2][2];
#pragma unroll
    for (int i = 0; i < 2; ++i) { int R, C; stage_rc(tid * 16 + i * 8192, R, C); sR[i] = R; sC[i] = C; const int Rb = (R & ~31) + perm32(R & 31);
        voffB[i] = g.toep ? (unsigned)(Rb * 32 + 1536 - (C >> 4) * 512 + (C & 15) * 2) : (unsigned)(Rb * g.ldb_b + C * 2);
#pragma unroll
        for (int h = 0; h < 2; ++h) { vA[h][i] = (unsigned)((h * HALF + R) * g.lda_b + C * 2); vN[h][i] = vA[h][i]; } }
    const long kA = g.kstepA, kB = g.kstepB;
    const long hB = (long)HALF * g.ldb_b;
    const unsigned ldsw = (unsigned)wid * 1024u;
    const int aoff = lds_byte(wr * 64 + fr, fq * 8), boff = lds_byte(wc * 32 + fr, fq * 8);
#define G8_SA(b, h) (((b) * 2 + (h)) * HTB)
#define G8_SB(b, h) ((4 + (b) * 2 + (h)) * HTB)
#define G8_STAGE(bufoff, gbase, v0, v1) do { \
        __builtin_amdgcn_global_load_lds((const unsigned*)((const char*)(gbase) + (v0)), (LAS unsigned*)(lds + (bufoff) + ldsw), 16, 0, 0); \
        __builtin_amdgcn_global_load_lds((const unsigned*)((const char*)(gbase) + (v1)), (LAS unsigned*)(lds + (bufoff) + ldsw + 8192), 16, 0, 0); } while (0)
#define G8_STB(bufoff, gbase) G8_STAGE(bufoff, gbase, voffB[0], voffB[1])
#define G8_LDA(dst, b, h) do { _Pragma("unroll") for (int m = 0; m < 4; ++m) _Pragma("unroll") for (int k = 0; k < 2; ++k) dst[m][k] = *(const LAS bf16x8*)(lds + G8_SA(b, h) + aoff + m * 2048 + k * 1024); } while (0)
#define G8_LDB(dst, b, h) do { _Pragma("unroll") for (int n = 0; n < 2; ++n) _Pragma("unroll") for (int k = 0; k < 2; ++k) dst[n][k] = *(const LAS bf16x8*)(lds + G8_SB(b, h) + boff + n * 2048 + k * 1024); } while (0)
#define G8_MMA(ai, bj, At, Bt) do { __builtin_amdgcn_s_setprio(1); _Pragma("unroll") for (int m = 0; m < 4; ++m) _Pragma("unroll") for (int n = 0; n < 2; ++n) _Pragma("unroll") for (int k = 0; k < 2; ++k) \
        acc[ai][bj][m][n] = __builtin_amdgcn_mfma_f32_16x16x32_bf16(Bt[n][k], At[m][k], acc[ai][bj][m][n], 0, 0, 0); __builtin_amdgcn_s_setprio(0); } while (0)
#define G8_WAIT_V(n) asm volatile("s_waitcnt vmcnt(" #n ")" ::: "memory")
#define G8_WAIT_L(n) asm volatile("s_waitcnt lgkmcnt(" #n ")" ::: "memory")
#define G8_BAR __builtin_amdgcn_s_barrier()
#define G8_SCHED __builtin_amdgcn_sched_barrier(0)
#define G8_ROWOFF(u_, h_, i_) ((unsigned)((unsigned)(((u_).rows[(h_) * HALF + sR[i_]] < 0 ? 0 : (u_).rows[(h_) * HALF + sR[i_]] >> 3)) * (unsigned)g.lda_b + (unsigned)(sC[i_] * 2)))
    Unit cur, nxt; int ui = 0;
    if (!S.next(0, cur)) return;
    Acc acc;
#pragma unroll
    for (int a = 0; a < 2; ++a)
#pragma unroll
        for (int b = 0; b < 2; ++b)
#pragma unroll
            for (int m = 0; m < 4; ++m)
#pragma unroll
                for (int n = 0; n < 2; ++n) acc[a][b][m][n] = (f32x4){0.f, 0.f, 0.f, 0.f};
    bf16x8 At[4][2], B0[2][2], B1[2][2];
    const char* cA = cur.A; const char* cB = cur.B;
    if (GATHER) {
#pragma unroll
        for (int h = 0; h < 2; ++h)
#pragma unroll
            for (int i = 0; i < 2; ++i) vA[h][i] = G8_ROWOFF(cur, h, i);
        asm volatile("" : "+v"(vA[0][0]), "+v"(vA[0][1]), "+v"(vA[1][0]), "+v"(vA[1][1]));
    }
    const long hA = GATHER ? 0 : 0;
    (void)hA;
    G8_STB(G8_SB(0, 0), cB); G8_STB(G8_SB(0, 1), cB + hB); G8_STAGE(G8_SA(0, 0), cA, vA[0][0], vA[0][1]); G8_STAGE(G8_SA(0, 1), cA, vA[1][0], vA[1][1]);
    if (wr == 1) G8_BAR;
    G8_WAIT_V(2); G8_BAR;
    G8_STB(G8_SB(1, 0), cB + kB); G8_STAGE(G8_SA(1, 0), cA + kA, vA[0][0], vA[0][1]); G8_STB(G8_SB(1, 1), cB + hB + kB);
    G8_WAIT_V(6); G8_BAR;
    for (;;) {
        const bool has_next = S.next(ui + 1, nxt);
        const char* nA = has_next ? nxt.A : cA; const char* nB = has_next ? nxt.B : cB;
        if (GATHER) {
            if (has_next) {
#pragma unroll
                for (int h = 0; h < 2; ++h)
#pragma unroll
                    for (int i = 0; i < 2; ++i) vN[h][i] = G8_ROWOFF(nxt, h, i);
            } else {
#pragma unroll
                for (int h = 0; h < 2; ++h)
#pragma unroll
                    for (int i = 0; i < 2; ++i) vN[h][i] = vA[h][i];
            }
            asm volatile("" : "+v"(vN[0][0]), "+v"(vN[0][1]), "+v"(vN[1][0]), "+v"(vN[1][1]));
        }
        const int nt = cur.nt;
        for (int t = 0; t < nt; t += 2) {
            const bool last = (t == nt - 2);
            const char* a1 = cA + (long)(t + 1) * kA;
            const char* a2 = last ? nA : cA + (long)(t + 2) * kA; const char* b2 = last ? nB : cB + (long)(t + 2) * kB;
            const char* a3 = a2 + kA; const char* b3 = b2 + kB;
            unsigned w00 = vA[0][0], w01 = vA[0][1], w10 = vA[1][0], w11 = vA[1][1];
            if (GATHER && last) { w00 = vN[0][0]; w01 = vN[0][1]; w10 = vN[1][0]; w11 = vN[1][1]; }
            G8_LDB(B0, 0, 0); G8_LDB(B1, 0, 1); G8_SCHED; G8_LDA(At, 0, 0); G8_STAGE(G8_SA(1, 1), a1, vA[1][0], vA[1][1]);
            G8_WAIT_V(8); G8_WAIT_L(0); G8_BAR; G8_MMA(0, 0, At, B0); G8_MMA(0, 1, At, B1); G8_BAR; G8_SCHED;
            G8_LDA(At, 0, 1); G8_STB(G8_SB(0, 0), b2); G8_STB(G8_SB(0, 1), b2 + hB); G8_STAGE(G8_SA(0, 0), a2, w00, w01);
            G8_WAIT_V(8); G8_WAIT_L(0); G8_BAR; G8_MMA(1, 0, At, B0); G8_MMA(1, 1, At, B1); G8_BAR; G8_SCHED;
            G8_LDB(B0, 1, 0); G8_LDB(B1, 1, 1); G8_SCHED; G8_LDA(At, 1, 0); G8_STAGE(G8_SA(0, 1), a2, w10, w11);
            G8_WAIT_V(8); G8_WAIT_L(0); G8_BAR; G8_MMA(0, 0, At, B0); G8_MMA(0, 1, At, B1); G8_BAR; G8_SCHED;
            G8_LDA(At, 1, 1); G8_STB(G8_SB(1, 0), b3); G8_STB(G8_SB(1, 1), b3 + hB); G8_STAGE(G8_SA(1, 0), a3, w00, w01);
            G8_WAIT_V(8); G8_WAIT_L(0); G8_BAR; G8_MMA(1, 0, At, B0); G8_MMA(1, 1, At, B1); G8_BAR; G8_SCHED;
        }
        if (wr == 0) G8_BAR;
        { int fr_ = fr, fq_ = fq; asm volatile("" : "+v"(fr_), "+v"(fq_)); E(acc, cur, wr, wc, fr_, fq_); }
        if (!has_next) break;
#pragma unroll
        for (int a = 0; a < 2; ++a)
#pragma unroll
            for (int b = 0; b < 2; ++b)
#pragma unroll
                for (int m = 0; m < 4; ++m)
#pragma unroll
                    for (int n = 0; n < 2; ++n) acc[a][b][m][n] = (f32x4){0.f, 0.f, 0.f, 0.f};
        cur = nxt; cA = nA; cB = nB; ++ui;
        if (GATHER) {
#pragma unroll
            for (int h = 0; h < 2; ++h)
#pragma unroll
                for (int i = 0; i < 2; ++i) vA[h][i] = vN[h][i];
        }
        if (wr == 1) G8_BAR;
    }
    G8_WAIT_V(0);
    G8_BAR;
#undef G8_SA
#undef G8_SB
#undef G8_STAGE
#undef G8_STB
#undef G8_LDA
#undef G8_LDB
#undef G8_MMA
#undef G8_WAIT_V
#undef G8_WAIT_L
#undef G8_BAR
#undef G8_SCHED
#undef G8_ROWOFF
}
}
namespace g8 {
__device__ __forceinline__ unsigned pk_bf16(float lo, float hi) { return (unsigned)f2bf(lo) | ((unsigned)f2bf(hi) << 16); }
__device__ __forceinline__ u32x4 pack8(const f32x4 a, const f32x4 b) { u32x4 w; w[0] = pk_bf16(a[0], a[1]); w[1] = pk_bf16(a[2], a[3]); w[2] = pk_bf16(b[0], b[1]); w[3] = pk_bf16(b[2], b[3]); return w; }
__device__ __forceinline__ int unit_index(int i, int nunits) {
    const int G = gridDim.x, c = blockIdx.x;
    if ((G & 7) != 0) { const long L = (long)i * G + c; return L < nunits ? (int)L : -1; }
    const int x = c & 7, r = c >> 3, GX = G >> 3;
    const int lo = (int)(((long)nunits * x) >> 3), hi = (int)(((long)nunits * (x + 1)) >> 3);
    const int L = lo + i * GX + r;
    return L < hi ? L : -1;
}
struct SchedReg {
    const char* A; const char* B; int lda_b, ldb_b, nM, nN, nt;
    __device__ __forceinline__ bool next(int i, Unit& u) const {
        const int L = unit_index(i, nM * nN); if (L < 0) return false;
        u.pm = L / nN; u.pn = L % nN; u.e = 0; u.nt = nt; u.rows = nullptr;
        u.A = A + (size_t)u.pm * 256 * lda_b; u.B = B + (size_t)u.pn * 256 * ldb_b; return true;
    }
};
struct SchedS5 {
    const char* A; const char* B; int lda_b, ldb_b, nN, nt; size_t a_gstride, b_gstride; int toep;
    __device__ __forceinline__ bool next(int i, Unit& u) const {
        const int L = unit_index(i, SG * 2 * nN); if (L < 0) return false;
        const int g = L / (2 * nN), r = L % (2 * nN);
        u.pm = r / nN; u.pn = r % nN; u.e = g; u.rows = nullptr;
        u.A = A + (size_t)g * a_gstride + (size_t)u.pm * 256 * lda_b;
        if (toep) { u.B = B + (size_t)g * 127 * 512 + 63 * 512 + (size_t)u.pn * 256 * 32 - 1536; u.nt = 4 * (u.pn + 1); }
        else { u.B = B + (size_t)g * b_gstride + (size_t)u.pn * 256 * ldb_b; u.nt = nt; }
        return true;
    }
};
struct SchedMoe {
    const char* A; const char* B; const int* eoff; const int* rowtok; int lda_b, npn, nt; size_t b_estride; int ldb_b; int gather;
    __device__ __forceinline__ bool next(int i, Unit& u) const {
        const int nrt = eoff[64] >> 8;
        const int L = unit_index(i, (nrt + T / 256) * npn); if (L < 0) return false;
        const int rt = L / npn; u.pn = L % npn; u.nt = nt;
        int e = 64;
        if (rt < nrt) { e = 0; while (e < 63 && eoff[e + 1] <= rt * 256) ++e; }
        u.e = e; u.pm = rt;
        u.B = B + (size_t)e * b_estride + (size_t)u.pn * 256 * ldb_b;
        if (gather) {
            u.A = A; u.rows = rowtok + ((e < 64) ? rt * 256 : SH_ROW0 + (rt - nrt) * 256);
        } else {
            const int row0 = (e < 64) ? rt * 256 : SH_ROW0 + (rt - nrt) * 256;
            u.A = A + (size_t)row0 * lda_b; u.rows = nullptr;
        }
        return true;
    }
};

#define EPI_ROWS_BEGIN _Pragma("unroll") for (int ai = 0; ai < 2; ++ai) _Pragma("unroll") for (int m = 0; m < 4; ++m) { const int rloc = ai * 128 + wr * 64 + m * 16 + fr;
#define EPI_ROWS_END }

struct EpiWin {
    bf16_t* cq; bf16_t* ckv; bf16_t* u; bf16_t* Kc; const float2* rope; float* rsqp; float* rskvp;
    __device__ __forceinline__ void operator()(const Acc& acc, const Unit& un, int wr, int wc, int fr, int fq) const {
        const int pn = un.pn;
        if (pn == 0) {
            EPI_ROWS_BEGIN
                const int t = un.pm * 256 + rloc;
                float ss = 0.f;
#pragma unroll
                for (int bj = 0; bj < 2; ++bj) { const f32x4 v0 = acc[ai][bj][m][0], v1 = acc[ai][bj][m][1];
                    *(u32x4*)(cq + (size_t)t * 256 + bj * 128 + wc * 32 + fq * 8) = pack8(v0, v1);
                    ss += v0[0] * v0[0] + v0[1] * v0[1] + v0[2] * v0[2] + v0[3] * v0[3] + v1[0] * v1[0] + v1[1] * v1[1] + v1[2] * v1[2] + v1[3] * v1[3]; }
                ss += __shfl_xor(ss, 16); ss += __shfl_xor(ss, 32);
                if (fq == 0) rsqp[(size_t)t * 4 + wc] = ss;
            EPI_ROWS_END
        } else if (pn <= 2) {
            EPI_ROWS_BEGIN
                const int t = un.pm * 256 + rloc;
                const int b = t >> 11, s = t & 2047, j = s >> 6, sl = s & 63;
#pragma unroll
                for (int bj = 0; bj < 2; ++bj) { const int ch0 = (pn - 1) * 256 + bj * 128 + wc * 32 + fq * 8, gi = ch0 >> 4, c0 = ch0 & 15;
                    *(u32x4*)(u + ((size_t)gi * 512 + b * 32 + j) * 1024 + sl * 16 + c0) = pack8(acc[ai][bj][m][0], acc[ai][bj][m][1]); }
            EPI_ROWS_END
        } else {
            EPI_ROWS_BEGIN
                const int t = un.pm * 256 + rloc;
                const f32x4 v0 = acc[ai][0][m][0], v1 = acc[ai][0][m][1];
                *(u32x4*)(ckv + (size_t)t * 256 + wc * 32 + fq * 8) = pack8(v0, v1);
                float ss = v0[0] * v0[0] + v0[1] * v0[1] + v0[2] * v0[2] + v0[3] * v0[3] + v1[0] * v1[0] + v1[1] * v1[1] + v1[2] * v1[2] + v1[3] * v1[3];
                ss += __shfl_xor(ss, 16); ss += __shfl_xor(ss, 32);
                if (fq == 0) rskvp[(size_t)t * 4 + wc] = ss;
                *(u32x4*)(ckv + (size_t)t * 256 + 128 + wc * 32 + fq * 8) = (u32x4){0u, 0u, 0u, 0u};
            EPI_ROWS_END
            if (wc == 0) {
                EPI_ROWS_BEGIN
                    const int t = un.pm * 256 + rloc;
                    const f32x4 x1 = acc[ai][1][m][0], x2 = acc[ai][1][m][1];
                    const f32x4 ca = *(const f32x4*)(rope + (size_t)t * 16 + fq * 4), cb = *(const f32x4*)(rope + (size_t)t * 16 + fq * 4 + 2);
                    const float o10 = x1[0] * ca[0] - x2[0] * ca[1], o11 = x1[1] * ca[2] - x2[1] * ca[3], o12 = x1[2] * cb[0] - x2[2] * cb[1], o13 = x1[3] * cb[2] - x2[3] * cb[3];
                    const float o20 = x2[0] * ca[0] + x1[0] * ca[1], o21 = x2[1] * ca[2] + x1[1] * ca[3], o22 = x2[2] * cb[0] + x1[2] * cb[1], o23 = x2[3] * cb[2] + x1[3] * cb[3];
                    uint2 w1, w2; w1.x = pk_bf16(o10, o11); w1.y = pk_bf16(o12, o13); w2.x = pk_bf16(o20, o21); w2.y = pk_bf16(o22, o23);
                    const int b = t >> 11, s = t & 2047;
                    bf16_t* kp = Kc + (((size_t)b * NH) * SEQ + s) * QKD + 64 + fq * 4;
#pragma unroll 1
                    for (int h = 0; h < NH; ++h) { *(uint2*)kp = w1; *(uint2*)(kp + 16) = w2; kp += (size_t)SEQ * QKD; }
                EPI_ROWS_END
            }
        }
    }
};
struct EpiQ {
    bf16_t* Q; const float* rsqp; const float2* rope;
    __device__ __forceinline__ void operator()(const Acc& acc, const Unit& un, int wr, int wc, int fr, int fq) const {
        EPI_ROWS_BEGIN
            const int t = un.pm * 256 + rloc, b = t >> 11, s = t & 2047;
            const f32x4 pp = *(const f32x4*)(rsqp + (size_t)t * 4);
            const float rs = rsqrtf((pp[0] + pp[1] + pp[2] + pp[3]) * (1.0f / 256) + EPS);
            if (un.pn < 2) {
#pragma unroll
                for (int bj = 0; bj < 2; ++bj) { const int col = un.pn * 256 + bj * 128 + wc * 32 + fq * 8;
                    *(u32x4*)(Q + (((size_t)b * NH + (col >> 6)) * SEQ + s) * QKD + (col & 63)) = pack8(acc[ai][bj][m][0] * rs, acc[ai][bj][m][1] * rs); }
            } else {
                const f32x4 ca = *(const f32x4*)(rope + (size_t)t * 16 + fq * 4), cb = *(const f32x4*)(rope + (size_t)t * 16 + fq * 4 + 2);
#pragma unroll
                for (int bj = 0; bj < 2; ++bj) { const f32x4 x1 = acc[ai][bj][m][0] * rs, x2 = acc[ai][bj][m][1] * rs;
                    const float o10 = x1[0] * ca[0] - x2[0] * ca[1], o11 = x1[1] * ca[2] - x2[1] * ca[3], o12 = x1[2] * cb[0] - x2[2] * cb[1], o13 = x1[3] * cb[2] - x2[3] * cb[3];
                    const float o20 = x2[0] * ca[0] + x1[0] * ca[1], o21 = x2[1] * ca[2] + x1[1] * ca[3], o22 = x2[2] * cb[0] + x1[2] * cb[1], o23 = x2[3] * cb[2] + x1[3] * cb[3];
                    uint2 w1, w2; w1.x = pk_bf16(o10, o11); w1.y = pk_bf16(o12, o13); w2.x = pk_bf16(o20, o21); w2.y = pk_bf16(o22, o23);
                    bf16_t* qp = Q + (((size_t)b * NH + (bj * 4 + wc)) * SEQ + s) * QKD + 64 + fq * 4; *(uint2*)qp = w1; *(uint2*)(qp + 16) = w2; }
            }
        EPI_ROWS_END
    }
};
struct EpiKV {
    bf16_t* Kc; bf16_t* V; const float* rskvp;
    __device__ __forceinline__ void operator()(const Acc& acc, const Unit& un, int wr, int wc, int fr, int fq) const {
        EPI_ROWS_BEGIN
            const int t = un.pm * 256 + rloc, b = t >> 11, s = t & 2047;
            const f32x4 pp = *(const f32x4*)(rskvp + (size_t)t * 4);
            const float rs = rsqrtf((pp[0] + pp[1] + pp[2] + pp[3]) * (1.0f / 128) + EPS);
#pragma unroll
            for (int bj = 0; bj < 2; ++bj) { const int col = (un.pn & 1) * 256 + bj * 128 + wc * 32 + fq * 8;
                const u32x4 w = pack8(acc[ai][bj][m][0] * rs, acc[ai][bj][m][1] * rs);
                if (un.pn < 2) *(u32x4*)(Kc + (((size_t)b * NH + (col >> 6)) * SEQ + s) * QKD + (col & 63)) = w;
                else *(u32x4*)(V + (((size_t)b * NH + (col >> 6)) * SEQ + s) * VD + (col & 63)) = w; }
        EPI_ROWS_END
    }
};
struct EpiS5b {
    float* xloc;
    __device__ __forceinline__ void operator()(const Acc& acc, const Unit& un, int wr, int wc, int fr, int fq) const {
        EPI_ROWS_BEGIN
            float* o = xloc + ((size_t)un.e * 512 + un.pm * 256 + rloc) * 128 + wc * 32 + fq * 8;
            *(f32x4*)o = acc[ai][0][m][0]; *(f32x4*)(o + 4) = acc[ai][0][m][1];
        EPI_ROWS_END
    }
};
template <int MODE> struct EpiS5y {
    bf16_t* dst; const bf16_t* yintra;
    __device__ __forceinline__ void operator()(const Acc& acc, const Unit& un, int wr, int wc, int fr, int fq) const {
        EPI_ROWS_BEGIN
            const int row = un.pm * 256 + rloc, b = row >> 5, j = row & 31;
#pragma unroll
            for (int bj = 0; bj < 2; ++bj) { const int n = un.pn * 256 + bj * 128 + wc * 32 + fq * 8, tt = n >> 4, c0 = n & 15;
                const size_t o = ((size_t)b * SEQ + j * CH + tt) * SSMW + un.e * SC + c0;
                f32x4 v0 = acc[ai][bj][m][0], v1 = acc[ai][bj][m][1];
                if (MODE == 1) { const bf16x8 yi = *(const bf16x8*)(yintra + o);
#pragma unroll
                    for (int q = 0; q < 4; ++q) { v0[q] = gelu_tanh(v0[q] + bf2f((bf16_t)yi[q])); v1[q] = gelu_tanh(v1[q] + bf2f((bf16_t)yi[4 + q])); } }
                *(u32x4*)(dst + o) = pack8(v0, v1); }
        EPI_ROWS_END
    }
};
struct EpiGlu {
    const bf16_t* Y; const float* bglu; bf16_t* AS;
    __device__ __forceinline__ void operator()(const Acc& acc, const Unit& un, int wr, int wc, int fr, int fq) const {
        EPI_ROWS_BEGIN
            const int t = un.pm * 256 + rloc;
#pragma unroll
            for (int bj = 0; bj < 2; ++bj) { const int col = un.pn * 256 + bj * 128 + wc * 32 + fq * 8;
                const bf16x8 yv = *(const bf16x8*)(Y + (size_t)t * 512 + col);
                const f32x4 b0 = *(const f32x4*)(bglu + col), b1 = *(const f32x4*)(bglu + col + 4);
                f32x4 v0 = acc[ai][bj][m][0], v1 = acc[ai][bj][m][1];
#pragma unroll
                for (int q = 0; q < 4; ++q) { v0[q] = bf2f((bf16_t)yv[q]) * sigmoidf_(v0[q] + b0[q]); v1[q] = bf2f((bf16_t)yv[4 + q]) * sigmoidf_(v1[q] + b1[q]); }
                *(u32x4*)(AS + (size_t)t * 1024 + 512 + col) = pack8(v0, v1); }
        EPI_ROWS_END
    }
};
struct EpiWo {
    const float* x; const float* xstat; const float* g; const float* bt; float* pre1;
    __device__ __forceinline__ void operator()(const Acc& acc, const Unit& un, int wr, int wc, int fr, int fq) const {
        EPI_ROWS_BEGIN
            const int t = un.pm * 256 + rloc;
            const float mu = xstat[2 * t], rstd = xstat[2 * t + 1];
#pragma unroll
            for (int bj = 0; bj < 2; ++bj) { const int col = un.pn * 256 + bj * 128 + wc * 32 + fq * 8;
#pragma unroll
                for (int n = 0; n < 2; ++n) { const f32x4 xv = *(const f32x4*)(x + (size_t)t * D + col + 4 * n), gg = *(const f32x4*)(g + col + 4 * n), bb = *(const f32x4*)(bt + col + 4 * n);
                    f32x4 o;
#pragma unroll
                    for (int q = 0; q < 4; ++q) o[q] = acc[ai][bj][m][n][q] + ALPHA * ((xv[q] - mu) * rstd * gg[q] + bb[q]);
                    *(f32x4*)(pre1 + (size_t)t * D + col + 4 * n) = o; } }
        EPI_ROWS_END
    }
};
struct EpiGU {
    bf16_t* H; const float* roww; const int* eoff;
    __device__ __forceinline__ void operator()(const Acc& acc, const Unit& un, int wr, int wc, int fr, int fq) const {
        const int nrt = eoff[64] >> 8;
        const bool shared = un.e == 64;
        const int row0 = shared ? SH_ROW0 + (un.pm - nrt) * 256 : un.pm * 256;
        EPI_ROWS_BEGIN
            const int row = row0 + rloc;
            const float w = shared ? 1.0f : roww[row];
            const f32x4 g0 = acc[ai][0][m][0], g1 = acc[ai][0][m][1], u0 = acc[ai][1][m][0], u1 = acc[ai][1][m][1];
            f32x4 h0, h1;
#pragma unroll
            for (int q = 0; q < 4; ++q) { h0[q] = g0[q] * sigmoidf_(g0[q]) * u0[q] * w; h1[q] = g1[q] * sigmoidf_(g1[q]) * u1[q] * w; }
            *(u32x4*)(H + (size_t)row * FF + un.pn * 128 + wc * 32 + fq * 8) = pack8(h0, h1);
        EPI_ROWS_END
    }
};
struct EpiDown {
    unsigned char* yslot; float* out; const bf16_t* x1; const int* rowtok; const int* eoff;
    __device__ __forceinline__ void operator()(const Acc& acc, const Unit& un, int wr, int wc, int fr, int fq) const {
        const int nrt = eoff[64] >> 8;
        if (un.e < 64) {
            EPI_ROWS_BEGIN
                const int slot = rowtok[un.pm * 256 + rloc];
                if (slot >= 0) {
#pragma unroll
                    for (int bj = 0; bj < 2; ++bj) { const int col = un.pn * 256 + bj * 128 + wc * 32 + fq * 8;
                        const f32x4 v0 = acc[ai][bj][m][0] * SLOT_SCALE, v1 = acc[ai][bj][m][1] * SLOT_SCALE;
                        int p0 = __builtin_amdgcn_cvt_pk_fp8_f32(v0[0], v0[1], 0, false); p0 = __builtin_amdgcn_cvt_pk_fp8_f32(v0[2], v0[3], p0, true);
                        int p1 = __builtin_amdgcn_cvt_pk_fp8_f32(v1[0], v1[1], 0, false); p1 = __builtin_amdgcn_cvt_pk_fp8_f32(v1[2], v1[3], p1, true);
                        uint2 w; w.x = (unsigned)p0; w.y = (unsigned)p1;
                        *(uint2*)(yslot + (size_t)slot * D + col) = w; }
                }
            EPI_ROWS_END
        } else {
            EPI_ROWS_BEGIN
                const int t = (un.pm - nrt) * 256 + rloc;
#pragma unroll
                for (int bj = 0; bj < 2; ++bj) { const int col = un.pn * 256 + bj * 128 + wc * 32 + fq * 8;
                    const bf16x8 xv = *(const bf16x8*)(x1 + (size_t)t * D + col);
                    f32x4 o0, o1;
#pragma unroll
                    for (int q = 0; q < 4; ++q) { o0[q] = acc[ai][bj][m][0][q] + ALPHA * bf2f((bf16_t)xv[q]); o1[q] = acc[ai][bj][m][1][q] + ALPHA * bf2f((bf16_t)xv[4 + q]); }
                    *(f32x4*)(out + (size_t)t * D + col) = o0; *(f32x4*)(out + (size_t)t * D + col + 4) = o1; }
            EPI_ROWS_END
        }
    }
};
}
__device__ __forceinline__ void fp_gemm_win(const Ptrs& P, LAS unsigned char* lds) {
    g8::Geo g{2048, 2048, 128, 128, 0};
    g8::SchedReg S{(const char*)WSP(bf16_t, WS_XN), (const char*)WSP(bf16_t, WS_WIN), 2048, 2048, T / 256, 4, 16};
    g8::EpiWin E{WSP(bf16_t, WS_CQ), WSP(bf16_t, WS_CKV), WSP(bf16_t, WS_U), WSP(bf16_t, WS_K), WSP(float2, WS_ROPE), WSP(float, WS_RSQ), WSP(float, WS_RSKV)};
    g8::gemm_body<g8::EpiWin, g8::SchedReg, false>(lds, g, S, E);
}
__device__ __forceinline__ void fp_gemm_q(const Ptrs& P, LAS unsigned char* lds) {
    g8::Geo g{512, 512, 128, 128, 0};
    g8::SchedReg S{(const char*)WSP(bf16_t, WS_CQ), (const char*)WSP(bf16_t, WS_WUQ), 512, 512, T / 256, 3, 4};
    g8::EpiQ E{WSP(bf16_t, WS_Q), WSP(float, WS_RSQ), WSP(float2, WS_ROPE)};
    g8::gemm_body<g8::EpiQ, g8::SchedReg, false>(lds, g, S, E);
}
__device__ __forceinline__ void fp_gemm_kv(const Ptrs& P, LAS unsigned char* lds) {
    g8::Geo g{512, 512, 128, 128, 0};
    g8::SchedReg S{(const char*)WSP(bf16_t, WS_CKV), (const char*)WSP(bf16_t, WS_WUKV), 512, 512, T / 256, 4, 4};
    g8::EpiKV E{WSP(bf16_t, WS_K), WSP(bf16_t, WS_V), WSP(float, WS_RSKV)};
    g8::gemm_body<g8::EpiKV, g8::SchedReg, false>(lds, g, S, E);
}
__device__ __forceinline__ void fp_gemm_s5b(const Ptrs& P, LAS unsigned char* lds) {
    g8::Geo g{2048, 2048, 128, 128, 0};
    g8::SchedS5 S{(const char*)WSP(bf16_t, WS_U), (const char*)WSP(bf16_t, WS_BLOC), 2048, 2048, 1, 16, (size_t)512 * 2048, (size_t)256 * 2048, 0};
    g8::EpiS5b E{WSP(float, WS_XLOC)};
    g8::gemm_body<g8::EpiS5b, g8::SchedS5, false>(lds, g, S, E);
}
__device__ __forceinline__ void fp_gemm_s5a(const Ptrs& P, LAS unsigned char* lds) {
    g8::Geo g{2048, 32, 128, -2048, 1};
    g8::SchedS5 S{(const char*)WSP(bf16_t, WS_U), (const char*)WSP(bf16_t, WS_KTAB), 2048, 32, 4, 16, (size_t)512 * 2048, 0, 1};
    g8::EpiS5y<0> E{WSP(bf16_t, WS_YINTRA), nullptr};
    g8::gemm_body<g8::EpiS5y<0>, g8::SchedS5, false>(lds, g, S, E);
}
__device__ __forceinline__ void fp_gemm_s5d(const Ptrs& P, LAS unsigned char* lds) {
    g8::Geo g{512, 512, 128, 128, 0};
    g8::SchedS5 S{(const char*)WSP(bf16_t, WS_XPREV), (const char*)WSP(bf16_t, WS_CLAM), 512, 512, 4, 4, (size_t)512 * 512, (size_t)1024 * 512, 0};
    g8::EpiS5y<1> E{WSP(bf16_t, WS_Y), WSP(bf16_t, WS_YINTRA)};
    g8::gemm_body<g8::EpiS5y<1>, g8::SchedS5, false>(lds, g, S, E);
}
__device__ __forceinline__ void fp_gemm_glu(const Ptrs& P, LAS unsigned char* lds) {
    g8::Geo g{1024, 1024, 128, 128, 0};
    g8::SchedReg S{(const char*)WSP(bf16_t, WS_Y), (const char*)WSP(bf16_t, WS_WGLU), 1024, 1024, T / 256, 2, 8};
    g8::EpiGlu E{WSP(bf16_t, WS_Y), P.b_glu, WSP(bf16_t, WS_AS)};
    g8::gemm_body<g8::EpiGlu, g8::SchedReg, false>(lds, g, S, E);
}
__device__ __forceinline__ void fp_gemm_wo(const Ptrs& P, LAS unsigned char* lds) {
    g8::Geo g{2048, 2048, 128, 128, 0};
    g8::SchedReg S{(const char*)WSP(bf16_t, WS_AS), (const char*)WSP(bf16_t, WS_WO), 2048, 2048, T / 256, 4, 16};
    g8::EpiWo E{P.x, WSP(float, WS_XSTAT), P.ln_in_g, P.ln_in_b, P.out};
    g8::gemm_body<g8::EpiWo, g8::SchedReg, false>(lds, g, S, E);
}
__device__ __forceinline__ void fp_gemm_gu(const Ptrs& P, LAS unsigned char* lds) {
    g8::Geo g{2048, 2048, 128, 128, 0};
    g8::SchedMoe S{(const char*)WSP(bf16_t, WS_X1), (const char*)WSP(bf16_t, WS_WGU), WSP(int, WS_EOFF), WSP(int, WS_ROWTOK), 2048, 2, 16, (size_t)512 * 2048, 2048, 1};
    g8::EpiGU E{WSP(bf16_t, WS_H), WSP(float, WS_ROWW), WSP(int, WS_EOFF)};
    g8::gemm_body<g8::EpiGU, g8::SchedMoe, true>(lds, g, S, E);
}
__device__ __forceinline__ void fp_gemm_down(const Ptrs& P, LAS unsigned char* lds) {
    g8::Geo g{512, 512, 128, 128, 0};
    g8::SchedMoe S{(const char*)WSP(bf16_t, WS_H), (const char*)WSP(bf16_t, WS_WD), WSP(int, WS_EOFF), WSP(int, WS_ROWTOK), 512, 4, 4, (size_t)1024 * 512, 512, 0};
    g8::EpiDown E{WSP(unsigned char, WS_YSLOT), P.out, WSP(bf16_t, WS_X1), WSP(int, WS_ROWTOK), WSP(int, WS_EOFF)};
    g8::gemm_body<g8::EpiDown, g8::SchedMoe, false>(lds, g, S, E);
}
namespace at8 {
typedef short s16x4 __attribute__((ext_vector_type(4)));
typedef short v4i16_t __attribute__((ext_vector_type(4)));
constexpr int KSLOT = 12288, VSLOT = 8192, NSLOT = 3;
constexpr int L_K = 0, L_V = NSLOT * KSLOT, L_WS = L_V + NSLOT * VSLOT, L_OST = L_WS + 8 * 256, L_END = L_OST + 8 * 4096;
__device__ __forceinline__ int crow(int r, int hi) { return (r & 3) + 8 * (r >> 2) + 4 * hi; }
__device__ __forceinline__ void glds16(const void* gsrc, LAS unsigned char* dst) { __builtin_amdgcn_global_load_lds((const unsigned*)gsrc, (LAS unsigned*)dst, 16, 0, 0); }
__device__ __forceinline__ s16x4 vtr(const LAS unsigned char* p) { return __builtin_bit_cast(s16x4, __builtin_amdgcn_ds_read_tr16_b64_v4i16((LAS v4i16_t*)p)); }
__device__ __forceinline__ unsigned cvtpk(float lo, float hi) { return (unsigned)f2bf(lo) | ((unsigned)f2bf(hi) << 16); }

__device__ __forceinline__ void attn_unit(int b, int h, int qb, const bf16_t* __restrict__ Q, const bf16_t* __restrict__ Kc, const bf16_t* __restrict__ V, bf16_t* __restrict__ AS, LAS unsigned char* lds) {
    const int tid = opaque_tid(), lane = tid & 63, r32 = lane & 31, hi = lane >> 5;
    const int wid = __builtin_amdgcn_readfirstlane(tid >> 6);
    const size_t bh = (size_t)b * NH + h;
    const bf16_t* Kbh = Kc + bh * SEQ * QKD; const bf16_t* Vbh = V + bh * SEQ * VD;
    const int q0 = qb * 256 + wid * 32;
    const int NT = 4 * (qb + 1);
    const int myNT = 4 * qb + (wid >> 1) + 1;
    const bf16_t* ksrc0 = Kbh + (size_t)lane * QKD + wid * 8;
    const bf16_t* ksrc1 = Kbh + (size_t)lane * QKD + (8 + (wid & 3)) * 8;
    const bf16_t* vsrc = Vbh + (size_t)(16 * (wid & 3) + (lane >> 2)) * VD + (wid >> 2) * 32 + (lane & 3) * 8;
#define AT_DMA(t, slot) do { glds16(ksrc0 + (size_t)(t) * 64 * QKD, lds + L_K + (slot) * KSLOT + wid * 1024); \
                             glds16(ksrc1 + (size_t)(t) * 64 * QKD, lds + L_K + (slot) * KSLOT + (8 + (wid & 3)) * 1024); \
                             glds16(vsrc + (size_t)(t) * 64 * VD, lds + L_V + (slot) * VSLOT + wid * 1024); } while (0)
    AT_DMA(0, 0);
    if (NT > 1) AT_DMA(1, 1);
    bf16x8 qr[6];
    const bf16_t* qp = Q + (bh * SEQ + q0 + r32) * QKD + hi * 8;
#pragma unroll
    for (int ks = 0; ks < 6; ++ks) qr[ks] = *(const bf16x8*)(qp + ks * 16);
    f32x16 o0, o1;
#pragma unroll
    for (int i = 0; i < 16; ++i) { o0[i] = 0.f; o1[i] = 0.f; }
    float m_run = -1e30f, l_run = 0.f;
    LAS float* wsf = (LAS float*)(lds + L_WS) + wid * 64;
    const LAS unsigned char* kp0 = lds + L_K + hi * 1024 + r32 * 16;
    const LAS unsigned char* vp0 = lds + L_V + ((lane >> 4) & 1) * 32 + (lane & 3) * 8 + (4 * hi + ((lane & 15) >> 2)) * 64;
    int slot = 0;
    for (int t = 0; t < NT; ++t) {
        if (t + 1 < NT) asm volatile("s_waitcnt vmcnt(3)" ::: "memory"); else asm volatile("s_waitcnt vmcnt(0)" ::: "memory");
        asm volatile("s_waitcnt lgkmcnt(0)\n\ts_barrier" ::: "memory");
        if (t + 2 < NT) { const int s2 = (slot == 0) ? 2 : slot - 1; AT_DMA(t + 2, s2); }
        if (t < myNT) {
            const LAS unsigned char* kp = kp0 + slot * KSLOT; const LAS unsigned char* vp = vp0 + slot * VSLOT;
            f32x16 p0, p1;
#pragma unroll
            for (int i = 0; i < 16; ++i) { p0[i] = 0.f; p1[i] = 0.f; }
#pragma unroll
            for (int ks = 0; ks < 6; ++ks) {
                const bf16x8 a0 = *(const LAS bf16x8*)(kp + ks * 2048), a1 = *(const LAS bf16x8*)(kp + ks * 2048 + 512);
                p0 = __builtin_amdgcn_mfma_f32_32x32x16_bf16(a0, qr[ks], p0, 0, 0, 0);
                p1 = __builtin_amdgcn_mfma_f32_32x32x16_bf16(a1, qr[ks], p1, 0, 0, 0);
            }
            float rm = fmaxf(p0[0], p1[0]);
#pragma unroll
            for (int i = 1; i < 16; ++i) rm = fmaxf(rm, fmaxf(p0[i], p1[i]));
            { auto rr = __builtin_amdgcn_permlane32_swap(__float_as_uint(rm), __float_as_uint(rm), false, false); rm = fmaxf(__uint_as_float(rr[0]), __uint_as_float(rr[1])); }
            if (__any(rm > m_run + 8.0f)) {
                const float m_new = fmaxf(m_run, rm);
                const float alpha = __builtin_amdgcn_exp2f(m_run - m_new);
                l_run *= alpha; m_run = m_new;
                if (hi == 0) wsf[r32] = alpha;
                asm volatile("s_waitcnt lgkmcnt(0)" ::: "memory");
#pragma unroll
                for (int i = 0; i < 16; ++i) { const float a = wsf[crow(i, hi)]; o0[i] *= a; o1[i] *= a; }
            }
            float ls = 0.f;
#pragma unroll
            for (int i = 0; i < 16; ++i) { p0[i] = __builtin_amdgcn_exp2f(p0[i] - m_run); p1[i] = __builtin_amdgcn_exp2f(p1[i] - m_run); ls += p0[i] + p1[i]; }
            l_run += ls;
            u32x4 w0, w1, w2, w3;
            w0 = (u32x4){cvtpk(p0[0], p0[1]), cvtpk(p0[2], p0[3]), cvtpk(p0[4], p0[5]), cvtpk(p0[6], p0[7])};
            w1 = (u32x4){cvtpk(p0[8], p0[9]), cvtpk(p0[10], p0[11]), cvtpk(p0[12], p0[13]), cvtpk(p0[14], p0[15])};
            w2 = (u32x4){cvtpk(p1[0], p1[1]), cvtpk(p1[2], p1[3]), cvtpk(p1[4], p1[5]), cvtpk(p1[6], p1[7])};
            w3 = (u32x4){cvtpk(p1[8], p1[9]), cvtpk(p1[10], p1[11]), cvtpk(p1[12], p1[13]), cvtpk(p1[14], p1[15])};
            const bf16x8 pa[4] = {__builtin_bit_cast(bf16x8, w0), __builtin_bit_cast(bf16x8, w1), __builtin_bit_cast(bf16x8, w2), __builtin_bit_cast(bf16x8, w3)};
#pragma unroll
            for (int k = 0; k < 4; ++k) {
                const s16x4 l0 = vtr(vp + k * 1024), h0 = vtr(vp + k * 1024 + 512), l1 = vtr(vp + 4096 + k * 1024), h1 = vtr(vp + 4096 + k * 1024 + 512);
                const bf16x8 v0 = (bf16x8){l0[0], l0[1], l0[2], l0[3], h0[0], h0[1], h0[2], h0[3]};
                const bf16x8 v1 = (bf16x8){l1[0], l1[1], l1[2], l1[3], h1[0], h1[1], h1[2], h1[3]};
                o0 = __builtin_amdgcn_mfma_f32_32x32x16_bf16(pa[k], v0, o0, 0, 0, 0);
                o1 = __builtin_amdgcn_mfma_f32_32x32x16_bf16(pa[k], v1, o1, 0, 0, 0);
            }
        }
        slot = (slot == 2) ? 0 : slot + 1;
    }
    { auto rr = __builtin_amdgcn_permlane32_swap(__float_as_uint(l_run), __float_as_uint(l_run), false, false); l_run = __uint_as_float(rr[0]) + __uint_as_float(rr[1]); }
    if (hi == 0) wsf[32 + r32] = l_run;
    asm volatile("s_waitcnt lgkmcnt(0)" ::: "memory");
    LAS bf16_t* stg = (LAS bf16_t*)(lds + L_OST) + wid * 2048;
#pragma unroll
    for (int i = 0; i < 16; ++i) { const int orow = crow(i, hi); const float rl = 1.0f / wsf[32 + orow];
        stg[orow * 64 + r32] = f2bf(o0[i] * rl); stg[orow * 64 + 32 + r32] = f2bf(o1[i] * rl); }
    asm volatile("s_waitcnt lgkmcnt(0)" ::: "memory");
    bf16_t* Ow = AS + ((size_t)b * SEQ + q0) * 1024 + h * 64;
#pragma unroll
    for (int i = 0; i < 4; ++i) { const int row = i * 8 + (lane >> 3), ch = lane & 7; const u32x4 v = *(const LAS u32x4*)(stg + row * 64 + ch * 8); *(u32x4*)(Ow + (size_t)row * 1024 + ch * 8) = v; }
    asm volatile("s_waitcnt lgkmcnt(0)\n\ts_barrier" ::: "memory");
#undef AT_DMA
}
__device__ __forceinline__ void attn_phase(const Ptrs& P, LAS unsigned char* lds, int bid, int nb) {
    const bf16_t* Q = WSP(bf16_t, WS_Q); const bf16_t* Kc = WSP(bf16_t, WS_K); const bf16_t* V = WSP(bf16_t, WS_V); bf16_t* AS = WSP(bf16_t, WS_AS);
    const int vcu = ((nb & 7) == 0) ? (bid & 7) * (nb >> 3) + (bid >> 3) : bid;
    for (int p = vcu; p < 512; p += nb) {
        const int bh = p >> 2, s = p & 3;
        attn_unit(bh >> 3, bh & 7, 7 - s, Q, Kc, V, AS, lds);
        attn_unit(bh >> 3, bh & 7, s, Q, Kc, V, AS, lds);
    }
}
}
__global__ void __launch_bounds__(NTHR, 2) mega(Args a) {
    extern __shared__ __attribute__((aligned(16))) unsigned char lds_raw[];
    LAS unsigned char* lds = (LAS unsigned char*)lds_raw;
    Ptrs P;
    P.x = (const float*)a.in[0]; P.positions = (const int*)a.in[1]; P.ln_in_g = (const float*)a.in[2]; P.ln_in_b = (const float*)a.in[3];
    P.w_in = (const float*)a.in[4]; P.q_norm_g = (const float*)a.in[5]; P.kv_norm_g = (const float*)a.in[6]; P.w_uq = (const float*)a.in[7]; P.w_ukv = (const float*)a.in[8];
    P.lambda_re = (const float*)a.in[9]; P.lambda_im = (const float*)a.in[10]; P.log_step = (const float*)a.in[11]; P.b_re = (const float*)a.in[12]; P.b_im = (const float*)a.in[13];
    P.c_re = (const float*)a.in[14]; P.c_im = (const float*)a.in[15]; P.d_skip = (const float*)a.in[16]; P.w_glu = (const float*)a.in[17]; P.b_glu = (const float*)a.in[18];
    P.attn_out_g = (const float*)a.in[19]; P.ssm_out_g = (const float*)a.in[20]; P.w_o = (const float*)a.in[21]; P.ln1_g = (const float*)a.in[22]; P.ln1_b = (const float*)a.in[23];
    P.w_router = (const float*)a.in[24]; P.router_bias = (const float*)a.in[25]; P.w_gate = (const float*)a.in[26]; P.w_up = (const float*)a.in[27]; P.w_down = (const float*)a.in[28];
    P.ws_gate = (const float*)a.in[29]; P.ws_up = (const float*)a.in[30]; P.ws_down = (const float*)a.in[31]; P.ln2_g = (const float*)a.in[32]; P.ln2_b = (const float*)a.in[33];
    P.out = a.out; P.ws = a.ws;
    const int bid = blockIdx.x, nb = gridDim.x;
    volatile LAS unsigned* misc = (volatile LAS unsigned*)(lds + LDS_MISC);
    if (threadIdx.x < 64) misc[threadIdx.x] = 0u;
    __syncthreads();
    XcdBarrier bar = xcd_barrier_post((unsigned*)(P.ws + WS_CTL) + 4096, misc);
#define GRID_BAR() xcd_barrier(bar)

    ph_ln_in(P, bid, nb); ph_wprep(P, lds, bid, nb); ph_s5tab1(P, bid, nb); ph_ropetab(P, bid, nb);
    GRID_BAR();
    ph_s5tab2(P, bid, nb);
#if FAST_WIN
    fp_gemm_win(P, lds);
    GRID_BAR();
#else
    ph_gemm_win(P, bid, nb);
    GRID_BAR();
    ph_rstat(P, bid, nb);
    GRID_BAR();
#endif
#if FAST_QKV
    fp_gemm_q(P, lds); fp_gemm_kv(P, lds);
#else
    ph_gemm_q(P, bid, nb); ph_gemm_kv(P, bid, nb);
#endif
#if FAST_S5
    fp_gemm_s5b(P, lds); fp_gemm_s5a(P, lds);
#else
    ph_gemm_s5b(P, bid, nb); ph_gemm_s5a(P, bid, nb);
#endif
    GRID_BAR();
#if !FAST_QKV || !FAST_WIN
    ph_rope_apply(P, bid, nb);
#endif
    ph_s5scan(P, bid, nb);
#if !FAST_QKV || !FAST_WIN
    GRID_BAR();
#endif
#if FAST_ATTN
    at8::attn_phase(P, lds, bid, nb);
#else
    ph_attn_simple(P, lds, bid, nb);
#endif
    GRID_BAR();
#if FAST_S5
    fp_gemm_s5d(P, lds);
#else
    ph_gemm_s5d(P, bid, nb);
#endif
    GRID_BAR();
#if FAST_GLU
    fp_gemm_glu(P, lds);
#else
    ph_gemm_glu(P, bid, nb);
#endif
    GRID_BAR();
    ph_asnorm(P, bid, nb);
    GRID_BAR();
#if FAST_WO
    fp_gemm_wo(P, lds);
#else
    ph_gemm_wo(P, bid, nb);
#endif
    GRID_BAR();
    ph_ln1(P, bid, nb);
    GRID_BAR();
    ph_router(P, bid, nb);
    GRID_BAR();
    ph_topk(P, bid, nb);
    GRID_BAR();
    ph_cnt(P, bid, nb);
    GRID_BAR();
    ph_off(P, lds, bid);
    GRID_BAR();
    ph_lists(P, bid, nb);
    GRID_BAR();
#if FAST_MOE
    fp_gemm_gu(P, lds);
    GRID_BAR();
    fp_gemm_down(P, lds);
#else
    ph_gemm_gu(P, bid, nb);
    GRID_BAR();
    ph_gemm_down(P, bid, nb);
#endif
    GRID_BAR();
    ph_combine(P, bid, nb);
}

extern "C" void kernel_launch(void* const* d_in, const int* in_sizes, int n_in, void* d_out, int out_size, void* d_ws, size_t ws_size, hipStream_t stream) {
    (void)in_sizes; (void)out_size;
    if (ws_size < WS_NEED || n_in != 34) return;
    static int grid = 0;
    if (grid == 0) {
        int dev = 0, cus = 0;
        if (hipGetDevice(&dev) != hipSuccess || hipDeviceGetAttribute(&cus, hipDeviceAttributeMultiprocessorCount, dev) != hipSuccess) { grid = -1; return; }
        if (hipFuncSetAttribute((const void*)mega, hipFuncAttributeMaxDynamicSharedMemorySize, LDS_BYTES) != hipSuccess) { grid = -1; return; }
        int per_cu = 0;
        if (hipOccupancyMaxActiveBlocksPerMultiprocessor(&per_cu, (const void*)mega, NTHR, LDS_BYTES) != hipSuccess || per_cu < 1) { (void)hipGetLastError(); }
        grid = cus;
    }
    if (grid < 0) return;
    (void)hipMemsetAsync((char*)d_ws + WS_CTL, 0, 1 << 20, stream);
    Args a; memset(&a, 0, sizeof(a));
    for (int i = 0; i < 34; ++i) a.in[i] = d_in[i];
    a.out = (float*)d_out; a.ws = (unsigned char*)d_ws;
    hipLaunchKernelGGL(mega, dim3(grid), dim3(NTHR), LDS_BYTES, stream, a);
}
```

```cpp
#include <hip/hip_runtime.h>
#include <stdint.h>
#include <string.h>

typedef unsigned short bf16_t;
typedef short bf16x8 __attribute__((ext_vector_type(8)));
typedef float f32x16 __attribute__((ext_vector_type(16)));
typedef float f32x4 __attribute__((ext_vector_type(4)));
typedef unsigned u32x4 __attribute__((ext_vector_type(4)));

#ifndef FAST_WIN
#define FAST_WIN 1
#endif
#ifndef FAST_QKV
#define FAST_QKV 1
#endif
#ifndef FAST_S5
#define FAST_S5 1
#endif
#ifndef FAST_GLU
#define FAST_GLU 1
#endif
#ifndef FAST_WO
#define FAST_WO 1
#endif
#ifndef FAST_ATTN
#define FAST_ATTN 1
#endif
#ifndef FAST_MOE
#define FAST_MOE 1
#endif
constexpr int T = 32768, D = 1024, SEQ = 2048, NB = 16;
constexpr int NH = 8, QKD = 96, VD = 64;
constexpr int QRANK = 256, KVRANK = 128, ROPE = 32;
constexpr int SSMW = 512, SG = 32, SC = 16, SP = 64, CH = 64, NCH = SEQ / CH;
constexpr int NE = 64, TOPK = 8, FF = 256;
constexpr float ALPHA = 1.189207115002721f;
constexpr float EPS = 1e-5f;
constexpr float QSCALE = 0.10206207261596577f * 1.4426950408889634f;
constexpr float SLOT_SCALE = 64.0f;
constexpr int RROUT = 278528;
constexpr int SH_ROW0 = RROUT;
constexpr int RTOT = RROUT + T;

constexpr size_t MiB = 1ull << 20;
constexpr size_t WS_CTL = 0;
constexpr size_t WS_TOPI = 1 * MiB, WS_TOPW = 2 * MiB, WS_ROWTOK = 3 * MiB, WS_ROWW = 4 * MiB + MiB / 2;
constexpr size_t WS_CNT = 6 * MiB, WS_TOFF = 6 * MiB + 65536, WS_EOFF = 6 * MiB + 131072, WS_ECNT = 6 * MiB + 131072 + 1024;
constexpr size_t WS_WD = 7 * MiB;
constexpr size_t WS_X1 = 40 * MiB;
constexpr size_t WS_XN = WS_X1, WS_AS = WS_X1;
constexpr size_t WS_H = 104 * MiB;
constexpr size_t WS_CQ = 104 * MiB, WS_CKV = 120 * MiB, WS_U = 136 * MiB, WS_YINTRA = 168 * MiB, WS_Y = 200 * MiB;
constexpr size_t WS_QRRAW = 200 * MiB;
constexpr size_t WS_XLOC = 232 * MiB, WS_XPREV = 240 * MiB, WS_LOGITS = 248 * MiB, WS_KRRAW = 248 * MiB;
constexpr size_t WS_X1LO = 104 * MiB;
constexpr size_t WS_YSLOT = 256 * MiB;
constexpr size_t WS_WGU = 256 * MiB;
constexpr size_t WS_WIN = 321 * MiB, WS_WO = 323 * MiB, WS_WUQ = 325 * MiB, WS_WUKV = 325 * MiB + MiB / 2, WS_WGLU = 326 * MiB;
constexpr size_t WS_WR = 326 * MiB + MiB / 2;
constexpr size_t WS_BLOC = 327 * MiB, WS_CLAM = 343 * MiB, WS_KTAB = 359 * MiB, WS_LAMPOW = 361 * MiB, WS_BBAR = 363 * MiB;
constexpr size_t WS_ROPE = 364 * MiB, WS_XSTAT = 368 * MiB, WS_RSQ = 368 * MiB + MiB / 2, WS_RSKV = 369 * MiB;
constexpr size_t WS_Q = 370 * MiB, WS_K = 418 * MiB, WS_V = 466 * MiB;
constexpr size_t WS_NEED = 512 * MiB;

__device__ __forceinline__ bf16_t f2bf(float f) { unsigned u = __float_as_uint(f); u += 0x7fffu + ((u >> 16) & 1u); return (bf16_t)(u >> 16); }
__device__ __forceinline__ float bf2f(bf16_t b) { return __uint_as_float(((unsigned)b) << 16); }
__device__ __forceinline__ int crow(int i, int h) { return (i & 3) + 8 * (i >> 2) + 4 * h; }
__device__ __forceinline__ float wave_sum(float v) {
#pragma unroll
    for (int o = 32; o > 0; o >>= 1) v += __shfl_xor(v, o);
    return v;
}
__device__ __forceinline__ float wave_max(float v) {
#pragma unroll
    for (int o = 32; o > 0; o >>= 1) v = fmaxf(v, __shfl_xor(v, o));
    return v;
}
__device__ __forceinline__ float sigmoidf_(float z) { return 1.0f / (1.0f + __expf(-z)); }
__device__ __forceinline__ float gelu_tanh(float y) {
    const float z = 0.7978845608028654f * (y + 0.044715f * y * y * y);
    const float th = 1.0f - 2.0f / (1.0f + __expf(2.0f * z));
    return 0.5f * y * (1.0f + th);
}
__host__ __device__ __forceinline__ int ropeperm(int q) { return 16 * ((q >> 2) & 1) + 4 * (q >> 3) + (q & 3); }
__host__ __device__ __forceinline__ int ropepos(int j) { const int n = j >> 4, r = j & 15; return 8 * (r >> 2) + 4 * n + (r & 3); }

__device__ __forceinline__ void cexp_d(double re, double im, double& ore, double& oim) {
    const double s = 1.0 / 1048576.0;
    const double a = re * s, b = im * s;
    double tr = 1.0, ti = 0.0, sr = 1.0, si = 0.0;
#pragma unroll
    for (int n = 1; n <= 8; ++n) {
        const double nr = (tr * a - ti * b) / n, ni = (tr * b + ti * a) / n;
        tr = nr; ti = ni; sr += tr; si += ti;
    }
#pragma unroll
    for (int i = 0; i < 20; ++i) { const double nr = sr * sr - si * si, ni = 2.0 * sr * si; sr = nr; si = ni; }
    ore = sr; oim = si;
}

__device__ __forceinline__ int opaque_tid() { int t = threadIdx.x; asm volatile("" : "+v"(t)); return t; }
template <bool DUAL, class AF, class BF, class EPI>
__device__ __forceinline__ void sg_tile(int m0, int n0, int K, AF arow, BF bptr, EPI epi) {
    const int tidx = opaque_tid();
    const int lane = tidx & 63, r = lane & 31, h = lane >> 5;
    f32x16 acc, acc2;
#pragma unroll
    for (int i = 0; i < 16; ++i) { acc[i] = 0.f; acc2[i] = 0.f; }
    const bf16_t* ap = arow(m0 + r);
    for (int k0 = 0; k0 < K; k0 += 16) {
        const bf16x8 a = *(const bf16x8*)(ap + k0 + 8 * h);
        const bf16x8 b = *(const bf16x8*)(bptr(n0 + r, k0 + 8 * h, 0));
        acc = __builtin_amdgcn_mfma_f32_32x32x16_bf16(a, b, acc, 0, 0, 0);
        if (DUAL) {
            const bf16x8 b2 = *(const bf16x8*)(bptr(n0 + r, k0 + 8 * h, 1));
            acc2 = __builtin_amdgcn_mfma_f32_32x32x16_bf16(a, b2, acc2, 0, 0, 0);
        }
    }
#pragma unroll
    for (int i = 0; i < 16; ++i) epi(m0 + crow(i, h), n0 + r, acc[i], acc2[i]);
}

#define LAS __attribute__((address_space(3)))
#define XB_TMO      128
#define XB_XCNT(j)  (256  + 64 * (j))
#define XB_XSUB(j)  (1280 + 64 * (j))
#define XB_XGEN(j)  (2304 + 64 * (j))
#define XB_TOP      3328
#define XB_TOPGEN   3392
#define XCD_BAR_WORDS 3456
#define XB_SPIN_CAP (1u << 18)
__device__ __forceinline__ unsigned xb_ld(unsigned* p)              { return __hip_atomic_load(p, __ATOMIC_RELAXED, __HIP_MEMORY_SCOPE_AGENT); }
__device__ __forceinline__ unsigned xb_add(unsigned* p, unsigned v) { return __hip_atomic_fetch_add(p, v, __ATOMIC_RELAXED, __HIP_MEMORY_SCOPE_AGENT); }
__device__ __forceinline__ unsigned xb_xcc_id() { return (unsigned)__builtin_amdgcn_s_getreg((3 << 11) | 20) & 0xFu; }
#define XB_SPIN(cond, bar) do { unsigned _sp = 0; while (cond) { __builtin_amdgcn_s_sleep(1); \
    if ((++_sp & 255u) == 0u) { if (xb_ld(&(bar)[XB_TMO])) break; if (_sp > XB_SPIN_CAP) { atomicAdd(&(bar)[XB_TMO], 1u); break; } } } } while (0)
struct XcdBarrier { unsigned* bar; unsigned x; volatile LAS unsigned* st; };
__device__ __forceinline__ XcdBarrier xcd_barrier_post(unsigned* bar, volatile LAS unsigned* st) {
    XcdBarrier b; b.bar = bar; b.x = xb_xcc_id(); b.st = st;
    if (threadIdx.x == 0) (void)xb_add(&bar[XB_XCNT(b.x)], 1u);
    return b;
}
__device__ __forceinline__ void xcd_barrier_complete(unsigned* bar, unsigned x, unsigned& nloc, unsigned& nx) {
    const unsigned G = gridDim.x * gridDim.y * gridDim.z;
    unsigned sum, cnt, mine, sp = 0u;
    for (;;) {
        sum = 0u; cnt = 0u; mine = 0u;
#pragma unroll
        for (unsigned j = 0; j < 16; ++j) { const unsigned c = xb_ld(&bar[XB_XCNT(j)]); sum += c; cnt += (c > 0u) ? 1u : 0u; mine = (j == x) ? c : mine; }
        if (sum == G) break;
        __builtin_amdgcn_s_sleep(1);
        if ((++sp & 255u) == 0u) { if (xb_ld(&bar[XB_TMO])) break; if (sp > XB_SPIN_CAP) { atomicAdd(&bar[XB_TMO], 1u); break; } }
    }
    nloc = mine > 0u ? mine : 1u; nx = cnt > 0u ? cnt : 1u;
}
__device__ __forceinline__ void xcd_barrier(const XcdBarrier& b) {
    asm volatile("s_waitcnt vmcnt(0)" ::: "memory");
    __syncthreads();
    if (threadIdx.x == 0) {
        unsigned* bar = b.bar;
        __builtin_amdgcn_s_waitcnt(0);
        unsigned nloc = b.st[0], nx = b.st[1];
        if (nloc == 0u) { xcd_barrier_complete(bar, b.x, nloc, nx); b.st[0] = nloc; b.st[1] = nx; }
        const unsigned old = xb_add(&bar[XB_XSUB(b.x)], 1u);
        const unsigned gen = old / nloc;
        if (old + 1u == (gen + 1u) * nloc) {
            __builtin_amdgcn_fence(__ATOMIC_RELEASE, "agent");
            asm volatile("s_waitcnt vmcnt(0)" ::: "memory");
            const unsigned og = xb_add(&bar[XB_TOP], 1u);
            const unsigned tg = og / nx;
            if (og + 1u == (tg + 1u) * nx) xb_add(&bar[XB_TOPGEN], 1u);
            else XB_SPIN(xb_ld(&bar[XB_TOPGEN]) == tg, bar);
            __builtin_amdgcn_fence(__ATOMIC_ACQUIRE, "agent");
            xb_add(&bar[XB_XGEN(b.x)], 1u);
            asm volatile("s_waitcnt vmcnt(0)" ::: "memory");
        } else {
            XB_SPIN(xb_ld(&bar[XB_XGEN(b.x)]) == gen, bar);
            __builtin_amdgcn_fence(__ATOMIC_ACQUIRE, "agent");
            asm volatile("s_waitcnt vmcnt(0)" ::: "memory");
        }
    }
    __syncthreads();
}

constexpr int NTHR = 512, NWAVE = 8;
constexpr int LDS_BYTES = 147456;
constexpr int LDS_MISC = 147456 - 256;
struct Args { const void* in[34]; float* out; unsigned char* ws; };
struct Ptrs {
    const float *x, *ln_in_g, *ln_in_b, *w_in, *q_norm_g, *kv_norm_g, *w_uq, *w_ukv, *lambda_re, *lambda_im, *log_step, *b_re, *b_im, *c_re, *c_im, *d_skip, *w_glu, *b_glu;
    const float *attn_out_g, *ssm_out_g, *w_o, *ln1_g, *ln1_b, *w_router, *router_bias, *w_gate, *w_up, *w_down, *ws_gate, *ws_up, *ws_down, *ln2_g, *ln2_b;
    const int* positions; float* out; unsigned char* ws;
};
#define WSP(T_, off) ((T_*)(P.ws + (off)))

__device__ __forceinline__ void ph_ln_in(const Ptrs& P, int bid, int nb) {
    const int tidx = opaque_tid();
    const int lane = tidx & 63, w = tidx >> 6;
    bf16_t* xn = WSP(bf16_t, WS_XN); float* xstat = WSP(float, WS_XSTAT);
    for (int t = bid * NWAVE + w; t < T; t += nb * NWAVE) {
        const float* xr = P.x + (size_t)t * D;
        float v[16]; float s = 0.f;
#pragma unroll
        for (int i = 0; i < 4; ++i) { const f32x4 q = *(const f32x4*)(xr + i * 256 + lane * 4); v[4 * i] = q[0]; v[4 * i + 1] = q[1]; v[4 * i + 2] = q[2]; v[4 * i + 3] = q[3]; s += q[0] + q[1] + q[2] + q[3]; }
        const float mu = wave_sum(s) * (1.0f / D);
        float ss = 0.f;
#pragma unroll
        for (int i = 0; i < 16; ++i) { const float d = v[i] - mu; ss += d * d; }
        const float rstd = rsqrtf(wave_sum(ss) * (1.0f / D) + EPS);
        if (lane == 0) { xstat[2 * t] = mu; xstat[2 * t + 1] = rstd; }
#pragma unroll
        for (int i = 0; i < 4; ++i) {
            const int c = i * 256 + lane * 4;
            const f32x4 gg = *(const f32x4*)(P.ln_in_g + c), bb = *(const f32x4*)(P.ln_in_b + c);
            ushort4 o;
            o.x = f2bf((v[4 * i] - mu) * rstd * gg[0] + bb[0]); o.y = f2bf((v[4 * i + 1] - mu) * rstd * gg[1] + bb[1]);
            o.z = f2bf((v[4 * i + 2] - mu) * rstd * gg[2] + bb[2]); o.w = f2bf((v[4 * i + 3] - mu) * rstd * gg[3] + bb[3]);
            *(ushort4*)(xn + (size_t)t * D + c) = o;
        }
    }
}
__device__ __forceinline__ int wprep_srccol(int mode, int n, int& which) {
    which = 0;
    switch (mode) {
    case 0: if (n < 256) return n; if (n < 768) return 416 + (n - 256); if (n < 896) return 256 + (n - 768); if (n < 928) return 384 + ropeperm(n - 896); return -1;
    case 1: if (n < 512) return (n >> 6) * 96 + (n & 63); { const int m = n - 512; return (m >> 5) * 96 + 64 + ropeperm(m & 31); }
    case 2: if (n < 512) return (n >> 6) * 128 + (n & 63); { const int m = n - 512; return (m >> 6) * 128 + 64 + (m & 63); }
    case 5: { const int pn = n >> 8, w = n & 255; which = w >> 7; return pn * 128 + (w & 127); }
    case 7: return n < 64 ? n : -1;
    default: return n;
    }
}
__device__ __forceinline__ void wprep_tile(LAS float* tile  , const float* s1, const float* s2, const float* ks, const float* ks2, bf16_t* dst,
                                           int mode, int Kd, int ldsrc, int Ksrc, float kmul, int n0, int k0) {
    const int tidx = opaque_tid();
    const int nn = tidx & 63, w = tidx >> 6;
    {
        int which; const int sc = wprep_srccol(mode, n0 + nn, which);
        const float* s = which ? s2 : s1;
        float v[32];
#pragma unroll
        for (int i = 0; i < 32; ++i) { const int k = k0 + w + 8 * i; v[i] = (sc >= 0 && k < Ksrc) ? s[(size_t)k * ldsrc + sc] : 0.f; }
#pragma unroll
        for (int i = 0; i < 32; ++i) { const int kk = w + 8 * i, k = k0 + kk; float x = v[i];
            if (ks && k < Ksrc) x *= (ks2 && k >= 512) ? ks2[k - 512] : ks[k];
            tile[kk * 65 + nn] = x * kmul; }
    }
    __syncthreads();
#pragma unroll
    for (int i = 0; i < 4; ++i) {
        const int kb = (i * 8 + w) * 8;
        u32x4 o;
#pragma unroll
        for (int j = 0; j < 4; ++j) o[j] = (unsigned)f2bf(tile[(kb + 2 * j) * 65 + nn]) | ((unsigned)f2bf(tile[(kb + 2 * j + 1) * 65 + nn]) << 16);
        *(u32x4*)(dst + (size_t)(n0 + nn) * Kd + k0 + kb) = o;
    }
    __syncthreads();
}
__device__ __forceinline__ void ph_wprep(const Ptrs& P, LAS unsigned char* lds, int bid, int nb) {
    LAS float* tile = (LAS float*)lds;
    constexpr int J0 = 64, J1 = J0 + 12, J2 = J1 + 16, J3 = J2 + 16, J4 = J3 + 64, J4b = J4 + 16, J5 = J4b + 65 * 32, J6 = J5 + 65 * 16;
    for (int j = bid; j < J6; j += nb) {
        if (j < J0)      { const int tl = j;      wprep_tile(tile, P.w_in, nullptr, nullptr, nullptr, WSP(bf16_t, WS_WIN), 0, 1024, 928, 1024, 1.0f, (tl / 4) * 64, (tl % 4) * 256); }
        else if (j < J1) { const int tl = j - J0; wprep_tile(tile, P.w_uq, nullptr, P.q_norm_g, nullptr, WSP(bf16_t, WS_WUQ), 1, 256, 768, 256, QSCALE, tl * 64, 0); }
        else if (j < J2) { const int tl = j - J1; wprep_tile(tile, P.w_ukv, nullptr, P.kv_norm_g, nullptr, WSP(bf16_t, WS_WUKV), 2, 256, 1024, 128, 1.0f, tl * 64, 0); }
        else if (j < J3) { const int tl = j - J2; wprep_tile(tile, P.w_glu, nullptr, nullptr, nullptr, WSP(bf16_t, WS_WGLU), 3, 512, 512, 512, 1.0f, (tl / 2) * 64, (tl % 2) * 256); }
        else if (j < J4) { const int tl = j - J3; wprep_tile(tile, P.w_o, nullptr, P.attn_out_g, P.ssm_out_g, WSP(bf16_t, WS_WO), 4, 1024, 1024, 1024, 1.0f, (tl / 4) * 64, (tl % 4) * 256); }
        else if (j < J4b) { const int tl = j - J4; wprep_tile(tile, P.w_router, nullptr, nullptr, nullptr, WSP(bf16_t, WS_WR), 7, 1024, 64, 1024, 1.0f, (tl / 4) * 64, (tl % 4) * 256); }
        else if (j < J5) { const int q = j - J4b, e = q / 32, tl = q % 32;
            const float* g = e < 64 ? P.w_gate + (size_t)e * 1024 * 256 : P.ws_gate; const float* u = e < 64 ? P.w_up + (size_t)e * 1024 * 256 : P.ws_up;
            wprep_tile(tile, g, u, nullptr, nullptr, WSP(bf16_t, WS_WGU) + (size_t)e * 512 * 1024, 5, 1024, 256, 1024, 1.0f, (tl / 4) * 64, (tl % 4) * 256); }
        else             { const int q = j - J5, e = q / 16, tl = q % 16;
            const float* d = e < 64 ? P.w_down + (size_t)e * 256 * 1024 : P.ws_down;
            wprep_tile(tile, d, nullptr, nullptr, nullptr, WSP(bf16_t, WS_WD) + (size_t)e * 1024 * 256, 6, 256, 1024, 256, 1.0f, tl * 64, 0); }
    }
}
__device__ __forceinline__ void ph_s5tab1(const Ptrs& P, int bid, int nb) {
    const int tidx = opaque_tid();
    float2* lampow = WSP(float2, WS_LAMPOW); float2* bbar = WSP(float2, WS_BBAR);
    for (int i = bid * NTHR + tidx; i < SG * SP; i += nb * NTHR) {
        const int g = i >> 6, p = i & 63;
        double lr = (double)P.lambda_re[g * SP + p]; if (lr > -1e-4) lr = -1e-4;
        const double li = (double)P.lambda_im[g * SP + p];
        double st, dummy; cexp_d((double)P.log_step[g], 0.0, st, dummy);
        double br, bi; cexp_d(lr * st, li * st, br, bi);
        const double nr = br - 1.0, ni = bi, den = lr * lr + li * li;
        const double cr = (nr * lr + ni * li) / den, ci = (ni * lr - nr * li) / den;
        double pr = 1.0, pi = 0.0;
        for (int tau = 0; tau <= 64; ++tau) {
            lampow[(g * SP + p) * 65 + tau] = make_float2((float)pr, (float)pi);
            const double tr = pr * br - pi * bi, ti = pr * bi + pi * br; pr = tr; pi = ti;
        }
        for (int c = 0; c < SC; ++c) {
            const double xr = (double)P.b_re[(g * SP + p) * SC + c], xi = (double)P.b_im[(g * SP + p) * SC + c];
            bbar[(g * SP + p) * SC + c] = make_float2((float)(cr * xr - ci * xi), (float)(cr * xi + ci * xr));
        }
    }
}
__device__ __forceinline__ void ph_s5tab2(const Ptrs& P, int bid, int nb) {
    const int tidx = opaque_tid();
    const float2* lampow = WSP(float2, WS_LAMPOW); const float2* bbar = WSP(float2, WS_BBAR);
    bf16_t* ktab = WSP(bf16_t, WS_KTAB); bf16_t* bloc = WSP(bf16_t, WS_BLOC); bf16_t* clam = WSP(bf16_t, WS_CLAM);
    const float* cre = P.c_re; const float* cim = P.c_im;
    const size_t nk = (size_t)SG * 127 * 256, nbl = (size_t)SG * 256 * 1024, nc = (size_t)SG * 1024 * 256;
    const size_t stride = (size_t)nb * NTHR;
    for (size_t i = (size_t)bid * NTHR + tidx; i < nk + nbl + nc; i += stride) {
        if (i < nk) {
            const int cp = (int)(i & 15), c = (int)((i >> 4) & 15), ti = (int)((i >> 8) % 127), g = (int)((i >> 8) / 127);
            const int tau = ti - 63;
            float v = 0.f;
            if (tau >= 0) {
                for (int p = 0; p < SP; ++p) {
                    const float2 l = lampow[(g * SP + p) * 65 + tau], bb = bbar[(g * SP + p) * SC + cp];
                    const float cr = cre[(g * SC + c) * SP + p], ci = cim[(g * SC + c) * SP + p];
                    const float mr = l.x * bb.x - l.y * bb.y, mi = l.x * bb.y + l.y * bb.x;
                    v += cr * mr - ci * mi;
                }
                if (tau == 0 && c == cp) v += P.d_skip[g * SC + c];
            }
            ktab[i] = f2bf(v);
        } else if (i < nk + nbl) {
            const size_t j = i - nk;
            const int k = (int)(j & 1023), n = (int)((j >> 10) & 255), g = (int)(j >> 18);
            float v = 0.f;
            if (n < 128) {
                const int p = n & 63, s = k >> 4, c = k & 15;
                const float2 l = lampow[(g * SP + p) * 65 + (63 - s)], bb = bbar[(g * SP + p) * SC + c];
                v = (n < 64) ? (l.x * bb.x - l.y * bb.y) : (l.x * bb.y + l.y * bb.x);
            }
            bloc[j] = f2bf(v);
        } else {
            const size_t j = i - nk - nbl;
            const int k = (int)(j & 255), n = (int)((j >> 8) & 1023), g = (int)(j >> 18);
            float v = 0.f;
            if (k < 128) {
                const int p = k & 63, t = n >> 4, c = n & 15;
                const float2 l = lampow[(g * SP + p) * 65 + (t + 1)];
                const float cr = cre[(g * SC + c) * SP + p], ci = cim[(g * SC + c) * SP + p];
                v = (k < 64) ? (cr * l.x - ci * l.y) : -(cr * l.y + ci * l.x);
            }
            clam[j] = f2bf(v);
        }
    }
}
__device__ __forceinline__ void ph_ropetab(const Ptrs& P, int bid, int nb) {
    const int tidx = opaque_tid();
    float2* rope = WSP(float2, WS_ROPE);
    for (int i = bid * NTHR + tidx; i < T * 16; i += nb * NTHR) {
        const int t = i >> 4, j = i & 15;
        double invf, dm; cexp_d(-(double)j / 16.0 * 9.210340371976184, 0.0, invf, dm);
        const float ang = (float)P.positions[t] * (float)invf;
        double c, s; cexp_d(0.0, (double)ang, c, s);
        rope[i] = make_float2((float)c, (float)s);
    }
}

#define GW_LOOP(ntiles) for (int tl = bid * NWAVE + (tidx >> 6); tl < (ntiles); tl += nb * NWAVE)
__device__ __forceinline__ void ph_gemm_win(const Ptrs& P, int bid, int nb) {
    const int tidx = opaque_tid();
    const bf16_t* xn = WSP(bf16_t, WS_XN); const bf16_t* wt = WSP(bf16_t, WS_WIN);
    bf16_t* cq = WSP(bf16_t, WS_CQ); bf16_t* ckv = WSP(bf16_t, WS_CKV); bf16_t* u = WSP(bf16_t, WS_U); float* krraw = WSP(float, WS_KRRAW);
    GW_LOOP((T / 32) * 32) {
        const int m0 = (tl >> 5) * 32, n0 = (tl & 31) * 32;
        sg_tile<false>(m0, n0, D,
            [&](int row) { return xn + (size_t)row * D; },
            [&](int n, int k, int) { return wt + (size_t)n * D + k; },
            [&](int t, int n, float v, float) {
                if (n < 256) cq[(size_t)t * 256 + n] = f2bf(v);
                else if (n < 768) {
                    const int ch = n - 256, g = ch >> 4, c = ch & 15, b = t >> 11, s = t & 2047, j = s >> 6, sl = s & 63;
                    u[((size_t)g * 512 + b * 32 + j) * 1024 + sl * 16 + c] = f2bf(v);
                } else if (n < 896) ckv[(size_t)t * 256 + (n - 768)] = f2bf(v);
                else {
                    ckv[(size_t)t * 256 + (n - 768)] = 0;
                    if (n < 928) krraw[(size_t)t * 32 + ropeperm(n - 896)] = v;
                }
            });
    }
}
__device__ __forceinline__ void ph_rstat(const Ptrs& P, int bid, int nb) {
    const int tidx = opaque_tid();
    const bf16_t* cq = WSP(bf16_t, WS_CQ); const bf16_t* ckv = WSP(bf16_t, WS_CKV); float* rsq = WSP(float, WS_RSQ); float* rskv = WSP(float, WS_RSKV);
    const int lane = tidx & 63, w = tidx >> 6;
    for (int t = bid * NWAVE + w; t < T; t += nb * NWAVE) {
        float s = 0.f, s2 = 0.f;
#pragma unroll
        for (int i = 0; i < 4; ++i) { const float v = bf2f(cq[(size_t)t * 256 + i * 64 + lane]); s += v * v; }
#pragma unroll
        for (int i = 0; i < 2; ++i) { const float v = bf2f(ckv[(size_t)t * 256 + i * 64 + lane]); s2 += v * v; }
        s = wave_sum(s); s2 = wave_sum(s2);
        if (lane == 0) { rsq[t] = rsqrtf(s * (1.0f / 256) + EPS); rskv[t] = rsqrtf(s2 * (1.0f / 128) + EPS); }
    }
}
__device__ __forceinline__ void ph_gemm_q(const Ptrs& P, int bid, int nb) {
    const int tidx = opaque_tid();
    const bf16_t* cq = WSP(bf16_t, WS_CQ); const bf16_t* wt = WSP(bf16_t, WS_WUQ); const float* rsq = WSP(float, WS_RSQ); bf16_t* Q = WSP(bf16_t, WS_Q); float* qrraw = WSP(float, WS_QRRAW);
    GW_LOOP((T / 32) * 24) {
        const int m0 = (tl / 24) * 32, n0 = (tl % 24) * 32;
        sg_tile<false>(m0, n0, 256,
            [&](int row) { return cq + (size_t)row * 256; },
            [&](int n, int k, int) { return wt + (size_t)n * 256 + k; },
            [&](int t, int n, float v, float) {
                v *= rsq[t];
                const int b = t >> 11, s = t & 2047;
                if (n < 512) Q[(((size_t)b * NH + (n >> 6)) * SEQ + s) * QKD + (n & 63)] = f2bf(v);
                else { const int m = n - 512; qrraw[(size_t)t * 256 + (m >> 5) * 32 + ropeperm(m & 31)] = v; }
            });
    }
}
__device__ __forceinline__ void ph_gemm_kv(const Ptrs& P, int bid, int nb) {
    const int tidx = opaque_tid();
    const bf16_t* ckv = WSP(bf16_t, WS_CKV); const bf16_t* wt = WSP(bf16_t, WS_WUKV); const float* rskv = WSP(float, WS_RSKV); bf16_t* Kc = WSP(bf16_t, WS_K); bf16_t* V = WSP(bf16_t, WS_V);
    GW_LOOP((T / 32) * 32) {
        const int m0 = (tl >> 5) * 32, n0 = (tl & 31) * 32;
        sg_tile<false>(m0, n0, 256,
            [&](int row) { return ckv + (size_t)row * 256; },
            [&](int n, int k, int) { return wt + (size_t)n * 256 + k; },
            [&](int t, int n, float v, float) {
                v *= rskv[t];
                const int b = t >> 11, s = t & 2047;
                if (n < 512) Kc[(((size_t)b * NH + (n >> 6)) * SEQ + s) * QKD + (n & 63)] = f2bf(v);
                else { const int m = n - 512; V[(((size_t)b * NH + (m >> 6)) * SEQ + s) * VD + (m & 63)] = f2bf(v); }
            });
    }
}
__device__ __forceinline__ void ph_rope_apply(const Ptrs& P, int bid, int nb) {
    const int tidx = opaque_tid();
    const float* qrraw = WSP(float, WS_QRRAW); const float* krraw = WSP(float, WS_KRRAW); const float2* rope = WSP(float2, WS_ROPE); bf16_t* Q = WSP(bf16_t, WS_Q); bf16_t* Kc = WSP(bf16_t, WS_K);
    for (int i = bid * NTHR + tidx; i < T * 9 * 16; i += nb * NTHR) {
        const int j = i & 15, hh = (i >> 4) % 9, t = (i >> 4) / 9;
        const float2 cs = rope[t * 16 + j];
        const int b = t >> 11, s = t & 2047;
        if (hh < 8) {
            const float x1 = qrraw[(size_t)t * 256 + hh * 32 + j], x2 = qrraw[(size_t)t * 256 + hh * 32 + 16 + j];
            bf16_t* q = Q + (((size_t)b * NH + hh) * SEQ + s) * QKD + 64;
            q[j] = f2bf(x1 * cs.x - x2 * cs.y); q[16 + j] = f2bf(x2 * cs.x + x1 * cs.y);
        } else {
            const float x1 = krraw[(size_t)t * 32 + j], x2 = krraw[(size_t)t * 32 + 16 + j];
            const bf16_t o1 = f2bf(x1 * cs.x - x2 * cs.y), o2 = f2bf(x2 * cs.x + x1 * cs.y);
            for (int h = 0; h < NH; ++h) { bf16_t* k = Kc + (((size_t)b * NH + h) * SEQ + s) * QKD + 64; k[j] = o1; k[16 + j] = o2; }
        }
    }
}
__device__ __forceinline__ void ph_gemm_s5b(const Ptrs& P, int bid, int nb) {
    const int tidx = opaque_tid();
    const bf16_t* u = WSP(bf16_t, WS_U); const bf16_t* bloc = WSP(bf16_t, WS_BLOC); float* xloc = WSP(float, WS_XLOC);
    GW_LOOP(SG * 16 * 4) {
        const int g = tl >> 6, m0 = ((tl >> 2) & 15) * 32, n0 = (tl & 3) * 32;
        sg_tile<false>(m0, n0, 1024,
            [&](int row) { return u + ((size_t)g * 512 + row) * 1024; },
            [&](int n, int k, int) { return bloc + ((size_t)g * 256 + n) * 1024 + k; },
            [&](int row, int n, float v, float) { xloc[((size_t)g * 512 + row) * 128 + n] = v; });
    }
}
__device__ __forceinline__ void ph_gemm_s5a(const Ptrs& P, int bid, int nb) {
    const int tidx = opaque_tid();
    const bf16_t* u = WSP(bf16_t, WS_U); const bf16_t* ktab = WSP(bf16_t, WS_KTAB); bf16_t* yintra = WSP(bf16_t, WS_YINTRA);
    GW_LOOP(SG * 16 * 32) {
        const int g = tl >> 9, m0 = ((tl >> 5) & 15) * 32, n0 = (tl & 31) * 32;
        sg_tile<false>(m0, n0, 1024,
            [&](int row) { return u + ((size_t)g * 512 + row) * 1024; },
            [&](int n, int k, int) { const int t = n >> 4, c = n & 15, s = k >> 4, c0 = k & 15; return ktab + (((size_t)g * 127 + (t - s + 63)) * 16 + c) * 16 + c0; },
            [&](int row, int n, float v, float) {
                const int b = row >> 5, j = row & 31, t = n >> 4, c = n & 15;
                yintra[((size_t)b * SEQ + j * CH + t) * SSMW + g * SC + c] = f2bf(v);
            });
    }
}
__device__ __forceinline__ void ph_attn_simple(const Ptrs& P, LAS unsigned char* lds, int bid, int nb) {
    const int tidx = opaque_tid();
    const bf16_t* Q = WSP(bf16_t, WS_Q); const bf16_t* Kc = WSP(bf16_t, WS_K); const bf16_t* V = WSP(bf16_t, WS_V); bf16_t* AS = WSP(bf16_t, WS_AS);
    const int lane = tidx & 63, w = tidx >> 6;
    LAS float* qs = (LAS float*)lds + w * (QKD + SEQ);
    LAS float* ps = qs + QKD;
    for (int row = bid * NWAVE + w; row < T * NH; row += nb * NWAVE) {
        const int bh = row >> 11, q = row & 2047, b = bh >> 3, h = bh & 7;
        asm volatile("s_waitcnt lgkmcnt(0)" ::: "memory");
        qs[lane] = bf2f(Q[(size_t)row * QKD + lane]);
        if (lane < 32) qs[64 + lane] = bf2f(Q[(size_t)row * QKD + 64 + lane]);
        asm volatile("s_waitcnt lgkmcnt(0)" ::: "memory");
        const int nk = ((q >> 6) + 1) * 64;
        float m = -INFINITY;
        for (int kb = 0; kb < nk; kb += 64) {
            const bf16_t* kp = Kc + ((size_t)bh * SEQ + kb + lane) * QKD;
            float s = 0.f;
#pragma unroll
            for (int c = 0; c < 12; ++c) {
                const bf16x8 kv = *(const bf16x8*)(kp + c * 8);
#pragma unroll
                for (int e = 0; e < 8; ++e) s += qs[c * 8 + e] * bf2f((bf16_t)kv[e]);
            }
            ps[kb + lane] = s; m = fmaxf(m, s);
        }
        m = wave_max(m);
        float l = 0.f;
        for (int kb = 0; kb < nk; kb += 64) { const float p = exp2f(ps[kb + lane] - m); ps[kb + lane] = p; l += p; }
        l = wave_sum(l);
        asm volatile("s_waitcnt lgkmcnt(0)" ::: "memory");
        float o = 0.f;
        const bf16_t* vp = V + (size_t)bh * SEQ * VD + lane;
        for (int k = 0; k < nk; ++k) o += ps[k] * bf2f(vp[(size_t)k * VD]);
        AS[((size_t)b * SEQ + q) * 1024 + h * 64 + lane] = f2bf(o / l);
    }
}
__device__ __forceinline__ void ph_s5scan(const Ptrs& P, int bid, int nb) {
    const int tidx = opaque_tid();
    const float* xloc = WSP(float, WS_XLOC); const float2* lampow = WSP(float2, WS_LAMPOW); bf16_t* xprev = WSP(bf16_t, WS_XPREV);
    for (int i = bid * NTHR + tidx; i < SG * NB * SP; i += nb * NTHR) {
        const int p = i & 63, b = (i >> 6) & 15, g = i >> 10;
        const float2 l64 = lampow[(g * SP + p) * 65 + 64];
        float xr = 0.f, xi = 0.f;
#pragma unroll
        for (int j = 0; j < NCH; ++j) {
            const size_t row = (size_t)g * 512 + b * 32 + j;
            bf16_t* xp = xprev + row * 256;
            xp[p] = f2bf(xr); xp[64 + p] = f2bf(xi); xp[128 + p] = 0; xp[192 + p] = 0;
            const float lr = xloc[row * 128 + p], li = xloc[row * 128 + 64 + p];
            const float nr = l64.x * xr - l64.y * xi + lr, ni = l64.x * xi + l64.y * xr + li;
            xr = nr; xi = ni;
        }
    }
}
__device__ __forceinline__ void ph_gemm_s5d(const Ptrs& P, int bid, int nb) {
    const int tidx = opaque_tid();
    const bf16_t* xprev = WSP(bf16_t, WS_XPREV); const bf16_t* clam = WSP(bf16_t, WS_CLAM); const bf16_t* yintra = WSP(bf16_t, WS_YINTRA); bf16_t* Y = WSP(bf16_t, WS_Y);
    GW_LOOP(SG * 16 * 32) {
        const int g = tl >> 9, m0 = ((tl >> 5) & 15) * 32, n0 = (tl & 31) * 32;
        sg_tile<false>(m0, n0, 256,
            [&](int row) { return xprev + ((size_t)g * 512 + row) * 256; },
            [&](int n, int k, int) { return clam + ((size_t)g * 1024 + n) * 256 + k; },
            [&](int row, int n, float v, float) {
                const int b = row >> 5, j = row & 31, t = n >> 4, c = n & 15;
                const size_t o = ((size_t)b * SEQ + j * CH + t) * SSMW + g * SC + c;
                Y[o] = f2bf(gelu_tanh(v + bf2f(yintra[o])));
            });
    }
}
__device__ __forceinline__ void ph_gemm_glu(const Ptrs& P, int bid, int nb) {
    const int tidx = opaque_tid();
    const bf16_t* Y = WSP(bf16_t, WS_Y); const bf16_t* wt = WSP(bf16_t, WS_WGLU); bf16_t* AS = WSP(bf16_t, WS_AS);
    GW_LOOP((T / 32) * 16) {
        const int m0 = (tl >> 4) * 32, n0 = (tl & 15) * 32;
        sg_tile<false>(m0, n0, 512,
            [&](int row) { return Y + (size_t)row * 512; },
            [&](int n, int k, int) { return wt + (size_t)n * 512 + k; },
            [&](int t, int n, float v, float) {
                const float yv = bf2f(Y[(size_t)t * 512 + n]);
                AS[(size_t)t * 1024 + 512 + n] = f2bf(yv * sigmoidf_(v + P.b_glu[n]));
            });
    }
}
__device__ __forceinline__ void ph_asnorm(const Ptrs& P, int bid, int nb) {
    const int tidx = opaque_tid();
    bf16_t* AS = WSP(bf16_t, WS_AS);
    const int lane = tidx & 63, w = tidx >> 6;
    for (int t = bid * NWAVE + w; t < T; t += nb * NWAVE) {
        bf16_t* r = AS + (size_t)t * 1024;
        float va[8], vs[8]; float sa = 0.f, ss = 0.f;
        const bf16x8 a = *(const bf16x8*)(r + lane * 8), s = *(const bf16x8*)(r + 512 + lane * 8);
#pragma unroll
        for (int i = 0; i < 8; ++i) { va[i] = bf2f((bf16_t)a[i]); vs[i] = bf2f((bf16_t)s[i]); sa += va[i] * va[i]; ss += vs[i] * vs[i]; }
        const float ra = rsqrtf(wave_sum(sa) * (1.0f / 512) + EPS), rs = rsqrtf(wave_sum(ss) * (1.0f / 512) + EPS);
        bf16x8 oa, os;
#pragma unroll
        for (int i = 0; i < 8; ++i) { oa[i] = (short)f2bf(va[i] * ra); os[i] = (short)f2bf(vs[i] * rs); }
        *(bf16x8*)(r + lane * 8) = oa; *(bf16x8*)(r + 512 + lane * 8) = os;
    }
}
__device__ __forceinline__ void ph_gemm_wo(const Ptrs& P, int bid, int nb) {
    const int tidx = opaque_tid();
    const bf16_t* AS = WSP(bf16_t, WS_AS); const bf16_t* wt = WSP(bf16_t, WS_WO); const float* xstat = WSP(float, WS_XSTAT); float* pre1 = P.out;
    GW_LOOP((T / 32) * 32) {
        const int m0 = (tl >> 5) * 32, n0 = (tl & 31) * 32;
        sg_tile<false>(m0, n0, 1024,
            [&](int row) { return AS + (size_t)row * 1024; },
            [&](int n, int k, int) { return wt + (size_t)n * 1024 + k; },
            [&](int t, int n, float v, float) {
                const float xn = (P.x[(size_t)t * D + n] - xstat[2 * t]) * xstat[2 * t + 1] * P.ln_in_g[n] + P.ln_in_b[n];
                pre1[(size_t)t * D + n] = v + ALPHA * xn;
            });
    }
}
__device__ __forceinline__ void ph_ln1(const Ptrs& P, int bid, int nb) {
    const int tidx = opaque_tid();
    const float* pre1 = P.out; bf16_t* x1 = WSP(bf16_t, WS_X1); bf16_t* x1lo = WSP(bf16_t, WS_X1LO);
    const int lane = tidx & 63, w = tidx >> 6;
    for (int t = bid * NWAVE + w; t < T; t += nb * NWAVE) {
        const float* xr = pre1 + (size_t)t * D;
        float v[16]; float s = 0.f;
#pragma unroll
        for (int i = 0; i < 4; ++i) { const f32x4 q = *(const f32x4*)(xr + i * 256 + lane * 4); v[4 * i] = q[0]; v[4 * i + 1] = q[1]; v[4 * i + 2] = q[2]; v[4 * i + 3] = q[3]; s += q[0] + q[1] + q[2] + q[3]; }
        const float mu = wave_sum(s) * (1.0f / D);
        float ss = 0.f;
#pragma unroll
        for (int i = 0; i < 16; ++i) { const float d = v[i] - mu; ss += d * d; }
        const float rstd = rsqrtf(wave_sum(ss) * (1.0f / D) + EPS);
#pragma unroll
        for (int i = 0; i < 4; ++i) {
            const int c = i * 256 + lane * 4;
            const f32x4 gg = *(const f32x4*)(P.ln1_g + c), bb = *(const f32x4*)(P.ln1_b + c);
            ushort4 o, ol;
            float y;
            y = (v[4 * i] - mu) * rstd * gg[0] + bb[0];     o.x = f2bf(y); ol.x = f2bf(y - bf2f(o.x));
            y = (v[4 * i + 1] - mu) * rstd * gg[1] + bb[1]; o.y = f2bf(y); ol.y = f2bf(y - bf2f(o.y));
            y = (v[4 * i + 2] - mu) * rstd * gg[2] + bb[2]; o.z = f2bf(y); ol.z = f2bf(y - bf2f(o.z));
            y = (v[4 * i + 3] - mu) * rstd * gg[3] + bb[3]; o.w = f2bf(y); ol.w = f2bf(y - bf2f(o.w));
            *(ushort4*)(x1 + (size_t)t * D + c) = o; (void)ol; (void)x1lo;
        }
    }
}
__device__ __forceinline__ void ph_router(const Ptrs& P, int bid, int nb) {
    const int tidx = opaque_tid();
    const bf16_t* x1 = WSP(bf16_t, WS_X1); const bf16_t* x1lo = WSP(bf16_t, WS_X1LO); float* logits = WSP(float, WS_LOGITS);
    const int e = tidx & 63, w = tidx >> 6;
    for (int t = bid * NWAVE + w; t < T; t += nb * NWAVE) {
        const bf16_t* a = x1 + (size_t)t * D; const bf16_t* al = x1lo + (size_t)t * D;
        float s = 0.f;
        for (int k = 0; k < D; k += 8) {
            const bf16x8 hi = *(const bf16x8*)(a + k), lo = *(const bf16x8*)(al + k);
#pragma unroll
            for (int i = 0; i < 8; ++i) s += (bf2f((bf16_t)hi[i]) + bf2f((bf16_t)lo[i])) * P.w_router[(size_t)(k + i) * NE + e];
        }
        logits[(size_t)t * NE + e] = s;
    }
}
__device__ __forceinline__ void ph_topk(const Ptrs& P, int bid, int nb) {
    const int tidx = opaque_tid();
    const float* logits = WSP(float, WS_LOGITS); int* topi = WSP(int, WS_TOPI); float* topw = WSP(float, WS_TOPW);
    const int lane = tidx & 63, w = tidx >> 6;
    for (int t = bid * NWAVE + w; t < T; t += nb * NWAVE) {
        const float sc = sigmoidf_(logits[(size_t)t * NE + lane]);
        const float sel = sc + P.router_bias[lane];
        const int grp = lane >> 3;
        float m1 = sel;
        m1 = fmaxf(m1, __shfl_xor(m1, 1)); m1 = fmaxf(m1, __shfl_xor(m1, 2)); m1 = fmaxf(m1, __shfl_xor(m1, 4));
        const unsigned long long bal = __ballot(sel == m1) & (0xFFull << (8 * grp));
        const int first = __ffsll((long long)bal) - 1;
        float m2 = (lane == first) ? -INFINITY : sel;
        m2 = fmaxf(m2, __shfl_xor(m2, 1)); m2 = fmaxf(m2, __shfl_xor(m2, 2)); m2 = fmaxf(m2, __shfl_xor(m2, 4));
        const float gs = m1 + m2;
        int cg = 0;
#pragma unroll
        for (int gj = 0; gj < 8; ++gj) { const float sj = __shfl(gs, gj * 8); cg += (sj > gs || (sj == gs && gj < grp)) ? 1 : 0; }
        const bool gsel = cg < 4;
        const float v = gsel ? sel : -INFINITY;
        int rank = 0;
        for (int e2 = 0; e2 < 64; ++e2) { const float ve = __shfl(v, e2); rank += (ve > v || (ve == v && e2 < lane)) ? 1 : 0; }
        const bool chosen = gsel && rank < TOPK;
        const float wsum = wave_sum(chosen ? sc : 0.f);
        if (chosen) { topi[(size_t)t * TOPK + rank] = lane; topw[(size_t)t * TOPK + rank] = sc / wsum * 2.5f; }
    }
}
__device__ __forceinline__ void ph_cnt(const Ptrs& P, int bid, int nb) {
    const int tidx = opaque_tid();
    const int* topi = WSP(int, WS_TOPI); int* cnt = WSP(int, WS_CNT);
    for (int i = bid * NTHR + tidx; i < 256 * 64; i += nb * NTHR) {
        const int tile = i >> 6, e = i & 63;
        int c = 0;
        for (int k = 0; k < 1024; ++k) c += (topi[tile * 1024 + k] == e) ? 1 : 0;
        cnt[i] = c;
    }
}
__device__ __forceinline__ void ph_off(const Ptrs& P, LAS unsigned char* lds, int bid) {
    const int tidx = opaque_tid();
    if (bid != 0) return;
    const int* cnt = WSP(int, WS_CNT); int* toff = WSP(int, WS_TOFF); int* eoff = WSP(int, WS_EOFF); int* ecnt = WSP(int, WS_ECNT);
    LAS int* tot = (LAS int*)lds; LAS int* off = tot + 64;
    const int e = tidx;
    if (e < 64) { int s = 0; for (int tile = 0; tile < 256; ++tile) s += cnt[tile * 64 + e]; tot[e] = s; ecnt[e] = s; }
    __syncthreads();
    if (e == 0) { int o = 0; for (int i = 0; i < 64; ++i) { off[i] = o; o += (tot[i] + 255) & ~255; } off[64] = o; }
    __syncthreads();
    if (e < 64) {
        eoff[e] = off[e]; if (e == 0) eoff[64] = off[64];
        int run = off[e];
        for (int tile = 0; tile < 256; ++tile) { toff[tile * 64 + e] = run; run += cnt[tile * 64 + e]; }
    }
}
__device__ __forceinline__ void ph_lists(const Ptrs& P, int bid, int nb) {
    const int tidx = opaque_tid();
    const int* topi = WSP(int, WS_TOPI); const float* topw = WSP(float, WS_TOPW); const int* toff = WSP(int, WS_TOFF); const int* eoff = WSP(int, WS_EOFF);
    int* rowtok = WSP(int, WS_ROWTOK); float* roww = WSP(float, WS_ROWW);
    for (int i = bid * NTHR + tidx; i < 256 * 64; i += nb * NTHR) {
        const int tile = i >> 6, e = i & 63;
        int pos = toff[tile * 64 + e];
        for (int k = 0; k < 1024; ++k) {
            if (topi[tile * 1024 + k] == e) { rowtok[pos] = tile * 1024 + k; roww[pos] = topw[tile * 1024 + k]; ++pos; }
        }
        if (tile == 255) { const int end = eoff[e + 1]; for (; pos < end; ++pos) { rowtok[pos] = -1; roww[pos] = 0.f; } }
    }
    for (int i = bid * NTHR + tidx; i < T; i += nb * NTHR) rowtok[SH_ROW0 + i] = i * 8;
}
__device__ __forceinline__ void ph_gemm_gu(const Ptrs& P, int bid, int nb) {
    const int tidx = opaque_tid();
    const bf16_t* x1 = WSP(bf16_t, WS_X1); const bf16_t* wgu = WSP(bf16_t, WS_WGU); const int* rowtok = WSP(int, WS_ROWTOK); const float* roww = WSP(float, WS_ROWW);
    const int* eoff = WSP(int, WS_EOFF); bf16_t* H = WSP(bf16_t, WS_H);
    const int nrt = eoff[64] / 32;
    const int ntl = (nrt + T / 32) * 8;
    GW_LOOP(ntl) {
        const int rt = tl >> 3, n0 = (tl & 7) * 32;
        if (rt < nrt) {
            const int m0 = rt * 32;
            int e = 0; while (e < 63 && eoff[e + 1] <= m0) ++e;
            const bf16_t* w = wgu + (size_t)e * 512 * 1024;
            sg_tile<true>(m0, n0, 1024,
                [&](int row) { const int s = rowtok[row]; return x1 + (size_t)(s >= 0 ? (s >> 3) : 0) * D; },
                [&](int f, int k, int which) { return w + (size_t)((f >> 7) * 256 + (f & 127) + which * 128) * 1024 + k; },
                [&](int row, int f, float gv, float uv) { H[(size_t)row * FF + f] = f2bf(gv * sigmoidf_(gv) * uv * roww[row]); });
        } else {
            const int m0 = (rt - nrt) * 32;
            const bf16_t* w = wgu + (size_t)64 * 512 * 1024;
            sg_tile<true>(m0, n0, 1024,
                [&](int row) { return x1 + (size_t)row * D; },
                [&](int f, int k, int which) { return w + (size_t)((f >> 7) * 256 + (f & 127) + which * 128) * 1024 + k; },
                [&](int row, int f, float gv, float uv) { H[(size_t)(SH_ROW0 + row) * FF + f] = f2bf(gv * sigmoidf_(gv) * uv); });
        }
    }
}
__device__ __forceinline__ unsigned char f2fp8(float v) { const int p = __builtin_amdgcn_cvt_pk_fp8_f32(v, v, 0, false); return (unsigned char)(p & 0xff); }
__device__ __forceinline__ void ph_gemm_down(const Ptrs& P, int bid, int nb) {
    const int tidx = opaque_tid();
    const bf16_t* H = WSP(bf16_t, WS_H); const bf16_t* wd = WSP(bf16_t, WS_WD); const int* rowtok = WSP(int, WS_ROWTOK); const int* eoff = WSP(int, WS_EOFF);
    const bf16_t* x1 = WSP(bf16_t, WS_X1); unsigned char* yslot = WSP(unsigned char, WS_YSLOT); float* out = P.out;
    const int nrt = eoff[64] / 32;
    const int ntl = (nrt + T / 32) * 32;
    GW_LOOP(ntl) {
        const int rt = tl >> 5, n0 = (tl & 31) * 32;
        if (rt < nrt) {
            const int m0 = rt * 32;
            int e = 0; while (e < 63 && eoff[e + 1] <= m0) ++e;
            const bf16_t* w = wd + (size_t)e * 1024 * 256;
            sg_tile<false>(m0, n0, 256,
                [&](int row) { return H + (size_t)row * FF; },
                [&](int n, int k, int) { return w + (size_t)n * 256 + k; },
                [&](int row, int n, float v, float) { const int s = rowtok[row]; if (s >= 0) yslot[(size_t)s * D + n] = f2fp8(v * SLOT_SCALE); });
        } else {
            const int m0 = (rt - nrt) * 32;
            const bf16_t* w = wd + (size_t)64 * 1024 * 256;
            sg_tile<false>(m0, n0, 256,
                [&](int row) { return H + (size_t)(SH_ROW0 + row) * FF; },
                [&](int n, int k, int) { return w + (size_t)n * 256 + k; },
                [&](int t, int n, float v, float) { out[(size_t)t * D + n] = v + ALPHA * bf2f(x1[(size_t)t * D + n]); });
        }
    }
}
__device__ __forceinline__ void ph_combine(const Ptrs& P, int bid, int nb) {
    const int tidx = opaque_tid();
    const unsigned char* yslot = WSP(unsigned char, WS_YSLOT); float* out = P.out;
    const int lane = tidx & 63, w = tidx >> 6;
    for (int t = bid * NWAVE + w; t < T; t += nb * NWAVE) {
        float* orow = out + (size_t)t * D + lane * 16;
        float v[16];
#pragma unroll
        for (int i = 0; i < 4; ++i) { const f32x4 q = *(const f32x4*)(orow + 4 * i); v[4 * i] = q[0]; v[4 * i + 1] = q[1]; v[4 * i + 2] = q[2]; v[4 * i + 3] = q[3]; }
#pragma unroll
        for (int k = 0; k < TOPK; ++k) {
            const u32x4 q = *(const u32x4*)(yslot + ((size_t)t * TOPK + k) * D + lane * 16);
#pragma unroll
            for (int i = 0; i < 4; ++i) {
                v[4 * i]     += __builtin_amdgcn_cvt_f32_fp8((int)q[i], 0) * (1.0f / SLOT_SCALE);
                v[4 * i + 1] += __builtin_amdgcn_cvt_f32_fp8((int)q[i], 1) * (1.0f / SLOT_SCALE);
                v[4 * i + 2] += __builtin_amdgcn_cvt_f32_fp8((int)q[i], 2) * (1.0f / SLOT_SCALE);
                v[4 * i + 3] += __builtin_amdgcn_cvt_f32_fp8((int)q[i], 3) * (1.0f / SLOT_SCALE);
            }
        }
        float s = 0.f;
#pragma unroll
        for (int i = 0; i < 16; ++i) s += v[i];
        const float mu = wave_sum(s) * (1.0f / D);
        float ss = 0.f;
#pragma unroll
        for (int i = 0; i < 16; ++i) { const float d = v[i] - mu; ss += d * d; }
        const float rstd = rsqrtf(wave_sum(ss) * (1.0f / D) + EPS);
#pragma unroll
        for (int i = 0; i < 4; ++i) {
            const int c = lane * 16 + 4 * i;
            const f32x4 gg = *(const f32x4*)(P.ln2_g + c), bb = *(const f32x4*)(P.ln2_b + c);
            f32x4 o;
            o[0] = (v[4 * i] - mu) * rstd * gg[0] + bb[0]; o[1] = (v[4 * i + 1] - mu) * rstd * gg[1] + bb[1];
            o[2] = (v[4 * i + 2] - mu) * rstd * gg[2] + bb[2]; o[3] = (v[4 * i + 3] - mu) * rstd * gg[3] + bb[3];
            *(f32x4*)(orow + 4 * i) = o;
        }
    }
}

namespace g8 {
constexpr int BM = 256, BK = 64, HALF = 128, HTB = HALF * BK * 2, STAGE_BYTES = 8 * HTB;
__device__ __forceinline__ int lds_byte(int r, int c) { const int st = (r >> 4) * 2 + (c >> 5), rr = r & 15, cc = c & 31, ob = rr * 64 + cc * 2; return st * 1024 + (ob ^ (((ob >> 9) & 1) << 5)); }
__device__ __forceinline__ void stage_rc(int b, int& R, int& C) { const int st = b / 1024, sb = b % 1024, swz = sb ^ (((sb >> 9) & 1) << 5); R = (st >> 1) * 16 + swz / 64; C = (st & 1) * 32 + (swz % 64) / 2; }
__device__ __forceinline__ int perm32(int rho) { const int n = rho >> 4, i = rho & 15; return 8 * (i >> 2) + 4 * n + (i & 3); }

struct Unit { const char* A; const char* B; const int* rows; int pm, pn, e, nt; };
struct Geo { int lda_b, ldb_b; long kstepA, kstepB; int toep; };

typedef float f32x4 __attribute__((ext_vector_type(4)));
typedef f32x4 Acc[2][2][4][2];

template <class Epi, class Sched, bool GATHER>
__device__ __forceinline__ void gemm_body(LAS unsigned char* lds, const Geo g, const Sched& S, const Epi& E) {
    const int tid = opaque_tid(), wid = __builtin_amdgcn_readfirstlane(tid >> 6), lane = tid & 63, wr = wid >> 2, wc = wid & 3, fr = lane & 15, fq = lane >> 4;
    int sR[2], sC[2];
    unsigned voffB[2], vA[2][2], vN[2][2];
#pragma unroll
    for (int i = 0; i < 2; ++i) { int R, C; stage_rc(tid * 16 + i * 8192, R, C); sR[i] = R; sC[i] = C; const int Rb = (R & ~31) + perm32(R & 31);
        voffB[i] = g.toep ? (unsigned)(Rb * 32 + 1536 - (C >> 4) * 512 + (C & 15) * 2) : (unsigned)(Rb * g.ldb_b + C * 2);
#pragma unroll
        for (int h = 0; h < 2; ++h) { vA[h][i] = (unsigned)((h * HALF + R) * g.lda_b + C * 2); vN[h][i] = vA[h][i]; } }
    const long kA = g.kstepA, kB = g.kstepB;
    const long hB = (long)HALF * g.ldb_b;
    const unsigned ldsw = (unsigned)wid * 1024u;
    const int aoff = lds_byte(wr * 64 + fr, fq * 8), boff = lds_byte(wc * 32 + fr, fq * 8);
#define G8_SA(b, h) (((b) * 2 + (h)) * HTB)
#define G8_SB(b, h) ((4 + (b) * 2 + (h)) * HTB)
#define G8_STAGE(bufoff, gbase, v0, v1) do { \
        __builtin_amdgcn_global_load_lds((const unsigned*)((const char*)(gbase) + (v0)), (LAS unsigned*)(lds + (bufoff) + ldsw), 16, 0, 0); \
        __builtin_amdgcn_global_load_lds((const unsigned*)((const char*)(gbase) + (v1)), (LAS unsigned*)(lds + (bufoff) + ldsw + 8192), 16, 0, 0); } while (0)
#define G8_STB(bufoff, gbase) G8_STAGE(bufoff, gbase, voffB[0], voffB[1])
#define G8_LDA(dst, b, h) do { _Pragma("unroll") for (int m = 0; m < 4; ++m) _Pragma("unroll") for (int k = 0; k < 2; ++k) dst[m][k] = *(const LAS bf16x8*)(lds + G8_SA(b, h) + aoff + m * 2048 + k * 1024); } while (0)
#define G8_LDB(dst, b, h) do { _Pragma("unroll") for (int n = 0; n < 2; ++n) _Pragma("unroll") for (int k = 0; k < 2; ++k) dst[n][k] = *(const LAS bf16x8*)(lds + G8_SB(b, h) + boff + n * 2048 + k * 1024); } while (0)
#define G8_MMA(ai, bj, At, Bt) do { __builtin_amdgcn_s_setprio(1); _Pragma("unroll") for (int m = 0; m < 4; ++m) _Pragma("unroll") for (int n = 0; n < 2; ++n) _Pragma("unroll") for (int k = 0; k < 2; ++k) \
        acc[ai][bj][m][n] = __builtin_amdgcn_mfma_f32_16x16x32_bf16(Bt[n][k], At[m][k], acc[ai][bj][m][n], 0, 0, 0); __builtin_amdgcn_s_setprio(0); } while (0)
#define G8_WAIT_V(n) asm volatile("s_waitcnt vmcnt(" #n ")" ::: "memory")
#define G8_WAIT_L(n) asm volatile("s_waitcnt lgkmcnt(" #n ")" ::: "memory")
#define G8_BAR __builtin_amdgcn_s_barrier()
#define G8_SCHED __builtin_amdgcn_sched_barrier(0)
#define G8_ROWOFF(u_, h_, i_) ((unsigned)((unsigned)(((u_).rows[(h_) * HALF + sR[i_]] < 0 ? 0 : (u_).rows[(h_) * HALF + sR[i_]] >> 3)) * (unsigned)g.lda_b + (unsigned)(sC[i_] * 2)))
    Unit cur, nxt; int ui = 0;
    if (!S.next(0, cur)) return;
    Acc acc;
#pragma unroll
    for (int a = 0; a < 2; ++a)
#pragma unroll
        for (int b = 0; b < 2; ++b)
#pragma unroll
            for (int m = 0; m < 4; ++m)
#pragma unroll
                for (int n = 0; n < 2; ++n) acc[a][b][m][n] = (f32x4){0.f, 0.f, 0.f, 0.f};
    bf16x8 At[4][2], B0[2][2], B1[2][2];
    const char* cA = cur.A; const char* cB = cur.B;
    if (GATHER) {
#pragma unroll
        for (int h = 0; h < 2; ++h)
#pragma unroll
            for (int i = 0; i < 2; ++i) vA[h][i] = G8_ROWOFF(cur, h, i);
        asm volatile("" : "+v"(vA[0][0]), "+v"(vA[0][1]), "+v"(vA[1][0]), "+v"(vA[1][1]));
    }
    const long hA = GATHER ? 0 : 0;
    (void)hA;
    G8_STB(G8_SB(0, 0), cB); G8_STB(G8_SB(0, 1), cB + hB); G8_STAGE(G8_SA(0, 0), cA, vA[0][0], vA[0][1]); G8_STAGE(G8_SA(0, 1), cA, vA[1][0], vA[1][1]);
    if (wr == 1) G8_BAR;
    G8_WAIT_V(2); G8_BAR;
    G8_STB(G8_SB(1, 0), cB + kB); G8_STAGE(G8_SA(1, 0), cA + kA, vA[0][0], vA[0][1]); G8_STB(G8_SB(1, 1), cB + hB + kB);
    G8_WAIT_V(6); G8_BAR;
    for (;;) {
        const bool has_next = S.next(ui + 1, nxt);
        const char* nA = has_next ? nxt.A : cA; const char* nB = has_next ? nxt.B : cB;
        if (GATHER) {
            if (has_next) {
#pragma unroll
                for (int h = 0; h < 2; ++h)
#pragma unroll
                    for (int i = 0; i < 2; ++i) vN[h][i] = G8_ROWOFF(nxt, h, i);
            } else {
#pragma unroll
                for (int h = 0; h < 2; ++h)
#pragma unroll
                    for (int i = 0; i < 2; ++i) vN[h][i] = vA[h][i];
            }
            asm volatile("" : "+v"(vN[0][0]), "+v"(vN[0][1]), "+v"(vN[1][0]), "+v"(vN[1][1]));
        }
        const int nt = cur.nt;
        for (int t = 0; t < nt; t += 2) {
            const bool last = (t == nt - 2);
            const char* a1 = cA + (long)(t + 1) * kA;
            const char* a2 = last ? nA : cA + (long)(t + 2) * kA; const char* b2 = last ? nB : cB + (long)(t + 2) * kB;
            const char* a3 = a2 + kA; const char* b3 = b2 + kB;
            unsigned w00 = vA[0][0], w01 = vA[0][1], w10 = vA[1][0], w11 = vA[1][1];
            if (GATHER && last) { w00 = vN[0][0]; w01 = vN[0][1]; w10 = vN[1][0]; w11 = vN[1][1]; }
            G8_LDB(B0, 0, 0); G8_LDB(B1, 0, 1); G8_SCHED; G8_LDA(At, 0, 0); G8_STAGE(G8_SA(1, 1), a1, vA[1][0], vA[1][1]);
            G8_WAIT_V(8); G8_WAIT_L(0); G8_BAR; G8_MMA(0, 0, At, B0); G8_MMA(0, 1, At, B1); G8_BAR; G8_SCHED;
            G8_LDA(At, 0, 1); G8_STB(G8_SB(0, 0), b2); G8_STB(G8_SB(0, 1), b2 + hB); G8_STAGE(G8_SA(0, 0), a2, w00, w01);
            G8_WAIT_V(8); G8_WAIT_L(0); G8_BAR; G8_MMA(1, 0, At, B0); G8_MMA(1, 1, At, B1); G8_BAR; G8_SCHED;
            G8_LDB(B0, 1, 0); G8_LDB(B1, 1, 1); G8_SCHED; G8_LDA(At, 1, 0); G8_STAGE(G8_SA(0, 1), a2, w10, w11);
            G8_WAIT_V(8); G8_WAIT_L(0); G8_BAR; G8_MMA(0, 0, At, B0); G8_MMA(0, 1, At, B1); G8_BAR; G8_SCHED;
            G8_LDA(At, 1, 1); G8_STB(G8_SB(1, 0), b3); G8_STB(G8_SB(1, 1), b3 + hB); G8_STAGE(G8_SA(1, 0), a3, w00, w01);
            G8_WAIT_V(8); G8_WAIT_L(0); G8_BAR; G8_MMA(1, 0, At, B0); G8_MMA(1, 1, At, B1); G8_BAR; G8_SCHED;
        }
        if (wr == 0) G8_BAR;
        { int fr_ = fr, fq_ = fq; asm volatile("" : "+v"(fr_), "+v"(fq_)); E(acc, cur, wr, wc, fr_, fq_); }
        if (!has_next) break;
#pragma unroll
        for (int a = 0; a < 2; ++a)
#pragma unroll
            for (int b = 0; b < 2; ++b)
#pragma unroll
                for (int m = 0; m < 4; ++m)
#pragma unroll
                    for (int n = 0; n < 2; ++n) acc[a][b][m][n] = (f32x4){0.f, 0.f, 0.f, 0.f};
        cur = nxt; cA = nA; cB = nB; ++ui;
        if (GATHER) {
#pragma unroll
            for (int h = 0; h < 2; ++h)
#pragma unroll
                for (int i = 0; i < 2; ++i) vA[h][i] = vN[h][i];
        }
        if (wr == 1) G8_BAR;
    }
    G8_WAIT_V(0);
    G8_BAR;
#undef G8_SA
#undef G8_SB
#undef G8_STAGE
#undef G8_STB
#undef G8_LDA
#undef G8_LDB
#undef G8_MMA
#undef G8_WAIT_V
#undef G8_WAIT_L
#undef G8_BAR
#undef G8_SCHED
#undef G8_ROWOFF
}
}
namespace g8 {
__device__ __forceinline__ unsigned pk_bf16(float lo, float hi) { return (unsigned)f2bf(lo) | ((unsigned)f2bf(hi) << 16); }
__device__ __forceinline__ u32x4 pack8(const f32x4 a, const f32x4 b) { u32x4 w; w[0] = pk_bf16(a[0], a[1]); w[1] = pk_bf16(a[2], a[3]); w[2] = pk_bf16(b[0], b[1]); w[3] = pk_bf16(b[2], b[3]); return w; }
__device__ __forceinline__ int unit_index(int i, int nunits) {
    const int G = gridDim.x, c = blockIdx.x;
    if ((G & 7) != 0) { const long L = (long)i * G + c; return L < nunits ? (int)L : -1; }
    const int x = c & 7, r = c >> 3, GX = G >> 3;
    const int lo = (int)(((long)nunits * x) >> 3), hi = (int)(((long)nunits * (x + 1)) >> 3);
    const int L = lo + i * GX + r;
    return L < hi ? L : -1;
}
struct SchedReg {
    const char* A; const char* B; int lda_b, ldb_b, nM, nN, nt;
    __device__ __forceinline__ bool next(int i, Unit& u) const {
        const int L = unit_index(i, nM * nN); if (L < 0) return false;
        u.pm = L / nN; u.pn = L % nN; u.e = 0; u.nt = nt; u.rows = nullptr;
        u.A = A + (size_t)u.pm * 256 * lda_b; u.B = B + (size_t)u.pn * 256 * ldb_b; return true;
    }
};
struct SchedS5 {
    const char* A; const char* B; int lda_b, ldb_b, nN, nt; size_t a_gstride, b_gstride; int toep;
    __device__ __forceinline__ bool next(int i, Unit& u) const {
        const int L = unit_index(i, SG * 2 * nN); if (L < 0) return false;
        const int g = L / (2 * nN), r = L % (2 * nN);
        u.pm = r / nN; u.pn = r % nN; u.e = g; u.rows = nullptr;
        u.A = A + (size_t)g * a_gstride + (size_t)u.pm * 256 * lda_b;
        if (toep) { u.B = B + (size_t)g * 127 * 512 + 63 * 512 + (size_t)u.pn * 256 * 32 - 1536; u.nt = 4 * (u.pn + 1); }
        else { u.B = B + (size_t)g * b_gstride + (size_t)u.pn * 256 * ldb_b; u.nt = nt; }
        return true;
    }
};
struct SchedMoe {
    const char* A; const char* B; const int* eoff; const int* rowtok; int lda_b, npn, nt; size_t b_estride; int ldb_b; int gather;
    __device__ __forceinline__ bool next(int i, Unit& u) const {
        const int nrt = eoff[64] >> 8;
        const int L = unit_index(i, (nrt + T / 256) * npn); if (L < 0) return false;
        const int rt = L / npn; u.pn = L % npn; u.nt = nt;
        int e = 64;
        if (rt < nrt) { e = 0; while (e < 63 && eoff[e + 1] <= rt * 256) ++e; }
        u.e = e; u.pm = rt;
        u.B = B + (size_t)e * b_estride + (size_t)u.pn * 256 * ldb_b;
        if (gather) {
            u.A = A; u.rows = rowtok + ((e < 64) ? rt * 256 : SH_ROW0 + (rt - nrt) * 256);
        } else {
            const int row0 = (e < 64) ? rt * 256 : SH_ROW0 + (rt - nrt) * 256;
            u.A = A + (size_t)row0 * lda_b; u.rows = nullptr;
        }
        return true;
    }
};

#define EPI_ROWS_BEGIN _Pragma("unroll") for (int ai = 0; ai < 2; ++ai) _Pragma("unroll") for (int m = 0; m < 4; ++m) { const int rloc = ai * 128 + wr * 64 + m * 16 + fr;
#define EPI_ROWS_END }

struct EpiWin {
    bf16_t* cq; bf16_t* ckv; bf16_t* u; bf16_t* Kc; const float2* rope; float* rsqp; float* rskvp;
    __device__ __forceinline__ void operator()(const Acc& acc, const Unit& un, int wr, int wc, int fr, int fq) const {
        const int pn = un.pn;
        if (pn == 0) {
            EPI_ROWS_BEGIN
                const int t = un.pm * 256 + rloc;
                float ss = 0.f;
#pragma unroll
                for (int bj = 0; bj < 2; ++bj) { const f32x4 v0 = acc[ai][bj][m][0], v1 = acc[ai][bj][m][1];
                    *(u32x4*)(cq + (size_t)t * 256 + bj * 128 + wc * 32 + fq * 8) = pack8(v0, v1);
                    ss += v0[0] * v0[0] + v0[1] * v0[1] + v0[2] * v0[2] + v0[3] * v0[3] + v1[0] * v1[0] + v1[1] * v1[1] + v1[2] * v1[2] + v1[3] * v1[3]; }
                ss += __shfl_xor(ss, 16); ss += __shfl_xor(ss, 32);
                if (fq == 0) rsqp[(size_t)t * 4 + wc] = ss;
            EPI_ROWS_END
        } else if (pn <= 2) {
            EPI_ROWS_BEGIN
                const int t = un.pm * 256 + rloc;
                const int b = t >> 11, s = t & 2047, j = s >> 6, sl = s & 63;
#pragma unroll
                for (int bj = 0; bj < 2; ++bj) { const int ch0 = (pn - 1) * 256 + bj * 128 + wc * 32 + fq * 8, gi = ch0 >> 4, c0 = ch0 & 15;
                    *(u32x4*)(u + ((size_t)gi * 512 + b * 32 + j) * 1024 + sl * 16 + c0) = pack8(acc[ai][bj][m][0], acc[ai][bj][m][1]); }
            EPI_ROWS_END
        } else {
            EPI_ROWS_BEGIN
                const int t = un.pm * 256 + rloc;
                const f32x4 v0 = acc[ai][0][m][0], v1 = acc[ai][0][m][1];
                *(u32x4*)(ckv + (size_t)t * 256 + wc * 32 + fq * 8) = pack8(v0, v1);
                float ss = v0[0] * v0[0] + v0[1] * v0[1] + v0[2] * v0[2] + v0[3] * v0[3] + v1[0] * v1[0] + v1[1] * v1[1] + v1[2] * v1[2] + v1[3] * v1[3];
                ss += __shfl_xor(ss, 16); ss += __shfl_xor(ss, 32);
                if (fq == 0) rskvp[(size_t)t * 4 + wc] = ss;
                *(u32x4*)(ckv + (size_t)t * 256 + 128 + wc * 32 + fq * 8) = (u32x4){0u, 0u, 0u, 0u};
            EPI_ROWS_END
            if (wc == 0) {
                EPI_ROWS_BEGIN
                    const int t = un.pm * 256 + rloc;
                    const f32x4 x1 = acc[ai][1][m][0], x2 = acc[ai][1][m][1];
                    const f32x4 ca = *(const f32x4*)(rope + (size_t)t * 16 + fq * 4), cb = *(const f32x4*)(rope + (size_t)t * 16 + fq * 4 + 2);
                    const float o10 = x1[0] * ca[0] - x2[0] * ca[1], o11 = x1[1] * ca[2] - x2[1] * ca[3], o12 = x1[2] * cb[0] - x2[2] * cb[1], o13 = x1[3] * cb[2] - x2[3] * cb[3];
                    const float o20 = x2[0] * ca[0] + x1[0] * ca[1], o21 = x2[1] * ca[2] + x1[1] * ca[3], o22 = x2[2] * cb[0] + x1[2] * cb[1], o23 = x2[3] * cb[2] + x1[3] * cb[3];
                    uint2 w1, w2; w1.x = pk_bf16(o10, o11); w1.y = pk_bf16(o12, o13); w2.x = pk_bf16(o20, o21); w2.y = pk_bf16(o22, o23);
                    const int b = t >> 11, s = t & 2047;
                    bf16_t* kp = Kc + (((size_t)b * NH) * SEQ + s) * QKD + 64 + fq * 4;
#pragma unroll 1
                    for (int h = 0; h < NH; ++h) { *(uint2*)kp = w1; *(uint2*)(kp + 16) = w2; kp += (size_t)SEQ * QKD; }
                EPI_ROWS_END
            }
        }
    }
};
struct EpiQ {
    bf16_t* Q; const float* rsqp; const float2* rope;
    __device__ __forceinline__ void operator()(const Acc& acc, const Unit& un, int wr, int wc, int fr, int fq) const {
        EPI_ROWS_BEGIN
            const int t = un.pm * 256 + rloc, b = t >> 11, s = t & 2047;
            const f32x4 pp = *(const f32x4*)(rsqp + (size_t)t * 4);
            const float rs = rsqrtf((pp[0] + pp[1] + pp[2] + pp[3]) * (1.0f / 256) + EPS);
            if (un.pn < 2) {
#pragma unroll
                for (int bj = 0; bj < 2; ++bj) { const int col = un.pn * 256 + bj * 128 + wc * 32 + fq * 8;
                    *(u32x4*)(Q + (((size_t)b * NH + (col >> 6)) * SEQ + s) * QKD + (col & 63)) = pack8(acc[ai][bj][m][0] * rs, acc[ai][bj][m][1] * rs); }
            } else {
                const f32x4 ca = *(const f32x4*)(rope + (size_t)t * 16 + fq * 4), cb = *(const f32x4*)(rope + (size_t)t * 16 + fq * 4 + 2);
#pragma unroll
                for (int bj = 0; bj < 2; ++bj) { const f32x4 x1 = acc[ai][bj][m][0] * rs, x2 = acc[ai][bj][m][1] * rs;
                    const float o10 = x1[0] * ca[0] - x2[0] * ca[1], o11 = x1[1] * ca[2] - x2[1] * ca[3], o12 = x1[2] * cb[0] - x2[2] * cb[1], o13 = x1[3] * cb[2] - x2[3] * cb[3];
                    const float o20 = x2[0] * ca[0] + x1[0] * ca[1], o21 = x2[1] * ca[2] + x1[1] * ca[3], o22 = x2[2] * cb[0] + x1[2] * cb[1], o23 = x2[3] * cb[2] + x1[3] * cb[3];
                    uint2 w1, w2; w1.x = pk_bf16(o10, o11); w1.y = pk_bf16(o12, o13); w2.x = pk_bf16(o20, o21); w2.y = pk_bf16(o22, o23);
                    bf16_t* qp = Q + (((size_t)b * NH + (bj * 4 + wc)) * SEQ + s) * QKD + 64 + fq * 4; *(uint2*)qp = w1; *(uint2*)(qp + 16) = w2; }
            }
        EPI_ROWS_END
    }
};
struct EpiKV {
    bf16_t* Kc; bf16_t* V; const float* rskvp;
    __device__ __forceinline__ void operator()(const Acc& acc, const Unit& un, int wr, int wc, int fr, int fq) const {
        EPI_ROWS_BEGIN
            const int t = un.pm * 256 + rloc, b = t >> 11, s = t & 2047;
            const f32x4 pp = *(const f32x4*)(rskvp + (size_t)t * 4);
            const float rs = rsqrtf((pp[0] + pp[1] + pp[2] + pp[3]) * (1.0f / 128) + EPS);
#pragma unroll
            for (int bj = 0; bj < 2; ++bj) { const int col = (un.pn & 1) * 256 + bj * 128 + wc * 32 + fq * 8;
                const u32x4 w = pack8(acc[ai][bj][m][0] * rs, acc[ai][bj][m][1] * rs);
                if (un.pn < 2) *(u32x4*)(Kc + (((size_t)b * NH + (col >> 6)) * SEQ + s) * QKD + (col & 63)) = w;
                else *(u32x4*)(V + (((size_t)b * NH + (col >> 6)) * SEQ + s) * VD + (col & 63)) = w; }
        EPI_ROWS_END
    }
};
struct EpiS5b {
    float* xloc;
    __device__ __forceinline__ void operator()(const Acc& acc, const Unit& un, int wr, int wc, int fr, int fq) const {
        EPI_ROWS_BEGIN
            float* o = xloc + ((size_t)un.e * 512 + un.pm * 256 + rloc) * 128 + wc * 32 + fq * 8;
            *(f32x4*)o = acc[ai][0][m][0]; *(f32x4*)(o + 4) = acc[ai][0][m][1];
        EPI_ROWS_END
    }
};
template <int MODE> struct EpiS5y {
    bf16_t* dst; const bf16_t* yintra;
    __device__ __forceinline__ void operator()(const Acc& acc, const Unit& un, int wr, int wc, int fr, int fq) const {
        EPI_ROWS_BEGIN
            const int row = un.pm * 256 + rloc, b = row >> 5, j = row & 31;
#pragma unroll
            for (int bj = 0; bj < 2; ++bj) { const int n = un.pn * 256 + bj * 128 + wc * 32 + fq * 8, tt = n >> 4, c0 = n & 15;
                const size_t o = ((size_t)b * SEQ + j * CH + tt) * SSMW + un.e * SC + c0;
                f32x4 v0 = acc[ai][bj][m][0], v1 = acc[ai][bj][m][1];
                if (MODE == 1) { const bf16x8 yi = *(const bf16x8*)(yintra + o);
#pragma unroll
                    for (int q = 0; q < 4; ++q) { v0[q] = gelu_tanh(v0[q] + bf2f((bf16_t)yi[q])); v1[q] = gelu_tanh(v1[q] + bf2f((bf16_t)yi[4 + q])); } }
                *(u32x4*)(dst + o) = pack8(v0, v1); }
        EPI_ROWS_END
    }
};
struct EpiGlu {
    const bf16_t* Y; const float* bglu; bf16_t* AS;
    __device__ __forceinline__ void operator()(const Acc& acc, const Unit& un, int wr, int wc, int fr, int fq) const {
        EPI_ROWS_BEGIN
            const int t = un.pm * 256 + rloc;
#pragma unroll
            for (int bj = 0; bj < 2; ++bj) { const int col = un.pn * 256 + bj * 128 + wc * 32 + fq * 8;
                const bf16x8 yv = *(const bf16x8*)(Y + (size_t)t * 512 + col);
                const f32x4 b0 = *(const f32x4*)(bglu + col), b1 = *(const f32x4*)(bglu + col + 4);
                f32x4 v0 = acc[ai][bj][m][0], v1 = acc[ai][bj][m][1];
#pragma unroll
                for (int q = 0; q < 4; ++q) { v0[q] = bf2f((bf16_t)yv[q]) * sigmoidf_(v0[q] + b0[q]); v1[q] = bf2f((bf16_t)yv[4 + q]) * sigmoidf_(v1[q] + b1[q]); }
                *(u32x4*)(AS + (size_t)t * 1024 + 512 + col) = pack8(v0, v1); }
        EPI_ROWS_END
    }
};
struct EpiWo {
    const float* x; const float* xstat; const float* g; const float* bt; float* pre1;
    __device__ __forceinline__ void operator()(const Acc& acc, const Unit& un, int wr, int wc, int fr, int fq) const {
        EPI_ROWS_BEGIN
            const int t = un.pm * 256 + rloc;
            const float mu = xstat[2 * t], rstd = xstat[2 * t + 1];
#pragma unroll
            for (int bj = 0; bj < 2; ++bj) { const int col = un.pn * 256 + bj * 128 + wc * 32 + fq * 8;
#pragma unroll
                for (int n = 0; n < 2; ++n) { const f32x4 xv = *(const f32x4*)(x + (size_t)t * D + col + 4 * n), gg = *(const f32x4*)(g + col + 4 * n), bb = *(const f32x4*)(bt + col + 4 * n);
                    f32x4 o;
#pragma unroll
                    for (int q = 0; q < 4; ++q) o[q] = acc[ai][bj][m][n][q] + ALPHA * ((xv[q] - mu) * rstd * gg[q] + bb[q]);
                    *(f32x4*)(pre1 + (size_t)t * D + col + 4 * n) = o; } }
        EPI_ROWS_END
    }
};
struct EpiGU {
    bf16_t* H; const float* roww; const int* eoff;
    __device__ __forceinline__ void operator()(const Acc& acc, const Unit& un, int wr, int wc, int fr, int fq) const {
        const int nrt = eoff[64] >> 8;
        const bool shared = un.e == 64;
        const int row0 = shared ? SH_ROW0 + (un.pm - nrt) * 256 : un.pm * 256;
        EPI_ROWS_BEGIN
            const int row = row0 + rloc;
            const float w = shared ? 1.0f : roww[row];
            const f32x4 g0 = acc[ai][0][m][0], g1 = acc[ai][0][m][1], u0 = acc[ai][1][m][0], u1 = acc[ai][1][m][1];
            f32x4 h0, h1;
#pragma unroll
            for (int q = 0; q < 4; ++q) { h0[q] = g0[q] * sigmoidf_(g0[q]) * u0[q] * w; h1[q] = g1[q] * sigmoidf_(g1[q]) * u1[q] * w; }
            *(u32x4*)(H + (size_t)row * FF + un.pn * 128 + wc * 32 + fq * 8) = pack8(h0, h1);
        EPI_ROWS_END
    }
};
struct EpiDown {
    unsigned char* yslot; float* out; const bf16_t* x1; const int* rowtok; const int* eoff;
    __device__ __forceinline__ void operator()(const Acc& acc, const Unit& un, int wr, int wc, int fr, int fq) const {
        const int nrt = eoff[64] >> 8;
        if (un.e < 64) {
            EPI_ROWS_BEGIN
                const int slot = rowtok[un.pm * 256 + rloc];
                if (slot >= 0) {
#pragma unroll
                    for (int bj = 0; bj < 2; ++bj) { const int col = un.pn * 256 + bj * 128 + wc * 32 + fq * 8;
                        const f32x4 v0 = acc[ai][bj][m][0] * SLOT_SCALE, v1 = acc[ai][bj][m][1] * SLOT_SCALE;
                        int p0 = __builtin_amdgcn_cvt_pk_fp8_f32(v0[0], v0[1], 0, false); p0 = __builtin_amdgcn_cvt_pk_fp8_f32(v0[2], v0[3], p0, true);
                        int p1 = __builtin_amdgcn_cvt_pk_fp8_f32(v1[0], v1[1], 0, false); p1 = __builtin_amdgcn_cvt_pk_fp8_f32(v1[2], v1[3], p1, true);
                        uint2 w; w.x = (unsigned)p0; w.y = (unsigned)p1;
                        *(uint2*)(yslot + (size_t)slot * D + col) = w; }
                }
            EPI_ROWS_END
        } else {
            EPI_ROWS_BEGIN
                const int t = (un.pm - nrt) * 256 + rloc;
#pragma unroll
                for (int bj = 0; bj < 2; ++bj) { const int col = un.pn * 256 + bj * 128 + wc * 32 + fq * 8;
                    const bf16x8 xv = *(const bf16x8*)(x1 + (size_t)t * D + col);
                    f32x4 o0, o1;
#pragma unroll
                    for (int q = 0; q < 4; ++q) { o0[q] = acc[ai][bj][m][0][q] + ALPHA * bf2f((bf16_t)xv[q]); o1[q] = acc[ai][bj][m][1][q] + ALPHA * bf2f((bf16_t)xv[4 + q]); }
                    *(f32x4*)(out + (size_t)t * D + col) = o0; *(f32x4*)(out + (size_t)t * D + col + 4) = o1; }
            EPI_ROWS_END
        }
    }
};
}
namespace g8 {
struct EpiRouter {
    float* logits;
    __device__ __forceinline__ void operator()(const Acc& acc, const Unit& un, int wr, int wc, int fr, int fq) const {
        if (wc >= 2) return;
        EPI_ROWS_BEGIN
            float* o = logits + (size_t)(un.pm * 256 + rloc) * NE + wc * 32 + fq * 8;
            *(f32x4*)o = acc[ai][0][m][0]; *(f32x4*)(o + 4) = acc[ai][0][m][1];
        EPI_ROWS_END
    }
};
}
__device__ __forceinline__ void fp_gemm_router(const Ptrs& P, LAS unsigned char* lds) {
    g8::Geo g{2048, 2048, 128, 128, 0};
    g8::SchedReg S{(const char*)WSP(bf16_t, WS_X1), (const char*)WSP(bf16_t, WS_WR), 2048, 2048, T / 256, 1, 16};
    g8::EpiRouter E{WSP(float, WS_LOGITS)};
    g8::gemm_body<g8::EpiRouter, g8::SchedReg, false>(lds, g, S, E);
}
__device__ __forceinline__ void ph_topk_cnt(const Ptrs& P, LAS unsigned char* lds, int bid, int nb) {
    const int tidx = opaque_tid();
    const float* logits = WSP(float, WS_LOGITS); int* topi = WSP(int, WS_TOPI); float* topw = WSP(float, WS_TOPW); int* cnt = WSP(int, WS_CNT);
    LAS int* hist = (LAS int*)lds;
    const int lane = tidx & 63, w = tidx >> 6;
    for (int tile = bid; tile < 256; tile += nb) {
        if (tidx < 64) hist[tidx] = 0;
        __syncthreads();
        for (int i = 0; i < 16; ++i) {
            const int t = tile * 128 + w * 16 + i;
            const float sc = sigmoidf_(logits[(size_t)t * NE + lane]);
            const float sel = sc + P.router_bias[lane];
            const int grp = lane >> 3;
            float m1 = sel;
            m1 = fmaxf(m1, __shfl_xor(m1, 1)); m1 = fmaxf(m1, __shfl_xor(m1, 2)); m1 = fmaxf(m1, __shfl_xor(m1, 4));
            const unsigned long long bal = __ballot(sel == m1) & (0xFFull << (8 * grp));
            const int first = __ffsll((long long)bal) - 1;
            float m2 = (lane == first) ? -INFINITY : sel;
            m2 = fmaxf(m2, __shfl_xor(m2, 1)); m2 = fmaxf(m2, __shfl_xor(m2, 2)); m2 = fmaxf(m2, __shfl_xor(m2, 4));
            const float gs = m1 + m2;
            int cg = 0;
#pragma unroll
            for (int gj = 0; gj < 8; ++gj) { const float sj = __shfl(gs, gj * 8); cg += (sj > gs || (sj == gs && gj < grp)) ? 1 : 0; }
            const bool gsel = cg < 4;
            const float v = gsel ? sel : -INFINITY;
            int rank = 0;
#pragma unroll 8
            for (int e2 = 0; e2 < 64; ++e2) { const float ve = __shfl(v, e2); rank += (ve > v || (ve == v && e2 < lane)) ? 1 : 0; }
            const bool chosen = gsel && rank < TOPK;
            const float wsum = wave_sum(chosen ? sc : 0.f);
            if (chosen) { topi[(size_t)t * TOPK + rank] = lane; topw[(size_t)t * TOPK + rank] = sc / wsum * 2.5f; atomicAdd((int*)&hist[lane], 1); }
        }
        __syncthreads();
        if (tidx < 64) cnt[tile * 64 + tidx] = hist[tidx];
        __syncthreads();
    }
}
__device__ __forceinline__ void ph_lists2(const Ptrs& P, LAS unsigned char* lds, int bid, int nb) {
    const int tidx = opaque_tid();
    const int* topi = WSP(int, WS_TOPI); const float* topw = WSP(float, WS_TOPW); const int* cnt = WSP(int, WS_CNT);
    int* eoff = WSP(int, WS_EOFF); int* rowtok = WSP(int, WS_ROWTOK); float* roww = WSP(float, WS_ROWW);
    LAS int* red_tot = (LAS int*)lds;
    LAS int* red_pre = red_tot + 512;
    LAS int* tot = red_pre + 512;
    LAS int* off = tot + 64;
    LAS int* seg = off + 128;
    LAS int* ti = seg + 512;
    const int e = tidx & 63, part = tidx >> 6;
    for (int tile = bid; tile < 256; tile += nb) {
        int st = 0, sp = 0;
        for (int t2 = part * 32; t2 < part * 32 + 32; ++t2) { const int c = cnt[t2 * 64 + e]; st += c; sp += (t2 < tile) ? c : 0; }
        red_tot[part * 64 + e] = st; red_pre[part * 64 + e] = sp;
        ti[tidx] = topi[tile * 1024 + tidx]; ti[tidx + 512] = topi[tile * 1024 + 512 + tidx];
        __syncthreads();
        int pre_e = 0;
        if (tidx < 64) { int a = 0; for (int q = 0; q < 8; ++q) { a += red_tot[q * 64 + tidx]; pre_e += red_pre[q * 64 + tidx]; } tot[tidx] = a; }
        __syncthreads();
        if (tidx == 0) { int o = 0; for (int i = 0; i < 64; ++i) { off[i] = o; o += (tot[i] + 255) & ~255; } off[64] = o; }
        int c = 0;
        for (int k = 0; k < 128; ++k) c += (ti[part * 128 + k] == e) ? 1 : 0;
        seg[part * 64 + e] = c;
        __syncthreads();
        if (tidx < 64) { red_pre[tidx] = pre_e; }
        __syncthreads();
        int pos = off[e] + red_pre[e];
        for (int q = 0; q < part; ++q) pos += seg[q * 64 + e];
        for (int k = 0; k < 128; ++k) { const int idx = part * 128 + k; if (ti[idx] == e) { rowtok[pos] = tile * 1024 + idx; roww[pos] = topw[tile * 1024 + idx]; ++pos; } }
        if (tile == 255 && part == 7) { const int end = off[e + 1]; for (; pos < end; ++pos) { rowtok[pos] = -1; roww[pos] = 0.f; } }
        if (bid == 0 && tidx <= 64) eoff[tidx] = off[tidx];
        __syncthreads();
    }
    for (int i = bid * NTHR + tidx; i < T; i += nb * NTHR) rowtok[SH_ROW0 + i] = i * 8;
}
__device__ __forceinline__ void fp_gemm_win(const Ptrs& P, LAS unsigned char* lds) {
    g8::Geo g{2048, 2048, 128, 128, 0};
    g8::SchedReg S{(const char*)WSP(bf16_t, WS_XN), (const char*)WSP(bf16_t, WS_WIN), 2048, 2048, T / 256, 4, 16};
    g8::EpiWin E{WSP(bf16_t, WS_CQ), WSP(bf16_t, WS_CKV), WSP(bf16_t, WS_U), WSP(bf16_t, WS_K), WSP(float2, WS_ROPE), WSP(float, WS_RSQ), WSP(float, WS_RSKV)};
    g8::gemm_body<g8::EpiWin, g8::SchedReg, false>(lds, g, S, E);
}
__device__ __forceinline__ void fp_gemm_q(const Ptrs& P, LAS unsigned char* lds) {
    g8::Geo g{512, 512, 128, 128, 0};
    g8::SchedReg S{(const char*)WSP(bf16_t, WS_CQ), (const char*)WSP(bf16_t, WS_WUQ), 512, 512, T / 256, 3, 4};
    g8::EpiQ E{WSP(bf16_t, WS_Q), WSP(float, WS_RSQ), WSP(float2, WS_ROPE)};
    g8::gemm_body<g8::EpiQ, g8::SchedReg, false>(lds, g, S, E);
}
__device__ __forceinline__ void fp_gemm_kv(const Ptrs& P, LAS unsigned char* lds) {
    g8::Geo g{512, 512, 128, 128, 0};
    g8::SchedReg S{(const char*)WSP(bf16_t, WS_CKV), (const char*)WSP(bf16_t, WS_WUKV), 512, 512, T / 256, 4, 4};
    g8::EpiKV E{WSP(bf16_t, WS_K), WSP(bf16_t, WS_V), WSP(float, WS_RSKV)};
    g8::gemm_body<g8::EpiKV, g8::SchedReg, false>(lds, g, S, E);
}
__device__ __forceinline__ void fp_gemm_s5b(const Ptrs& P, LAS unsigned char* lds) {
    g8::Geo g{2048, 2048, 128, 128, 0};
    g8::SchedS5 S{(const char*)WSP(bf16_t, WS_U), (const char*)WSP(bf16_t, WS_BLOC), 2048, 2048, 1, 16, (size_t)512 * 2048, (size_t)256 * 2048, 0};
    g8::EpiS5b E{WSP(float, WS_XLOC)};
    g8::gemm_body<g8::EpiS5b, g8::SchedS5, false>(lds, g, S, E);
}
__device__ __forceinline__ void fp_gemm_s5a(const Ptrs& P, LAS unsigned char* lds) {
    g8::Geo g{2048, 32, 128, -2048, 1};
    g8::SchedS5 S{(const char*)WSP(bf16_t, WS_U), (const char*)WSP(bf16_t, WS_KTAB), 2048, 32, 4, 16, (size_t)512 * 2048, 0, 1};
    g8::EpiS5y<0> E{WSP(bf16_t, WS_YINTRA), nullptr};
    g8::gemm_body<g8::EpiS5y<0>, g8::SchedS5, false>(lds, g, S, E);
}
__device__ __forceinline__ void fp_gemm_s5d(const Ptrs& P, LAS unsigned char* lds) {
    g8::Geo g{512, 512, 128, 128, 0};
    g8::SchedS5 S{(const char*)WSP(bf16_t, WS_XPREV), (const char*)WSP(bf16_t, WS_CLAM), 512, 512, 4, 4, (size_t)512 * 512, (size_t)1024 * 512, 0};
    g8::EpiS5y<1> E{WSP(bf16_t, WS_Y), WSP(bf16_t, WS_YINTRA)};
    g8::gemm_body<g8::EpiS5y<1>, g8::SchedS5, false>(lds, g, S, E);
}
__device__ __forceinline__ void fp_gemm_glu(const Ptrs& P, LAS unsigned char* lds) {
    g8::Geo g{1024, 1024, 128, 128, 0};
    g8::SchedReg S{(const char*)WSP(bf16_t, WS_Y), (const char*)WSP(bf16_t, WS_WGLU), 1024, 1024, T / 256, 2, 8};
    g8::EpiGlu E{WSP(bf16_t, WS_Y), P.b_glu, WSP(bf16_t, WS_AS)};
    g8::gemm_body<g8::EpiGlu, g8::SchedReg, false>(lds, g, S, E);
}
__device__ __forceinline__ void fp_gemm_wo(const Ptrs& P, LAS unsigned char* lds) {
    g8::Geo g{2048, 2048, 128, 128, 0};
    g8::SchedReg S{(const char*)WSP(bf16_t, WS_AS), (const char*)WSP(bf16_t, WS_WO), 2048, 2048, T / 256, 4, 16};
    g8::EpiWo E{P.x, WSP(float, WS_XSTAT), P.ln_in_g, P.ln_in_b, P.out};
    g8::gemm_body<g8::EpiWo, g8::SchedReg, false>(lds, g, S, E);
}
__device__ __forceinline__ void fp_gemm_gu(const Ptrs& P, LAS unsigned char* lds) {
    g8::Geo g{2048, 2048, 128, 128, 0};
    g8::SchedMoe S{(const char*)WSP(bf16_t, WS_X1), (const char*)WSP(bf16_t, WS_WGU), WSP(int, WS_EOFF), WSP(int, WS_ROWTOK), 2048, 2, 16, (size_t)512 * 2048, 2048, 1};
    g8::EpiGU E{WSP(bf16_t, WS_H), WSP(float, WS_ROWW), WSP(int, WS_EOFF)};
    g8::gemm_body<g8::EpiGU, g8::SchedMoe, true>(lds, g, S, E);
}
__device__ __forceinline__ void fp_gemm_down(const Ptrs& P, LAS unsigned char* lds) {
    g8::Geo g{512, 512, 128, 128, 0};
    g8::SchedMoe S{(const char*)WSP(bf16_t, WS_H), (const char*)WSP(bf16_t, WS_WD), WSP(int, WS_EOFF), WSP(int, WS_ROWTOK), 512, 4, 4, (size_t)1024 * 512, 512, 0};
    g8::EpiDown E{WSP(unsigned char, WS_YSLOT), P.out, WSP(bf16_t, WS_X1), WSP(int, WS_ROWTOK), WSP(int, WS_EOFF)};
    g8::gemm_body<g8::EpiDown, g8::SchedMoe, false>(lds, g, S, E);
}
namespace at8 {
typedef short s16x4 __attribute__((ext_vector_type(4)));
typedef short v4i16_t __attribute__((ext_vector_type(4)));
constexpr int KSLOT = 12288, VSLOT = 8192, NSLOT = 3;
constexpr int L_K = 0, L_V = NSLOT * KSLOT, L_WS = L_V + NSLOT * VSLOT, L_OST = L_WS + 8 * 256, L_END = L_OST + 8 * 4096;
__device__ __forceinline__ int crow(int r, int hi) { return (r & 3) + 8 * (r >> 2) + 4 * hi; }
__device__ __forceinline__ void glds16(const void* gsrc, LAS unsigned char* dst) { __builtin_amdgcn_global_load_lds((const unsigned*)gsrc, (LAS unsigned*)dst, 16, 0, 0); }
__device__ __forceinline__ s16x4 vtr(const LAS unsigned char* p) { return __builtin_bit_cast(s16x4, __builtin_amdgcn_ds_read_tr16_b64_v4i16((LAS v4i16_t*)p)); }
__device__ __forceinline__ unsigned cvtpk(float lo, float hi) { return (unsigned)f2bf(lo) | ((unsigned)f2bf(hi) << 16); }

__device__ __forceinline__ void attn_unit(int b, int h, int qb, const bf16_t* __restrict__ Q, const bf16_t* __restrict__ Kc, const bf16_t* __restrict__ V, bf16_t* __restrict__ AS, LAS unsigned char* lds) {
    const int tid = opaque_tid(), lane = tid & 63, r32 = lane & 31, hi = lane >> 5;
    const int wid = __builtin_amdgcn_readfirstlane(tid >> 6);
    const size_t bh = (size_t)b * NH + h;
    const bf16_t* Kbh = Kc + bh * SEQ * QKD; const bf16_t* Vbh = V + bh * SEQ * VD;
    const int q0 = qb * 256 + wid * 32;
    const int NT = 4 * (qb + 1);
    const int myNT = 4 * qb + (wid >> 1) + 1;
    const bf16_t* ksrc0 = Kbh + (size_t)lane * QKD + wid * 8;
    const bf16_t* ksrc1 = Kbh + (size_t)lane * QKD + (8 + (wid & 3)) * 8;
    const bf16_t* vsrc = Vbh + (size_t)(16 * (wid & 3) + (lane >> 2)) * VD + (wid >> 2) * 32 + (lane & 3) * 8;
#define AT_DMA(t, slot) do { glds16(ksrc0 + (size_t)(t) * 64 * QKD, lds + L_K + (slot) * KSLOT + wid * 1024); \
                             glds16(ksrc1 + (size_t)(t) * 64 * QKD, lds + L_K + (slot) * KSLOT + (8 + (wid & 3)) * 1024); \
                             glds16(vsrc + (size_t)(t) * 64 * VD, lds + L_V + (slot) * VSLOT + wid * 1024); } while (0)
    AT_DMA(0, 0);
    if (NT > 1) AT_DMA(1, 1);
    bf16x8 qr[6];
    const bf16_t* qp = Q + (bh * SEQ + q0 + r32) * QKD + hi * 8;
#pragma unroll
    for (int ks = 0; ks < 6; ++ks) qr[ks] = *(const bf16x8*)(qp + ks * 16);
    f32x16 o0, o1;
#pragma unroll
    for (int i = 0; i < 16; ++i) { o0[i] = 0.f; o1[i] = 0.f; }
    float m_run = -1e30f, l_run = 0.f;
    LAS float* wsf = (LAS float*)(lds + L_WS) + wid * 64;
    const LAS unsigned char* kp0 = lds + L_K + hi * 1024 + r32 * 16;
    const LAS unsigned char* vp0 = lds + L_V + ((lane >> 4) & 1) * 32 + (lane & 3) * 8 + (4 * hi + ((lane & 15) >> 2)) * 64;
    int slot = 0;
    for (int t = 0; t < NT; ++t) {
        if (t + 1 < NT) asm volatile("s_waitcnt vmcnt(3)" ::: "memory"); else asm volatile("s_waitcnt vmcnt(0)" ::: "memory");
        asm volatile("s_waitcnt lgkmcnt(0)\n\ts_barrier" ::: "memory");
        if (t + 2 < NT) { const int s2 = (slot == 0) ? 2 : slot - 1; AT_DMA(t + 2, s2); }
        if (t < myNT) {
            const LAS unsigned char* kp = kp0 + slot * KSLOT; const LAS unsigned char* vp = vp0 + slot * VSLOT;
            f32x16 p0, p1;
#pragma unroll
            for (int i = 0; i < 16; ++i) { p0[i] = 0.f; p1[i] = 0.f; }
#pragma unroll
            for (int ks = 0; ks < 6; ++ks) {
                const bf16x8 a0 = *(const LAS bf16x8*)(kp + ks * 2048), a1 = *(const LAS bf16x8*)(kp + ks * 2048 + 512);
                p0 = __builtin_amdgcn_mfma_f32_32x32x16_bf16(a0, qr[ks], p0, 0, 0, 0);
                p1 = __builtin_amdgcn_mfma_f32_32x32x16_bf16(a1, qr[ks], p1, 0, 0, 0);
            }
            float rm = fmaxf(p0[0], p1[0]);
#pragma unroll
            for (int i = 1; i < 16; ++i) rm = fmaxf(rm, fmaxf(p0[i], p1[i]));
            { auto rr = __builtin_amdgcn_permlane32_swap(__float_as_uint(rm), __float_as_uint(rm), false, false); rm = fmaxf(__uint_as_float(rr[0]), __uint_as_float(rr[1])); }
            if (__any(rm > m_run + 8.0f)) {
                const float m_new = fmaxf(m_run, rm);
                const float alpha = __builtin_amdgcn_exp2f(m_run - m_new);
                l_run *= alpha; m_run = m_new;
                if (hi == 0) wsf[r32] = alpha;
                asm volatile("s_waitcnt lgkmcnt(0)" ::: "memory");
#pragma unroll
                for (int i = 0; i < 16; ++i) { const float a = wsf[crow(i, hi)]; o0[i] *= a; o1[i] *= a; }
            }
            float ls = 0.f;
#pragma unroll
            for (int i = 0; i < 16; ++i) { p0[i] = __builtin_amdgcn_exp2f(p0[i] - m_run); p1[i] = __builtin_amdgcn_exp2f(p1[i] - m_run); ls += p0[i] + p1[i]; }
            l_run += ls;
            u32x4 w0, w1, w2, w3;
            w0 = (u32x4){cvtpk(p0[0], p0[1]), cvtpk(p0[2], p0[3]), cvtpk(p0[4], p0[5]), cvtpk(p0[6], p0[7])};
            w1 = (u32x4){cvtpk(p0[8], p0[9]), cvtpk(p0[10], p0[11]), cvtpk(p0[12], p0[13]), cvtpk(p0[14], p0[15])};
            w2 = (u32x4){cvtpk(p1[0], p1[1]), cvtpk(p1[2], p1[3]), cvtpk(p1[4], p1[5]), cvtpk(p1[6], p1[7])};
            w3 = (u32x4){cvtpk(p1[8], p1[9]), cvtpk(p1[10], p1[11]), cvtpk(p1[12], p1[13]), cvtpk(p1[14], p1[15])};
            const bf16x8 pa[4] = {__builtin_bit_cast(bf16x8, w0), __builtin_bit_cast(bf16x8, w1), __builtin_bit_cast(bf16x8, w2), __builtin_bit_cast(bf16x8, w3)};
#pragma unroll
            for (int k = 0; k < 4; ++k) {
                const s16x4 l0 = vtr(vp + k * 1024), h0 = vtr(vp + k * 1024 + 512), l1 = vtr(vp + 4096 + k * 1024), h1 = vtr(vp + 4096 + k * 1024 + 512);
                const bf16x8 v0 = (bf16x8){l0[0], l0[1], l0[2], l0[3], h0[0], h0[1], h0[2], h0[3]};
                const bf16x8 v1 = (bf16x8){l1[0], l1[1], l1[2], l1[3], h1[0], h1[1], h1[2], h1[3]};
                o0 = __builtin_amdgcn_mfma_f32_32x32x16_bf16(pa[k], v0, o0, 0, 0, 0);
                o1 = __builtin_amdgcn_mfma_f32_32x32x16_bf16(pa[k], v1, o1, 0, 0, 0);
            }
        }
        slot = (slot == 2) ? 0 : slot + 1;
    }
    { auto rr = __builtin_amdgcn_permlane32_swap(__float_as_uint(l_run), __float_as_uint(l_run), false, false); l_run = __uint_as_float(rr[0]) + __uint_as_float(rr[1]); }
    if (hi == 0) wsf[32 + r32] = l_run;
    asm volatile("s_waitcnt lgkmcnt(0)" ::: "memory");
    LAS bf16_t* stg = (LAS bf16_t*)(lds + L_OST) + wid * 2048;
#pragma unroll
    for (int i = 0; i < 16; ++i) { const int orow = crow(i, hi); const float rl = 1.0f / wsf[32 + orow];
        stg[orow * 64 + r32] = f2bf(o0[i] * rl); stg[orow * 64 + 32 + r32] = f2bf(o1[i] * rl); }
    asm volatile("s_waitcnt lgkmcnt(0)" ::: "memory");
    bf16_t* Ow = AS + ((size_t)b * SEQ + q0) * 1024 + h * 64;
#pragma unroll
    for (int i = 0; i < 4; ++i) { const int row = i * 8 + (lane >> 3), ch = lane & 7; const u32x4 v = *(const LAS u32x4*)(stg + row * 64 + ch * 8); *(u32x4*)(Ow + (size_t)row * 1024 + ch * 8) = v; }
    asm volatile("s_waitcnt lgkmcnt(0)\n\ts_barrier" ::: "memory");
#undef AT_DMA
}
__device__ __forceinline__ void attn_phase(const Ptrs& P, LAS unsigned char* lds, int bid, int nb) {
    const bf16_t* Q = WSP(bf16_t, WS_Q); const bf16_t* Kc = WSP(bf16_t, WS_K); const bf16_t* V = WSP(bf16_t, WS_V); bf16_t* AS = WSP(bf16_t, WS_AS);
    const int vcu = ((nb & 7) == 0) ? (bid & 7) * (nb >> 3) + (bid >> 3) : bid;
    for (int p = vcu; p < 512; p += nb) {
        const int bh = p >> 2, s = p & 3;
        attn_unit(bh >> 3, bh & 7, 7 - s, Q, Kc, V, AS, lds);
        attn_unit(bh >> 3, bh & 7, s, Q, Kc, V, AS, lds);
    }
}
}
__global__ void __launch_bounds__(NTHR, 2) mega(Args a) {
    extern __shared__ __attribute__((aligned(16))) unsigned char lds_raw[];
    LAS unsigned char* lds = (LAS unsigned char*)lds_raw;
    Ptrs P;
    P.x = (const float*)a.in[0]; P.positions = (const int*)a.in[1]; P.ln_in_g = (const float*)a.in[2]; P.ln_in_b = (const float*)a.in[3];
    P.w_in = (const float*)a.in[4]; P.q_norm_g = (const float*)a.in[5]; P.kv_norm_g = (const float*)a.in[6]; P.w_uq = (const float*)a.in[7]; P.w_ukv = (const float*)a.in[8];
    P.lambda_re = (const float*)a.in[9]; P.lambda_im = (const float*)a.in[10]; P.log_step = (const float*)a.in[11]; P.b_re = (const float*)a.in[12]; P.b_im = (const float*)a.in[13];
    P.c_re = (const float*)a.in[14]; P.c_im = (const float*)a.in[15]; P.d_skip = (const float*)a.in[16]; P.w_glu = (const float*)a.in[17]; P.b_glu = (const float*)a.in[18];
    P.attn_out_g = (const float*)a.in[19]; P.ssm_out_g = (const float*)a.in[20]; P.w_o = (const float*)a.in[21]; P.ln1_g = (const float*)a.in[22]; P.ln1_b = (const float*)a.in[23];
    P.w_router = (const float*)a.in[24]; P.router_bias = (const float*)a.in[25]; P.w_gate = (const float*)a.in[26]; P.w_up = (const float*)a.in[27]; P.w_down = (const float*)a.in[28];
    P.ws_gate = (const float*)a.in[29]; P.ws_up = (const float*)a.in[30]; P.ws_down = (const float*)a.in[31]; P.ln2_g = (const float*)a.in[32]; P.ln2_b = (const float*)a.in[33];
    P.out = a.out; P.ws = a.ws;
    const int bid = blockIdx.x, nb = gridDim.x;
    volatile LAS unsigned* misc = (volatile LAS unsigned*)(lds + LDS_MISC);
    if (threadIdx.x < 64) misc[threadIdx.x] = 0u;
    __syncthreads();
    XcdBarrier bar = xcd_barrier_post((unsigned*)(P.ws + WS_CTL) + 4096, misc);
#define GRID_BAR() xcd_barrier(bar)

    ph_ln_in(P, bid, nb); ph_wprep(P, lds, bid, nb); ph_s5tab1(P, bid, nb); ph_ropetab(P, bid, nb);
    GRID_BAR();
    ph_s5tab2(P, bid, nb);
#if FAST_WIN
    fp_gemm_win(P, lds);
    GRID_BAR();
#else
    ph_gemm_win(P, bid, nb);
    GRID_BAR();
    ph_rstat(P, bid, nb);
    GRID_BAR();
#endif
#if FAST_QKV
    fp_gemm_q(P, lds); fp_gemm_kv(P, lds);
#else
    ph_gemm_q(P, bid, nb); ph_gemm_kv(P, bid, nb);
#endif
#if FAST_S5
    fp_gemm_s5b(P, lds); fp_gemm_s5a(P, lds);
#else
    ph_gemm_s5b(P, bid, nb); ph_gemm_s5a(P, bid, nb);
#endif
    GRID_BAR();
#if !FAST_QKV || !FAST_WIN
    ph_rope_apply(P, bid, nb);
#endif
    ph_s5scan(P, bid, nb);
#if !FAST_QKV || !FAST_WIN
    GRID_BAR();
#endif
#if FAST_ATTN
    at8::attn_phase(P, lds, bid, nb);
#else
    ph_attn_simple(P, lds, bid, nb);
#endif
    GRID_BAR();
#if FAST_S5
    fp_gemm_s5d(P, lds);
#else
    ph_gemm_s5d(P, bid, nb);
#endif
    GRID_BAR();
#if FAST_GLU
    fp_gemm_glu(P, lds);
#else
    ph_gemm_glu(P, bid, nb);
#endif
    GRID_BAR();
    ph_asnorm(P, bid, nb);
    GRID_BAR();
#if FAST_WO
    fp_gemm_wo(P, lds);
#else
    ph_gemm_wo(P, bid, nb);
#endif
    GRID_BAR();
    ph_ln1(P, bid, nb);
    GRID_BAR();
    fp_gemm_router(P, lds);
    GRID_BAR();
    ph_topk_cnt(P, lds, bid, nb);
    GRID_BAR();
    ph_lists2(P, lds, bid, nb);
    GRID_BAR();
#if FAST_MOE
    fp_gemm_gu(P, lds);
    GRID_BAR();
    fp_gemm_down(P, lds);
#else
    ph_gemm_gu(P, bid, nb);
    GRID_BAR();
    ph_gemm_down(P, bid, nb);
#endif
    GRID_BAR();
    ph_combine(P, bid, nb);
}

extern "C" void kernel_launch(void* const* d_in, const int* in_sizes, int n_in, void* d_out, int out_size, void* d_ws, size_t ws_size, hipStream_t stream) {
    (void)in_sizes; (void)out_size;
    if (ws_size < WS_NEED || n_in != 34) return;
    static int grid = 0;
    if (grid == 0) {
        int dev = 0, cus = 0;
        if (hipGetDevice(&dev) != hipSuccess || hipDeviceGetAttribute(&cus, hipDeviceAttributeMultiprocessorCount, dev) != hipSuccess) { grid = -1; return; }
        if (hipFuncSetAttribute((const void*)mega, hipFuncAttributeMaxDynamicSharedMemorySize, LDS_BYTES) != hipSuccess) { grid = -1; return; }
        int per_cu = 0;
        if (hipOccupancyMaxActiveBlocksPerMultiprocessor(&per_cu, (const void*)mega, NTHR, LDS_BYTES) != hipSuccess || per_cu < 1) { (void)hipGetLastError(); }
        grid = cus;
    }
    if (grid < 0) return;
    (void)hipMemsetAsync((char*)d_ws + WS_CTL, 0, 1 << 20, stream);
    Args a; memset(&a, 0, sizeof(a));
    for (int i = 0; i < 34; ++i) a.in[i] = d_in[i];
    a.out = (float*)d_out; a.ws = (unsigned char*)d_ws;
    hipLaunchKernelGGL(mega, dim3(grid), dim3(NTHR), LDS_BYTES, stream, a);
}
```

```cpp
#include <hip/hip_runtime.h>
#include <stdint.h>
#include <string.h>

typedef unsigned short bf16_t;
typedef short bf16x8 __attribute__((ext_vector_type(8)));
typedef float f32x16 __attribute__((ext_vector_type(16)));
typedef float f32x4 __attribute__((ext_vector_type(4)));
typedef unsigned u32x4 __attribute__((ext_vector_type(4)));
typedef unsigned u32x2 __attribute__((ext_vector_type(2)));
typedef float f32x2 __attribute__((ext_vector_type(2)));

#ifndef FAST_WIN
#define FAST_WIN 1
#endif
#ifndef FAST_QKV
#define FAST_QKV 1
#endif
#ifndef FAST_S5
#define FAST_S5 1
#endif
#ifndef FAST_GLU
#define FAST_GLU 1
#endif
#ifndef FAST_WO
#define FAST_WO 1
#endif
#ifndef FAST_ATTN
#define FAST_ATTN 1
#endif
#ifndef FAST_MOE
#define FAST_MOE 1
#endif
constexpr int T = 32768, D = 1024, SEQ = 2048, NB = 16;
constexpr int NH = 8, QKD = 96, VD = 64;
constexpr int QRANK = 256, KVRANK = 128, ROPE = 32;
constexpr int SSMW = 512, SG = 32, SC = 16, SP = 64, CH = 64, NCH = SEQ / CH;
constexpr int NE = 64, TOPK = 8, FF = 256;
constexpr float ALPHA = 1.189207115002721f;
constexpr float EPS = 1e-5f;
constexpr float QSCALE = 0.10206207261596577f * 1.4426950408889634f;
constexpr float SLOT_SCALE = 64.0f;
constexpr int RROUT = 278528;
constexpr int SH_ROW0 = RROUT;
constexpr int RTOT = RROUT + T;

constexpr size_t MiB = 1ull << 20;
constexpr size_t WS_CTL = 0;
constexpr size_t WS_TOPI = 1 * MiB, WS_TOPW = 2 * MiB, WS_ROWTOK = 3 * MiB, WS_ROWW = 4 * MiB + MiB / 2;
constexpr size_t WS_CNT = 6 * MiB, WS_TOFF = 6 * MiB + 65536, WS_EOFF = 6 * MiB + 131072, WS_ECNT = 6 * MiB + 131072 + 1024;
constexpr size_t WS_TILEE = 6 * MiB + 262144;
constexpr size_t WS_WD = 7 * MiB;
constexpr size_t WS_X1 = 40 * MiB;
constexpr size_t WS_XN = WS_X1, WS_AS = WS_X1;
constexpr size_t WS_H = 104 * MiB;
constexpr size_t WS_CQ = 104 * MiB, WS_CKV = 120 * MiB, WS_U = 136 * MiB, WS_YINTRA = 168 * MiB, WS_Y = 200 * MiB;
constexpr size_t WS_QRRAW = 200 * MiB;
constexpr size_t WS_XLOC = 232 * MiB, WS_XPREV = 240 * MiB, WS_LOGITS = 248 * MiB, WS_KRRAW = 248 * MiB;
constexpr size_t WS_X1LO = 104 * MiB;
constexpr size_t WS_YSLOT = 256 * MiB;
constexpr size_t WS_WGU = 256 * MiB;
constexpr size_t WS_WIN = 321 * MiB, WS_WO = 323 * MiB, WS_WUQ = 325 * MiB, WS_WUKV = 325 * MiB + MiB / 2, WS_WGLU = 326 * MiB;
constexpr size_t WS_WR = 326 * MiB + MiB / 2;
constexpr size_t WS_BLOC = 327 * MiB, WS_CLAM = 343 * MiB, WS_KTAB = 359 * MiB, WS_LAMPOW = 361 * MiB, WS_BBAR = 363 * MiB;
constexpr size_t WS_ROPE = 364 * MiB, WS_XSTAT = 368 * MiB, WS_RSQ = 368 * MiB + MiB / 2, WS_RSKV = 369 * MiB;
constexpr size_t WS_Q = 370 * MiB, WS_K = 418 * MiB, WS_V = 466 * MiB;
constexpr size_t WS_LAMPOWT = 498 * MiB;
constexpr size_t WS_NEED = 512 * MiB;

__device__ __forceinline__ bf16_t f2bf(float f) { unsigned u = __float_as_uint(f); u += 0x7fffu + ((u >> 16) & 1u); return (bf16_t)(u >> 16); }
__device__ __forceinline__ float bf2f(bf16_t b) { return __uint_as_float(((unsigned)b) << 16); }
__device__ __forceinline__ int crow(int i, int h) { return (i & 3) + 8 * (i >> 2) + 4 * h; }
__device__ __forceinline__ float wave_sum(float v) {
#pragma unroll
    for (int o = 32; o > 0; o >>= 1) v += __shfl_xor(v, o);
    return v;
}
__device__ __forceinline__ float wave_max(float v) {
#pragma unroll
    for (int o = 32; o > 0; o >>= 1) v = fmaxf(v, __shfl_xor(v, o));
    return v;
}
__device__ __forceinline__ float sigmoidf_(float z) { return 1.0f / (1.0f + __expf(-z)); }
__device__ __forceinline__ float gelu_tanh(float y) {
    const float z = 0.7978845608028654f * (y + 0.044715f * y * y * y);
    const float th = 1.0f - 2.0f / (1.0f + __expf(2.0f * z));
    return 0.5f * y * (1.0f + th);
}
__host__ __device__ __forceinline__ int ropeperm(int q) { return 16 * ((q >> 2) & 1) + 4 * (q >> 3) + (q & 3); }
__host__ __device__ __forceinline__ int ropepos(int j) { const int n = j >> 4, r = j & 15; return 8 * (r >> 2) + 4 * n + (r & 3); }

__device__ __forceinline__ void cexp_d(double re, double im, double& ore, double& oim) {
    const double s = 1.0 / 1048576.0;
    const double a = re * s, b = im * s;
    double tr = 1.0, ti = 0.0, sr = 1.0, si = 0.0;
#pragma unroll
    for (int n = 1; n <= 8; ++n) {
        const double nr = (tr * a - ti * b) / n, ni = (tr * b + ti * a) / n;
        tr = nr; ti = ni; sr += tr; si += ti;
    }
#pragma unroll
    for (int i = 0; i < 20; ++i) { const double nr = sr * sr - si * si, ni = 2.0 * sr * si; sr = nr; si = ni; }
    ore = sr; oim = si;
}

__device__ __forceinline__ int opaque_tid() { int t = threadIdx.x; asm volatile("" : "+v"(t)); return t; }
template <bool DUAL, class AF, class BF, class EPI>
__device__ __forceinline__ void sg_tile(int m0, int n0, int K, AF arow, BF bptr, EPI epi) {
    const int tidx = opaque_tid();
    const int lane = tidx & 63, r = lane & 31, h = lane >> 5;
    f32x16 acc, acc2;
#pragma unroll
    for (int i = 0; i < 16; ++i) { acc[i] = 0.f; acc2[i] = 0.f; }
    const bf16_t* ap = arow(m0 + r);
    for (int k0 = 0; k0 < K; k0 += 16) {
        const bf16x8 a = *(const bf16x8*)(ap + k0 + 8 * h);
        const bf16x8 b = *(const bf16x8*)(bptr(n0 + r, k0 + 8 * h, 0));
        acc = __builtin_amdgcn_mfma_f32_32x32x16_bf16(a, b, acc, 0, 0, 0);
        if (DUAL) {
            const bf16x8 b2 = *(const bf16x8*)(bptr(n0 + r, k0 + 8 * h, 1));
            acc2 = __builtin_amdgcn_mfma_f32_32x32x16_bf16(a, b2, acc2, 0, 0, 0);
        }
    }
#pragma unroll
    for (int i = 0; i < 16; ++i) epi(m0 + crow(i, h), n0 + r, acc[i], acc2[i]);
}

#define LAS __attribute__((address_space(3)))
#define XB_TMO      128
#define XB_XCNT(j)  (256  + 64 * (j))
#define XB_XSUB(j)  (1280 + 64 * (j))
#define XB_XGEN(j)  (2304 + 64 * (j))
#define XB_TOP      3328
#define XB_TOPGEN   3392
#define XCD_BAR_WORDS 3456
#define XB_SPIN_CAP (1u << 18)
__device__ __forceinline__ unsigned xb_ld(unsigned* p)              { return __hip_atomic_load(p, __ATOMIC_RELAXED, __HIP_MEMORY_SCOPE_AGENT); }
__device__ __forceinline__ unsigned xb_add(unsigned* p, unsigned v) { return __hip_atomic_fetch_add(p, v, __ATOMIC_RELAXED, __HIP_MEMORY_SCOPE_AGENT); }
__device__ __forceinline__ unsigned xb_xcc_id() { return (unsigned)__builtin_amdgcn_s_getreg((3 << 11) | 20) & 0xFu; }
#define XB_SPIN(cond, bar) do { unsigned _sp = 0; while (cond) { __builtin_amdgcn_s_sleep(1); \
    if ((++_sp & 255u) == 0u) { if (xb_ld(&(bar)[XB_TMO])) break; if (_sp > XB_SPIN_CAP) { atomicAdd(&(bar)[XB_TMO], 1u); break; } } } } while (0)
struct XcdBarrier { unsigned* bar; unsigned x; volatile LAS unsigned* st; };
__device__ __forceinline__ XcdBarrier xcd_barrier_post(unsigned* bar, volatile LAS unsigned* st) {
    XcdBarrier b; b.bar = bar; b.x = xb_xcc_id(); b.st = st;
    if (threadIdx.x == 0) (void)xb_add(&bar[XB_XCNT(b.x)], 1u);
    return b;
}
__device__ __forceinline__ void xcd_barrier_complete(unsigned* bar, unsigned x, unsigned& nloc, unsigned& nx) {
    const unsigned G = gridDim.x * gridDim.y * gridDim.z;
    unsigned sum, cnt, mine, sp = 0u;
    for (;;) {
        sum = 0u; cnt = 0u; mine = 0u;
#pragma unroll
        for (unsigned j = 0; j < 16; ++j) { const unsigned c = xb_ld(&bar[XB_XCNT(j)]); sum += c; cnt += (c > 0u) ? 1u : 0u; mine = (j == x) ? c : mine; }
        if (sum == G) break;
        __builtin_amdgcn_s_sleep(1);
        if ((++sp & 255u) == 0u) { if (xb_ld(&bar[XB_TMO])) break; if (sp > XB_SPIN_CAP) { atomicAdd(&bar[XB_TMO], 1u); break; } }
    }
    nloc = mine > 0u ? mine : 1u; nx = cnt > 0u ? cnt : 1u;
}
__device__ __forceinline__ void xcd_barrier(const XcdBarrier& b) {
    asm volatile("s_waitcnt vmcnt(0)" ::: "memory");
    __syncthreads();
    if (threadIdx.x == 0) {
        unsigned* bar = b.bar;
        __builtin_amdgcn_s_waitcnt(0);
        unsigned nloc = b.st[0], nx = b.st[1];
        if (nloc == 0u) { xcd_barrier_complete(bar, b.x, nloc, nx); b.st[0] = nloc; b.st[1] = nx; }
        const unsigned old = xb_add(&bar[XB_XSUB(b.x)], 1u);
        const unsigned gen = old / nloc;
        if (old + 1u == (gen + 1u) * nloc) {
            __builtin_amdgcn_fence(__ATOMIC_RELEASE, "agent");
            asm volatile("s_waitcnt vmcnt(0)" ::: "memory");
            const unsigned og = xb_add(&bar[XB_TOP], 1u);
            const unsigned tg = og / nx;
            if (og + 1u == (tg + 1u) * nx) xb_add(&bar[XB_TOPGEN], 1u);
            else XB_SPIN(xb_ld(&bar[XB_TOPGEN]) == tg, bar);
            __builtin_amdgcn_fence(__ATOMIC_ACQUIRE, "agent");
            xb_add(&bar[XB_XGEN(b.x)], 1u);
            asm volatile("s_waitcnt vmcnt(0)" ::: "memory");
        } else {
            XB_SPIN(xb_ld(&bar[XB_XGEN(b.x)]) == gen, bar);
            __builtin_amdgcn_fence(__ATOMIC_ACQUIRE, "agent");
            asm volatile("s_waitcnt vmcnt(0)" ::: "memory");
        }
    }
    __syncthreads();
}

constexpr int NTHR = 512, NWAVE = 8;
constexpr int LDS_BYTES = 163840;
constexpr int LDS_MISC = 163840 - 256;
constexpr int LDS_XTRA = 131072;
struct Args { const void* in[34]; float* out; unsigned char* ws; };
struct Ptrs {
    const float *x, *ln_in_g, *ln_in_b, *w_in, *q_norm_g, *kv_norm_g, *w_uq, *w_ukv, *lambda_re, *lambda_im, *log_step, *b_re, *b_im, *c_re, *c_im, *d_skip, *w_glu, *b_glu;
    const float *attn_out_g, *ssm_out_g, *w_o, *ln1_g, *ln1_b, *w_router, *router_bias, *w_gate, *w_up, *w_down, *ws_gate, *ws_up, *ws_down, *ln2_g, *ln2_b;
    const int* positions; float* out; unsigned char* ws;
};
#define WSP(T_, off) ((T_*)(P.ws + (off)))

__device__ __forceinline__ void ph_ln_in(const Ptrs& P, int bid, int nb) {
    const int tidx = opaque_tid();
    const int lane = tidx & 63, w = tidx >> 6;
    bf16_t* xn = WSP(bf16_t, WS_XN); float* xstat = WSP(float, WS_XSTAT);
    for (int t0 = (bid * NWAVE + w) * 2; t0 < T; t0 += nb * NWAVE * 2) {
        f32x4 q[2][4];
#pragma unroll
        for (int r = 0; r < 2; ++r)
#pragma unroll
            for (int i = 0; i < 4; ++i) q[r][i] = *(const f32x4*)(P.x + (size_t)(t0 + r) * D + i * 256 + lane * 4);
#pragma unroll
        for (int r = 0; r < 2; ++r) {
            const int t = t0 + r;
            float s = 0.f;
#pragma unroll
            for (int i = 0; i < 4; ++i) s += q[r][i][0] + q[r][i][1] + q[r][i][2] + q[r][i][3];
            const float mu = wave_sum(s) * (1.0f / D);
            float ss = 0.f;
#pragma unroll
            for (int i = 0; i < 4; ++i)
#pragma unroll
                for (int e = 0; e < 4; ++e) { const float d = q[r][i][e] - mu; ss += d * d; }
            const float rstd = rsqrtf(wave_sum(ss) * (1.0f / D) + EPS);
            if (lane == 0) { xstat[2 * t] = mu; xstat[2 * t + 1] = rstd; }
#pragma unroll
            for (int i = 0; i < 4; ++i) {
                const int c = i * 256 + lane * 4;
                const f32x4 gg = *(const f32x4*)(P.ln_in_g + c), bb = *(const f32x4*)(P.ln_in_b + c);
                ushort4 o;
                o.x = f2bf((q[r][i][0] - mu) * rstd * gg[0] + bb[0]); o.y = f2bf((q[r][i][1] - mu) * rstd * gg[1] + bb[1]);
                o.z = f2bf((q[r][i][2] - mu) * rstd * gg[2] + bb[2]); o.w = f2bf((q[r][i][3] - mu) * rstd * gg[3] + bb[3]);
                *(ushort4*)(xn + (size_t)t * D + c) = o;
            }
        }
    }
}
__device__ __forceinline__ int wprep_srccol(int mode, int n, int& which) {
    which = 0;
    switch (mode) {
    case 0: if (n < 256) return n; if (n < 768) return 416 + (n - 256); if (n < 896) return 256 + (n - 768); if (n < 928) return 384 + ropeperm(n - 896); return -1;
    case 1: if (n < 512) return (n >> 6) * 96 + (n & 63); { const int m = n - 512; return (m >> 5) * 96 + 64 + ropeperm(m & 31); }
    case 2: if (n < 512) return (n >> 6) * 128 + (n & 63); { const int m = n - 512; return (m >> 6) * 128 + 64 + (m & 63); }
    case 5: { const int pn = n >> 8, w = n & 255; which = w >> 7; return pn * 128 + (w & 127); }
    case 7: return n < 64 ? n : -1;
    default: return n;
    }
}
__device__ __forceinline__ void wprep_tile(LAS float* tile  , const float* s1, const float* s2, const float* ks, const float* ks2, bf16_t* dst,
                                           int mode, int Kd, int ldsrc, int Ksrc, float kmul, int n0, int k0) {
    const int tidx = opaque_tid();
    const int nn = tidx & 63, w = tidx >> 6;
    {
        int which; const int sc = wprep_srccol(mode, n0 + nn, which);
        const float* s = which ? s2 : s1;
        float v[32];
#pragma unroll
        for (int i = 0; i < 32; ++i) { const int k = k0 + w + 8 * i; v[i] = (sc >= 0 && k < Ksrc) ? s[(size_t)k * ldsrc + sc] : 0.f; }
#pragma unroll
        for (int i = 0; i < 32; ++i) { const int kk = w + 8 * i, k = k0 + kk; float x = v[i];
            if (ks && k < Ksrc) x *= (ks2 && k >= 512) ? ks2[k - 512] : ks[k];
            tile[kk * 65 + nn] = x * kmul; }
    }
    __syncthreads();
#pragma unroll
    for (int i = 0; i < 4; ++i) {
        const int kb = (i * 8 + w) * 8;
        u32x4 o;
#pragma unroll
        for (int j = 0; j < 4; ++j) o[j] = (unsigned)f2bf(tile[(kb + 2 * j) * 65 + nn]) | ((unsigned)f2bf(tile[(kb + 2 * j + 1) * 65 + nn]) << 16);
        *(u32x4*)(dst + (size_t)(n0 + nn) * Kd + k0 + kb) = o;
    }
    __syncthreads();
}
__device__ __forceinline__ void ph_wprep(const Ptrs& P, LAS unsigned char* lds, int bid, int nb) {
    LAS float* tile = (LAS float*)lds;
    constexpr int J0 = 64, J1 = J0 + 12, J2 = J1 + 16, J3 = J2 + 16, J4 = J3 + 64, J4b = J4 + 16, J5 = J4b + 65 * 32, J6 = J5 + 65 * 16;
    for (int j = bid; j < J6; j += nb) {
        if (j < J0)      { const int tl = j;      wprep_tile(tile, P.w_in, nullptr, nullptr, nullptr, WSP(bf16_t, WS_WIN), 0, 1024, 928, 1024, 1.0f, (tl / 4) * 64, (tl % 4) * 256); }
        else if (j < J1) { const int tl = j - J0; wprep_tile(tile, P.w_uq, nullptr, P.q_norm_g, nullptr, WSP(bf16_t, WS_WUQ), 1, 256, 768, 256, QSCALE, tl * 64, 0); }
        else if (j < J2) { const int tl = j - J1; wprep_tile(tile, P.w_ukv, nullptr, P.kv_norm_g, nullptr, WSP(bf16_t, WS_WUKV), 2, 256, 1024, 128, 1.0f, tl * 64, 0); }
        else if (j < J3) { const int tl = j - J2; wprep_tile(tile, P.w_glu, nullptr, nullptr, nullptr, WSP(bf16_t, WS_WGLU), 3, 512, 512, 512, 1.0f, (tl / 2) * 64, (tl % 2) * 256); }
        else if (j < J4) { const int tl = j - J3; wprep_tile(tile, P.w_o, nullptr, P.attn_out_g, P.ssm_out_g, WSP(bf16_t, WS_WO), 4, 1024, 1024, 1024, 1.0f, (tl / 4) * 64, (tl % 4) * 256); }
        else if (j < J4b) { const int tl = j - J4; wprep_tile(tile, P.w_router, nullptr, nullptr, nullptr, WSP(bf16_t, WS_WR), 7, 1024, 64, 1024, 1.0f, (tl / 4) * 64, (tl % 4) * 256); }
        else if (j < J5) { const int q = j - J4b, e = q / 32, tl = q % 32;
            const float* g = e < 64 ? P.w_gate + (size_t)e * 1024 * 256 : P.ws_gate; const float* u = e < 64 ? P.w_up + (size_t)e * 1024 * 256 : P.ws_up;
            wprep_tile(tile, g, u, nullptr, nullptr, WSP(bf16_t, WS_WGU) + (size_t)e * 512 * 1024, 5, 1024, 256, 1024, 1.0f, (tl / 4) * 64, (tl % 4) * 256); }
        else             { const int q = j - J5, e = q / 16, tl = q % 16;
            const float* d = e < 64 ? P.w_down + (size_t)e * 256 * 1024 : P.ws_down;
            wprep_tile(tile, d, nullptr, nullptr, nullptr, WSP(bf16_t, WS_WD) + (size_t)e * 1024 * 256, 6, 256, 1024, 256, 1.0f, tl * 64, 0); }
    }
}
__device__ __forceinline__ void ph_s5tab1(const Ptrs& P, int bid, int nb) {
    const int tidx = opaque_tid();
    float2* lampow = WSP(float2, WS_LAMPOW); float2* lampow_t = WSP(float2, WS_LAMPOWT); float2* bbar = WSP(float2, WS_BBAR);
    for (int i = bid * NTHR + tidx; i < SG * SP * 65 + SG * SP * SC; i += nb * NTHR) {
        const bool isb = i >= SG * SP * 65;
        const int q = isb ? i - SG * SP * 65 : i;
        const int gp = isb ? q >> 4 : q / 65, tau = isb ? 1 : q % 65, g = gp >> 6, p = gp & 63;
        double lr = (double)P.lambda_re[gp]; if (lr > -1e-4) lr = -1e-4;
        const double li = (double)P.lambda_im[gp];
        double st, dummy; cexp_d((double)P.log_step[g], 0.0, st, dummy);
        double br, bi; cexp_d(lr * st * tau, li * st * tau, br, bi);
        if (!isb) {
            const float2 v = make_float2((float)br, (float)bi);
            lampow[gp * 65 + tau] = v; lampow_t[(g * 65 + tau) * 64 + p] = v;
        } else {
            const int c = q & 15;
            const double nr = br - 1.0, ni = bi, den = lr * lr + li * li;
            const double cr = (nr * lr + ni * li) / den, ci = (ni * lr - nr * li) / den;
            const double xr = (double)P.b_re[gp * SC + c], xi = (double)P.b_im[gp * SC + c];
            bbar[gp * SC + c] = make_float2((float)(cr * xr - ci * xi), (float)(cr * xi + ci * xr));
        }
    }
}
__device__ __forceinline__ void ph_s5tab2(const Ptrs& P, LAS unsigned char* lds, int bid, int nb) {
    const int tidx = opaque_tid();
    const float2* lampow = WSP(float2, WS_LAMPOW); const float2* lampow_t = WSP(float2, WS_LAMPOWT); const float2* bbar = WSP(float2, WS_BBAR);
    bf16_t* ktab = WSP(bf16_t, WS_KTAB); bf16_t* bloc = WSP(bf16_t, WS_BLOC); bf16_t* clam = WSP(bf16_t, WS_CLAM);
    const int lane = tidx & 63, w = tidx >> 6;
    LAS f32x2* Cs = (LAS f32x2*)lds;
    LAS f32x2* Bs = Cs + 1024;
    LAS f32x2* Ls = Bs + 1024;
    for (int un = bid; un < SG * 8; un += nb) {
        const int g = un >> 3, tb = (un & 7) * 8;
        __syncthreads();
        for (int i = tidx; i < 1024; i += NTHR) { const int c = i >> 6, p = i & 63; Cs[i] = (f32x2){P.c_re[(g * SC + c) * SP + p], P.c_im[(g * SC + c) * SP + p]}; { const float2 bq = bbar[g * 1024 + i]; Bs[i] = (f32x2){bq.x, bq.y}; } }
        { const int tl = tidx >> 6, p = tidx & 63; { const float2 lq = lampow_t[(g * 65 + tb + tl) * 64 + p]; Ls[tidx] = (f32x2){lq.x, lq.y}; } }
        __syncthreads();
        const int tl = tidx >> 6, c = (tidx >> 2) & 15, c0 = (tidx & 3) * 4;
        float a0 = 0.f, a1 = 0.f, a2 = 0.f, a3 = 0.f;
        for (int p = 0; p < SP; ++p) {
            const f32x2 l = Ls[tl * 64 + p], cc = Cs[c * 64 + p];
            const float kr = cc.x * l.x - cc.y * l.y, ki = cc.x * l.y + cc.y * l.x;
            const f32x2 b0 = Bs[p * 16 + c0], b1 = Bs[p * 16 + c0 + 1], b2 = Bs[p * 16 + c0 + 2], b3 = Bs[p * 16 + c0 + 3];
            a0 += kr * b0.x - ki * b0.y; a1 += kr * b1.x - ki * b1.y; a2 += kr * b2.x - ki * b2.y; a3 += kr * b3.x - ki * b3.y;
        }
        const int tau = tb + tl;
        if (tau == 0) { const float dsk = P.d_skip[g * SC + c]; if (c == c0) a0 += dsk; if (c == c0 + 1) a1 += dsk; if (c == c0 + 2) a2 += dsk; if (c == c0 + 3) a3 += dsk; }
        ushort4 o; o.x = f2bf(a0); o.y = f2bf(a1); o.z = f2bf(a2); o.w = f2bf(a3);
        *(ushort4*)(ktab + (((size_t)g * 127 + 63 + tau) * 16 + c) * 16 + c0) = o;
    }
    for (int i = bid * NTHR + tidx; i < SG * 63 * 32; i += nb * NTHR) { const int g = i / (63 * 32), r = i % (63 * 32); *(u32x4*)(ktab + (size_t)g * 127 * 256 + (size_t)r * 8) = (u32x4){0u, 0u, 0u, 0u}; }
    for (int row = bid * NWAVE + w; row < SG * 256; row += nb * NWAVE) {
        const int g = row >> 8, n = row & 255;
        u32x4 o0 = (u32x4){0u, 0u, 0u, 0u}, o1 = o0;
        if (n < 128) {
            const int p = n & 63;
            const float2 l = lampow[(g * SP + p) * 65 + (63 - lane)];
            float v[16];
#pragma unroll
            for (int c = 0; c < 16; ++c) { const float2 bb = bbar[(g * SP + p) * SC + c]; v[c] = (n < 64) ? (l.x * bb.x - l.y * bb.y) : (l.x * bb.y + l.y * bb.x); }
#pragma unroll
            for (int j = 0; j < 4; ++j) { o0[j] = (unsigned)f2bf(v[2 * j]) | ((unsigned)f2bf(v[2 * j + 1]) << 16); o1[j] = (unsigned)f2bf(v[8 + 2 * j]) | ((unsigned)f2bf(v[9 + 2 * j]) << 16); }
        }
        bf16_t* d = bloc + (size_t)row * 1024 + lane * 16;
        *(u32x4*)d = o0; *(u32x4*)(d + 8) = o1;
    }
    for (int row = bid * NWAVE + w; row < SG * 1024; row += nb * NWAVE) {
        const int g = row >> 10, n = row & 1023, t = n >> 4, c = n & 15;
        ushort4 o; o.x = 0; o.y = 0; o.z = 0; o.w = 0;
        if (lane < 32) {
            const int p0 = (lane & 15) * 4;
            const f32x4 cr = *(const f32x4*)(P.c_re + (g * SC + c) * SP + p0), ci = *(const f32x4*)(P.c_im + (g * SC + c) * SP + p0);
            const float2* lp = lampow_t + (g * 65 + t + 1) * 64 + p0;
            float v[4];
#pragma unroll
            for (int j = 0; j < 4; ++j) { const float2 l = lp[j]; v[j] = (lane < 16) ? (cr[j] * l.x - ci[j] * l.y) : -(cr[j] * l.y + ci[j] * l.x); }
            o.x = f2bf(v[0]); o.y = f2bf(v[1]); o.z = f2bf(v[2]); o.w = f2bf(v[3]);
        }
        *(ushort4*)(clam + (size_t)row * 256 + lane * 4) = o;
    }
}
__device__ __forceinline__ void ph_ropetab(const Ptrs& P, int bid, int nb) {
    const int tidx = opaque_tid();
    float2* rope = WSP(float2, WS_ROPE);
    const double invf[16] = {0.15915494309189535, 0.08949940160889101, 0.050329212104487035, 0.0283021958306234, 0.015915494309189534, 0.008949940160889102, 0.005032921210448704, 0.00283021958306234,
                             0.0015915494309189536, 0.0008949940160889102, 0.0005032921210448703, 0.00028302195830623395, 0.00015915494309189535, 8.949940160889102e-05, 5.0329212104487035e-05, 2.8302195830623396e-05};
    for (int t = bid * NTHR + tidx; t < T; t += nb * NTHR) {
        const double p = (double)P.positions[t];
#pragma unroll
        for (int j = 0; j < 16; ++j) {
            const double rev = p * invf[j];
            const float fr = (float)(rev - __builtin_rint(rev));
            rope[t * 16 + j] = make_float2(__builtin_amdgcn_cosf(fr), __builtin_amdgcn_sinf(fr));
        }
    }
}

#define GW_LOOP(ntiles) for (int tl = bid * NWAVE + (tidx >> 6); tl < (ntiles); tl += nb * NWAVE)
__device__ __forceinline__ void ph_gemm_win(const Ptrs& P, int bid, int nb) {
    const int tidx = opaque_tid();
    const bf16_t* xn = WSP(bf16_t, WS_XN); const bf16_t* wt = WSP(bf16_t, WS_WIN);
    bf16_t* cq = WSP(bf16_t, WS_CQ); bf16_t* ckv = WSP(bf16_t, WS_CKV); bf16_t* u = WSP(bf16_t, WS_U); float* krraw = WSP(float, WS_KRRAW);
    GW_LOOP((T / 32) * 32) {
        const int m0 = (tl >> 5) * 32, n0 = (tl & 31) * 32;
        sg_tile<false>(m0, n0, D,
            [&](int row) { return xn + (size_t)row * D; },
            [&](int n, int k, int) { return wt + (size_t)n * D + k; },
            [&](int t, int n, float v, float) {
                if (n < 256) cq[(size_t)t * 256 + n] = f2bf(v);
                else if (n < 768) {
                    const int ch = n - 256, g = ch >> 4, c = ch & 15, b = t >> 11, s = t & 2047, j = s >> 6, sl = s & 63;
                    u[((size_t)g * 512 + b * 32 + j) * 1024 + sl * 16 + c] = f2bf(v);
                } else if (n < 896) ckv[(size_t)t * 256 + (n - 768)] = f2bf(v);
                else {
                    ckv[(size_t)t * 256 + (n - 768)] = 0;
                    if (n < 928) krraw[(size_t)t * 32 + ropeperm(n - 896)] = v;
                }
            });
    }
}
__device__ __forceinline__ void ph_rstat(const Ptrs& P, int bid, int nb) {
    const int tidx = opaque_tid();
    const bf16_t* cq = WSP(bf16_t, WS_CQ); const bf16_t* ckv = WSP(bf16_t, WS_CKV); float* rsq = WSP(float, WS_RSQ); float* rskv = WSP(float, WS_RSKV);
    const int lane = tidx & 63, w = tidx >> 6;
    for (int t = bid * NWAVE + w; t < T; t += nb * NWAVE) {
        float s = 0.f, s2 = 0.f;
#pragma unroll
        for (int i = 0; i < 4; ++i) { const float v = bf2f(cq[(size_t)t * 256 + i * 64 + lane]); s += v * v; }
#pragma unroll
        for (int i = 0; i < 2; ++i) { const float v = bf2f(ckv[(size_t)t * 256 + i * 64 + lane]); s2 += v * v; }
        s = wave_sum(s); s2 = wave_sum(s2);
        if (lane == 0) { rsq[t] = rsqrtf(s * (1.0f / 256) + EPS); rskv[t] = rsqrtf(s2 * (1.0f / 128) + EPS); }
    }
}
__device__ __forceinline__ void ph_gemm_q(const Ptrs& P, int bid, int nb) {
    const int tidx = opaque_tid();
    const bf16_t* cq = WSP(bf16_t, WS_CQ); const bf16_t* wt = WSP(bf16_t, WS_WUQ); const float* rsq = WSP(float, WS_RSQ); bf16_t* Q = WSP(bf16_t, WS_Q); float* qrraw = WSP(float, WS_QRRAW);
    GW_LOOP((T / 32) * 24) {
        const int m0 = (tl / 24) * 32, n0 = (tl % 24) * 32;
        sg_tile<false>(m0, n0, 256,
            [&](int row) { return cq + (size_t)row * 256; },
            [&](int n, int k, int) { return wt + (size_t)n * 256 + k; },
            [&](int t, int n, float v, float) {
                v *= rsq[t];
                const int b = t >> 11, s = t & 2047;
                if (n < 512) Q[(((size_t)b * NH + (n >> 6)) * SEQ + s) * QKD + (n & 63)] = f2bf(v);
                else { const int m = n - 512; qrraw[(size_t)t * 256 + (m >> 5) * 32 + ropeperm(m & 31)] = v; }
            });
    }
}
__device__ __forceinline__ void ph_gemm_kv(const Ptrs& P, int bid, int nb) {
    const int tidx = opaque_tid();
    const bf16_t* ckv = WSP(bf16_t, WS_CKV); const bf16_t* wt = WSP(bf16_t, WS_WUKV); const float* rskv = WSP(float, WS_RSKV); bf16_t* Kc = WSP(bf16_t, WS_K); bf16_t* V = WSP(bf16_t, WS_V);
    GW_LOOP((T / 32) * 32) {
        const int m0 = (tl >> 5) * 32, n0 = (tl & 31) * 32;
        sg_tile<false>(m0, n0, 256,
            [&](int row) { return ckv + (size_t)row * 256; },
            [&](int n, int k, int) { return wt + (size_t)n * 256 + k; },
            [&](int t, int n, float v, float) {
                v *= rskv[t];
                const int b = t >> 11, s = t & 2047;
                if (n < 512) Kc[(((size_t)b * NH + (n >> 6)) * SEQ + s) * QKD + (n & 63)] = f2bf(v);
                else { const int m = n - 512; V[(((size_t)b * NH + (m >> 6)) * SEQ + s) * VD + (m & 63)] = f2bf(v); }
            });
    }
}
__device__ __forceinline__ void ph_rope_apply(const Ptrs& P, int bid, int nb) {
    const int tidx = opaque_tid();
    const float* qrraw = WSP(float, WS_QRRAW); const float* krraw = WSP(float, WS_KRRAW); const float2* rope = WSP(float2, WS_ROPE); bf16_t* Q = WSP(bf16_t, WS_Q); bf16_t* Kc = WSP(bf16_t, WS_K);
    for (int i = bid * NTHR + tidx; i < T * 9 * 16; i += nb * NTHR) {
        const int j = i & 15, hh = (i >> 4) % 9, t = (i >> 4) / 9;
        const float2 cs = rope[t * 16 + j];
        const int b = t >> 11, s = t & 2047;
        if (hh < 8) {
            const float x1 = qrraw[(size_t)t * 256 + hh * 32 + j], x2 = qrraw[(size_t)t * 256 + hh * 32 + 16 + j];
            bf16_t* q = Q + (((size_t)b * NH + hh) * SEQ + s) * QKD + 64;
            q[j] = f2bf(x1 * cs.x - x2 * cs.y); q[16 + j] = f2bf(x2 * cs.x + x1 * cs.y);
        } else {
            const float x1 = krraw[(size_t)t * 32 + j], x2 = krraw[(size_t)t * 32 + 16 + j];
            const bf16_t o1 = f2bf(x1 * cs.x - x2 * cs.y), o2 = f2bf(x2 * cs.x + x1 * cs.y);
            for (int h = 0; h < NH; ++h) { bf16_t* k = Kc + (((size_t)b * NH + h) * SEQ + s) * QKD + 64; k[j] = o1; k[16 + j] = o2; }
        }
    }
}
__device__ __forceinline__ void ph_gemm_s5b(const Ptrs& P, int bid, int nb) {
    const int tidx = opaque_tid();
    const bf16_t* u = WSP(bf16_t, WS_U); const bf16_t* bloc = WSP(bf16_t, WS_BLOC); float* xloc = WSP(float, WS_XLOC);
    GW_LOOP(SG * 16 * 4) {
        const int g = tl >> 6, m0 = ((tl >> 2) & 15) * 32, n0 = (tl & 3) * 32;
        sg_tile<false>(m0, n0, 1024,
            [&](int row) { return u + ((size_t)g * 512 + row) * 1024; },
            [&](int n, int k, int) { return bloc + ((size_t)g * 256 + n) * 1024 + k; },
            [&](int row, int n, float v, float) { xloc[((size_t)g * 512 + row) * 128 + n] = v; });
    }
}
__device__ __forceinline__ void ph_gemm_s5a(const Ptrs& P, int bid, int nb) {
    const int tidx = opaque_tid();
    const bf16_t* u = WSP(bf16_t, WS_U); const bf16_t* ktab = WSP(bf16_t, WS_KTAB); bf16_t* yintra = WSP(bf16_t, WS_YINTRA);
    GW_LOOP(SG * 16 * 32) {
        const int g = tl >> 9, m0 = ((tl >> 5) & 15) * 32, n0 = (tl & 31) * 32;
        sg_tile<false>(m0, n0, 1024,
            [&](int row) { return u + ((size_t)g * 512 + row) * 1024; },
            [&](int n, int k, int) { const int t = n >> 4, c = n & 15, s = k >> 4, c0 = k & 15; return ktab + (((size_t)g * 127 + (t - s + 63)) * 16 + c) * 16 + c0; },
            [&](int row, int n, float v, float) {
                const int b = row >> 5, j = row & 31, t = n >> 4, c = n & 15;
                yintra[((size_t)b * SEQ + j * CH + t) * SSMW + g * SC + c] = f2bf(v);
            });
    }
}
__device__ __forceinline__ void ph_attn_simple(const Ptrs& P, LAS unsigned char* lds, int bid, int nb) {
    const int tidx = opaque_tid();
    const bf16_t* Q = WSP(bf16_t, WS_Q); const bf16_t* Kc = WSP(bf16_t, WS_K); const bf16_t* V = WSP(bf16_t, WS_V); bf16_t* AS = WSP(bf16_t, WS_AS);
    const int lane = tidx & 63, w = tidx >> 6;
    LAS float* qs = (LAS float*)lds + w * (QKD + SEQ);
    LAS float* ps = qs + QKD;
    for (int row = bid * NWAVE + w; row < T * NH; row += nb * NWAVE) {
        const int bh = row >> 11, q = row & 2047, b = bh >> 3, h = bh & 7;
        asm volatile("s_waitcnt lgkmcnt(0)" ::: "memory");
        qs[lane] = bf2f(Q[(size_t)row * QKD + lane]);
        if (lane < 32) qs[64 + lane] = bf2f(Q[(size_t)row * QKD + 64 + lane]);
        asm volatile("s_waitcnt lgkmcnt(0)" ::: "memory");
        const int nk = ((q >> 6) + 1) * 64;
        float m = -INFINITY;
        for (int kb = 0; kb < nk; kb += 64) {
            const bf16_t* kp = Kc + ((size_t)bh * SEQ + kb + lane) * QKD;
            float s = 0.f;
#pragma unroll
            for (int c = 0; c < 12; ++c) {
                const bf16x8 kv = *(const bf16x8*)(kp + c * 8);
#pragma unroll
                for (int e = 0; e < 8; ++e) s += qs[c * 8 + e] * bf2f((bf16_t)kv[e]);
            }
            ps[kb + lane] = s; m = fmaxf(m, s);
        }
        m = wave_max(m);
        float l = 0.f;
        for (int kb = 0; kb < nk; kb += 64) { const float p = exp2f(ps[kb + lane] - m); ps[kb + lane] = p; l += p; }
        l = wave_sum(l);
        asm volatile("s_waitcnt lgkmcnt(0)" ::: "memory");
        float o = 0.f;
        const bf16_t* vp = V + (size_t)bh * SEQ * VD + lane;
        for (int k = 0; k < nk; ++k) o += ps[k] * bf2f(vp[(size_t)k * VD]);
        AS[((size_t)b * SEQ + q) * 1024 + h * 64 + lane] = f2bf(o / l);
    }
}
__device__ __forceinline__ void ph_s5scan(const Ptrs& P, int bid, int nb) {
    const int tidx = opaque_tid();
    const float* xloc = WSP(float, WS_XLOC); const float2* lampow = WSP(float2, WS_LAMPOW); bf16_t* xprev = WSP(bf16_t, WS_XPREV);
    for (int i = bid * NTHR + tidx; i < SG * NB * SP; i += nb * NTHR) {
        const int p = i & 63, b = (i >> 6) & 15, g = i >> 10;
        const float2 l64 = lampow[(g * SP + p) * 65 + 64];
        float xr = 0.f, xi = 0.f;
#pragma unroll
        for (int j = 0; j < NCH; ++j) {
            const size_t row = (size_t)g * 512 + b * 32 + j;
            bf16_t* xp = xprev + row * 256;
            xp[p] = f2bf(xr); xp[64 + p] = f2bf(xi); xp[128 + p] = 0; xp[192 + p] = 0;
            const float lr = xloc[row * 128 + p], li = xloc[row * 128 + 64 + p];
            const float nr = l64.x * xr - l64.y * xi + lr, ni = l64.x * xi + l64.y * xr + li;
            xr = nr; xi = ni;
        }
    }
}
__device__ __forceinline__ void ph_gemm_s5d(const Ptrs& P, int bid, int nb) {
    const int tidx = opaque_tid();
    const bf16_t* xprev = WSP(bf16_t, WS_XPREV); const bf16_t* clam = WSP(bf16_t, WS_CLAM); const bf16_t* yintra = WSP(bf16_t, WS_YINTRA); bf16_t* Y = WSP(bf16_t, WS_Y);
    GW_LOOP(SG * 16 * 32) {
        const int g = tl >> 9, m0 = ((tl >> 5) & 15) * 32, n0 = (tl & 31) * 32;
        sg_tile<false>(m0, n0, 256,
            [&](int row) { return xprev + ((size_t)g * 512 + row) * 256; },
            [&](int n, int k, int) { return clam + ((size_t)g * 1024 + n) * 256 + k; },
            [&](int row, int n, float v, float) {
                const int b = row >> 5, j = row & 31, t = n >> 4, c = n & 15;
                const size_t o = ((size_t)b * SEQ + j * CH + t) * SSMW + g * SC + c;
                Y[o] = f2bf(gelu_tanh(v + bf2f(yintra[o])));
            });
    }
}
__device__ __forceinline__ void ph_gemm_glu(const Ptrs& P, int bid, int nb) {
    const int tidx = opaque_tid();
    const bf16_t* Y = WSP(bf16_t, WS_Y); const bf16_t* wt = WSP(bf16_t, WS_WGLU); bf16_t* AS = WSP(bf16_t, WS_AS);
    GW_LOOP((T / 32) * 16) {
        const int m0 = (tl >> 4) * 32, n0 = (tl & 15) * 32;
        sg_tile<false>(m0, n0, 512,
            [&](int row) { return Y + (size_t)row * 512; },
            [&](int n, int k, int) { return wt + (size_t)n * 512 + k; },
            [&](int t, int n, float v, float) {
                const float yv = bf2f(Y[(size_t)t * 512 + n]);
                AS[(size_t)t * 1024 + 512 + n] = f2bf(yv * sigmoidf_(v + P.b_glu[n]));
            });
    }
}
__device__ __forceinline__ void ph_asnorm(const Ptrs& P, int bid, int nb) {
    const int tidx = opaque_tid();
    bf16_t* AS = WSP(bf16_t, WS_AS);
    const int lane = tidx & 63, w = tidx >> 6;
    for (int t = bid * NWAVE + w; t < T; t += nb * NWAVE) {
        bf16_t* r = AS + (size_t)t * 1024;
        float va[8], vs[8]; float sa = 0.f, ss = 0.f;
        const bf16x8 a = *(const bf16x8*)(r + lane * 8), s = *(const bf16x8*)(r + 512 + lane * 8);
#pragma unroll
        for (int i = 0; i < 8; ++i) { va[i] = bf2f((bf16_t)a[i]); vs[i] = bf2f((bf16_t)s[i]); sa += va[i] * va[i]; ss += vs[i] * vs[i]; }
        const float ra = rsqrtf(wave_sum(sa) * (1.0f / 512) + EPS), rs = rsqrtf(wave_sum(ss) * (1.0f / 512) + EPS);
        bf16x8 oa, os;
#pragma unroll
        for (int i = 0; i < 8; ++i) { oa[i] = (short)f2bf(va[i] * ra); os[i] = (short)f2bf(vs[i] * rs); }
        *(bf16x8*)(r + lane * 8) = oa; *(bf16x8*)(r + 512 + lane * 8) = os;
    }
}
__device__ __forceinline__ void ph_gemm_wo(const Ptrs& P, int bid, int nb) {
    const int tidx = opaque_tid();
    const bf16_t* AS = WSP(bf16_t, WS_AS); const bf16_t* wt = WSP(bf16_t, WS_WO); const float* xstat = WSP(float, WS_XSTAT); float* pre1 = P.out;
    GW_LOOP((T / 32) * 32) {
        const int m0 = (tl >> 5) * 32, n0 = (tl & 31) * 32;
        sg_tile<false>(m0, n0, 1024,
            [&](int row) { return AS + (size_t)row * 1024; },
            [&](int n, int k, int) { return wt + (size_t)n * 1024 + k; },
            [&](int t, int n, float v, float) {
                const float xn = (P.x[(size_t)t * D + n] - xstat[2 * t]) * xstat[2 * t + 1] * P.ln_in_g[n] + P.ln_in_b[n];
                pre1[(size_t)t * D + n] = v + ALPHA * xn;
            });
    }
}
__device__ __forceinline__ void ph_ln1(const Ptrs& P, int bid, int nb) {
    const int tidx = opaque_tid();
    const float* pre1 = P.out; bf16_t* x1 = WSP(bf16_t, WS_X1); bf16_t* x1lo = WSP(bf16_t, WS_X1LO);
    const int lane = tidx & 63, w = tidx >> 6;
    for (int t = bid * NWAVE + w; t < T; t += nb * NWAVE) {
        const float* xr = pre1 + (size_t)t * D;
        float v[16]; float s = 0.f;
#pragma unroll
        for (int i = 0; i < 4; ++i) { const f32x4 q = *(const f32x4*)(xr + i * 256 + lane * 4); v[4 * i] = q[0]; v[4 * i + 1] = q[1]; v[4 * i + 2] = q[2]; v[4 * i + 3] = q[3]; s += q[0] + q[1] + q[2] + q[3]; }
        const float mu = wave_sum(s) * (1.0f / D);
        float ss = 0.f;
#pragma unroll
        for (int i = 0; i < 16; ++i) { const float d = v[i] - mu; ss += d * d; }
        const float rstd = rsqrtf(wave_sum(ss) * (1.0f / D) + EPS);
#pragma unroll
        for (int i = 0; i < 4; ++i) {
            const int c = i * 256 + lane * 4;
            const f32x4 gg = *(const f32x4*)(P.ln1_g + c), bb = *(const f32x4*)(P.ln1_b + c);
            ushort4 o, ol;
            float y;
            y = (v[4 * i] - mu) * rstd * gg[0] + bb[0];     o.x = f2bf(y); ol.x = f2bf(y - bf2f(o.x));
            y = (v[4 * i + 1] - mu) * rstd * gg[1] + bb[1]; o.y = f2bf(y); ol.y = f2bf(y - bf2f(o.y));
            y = (v[4 * i + 2] - mu) * rstd * gg[2] + bb[2]; o.z = f2bf(y); ol.z = f2bf(y - bf2f(o.z));
            y = (v[4 * i + 3] - mu) * rstd * gg[3] + bb[3]; o.w = f2bf(y); ol.w = f2bf(y - bf2f(o.w));
            *(ushort4*)(x1 + (size_t)t * D + c) = o; (void)ol; (void)x1lo;
        }
    }
}
__device__ __forceinline__ void ph_router(const Ptrs& P, int bid, int nb) {
    const int tidx = opaque_tid();
    const bf16_t* x1 = WSP(bf16_t, WS_X1); const bf16_t* x1lo = WSP(bf16_t, WS_X1LO); float* logits = WSP(float, WS_LOGITS);
    const int e = tidx & 63, w = tidx >> 6;
    for (int t = bid * NWAVE + w; t < T; t += nb * NWAVE) {
        const bf16_t* a = x1 + (size_t)t * D; const bf16_t* al = x1lo + (size_t)t * D;
        float s = 0.f;
        for (int k = 0; k < D; k += 8) {
            const bf16x8 hi = *(const bf16x8*)(a + k), lo = *(const bf16x8*)(al + k);
#pragma unroll
            for (int i = 0; i < 8; ++i) s += (bf2f((bf16_t)hi[i]) + bf2f((bf16_t)lo[i])) * P.w_router[(size_t)(k + i) * NE + e];
        }
        logits[(size_t)t * NE + e] = s;
    }
}
__device__ __forceinline__ void ph_topk(const Ptrs& P, int bid, int nb) {
    const int tidx = opaque_tid();
    const float* logits = WSP(float, WS_LOGITS); int* topi = WSP(int, WS_TOPI); float* topw = WSP(float, WS_TOPW);
    const int lane = tidx & 63, w = tidx >> 6;
    for (int t = bid * NWAVE + w; t < T; t += nb * NWAVE) {
        const float sc = sigmoidf_(logits[(size_t)t * NE + lane]);
        const float sel = sc + P.router_bias[lane];
        const int grp = lane >> 3;
        float m1 = sel;
        m1 = fmaxf(m1, __shfl_xor(m1, 1)); m1 = fmaxf(m1, __shfl_xor(m1, 2)); m1 = fmaxf(m1, __shfl_xor(m1, 4));
        const unsigned long long bal = __ballot(sel == m1) & (0xFFull << (8 * grp));
        const int first = __ffsll((long long)bal) - 1;
        float m2 = (lane == first) ? -INFINITY : sel;
        m2 = fmaxf(m2, __shfl_xor(m2, 1)); m2 = fmaxf(m2, __shfl_xor(m2, 2)); m2 = fmaxf(m2, __shfl_xor(m2, 4));
        const float gs = m1 + m2;
        int cg = 0;
#pragma unroll
        for (int gj = 0; gj < 8; ++gj) { const float sj = __shfl(gs, gj * 8); cg += (sj > gs || (sj == gs && gj < grp)) ? 1 : 0; }
        const bool gsel = cg < 4;
        const float v = gsel ? sel : -INFINITY;
        int rank = 0;
        for (int e2 = 0; e2 < 64; ++e2) { const float ve = __shfl(v, e2); rank += (ve > v || (ve == v && e2 < lane)) ? 1 : 0; }
        const bool chosen = gsel && rank < TOPK;
        const float wsum = wave_sum(chosen ? sc : 0.f);
        if (chosen) { topi[(size_t)t * TOPK + rank] = lane; topw[(size_t)t * TOPK + rank] = sc / wsum * 2.5f; }
    }
}
__device__ __forceinline__ void ph_cnt(const Ptrs& P, int bid, int nb) {
    const int tidx = opaque_tid();
    const int* topi = WSP(int, WS_TOPI); int* cnt = WSP(int, WS_CNT);
    for (int i = bid * NTHR + tidx; i < 256 * 64; i += nb * NTHR) {
        const int tile = i >> 6, e = i & 63;
        int c = 0;
        for (int k = 0; k < 1024; ++k) c += (topi[tile * 1024 + k] == e) ? 1 : 0;
        cnt[i] = c;
    }
}
__device__ __forceinline__ void ph_off(const Ptrs& P, LAS unsigned char* lds, int bid) {
    const int tidx = opaque_tid();
    if (bid != 0) return;
    const int* cnt = WSP(int, WS_CNT); int* toff = WSP(int, WS_TOFF); int* eoff = WSP(int, WS_EOFF); int* ecnt = WSP(int, WS_ECNT);
    LAS int* tot = (LAS int*)lds; LAS int* off = tot + 64;
    const int e = tidx;
    if (e < 64) { int s = 0; for (int tile = 0; tile < 256; ++tile) s += cnt[tile * 64 + e]; tot[e] = s; ecnt[e] = s; }
    __syncthreads();
    if (e == 0) { int o = 0; for (int i = 0; i < 64; ++i) { off[i] = o; o += (tot[i] + 255) & ~255; } off[64] = o; }
    __syncthreads();
    if (e < 64) {
        eoff[e] = off[e]; if (e == 0) eoff[64] = off[64];
        int run = off[e];
        for (int tile = 0; tile < 256; ++tile) { toff[tile * 64 + e] = run; run += cnt[tile * 64 + e]; }
    }
}
__device__ __forceinline__ void ph_lists(const Ptrs& P, int bid, int nb) {
    const int tidx = opaque_tid();
    const int* topi = WSP(int, WS_TOPI); const float* topw = WSP(float, WS_TOPW); const int* toff = WSP(int, WS_TOFF); const int* eoff = WSP(int, WS_EOFF);
    int* rowtok = WSP(int, WS_ROWTOK); float* roww = WSP(float, WS_ROWW);
    for (int i = bid * NTHR + tidx; i < 256 * 64; i += nb * NTHR) {
        const int tile = i >> 6, e = i & 63;
        int pos = toff[tile * 64 + e];
        for (int k = 0; k < 1024; ++k) {
            if (topi[tile * 1024 + k] == e) { rowtok[pos] = tile * 1024 + k; roww[pos] = topw[tile * 1024 + k]; ++pos; }
        }
        if (tile == 255) { const int end = eoff[e + 1]; for (; pos < end; ++pos) { rowtok[pos] = -1; roww[pos] = 0.f; } }
    }
    for (int i = bid * NTHR + tidx; i < T; i += nb * NTHR) rowtok[SH_ROW0 + i] = i * 8;
}
__device__ __forceinline__ void ph_gemm_gu(const Ptrs& P, int bid, int nb) {
    const int tidx = opaque_tid();
    const bf16_t* x1 = WSP(bf16_t, WS_X1); const bf16_t* wgu = WSP(bf16_t, WS_WGU); const int* rowtok = WSP(int, WS_ROWTOK); const float* roww = WSP(float, WS_ROWW);
    const int* eoff = WSP(int, WS_EOFF); bf16_t* H = WSP(bf16_t, WS_H);
    const int nrt = eoff[64] / 32;
    const int ntl = (nrt + T / 32) * 8;
    GW_LOOP(ntl) {
        const int rt = tl >> 3, n0 = (tl & 7) * 32;
        if (rt < nrt) {
            const int m0 = rt * 32;
            int e = 0; while (e < 63 && eoff[e + 1] <= m0) ++e;
            const bf16_t* w = wgu + (size_t)e * 512 * 1024;
            sg_tile<true>(m0, n0, 1024,
                [&](int row) { const int s = rowtok[row]; return x1 + (size_t)(s >= 0 ? (s >> 3) : 0) * D; },
                [&](int f, int k, int which) { return w + (size_t)((f >> 7) * 256 + (f & 127) + which * 128) * 1024 + k; },
                [&](int row, int f, float gv, float uv) { H[(size_t)row * FF + f] = f2bf(gv * sigmoidf_(gv) * uv * roww[row]); });
        } else {
            const int m0 = (rt - nrt) * 32;
            const bf16_t* w = wgu + (size_t)64 * 512 * 1024;
            sg_tile<true>(m0, n0, 1024,
                [&](int row) { return x1 + (size_t)row * D; },
                [&](int f, int k, int which) { return w + (size_t)((f >> 7) * 256 + (f & 127) + which * 128) * 1024 + k; },
                [&](int row, int f, float gv, float uv) { H[(size_t)(SH_ROW0 + row) * FF + f] = f2bf(gv * sigmoidf_(gv) * uv); });
        }
    }
}
__device__ __forceinline__ unsigned char f2fp8(float v) { const int p = __builtin_amdgcn_cvt_pk_fp8_f32(v, v, 0, false); return (unsigned char)(p & 0xff); }
__device__ __forceinline__ void ph_gemm_down(const Ptrs& P, int bid, int nb) {
    const int tidx = opaque_tid();
    const bf16_t* H = WSP(bf16_t, WS_H); const bf16_t* wd = WSP(bf16_t, WS_WD); const int* rowtok = WSP(int, WS_ROWTOK); const int* eoff = WSP(int, WS_EOFF);
    const bf16_t* x1 = WSP(bf16_t, WS_X1); unsigned char* yslot = WSP(unsigned char, WS_YSLOT); float* out = P.out;
    const int nrt = eoff[64] / 32;
    const int ntl = (nrt + T / 32) * 32;
    GW_LOOP(ntl) {
        const int rt = tl >> 5, n0 = (tl & 31) * 32;
        if (rt < nrt) {
            const int m0 = rt * 32;
            int e = 0; while (e < 63 && eoff[e + 1] <= m0) ++e;
            const bf16_t* w = wd + (size_t)e * 1024 * 256;
            sg_tile<false>(m0, n0, 256,
                [&](int row) { return H + (size_t)row * FF; },
                [&](int n, int k, int) { return w + (size_t)n * 256 + k; },
                [&](int row, int n, float v, float) { const int s = rowtok[row]; if (s >= 0) yslot[(size_t)s * D + n] = f2fp8(v * SLOT_SCALE); });
        } else {
            const int m0 = (rt - nrt) * 32;
            const bf16_t* w = wd + (size_t)64 * 1024 * 256;
            sg_tile<false>(m0, n0, 256,
                [&](int row) { return H + (size_t)(SH_ROW0 + row) * FF; },
                [&](int n, int k, int) { return w + (size_t)n * 256 + k; },
                [&](int t, int n, float v, float) { out[(size_t)t * D + n] = v + ALPHA * bf2f(x1[(size_t)t * D + n]); });
        }
    }
}
__device__ __forceinline__ void ph_combine(const Ptrs& P, int bid, int nb) {
    const int tidx = opaque_tid();
    const unsigned char* yslot = WSP(unsigned char, WS_YSLOT); float* out = P.out;
    const int lane = tidx & 63, w = tidx >> 6;
    for (int t = bid * NWAVE + w; t < T; t += nb * NWAVE) {
        float* orow = out + (size_t)t * D + lane * 16;
        float v[16];
        { const bf16_t* xr = WSP(bf16_t, WS_X1) + (size_t)t * D + lane * 16;
          const bf16x8 a = *(const bf16x8*)xr, b = *(const bf16x8*)(xr + 8);
#pragma unroll
          for (int i = 0; i < 8; ++i) { v[i] = bf2f((bf16_t)a[i]); v[8 + i] = bf2f((bf16_t)b[i]); } }
#pragma unroll
        for (int k = 0; k < TOPK; ++k) {
            const u32x4 q = *(const u32x4*)(yslot + ((size_t)t * TOPK + k) * D + lane * 16);
#pragma unroll
            for (int i = 0; i < 4; ++i) {
                v[4 * i]     += __builtin_amdgcn_cvt_f32_fp8((int)q[i], 0) * (1.0f / SLOT_SCALE);
                v[4 * i + 1] += __builtin_amdgcn_cvt_f32_fp8((int)q[i], 1) * (1.0f / SLOT_SCALE);
                v[4 * i + 2] += __builtin_amdgcn_cvt_f32_fp8((int)q[i], 2) * (1.0f / SLOT_SCALE);
                v[4 * i + 3] += __builtin_amdgcn_cvt_f32_fp8((int)q[i], 3) * (1.0f / SLOT_SCALE);
            }
        }
        float s = 0.f;
#pragma unroll
        for (int i = 0; i < 16; ++i) s += v[i];
        const float mu = wave_sum(s) * (1.0f / D);
        float ss = 0.f;
#pragma unroll
        for (int i = 0; i < 16; ++i) { const float d = v[i] - mu; ss += d * d; }
        const float rstd = rsqrtf(wave_sum(ss) * (1.0f / D) + EPS);
#pragma unroll
        for (int i = 0; i < 4; ++i) {
            const int c = lane * 16 + 4 * i;
            const f32x4 gg = *(const f32x4*)(P.ln2_g + c), bb = *(const f32x4*)(P.ln2_b + c);
            f32x4 o;
            o[0] = (v[4 * i] - mu) * rstd * gg[0] + bb[0]; o[1] = (v[4 * i + 1] - mu) * rstd * gg[1] + bb[1];
            o[2] = (v[4 * i + 2] - mu) * rstd * gg[2] + bb[2]; o[3] = (v[4 * i + 3] - mu) * rstd * gg[3] + bb[3];
            *(f32x4*)(orow + 4 * i) = o;
        }
    }
}

namespace g8 {
constexpr int BM = 256, BK = 64, HALF = 128, HTB = HALF * BK * 2, STAGE_BYTES = 8 * HTB;
__device__ __forceinline__ int lds_byte(int r, int c) { const int st = (r >> 4) * 2 + (c >> 5), rr = r & 15, cc = c & 31, ob = rr * 64 + cc * 2; return st * 1024 + (ob ^ (((ob >> 9) & 1) << 5)); }
__device__ __forceinline__ void stage_rc(int b, int& R, int& C) { const int st = b / 1024, sb = b % 1024, swz = sb ^ (((sb >> 9) & 1) << 5); R = (st >> 1) * 16 + swz / 64; C = (st & 1) * 32 + (swz % 64) / 2; }
__device__ __forceinline__ int perm32(int rho) { const int n = rho >> 4, i = rho & 15; return 8 * (i >> 2) + 4 * n + (i & 3); }

struct Unit { const char* A; const char* B; const int* rows; int pm, pn, e, nt; };
struct Geo { int lda_b, ldb_b; long kstepA, kstepB; int toep; };

typedef float f32x4 __attribute__((ext_vector_type(4)));
typedef f32x4 Acc[2][2][4][2];

template <class Epi, class Sched, bool GATHER>
__device__ __forceinline__ void gemm_body(LAS unsigned char* lds, const Geo g, const Sched& S, const Epi& E) {
    const int tid = opaque_tid(), wid = __builtin_amdgcn_readfirstlane(tid >> 6), lane = tid & 63, wr = wid >> 2, wc = wid & 3, fr = lane & 15, fq = lane >> 4;
    int sR[2], sC[2];
    unsigned voffB[2], vA[2][2], vN[2][2];
#pragma unroll
    for (int i = 0; i < 2; ++i) { int R, C; stage_rc(tid * 16 + i * 8192, R, C); sR[i] = R; sC[i] = C; const int Rb = (R & ~31) + perm32(R & 31);
        voffB[i] = g.toep ? (unsigned)(Rb * 32 + 1536 - (C >> 4) * 512 + (C & 15) * 2) : (unsigned)(Rb * g.ldb_b + C * 2);
#pragma unroll
        for (int h = 0; h < 2; ++h) { vA[h][i] = (unsigned)((h * HALF + R) * g.lda_b + C * 2); vN[h][i] = vA[h][i]; } }
    const long kA = g.kstepA, kB = g.kstepB;
    const long hB = (long)HALF * g.ldb_b;
    const unsigned ldsw = (unsigned)wid * 1024u;
    const int aoff = lds_byte(wr * 64 + fr, fq * 8), boff = lds_byte(wc * 32 + fr, fq * 8);
#define G8_SA(b, h) (((b) * 2 + (h)) * HTB)
#define G8_SB(b, h) ((4 + (b) * 2 + (h)) * HTB)
#define G8_STAGE(bufoff, gbase, v0, v1) do { \
        __builtin_amdgcn_global_load_lds((const unsigned*)((const char*)(gbase) + (v0)), (LAS unsigned*)(lds + (bufoff) + ldsw), 16, 0, 0); \
        __builtin_amdgcn_global_load_lds((const unsigned*)((const char*)(gbase) + (v1)), (LAS unsigned*)(lds + (bufoff) + ldsw + 8192), 16, 0, 0); } while (0)
#define G8_STB(bufoff, gbase) G8_STAGE(bufoff, gbase, voffB[0], voffB[1])
#define G8_LDA(dst, b, h) do { _Pragma("unroll") for (int m = 0; m < 4; ++m) _Pragma("unroll") for (int k = 0; k < 2; ++k) dst[m][k] = *(const LAS bf16x8*)(lds + G8_SA(b, h) + aoff + m * 2048 + k * 1024); } while (0)
#define G8_LDB(dst, b, h) do { _Pragma("unroll") for (int n = 0; n < 2; ++n) _Pragma("unroll") for (int k = 0; k < 2; ++k) dst[n][k] = *(const LAS bf16x8*)(lds + G8_SB(b, h) + boff + n * 2048 + k * 1024); } while (0)
#define G8_MMA(ai, bj, At, Bt) do { __builtin_amdgcn_s_setprio(1); _Pragma("unroll") for (int m = 0; m < 4; ++m) _Pragma("unroll") for (int n = 0; n < 2; ++n) _Pragma("unroll") for (int k = 0; k < 2; ++k) \
        acc[ai][bj][m][n] = __builtin_amdgcn_mfma_f32_16x16x32_bf16(Bt[n][k], At[m][k], acc[ai][bj][m][n], 0, 0, 0); __builtin_amdgcn_s_setprio(0); } while (0)
#define G8_WAIT_V(n) asm volatile("s_waitcnt vmcnt(" #n ")" ::: "memory")
#define G8_WAIT_L(n) asm volatile("s_waitcnt lgkmcnt(" #n ")" ::: "memory")
#define G8_BAR __builtin_amdgcn_s_barrier()
#define G8_SCHED __builtin_amdgcn_sched_barrier(0)
#define G8_ROWOFF(u_, h_, i_) ((unsigned)((unsigned)(((u_).rows[(h_) * HALF + sR[i_]] < 0 ? 0 : (u_).rows[(h_) * HALF + sR[i_]] >> 3)) * (unsigned)g.lda_b + (unsigned)(sC[i_] * 2)))
    Unit cur, nxt; int ui = 0;
    if (!S.next(0, cur)) return;
    Acc acc;
#pragma unroll
    for (int a = 0; a < 2; ++a)
#pragma unroll
        for (int b = 0; b < 2; ++b)
#pragma unroll
            for (int m = 0; m < 4; ++m)
#pragma unroll
                for (int n = 0; n < 2; ++n) acc[a][b][m][n] = (f32x4){0.f, 0.f, 0.f, 0.f};
    bf16x8 At[4][2], B0[2][2], B1[2][2];
    const char* cA = cur.A; const char* cB = cur.B;
    if (GATHER) {
#pragma unroll
        for (int h = 0; h < 2; ++h)
#pragma unroll
            for (int i = 0; i < 2; ++i) vA[h][i] = G8_ROWOFF(cur, h, i);
        asm volatile("" : "+v"(vA[0][0]), "+v"(vA[0][1]), "+v"(vA[1][0]), "+v"(vA[1][1]));
    }
    const long hA = GATHER ? 0 : 0;
    (void)hA;
    G8_STB(G8_SB(0, 0), cB); G8_STB(G8_SB(0, 1), cB + hB); G8_STAGE(G8_SA(0, 0), cA, vA[0][0], vA[0][1]); G8_STAGE(G8_SA(0, 1), cA, vA[1][0], vA[1][1]);
    if (wr == 1) G8_BAR;
    G8_WAIT_V(2); G8_BAR;
    G8_STB(G8_SB(1, 0), cB + kB); G8_STAGE(G8_SA(1, 0), cA + kA, vA[0][0], vA[0][1]); G8_STB(G8_SB(1, 1), cB + hB + kB);
    G8_WAIT_V(6); G8_BAR;
    for (;;) {
        const bool has_next = S.next(ui + 1, nxt);
        const char* nA = has_next ? nxt.A : cA; const char* nB = has_next ? nxt.B : cB;
        if (GATHER) {
            if (has_next) {
#pragma unroll
                for (int h = 0; h < 2; ++h)
#pragma unroll
                    for (int i = 0; i < 2; ++i) vN[h][i] = G8_ROWOFF(nxt, h, i);
            } else {
#pragma unroll
                for (int h = 0; h < 2; ++h)
#pragma unroll
                    for (int i = 0; i < 2; ++i) vN[h][i] = vA[h][i];
            }
            asm volatile("" : "+v"(vN[0][0]), "+v"(vN[0][1]), "+v"(vN[1][0]), "+v"(vN[1][1]));
        }
        const int nt = cur.nt;
        for (int t = 0; t < nt; t += 2) {
            const bool last = (t == nt - 2);
            const char* a1 = cA + (long)(t + 1) * kA;
            const char* a2 = last ? nA : cA + (long)(t + 2) * kA; const char* b2 = last ? nB : cB + (long)(t + 2) * kB;
            const char* a3 = a2 + kA; const char* b3 = b2 + kB;
            unsigned w00 = vA[0][0], w01 = vA[0][1], w10 = vA[1][0], w11 = vA[1][1];
            if (GATHER && last) { w00 = vN[0][0]; w01 = vN[0][1]; w10 = vN[1][0]; w11 = vN[1][1]; }
            G8_LDB(B0, 0, 0); G8_LDB(B1, 0, 1); G8_SCHED; G8_LDA(At, 0, 0); G8_STAGE(G8_SA(1, 1), a1, vA[1][0], vA[1][1]);
            G8_WAIT_V(8); G8_WAIT_L(0); G8_BAR; G8_MMA(0, 0, At, B0); G8_MMA(0, 1, At, B1); G8_BAR; G8_SCHED;
            G8_LDA(At, 0, 1); G8_STB(G8_SB(0, 0), b2); G8_STB(G8_SB(0, 1), b2 + hB); G8_STAGE(G8_SA(0, 0), a2, w00, w01);
            G8_WAIT_V(8); G8_WAIT_L(0); G8_BAR; G8_MMA(1, 0, At, B0); G8_MMA(1, 1, At, B1); G8_BAR; G8_SCHED;
            G8_LDB(B0, 1, 0); G8_LDB(B1, 1, 1); G8_SCHED; G8_LDA(At, 1, 0); G8_STAGE(G8_SA(0, 1), a2, w10, w11);
            G8_WAIT_V(8); G8_WAIT_L(0); G8_BAR; G8_MMA(0, 0, At, B0); G8_MMA(0, 1, At, B1); G8_BAR; G8_SCHED;
            G8_LDA(At, 1, 1); G8_STB(G8_SB(1, 0), b3); G8_STB(G8_SB(1, 1), b3 + hB); G8_STAGE(G8_SA(1, 0), a3, w00, w01);
            G8_WAIT_V(8); G8_WAIT_L(0); G8_BAR; G8_MMA(1, 0, At, B0); G8_MMA(1, 1, At, B1); G8_BAR; G8_SCHED;
        }
        if (wr == 0) G8_BAR;
        { int fr_ = fr, fq_ = fq; asm volatile("" : "+v"(fr_), "+v"(fq_)); E(acc, cur, wr, wc, fr_, fq_); }
        if (!has_next) break;
#pragma unroll
        for (int a = 0; a < 2; ++a)
#pragma unroll
            for (int b = 0; b < 2; ++b)
#pragma unroll
                for (int m = 0; m < 4; ++m)
#pragma unroll
                    for (int n = 0; n < 2; ++n) acc[a][b][m][n] = (f32x4){0.f, 0.f, 0.f, 0.f};
        cur = nxt; cA = nA; cB = nB; ++ui;
        if (GATHER) {
#pragma unroll
            for (int h = 0; h < 2; ++h)
#pragma unroll
                for (int i = 0; i < 2; ++i) vA[h][i] = vN[h][i];
        }
        if (wr == 1) G8_BAR;
    }
    G8_WAIT_V(0);
    G8_BAR;
#undef G8_SA
#undef G8_SB
#undef G8_STAGE
#undef G8_STB
#undef G8_LDA
#undef G8_LDB
#undef G8_MMA
#undef G8_WAIT_V
#undef G8_WAIT_L
#undef G8_BAR
#undef G8_SCHED
#undef G8_ROWOFF
}
}
namespace g8 {
__device__ __forceinline__ unsigned pk_bf16(float lo, float hi) { return (unsigned)f2bf(lo) | ((unsigned)f2bf(hi) << 16); }
__device__ __forceinline__ u32x4 pack8(const f32x4 a, const f32x4 b) { u32x4 w; w[0] = pk_bf16(a[0], a[1]); w[1] = pk_bf16(a[2], a[3]); w[2] = pk_bf16(b[0], b[1]); w[3] = pk_bf16(b[2], b[3]); return w; }
__device__ __forceinline__ int unit_index(int i, int nunits) {
    const int G = gridDim.x, c = blockIdx.x;
    if ((G & 7) != 0) { const long L = (long)i * G + c; return L < nunits ? (int)L : -1; }
    const int x = c & 7, r = c >> 3, GX = G >> 3;
    const int lo = (int)(((long)nunits * x) >> 3), hi = (int)(((long)nunits * (x + 1)) >> 3);
    const int L = lo + i * GX + r;
    return L < hi ? L : -1;
}
struct SchedReg {
    const char* A; const char* B; int lda_b, ldb_b, nM, nN, nt;
    __device__ __forceinline__ bool next(int i, Unit& u) const {
        const int L = unit_index(i, nM * nN); if (L < 0) return false;
        u.pm = L / nN; u.pn = L % nN; u.e = 0; u.nt = nt; u.rows = nullptr;
        u.A = A + (size_t)u.pm * 256 * lda_b; u.B = B + (size_t)u.pn * 256 * ldb_b; return true;
    }
};
struct SchedS5 {
    const char* A; const char* B; int lda_b, ldb_b, nN, nt; size_t a_gstride, b_gstride; int toep;
    __device__ __forceinline__ bool next(int i, Unit& u) const {
        const int L = unit_index(i, SG * 2 * nN); if (L < 0) return false;
        const int g = L / (2 * nN), r = L % (2 * nN);
        u.pm = r / nN; u.pn = r % nN; u.e = g; u.rows = nullptr;
        u.A = A + (size_t)g * a_gstride + (size_t)u.pm * 256 * lda_b;
        if (toep) { u.B = B + (size_t)g * 127 * 512 + 63 * 512 + (size_t)u.pn * 256 * 32 - 1536; u.nt = 4 * (u.pn + 1); }
        else { u.B = B + (size_t)g * b_gstride + (size_t)u.pn * 256 * ldb_b; u.nt = nt; }
        return true;
    }
};
struct SchedMoe {
    const char* A; const char* B; const int* eoff; const int* rowtok; int lda_b, npn, nt; size_t b_estride; int ldb_b; int gather; const int* tile_e;
    __device__ __forceinline__ bool next(int i, Unit& u) const {
        const int nrt = eoff[64] >> 8;
        const int G = gridDim.x, c = blockIdx.x;
        int rt;
        if ((G & 7) == 0) {
            const int x = c & 7, r = c >> 3, GX = G >> 3;
            const int r0 = (nrt * x) >> 3, r1 = (nrt * (x + 1)) >> 3, nr = r1 - r0;
            const int j = i * GX + r;
            if (j >= (nr + 16) * npn) return false;
            const int tl = j / npn; u.pn = j % npn;
            rt = (tl < nr) ? r0 + tl : nrt + 16 * x + (tl - nr);
        } else {
            const long L = (long)i * G + c; if (L >= (long)(nrt + T / 256) * npn) return false;
            rt = (int)(L / npn); u.pn = (int)(L % npn);
        }
        u.nt = nt;
        int e = 64;
        if (rt < nrt) e = tile_e[rt];
        u.e = e; u.pm = rt;
        u.B = B + (size_t)e * b_estride + (size_t)u.pn * 256 * ldb_b;
        if (gather) {
            u.A = A; u.rows = rowtok + ((e < 64) ? rt * 256 : SH_ROW0 + (rt - nrt) * 256);
        } else {
            const int row0 = (e < 64) ? rt * 256 : SH_ROW0 + (rt - nrt) * 256;
            u.A = A + (size_t)row0 * lda_b; u.rows = nullptr;
        }
        return true;
    }
};

#define EPI_ROWS_BEGIN _Pragma("unroll") for (int ai = 0; ai < 2; ++ai) _Pragma("unroll") for (int m = 0; m < 4; ++m) { const int rloc = ai * 128 + wr * 64 + m * 16 + fr;
#define EPI_ROWS_END }

struct EpiWin {
    bf16_t* cq; bf16_t* ckv; bf16_t* u; bf16_t* Kc; const float2* rope; float* rsqp; float* rskvp;
    __device__ __forceinline__ void operator()(const Acc& acc, const Unit& un, int wr, int wc, int fr, int fq) const {
        const int pn = un.pn;
        if (pn == 0) {
            EPI_ROWS_BEGIN
                const int t = un.pm * 256 + rloc;
                float ss = 0.f;
#pragma unroll
                for (int bj = 0; bj < 2; ++bj) { const f32x4 v0 = acc[ai][bj][m][0], v1 = acc[ai][bj][m][1];
                    *(u32x4*)(cq + (size_t)t * 256 + bj * 128 + wc * 32 + fq * 8) = pack8(v0, v1);
                    ss += v0[0] * v0[0] + v0[1] * v0[1] + v0[2] * v0[2] + v0[3] * v0[3] + v1[0] * v1[0] + v1[1] * v1[1] + v1[2] * v1[2] + v1[3] * v1[3]; }
                ss += __shfl_xor(ss, 16); ss += __shfl_xor(ss, 32);
                if (fq == 0) rsqp[(size_t)t * 4 + wc] = ss;
            EPI_ROWS_END
        } else if (pn <= 2) {
            EPI_ROWS_BEGIN
                const int t = un.pm * 256 + rloc;
                const int b = t >> 11, s = t & 2047, j = s >> 6, sl = s & 63;
#pragma unroll
                for (int bj = 0; bj < 2; ++bj) { const int ch0 = (pn - 1) * 256 + bj * 128 + wc * 32 + fq * 8, gi = ch0 >> 4, c0 = ch0 & 15;
                    *(u32x4*)(u + ((size_t)gi * 512 + b * 32 + j) * 1024 + sl * 16 + c0) = pack8(acc[ai][bj][m][0], acc[ai][bj][m][1]); }
            EPI_ROWS_END
        } else {
            EPI_ROWS_BEGIN
                const int t = un.pm * 256 + rloc;
                const f32x4 v0 = acc[ai][0][m][0], v1 = acc[ai][0][m][1];
                *(u32x4*)(ckv + (size_t)t * 256 + wc * 32 + fq * 8) = pack8(v0, v1);
                float ss = v0[0] * v0[0] + v0[1] * v0[1] + v0[2] * v0[2] + v0[3] * v0[3] + v1[0] * v1[0] + v1[1] * v1[1] + v1[2] * v1[2] + v1[3] * v1[3];
                ss += __shfl_xor(ss, 16); ss += __shfl_xor(ss, 32);
                if (fq == 0) rskvp[(size_t)t * 4 + wc] = ss;
                *(u32x4*)(ckv + (size_t)t * 256 + 128 + wc * 32 + fq * 8) = (u32x4){0u, 0u, 0u, 0u};
            EPI_ROWS_END
            if (wc == 0) {
                EPI_ROWS_BEGIN
                    const int t = un.pm * 256 + rloc;
                    const f32x4 x1 = acc[ai][1][m][0], x2 = acc[ai][1][m][1];
                    const f32x4 ca = *(const f32x4*)(rope + (size_t)t * 16 + fq * 4), cb = *(const f32x4*)(rope + (size_t)t * 16 + fq * 4 + 2);
                    const float o10 = x1[0] * ca[0] - x2[0] * ca[1], o11 = x1[1] * ca[2] - x2[1] * ca[3], o12 = x1[2] * cb[0] - x2[2] * cb[1], o13 = x1[3] * cb[2] - x2[3] * cb[3];
                    const float o20 = x2[0] * ca[0] + x1[0] * ca[1], o21 = x2[1] * ca[2] + x1[1] * ca[3], o22 = x2[2] * cb[0] + x1[2] * cb[1], o23 = x2[3] * cb[2] + x1[3] * cb[3];
                    uint2 w1, w2; w1.x = pk_bf16(o10, o11); w1.y = pk_bf16(o12, o13); w2.x = pk_bf16(o20, o21); w2.y = pk_bf16(o22, o23);
                    const int b = t >> 11, s = t & 2047;
                    bf16_t* kp = Kc + (((size_t)b * NH) * SEQ + s) * QKD + 64 + fq * 4;
#pragma unroll 1
                    for (int h = 0; h < NH; ++h) { *(uint2*)kp = w1; *(uint2*)(kp + 16) = w2; kp += (size_t)SEQ * QKD; }
                EPI_ROWS_END
            }
        }
    }
};
struct EpiQ {
    bf16_t* Q; const float* rsqp; const float2* rope;
    __device__ __forceinline__ void operator()(const Acc& acc, const Unit& un, int wr, int wc, int fr, int fq) const {
        EPI_ROWS_BEGIN
            const int t = un.pm * 256 + rloc, b = t >> 11, s = t & 2047;
            const f32x4 pp = *(const f32x4*)(rsqp + (size_t)t * 4);
            const float rs = rsqrtf((pp[0] + pp[1] + pp[2] + pp[3]) * (1.0f / 256) + EPS);
            if (un.pn < 2) {
#pragma unroll
                for (int bj = 0; bj < 2; ++bj) { const int col = un.pn * 256 + bj * 128 + wc * 32 + fq * 8;
                    *(u32x4*)(Q + (((size_t)b * NH + (col >> 6)) * SEQ + s) * QKD + (col & 63)) = pack8(acc[ai][bj][m][0] * rs, acc[ai][bj][m][1] * rs); }
            } else {
                const f32x4 ca = *(const f32x4*)(rope + (size_t)t * 16 + fq * 4), cb = *(const f32x4*)(rope + (size_t)t * 16 + fq * 4 + 2);
#pragma unroll
                for (int bj = 0; bj < 2; ++bj) { const f32x4 x1 = acc[ai][bj][m][0] * rs, x2 = acc[ai][bj][m][1] * rs;
                    const float o10 = x1[0] * ca[0] - x2[0] * ca[1], o11 = x1[1] * ca[2] - x2[1] * ca[3], o12 = x1[2] * cb[0] - x2[2] * cb[1], o13 = x1[3] * cb[2] - x2[3] * cb[3];
                    const float o20 = x2[0] * ca[0] + x1[0] * ca[1], o21 = x2[1] * ca[2] + x1[1] * ca[3], o22 = x2[2] * cb[0] + x1[2] * cb[1], o23 = x2[3] * cb[2] + x1[3] * cb[3];
                    uint2 w1, w2; w1.x = pk_bf16(o10, o11); w1.y = pk_bf16(o12, o13); w2.x = pk_bf16(o20, o21); w2.y = pk_bf16(o22, o23);
                    bf16_t* qp = Q + (((size_t)b * NH + (bj * 4 + wc)) * SEQ + s) * QKD + 64 + fq * 4; *(uint2*)qp = w1; *(uint2*)(qp + 16) = w2; }
            }
        EPI_ROWS_END
    }
};
struct EpiKV {
    bf16_t* Kc; bf16_t* V; const float* rskvp;
    __device__ __forceinline__ void operator()(const Acc& acc, const Unit& un, int wr, int wc, int fr, int fq) const {
        EPI_ROWS_BEGIN
            const int t = un.pm * 256 + rloc, b = t >> 11, s = t & 2047;
            const f32x4 pp = *(const f32x4*)(rskvp + (size_t)t * 4);
            const float rs = rsqrtf((pp[0] + pp[1] + pp[2] + pp[3]) * (1.0f / 128) + EPS);
#pragma unroll
            for (int bj = 0; bj < 2; ++bj) { const int col = (un.pn & 1) * 256 + bj * 128 + wc * 32 + fq * 8;
                const u32x4 w = pack8(acc[ai][bj][m][0] * rs, acc[ai][bj][m][1] * rs);
                if (un.pn < 2) *(u32x4*)(Kc + (((size_t)b * NH + (col >> 6)) * SEQ + s) * QKD + (col & 63)) = w;
                else *(u32x4*)(V + (((size_t)b * NH + (col >> 6)) * SEQ + s) * VD + (col & 63)) = w; }
        EPI_ROWS_END
    }
};
struct EpiS5b {
    float* xloc;
    __device__ __forceinline__ void operator()(const Acc& acc, const Unit& un, int wr, int wc, int fr, int fq) const {
        EPI_ROWS_BEGIN
            float* o = xloc + ((size_t)un.e * 512 + un.pm * 256 + rloc) * 128 + wc * 32 + fq * 8;
            *(f32x4*)o = acc[ai][0][m][0]; *(f32x4*)(o + 4) = acc[ai][0][m][1];
        EPI_ROWS_END
    }
};
template <int MODE> struct EpiS5y {
    bf16_t* dst; const bf16_t* yintra;
    __device__ __forceinline__ void operator()(const Acc& acc, const Unit& un, int wr, int wc, int fr, int fq) const {
        EPI_ROWS_BEGIN
            const int row = un.pm * 256 + rloc, b = row >> 5, j = row & 31;
#pragma unroll
            for (int bj = 0; bj < 2; ++bj) { const int n = un.pn * 256 + bj * 128 + wc * 32 + fq * 8, tt = n >> 4, c0 = n & 15;
                const size_t o = ((size_t)b * SEQ + j * CH + tt) * SSMW + un.e * SC + c0;
                f32x4 v0 = acc[ai][bj][m][0], v1 = acc[ai][bj][m][1];
                if (MODE == 1) { const bf16x8 yi = *(const bf16x8*)(yintra + o);
#pragma unroll
                    for (int q = 0; q < 4; ++q) { v0[q] = gelu_tanh(v0[q] + bf2f((bf16_t)yi[q])); v1[q] = gelu_tanh(v1[q] + bf2f((bf16_t)yi[4 + q])); } }
                *(u32x4*)(dst + o) = pack8(v0, v1); }
        EPI_ROWS_END
    }
};
struct EpiGlu {
    const bf16_t* Y; const float* bglu; bf16_t* AS;
    __device__ __forceinline__ void operator()(const Acc& acc, const Unit& un, int wr, int wc, int fr, int fq) const {
        EPI_ROWS_BEGIN
            const int t = un.pm * 256 + rloc;
#pragma unroll
            for (int bj = 0; bj < 2; ++bj) { const int col = un.pn * 256 + bj * 128 + wc * 32 + fq * 8;
                const bf16x8 yv = *(const bf16x8*)(Y + (size_t)t * 512 + col);
                const f32x4 b0 = *(const f32x4*)(bglu + col), b1 = *(const f32x4*)(bglu + col + 4);
                f32x4 v0 = acc[ai][bj][m][0], v1 = acc[ai][bj][m][1];
#pragma unroll
                for (int q = 0; q < 4; ++q) { v0[q] = bf2f((bf16_t)yv[q]) * sigmoidf_(v0[q] + b0[q]); v1[q] = bf2f((bf16_t)yv[4 + q]) * sigmoidf_(v1[q] + b1[q]); }
                *(u32x4*)(AS + (size_t)t * 1024 + 512 + col) = pack8(v0, v1); }
        EPI_ROWS_END
    }
};
struct EpiWo {
    const float* x; const float* xstat; const float* g; const float* bt; float* pre1;
    __device__ __forceinline__ void operator()(const Acc& acc, const Unit& un, int wr, int wc, int fr, int fq) const {
        EPI_ROWS_BEGIN
            const int t = un.pm * 256 + rloc;
            const float mu = xstat[2 * t], rstd = xstat[2 * t + 1];
#pragma unroll
            for (int bj = 0; bj < 2; ++bj) { const int col = un.pn * 256 + bj * 128 + wc * 32 + fq * 8;
#pragma unroll
                for (int n = 0; n < 2; ++n) { const f32x4 xv = *(const f32x4*)(x + (size_t)t * D + col + 4 * n), gg = *(const f32x4*)(g + col + 4 * n), bb = *(const f32x4*)(bt + col + 4 * n);
                    f32x4 o;
#pragma unroll
                    for (int q = 0; q < 4; ++q) o[q] = acc[ai][bj][m][n][q] + ALPHA * ((xv[q] - mu) * rstd * gg[q] + bb[q]);
                    *(f32x4*)(pre1 + (size_t)t * D + col + 4 * n) = o; } }
        EPI_ROWS_END
    }
};
struct EpiGU {
    bf16_t* H; const float* roww; const int* eoff;
    __device__ __forceinline__ void operator()(const Acc& acc, const Unit& un, int wr, int wc, int fr, int fq) const {
        const int nrt = eoff[64] >> 8;
        const bool shared = un.e == 64;
        const int row0 = shared ? SH_ROW0 + (un.pm - nrt) * 256 : un.pm * 256;
        EPI_ROWS_BEGIN
            const int row = row0 + rloc;
            const float w = shared ? 1.0f : roww[row];
            const f32x4 g0 = acc[ai][0][m][0], g1 = acc[ai][0][m][1], u0 = acc[ai][1][m][0], u1 = acc[ai][1][m][1];
            f32x4 h0, h1;
#pragma unroll
            for (int q = 0; q < 4; ++q) { h0[q] = g0[q] * sigmoidf_(g0[q]) * u0[q] * w; h1[q] = g1[q] * sigmoidf_(g1[q]) * u1[q] * w; }
            *(u32x4*)(H + (size_t)row * FF + un.pn * 128 + wc * 32 + fq * 8) = pack8(h0, h1);
        EPI_ROWS_END
    }
};
struct EpiDown {
    unsigned char* yslot; float* out; bf16_t* x1; const int* rowtok; const int* eoff; LAS unsigned char* stg;
    __device__ __forceinline__ void operator()(const Acc& acc, const Unit& un, int wr, int wc, int fr, int fq) const {
        const int nrt = eoff[64] >> 8;
        if (un.e < 64) {
            const int tid = (wr * 4 + wc) * 64 + fq * 16 + fr;
            const int rrow = tid >> 4, rcol = (tid & 15) * 16;
            int slots[8];
#pragma unroll
            for (int q = 0; q < 8; ++q) slots[q] = rowtok[un.pm * 256 + (q >> 2) * 128 + (rrow >> 4) * 64 + (q & 3) * 16 + (rrow & 15)];
            int p = 0;
#pragma unroll
            for (int ai = 0; ai < 2; ++ai)
#pragma unroll
                for (int m = 0; m < 4; ++m, ++p) {
                    LAS unsigned char* sb = stg + (p & 1) * (32 * 288);
#pragma unroll
                    for (int bj = 0; bj < 2; ++bj) {
                        const f32x4 v0 = acc[ai][bj][m][0] * SLOT_SCALE, v1 = acc[ai][bj][m][1] * SLOT_SCALE;
                        int p0 = __builtin_amdgcn_cvt_pk_fp8_f32(v0[0], v0[1], 0, false); p0 = __builtin_amdgcn_cvt_pk_fp8_f32(v0[2], v0[3], p0, true);
                        int p1 = __builtin_amdgcn_cvt_pk_fp8_f32(v1[0], v1[1], 0, false); p1 = __builtin_amdgcn_cvt_pk_fp8_f32(v1[2], v1[3], p1, true);
                        u32x2 w; w[0] = (unsigned)p0; w[1] = (unsigned)p1;
                        *(LAS u32x2*)(sb + (wr * 16 + fr) * 288 + bj * 128 + wc * 32 + fq * 8) = w;
                    }
                    asm volatile("s_waitcnt lgkmcnt(0)\n\ts_barrier" ::: "memory");
                    const int slot = slots[ai * 4 + m];
                    const u32x4 v = *(const LAS u32x4*)(sb + rrow * 288 + rcol);
                    if (slot >= 0) *(u32x4*)(yslot + (size_t)slot * D + un.pn * 256 + rcol) = v;
                }
            asm volatile("s_waitcnt lgkmcnt(0)\n\ts_barrier" ::: "memory");
        } else {
            EPI_ROWS_BEGIN
                const int t = (un.pm - nrt) * 256 + rloc;
#pragma unroll
                for (int bj = 0; bj < 2; ++bj) { const int col = un.pn * 256 + bj * 128 + wc * 32 + fq * 8;
                    bf16_t* xp = x1 + (size_t)t * D + col;
                    const bf16x8 xv = *(const bf16x8*)xp;
                    f32x4 o0, o1;
#pragma unroll
                    for (int q = 0; q < 4; ++q) { o0[q] = acc[ai][bj][m][0][q] + ALPHA * bf2f((bf16_t)xv[q]); o1[q] = acc[ai][bj][m][1][q] + ALPHA * bf2f((bf16_t)xv[4 + q]); }
                    *(u32x4*)xp = pack8(o0, o1); }
            EPI_ROWS_END
        }
    }
};
}
namespace g8 {
struct EpiRouter {
    float* logits;
    __device__ __forceinline__ void operator()(const Acc& acc, const Unit& un, int wr, int wc, int fr, int fq) const {
        if (wc >= 2) return;
        EPI_ROWS_BEGIN
            float* o = logits + (size_t)(un.pm * 256 + rloc) * NE + wc * 32 + fq * 8;
            *(f32x4*)o = acc[ai][0][m][0]; *(f32x4*)(o + 4) = acc[ai][0][m][1];
        EPI_ROWS_END
    }
};
}
__device__ __forceinline__ void fp_gemm_router(const Ptrs& P, LAS unsigned char* lds) {
    g8::Geo g{2048, 2048, 128, 128, 0};
    g8::SchedReg S{(const char*)WSP(bf16_t, WS_X1), (const char*)WSP(bf16_t, WS_WR), 2048, 2048, T / 256, 1, 16};
    g8::EpiRouter E{WSP(float, WS_LOGITS)};
    g8::gemm_body<g8::EpiRouter, g8::SchedReg, false>(lds, g, S, E);
}
__device__ __forceinline__ void ph_topk_cnt(const Ptrs& P, LAS unsigned char* lds, int bid, int nb) {
    const int tidx = opaque_tid();
    const float* logits = WSP(float, WS_LOGITS); int* topi = WSP(int, WS_TOPI); float* topw = WSP(float, WS_TOPW); int* cnt = WSP(int, WS_CNT);
    LAS int* hist = (LAS int*)lds;
    const int lane = tidx & 63, w = tidx >> 6;
    for (int tile = bid; tile < 256; tile += nb) {
        if (tidx < 64) hist[tidx] = 0;
        __syncthreads();
        for (int i = 0; i < 16; ++i) {
            const int t = tile * 128 + w * 16 + i;
            const float sc = sigmoidf_(logits[(size_t)t * NE + lane]);
            const float sel = sc + P.router_bias[lane];
            const int grp = lane >> 3;
            float m1 = sel;
            m1 = fmaxf(m1, __shfl_xor(m1, 1)); m1 = fmaxf(m1, __shfl_xor(m1, 2)); m1 = fmaxf(m1, __shfl_xor(m1, 4));
            const unsigned long long bal = __ballot(sel == m1) & (0xFFull << (8 * grp));
            const int first = __ffsll((long long)bal) - 1;
            float m2 = (lane == first) ? -INFINITY : sel;
            m2 = fmaxf(m2, __shfl_xor(m2, 1)); m2 = fmaxf(m2, __shfl_xor(m2, 2)); m2 = fmaxf(m2, __shfl_xor(m2, 4));
            const float gs = m1 + m2;
            int cg = 0;
#pragma unroll
            for (int gj = 0; gj < 8; ++gj) { const float sj = __shfl(gs, gj * 8); cg += (sj > gs || (sj == gs && gj < grp)) ? 1 : 0; }
            const bool gsel = cg < 4;
            const float v = gsel ? sel : -INFINITY;
            int rank = 0;
#pragma unroll 8
            for (int e2 = 0; e2 < 64; ++e2) { const float ve = __shfl(v, e2); rank += (ve > v || (ve == v && e2 < lane)) ? 1 : 0; }
            const bool chosen = gsel && rank < TOPK;
            const float wsum = wave_sum(chosen ? sc : 0.f);
            if (chosen) { topi[(size_t)t * TOPK + rank] = lane; topw[(size_t)t * TOPK + rank] = sc / wsum * 2.5f; atomicAdd((int*)&hist[lane], 1); }
        }
        __syncthreads();
        if (tidx < 64) cnt[tile * 64 + tidx] = hist[tidx];
        __syncthreads();
    }
}
__device__ __forceinline__ void ph_lists2(const Ptrs& P, LAS unsigned char* lds, int bid, int nb) {
    const int tidx = opaque_tid();
    const int* topi = WSP(int, WS_TOPI); const float* topw = WSP(float, WS_TOPW); const int* cnt = WSP(int, WS_CNT);
    int* eoff = WSP(int, WS_EOFF); int* rowtok = WSP(int, WS_ROWTOK); float* roww = WSP(float, WS_ROWW);
    LAS int* red_tot = (LAS int*)lds;
    LAS int* red_pre = red_tot + 512;
    LAS int* tot = red_pre + 512;
    LAS int* off = tot + 64;
    LAS int* seg = off + 128;
    LAS int* ti = seg + 512;
    const int e = tidx & 63, part = tidx >> 6;
    for (int tile = bid; tile < 256; tile += nb) {
        int st = 0, sp = 0;
        for (int t2 = part * 32; t2 < part * 32 + 32; ++t2) { const int c = cnt[t2 * 64 + e]; st += c; sp += (t2 < tile) ? c : 0; }
        red_tot[part * 64 + e] = st; red_pre[part * 64 + e] = sp;
        ti[tidx] = topi[tile * 1024 + tidx]; ti[tidx + 512] = topi[tile * 1024 + 512 + tidx];
        __syncthreads();
        int pre_e = 0;
        if (tidx < 64) { int a = 0; for (int q = 0; q < 8; ++q) { a += red_tot[q * 64 + tidx]; pre_e += red_pre[q * 64 + tidx]; } tot[tidx] = a; }
        __syncthreads();
        if (tidx == 0) { int o = 0; for (int i = 0; i < 64; ++i) { off[i] = o; o += (tot[i] + 255) & ~255; } off[64] = o; }
        int c = 0;
        for (int k = 0; k < 128; ++k) c += (ti[part * 128 + k] == e) ? 1 : 0;
        seg[part * 64 + e] = c;
        __syncthreads();
        if (tidx < 64) { red_pre[tidx] = pre_e; }
        __syncthreads();
        int pos = off[e] + red_pre[e];
        for (int q = 0; q < part; ++q) pos += seg[q * 64 + e];
        for (int k = 0; k < 128; ++k) { const int idx = part * 128 + k; if (ti[idx] == e) { rowtok[pos] = tile * 1024 + idx; roww[pos] = topw[tile * 1024 + idx]; ++pos; } }
        if (tile == 255 && part == 7) { const int end = off[e + 1]; for (; pos < end; ++pos) { rowtok[pos] = -1; roww[pos] = 0.f; } }
        if (bid == 0 && tidx <= 64) eoff[tidx] = off[tidx];
        if (bid == 0 && tidx < 64) { int* tile_e = WSP(int, WS_TILEE); for (int rt = off[tidx] >> 8; rt < (off[tidx + 1] >> 8); ++rt) tile_e[rt] = tidx; }
        __syncthreads();
    }
    for (int i = bid * NTHR + tidx; i < T; i += nb * NTHR) rowtok[SH_ROW0 + i] = i * 8;
}
__device__ __forceinline__ void fp_gemm_win(const Ptrs& P, LAS unsigned char* lds) {
    g8::Geo g{2048, 2048, 128, 128, 0};
    g8::SchedReg S{(const char*)WSP(bf16_t, WS_XN), (const char*)WSP(bf16_t, WS_WIN), 2048, 2048, T / 256, 4, 16};
    g8::EpiWin E{WSP(bf16_t, WS_CQ), WSP(bf16_t, WS_CKV), WSP(bf16_t, WS_U), WSP(bf16_t, WS_K), WSP(float2, WS_ROPE), WSP(float, WS_RSQ), WSP(float, WS_RSKV)};
    g8::gemm_body<g8::EpiWin, g8::SchedReg, false>(lds, g, S, E);
}
__device__ __forceinline__ void fp_gemm_q(const Ptrs& P, LAS unsigned char* lds) {
    g8::Geo g{512, 512, 128, 128, 0};
    g8::SchedReg S{(const char*)WSP(bf16_t, WS_CQ), (const char*)WSP(bf16_t, WS_WUQ), 512, 512, T / 256, 3, 4};
    g8::EpiQ E{WSP(bf16_t, WS_Q), WSP(float, WS_RSQ), WSP(float2, WS_ROPE)};
    g8::gemm_body<g8::EpiQ, g8::SchedReg, false>(lds, g, S, E);
}
__device__ __forceinline__ void fp_gemm_kv(const Ptrs& P, LAS unsigned char* lds) {
    g8::Geo g{512, 512, 128, 128, 0};
    g8::SchedReg S{(const char*)WSP(bf16_t, WS_CKV), (const char*)WSP(bf16_t, WS_WUKV), 512, 512, T / 256, 4, 4};
    g8::EpiKV E{WSP(bf16_t, WS_K), WSP(bf16_t, WS_V), WSP(float, WS_RSKV)};
    g8::gemm_body<g8::EpiKV, g8::SchedReg, false>(lds, g, S, E);
}
__device__ __forceinline__ void fp_gemm_s5b(const Ptrs& P, LAS unsigned char* lds) {
    g8::Geo g{2048, 2048, 128, 128, 0};
    g8::SchedS5 S{(const char*)WSP(bf16_t, WS_U), (const char*)WSP(bf16_t, WS_BLOC), 2048, 2048, 1, 16, (size_t)512 * 2048, (size_t)256 * 2048, 0};
    g8::EpiS5b E{WSP(float, WS_XLOC)};
    g8::gemm_body<g8::EpiS5b, g8::SchedS5, false>(lds, g, S, E);
}
__device__ __forceinline__ void fp_gemm_s5a(const Ptrs& P, LAS unsigned char* lds) {
    g8::Geo g{2048, 32, 128, -2048, 1};
    g8::SchedS5 S{(const char*)WSP(bf16_t, WS_U), (const char*)WSP(bf16_t, WS_KTAB), 2048, 32, 4, 16, (size_t)512 * 2048, 0, 1};
    g8::EpiS5y<0> E{WSP(bf16_t, WS_YINTRA), nullptr};
    g8::gemm_body<g8::EpiS5y<0>, g8::SchedS5, false>(lds, g, S, E);
}
__device__ __forceinline__ void fp_gemm_s5d(const Ptrs& P, LAS unsigned char* lds) {
    g8::Geo g{512, 512, 128, 128, 0};
    g8::SchedS5 S{(const char*)WSP(bf16_t, WS_XPREV), (const char*)WSP(bf16_t, WS_CLAM), 512, 512, 4, 4, (size_t)512 * 512, (size_t)1024 * 512, 0};
    g8::EpiS5y<1> E{WSP(bf16_t, WS_Y), WSP(bf16_t, WS_YINTRA)};
    g8::gemm_body<g8::EpiS5y<1>, g8::SchedS5, false>(lds, g, S, E);
}
__device__ __forceinline__ void fp_gemm_glu(const Ptrs& P, LAS unsigned char* lds) {
    g8::Geo g{1024, 1024, 128, 128, 0};
    g8::SchedReg S{(const char*)WSP(bf16_t, WS_Y), (const char*)WSP(bf16_t, WS_WGLU), 1024, 1024, T / 256, 2, 8};
    g8::EpiGlu E{WSP(bf16_t, WS_Y), P.b_glu, WSP(bf16_t, WS_AS)};
    g8::gemm_body<g8::EpiGlu, g8::SchedReg, false>(lds, g, S, E);
}
__device__ __forceinline__ void fp_gemm_wo(const Ptrs& P, LAS unsigned char* lds) {
    g8::Geo g{2048, 2048, 128, 128, 0};
    g8::SchedReg S{(const char*)WSP(bf16_t, WS_AS), (const char*)WSP(bf16_t, WS_WO), 2048, 2048, T / 256, 4, 16};
    g8::EpiWo E{P.x, WSP(float, WS_XSTAT), P.ln_in_g, P.ln_in_b, P.out};
    g8::gemm_body<g8::EpiWo, g8::SchedReg, false>(lds, g, S, E);
}
__device__ __forceinline__ void fp_gemm_gu(const Ptrs& P, LAS unsigned char* lds) {
    g8::Geo g{2048, 2048, 128, 128, 0};
    g8::SchedMoe S{(const char*)WSP(bf16_t, WS_X1), (const char*)WSP(bf16_t, WS_WGU), WSP(int, WS_EOFF), WSP(int, WS_ROWTOK), 2048, 2, 16, (size_t)512 * 2048, 2048, 1, WSP(int, WS_TILEE)};
    g8::EpiGU E{WSP(bf16_t, WS_H), WSP(float, WS_ROWW), WSP(int, WS_EOFF)};
    g8::gemm_body<g8::EpiGU, g8::SchedMoe, true>(lds, g, S, E);
}
__device__ __forceinline__ void fp_gemm_down(const Ptrs& P, LAS unsigned char* lds) {
    g8::Geo g{512, 512, 128, 128, 0};
    g8::SchedMoe S{(const char*)WSP(bf16_t, WS_H), (const char*)WSP(bf16_t, WS_WD), WSP(int, WS_EOFF), WSP(int, WS_ROWTOK), 512, 4, 4, (size_t)1024 * 512, 512, 0, WSP(int, WS_TILEE)};
    g8::EpiDown E{WSP(unsigned char, WS_YSLOT), P.out, WSP(bf16_t, WS_X1), WSP(int, WS_ROWTOK), WSP(int, WS_EOFF), lds + LDS_XTRA};
    g8::gemm_body<g8::EpiDown, g8::SchedMoe, false>(lds, g, S, E);
}
namespace at8 {
typedef short s16x4 __attribute__((ext_vector_type(4)));
typedef short v4i16_t __attribute__((ext_vector_type(4)));
constexpr int KSLOT = 12288, VSLOT = 8192, NSLOT = 3;
constexpr int L_K = 0, L_V = NSLOT * KSLOT, L_WS = L_V + NSLOT * VSLOT, L_OST = L_WS + 8 * 256, L_END = L_OST + 8 * 4096;
__device__ __forceinline__ int crow(int r, int hi) { return (r & 3) + 8 * (r >> 2) + 4 * hi; }
__device__ __forceinline__ void glds16(const void* gsrc, LAS unsigned char* dst) { __builtin_amdgcn_global_load_lds((const unsigned*)gsrc, (LAS unsigned*)dst, 16, 0, 0); }
__device__ __forceinline__ s16x4 vtr(const LAS unsigned char* p) { return __builtin_bit_cast(s16x4, __builtin_amdgcn_ds_read_tr16_b64_v4i16((LAS v4i16_t*)p)); }
__device__ __forceinline__ unsigned cvtpk(float lo, float hi) { return (unsigned)f2bf(lo) | ((unsigned)f2bf(hi) << 16); }

__device__ __forceinline__ void attn_unit(int b, int h, int qb, const bf16_t* __restrict__ Q, const bf16_t* __restrict__ Kc, const bf16_t* __restrict__ V, bf16_t* __restrict__ AS, LAS unsigned char* lds) {
    const int tid = opaque_tid(), lane = tid & 63, r32 = lane & 31, hi = lane >> 5;
    const int wid = __builtin_amdgcn_readfirstlane(tid >> 6);
    const size_t bh = (size_t)b * NH + h;
    const bf16_t* Kbh = Kc + bh * SEQ * QKD; const bf16_t* Vbh = V + bh * SEQ * VD;
    const int q0 = qb * 256 + wid * 32;
    const int NT = 4 * (qb + 1);
    const int myNT = 4 * qb + (wid >> 1) + 1;
    const bf16_t* ksrc0 = Kbh + (size_t)lane * QKD + wid * 8;
    const bf16_t* ksrc1 = Kbh + (size_t)lane * QKD + (8 + (wid & 3)) * 8;
    const bf16_t* vsrc = Vbh + (size_t)(16 * (wid & 3) + (lane >> 2)) * VD + (wid >> 2) * 32 + (lane & 3) * 8;
#define AT_DMA(t, slot) do { glds16(ksrc0 + (size_t)(t) * 64 * QKD, lds + L_K + (slot) * KSLOT + wid * 1024); \
                             glds16(ksrc1 + (size_t)(t) * 64 * QKD, lds + L_K + (slot) * KSLOT + (8 + (wid & 3)) * 1024); \
                             glds16(vsrc + (size_t)(t) * 64 * VD, lds + L_V + (slot) * VSLOT + wid * 1024); } while (0)
    AT_DMA(0, 0);
    if (NT > 1) AT_DMA(1, 1);
    bf16x8 qr[6];
    const bf16_t* qp = Q + (bh * SEQ + q0 + r32) * QKD + hi * 8;
#pragma unroll
    for (int ks = 0; ks < 6; ++ks) qr[ks] = *(const bf16x8*)(qp + ks * 16);
    f32x16 o0, o1;
#pragma unroll
    for (int i = 0; i < 16; ++i) { o0[i] = 0.f; o1[i] = 0.f; }
    float m_run = -1e30f, l_run = 0.f;
    LAS float* wsf = (LAS float*)(lds + L_WS) + wid * 64;
    const LAS unsigned char* kp0 = lds + L_K + hi * 1024 + r32 * 16;
    const LAS unsigned char* vp0 = lds + L_V + ((lane >> 4) & 1) * 32 + (lane & 3) * 8 + (4 * hi + ((lane & 15) >> 2)) * 64;
    int slot = 0;
    for (int t = 0; t < NT; ++t) {
        if (t + 1 < NT) asm volatile("s_waitcnt vmcnt(3)" ::: "memory"); else asm volatile("s_waitcnt vmcnt(0)" ::: "memory");
        asm volatile("s_waitcnt lgkmcnt(0)\n\ts_barrier" ::: "memory");
        if (t + 2 < NT) { const int s2 = (slot == 0) ? 2 : slot - 1; AT_DMA(t + 2, s2); }
        if (t < myNT) {
            const LAS unsigned char* kp = kp0 + slot * KSLOT; const LAS unsigned char* vp = vp0 + slot * VSLOT;
            f32x16 p0, p1;
#pragma unroll
            for (int i = 0; i < 16; ++i) { p0[i] = 0.f; p1[i] = 0.f; }
#pragma unroll
            for (int ks = 0; ks < 6; ++ks) {
                const bf16x8 a0 = *(const LAS bf16x8*)(kp + ks * 2048), a1 = *(const LAS bf16x8*)(kp + ks * 2048 + 512);
                p0 = __builtin_amdgcn_mfma_f32_32x32x16_bf16(a0, qr[ks], p0, 0, 0, 0);
                p1 = __builtin_amdgcn_mfma_f32_32x32x16_bf16(a1, qr[ks], p1, 0, 0, 0);
            }
            float rm = fmaxf(p0[0], p1[0]);
#pragma unroll
            for (int i = 1; i < 16; ++i) rm = fmaxf(rm, fmaxf(p0[i], p1[i]));
            { auto rr = __builtin_amdgcn_permlane32_swap(__float_as_uint(rm), __float_as_uint(rm), false, false); rm = fmaxf(__uint_as_float(rr[0]), __uint_as_float(rr[1])); }
            if (__any(rm > m_run + 8.0f)) {
                const float m_new = fmaxf(m_run, rm);
                const float alpha = __builtin_amdgcn_exp2f(m_run - m_new);
                l_run *= alpha; m_run = m_new;
                if (hi == 0) wsf[r32] = alpha;
                asm volatile("s_waitcnt lgkmcnt(0)" ::: "memory");
#pragma unroll
                for (int i = 0; i < 16; ++i) { const float a = wsf[crow(i, hi)]; o0[i] *= a; o1[i] *= a; }
            }
            float ls = 0.f;
#pragma unroll
            for (int i = 0; i < 16; ++i) { p0[i] = __builtin_amdgcn_exp2f(p0[i] - m_run); p1[i] = __builtin_amdgcn_exp2f(p1[i] - m_run); ls += p0[i] + p1[i]; }
            l_run += ls;
            u32x4 w0, w1, w2, w3;
            w0 = (u32x4){cvtpk(p0[0], p0[1]), cvtpk(p0[2], p0[3]), cvtpk(p0[4], p0[5]), cvtpk(p0[6], p0[7])};
            w1 = (u32x4){cvtpk(p0[8], p0[9]), cvtpk(p0[10], p0[11]), cvtpk(p0[12], p0[13]), cvtpk(p0[14], p0[15])};
            w2 = (u32x4){cvtpk(p1[0], p1[1]), cvtpk(p1[2], p1[3]), cvtpk(p1[4], p1[5]), cvtpk(p1[6], p1[7])};
            w3 = (u32x4){cvtpk(p1[8], p1[9]), cvtpk(p1[10], p1[11]), cvtpk(p1[12], p1[13]), cvtpk(p1[14], p1[15])};
            const bf16x8 pa[4] = {__builtin_bit_cast(bf16x8, w0), __builtin_bit_cast(bf16x8, w1), __builtin_bit_cast(bf16x8, w2), __builtin_bit_cast(bf16x8, w3)};
#pragma unroll
            for (int k = 0; k < 4; ++k) {
                const s16x4 l0 = vtr(vp + k * 1024), h0 = vtr(vp + k * 1024 + 512), l1 = vtr(vp + 4096 + k * 1024), h1 = vtr(vp + 4096 + k * 1024 + 512);
                const bf16x8 v0 = (bf16x8){l0[0], l0[1], l0[2], l0[3], h0[0], h0[1], h0[2], h0[3]};
                const bf16x8 v1 = (bf16x8){l1[0], l1[1], l1[2], l1[3], h1[0], h1[1], h1[2], h1[3]};
                o0 = __builtin_amdgcn_mfma_f32_32x32x16_bf16(pa[k], v0, o0, 0, 0, 0);
                o1 = __builtin_amdgcn_mfma_f32_32x32x16_bf16(pa[k], v1, o1, 0, 0, 0);
            }
        }
        slot = (slot == 2) ? 0 : slot + 1;
    }
    { auto rr = __builtin_amdgcn_permlane32_swap(__float_as_uint(l_run), __float_as_uint(l_run), false, false); l_run = __uint_as_float(rr[0]) + __uint_as_float(rr[1]); }
    if (hi == 0) wsf[32 + r32] = l_run;
    asm volatile("s_waitcnt lgkmcnt(0)" ::: "memory");
    LAS bf16_t* stg = (LAS bf16_t*)(lds + L_OST) + wid * 2048;
#pragma unroll
    for (int i = 0; i < 16; ++i) { const int orow = crow(i, hi); const float rl = 1.0f / wsf[32 + orow];
        stg[orow * 64 + r32] = f2bf(o0[i] * rl); stg[orow * 64 + 32 + r32] = f2bf(o1[i] * rl); }
    asm volatile("s_waitcnt lgkmcnt(0)" ::: "memory");
    bf16_t* Ow = AS + ((size_t)b * SEQ + q0) * 1024 + h * 64;
#pragma unroll
    for (int i = 0; i < 4; ++i) { const int row = i * 8 + (lane >> 3), ch = lane & 7; const u32x4 v = *(const LAS u32x4*)(stg + row * 64 + ch * 8); *(u32x4*)(Ow + (size_t)row * 1024 + ch * 8) = v; }
    asm volatile("s_waitcnt lgkmcnt(0)\n\ts_barrier" ::: "memory");
#undef AT_DMA
}
__device__ __forceinline__ void attn_phase(const Ptrs& P, LAS unsigned char* lds, int bid, int nb) {
    const bf16_t* Q = WSP(bf16_t, WS_Q); const bf16_t* Kc = WSP(bf16_t, WS_K); const bf16_t* V = WSP(bf16_t, WS_V); bf16_t* AS = WSP(bf16_t, WS_AS);
    const int vcu = ((nb & 7) == 0) ? (bid & 7) * (nb >> 3) + (bid >> 3) : bid;
    for (int p = vcu; p < 512; p += nb) {
        const int bh = p >> 2, s = p & 3;
        attn_unit(bh >> 3, bh & 7, 7 - s, Q, Kc, V, AS, lds);
        attn_unit(bh >> 3, bh & 7, s, Q, Kc, V, AS, lds);
    }
}
}
__global__ void __launch_bounds__(NTHR, 2) mega(Args a) {
    extern __shared__ __attribute__((aligned(16))) unsigned char lds_raw[];
    LAS unsigned char* lds = (LAS unsigned char*)lds_raw;
    Ptrs P;
    P.x = (const float*)a.in[0]; P.positions = (const int*)a.in[1]; P.ln_in_g = (const float*)a.in[2]; P.ln_in_b = (const float*)a.in[3];
    P.w_in = (const float*)a.in[4]; P.q_norm_g = (const float*)a.in[5]; P.kv_norm_g = (const float*)a.in[6]; P.w_uq = (const float*)a.in[7]; P.w_ukv = (const float*)a.in[8];
    P.lambda_re = (const float*)a.in[9]; P.lambda_im = (const float*)a.in[10]; P.log_step = (const float*)a.in[11]; P.b_re = (const float*)a.in[12]; P.b_im = (const float*)a.in[13];
    P.c_re = (const float*)a.in[14]; P.c_im = (const float*)a.in[15]; P.d_skip = (const float*)a.in[16]; P.w_glu = (const float*)a.in[17]; P.b_glu = (const float*)a.in[18];
    P.attn_out_g = (const float*)a.in[19]; P.ssm_out_g = (const float*)a.in[20]; P.w_o = (const float*)a.in[21]; P.ln1_g = (const float*)a.in[22]; P.ln1_b = (const float*)a.in[23];
    P.w_router = (const float*)a.in[24]; P.router_bias = (const float*)a.in[25]; P.w_gate = (const float*)a.in[26]; P.w_up = (const float*)a.in[27]; P.w_down = (const float*)a.in[28];
    P.ws_gate = (const float*)a.in[29]; P.ws_up = (const float*)a.in[30]; P.ws_down = (const float*)a.in[31]; P.ln2_g = (const float*)a.in[32]; P.ln2_b = (const float*)a.in[33];
    P.out = a.out; P.ws = a.ws;
    const int bid = blockIdx.x, nb = gridDim.x;
    volatile LAS unsigned* misc = (volatile LAS unsigned*)(lds + LDS_MISC);
    if (threadIdx.x < 64) misc[threadIdx.x] = 0u;
    __syncthreads();
    XcdBarrier bar = xcd_barrier_post((unsigned*)(P.ws + WS_CTL) + 4096, misc);
#define GRID_BAR() xcd_barrier(bar)

    ph_ln_in(P, bid, nb); ph_wprep(P, lds, bid, nb); ph_s5tab1(P, bid, nb); ph_ropetab(P, bid, nb);
    GRID_BAR();
    ph_s5tab2(P, lds, bid, nb);
#if FAST_WIN
    fp_gemm_win(P, lds);
    GRID_BAR();
#else
    ph_gemm_win(P, bid, nb);
    GRID_BAR();
    ph_rstat(P, bid, nb);
    GRID_BAR();
#endif
#if FAST_QKV
    fp_gemm_q(P, lds); fp_gemm_kv(P, lds);
#else
    ph_gemm_q(P, bid, nb); ph_gemm_kv(P, bid, nb);
#endif
#if FAST_S5
    fp_gemm_s5b(P, lds); fp_gemm_s5a(P, lds);
#else
    ph_gemm_s5b(P, bid, nb); ph_gemm_s5a(P, bid, nb);
#endif
    GRID_BAR();
#if !FAST_QKV || !FAST_WIN
    ph_rope_apply(P, bid, nb);
#endif
    ph_s5scan(P, bid, nb);
#if !FAST_QKV || !FAST_WIN
    GRID_BAR();
#endif
#if FAST_ATTN
    at8::attn_phase(P, lds, bid, nb);
#else
    ph_attn_simple(P, lds, bid, nb);
#endif
    GRID_BAR();
#if FAST_S5
    fp_gemm_s5d(P, lds);
#else
    ph_gemm_s5d(P, bid, nb);
#endif
    GRID_BAR();
#if FAST_GLU
    fp_gemm_glu(P, lds);
#else
    ph_gemm_glu(P, bid, nb);
#endif
    GRID_BAR();
    ph_asnorm(P, bid, nb);
    GRID_BAR();
#if FAST_WO
    fp_gemm_wo(P, lds);
#else
    ph_gemm_wo(P, bid, nb);
#endif
    GRID_BAR();
    ph_ln1(P, bid, nb);
    GRID_BAR();
    fp_gemm_router(P, lds);
    GRID_BAR();
    ph_topk_cnt(P, lds, bid, nb);
    GRID_BAR();
    ph_lists2(P, lds, bid, nb);
    GRID_BAR();
#if FAST_MOE
    fp_gemm_gu(P, lds);
    GRID_BAR();
    fp_gemm_down(P, lds);
#else
    ph_gemm_gu(P, bid, nb);
    GRID_BAR();
    ph_gemm_down(P, bid, nb);
#endif
    GRID_BAR();
    ph_combine(P, bid, nb);
}

extern "C" void kernel_launch(void* const* d_in, const int* in_sizes, int n_in, void* d_out, int out_size, void* d_ws, size_t ws_size, hipStream_t stream) {
    (void)in_sizes; (void)out_size;
    if (ws_size < WS_NEED || n_in != 34) return;
    static int grid = 0;
    if (grid == 0) {
        int dev = 0, cus = 0;
        if (hipGetDevice(&dev) != hipSuccess || hipDeviceGetAttribute(&cus, hipDeviceAttributeMultiprocessorCount, dev) != hipSuccess) { grid = -1; return; }
        if (hipFuncSetAttribute((const void*)mega, hipFuncAttributeMaxDynamicSharedMemorySize, LDS_BYTES) != hipSuccess) { grid = -1; return; }
        int per_cu = 0;
        if (hipOccupancyMaxActiveBlocksPerMultiprocessor(&per_cu, (const void*)mega, NTHR, LDS_BYTES) != hipSuccess || per_cu < 1) { (void)hipGetLastError(); }
        grid = cus;
    }
    if (grid < 0) return;
    (void)hipMemsetAsync((char*)d_ws + WS_CTL, 0, 1 << 20, stream);
    Args a; memset(&a, 0, sizeof(a));
    for (int i = 0; i < 34; ++i) a.in[i] = d_in[i];
    a.out = (float*)d_out; a.ws = (unsigned char*)d_ws;
    hipLaunchKernelGGL(mega, dim3(grid), dim3(NTHR), LDS_BYTES, stream, a);
}
```

```cpp
#include <hip/hip_runtime.h>
#include <stdint.h>
#include <string.h>

typedef unsigned short bf16_t;
typedef short bf16x8 __attribute__((ext_vector_type(8)));
typedef float f32x16 __attribute__((ext_vector_type(16)));
typedef float f32x4 __attribute__((ext_vector_type(4)));
typedef unsigned u32x4 __attribute__((ext_vector_type(4)));
typedef unsigned u32x2 __attribute__((ext_vector_type(2)));
typedef float f32x2 __attribute__((ext_vector_type(2)));

#ifndef FAST_WIN
#define FAST_WIN 1
#endif
#ifndef FAST_QKV
#define FAST_QKV 1
#endif
#ifndef FAST_S5
#define FAST_S5 1
#endif
#ifndef FAST_GLU
#define FAST_GLU 1
#endif
#ifndef FAST_WO
#define FAST_WO 1
#endif
#ifndef FAST_ATTN
#define FAST_ATTN 1
#endif
#ifndef FAST_MOE
#define FAST_MOE 1
#endif
constexpr int T = 32768, D = 1024, SEQ = 2048, NB = 16;
constexpr int NH = 8, QKD = 96, VD = 64;
constexpr int QRANK = 256, KVRANK = 128, ROPE = 32;
constexpr int SSMW = 512, SG = 32, SC = 16, SP = 64, CH = 64, NCH = SEQ / CH;
constexpr int NE = 64, TOPK = 8, FF = 256;
constexpr float ALPHA = 1.189207115002721f;
constexpr float EPS = 1e-5f;
constexpr float QSCALE = 0.10206207261596577f * 1.4426950408889634f;
constexpr float SLOT_SCALE = 64.0f;
constexpr float XQ_SCALE = 16.0f, WQ_SCALE = 256.0f;
constexpr int RROUT = 278528;
constexpr int SH_ROW0 = RROUT;
constexpr int RTOT = RROUT + T;

constexpr size_t MiB = 1ull << 20;
constexpr size_t WS_CTL = 0;
constexpr size_t WS_TOPI = 1 * MiB, WS_TOPW = 2 * MiB, WS_ROWTOK = 3 * MiB, WS_ROWW = 4 * MiB + MiB / 2;
constexpr size_t WS_CNT = 6 * MiB, WS_TOFF = 6 * MiB + 65536, WS_EOFF = 6 * MiB + 131072, WS_ECNT = 6 * MiB + 131072 + 1024;
constexpr size_t WS_TILEE = 6 * MiB + 262144;
constexpr size_t WS_WD = 7 * MiB;
constexpr size_t WS_X1 = 40 * MiB;
constexpr size_t WS_XN = WS_X1, WS_AS = WS_X1;
constexpr size_t WS_H = 104 * MiB;
constexpr size_t WS_CQ = 104 * MiB, WS_CKV = 120 * MiB, WS_U = 136 * MiB, WS_YINTRA = 168 * MiB, WS_Y = 200 * MiB;
constexpr size_t WS_QRRAW = 200 * MiB;
constexpr size_t WS_XLOC = 232 * MiB, WS_XPREV = 240 * MiB, WS_LOGITS = 248 * MiB, WS_KRRAW = 248 * MiB;
constexpr size_t WS_X1LO = 104 * MiB;
constexpr size_t WS_YSLOT = 256 * MiB;
constexpr size_t WS_WGU = 256 * MiB;
constexpr size_t WS_WIN = 321 * MiB, WS_WO = 323 * MiB, WS_WUQ = 325 * MiB, WS_WUKV = 325 * MiB + MiB / 2, WS_WGLU = 326 * MiB;
constexpr size_t WS_WR = 326 * MiB + MiB / 2;
constexpr size_t WS_BLOC = 327 * MiB, WS_CLAM = 343 * MiB, WS_KTAB = 359 * MiB, WS_LAMPOW = 361 * MiB, WS_BBAR = 363 * MiB;
constexpr size_t WS_ROPE = 364 * MiB, WS_XSTAT = 368 * MiB, WS_RSQ = 368 * MiB + MiB / 2, WS_RSKV = 369 * MiB;
constexpr size_t WS_Q = 370 * MiB, WS_K = 418 * MiB, WS_V = 466 * MiB;
constexpr size_t WS_LAMPOWT = 498 * MiB;
constexpr size_t WS_X1Q = 370 * MiB;
constexpr size_t WS_NEED = 512 * MiB;

__device__ __forceinline__ bf16_t f2bf(float f) { unsigned u = __float_as_uint(f); u += 0x7fffu + ((u >> 16) & 1u); return (bf16_t)(u >> 16); }
__device__ __forceinline__ float bf2f(bf16_t b) { return __uint_as_float(((unsigned)b) << 16); }
__device__ __forceinline__ int crow(int i, int h) { return (i & 3) + 8 * (i >> 2) + 4 * h; }
__device__ __forceinline__ float wave_sum(float v) {
#pragma unroll
    for (int o = 32; o > 0; o >>= 1) v += __shfl_xor(v, o);
    return v;
}
__device__ __forceinline__ float wave_max(float v) {
#pragma unroll
    for (int o = 32; o > 0; o >>= 1) v = fmaxf(v, __shfl_xor(v, o));
    return v;
}
__device__ __forceinline__ float sigmoidf_(float z) { return 1.0f / (1.0f + __expf(-z)); }
__device__ __forceinline__ float gelu_tanh(float y) {
    const float z = 0.7978845608028654f * (y + 0.044715f * y * y * y);
    const float th = 1.0f - 2.0f / (1.0f + __expf(2.0f * z));
    return 0.5f * y * (1.0f + th);
}
__host__ __device__ __forceinline__ int ropeperm(int q) { return 16 * ((q >> 2) & 1) + 4 * (q >> 3) + (q & 3); }
__host__ __device__ __forceinline__ int ropepos(int j) { const int n = j >> 4, r = j & 15; return 8 * (r >> 2) + 4 * n + (r & 3); }

__device__ __forceinline__ void cexp_d(double re, double im, double& ore, double& oim) {
    const double s = 1.0 / 1048576.0;
    const double a = re * s, b = im * s;
    double tr = 1.0, ti = 0.0, sr = 1.0, si = 0.0;
#pragma unroll
    for (int n = 1; n <= 8; ++n) {
        const double nr = (tr * a - ti * b) / n, ni = (tr * b + ti * a) / n;
        tr = nr; ti = ni; sr += tr; si += ti;
    }
#pragma unroll
    for (int i = 0; i < 20; ++i) { const double nr = sr * sr - si * si, ni = 2.0 * sr * si; sr = nr; si = ni; }
    ore = sr; oim = si;
}

__device__ __forceinline__ int opaque_tid() { int t = threadIdx.x; asm volatile("" : "+v"(t)); return t; }
template <bool DUAL, class AF, class BF, class EPI>
__device__ __forceinline__ void sg_tile(int m0, int n0, int K, AF arow, BF bptr, EPI epi) {
    const int tidx = opaque_tid();
    const int lane = tidx & 63, r = lane & 31, h = lane >> 5;
    f32x16 acc, acc2;
#pragma unroll
    for (int i = 0; i < 16; ++i) { acc[i] = 0.f; acc2[i] = 0.f; }
    const bf16_t* ap = arow(m0 + r);
    for (int k0 = 0; k0 < K; k0 += 16) {
        const bf16x8 a = *(const bf16x8*)(ap + k0 + 8 * h);
        const bf16x8 b = *(const bf16x8*)(bptr(n0 + r, k0 + 8 * h, 0));
        acc = __builtin_amdgcn_mfma_f32_32x32x16_bf16(a, b, acc, 0, 0, 0);
        if (DUAL) {
            const bf16x8 b2 = *(const bf16x8*)(bptr(n0 + r, k0 + 8 * h, 1));
            acc2 = __builtin_amdgcn_mfma_f32_32x32x16_bf16(a, b2, acc2, 0, 0, 0);
        }
    }
#pragma unroll
    for (int i = 0; i < 16; ++i) epi(m0 + crow(i, h), n0 + r, acc[i], acc2[i]);
}

#define LAS __attribute__((address_space(3)))
#define XB_TMO      128
#define XB_XCNT(j)  (256  + 64 * (j))
#define XB_XSUB(j)  (1280 + 64 * (j))
#define XB_XGEN(j)  (2304 + 64 * (j))
#define XB_TOP      3328
#define XB_TOPGEN   3392
#define XCD_BAR_WORDS 3456
#define XB_SPIN_CAP (1u << 18)
__device__ __forceinline__ unsigned xb_ld(unsigned* p)              { return __hip_atomic_load(p, __ATOMIC_RELAXED, __HIP_MEMORY_SCOPE_AGENT); }
__device__ __forceinline__ unsigned xb_add(unsigned* p, unsigned v) { return __hip_atomic_fetch_add(p, v, __ATOMIC_RELAXED, __HIP_MEMORY_SCOPE_AGENT); }
__device__ __forceinline__ unsigned xb_xcc_id() { return (unsigned)__builtin_amdgcn_s_getreg((3 << 11) | 20) & 0xFu; }
#define XB_SPIN(cond, bar) do { unsigned _sp = 0; while (cond) { __builtin_amdgcn_s_sleep(1); \
    if ((++_sp & 255u) == 0u) { if (xb_ld(&(bar)[XB_TMO])) break; if (_sp > XB_SPIN_CAP) { atomicAdd(&(bar)[XB_TMO], 1u); break; } } } } while (0)
struct XcdBarrier { unsigned* bar; unsigned x; volatile LAS unsigned* st; };
__device__ __forceinline__ XcdBarrier xcd_barrier_post(unsigned* bar, volatile LAS unsigned* st) {
    XcdBarrier b; b.bar = bar; b.x = xb_xcc_id(); b.st = st;
    if (threadIdx.x == 0) (void)xb_add(&bar[XB_XCNT(b.x)], 1u);
    return b;
}
__device__ __forceinline__ void xcd_barrier_complete(unsigned* bar, unsigned x, unsigned& nloc, unsigned& nx) {
    const unsigned G = gridDim.x * gridDim.y * gridDim.z;
    unsigned sum, cnt, mine, sp = 0u;
    for (;;) {
        sum = 0u; cnt = 0u; mine = 0u;
#pragma unroll
        for (unsigned j = 0; j < 16; ++j) { const unsigned c = xb_ld(&bar[XB_XCNT(j)]); sum += c; cnt += (c > 0u) ? 1u : 0u; mine = (j == x) ? c : mine; }
        if (sum == G) break;
        __builtin_amdgcn_s_sleep(1);
        if ((++sp & 255u) == 0u) { if (xb_ld(&bar[XB_TMO])) break; if (sp > XB_SPIN_CAP) { atomicAdd(&bar[XB_TMO], 1u); break; } }
    }
    nloc = mine > 0u ? mine : 1u; nx = cnt > 0u ? cnt : 1u;
}
__device__ __forceinline__ void xcd_barrier(const XcdBarrier& b) {
    asm volatile("s_waitcnt vmcnt(0)" ::: "memory");
    __syncthreads();
    if (threadIdx.x == 0) {
        unsigned* bar = b.bar;
        __builtin_amdgcn_s_waitcnt(0);
        unsigned nloc = b.st[0], nx = b.st[1];
        if (nloc == 0u) { xcd_barrier_complete(bar, b.x, nloc, nx); b.st[0] = nloc; b.st[1] = nx; }
        const unsigned old = xb_add(&bar[XB_XSUB(b.x)], 1u);
        const unsigned gen = old / nloc;
        if (old + 1u == (gen + 1u) * nloc) {
            __builtin_amdgcn_fence(__ATOMIC_RELEASE, "agent");
            asm volatile("s_waitcnt vmcnt(0)" ::: "memory");
            const unsigned og = xb_add(&bar[XB_TOP], 1u);
            const unsigned tg = og / nx;
            if (og + 1u == (tg + 1u) * nx) xb_add(&bar[XB_TOPGEN], 1u);
            else XB_SPIN(xb_ld(&bar[XB_TOPGEN]) == tg, bar);
            __builtin_amdgcn_fence(__ATOMIC_ACQUIRE, "agent");
            xb_add(&bar[XB_XGEN(b.x)], 1u);
            asm volatile("s_waitcnt vmcnt(0)" ::: "memory");
        } else {
            XB_SPIN(xb_ld(&bar[XB_XGEN(b.x)]) == gen, bar);
            __builtin_amdgcn_fence(__ATOMIC_ACQUIRE, "agent");
            asm volatile("s_waitcnt vmcnt(0)" ::: "memory");
        }
    }
    __syncthreads();
}

constexpr int NTHR = 512, NWAVE = 8;
constexpr int LDS_BYTES = 163840;
constexpr int LDS_MISC = 163840 - 256;
constexpr int LDS_XTRA = 131072;
struct Args { const void* in[34]; float* out; unsigned char* ws; };
struct Ptrs {
    const float *x, *ln_in_g, *ln_in_b, *w_in, *q_norm_g, *kv_norm_g, *w_uq, *w_ukv, *lambda_re, *lambda_im, *log_step, *b_re, *b_im, *c_re, *c_im, *d_skip, *w_glu, *b_glu;
    const float *attn_out_g, *ssm_out_g, *w_o, *ln1_g, *ln1_b, *w_router, *router_bias, *w_gate, *w_up, *w_down, *ws_gate, *ws_up, *ws_down, *ln2_g, *ln2_b;
    const int* positions; float* out; unsigned char* ws;
};
#define WSP(T_, off) ((T_*)(P.ws + (off)))

__device__ __forceinline__ void ph_ln_in(const Ptrs& P, int bid, int nb) {
    const int tidx = opaque_tid();
    const int lane = tidx & 63, w = tidx >> 6;
    bf16_t* xn = WSP(bf16_t, WS_XN); float* xstat = WSP(float, WS_XSTAT);
    for (int t0 = (bid * NWAVE + w) * 2; t0 < T; t0 += nb * NWAVE * 2) {
        f32x4 q[2][4];
#pragma unroll
        for (int r = 0; r < 2; ++r)
#pragma unroll
            for (int i = 0; i < 4; ++i) q[r][i] = *(const f32x4*)(P.x + (size_t)(t0 + r) * D + i * 256 + lane * 4);
#pragma unroll
        for (int r = 0; r < 2; ++r) {
            const int t = t0 + r;
            float s = 0.f;
#pragma unroll
            for (int i = 0; i < 4; ++i) s += q[r][i][0] + q[r][i][1] + q[r][i][2] + q[r][i][3];
            const float mu = wave_sum(s) * (1.0f / D);
            float ss = 0.f;
#pragma unroll
            for (int i = 0; i < 4; ++i)
#pragma unroll
                for (int e = 0; e < 4; ++e) { const float d = q[r][i][e] - mu; ss += d * d; }
            const float rstd = rsqrtf(wave_sum(ss) * (1.0f / D) + EPS);
            if (lane == 0) { xstat[2 * t] = mu; xstat[2 * t + 1] = rstd; }
#pragma unroll
            for (int i = 0; i < 4; ++i) {
                const int c = i * 256 + lane * 4;
                const f32x4 gg = *(const f32x4*)(P.ln_in_g + c), bb = *(const f32x4*)(P.ln_in_b + c);
                ushort4 o;
                o.x = f2bf((q[r][i][0] - mu) * rstd * gg[0] + bb[0]); o.y = f2bf((q[r][i][1] - mu) * rstd * gg[1] + bb[1]);
                o.z = f2bf((q[r][i][2] - mu) * rstd * gg[2] + bb[2]); o.w = f2bf((q[r][i][3] - mu) * rstd * gg[3] + bb[3]);
                *(ushort4*)(xn + (size_t)t * D + c) = o;
            }
        }
    }
}
__device__ __forceinline__ int wprep_srccol(int mode, int n, int& which) {
    which = 0;
    switch (mode) {
    case 0: if (n < 256) return n; if (n < 768) return 416 + (n - 256); if (n < 896) return 256 + (n - 768); if (n < 928) return 384 + ropeperm(n - 896); return -1;
    case 1: if (n < 512) return (n >> 6) * 96 + (n & 63); { const int m = n - 512; return (m >> 5) * 96 + 64 + ropeperm(m & 31); }
    case 2: if (n < 512) return (n >> 6) * 128 + (n & 63); { const int m = n - 512; return (m >> 6) * 128 + 64 + (m & 63); }
    case 5: { const int pn = n >> 8, w = n & 255; which = w >> 7; return pn * 128 + (w & 127); }
    case 7: return n < 64 ? n : -1;
    default: return n;
    }
}
__device__ __forceinline__ void wprep_tile(LAS float* tile  , const float* s1, const float* s2, const float* ks, const float* ks2, bf16_t* dst,
                                           int mode, int Kd, int ldsrc, int Ksrc, float kmul, int n0, int k0) {
    const int tidx = opaque_tid();
    const int nn = tidx & 63, w = tidx >> 6;
    {
        int which; const int sc = wprep_srccol(mode, n0 + nn, which);
        const float* s = which ? s2 : s1;
        float v[32];
#pragma unroll
        for (int i = 0; i < 32; ++i) { const int k = k0 + w + 8 * i; v[i] = (sc >= 0 && k < Ksrc) ? s[(size_t)k * ldsrc + sc] : 0.f; }
#pragma unroll
        for (int i = 0; i < 32; ++i) { const int kk = w + 8 * i, k = k0 + kk; float x = v[i];
            if (ks && k < Ksrc) x *= (ks2 && k >= 512) ? ks2[k - 512] : ks[k];
            tile[kk * 65 + nn] = x * kmul; }
    }
    __syncthreads();
#pragma unroll
    for (int i = 0; i < 4; ++i) {
        const int kb = (i * 8 + w) * 8;
        u32x4 o;
#pragma unroll
        for (int j = 0; j < 4; ++j) o[j] = (unsigned)f2bf(tile[(kb + 2 * j) * 65 + nn]) | ((unsigned)f2bf(tile[(kb + 2 * j + 1) * 65 + nn]) << 16);
        *(u32x4*)(dst + (size_t)(n0 + nn) * Kd + k0 + kb) = o;
    }
    __syncthreads();
}
__device__ __forceinline__ void wprep_tile_fp8(const float* s1, const float* s2, unsigned char* dst, int mode, int Kd, int ldsrc, float kmul, int n0, int k0) {
    const int tidx = opaque_tid();
    const int nn = tidx & 63, w = tidx >> 6;
    int which; const int sc = wprep_srccol(mode, n0 + nn, which);
    const float* s = which ? s2 : s1;
    float v[2][16];
#pragma unroll
    for (int i = 0; i < 2; ++i)
#pragma unroll
        for (int j = 0; j < 16; ++j) { const int k = k0 + (i * 8 + w) * 16 + j; v[i][j] = s[(size_t)k * ldsrc + sc] * kmul; }
#pragma unroll
    for (int i = 0; i < 2; ++i) {
        u32x4 o;
#pragma unroll
        for (int j = 0; j < 4; ++j) { int p = __builtin_amdgcn_cvt_pk_fp8_f32(v[i][4 * j], v[i][4 * j + 1], 0, false); p = __builtin_amdgcn_cvt_pk_fp8_f32(v[i][4 * j + 2], v[i][4 * j + 3], p, true); o[j] = (unsigned)p; }
        *(u32x4*)(dst + (size_t)(n0 + nn) * Kd + k0 + (i * 8 + w) * 16) = o;
    }
}
__device__ __forceinline__ void ph_wprep(const Ptrs& P, LAS unsigned char* lds, int bid, int nb) {
    LAS float* tile = (LAS float*)lds;
    constexpr int J0 = 64, J1 = J0 + 12, J2 = J1 + 16, J3 = J2 + 16, J4 = J3 + 64, J4b = J4 + 16, J5 = J4b + 65 * 32, J6 = J5 + 65 * 16;
    for (int j = bid; j < J6; j += nb) {
        if (j < J0)      { const int tl = j;      wprep_tile(tile, P.w_in, nullptr, nullptr, nullptr, WSP(bf16_t, WS_WIN), 0, 1024, 928, 1024, 1.0f, (tl / 4) * 64, (tl % 4) * 256); }
        else if (j < J1) { const int tl = j - J0; wprep_tile(tile, P.w_uq, nullptr, P.q_norm_g, nullptr, WSP(bf16_t, WS_WUQ), 1, 256, 768, 256, QSCALE, tl * 64, 0); }
        else if (j < J2) { const int tl = j - J1; wprep_tile(tile, P.w_ukv, nullptr, P.kv_norm_g, nullptr, WSP(bf16_t, WS_WUKV), 2, 256, 1024, 128, 1.0f, tl * 64, 0); }
        else if (j < J3) { const int tl = j - J2; wprep_tile(tile, P.w_glu, nullptr, nullptr, nullptr, WSP(bf16_t, WS_WGLU), 3, 512, 512, 512, 1.0f, (tl / 2) * 64, (tl % 2) * 256); }
        else if (j < J4) { const int tl = j - J3; wprep_tile(tile, P.w_o, nullptr, P.attn_out_g, P.ssm_out_g, WSP(bf16_t, WS_WO), 4, 1024, 1024, 1024, 1.0f, (tl / 4) * 64, (tl % 4) * 256); }
        else if (j < J4b) { const int tl = j - J4; wprep_tile(tile, P.w_router, nullptr, nullptr, nullptr, WSP(bf16_t, WS_WR), 7, 1024, 64, 1024, 1.0f, (tl / 4) * 64, (tl % 4) * 256); }
        else if (j < J5) { const int q = j - J4b, e = q / 32, tl = q % 32;
            const float* g = e < 64 ? P.w_gate + (size_t)e * 1024 * 256 : P.ws_gate; const float* u = e < 64 ? P.w_up + (size_t)e * 1024 * 256 : P.ws_up;
            wprep_tile_fp8(g, u, WSP(unsigned char, WS_WGU) + (size_t)e * 512 * 1024, 5, 1024, 256, WQ_SCALE, (tl / 4) * 64, (tl % 4) * 256); }
        else             { const int q = j - J5, e = q / 16, tl = q % 16;
            const float* d = e < 64 ? P.w_down + (size_t)e * 256 * 1024 : P.ws_down;
            wprep_tile(tile, d, nullptr, nullptr, nullptr, WSP(bf16_t, WS_WD) + (size_t)e * 1024 * 256, 6, 256, 1024, 256, 1.0f, tl * 64, 0); }
    }
}
__device__ __forceinline__ void ph_s5tab1(const Ptrs& P, int bid, int nb) {
    const int tidx = opaque_tid();
    float2* lampow = WSP(float2, WS_LAMPOW); float2* lampow_t = WSP(float2, WS_LAMPOWT); float2* bbar = WSP(float2, WS_BBAR);
    for (int i = bid * NTHR + tidx; i < SG * SP * 65 + SG * SP * SC; i += nb * NTHR) {
        const bool isb = i >= SG * SP * 65;
        const int q = isb ? i - SG * SP * 65 : i;
        const int gp = isb ? q >> 4 : q / 65, tau = isb ? 1 : q % 65, g = gp >> 6, p = gp & 63;
        double lr = (double)P.lambda_re[gp]; if (lr > -1e-4) lr = -1e-4;
        const double li = (double)P.lambda_im[gp];
        double st, dummy; cexp_d((double)P.log_step[g], 0.0, st, dummy);
        double br, bi; cexp_d(lr * st * tau, li * st * tau, br, bi);
        if (!isb) {
            const float2 v = make_float2((float)br, (float)bi);
            lampow[gp * 65 + tau] = v; lampow_t[(g * 65 + tau) * 64 + p] = v;
        } else {
            const int c = q & 15;
            const double nr = br - 1.0, ni = bi, den = lr * lr + li * li;
            const double cr = (nr * lr + ni * li) / den, ci = (ni * lr - nr * li) / den;
            const double xr = (double)P.b_re[gp * SC + c], xi = (double)P.b_im[gp * SC + c];
            bbar[gp * SC + c] = make_float2((float)(cr * xr - ci * xi), (float)(cr * xi + ci * xr));
        }
    }
}
__device__ __forceinline__ void ph_s5tab2(const Ptrs& P, LAS unsigned char* lds, int bid, int nb) {
    const int tidx = opaque_tid();
    const float2* lampow = WSP(float2, WS_LAMPOW); const float2* lampow_t = WSP(float2, WS_LAMPOWT); const float2* bbar = WSP(float2, WS_BBAR);
    bf16_t* ktab = WSP(bf16_t, WS_KTAB); bf16_t* bloc = WSP(bf16_t, WS_BLOC); bf16_t* clam = WSP(bf16_t, WS_CLAM);
    const int lane = tidx & 63, w = tidx >> 6;
    LAS f32x2* Cs = (LAS f32x2*)lds;
    LAS f32x2* Bs = Cs + 1024;
    LAS f32x2* Ls = Bs + 1024;
    for (int un = bid; un < SG * 8; un += nb) {
        const int g = un >> 3, tb = (un & 7) * 8;
        __syncthreads();
        for (int i = tidx; i < 1024; i += NTHR) { const int c = i >> 6, p = i & 63; Cs[i] = (f32x2){P.c_re[(g * SC + c) * SP + p], P.c_im[(g * SC + c) * SP + p]}; { const float2 bq = bbar[g * 1024 + i]; Bs[i] = (f32x2){bq.x, bq.y}; } }
        { const int tl = tidx >> 6, p = tidx & 63; { const float2 lq = lampow_t[(g * 65 + tb + tl) * 64 + p]; Ls[tidx] = (f32x2){lq.x, lq.y}; } }
        __syncthreads();
        const int tl = tidx >> 6, c = (tidx >> 2) & 15, c0 = (tidx & 3) * 4;
        float a0 = 0.f, a1 = 0.f, a2 = 0.f, a3 = 0.f;
        for (int p = 0; p < SP; ++p) {
            const f32x2 l = Ls[tl * 64 + p], cc = Cs[c * 64 + p];
            const float kr = cc.x * l.x - cc.y * l.y, ki = cc.x * l.y + cc.y * l.x;
            const f32x2 b0 = Bs[p * 16 + c0], b1 = Bs[p * 16 + c0 + 1], b2 = Bs[p * 16 + c0 + 2], b3 = Bs[p * 16 + c0 + 3];
            a0 += kr * b0.x - ki * b0.y; a1 += kr * b1.x - ki * b1.y; a2 += kr * b2.x - ki * b2.y; a3 += kr * b3.x - ki * b3.y;
        }
        const int tau = tb + tl;
        if (tau == 0) { const float dsk = P.d_skip[g * SC + c]; if (c == c0) a0 += dsk; if (c == c0 + 1) a1 += dsk; if (c == c0 + 2) a2 += dsk; if (c == c0 + 3) a3 += dsk; }
        ushort4 o; o.x = f2bf(a0); o.y = f2bf(a1); o.z = f2bf(a2); o.w = f2bf(a3);
        *(ushort4*)(ktab + (((size_t)g * 127 + 63 + tau) * 16 + c) * 16 + c0) = o;
    }
    for (int i = bid * NTHR + tidx; i < SG * 63 * 32; i += nb * NTHR) { const int g = i / (63 * 32), r = i % (63 * 32); *(u32x4*)(ktab + (size_t)g * 127 * 256 + (size_t)r * 8) = (u32x4){0u, 0u, 0u, 0u}; }
    for (int row = bid * NWAVE + w; row < SG * 256; row += nb * NWAVE) {
        const int g = row >> 8, n = row & 255;
        u32x4 o0 = (u32x4){0u, 0u, 0u, 0u}, o1 = o0;
        if (n < 128) {
            const int p = n & 63;
            const float2 l = lampow[(g * SP + p) * 65 + (63 - lane)];
            float v[16];
#pragma unroll
            for (int c = 0; c < 16; ++c) { const float2 bb = bbar[(g * SP + p) * SC + c]; v[c] = (n < 64) ? (l.x * bb.x - l.y * bb.y) : (l.x * bb.y + l.y * bb.x); }
#pragma unroll
            for (int j = 0; j < 4; ++j) { o0[j] = (unsigned)f2bf(v[2 * j]) | ((unsigned)f2bf(v[2 * j + 1]) << 16); o1[j] = (unsigned)f2bf(v[8 + 2 * j]) | ((unsigned)f2bf(v[9 + 2 * j]) << 16); }
        }
        bf16_t* d = bloc + (size_t)row * 1024 + lane * 16;
        *(u32x4*)d = o0; *(u32x4*)(d + 8) = o1;
    }
    for (int row = bid * NWAVE + w; row < SG * 1024; row += nb * NWAVE) {
        const int g = row >> 10, n = row & 1023, t = n >> 4, c = n & 15;
        ushort4 o; o.x = 0; o.y = 0; o.z = 0; o.w = 0;
        if (lane < 32) {
            const int p0 = (lane & 15) * 4;
            const f32x4 cr = *(const f32x4*)(P.c_re + (g * SC + c) * SP + p0), ci = *(const f32x4*)(P.c_im + (g * SC + c) * SP + p0);
            const float2* lp = lampow_t + (g * 65 + t + 1) * 64 + p0;
            float v[4];
#pragma unroll
            for (int j = 0; j < 4; ++j) { const float2 l = lp[j]; v[j] = (lane < 16) ? (cr[j] * l.x - ci[j] * l.y) : -(cr[j] * l.y + ci[j] * l.x); }
            o.x = f2bf(v[0]); o.y = f2bf(v[1]); o.z = f2bf(v[2]); o.w = f2bf(v[3]);
        }
        *(ushort4*)(clam + (size_t)row * 256 + lane * 4) = o;
    }
}
__device__ __forceinline__ void ph_ropetab(const Ptrs& P, int bid, int nb) {
    const int tidx = opaque_tid();
    float2* rope = WSP(float2, WS_ROPE);
    const double invf[16] = {0.15915494309189535, 0.08949940160889101, 0.050329212104487035, 0.0283021958306234, 0.015915494309189534, 0.008949940160889102, 0.005032921210448704, 0.00283021958306234,
                             0.0015915494309189536, 0.0008949940160889102, 0.0005032921210448703, 0.00028302195830623395, 0.00015915494309189535, 8.949940160889102e-05, 5.0329212104487035e-05, 2.8302195830623396e-05};
    for (int t = bid * NTHR + tidx; t < T; t += nb * NTHR) {
        const double p = (double)P.positions[t];
#pragma unroll
        for (int j = 0; j < 16; ++j) {
            const double rev = p * invf[j];
            const float fr = (float)(rev - __builtin_rint(rev));
            rope[t * 16 + j] = make_float2(__builtin_amdgcn_cosf(fr), __builtin_amdgcn_sinf(fr));
        }
    }
}

#define GW_LOOP(ntiles) for (int tl = bid * NWAVE + (tidx >> 6); tl < (ntiles); tl += nb * NWAVE)
__device__ __forceinline__ void ph_gemm_win(const Ptrs& P, int bid, int nb) {
    const int tidx = opaque_tid();
    const bf16_t* xn = WSP(bf16_t, WS_XN); const bf16_t* wt = WSP(bf16_t, WS_WIN);
    bf16_t* cq = WSP(bf16_t, WS_CQ); bf16_t* ckv = WSP(bf16_t, WS_CKV); bf16_t* u = WSP(bf16_t, WS_U); float* krraw = WSP(float, WS_KRRAW);
    GW_LOOP((T / 32) * 32) {
        const int m0 = (tl >> 5) * 32, n0 = (tl & 31) * 32;
        sg_tile<false>(m0, n0, D,
            [&](int row) { return xn + (size_t)row * D; },
            [&](int n, int k, int) { return wt + (size_t)n * D + k; },
            [&](int t, int n, float v, float) {
                if (n < 256) cq[(size_t)t * 256 + n] = f2bf(v);
                else if (n < 768) {
                    const int ch = n - 256, g = ch >> 4, c = ch & 15, b = t >> 11, s = t & 2047, j = s >> 6, sl = s & 63;
                    u[((size_t)g * 512 + b * 32 + j) * 1024 + sl * 16 + c] = f2bf(v);
                } else if (n < 896) ckv[(size_t)t * 256 + (n - 768)] = f2bf(v);
                else {
                    ckv[(size_t)t * 256 + (n - 768)] = 0;
                    if (n < 928) krraw[(size_t)t * 32 + ropeperm(n - 896)] = v;
                }
            });
    }
}
__device__ __forceinline__ void ph_rstat(const Ptrs& P, int bid, int nb) {
    const int tidx = opaque_tid();
    const bf16_t* cq = WSP(bf16_t, WS_CQ); const bf16_t* ckv = WSP(bf16_t, WS_CKV); float* rsq = WSP(float, WS_RSQ); float* rskv = WSP(float, WS_RSKV);
    const int lane = tidx & 63, w = tidx >> 6;
    for (int t = bid * NWAVE + w; t < T; t += nb * NWAVE) {
        float s = 0.f, s2 = 0.f;
#pragma unroll
        for (int i = 0; i < 4; ++i) { const float v = bf2f(cq[(size_t)t * 256 + i * 64 + lane]); s += v * v; }
#pragma unroll
        for (int i = 0; i < 2; ++i) { const float v = bf2f(ckv[(size_t)t * 256 + i * 64 + lane]); s2 += v * v; }
        s = wave_sum(s); s2 = wave_sum(s2);
        if (lane == 0) { rsq[t] = rsqrtf(s * (1.0f / 256) + EPS); rskv[t] = rsqrtf(s2 * (1.0f / 128) + EPS); }
    }
}
__device__ __forceinline__ void ph_gemm_q(const Ptrs& P, int bid, int nb) {
    const int tidx = opaque_tid();
    const bf16_t* cq = WSP(bf16_t, WS_CQ); const bf16_t* wt = WSP(bf16_t, WS_WUQ); const float* rsq = WSP(float, WS_RSQ); bf16_t* Q = WSP(bf16_t, WS_Q); float* qrraw = WSP(float, WS_QRRAW);
    GW_LOOP((T / 32) * 24) {
        const int m0 = (tl / 24) * 32, n0 = (tl % 24) * 32;
        sg_tile<false>(m0, n0, 256,
            [&](int row) { return cq + (size_t)row * 256; },
            [&](int n, int k, int) { return wt + (size_t)n * 256 + k; },
            [&](int t, int n, float v, float) {
                v *= rsq[t];
                const int b = t >> 11, s = t & 2047;
                if (n < 512) Q[(((size_t)b * NH + (n >> 6)) * SEQ + s) * QKD + (n & 63)] = f2bf(v);
                else { const int m = n - 512; qrraw[(size_t)t * 256 + (m >> 5) * 32 + ropeperm(m & 31)] = v; }
            });
    }
}
__device__ __forceinline__ void ph_gemm_kv(const Ptrs& P, int bid, int nb) {
    const int tidx = opaque_tid();
    const bf16_t* ckv = WSP(bf16_t, WS_CKV); const bf16_t* wt = WSP(bf16_t, WS_WUKV); const float* rskv = WSP(float, WS_RSKV); bf16_t* Kc = WSP(bf16_t, WS_K); bf16_t* V = WSP(bf16_t, WS_V);
    GW_LOOP((T / 32) * 32) {
        const int m0 = (tl >> 5) * 32, n0 = (tl & 31) * 32;
        sg_tile<false>(m0, n0, 256,
            [&](int row) { return ckv + (size_t)row * 256; },
            [&](int n, int k, int) { return wt + (size_t)n * 256 + k; },
            [&](int t, int n, float v, float) {
                v *= rskv[t];
                const int b = t >> 11, s = t & 2047;
                if (n < 512) Kc[(((size_t)b * NH + (n >> 6)) * SEQ + s) * QKD + (n & 63)] = f2bf(v);
                else { const int m = n - 512; V[(((size_t)b * NH + (m >> 6)) * SEQ + s) * VD + (m & 63)] = f2bf(v); }
            });
    }
}
__device__ __forceinline__ void ph_rope_apply(const Ptrs& P, int bid, int nb) {
    const int tidx = opaque_tid();
    const float* qrraw = WSP(float, WS_QRRAW); const float* krraw = WSP(float, WS_KRRAW); const float2* rope = WSP(float2, WS_ROPE); bf16_t* Q = WSP(bf16_t, WS_Q); bf16_t* Kc = WSP(bf16_t, WS_K);
    for (int i = bid * NTHR + tidx; i < T * 9 * 16; i += nb * NTHR) {
        const int j = i & 15, hh = (i >> 4) % 9, t = (i >> 4) / 9;
        const float2 cs = rope[t * 16 + j];
        const int b = t >> 11, s = t & 2047;
        if (hh < 8) {
            const float x1 = qrraw[(size_t)t * 256 + hh * 32 + j], x2 = qrraw[(size_t)t * 256 + hh * 32 + 16 + j];
            bf16_t* q = Q + (((size_t)b * NH + hh) * SEQ + s) * QKD + 64;
            q[j] = f2bf(x1 * cs.x - x2 * cs.y); q[16 + j] = f2bf(x2 * cs.x + x1 * cs.y);
        } else {
            const float x1 = krraw[(size_t)t * 32 + j], x2 = krraw[(size_t)t * 32 + 16 + j];
            const bf16_t o1 = f2bf(x1 * cs.x - x2 * cs.y), o2 = f2bf(x2 * cs.x + x1 * cs.y);
            for (int h = 0; h < NH; ++h) { bf16_t* k = Kc + (((size_t)b * NH + h) * SEQ + s) * QKD + 64; k[j] = o1; k[16 + j] = o2; }
        }
    }
}
__device__ __forceinline__ void ph_gemm_s5b(const Ptrs& P, int bid, int nb) {
    const int tidx = opaque_tid();
    const bf16_t* u = WSP(bf16_t, WS_U); const bf16_t* bloc = WSP(bf16_t, WS_BLOC); float* xloc = WSP(float, WS_XLOC);
    GW_LOOP(SG * 16 * 4) {
        const int g = tl >> 6, m0 = ((tl >> 2) & 15) * 32, n0 = (tl & 3) * 32;
        sg_tile<false>(m0, n0, 1024,
            [&](int row) { return u + ((size_t)g * 512 + row) * 1024; },
            [&](int n, int k, int) { return bloc + ((size_t)g * 256 + n) * 1024 + k; },
            [&](int row, int n, float v, float) { xloc[((size_t)g * 512 + row) * 128 + n] = v; });
    }
}
__device__ __forceinline__ void ph_gemm_s5a(const Ptrs& P, int bid, int nb) {
    const int tidx = opaque_tid();
    const bf16_t* u = WSP(bf16_t, WS_U); const bf16_t* ktab = WSP(bf16_t, WS_KTAB); bf16_t* yintra = WSP(bf16_t, WS_YINTRA);
    GW_LOOP(SG * 16 * 32) {
        const int g = tl >> 9, m0 = ((tl >> 5) & 15) * 32, n0 = (tl & 31) * 32;
        sg_tile<false>(m0, n0, 1024,
            [&](int row) { return u + ((size_t)g * 512 + row) * 1024; },
            [&](int n, int k, int) { const int t = n >> 4, c = n & 15, s = k >> 4, c0 = k & 15; return ktab + (((size_t)g * 127 + (t - s + 63)) * 16 + c) * 16 + c0; },
            [&](int row, int n, float v, float) {
                const int b = row >> 5, j = row & 31, t = n >> 4, c = n & 15;
                yintra[((size_t)b * SEQ + j * CH + t) * SSMW + g * SC + c] = f2bf(v);
            });
    }
}
__device__ __forceinline__ void ph_attn_simple(const Ptrs& P, LAS unsigned char* lds, int bid, int nb) {
    const int tidx = opaque_tid();
    const bf16_t* Q = WSP(bf16_t, WS_Q); const bf16_t* Kc = WSP(bf16_t, WS_K); const bf16_t* V = WSP(bf16_t, WS_V); bf16_t* AS = WSP(bf16_t, WS_AS);
    const int lane = tidx & 63, w = tidx >> 6;
    LAS float* qs = (LAS float*)lds + w * (QKD + SEQ);
    LAS float* ps = qs + QKD;
    for (int row = bid * NWAVE + w; row < T * NH; row += nb * NWAVE) {
        const int bh = row >> 11, q = row & 2047, b = bh >> 3, h = bh & 7;
        asm volatile("s_waitcnt lgkmcnt(0)" ::: "memory");
        qs[lane] = bf2f(Q[(size_t)row * QKD + lane]);
        if (lane < 32) qs[64 + lane] = bf2f(Q[(size_t)row * QKD + 64 + lane]);
        asm volatile("s_waitcnt lgkmcnt(0)" ::: "memory");
        const int nk = ((q >> 6) + 1) * 64;
        float m = -INFINITY;
        for (int kb = 0; kb < nk; kb += 64) {
            const bf16_t* kp = Kc + ((size_t)bh * SEQ + kb + lane) * QKD;
            float s = 0.f;
#pragma unroll
            for (int c = 0; c < 12; ++c) {
                const bf16x8 kv = *(const bf16x8*)(kp + c * 8);
#pragma unroll
                for (int e = 0; e < 8; ++e) s += qs[c * 8 + e] * bf2f((bf16_t)kv[e]);
            }
            ps[kb + lane] = s; m = fmaxf(m, s);
        }
        m = wave_max(m);
        float l = 0.f;
        for (int kb = 0; kb < nk; kb += 64) { const float p = exp2f(ps[kb + lane] - m); ps[kb + lane] = p; l += p; }
        l = wave_sum(l);
        asm volatile("s_waitcnt lgkmcnt(0)" ::: "memory");
        float o = 0.f;
        const bf16_t* vp = V + (size_t)bh * SEQ * VD + lane;
        for (int k = 0; k < nk; ++k) o += ps[k] * bf2f(vp[(size_t)k * VD]);
        AS[((size_t)b * SEQ + q) * 1024 + h * 64 + lane] = f2bf(o / l);
    }
}
__device__ __forceinline__ void ph_s5scan(const Ptrs& P, int bid, int nb) {
    const int tidx = opaque_tid();
    const float* xloc = WSP(float, WS_XLOC); const float2* lampow = WSP(float2, WS_LAMPOW); bf16_t* xprev = WSP(bf16_t, WS_XPREV);
    for (int i = bid * NTHR + tidx; i < SG * NB * SP; i += nb * NTHR) {
        const int p = i & 63, b = (i >> 6) & 15, g = i >> 10;
        const float2 l64 = lampow[(g * SP + p) * 65 + 64];
        float xr = 0.f, xi = 0.f;
#pragma unroll
        for (int j = 0; j < NCH; ++j) {
            const size_t row = (size_t)g * 512 + b * 32 + j;
            bf16_t* xp = xprev + row * 256;
            xp[p] = f2bf(xr); xp[64 + p] = f2bf(xi); xp[128 + p] = 0; xp[192 + p] = 0;
            const float lr = xloc[row * 128 + p], li = xloc[row * 128 + 64 + p];
            const float nr = l64.x * xr - l64.y * xi + lr, ni = l64.x * xi + l64.y * xr + li;
            xr = nr; xi = ni;
        }
    }
}
__device__ __forceinline__ void ph_gemm_s5d(const Ptrs& P, int bid, int nb) {
    const int tidx = opaque_tid();
    const bf16_t* xprev = WSP(bf16_t, WS_XPREV); const bf16_t* clam = WSP(bf16_t, WS_CLAM); const bf16_t* yintra = WSP(bf16_t, WS_YINTRA); bf16_t* Y = WSP(bf16_t, WS_Y);
    GW_LOOP(SG * 16 * 32) {
        const int g = tl >> 9, m0 = ((tl >> 5) & 15) * 32, n0 = (tl & 31) * 32;
        sg_tile<false>(m0, n0, 256,
            [&](int row) { return xprev + ((size_t)g * 512 + row) * 256; },
            [&](int n, int k, int) { return clam + ((size_t)g * 1024 + n) * 256 + k; },
            [&](int row, int n, float v, float) {
                const int b = row >> 5, j = row & 31, t = n >> 4, c = n & 15;
                const size_t o = ((size_t)b * SEQ + j * CH + t) * SSMW + g * SC + c;
                Y[o] = f2bf(gelu_tanh(v + bf2f(yintra[o])));
            });
    }
}
__device__ __forceinline__ void ph_gemm_glu(const Ptrs& P, int bid, int nb) {
    const int tidx = opaque_tid();
    const bf16_t* Y = WSP(bf16_t, WS_Y); const bf16_t* wt = WSP(bf16_t, WS_WGLU); bf16_t* AS = WSP(bf16_t, WS_AS);
    GW_LOOP((T / 32) * 16) {
        const int m0 = (tl >> 4) * 32, n0 = (tl & 15) * 32;
        sg_tile<false>(m0, n0, 512,
            [&](int row) { return Y + (size_t)row * 512; },
            [&](int n, int k, int) { return wt + (size_t)n * 512 + k; },
            [&](int t, int n, float v, float) {
                const float yv = bf2f(Y[(size_t)t * 512 + n]);
                AS[(size_t)t * 1024 + 512 + n] = f2bf(yv * sigmoidf_(v + P.b_glu[n]));
            });
    }
}
__device__ __forceinline__ void ph_asnorm(const Ptrs& P, int bid, int nb) {
    const int tidx = opaque_tid();
    bf16_t* AS = WSP(bf16_t, WS_AS);
    const int lane = tidx & 63, w = tidx >> 6;
    for (int t = bid * NWAVE + w; t < T; t += nb * NWAVE) {
        bf16_t* r = AS + (size_t)t * 1024;
        float va[8], vs[8]; float sa = 0.f, ss = 0.f;
        const bf16x8 a = *(const bf16x8*)(r + lane * 8), s = *(const bf16x8*)(r + 512 + lane * 8);
#pragma unroll
        for (int i = 0; i < 8; ++i) { va[i] = bf2f((bf16_t)a[i]); vs[i] = bf2f((bf16_t)s[i]); sa += va[i] * va[i]; ss += vs[i] * vs[i]; }
        const float ra = rsqrtf(wave_sum(sa) * (1.0f / 512) + EPS), rs = rsqrtf(wave_sum(ss) * (1.0f / 512) + EPS);
        bf16x8 oa, os;
#pragma unroll
        for (int i = 0; i < 8; ++i) { oa[i] = (short)f2bf(va[i] * ra); os[i] = (short)f2bf(vs[i] * rs); }
        *(bf16x8*)(r + lane * 8) = oa; *(bf16x8*)(r + 512 + lane * 8) = os;
    }
}
__device__ __forceinline__ void ph_gemm_wo(const Ptrs& P, int bid, int nb) {
    const int tidx = opaque_tid();
    const bf16_t* AS = WSP(bf16_t, WS_AS); const bf16_t* wt = WSP(bf16_t, WS_WO); const float* xstat = WSP(float, WS_XSTAT); float* pre1 = P.out;
    GW_LOOP((T / 32) * 32) {
        const int m0 = (tl >> 5) * 32, n0 = (tl & 31) * 32;
        sg_tile<false>(m0, n0, 1024,
            [&](int row) { return AS + (size_t)row * 1024; },
            [&](int n, int k, int) { return wt + (size_t)n * 1024 + k; },
            [&](int t, int n, float v, float) {
                const float xn = (P.x[(size_t)t * D + n] - xstat[2 * t]) * xstat[2 * t + 1] * P.ln_in_g[n] + P.ln_in_b[n];
                pre1[(size_t)t * D + n] = v + ALPHA * xn;
            });
    }
}
__device__ __forceinline__ void ph_ln1(const Ptrs& P, int bid, int nb) {
    const int tidx = opaque_tid();
    const float* pre1 = P.out; bf16_t* x1 = WSP(bf16_t, WS_X1); bf16_t* x1lo = WSP(bf16_t, WS_X1LO);
    const int lane = tidx & 63, w = tidx >> 6;
    for (int t = bid * NWAVE + w; t < T; t += nb * NWAVE) {
        const float* xr = pre1 + (size_t)t * D;
        float v[16]; float s = 0.f;
#pragma unroll
        for (int i = 0; i < 4; ++i) { const f32x4 q = *(const f32x4*)(xr + i * 256 + lane * 4); v[4 * i] = q[0]; v[4 * i + 1] = q[1]; v[4 * i + 2] = q[2]; v[4 * i + 3] = q[3]; s += q[0] + q[1] + q[2] + q[3]; }
        const float mu = wave_sum(s) * (1.0f / D);
        float ss = 0.f;
#pragma unroll
        for (int i = 0; i < 16; ++i) { const float d = v[i] - mu; ss += d * d; }
        const float rstd = rsqrtf(wave_sum(ss) * (1.0f / D) + EPS);
#pragma unroll
        for (int i = 0; i < 4; ++i) {
            const int c = i * 256 + lane * 4;
            const f32x4 gg = *(const f32x4*)(P.ln1_g + c), bb = *(const f32x4*)(P.ln1_b + c);
            ushort4 o, ol;
            float y;
            y = (v[4 * i] - mu) * rstd * gg[0] + bb[0];     o.x = f2bf(y); ol.x = f2bf(y - bf2f(o.x));
            y = (v[4 * i + 1] - mu) * rstd * gg[1] + bb[1]; o.y = f2bf(y); ol.y = f2bf(y - bf2f(o.y));
            y = (v[4 * i + 2] - mu) * rstd * gg[2] + bb[2]; o.z = f2bf(y); ol.z = f2bf(y - bf2f(o.z));
            y = (v[4 * i + 3] - mu) * rstd * gg[3] + bb[3]; o.w = f2bf(y); ol.w = f2bf(y - bf2f(o.w));
            *(ushort4*)(x1 + (size_t)t * D + c) = o; (void)ol; (void)x1lo;
            { int p = __builtin_amdgcn_cvt_pk_fp8_f32(bf2f(o.x) * XQ_SCALE, bf2f(o.y) * XQ_SCALE, 0, false); p = __builtin_amdgcn_cvt_pk_fp8_f32(bf2f(o.z) * XQ_SCALE, bf2f(o.w) * XQ_SCALE, p, true);
              *(int*)(WSP(unsigned char, WS_X1Q) + (size_t)t * D + c) = p; }
        }
    }
}
__device__ __forceinline__ void ph_router(const Ptrs& P, int bid, int nb) {
    const int tidx = opaque_tid();
    const bf16_t* x1 = WSP(bf16_t, WS_X1); const bf16_t* x1lo = WSP(bf16_t, WS_X1LO); float* logits = WSP(float, WS_LOGITS);
    const int e = tidx & 63, w = tidx >> 6;
    for (int t = bid * NWAVE + w; t < T; t += nb * NWAVE) {
        const bf16_t* a = x1 + (size_t)t * D; const bf16_t* al = x1lo + (size_t)t * D;
        float s = 0.f;
        for (int k = 0; k < D; k += 8) {
            const bf16x8 hi = *(const bf16x8*)(a + k), lo = *(const bf16x8*)(al + k);
#pragma unroll
            for (int i = 0; i < 8; ++i) s += (bf2f((bf16_t)hi[i]) + bf2f((bf16_t)lo[i])) * P.w_router[(size_t)(k + i) * NE + e];
        }
        logits[(size_t)t * NE + e] = s;
    }
}
__device__ __forceinline__ void ph_topk(const Ptrs& P, int bid, int nb) {
    const int tidx = opaque_tid();
    const float* logits = WSP(float, WS_LOGITS); int* topi = WSP(int, WS_TOPI); float* topw = WSP(float, WS_TOPW);
    const int lane = tidx & 63, w = tidx >> 6;
    for (int t = bid * NWAVE + w; t < T; t += nb * NWAVE) {
        const float sc = sigmoidf_(logits[(size_t)t * NE + lane]);
        const float sel = sc + P.router_bias[lane];
        const int grp = lane >> 3;
        float m1 = sel;
        m1 = fmaxf(m1, __shfl_xor(m1, 1)); m1 = fmaxf(m1, __shfl_xor(m1, 2)); m1 = fmaxf(m1, __shfl_xor(m1, 4));
        const unsigned long long bal = __ballot(sel == m1) & (0xFFull << (8 * grp));
        const int first = __ffsll((long long)bal) - 1;
        float m2 = (lane == first) ? -INFINITY : sel;
        m2 = fmaxf(m2, __shfl_xor(m2, 1)); m2 = fmaxf(m2, __shfl_xor(m2, 2)); m2 = fmaxf(m2, __shfl_xor(m2, 4));
        const float gs = m1 + m2;
        int cg = 0;
#pragma unroll
        for (int gj = 0; gj < 8; ++gj) { const float sj = __shfl(gs, gj * 8); cg += (sj > gs || (sj == gs && gj < grp)) ? 1 : 0; }
        const bool gsel = cg < 4;
        const float v = gsel ? sel : -INFINITY;
        int rank = 0;
        for (int e2 = 0; e2 < 64; ++e2) { const float ve = __shfl(v, e2); rank += (ve > v || (ve == v && e2 < lane)) ? 1 : 0; }
        const bool chosen = gsel && rank < TOPK;
        const float wsum = wave_sum(chosen ? sc : 0.f);
        if (chosen) { topi[(size_t)t * TOPK + rank] = lane; topw[(size_t)t * TOPK + rank] = sc / wsum * 2.5f; }
    }
}
__device__ __forceinline__ void ph_cnt(const Ptrs& P, int bid, int nb) {
    const int tidx = opaque_tid();
    const int* topi = WSP(int, WS_TOPI); int* cnt = WSP(int, WS_CNT);
    for (int i = bid * NTHR + tidx; i < 256 * 64; i += nb * NTHR) {
        const int tile = i >> 6, e = i & 63;
        int c = 0;
        for (int k = 0; k < 1024; ++k) c += (topi[tile * 1024 + k] == e) ? 1 : 0;
        cnt[i] = c;
    }
}
__device__ __forceinline__ void ph_off(const Ptrs& P, LAS unsigned char* lds, int bid) {
    const int tidx = opaque_tid();
    if (bid != 0) return;
    const int* cnt = WSP(int, WS_CNT); int* toff = WSP(int, WS_TOFF); int* eoff = WSP(int, WS_EOFF); int* ecnt = WSP(int, WS_ECNT);
    LAS int* tot = (LAS int*)lds; LAS int* off = tot + 64;
    const int e = tidx;
    if (e < 64) { int s = 0; for (int tile = 0; tile < 256; ++tile) s += cnt[tile * 64 + e]; tot[e] = s; ecnt[e] = s; }
    __syncthreads();
    if (e == 0) { int o = 0; for (int i = 0; i < 64; ++i) { off[i] = o; o += (tot[i] + 255) & ~255; } off[64] = o; }
    __syncthreads();
    if (e < 64) {
        eoff[e] = off[e]; if (e == 0) eoff[64] = off[64];
        int run = off[e];
        for (int tile = 0; tile < 256; ++tile) { toff[tile * 64 + e] = run; run += cnt[tile * 64 + e]; }
    }
}
__device__ __forceinline__ void ph_lists(const Ptrs& P, int bid, int nb) {
    const int tidx = opaque_tid();
    const int* topi = WSP(int, WS_TOPI); const float* topw = WSP(float, WS_TOPW); const int* toff = WSP(int, WS_TOFF); const int* eoff = WSP(int, WS_EOFF);
    int* rowtok = WSP(int, WS_ROWTOK); float* roww = WSP(float, WS_ROWW);
    for (int i = bid * NTHR + tidx; i < 256 * 64; i += nb * NTHR) {
        const int tile = i >> 6, e = i & 63;
        int pos = toff[tile * 64 + e];
        for (int k = 0; k < 1024; ++k) {
            if (topi[tile * 1024 + k] == e) { rowtok[pos] = tile * 1024 + k; roww[pos] = topw[tile * 1024 + k]; ++pos; }
        }
        if (tile == 255) { const int end = eoff[e + 1]; for (; pos < end; ++pos) { rowtok[pos] = -1; roww[pos] = 0.f; } }
    }
    for (int i = bid * NTHR + tidx; i < T; i += nb * NTHR) rowtok[SH_ROW0 + i] = i * 8;
}
__device__ __forceinline__ void ph_gemm_gu(const Ptrs& P, int bid, int nb) {
    const int tidx = opaque_tid();
    const bf16_t* x1 = WSP(bf16_t, WS_X1); const bf16_t* wgu = WSP(bf16_t, WS_WGU); const int* rowtok = WSP(int, WS_ROWTOK); const float* roww = WSP(float, WS_ROWW);
    const int* eoff = WSP(int, WS_EOFF); bf16_t* H = WSP(bf16_t, WS_H);
    const int nrt = eoff[64] / 32;
    const int ntl = (nrt + T / 32) * 8;
    GW_LOOP(ntl) {
        const int rt = tl >> 3, n0 = (tl & 7) * 32;
        if (rt < nrt) {
            const int m0 = rt * 32;
            int e = 0; while (e < 63 && eoff[e + 1] <= m0) ++e;
            const bf16_t* w = wgu + (size_t)e * 512 * 1024;
            sg_tile<true>(m0, n0, 1024,
                [&](int row) { const int s = rowtok[row]; return x1 + (size_t)(s >= 0 ? (s >> 3) : 0) * D; },
                [&](int f, int k, int which) { return w + (size_t)((f >> 7) * 256 + (f & 127) + which * 128) * 1024 + k; },
                [&](int row, int f, float gv, float uv) { H[(size_t)row * FF + f] = f2bf(gv * sigmoidf_(gv) * uv * roww[row]); });
        } else {
            const int m0 = (rt - nrt) * 32;
            const bf16_t* w = wgu + (size_t)64 * 512 * 1024;
            sg_tile<true>(m0, n0, 1024,
                [&](int row) { return x1 + (size_t)row * D; },
                [&](int f, int k, int which) { return w + (size_t)((f >> 7) * 256 + (f & 127) + which * 128) * 1024 + k; },
                [&](int row, int f, float gv, float uv) { H[(size_t)(SH_ROW0 + row) * FF + f] = f2bf(gv * sigmoidf_(gv) * uv); });
        }
    }
}
__device__ __forceinline__ unsigned char f2fp8(float v) { const int p = __builtin_amdgcn_cvt_pk_fp8_f32(v, v, 0, false); return (unsigned char)(p & 0xff); }
__device__ __forceinline__ void ph_gemm_down(const Ptrs& P, int bid, int nb) {
    const int tidx = opaque_tid();
    const bf16_t* H = WSP(bf16_t, WS_H); const bf16_t* wd = WSP(bf16_t, WS_WD); const int* rowtok = WSP(int, WS_ROWTOK); const int* eoff = WSP(int, WS_EOFF);
    const bf16_t* x1 = WSP(bf16_t, WS_X1); unsigned char* yslot = WSP(unsigned char, WS_YSLOT); float* out = P.out;
    const int nrt = eoff[64] / 32;
    const int ntl = (nrt + T / 32) * 32;
    GW_LOOP(ntl) {
        const int rt = tl >> 5, n0 = (tl & 31) * 32;
        if (rt < nrt) {
            const int m0 = rt * 32;
            int e = 0; while (e < 63 && eoff[e + 1] <= m0) ++e;
            const bf16_t* w = wd + (size_t)e * 1024 * 256;
            sg_tile<false>(m0, n0, 256,
                [&](int row) { return H + (size_t)row * FF; },
                [&](int n, int k, int) { return w + (size_t)n * 256 + k; },
                [&](int row, int n, float v, float) { const int s = rowtok[row]; if (s >= 0) yslot[(size_t)s * D + n] = f2fp8(v * SLOT_SCALE); });
        } else {
            const int m0 = (rt - nrt) * 32;
            const bf16_t* w = wd + (size_t)64 * 1024 * 256;
            sg_tile<false>(m0, n0, 256,
                [&](int row) { return H + (size_t)(SH_ROW0 + row) * FF; },
                [&](int n, int k, int) { return w + (size_t)n * 256 + k; },
                [&](int t, int n, float v, float) { out[(size_t)t * D + n] = v + ALPHA * bf2f(x1[(size_t)t * D + n]); });
        }
    }
}
__device__ __forceinline__ void ph_combine(const Ptrs& P, int bid, int nb) {
    const int tidx = opaque_tid();
    const unsigned char* yslot = WSP(unsigned char, WS_YSLOT); float* out = P.out;
    const int lane = tidx & 63, w = tidx >> 6;
    for (int t = bid * NWAVE + w; t < T; t += nb * NWAVE) {
        float* orow = out + (size_t)t * D + lane * 16;
        float v[16];
        { const bf16_t* xr = WSP(bf16_t, WS_X1) + (size_t)t * D + lane * 16;
          const bf16x8 a = *(const bf16x8*)xr, b = *(const bf16x8*)(xr + 8);
#pragma unroll
          for (int i = 0; i < 8; ++i) { v[i] = bf2f((bf16_t)a[i]); v[8 + i] = bf2f((bf16_t)b[i]); } }
#pragma unroll
        for (int k = 0; k < TOPK; ++k) {
            const u32x4 q = *(const u32x4*)(yslot + ((size_t)t * TOPK + k) * D + lane * 16);
#pragma unroll
            for (int i = 0; i < 4; ++i) {
                v[4 * i]     += __builtin_amdgcn_cvt_f32_fp8((int)q[i], 0) * (1.0f / SLOT_SCALE);
                v[4 * i + 1] += __builtin_amdgcn_cvt_f32_fp8((int)q[i], 1) * (1.0f / SLOT_SCALE);
                v[4 * i + 2] += __builtin_amdgcn_cvt_f32_fp8((int)q[i], 2) * (1.0f / SLOT_SCALE);
                v[4 * i + 3] += __builtin_amdgcn_cvt_f32_fp8((int)q[i], 3) * (1.0f / SLOT_SCALE);
            }
        }
        float s = 0.f;
#pragma unroll
        for (int i = 0; i < 16; ++i) s += v[i];
        const float mu = wave_sum(s) * (1.0f / D);
        float ss = 0.f;
#pragma unroll
        for (int i = 0; i < 16; ++i) { const float d = v[i] - mu; ss += d * d; }
        const float rstd = rsqrtf(wave_sum(ss) * (1.0f / D) + EPS);
#pragma unroll
        for (int i = 0; i < 4; ++i) {
            const int c = lane * 16 + 4 * i;
            const f32x4 gg = *(const f32x4*)(P.ln2_g + c), bb = *(const f32x4*)(P.ln2_b + c);
            f32x4 o;
            o[0] = (v[4 * i] - mu) * rstd * gg[0] + bb[0]; o[1] = (v[4 * i + 1] - mu) * rstd * gg[1] + bb[1];
            o[2] = (v[4 * i + 2] - mu) * rstd * gg[2] + bb[2]; o[3] = (v[4 * i + 3] - mu) * rstd * gg[3] + bb[3];
            *(f32x4*)(orow + 4 * i) = o;
        }
    }
}

namespace g8 {
constexpr int BM = 256, BK = 64, HALF = 128, HTB = HALF * BK * 2, STAGE_BYTES = 8 * HTB;
__device__ __forceinline__ int lds_byte(int r, int c) { const int st = (r >> 4) * 2 + (c >> 5), rr = r & 15, cc = c & 31, ob = rr * 64 + cc * 2; return st * 1024 + (ob ^ (((ob >> 9) & 1) << 5)); }
__device__ __forceinline__ void stage_rc(int b, int& R, int& C) { const int st = b / 1024, sb = b % 1024, swz = sb ^ (((sb >> 9) & 1) << 5); R = (st >> 1) * 16 + swz / 64; C = (st & 1) * 32 + (swz % 64) / 2; }
__device__ __forceinline__ int perm32(int rho) { const int n = rho >> 4, i = rho & 15; return 8 * (i >> 2) + 4 * n + (i & 3); }

struct Unit { const char* A; const char* B; const int* rows; int pm, pn, e, nt; };
struct Geo { int lda_b, ldb_b; long kstepA, kstepB; int toep; };

typedef float f32x4 __attribute__((ext_vector_type(4)));
typedef f32x4 Acc[2][2][4][2];
typedef int v8i_t __attribute__((ext_vector_type(8)));
typedef int v4i_t __attribute__((ext_vector_type(4)));

__device__ __forceinline__ unsigned g8_rowoff(const int* rows, int h, int i, int tid, int lda_b) {
    int t2 = tid; asm volatile("" : "+v"(t2));
    int R, C; stage_rc(t2 * 16 + i * 8192, R, C);
    const int sl = rows[h * HALF + R];
    return (unsigned)((sl < 0 ? 0 : sl >> 3) * lda_b + C * 2);
}
template <class Epi, class Sched, bool GATHER, int DT = 0>
__device__ __forceinline__ void gemm_body(LAS unsigned char* lds, const Geo g, const Sched& S, const Epi& E) {
    const int tid = opaque_tid(), wid = __builtin_amdgcn_readfirstlane(tid >> 6), lane = tid & 63, wr = wid >> 2, wc = wid & 3, fr = lane & 15, fq = lane >> 4;
    unsigned voffB[2], vA[2][2];
#pragma unroll
    for (int i = 0; i < 2; ++i) { int R, C; stage_rc(tid * 16 + i * 8192, R, C); const int Rb = (R & ~31) + perm32(R & 31);
        voffB[i] = g.toep ? (unsigned)(Rb * 32 + 1536 - (C >> 4) * 512 + (C & 15) * 2) : (unsigned)(Rb * g.ldb_b + C * 2);
#pragma unroll
        for (int h = 0; h < 2; ++h) vA[h][i] = (unsigned)((h * HALF + R) * g.lda_b + C * 2); }
    const long kA = g.kstepA, kB = g.kstepB;
    const long hB = (long)HALF * g.ldb_b;
    const unsigned ldsw = (unsigned)wid * 1024u;
    const int aoff = lds_byte(wr * 64 + fr, fq * 8), boff = lds_byte(wc * 32 + fr, fq * 8);
#define G8_SA(b, h) (((b) * 2 + (h)) * HTB)
#define G8_SB(b, h) ((4 + (b) * 2 + (h)) * HTB)
#define G8_STAGE(bufoff, gbase, v0, v1) do { \
        unsigned v0_ = (v0), v1_ = (v1); if (GATHER) asm volatile("" : "+v"(v0_), "+v"(v1_)); \
        __builtin_amdgcn_global_load_lds((const unsigned*)((const char*)(gbase) + v0_), (LAS unsigned*)(lds + (bufoff) + ldsw), 16, 0, 0); \
        __builtin_amdgcn_global_load_lds((const unsigned*)((const char*)(gbase) + v1_), (LAS unsigned*)(lds + (bufoff) + ldsw + 8192), 16, 0, 0); } while (0)
#define G8_STB(bufoff, gbase) G8_STAGE(bufoff, gbase, voffB[0], voffB[1])
#define G8_LDA(dst, b, h) do { if (DT == 0) { _Pragma("unroll") for (int m = 0; m < 4; ++m) _Pragma("unroll") for (int k = 0; k < 2; ++k) dst[m][k] = *(const LAS bf16x8*)(lds + G8_SA(b, h) + aoff + m * 2048 + k * 1024); } \
        else { _Pragma("unroll") for (int m = 0; m < 4; ++m) dst##8[m] = __builtin_shufflevector(*(const LAS v4i_t*)(aBase + G8_SA(b, h) + m * 2048), *(const LAS v4i_t*)(aBase + G8_SA(b, h) + m * 2048 + 1024), 0, 1, 2, 3, 4, 5, 6, 7); } } while (0)
#define G8_LDB(dst, b, h) do { if (DT == 0) { _Pragma("unroll") for (int n = 0; n < 2; ++n) _Pragma("unroll") for (int k = 0; k < 2; ++k) dst[n][k] = *(const LAS bf16x8*)(lds + G8_SB(b, h) + boff + n * 2048 + k * 1024); } \
        else { _Pragma("unroll") for (int n = 0; n < 2; ++n) dst##8[n] = __builtin_shufflevector(*(const LAS v4i_t*)(bBase + (G8_SB(b, h) - 65536) + n * 2048), *(const LAS v4i_t*)(bBase + (G8_SB(b, h) - 65536) + n * 2048 + 1024), 0, 1, 2, 3, 4, 5, 6, 7); } } while (0)
#define G8_MMA(ai, bj, At, Bt) do { __builtin_amdgcn_s_setprio(1); \
        if (DT == 0) { _Pragma("unroll") for (int m = 0; m < 4; ++m) _Pragma("unroll") for (int n = 0; n < 2; ++n) _Pragma("unroll") for (int k = 0; k < 2; ++k) \
            acc[ai][bj][m][n] = __builtin_amdgcn_mfma_f32_16x16x32_bf16(Bt[n][k], At[m][k], acc[ai][bj][m][n], 0, 0, 0); } \
        else { _Pragma("unroll") for (int m = 0; m < 4; ++m) _Pragma("unroll") for (int n = 0; n < 2; ++n) \
            acc[ai][bj][m][n] = __builtin_amdgcn_mfma_scale_f32_16x16x128_f8f6f4(Bt##8[n], At##8[m], acc[ai][bj][m][n], 0, 0, 0, 127, 0, 127); } \
        __builtin_amdgcn_s_setprio(0); } while (0)
#define G8_WAIT_V(n) asm volatile("s_waitcnt vmcnt(" #n ")" ::: "memory")
#define G8_WAIT_L(n) asm volatile("s_waitcnt lgkmcnt(" #n ")" ::: "memory")
#define G8_BAR __builtin_amdgcn_s_barrier()
#define G8_SCHED __builtin_amdgcn_sched_barrier(0)
#define G8_ROWOFF(u_, h_, i_) g8_rowoff((u_).rows, (h_), (i_), tid, g.lda_b)
    Unit cur, nxt; int ui = 0;
    if (!S.next(0, cur)) return;
    Acc acc;
#pragma unroll
    for (int a = 0; a < 2; ++a)
#pragma unroll
        for (int b = 0; b < 2; ++b)
#pragma unroll
            for (int m = 0; m < 4; ++m)
#pragma unroll
                for (int n = 0; n < 2; ++n) acc[a][b][m][n] = (f32x4){0.f, 0.f, 0.f, 0.f};
    bf16x8 At[4][2], B0[2][2], B1[2][2];
    v8i_t At8[4], B08[2], B18[2];
    LAS unsigned char* aBase = lds + aoff; LAS unsigned char* bBase = lds + 65536 + boff;
    asm volatile("" : "+v"(aBase), "+v"(bBase));
    const char* cA = cur.A; const char* cB = cur.B;
    if (GATHER) {
#pragma unroll
        for (int h = 0; h < 2; ++h)
#pragma unroll
            for (int i = 0; i < 2; ++i) vA[h][i] = G8_ROWOFF(cur, h, i);
        asm volatile("" : "+v"(vA[0][0]), "+v"(vA[0][1]), "+v"(vA[1][0]), "+v"(vA[1][1]));
    }
    const long hA = GATHER ? 0 : 0;
    (void)hA;
    G8_STB(G8_SB(0, 0), cB); G8_STB(G8_SB(0, 1), cB + hB); G8_STAGE(G8_SA(0, 0), cA, vA[0][0], vA[0][1]); G8_STAGE(G8_SA(0, 1), cA, vA[1][0], vA[1][1]);
    if (wr == 1) G8_BAR;
    G8_WAIT_V(2); G8_BAR;
    G8_STB(G8_SB(1, 0), cB + kB); G8_STAGE(G8_SA(1, 0), cA + kA, vA[0][0], vA[0][1]); G8_STB(G8_SB(1, 1), cB + hB + kB);
    G8_WAIT_V(6); G8_BAR;
    for (;;) {
        const bool has_next = S.next(ui + 1, nxt);
        const char* nA = has_next ? nxt.A : cA; const char* nB = has_next ? nxt.B : cB;
        const int nt = cur.nt;
        for (int t = 0; t < nt; t += 2) {
            const bool last = (t == nt - 2);
            const char* a1 = cA + (long)(t + 1) * kA;
            const char* a2 = last ? nA : cA + (long)(t + 2) * kA; const char* b2 = last ? nB : cB + (long)(t + 2) * kB;
            const char* a3 = a2 + kA; const char* b3 = b2 + kB;
            G8_LDB(B0, 0, 0); G8_LDB(B1, 0, 1); G8_SCHED; G8_LDA(At, 0, 0); G8_STAGE(G8_SA(1, 1), a1, vA[1][0], vA[1][1]);
            if (GATHER && last && has_next) {
                vA[0][0] = G8_ROWOFF(nxt, 0, 0); vA[0][1] = G8_ROWOFF(nxt, 0, 1); vA[1][0] = G8_ROWOFF(nxt, 1, 0); vA[1][1] = G8_ROWOFF(nxt, 1, 1);
                asm volatile("" : "+v"(vA[0][0]), "+v"(vA[0][1]), "+v"(vA[1][0]), "+v"(vA[1][1]));
            }
            const unsigned w00 = vA[0][0], w01 = vA[0][1], w10 = vA[1][0], w11 = vA[1][1];
            G8_WAIT_V(8); G8_WAIT_L(0); G8_BAR; G8_MMA(0, 0, At, B0); G8_MMA(0, 1, At, B1); G8_BAR; G8_SCHED;
            G8_LDA(At, 0, 1); G8_STB(G8_SB(0, 0), b2); G8_STB(G8_SB(0, 1), b2 + hB); G8_STAGE(G8_SA(0, 0), a2, w00, w01);
            G8_WAIT_V(8); G8_WAIT_L(0); G8_BAR; G8_MMA(1, 0, At, B0); G8_MMA(1, 1, At, B1); G8_BAR; G8_SCHED;
            G8_LDB(B0, 1, 0); G8_LDB(B1, 1, 1); G8_SCHED; G8_LDA(At, 1, 0); G8_STAGE(G8_SA(0, 1), a2, w10, w11);
            G8_WAIT_V(8); G8_WAIT_L(0); G8_BAR; G8_MMA(0, 0, At, B0); G8_MMA(0, 1, At, B1); G8_BAR; G8_SCHED;
            G8_LDA(At, 1, 1); G8_STB(G8_SB(1, 0), b3); G8_STB(G8_SB(1, 1), b3 + hB); G8_STAGE(G8_SA(1, 0), a3, w00, w01);
            G8_WAIT_V(8); G8_WAIT_L(0); G8_BAR; G8_MMA(1, 0, At, B0); G8_MMA(1, 1, At, B1); G8_BAR; G8_SCHED;
        }
        if (wr == 0) G8_BAR;
        { int t3_ = threadIdx.x; asm volatile("" : "+v"(t3_)); E(acc, cur, wr, wc, t3_ & 15, (t3_ >> 4) & 3); }
        if (!has_next) break;
#pragma unroll
        for (int a = 0; a < 2; ++a)
#pragma unroll
            for (int b = 0; b < 2; ++b)
#pragma unroll
                for (int m = 0; m < 4; ++m)
#pragma unroll
                    for (int n = 0; n < 2; ++n) acc[a][b][m][n] = (f32x4){0.f, 0.f, 0.f, 0.f};
        cur = nxt; cA = nA; cB = nB; ++ui;
        if (wr == 1) G8_BAR;
    }
    G8_WAIT_V(0);
    G8_BAR;
#undef G8_SA
#undef G8_SB
#undef G8_STAGE
#undef G8_STB
#undef G8_LDA
#undef G8_LDB
#undef G8_MMA
#undef G8_WAIT_V
#undef G8_WAIT_L
#undef G8_BAR
#undef G8_SCHED
#undef G8_ROWOFF
}
}
namespace g8 {
__device__ __forceinline__ unsigned pk_bf16(float lo, float hi) { return (unsigned)f2bf(lo) | ((unsigned)f2bf(hi) << 16); }
__device__ __forceinline__ u32x4 pack8(const f32x4 a, const f32x4 b) { u32x4 w; w[0] = pk_bf16(a[0], a[1]); w[1] = pk_bf16(a[2], a[3]); w[2] = pk_bf16(b[0], b[1]); w[3] = pk_bf16(b[2], b[3]); return w; }
__device__ __forceinline__ int unit_index(int i, int nunits) {
    const int G = gridDim.x, c = blockIdx.x;
    if ((G & 7) != 0) { const long L = (long)i * G + c; return L < nunits ? (int)L : -1; }
    const int x = c & 7, r = c >> 3, GX = G >> 3;
    const int lo = (int)(((long)nunits * x) >> 3), hi = (int)(((long)nunits * (x + 1)) >> 3);
    const int L = lo + i * GX + r;
    return L < hi ? L : -1;
}
struct SchedReg {
    const char* A; const char* B; int lda_b, ldb_b, nM, nN, nt;
    __device__ __forceinline__ bool next(int i, Unit& u) const {
        const int L = unit_index(i, nM * nN); if (L < 0) return false;
        u.pm = L / nN; u.pn = L % nN; u.e = 0; u.nt = nt; u.rows = nullptr;
        u.A = A + (size_t)u.pm * 256 * lda_b; u.B = B + (size_t)u.pn * 256 * ldb_b; return true;
    }
};
struct SchedS5 {
    const char* A; const char* B; int lda_b, ldb_b, nN, nt; size_t a_gstride, b_gstride; int toep;
    __device__ __forceinline__ bool next(int i, Unit& u) const {
        const int L = unit_index(i, SG * 2 * nN); if (L < 0) return false;
        const int g = L / (2 * nN), r = L % (2 * nN);
        u.pm = r / nN; u.pn = r % nN; u.e = g; u.rows = nullptr;
        u.A = A + (size_t)g * a_gstride + (size_t)u.pm * 256 * lda_b;
        if (toep) { u.B = B + (size_t)g * 127 * 512 + 63 * 512 + (size_t)u.pn * 256 * 32 - 1536; u.nt = 4 * (u.pn + 1); }
        else { u.B = B + (size_t)g * b_gstride + (size_t)u.pn * 256 * ldb_b; u.nt = nt; }
        return true;
    }
};
struct SchedMoe {
    const char* A; const char* B; const int* eoff; const int* rowtok; int lda_b, npn, nt; size_t b_estride; int ldb_b; int gather; const int* tile_e;
    __device__ __forceinline__ bool next(int i, Unit& u) const {
        const int nrt = eoff[64] >> 8;
        const int G = gridDim.x, c = blockIdx.x;
        int rt;
        if ((G & 7) == 0) {
            const int x = c & 7, r = c >> 3, GX = G >> 3;
            const int r0 = (nrt * x) >> 3, r1 = (nrt * (x + 1)) >> 3, nr = r1 - r0;
            const int j = i * GX + r;
            if (j >= (nr + 16) * npn) return false;
            const int tl = j / npn; u.pn = j % npn;
            rt = (tl < nr) ? r0 + tl : nrt + 16 * x + (tl - nr);
        } else {
            const long L = (long)i * G + c; if (L >= (long)(nrt + T / 256) * npn) return false;
            rt = (int)(L / npn); u.pn = (int)(L % npn);
        }
        u.nt = nt;
        int e = 64;
        if (rt < nrt) e = tile_e[rt];
        u.e = e; u.pm = rt;
        u.B = B + (size_t)e * b_estride + (size_t)u.pn * 256 * ldb_b;
        if (gather) {
            u.A = A; u.rows = rowtok + ((e < 64) ? rt * 256 : SH_ROW0 + (rt - nrt) * 256);
        } else {
            const int row0 = (e < 64) ? rt * 256 : SH_ROW0 + (rt - nrt) * 256;
            u.A = A + (size_t)row0 * lda_b; u.rows = nullptr;
        }
        return true;
    }
};

#define EPI_ROWS_BEGIN _Pragma("unroll") for (int ai = 0; ai < 2; ++ai) _Pragma("unroll") for (int m = 0; m < 4; ++m) { const int rloc = ai * 128 + wr * 64 + m * 16 + fr;
#define EPI_ROWS_END }

struct EpiWin {
    bf16_t* cq; bf16_t* ckv; bf16_t* u; bf16_t* Kc; const float2* rope; float* rsqp; float* rskvp;
    __device__ __forceinline__ void operator()(const Acc& acc, const Unit& un, int wr, int wc, int fr, int fq) const {
        const int pn = un.pn;
        if (pn == 0) {
            EPI_ROWS_BEGIN
                const int t = un.pm * 256 + rloc;
                float ss = 0.f;
#pragma unroll
                for (int bj = 0; bj < 2; ++bj) { const f32x4 v0 = acc[ai][bj][m][0], v1 = acc[ai][bj][m][1];
                    *(u32x4*)(cq + (size_t)t * 256 + bj * 128 + wc * 32 + fq * 8) = pack8(v0, v1);
                    ss += v0[0] * v0[0] + v0[1] * v0[1] + v0[2] * v0[2] + v0[3] * v0[3] + v1[0] * v1[0] + v1[1] * v1[1] + v1[2] * v1[2] + v1[3] * v1[3]; }
                ss += __shfl_xor(ss, 16); ss += __shfl_xor(ss, 32);
                if (fq == 0) rsqp[(size_t)t * 4 + wc] = ss;
            EPI_ROWS_END
        } else if (pn <= 2) {
            EPI_ROWS_BEGIN
                const int t = un.pm * 256 + rloc;
                const int b = t >> 11, s = t & 2047, j = s >> 6, sl = s & 63;
#pragma unroll
                for (int bj = 0; bj < 2; ++bj) { const int ch0 = (pn - 1) * 256 + bj * 128 + wc * 32 + fq * 8, gi = ch0 >> 4, c0 = ch0 & 15;
                    *(u32x4*)(u + ((size_t)gi * 512 + b * 32 + j) * 1024 + sl * 16 + c0) = pack8(acc[ai][bj][m][0], acc[ai][bj][m][1]); }
            EPI_ROWS_END
        } else {
            EPI_ROWS_BEGIN
                const int t = un.pm * 256 + rloc;
                const f32x4 v0 = acc[ai][0][m][0], v1 = acc[ai][0][m][1];
                *(u32x4*)(ckv + (size_t)t * 256 + wc * 32 + fq * 8) = pack8(v0, v1);
                float ss = v0[0] * v0[0] + v0[1] * v0[1] + v0[2] * v0[2] + v0[3] * v0[3] + v1[0] * v1[0] + v1[1] * v1[1] + v1[2] * v1[2] + v1[3] * v1[3];
                ss += __shfl_xor(ss, 16); ss += __shfl_xor(ss, 32);
                if (fq == 0) rskvp[(size_t)t * 4 + wc] = ss;
                *(u32x4*)(ckv + (size_t)t * 256 + 128 + wc * 32 + fq * 8) = (u32x4){0u, 0u, 0u, 0u};
            EPI_ROWS_END
            if (wc == 0) {
                EPI_ROWS_BEGIN
                    const int t = un.pm * 256 + rloc;
                    const f32x4 x1 = acc[ai][1][m][0], x2 = acc[ai][1][m][1];
                    const f32x4 ca = *(const f32x4*)(rope + (size_t)t * 16 + fq * 4), cb = *(const f32x4*)(rope + (size_t)t * 16 + fq * 4 + 2);
                    const float o10 = x1[0] * ca[0] - x2[0] * ca[1], o11 = x1[1] * ca[2] - x2[1] * ca[3], o12 = x1[2] * cb[0] - x2[2] * cb[1], o13 = x1[3] * cb[2] - x2[3] * cb[3];
                    const float o20 = x2[0] * ca[0] + x1[0] * ca[1], o21 = x2[1] * ca[2] + x1[1] * ca[3], o22 = x2[2] * cb[0] + x1[2] * cb[1], o23 = x2[3] * cb[2] + x1[3] * cb[3];
                    uint2 w1, w2; w1.x = pk_bf16(o10, o11); w1.y = pk_bf16(o12, o13); w2.x = pk_bf16(o20, o21); w2.y = pk_bf16(o22, o23);
                    const int b = t >> 11, s = t & 2047;
                    bf16_t* kp = Kc + (((size_t)b * NH) * SEQ + s) * QKD + 64 + fq * 4;
#pragma unroll 1
                    for (int h = 0; h < NH; ++h) { *(uint2*)kp = w1; *(uint2*)(kp + 16) = w2; kp += (size_t)SEQ * QKD; }
                EPI_ROWS_END
            }
        }
    }
};
struct EpiQ {
    bf16_t* Q; const float* rsqp; const float2* rope;
    __device__ __forceinline__ void operator()(const Acc& acc, const Unit& un, int wr, int wc, int fr, int fq) const {
        EPI_ROWS_BEGIN
            const int t = un.pm * 256 + rloc, b = t >> 11, s = t & 2047;
            const f32x4 pp = *(const f32x4*)(rsqp + (size_t)t * 4);
            const float rs = rsqrtf((pp[0] + pp[1] + pp[2] + pp[3]) * (1.0f / 256) + EPS);
            if (un.pn < 2) {
#pragma unroll
                for (int bj = 0; bj < 2; ++bj) { const int col = un.pn * 256 + bj * 128 + wc * 32 + fq * 8;
                    *(u32x4*)(Q + (((size_t)b * NH + (col >> 6)) * SEQ + s) * QKD + (col & 63)) = pack8(acc[ai][bj][m][0] * rs, acc[ai][bj][m][1] * rs); }
            } else {
                const f32x4 ca = *(const f32x4*)(rope + (size_t)t * 16 + fq * 4), cb = *(const f32x4*)(rope + (size_t)t * 16 + fq * 4 + 2);
#pragma unroll
                for (int bj = 0; bj < 2; ++bj) { const f32x4 x1 = acc[ai][bj][m][0] * rs, x2 = acc[ai][bj][m][1] * rs;
                    const float o10 = x1[0] * ca[0] - x2[0] * ca[1], o11 = x1[1] * ca[2] - x2[1] * ca[3], o12 = x1[2] * cb[0] - x2[2] * cb[1], o13 = x1[3] * cb[2] - x2[3] * cb[3];
                    const float o20 = x2[0] * ca[0] + x1[0] * ca[1], o21 = x2[1] * ca[2] + x1[1] * ca[3], o22 = x2[2] * cb[0] + x1[2] * cb[1], o23 = x2[3] * cb[2] + x1[3] * cb[3];
                    uint2 w1, w2; w1.x = pk_bf16(o10, o11); w1.y = pk_bf16(o12, o13); w2.x = pk_bf16(o20, o21); w2.y = pk_bf16(o22, o23);
                    bf16_t* qp = Q + (((size_t)b * NH + (bj * 4 + wc)) * SEQ + s) * QKD + 64 + fq * 4; *(uint2*)qp = w1; *(uint2*)(qp + 16) = w2; }
            }
        EPI_ROWS_END
    }
};
struct EpiKV {
    bf16_t* Kc; bf16_t* V; const float* rskvp;
    __device__ __forceinline__ void operator()(const Acc& acc, const Unit& un, int wr, int wc, int fr, int fq) const {
        EPI_ROWS_BEGIN
            const int t = un.pm * 256 + rloc, b = t >> 11, s = t & 2047;
            const f32x4 pp = *(const f32x4*)(rskvp + (size_t)t * 4);
            const float rs = rsqrtf((pp[0] + pp[1] + pp[2] + pp[3]) * (1.0f / 128) + EPS);
#pragma unroll
            for (int bj = 0; bj < 2; ++bj) { const int col = (un.pn & 1) * 256 + bj * 128 + wc * 32 + fq * 8;
                const u32x4 w = pack8(acc[ai][bj][m][0] * rs, acc[ai][bj][m][1] * rs);
                if (un.pn < 2) *(u32x4*)(Kc + (((size_t)b * NH + (col >> 6)) * SEQ + s) * QKD + (col & 63)) = w;
                else *(u32x4*)(V + (((size_t)b * NH + (col >> 6)) * SEQ + s) * VD + (col & 63)) = w; }
        EPI_ROWS_END
    }
};
struct EpiS5b {
    float* xloc;
    __device__ __forceinline__ void operator()(const Acc& acc, const Unit& un, int wr, int wc, int fr, int fq) const {
        EPI_ROWS_BEGIN
            float* o = xloc + ((size_t)un.e * 512 + un.pm * 256 + rloc) * 128 + wc * 32 + fq * 8;
            *(f32x4*)o = acc[ai][0][m][0]; *(f32x4*)(o + 4) = acc[ai][0][m][1];
        EPI_ROWS_END
    }
};
template <int MODE> struct EpiS5y {
    bf16_t* dst; const bf16_t* yintra;
    __device__ __forceinline__ void operator()(const Acc& acc, const Unit& un, int wr, int wc, int fr, int fq) const {
        EPI_ROWS_BEGIN
            const int row = un.pm * 256 + rloc, b = row >> 5, j = row & 31;
#pragma unroll
            for (int bj = 0; bj < 2; ++bj) { const int n = un.pn * 256 + bj * 128 + wc * 32 + fq * 8, tt = n >> 4, c0 = n & 15;
                const size_t o = ((size_t)b * SEQ + j * CH + tt) * SSMW + un.e * SC + c0;
                f32x4 v0 = acc[ai][bj][m][0], v1 = acc[ai][bj][m][1];
                if (MODE == 1) { const bf16x8 yi = *(const bf16x8*)(yintra + o);
#pragma unroll
                    for (int q = 0; q < 4; ++q) { v0[q] = gelu_tanh(v0[q] + bf2f((bf16_t)yi[q])); v1[q] = gelu_tanh(v1[q] + bf2f((bf16_t)yi[4 + q])); } }
                *(u32x4*)(dst + o) = pack8(v0, v1); }
        EPI_ROWS_END
    }
};
struct EpiGlu {
    const bf16_t* Y; const float* bglu; bf16_t* AS;
    __device__ __forceinline__ void operator()(const Acc& acc, const Unit& un, int wr, int wc, int fr, int fq) const {
        EPI_ROWS_BEGIN
            const int t = un.pm * 256 + rloc;
#pragma unroll
            for (int bj = 0; bj < 2; ++bj) { const int col = un.pn * 256 + bj * 128 + wc * 32 + fq * 8;
                const bf16x8 yv = *(const bf16x8*)(Y + (size_t)t * 512 + col);
                const f32x4 b0 = *(const f32x4*)(bglu + col), b1 = *(const f32x4*)(bglu + col + 4);
                f32x4 v0 = acc[ai][bj][m][0], v1 = acc[ai][bj][m][1];
#pragma unroll
                for (int q = 0; q < 4; ++q) { v0[q] = bf2f((bf16_t)yv[q]) * sigmoidf_(v0[q] + b0[q]); v1[q] = bf2f((bf16_t)yv[4 + q]) * sigmoidf_(v1[q] + b1[q]); }
                *(u32x4*)(AS + (size_t)t * 1024 + 512 + col) = pack8(v0, v1); }
        EPI_ROWS_END
    }
};
struct EpiWo {
    const float* x; const float* xstat; const float* g; const float* bt; float* pre1;
    __device__ __forceinline__ void operator()(const Acc& acc, const Unit& un, int wr, int wc, int fr, int fq) const {
        EPI_ROWS_BEGIN
            const int t = un.pm * 256 + rloc;
            const float mu = xstat[2 * t], rstd = xstat[2 * t + 1];
#pragma unroll
            for (int bj = 0; bj < 2; ++bj) { const int col = un.pn * 256 + bj * 128 + wc * 32 + fq * 8;
#pragma unroll
                for (int n = 0; n < 2; ++n) { const f32x4 xv = *(const f32x4*)(x + (size_t)t * D + col + 4 * n), gg = *(const f32x4*)(g + col + 4 * n), bb = *(const f32x4*)(bt + col + 4 * n);
                    f32x4 o;
#pragma unroll
                    for (int q = 0; q < 4; ++q) o[q] = acc[ai][bj][m][n][q] + ALPHA * ((xv[q] - mu) * rstd * gg[q] + bb[q]);
                    *(f32x4*)(pre1 + (size_t)t * D + col + 4 * n) = o; } }
        EPI_ROWS_END
    }
};
struct EpiGU {
    static constexpr float QINV = 1.0f / (XQ_SCALE * WQ_SCALE);
    bf16_t* H; const float* roww; const int* eoff;
    __device__ __forceinline__ void operator()(const Acc& acc, const Unit& un, int wr, int wc, int fr, int fq) const {
        const int nrt = eoff[64] >> 8;
        const bool shared = un.e == 64;
        const int row0 = shared ? SH_ROW0 + (un.pm - nrt) * 256 : un.pm * 256;
        EPI_ROWS_BEGIN
            const int row = row0 + rloc;
            const float w = shared ? 1.0f : roww[row];
            const f32x4 g0 = acc[ai][0][m][0], g1 = acc[ai][0][m][1], u0 = acc[ai][1][m][0], u1 = acc[ai][1][m][1];
            f32x4 h0, h1;
#pragma unroll
            for (int q = 0; q < 4; ++q) { const float ga = g0[q] * QINV, gb = g1[q] * QINV; h0[q] = ga * sigmoidf_(ga) * (u0[q] * QINV) * w; h1[q] = gb * sigmoidf_(gb) * (u1[q] * QINV) * w; }
            *(u32x4*)(H + (size_t)row * FF + un.pn * 128 + wc * 32 + fq * 8) = pack8(h0, h1);
        EPI_ROWS_END
    }
};
struct EpiDown {
    unsigned char* yslot; float* out; bf16_t* x1; const int* rowtok; const int* eoff; LAS unsigned char* stg;
    __device__ __forceinline__ void operator()(const Acc& acc, const Unit& un, int wr, int wc, int fr, int fq) const {
        const int nrt = eoff[64] >> 8;
        if (un.e < 64) {
            const int tid = (wr * 4 + wc) * 64 + fq * 16 + fr;
            const int rrow = tid >> 4, rcol = (tid & 15) * 16;
            int slots[8];
#pragma unroll
            for (int q = 0; q < 8; ++q) slots[q] = rowtok[un.pm * 256 + (q >> 2) * 128 + (rrow >> 4) * 64 + (q & 3) * 16 + (rrow & 15)];
            int p = 0;
#pragma unroll
            for (int ai = 0; ai < 2; ++ai)
#pragma unroll
                for (int m = 0; m < 4; ++m, ++p) {
                    LAS unsigned char* sb = stg + (p & 1) * (32 * 288);
#pragma unroll
                    for (int bj = 0; bj < 2; ++bj) {
                        const f32x4 v0 = acc[ai][bj][m][0] * SLOT_SCALE, v1 = acc[ai][bj][m][1] * SLOT_SCALE;
                        int p0 = __builtin_amdgcn_cvt_pk_fp8_f32(v0[0], v0[1], 0, false); p0 = __builtin_amdgcn_cvt_pk_fp8_f32(v0[2], v0[3], p0, true);
                        int p1 = __builtin_amdgcn_cvt_pk_fp8_f32(v1[0], v1[1], 0, false); p1 = __builtin_amdgcn_cvt_pk_fp8_f32(v1[2], v1[3], p1, true);
                        u32x2 w; w[0] = (unsigned)p0; w[1] = (unsigned)p1;
                        *(LAS u32x2*)(sb + (wr * 16 + fr) * 288 + bj * 128 + wc * 32 + fq * 8) = w;
                    }
                    asm volatile("s_waitcnt lgkmcnt(0)\n\ts_barrier" ::: "memory");
                    const int slot = slots[ai * 4 + m];
                    const u32x4 v = *(const LAS u32x4*)(sb + rrow * 288 + rcol);
                    if (slot >= 0) *(u32x4*)(yslot + (size_t)slot * D + un.pn * 256 + rcol) = v;
                }
            asm volatile("s_waitcnt lgkmcnt(0)\n\ts_barrier" ::: "memory");
        } else {
            EPI_ROWS_BEGIN
                const int t = (un.pm - nrt) * 256 + rloc;
#pragma unroll
                for (int bj = 0; bj < 2; ++bj) { const int col = un.pn * 256 + bj * 128 + wc * 32 + fq * 8;
                    bf16_t* xp = x1 + (size_t)t * D + col;
                    const bf16x8 xv = *(const bf16x8*)xp;
                    f32x4 o0, o1;
#pragma unroll
                    for (int q = 0; q < 4; ++q) { o0[q] = acc[ai][bj][m][0][q] + ALPHA * bf2f((bf16_t)xv[q]); o1[q] = acc[ai][bj][m][1][q] + ALPHA * bf2f((bf16_t)xv[4 + q]); }
                    *(u32x4*)xp = pack8(o0, o1); }
            EPI_ROWS_END
        }
    }
};
}
namespace g8 {
struct EpiRouter {
    float* logits;
    __device__ __forceinline__ void operator()(const Acc& acc, const Unit& un, int wr, int wc, int fr, int fq) const {
        if (wc >= 2) return;
        EPI_ROWS_BEGIN
            float* o = logits + (size_t)(un.pm * 256 + rloc) * NE + wc * 32 + fq * 8;
            *(f32x4*)o = acc[ai][0][m][0]; *(f32x4*)(o + 4) = acc[ai][0][m][1];
        EPI_ROWS_END
    }
};
}
__device__ __forceinline__ void fp_gemm_router(const Ptrs& P, LAS unsigned char* lds) {
    g8::Geo g{2048, 2048, 128, 128, 0};
    g8::SchedReg S{(const char*)WSP(bf16_t, WS_X1), (const char*)WSP(bf16_t, WS_WR), 2048, 2048, T / 256, 1, 16};
    g8::EpiRouter E{WSP(float, WS_LOGITS)};
    g8::gemm_body<g8::EpiRouter, g8::SchedReg, false>(lds, g, S, E);
}
__device__ __forceinline__ void ph_topk_cnt(const Ptrs& P, LAS unsigned char* lds, int bid, int nb) {
    const int tidx = opaque_tid();
    const float* logits = WSP(float, WS_LOGITS); int* topi = WSP(int, WS_TOPI); float* topw = WSP(float, WS_TOPW); int* cnt = WSP(int, WS_CNT);
    LAS int* hist = (LAS int*)lds;
    const int lane = tidx & 63, w = tidx >> 6;
    for (int tile = bid; tile < 256; tile += nb) {
        if (tidx < 64) hist[tidx] = 0;
        __syncthreads();
        for (int i = 0; i < 16; ++i) {
            const int t = tile * 128 + w * 16 + i;
            const float sc = sigmoidf_(logits[(size_t)t * NE + lane]);
            const float sel = sc + P.router_bias[lane];
            const int grp = lane >> 3;
            float m1 = sel;
            m1 = fmaxf(m1, __shfl_xor(m1, 1)); m1 = fmaxf(m1, __shfl_xor(m1, 2)); m1 = fmaxf(m1, __shfl_xor(m1, 4));
            const unsigned long long bal = __ballot(sel == m1) & (0xFFull << (8 * grp));
            const int first = __ffsll((long long)bal) - 1;
            float m2 = (lane == first) ? -INFINITY : sel;
            m2 = fmaxf(m2, __shfl_xor(m2, 1)); m2 = fmaxf(m2, __shfl_xor(m2, 2)); m2 = fmaxf(m2, __shfl_xor(m2, 4));
            const float gs = m1 + m2;
            int cg = 0;
#pragma unroll
            for (int gj = 0; gj < 8; ++gj) { const float sj = __shfl(gs, gj * 8); cg += (sj > gs || (sj == gs && gj < grp)) ? 1 : 0; }
            const bool gsel = cg < 4;
            const float v = gsel ? sel : -INFINITY;
            int rank = 0;
#pragma unroll 8
            for (int e2 = 0; e2 < 64; ++e2) { const float ve = __shfl(v, e2); rank += (ve > v || (ve == v && e2 < lane)) ? 1 : 0; }
            const bool chosen = gsel && rank < TOPK;
            const float wsum = wave_sum(chosen ? sc : 0.f);
            if (chosen) { topi[(size_t)t * TOPK + rank] = lane; topw[(size_t)t * TOPK + rank] = sc / wsum * 2.5f; atomicAdd((int*)&hist[lane], 1); }
        }
        __syncthreads();
        if (tidx < 64) cnt[tile * 64 + tidx] = hist[tidx];
        __syncthreads();
    }
}
__device__ __forceinline__ void ph_lists2(const Ptrs& P, LAS unsigned char* lds, int bid, int nb) {
    const int tidx = opaque_tid();
    const int* topi = WSP(int, WS_TOPI); const float* topw = WSP(float, WS_TOPW); const int* cnt = WSP(int, WS_CNT);
    int* eoff = WSP(int, WS_EOFF); int* rowtok = WSP(int, WS_ROWTOK); float* roww = WSP(float, WS_ROWW);
    LAS int* red_tot = (LAS int*)lds;
    LAS int* red_pre = red_tot + 512;
    LAS int* tot = red_pre + 512;
    LAS int* off = tot + 64;
    LAS int* seg = off + 128;
    LAS int* ti = seg + 512;
    const int e = tidx & 63, part = tidx >> 6;
    for (int tile = bid; tile < 256; tile += nb) {
        int st = 0, sp = 0;
        for (int t2 = part * 32; t2 < part * 32 + 32; ++t2) { const int c = cnt[t2 * 64 + e]; st += c; sp += (t2 < tile) ? c : 0; }
        red_tot[part * 64 + e] = st; red_pre[part * 64 + e] = sp;
        ti[tidx] = topi[tile * 1024 + tidx]; ti[tidx + 512] = topi[tile * 1024 + 512 + tidx];
        __syncthreads();
        int pre_e = 0;
        if (tidx < 64) { int a = 0; for (int q = 0; q < 8; ++q) { a += red_tot[q * 64 + tidx]; pre_e += red_pre[q * 64 + tidx]; } tot[tidx] = a; }
        __syncthreads();
        if (tidx == 0) { int o = 0; for (int i = 0; i < 64; ++i) { off[i] = o; o += (tot[i] + 255) & ~255; } off[64] = o; }
        int c = 0;
        for (int k = 0; k < 128; ++k) c += (ti[part * 128 + k] == e) ? 1 : 0;
        seg[part * 64 + e] = c;
        __syncthreads();
        if (tidx < 64) { red_pre[tidx] = pre_e; }
        __syncthreads();
        int pos = off[e] + red_pre[e];
        for (int q = 0; q < part; ++q) pos += seg[q * 64 + e];
        for (int k = 0; k < 128; ++k) { const int idx = part * 128 + k; if (ti[idx] == e) { rowtok[pos] = tile * 1024 + idx; roww[pos] = topw[tile * 1024 + idx]; ++pos; } }
        if (tile == 255 && part == 7) { const int end = off[e + 1]; for (; pos < end; ++pos) { rowtok[pos] = -1; roww[pos] = 0.f; } }
        if (bid == 0 && tidx <= 64) eoff[tidx] = off[tidx];
        if (bid == 0 && tidx < 64) { int* tile_e = WSP(int, WS_TILEE); for (int rt = off[tidx] >> 8; rt < (off[tidx + 1] >> 8); ++rt) tile_e[rt] = tidx; }
        __syncthreads();
    }
    for (int i = bid * NTHR + tidx; i < T; i += nb * NTHR) rowtok[SH_ROW0 + i] = i * 8;
}
__device__ __forceinline__ void fp_gemm_win(const Ptrs& P, LAS unsigned char* lds) {
    g8::Geo g{2048, 2048, 128, 128, 0};
    g8::SchedReg S{(const char*)WSP(bf16_t, WS_XN), (const char*)WSP(bf16_t, WS_WIN), 2048, 2048, T / 256, 4, 16};
    g8::EpiWin E{WSP(bf16_t, WS_CQ), WSP(bf16_t, WS_CKV), WSP(bf16_t, WS_U), WSP(bf16_t, WS_K), WSP(float2, WS_ROPE), WSP(float, WS_RSQ), WSP(float, WS_RSKV)};
    g8::gemm_body<g8::EpiWin, g8::SchedReg, false>(lds, g, S, E);
}
__device__ __forceinline__ void fp_gemm_q(const Ptrs& P, LAS unsigned char* lds) {
    g8::Geo g{512, 512, 128, 128, 0};
    g8::SchedReg S{(const char*)WSP(bf16_t, WS_CQ), (const char*)WSP(bf16_t, WS_WUQ), 512, 512, T / 256, 3, 4};
    g8::EpiQ E{WSP(bf16_t, WS_Q), WSP(float, WS_RSQ), WSP(float2, WS_ROPE)};
    g8::gemm_body<g8::EpiQ, g8::SchedReg, false>(lds, g, S, E);
}
__device__ __forceinline__ void fp_gemm_kv(const Ptrs& P, LAS unsigned char* lds) {
    g8::Geo g{512, 512, 128, 128, 0};
    g8::SchedReg S{(const char*)WSP(bf16_t, WS_CKV), (const char*)WSP(bf16_t, WS_WUKV), 512, 512, T / 256, 4, 4};
    g8::EpiKV E{WSP(bf16_t, WS_K), WSP(bf16_t, WS_V), WSP(float, WS_RSKV)};
    g8::gemm_body<g8::EpiKV, g8::SchedReg, false>(lds, g, S, E);
}
__device__ __forceinline__ void fp_gemm_s5b(const Ptrs& P, LAS unsigned char* lds) {
    g8::Geo g{2048, 2048, 128, 128, 0};
    g8::SchedS5 S{(const char*)WSP(bf16_t, WS_U), (const char*)WSP(bf16_t, WS_BLOC), 2048, 2048, 1, 16, (size_t)512 * 2048, (size_t)256 * 2048, 0};
    g8::EpiS5b E{WSP(float, WS_XLOC)};
    g8::gemm_body<g8::EpiS5b, g8::SchedS5, false>(lds, g, S, E);
}
__device__ __forceinline__ void fp_gemm_s5a(const Ptrs& P, LAS unsigned char* lds) {
    g8::Geo g{2048, 32, 128, -2048, 1};
    g8::SchedS5 S{(const char*)WSP(bf16_t, WS_U), (const char*)WSP(bf16_t, WS_KTAB), 2048, 32, 4, 16, (size_t)512 * 2048, 0, 1};
    g8::EpiS5y<0> E{WSP(bf16_t, WS_YINTRA), nullptr};
    g8::gemm_body<g8::EpiS5y<0>, g8::SchedS5, false>(lds, g, S, E);
}
__device__ __forceinline__ void fp_gemm_s5d(const Ptrs& P, LAS unsigned char* lds) {
    g8::Geo g{512, 512, 128, 128, 0};
    g8::SchedS5 S{(const char*)WSP(bf16_t, WS_XPREV), (const char*)WSP(bf16_t, WS_CLAM), 512, 512, 4, 4, (size_t)512 * 512, (size_t)1024 * 512, 0};
    g8::EpiS5y<1> E{WSP(bf16_t, WS_Y), WSP(bf16_t, WS_YINTRA)};
    g8::gemm_body<g8::EpiS5y<1>, g8::SchedS5, false>(lds, g, S, E);
}
__device__ __forceinline__ void fp_gemm_glu(const Ptrs& P, LAS unsigned char* lds) {
    g8::Geo g{1024, 1024, 128, 128, 0};
    g8::SchedReg S{(const char*)WSP(bf16_t, WS_Y), (const char*)WSP(bf16_t, WS_WGLU), 1024, 1024, T / 256, 2, 8};
    g8::EpiGlu E{WSP(bf16_t, WS_Y), P.b_glu, WSP(bf16_t, WS_AS)};
    g8::gemm_body<g8::EpiGlu, g8::SchedReg, false>(lds, g, S, E);
}
__device__ __forceinline__ void fp_gemm_wo(const Ptrs& P, LAS unsigned char* lds) {
    g8::Geo g{2048, 2048, 128, 128, 0};
    g8::SchedReg S{(const char*)WSP(bf16_t, WS_AS), (const char*)WSP(bf16_t, WS_WO), 2048, 2048, T / 256, 4, 16};
    g8::EpiWo E{P.x, WSP(float, WS_XSTAT), P.ln_in_g, P.ln_in_b, P.out};
    g8::gemm_body<g8::EpiWo, g8::SchedReg, false>(lds, g, S, E);
}
__device__ __forceinline__ void fp_gemm_gu(const Ptrs& P, LAS unsigned char* lds) {
    g8::Geo g{1024, 1024, 128, 128, 0};
    g8::SchedMoe S{(const char*)WSP(unsigned char, WS_X1Q), (const char*)WSP(unsigned char, WS_WGU), WSP(int, WS_EOFF), WSP(int, WS_ROWTOK), 1024, 2, 8, (size_t)512 * 1024, 1024, 1, WSP(int, WS_TILEE)};
    g8::EpiGU E{WSP(bf16_t, WS_H), WSP(float, WS_ROWW), WSP(int, WS_EOFF)};
    g8::gemm_body<g8::EpiGU, g8::SchedMoe, true, 1>(lds, g, S, E);
}
__device__ __forceinline__ void fp_gemm_down(const Ptrs& P, LAS unsigned char* lds) {
    g8::Geo g{512, 512, 128, 128, 0};
    g8::SchedMoe S{(const char*)WSP(bf16_t, WS_H), (const char*)WSP(bf16_t, WS_WD), WSP(int, WS_EOFF), WSP(int, WS_ROWTOK), 512, 4, 4, (size_t)1024 * 512, 512, 0, WSP(int, WS_TILEE)};
    g8::EpiDown E{WSP(unsigned char, WS_YSLOT), P.out, WSP(bf16_t, WS_X1), WSP(int, WS_ROWTOK), WSP(int, WS_EOFF), lds + LDS_XTRA};
    g8::gemm_body<g8::EpiDown, g8::SchedMoe, false>(lds, g, S, E);
}
namespace at8 {
typedef short s16x4 __attribute__((ext_vector_type(4)));
typedef short v4i16_t __attribute__((ext_vector_type(4)));
constexpr int KSLOT = 12288, VSLOT = 8192, NSLOT = 3;
constexpr int L_K = 0, L_V = NSLOT * KSLOT, L_WS = L_V + NSLOT * VSLOT, L_OST = L_WS + 8 * 256, L_END = L_OST + 8 * 4096;
__device__ __forceinline__ int crow(int r, int hi) { return (r & 3) + 8 * (r >> 2) + 4 * hi; }
__device__ __forceinline__ void glds16(const void* gsrc, LAS unsigned char* dst) { __builtin_amdgcn_global_load_lds((const unsigned*)gsrc, (LAS unsigned*)dst, 16, 0, 0); }
__device__ __forceinline__ s16x4 vtr(const LAS unsigned char* p) { return __builtin_bit_cast(s16x4, __builtin_amdgcn_ds_read_tr16_b64_v4i16((LAS v4i16_t*)p)); }
__device__ __forceinline__ unsigned cvtpk(float lo, float hi) { return (unsigned)f2bf(lo) | ((unsigned)f2bf(hi) << 16); }

__device__ __forceinline__ void attn_unit(int b, int h, int qb, const bf16_t* __restrict__ Q, const bf16_t* __restrict__ Kc, const bf16_t* __restrict__ V, bf16_t* __restrict__ AS, LAS unsigned char* lds) {
    const int tid = opaque_tid(), lane = tid & 63, r32 = lane & 31, hi = lane >> 5;
    const int wid = __builtin_amdgcn_readfirstlane(tid >> 6);
    const size_t bh = (size_t)b * NH + h;
    const bf16_t* Kbh = Kc + bh * SEQ * QKD; const bf16_t* Vbh = V + bh * SEQ * VD;
    const int q0 = qb * 256 + wid * 32;
    const int NT = 4 * (qb + 1);
    const int myNT = 4 * qb + (wid >> 1) + 1;
    const bf16_t* ksrc0 = Kbh + (size_t)lane * QKD + wid * 8;
    const bf16_t* ksrc1 = Kbh + (size_t)lane * QKD + (8 + (wid & 3)) * 8;
    const bf16_t* vsrc = Vbh + (size_t)(16 * (wid & 3) + (lane >> 2)) * VD + (wid >> 2) * 32 + (lane & 3) * 8;
#define AT_DMA(t, slot) do { glds16(ksrc0 + (size_t)(t) * 64 * QKD, lds + L_K + (slot) * KSLOT + wid * 1024); \
                             glds16(ksrc1 + (size_t)(t) * 64 * QKD, lds + L_K + (slot) * KSLOT + (8 + (wid & 3)) * 1024); \
                             glds16(vsrc + (size_t)(t) * 64 * VD, lds + L_V + (slot) * VSLOT + wid * 1024); } while (0)
    AT_DMA(0, 0);
    if (NT > 1) AT_DMA(1, 1);
    bf16x8 qr[6];
    const bf16_t* qp = Q + (bh * SEQ + q0 + r32) * QKD + hi * 8;
#pragma unroll
    for (int ks = 0; ks < 6; ++ks) qr[ks] = *(const bf16x8*)(qp + ks * 16);
    f32x16 o0, o1;
#pragma unroll
    for (int i = 0; i < 16; ++i) { o0[i] = 0.f; o1[i] = 0.f; }
    float m_run = -1e30f, l_run = 0.f;
    LAS float* wsf = (LAS float*)(lds + L_WS) + wid * 64;
    const LAS unsigned char* kp0 = lds + L_K + hi * 1024 + r32 * 16;
    const LAS unsigned char* vp0 = lds + L_V + ((lane >> 4) & 1) * 32 + (lane & 3) * 8 + (4 * hi + ((lane & 15) >> 2)) * 64;
    int slot = 0;
    for (int t = 0; t < NT; ++t) {
        if (t + 1 < NT) asm volatile("s_waitcnt vmcnt(3)" ::: "memory"); else asm volatile("s_waitcnt vmcnt(0)" ::: "memory");
        asm volatile("s_waitcnt lgkmcnt(0)\n\ts_barrier" ::: "memory");
        if (t + 2 < NT) { const int s2 = (slot == 0) ? 2 : slot - 1; AT_DMA(t + 2, s2); }
        if (t < myNT) {
            const LAS unsigned char* kp = kp0 + slot * KSLOT; const LAS unsigned char* vp = vp0 + slot * VSLOT;
            f32x16 p0, p1;
#pragma unroll
            for (int i = 0; i < 16; ++i) { p0[i] = 0.f; p1[i] = 0.f; }
#pragma unroll
            for (int ks = 0; ks < 6; ++ks) {
                const bf16x8 a0 = *(const LAS bf16x8*)(kp + ks * 2048), a1 = *(const LAS bf16x8*)(kp + ks * 2048 + 512);
                p0 = __builtin_amdgcn_mfma_f32_32x32x16_bf16(a0, qr[ks], p0, 0, 0, 0);
                p1 = __builtin_amdgcn_mfma_f32_32x32x16_bf16(a1, qr[ks], p1, 0, 0, 0);
            }
            float rm = fmaxf(p0[0], p1[0]);
#pragma unroll
            for (int i = 1; i < 16; ++i) rm = fmaxf(rm, fmaxf(p0[i], p1[i]));
            { auto rr = __builtin_amdgcn_permlane32_swap(__float_as_uint(rm), __float_as_uint(rm), false, false); rm = fmaxf(__uint_as_float(rr[0]), __uint_as_float(rr[1])); }
            if (__any(rm > m_run + 8.0f)) {
                const float m_new = fmaxf(m_run, rm);
                const float alpha = __builtin_amdgcn_exp2f(m_run - m_new);
                l_run *= alpha; m_run = m_new;
                if (hi == 0) wsf[r32] = alpha;
                asm volatile("s_waitcnt lgkmcnt(0)" ::: "memory");
#pragma unroll
                for (int i = 0; i < 16; ++i) { const float a = wsf[crow(i, hi)]; o0[i] *= a; o1[i] *= a; }
            }
            float ls = 0.f;
#pragma unroll
            for (int i = 0; i < 16; ++i) { p0[i] = __builtin_amdgcn_exp2f(p0[i] - m_run); p1[i] = __builtin_amdgcn_exp2f(p1[i] - m_run); ls += p0[i] + p1[i]; }
            l_run += ls;
            u32x4 w0, w1, w2, w3;
            w0 = (u32x4){cvtpk(p0[0], p0[1]), cvtpk(p0[2], p0[3]), cvtpk(p0[4], p0[5]), cvtpk(p0[6], p0[7])};
            w1 = (u32x4){cvtpk(p0[8], p0[9]), cvtpk(p0[10], p0[11]), cvtpk(p0[12], p0[13]), cvtpk(p0[14], p0[15])};
            w2 = (u32x4){cvtpk(p1[0], p1[1]), cvtpk(p1[2], p1[3]), cvtpk(p1[4], p1[5]), cvtpk(p1[6], p1[7])};
            w3 = (u32x4){cvtpk(p1[8], p1[9]), cvtpk(p1[10], p1[11]), cvtpk(p1[12], p1[13]), cvtpk(p1[14], p1[15])};
            const bf16x8 pa[4] = {__builtin_bit_cast(bf16x8, w0), __builtin_bit_cast(bf16x8, w1), __builtin_bit_cast(bf16x8, w2), __builtin_bit_cast(bf16x8, w3)};
#pragma unroll
            for (int k = 0; k < 4; ++k) {
                const s16x4 l0 = vtr(vp + k * 1024), h0 = vtr(vp + k * 1024 + 512), l1 = vtr(vp + 4096 + k * 1024), h1 = vtr(vp + 4096 + k * 1024 + 512);
                const bf16x8 v0 = (bf16x8){l0[0], l0[1], l0[2], l0[3], h0[0], h0[1], h0[2], h0[3]};
                const bf16x8 v1 = (bf16x8){l1[0], l1[1], l1[2], l1[3], h1[0], h1[1], h1[2], h1[3]};
                o0 = __builtin_amdgcn_mfma_f32_32x32x16_bf16(pa[k], v0, o0, 0, 0, 0);
                o1 = __builtin_amdgcn_mfma_f32_32x32x16_bf16(pa[k], v1, o1, 0, 0, 0);
            }
        }
        slot = (slot == 2) ? 0 : slot + 1;
    }
    { auto rr = __builtin_amdgcn_permlane32_swap(__float_as_uint(l_run), __float_as_uint(l_run), false, false); l_run = __uint_as_float(rr[0]) + __uint_as_float(rr[1]); }
    if (hi == 0) wsf[32 + r32] = l_run;
    asm volatile("s_waitcnt lgkmcnt(0)" ::: "memory");
    LAS bf16_t* stg = (LAS bf16_t*)(lds + L_OST) + wid * 2048;
#pragma unroll
    for (int i = 0; i < 16; ++i) { const int orow = crow(i, hi); const float rl = 1.0f / wsf[32 + orow];
        stg[orow * 64 + r32] = f2bf(o0[i] * rl); stg[orow * 64 + 32 + r32] = f2bf(o1[i] * rl); }
    asm volatile("s_waitcnt lgkmcnt(0)" ::: "memory");
    bf16_t* Ow = AS + ((size_t)b * SEQ + q0) * 1024 + h * 64;
#pragma unroll
    for (int i = 0; i < 4; ++i) { const int row = i * 8 + (lane >> 3), ch = lane & 7; const u32x4 v = *(const LAS u32x4*)(stg + row * 64 + ch * 8); *(u32x4*)(Ow + (size_t)row * 1024 + ch * 8) = v; }
    asm volatile("s_waitcnt lgkmcnt(0)\n\ts_barrier" ::: "memory");
#undef AT_DMA
}
__device__ __forceinline__ void attn_phase(const Ptrs& P, LAS unsigned char* lds, int bid, int nb) {
    const bf16_t* Q = WSP(bf16_t, WS_Q); const bf16_t* Kc = WSP(bf16_t, WS_K); const bf16_t* V = WSP(bf16_t, WS_V); bf16_t* AS = WSP(bf16_t, WS_AS);
    const int vcu = ((nb & 7) == 0) ? (bid & 7) * (nb >> 3) + (bid >> 3) : bid;
    for (int p = vcu; p < 512; p += nb) {
        const int bh = p >> 2, s = p & 3;
        attn_unit(bh >> 3, bh & 7, 7 - s, Q, Kc, V, AS, lds);
        attn_unit(bh >> 3, bh & 7, s, Q, Kc, V, AS, lds);
    }
}
}
__global__ void __launch_bounds__(NTHR, 2) mega(Args a) {
    extern __shared__ __attribute__((aligned(16))) unsigned char lds_raw[];
    LAS unsigned char* lds = (LAS unsigned char*)lds_raw;
    Ptrs P;
    P.x = (const float*)a.in[0]; P.positions = (const int*)a.in[1]; P.ln_in_g = (const float*)a.in[2]; P.ln_in_b = (const float*)a.in[3];
    P.w_in = (const float*)a.in[4]; P.q_norm_g = (const float*)a.in[5]; P.kv_norm_g = (const float*)a.in[6]; P.w_uq = (const float*)a.in[7]; P.w_ukv = (const float*)a.in[8];
    P.lambda_re = (const float*)a.in[9]; P.lambda_im = (const float*)a.in[10]; P.log_step = (const float*)a.in[11]; P.b_re = (const float*)a.in[12]; P.b_im = (const float*)a.in[13];
    P.c_re = (const float*)a.in[14]; P.c_im = (const float*)a.in[15]; P.d_skip = (const float*)a.in[16]; P.w_glu = (const float*)a.in[17]; P.b_glu = (const float*)a.in[18];
    P.attn_out_g = (const float*)a.in[19]; P.ssm_out_g = (const float*)a.in[20]; P.w_o = (const float*)a.in[21]; P.ln1_g = (const float*)a.in[22]; P.ln1_b = (const float*)a.in[23];
    P.w_router = (const float*)a.in[24]; P.router_bias = (const float*)a.in[25]; P.w_gate = (const float*)a.in[26]; P.w_up = (const float*)a.in[27]; P.w_down = (const float*)a.in[28];
    P.ws_gate = (const float*)a.in[29]; P.ws_up = (const float*)a.in[30]; P.ws_down = (const float*)a.in[31]; P.ln2_g = (const float*)a.in[32]; P.ln2_b = (const float*)a.in[33];
    P.out = a.out; P.ws = a.ws;
    const int bid = blockIdx.x, nb = gridDim.x;
    volatile LAS unsigned* misc = (volatile LAS unsigned*)(lds + LDS_MISC);
    if (threadIdx.x < 64) misc[threadIdx.x] = 0u;
    __syncthreads();
    XcdBarrier bar = xcd_barrier_post((unsigned*)(P.ws + WS_CTL) + 4096, misc);
#define GRID_BAR() xcd_barrier(bar)

    ph_ln_in(P, bid, nb); ph_wprep(P, lds, bid, nb); ph_s5tab1(P, bid, nb); ph_ropetab(P, bid, nb);
    GRID_BAR();
    ph_s5tab2(P, lds, bid, nb);
#if FAST_WIN
    fp_gemm_win(P, lds);
    GRID_BAR();
#else
    ph_gemm_win(P, bid, nb);
    GRID_BAR();
    ph_rstat(P, bid, nb);
    GRID_BAR();
#endif
#if FAST_QKV
    fp_gemm_q(P, lds); fp_gemm_kv(P, lds);
#else
    ph_gemm_q(P, bid, nb); ph_gemm_kv(P, bid, nb);
#endif
#if FAST_S5
    fp_gemm_s5b(P, lds); fp_gemm_s5a(P, lds);
#else
    ph_gemm_s5b(P, bid, nb); ph_gemm_s5a(P, bid, nb);
#endif
    GRID_BAR();
#if !FAST_QKV || !FAST_WIN
    ph_rope_apply(P, bid, nb);
#endif
    ph_s5scan(P, bid, nb);
#if !FAST_QKV || !FAST_WIN
    GRID_BAR();
#endif
#if FAST_ATTN
    at8::attn_phase(P, lds, bid, nb);
#else
    ph_attn_simple(P, lds, bid, nb);
#endif
    GRID_BAR();
#if FAST_S5
    fp_gemm_s5d(P, lds);
#else
    ph_gemm_s5d(P, bid, nb);
#endif
    GRID_BAR();
#if FAST_GLU
    fp_gemm_glu(P, lds);
#else
    ph_gemm_glu(P, bid, nb);
#endif
    GRID_BAR();
    ph_asnorm(P, bid, nb);
    GRID_BAR();
#if FAST_WO
    fp_gemm_wo(P, lds);
#else
    ph_gemm_wo(P, bid, nb);
#endif
    GRID_BAR();
    ph_ln1(P, bid, nb);
    GRID_BAR();
    fp_gemm_router(P, lds);
    GRID_BAR();
    ph_topk_cnt(P, lds, bid, nb);
    GRID_BAR();
    ph_lists2(P, lds, bid, nb);
    GRID_BAR();
#if FAST_MOE
    fp_gemm_gu(P, lds);
    GRID_BAR();
    fp_gemm_down(P, lds);
#else
    ph_gemm_gu(P, bid, nb);
    GRID_BAR();
    ph_gemm_down(P, bid, nb);
#endif
    GRID_BAR();
    ph_combine(P, bid, nb);
}

extern "C" void kernel_launch(void* const* d_in, const int* in_sizes, int n_in, void* d_out, int out_size, void* d_ws, size_t ws_size, hipStream_t stream) {
    (void)in_sizes; (void)out_size;
    if (ws_size < WS_NEED || n_in != 34) return;
    static int grid = 0;
    if (grid == 0) {
        int dev = 0, cus = 0;
        if (hipGetDevice(&dev) != hipSuccess || hipDeviceGetAttribute(&cus, hipDeviceAttributeMultiprocessorCount, dev) != hipSuccess) { grid = -1; return; }
        if (hipFuncSetAttribute((const void*)mega, hipFuncAttributeMaxDynamicSharedMemorySize, LDS_BYTES) != hipSuccess) { grid = -1; return; }
        int per_cu = 0;
        if (hipOccupancyMaxActiveBlocksPerMultiprocessor(&per_cu, (const void*)mega, NTHR, LDS_BYTES) != hipSuccess || per_cu < 1) { (void)hipGetLastError(); }
        grid = cus;
    }
    if (grid < 0) return;
    (void)hipMemsetAsync((char*)d_ws + WS_CTL, 0, 1 << 20, stream);
    Args a; memset(&a, 0, sizeof(a));
    for (int i = 0; i < 34; ++i) a.in[i] = d_in[i];
    a.out = (float*)d_out; a.ws = (unsigned char*)d_ws;
    hipLaunchKernelGGL(mega, dim3(grid), dim3(NTHR), LDS_BYTES, stream, a);
}
```

```cpp
#include <hip/hip_runtime.h>
#include <stdint.h>
#include <string.h>

typedef unsigned short bf16_t;
typedef short bf16x8 __attribute__((ext_vector_type(8)));
typedef float f32x16 __attribute__((ext_vector_type(16)));
typedef float f32x4 __attribute__((ext_vector_type(4)));
typedef unsigned u32x4 __attribute__((ext_vector_type(4)));
typedef unsigned u32x2 __attribute__((ext_vector_type(2)));
typedef float f32x2 __attribute__((ext_vector_type(2)));

#ifndef FAST_WIN
#define FAST_WIN 1
#endif
#ifndef FAST_QKV
#define FAST_QKV 1
#endif
#ifndef FAST_S5
#define FAST_S5 1
#endif
#ifndef FAST_GLU
#define FAST_GLU 1
#endif
#ifndef FAST_WO
#define FAST_WO 1
#endif
#ifndef FAST_ATTN
#define FAST_ATTN 1
#endif
#ifndef FAST_MOE
#define FAST_MOE 1
#endif
constexpr int T = 32768, D = 1024, SEQ = 2048, NB = 16;
constexpr int NH = 8, QKD = 96, VD = 64;
constexpr int QRANK = 256, KVRANK = 128, ROPE = 32;
constexpr int SSMW = 512, SG = 32, SC = 16, SP = 64, CH = 64, NCH = SEQ / CH;
constexpr int NE = 64, TOPK = 8, FF = 256;
constexpr float ALPHA = 1.189207115002721f;
constexpr float EPS = 1e-5f;
constexpr float QSCALE = 0.10206207261596577f * 1.4426950408889634f;
constexpr float SLOT_SCALE = 16.0f;
constexpr float XQ_SCALE = 16.0f, WQ_SCALE = 256.0f, HQ_SCALE = 8.0f;
constexpr int RROUT = 278528;
constexpr int SH_ROW0 = RROUT;
constexpr int RTOT = RROUT + T;

constexpr size_t MiB = 1ull << 20;
constexpr size_t WS_CTL = 0;
constexpr size_t WS_TOPI = 1 * MiB, WS_TOPW = 2 * MiB, WS_ROWTOK = 3 * MiB, WS_ROWW = 4 * MiB + MiB / 2;
constexpr size_t WS_CNT = 6 * MiB, WS_TOFF = 6 * MiB + 65536, WS_EOFF = 6 * MiB + 131072, WS_ECNT = 6 * MiB + 131072 + 1024;
constexpr size_t WS_TILEE = 6 * MiB + 262144;
constexpr size_t WS_WD = 7 * MiB;
constexpr size_t WS_X1 = 40 * MiB;
constexpr size_t WS_XN = WS_X1, WS_AS = WS_X1;
constexpr size_t WS_H = 104 * MiB;
constexpr size_t WS_CQ = 104 * MiB, WS_CKV = 120 * MiB, WS_U = 136 * MiB, WS_YINTRA = 168 * MiB, WS_Y = 200 * MiB;
constexpr size_t WS_QRRAW = 200 * MiB;
constexpr size_t WS_XLOC = 232 * MiB, WS_XPREV = 240 * MiB, WS_LOGITS = 248 * MiB, WS_KRRAW = 248 * MiB;
constexpr size_t WS_X1LO = 104 * MiB;
constexpr size_t WS_YSLOT = 256 * MiB;
constexpr size_t WS_WGU = 256 * MiB;
constexpr size_t WS_WIN = 321 * MiB, WS_WO = 323 * MiB, WS_WUQ = 325 * MiB, WS_WUKV = 325 * MiB + MiB / 2, WS_WGLU = 326 * MiB;
constexpr size_t WS_WR = 326 * MiB + MiB / 2;
constexpr size_t WS_BLOC = 327 * MiB, WS_CLAM = 343 * MiB, WS_KTAB = 359 * MiB, WS_LAMPOW = 361 * MiB, WS_BBAR = 363 * MiB;
constexpr size_t WS_ROPE = 364 * MiB, WS_XSTAT = 368 * MiB, WS_RSQ = 368 * MiB + MiB / 2, WS_RSKV = 369 * MiB;
constexpr size_t WS_Q = 370 * MiB, WS_K = 418 * MiB, WS_V = 466 * MiB;
constexpr size_t WS_LAMPOWT = 498 * MiB;
constexpr size_t WS_X1Q = 370 * MiB;
constexpr size_t WS_SHSLOT = 184 * MiB;
constexpr size_t WS_NEED = 512 * MiB;

__device__ __forceinline__ bf16_t f2bf(float f) { unsigned u = __float_as_uint(f); u += 0x7fffu + ((u >> 16) & 1u); return (bf16_t)(u >> 16); }
__device__ __forceinline__ float bf2f(bf16_t b) { return __uint_as_float(((unsigned)b) << 16); }
__device__ __forceinline__ int crow(int i, int h) { return (i & 3) + 8 * (i >> 2) + 4 * h; }
__device__ __forceinline__ float wave_sum(float v) {
#pragma unroll
    for (int o = 32; o > 0; o >>= 1) v += __shfl_xor(v, o);
    return v;
}
__device__ __forceinline__ float wave_max(float v) {
#pragma unroll
    for (int o = 32; o > 0; o >>= 1) v = fmaxf(v, __shfl_xor(v, o));
    return v;
}
__device__ __forceinline__ float sigmoidf_(float z) { return 1.0f / (1.0f + __expf(-z)); }
__device__ __forceinline__ float gelu_tanh(float y) {
    const float z = 0.7978845608028654f * (y + 0.044715f * y * y * y);
    const float th = 1.0f - 2.0f / (1.0f + __expf(2.0f * z));
    return 0.5f * y * (1.0f + th);
}
__host__ __device__ __forceinline__ int ropeperm(int q) { return 16 * ((q >> 2) & 1) + 4 * (q >> 3) + (q & 3); }
__host__ __device__ __forceinline__ int ropepos(int j) { const int n = j >> 4, r = j & 15; return 8 * (r >> 2) + 4 * n + (r & 3); }

__device__ __forceinline__ void cexp_d(double re, double im, double& ore, double& oim) {
    const double s = 1.0 / 1048576.0;
    const double a = re * s, b = im * s;
    double tr = 1.0, ti = 0.0, sr = 1.0, si = 0.0;
#pragma unroll
    for (int n = 1; n <= 8; ++n) {
        const double nr = (tr * a - ti * b) / n, ni = (tr * b + ti * a) / n;
        tr = nr; ti = ni; sr += tr; si += ti;
    }
#pragma unroll
    for (int i = 0; i < 20; ++i) { const double nr = sr * sr - si * si, ni = 2.0 * sr * si; sr = nr; si = ni; }
    ore = sr; oim = si;
}

__device__ __forceinline__ int opaque_tid() { int t = threadIdx.x; asm volatile("" : "+v"(t)); return t; }
template <bool DUAL, class AF, class BF, class EPI>
__device__ __forceinline__ void sg_tile(int m0, int n0, int K, AF arow, BF bptr, EPI epi) {
    const int tidx = opaque_tid();
    const int lane = tidx & 63, r = lane & 31, h = lane >> 5;
    f32x16 acc, acc2;
#pragma unroll
    for (int i = 0; i < 16; ++i) { acc[i] = 0.f; acc2[i] = 0.f; }
    const bf16_t* ap = arow(m0 + r);
    for (int k0 = 0; k0 < K; k0 += 16) {
        const bf16x8 a = *(const bf16x8*)(ap + k0 + 8 * h);
        const bf16x8 b = *(const bf16x8*)(bptr(n0 + r, k0 + 8 * h, 0));
        acc = __builtin_amdgcn_mfma_f32_32x32x16_bf16(a, b, acc, 0, 0, 0);
        if (DUAL) {
            const bf16x8 b2 = *(const bf16x8*)(bptr(n0 + r, k0 + 8 * h, 1));
            acc2 = __builtin_amdgcn_mfma_f32_32x32x16_bf16(a, b2, acc2, 0, 0, 0);
        }
    }
#pragma unroll
    for (int i = 0; i < 16; ++i) epi(m0 + crow(i, h), n0 + r, acc[i], acc2[i]);
}

#define LAS __attribute__((address_space(3)))
#define XB_TMO      128
#define XB_XCNT(j)  (256  + 64 * (j))
#define XB_XSUB(j)  (1280 + 64 * (j))
#define XB_XGEN(j)  (2304 + 64 * (j))
#define XB_TOP      3328
#define XB_TOPGEN   3392
#define XCD_BAR_WORDS 3456
#define XB_SPIN_CAP (1u << 18)
__device__ __forceinline__ unsigned xb_ld(unsigned* p)              { return __hip_atomic_load(p, __ATOMIC_RELAXED, __HIP_MEMORY_SCOPE_AGENT); }
__device__ __forceinline__ unsigned xb_add(unsigned* p, unsigned v) { return __hip_atomic_fetch_add(p, v, __ATOMIC_RELAXED, __HIP_MEMORY_SCOPE_AGENT); }
__device__ __forceinline__ unsigned xb_xcc_id() { return (unsigned)__builtin_amdgcn_s_getreg((3 << 11) | 20) & 0xFu; }
#define XB_SPIN(cond, bar) do { unsigned _sp = 0; while (cond) { __builtin_amdgcn_s_sleep(1); \
    if ((++_sp & 255u) == 0u) { if (xb_ld(&(bar)[XB_TMO])) break; if (_sp > XB_SPIN_CAP) { atomicAdd(&(bar)[XB_TMO], 1u); break; } } } } while (0)
struct XcdBarrier { unsigned* bar; unsigned x; volatile LAS unsigned* st; };
__device__ __forceinline__ XcdBarrier xcd_barrier_post(unsigned* bar, volatile LAS unsigned* st) {
    XcdBarrier b; b.bar = bar; b.x = xb_xcc_id(); b.st = st;
    if (threadIdx.x == 0) (void)xb_add(&bar[XB_XCNT(b.x)], 1u);
    return b;
}
__device__ __forceinline__ void xcd_barrier_complete(unsigned* bar, unsigned x, unsigned& nloc, unsigned& nx) {
    const unsigned G = gridDim.x * gridDim.y * gridDim.z;
    unsigned sum, cnt, mine, sp = 0u;
    for (;;) {
        sum = 0u; cnt = 0u; mine = 0u;
#pragma unroll
        for (unsigned j = 0; j < 16; ++j) { const unsigned c = xb_ld(&bar[XB_XCNT(j)]); sum += c; cnt += (c > 0u) ? 1u : 0u; mine = (j == x) ? c : mine; }
        if (sum == G) break;
        __builtin_amdgcn_s_sleep(1);
        if ((++sp & 255u) == 0u) { if (xb_ld(&bar[XB_TMO])) break; if (sp > XB_SPIN_CAP) { atomicAdd(&bar[XB_TMO], 1u); break; } }
    }
    nloc = mine > 0u ? mine : 1u; nx = cnt > 0u ? cnt : 1u;
}
__device__ __forceinline__ void xcd_barrier(const XcdBarrier& b) {
    asm volatile("s_waitcnt vmcnt(0)" ::: "memory");
    __syncthreads();
    if (threadIdx.x == 0) {
        unsigned* bar = b.bar;
        __builtin_amdgcn_s_waitcnt(0);
        unsigned nloc = b.st[0], nx = b.st[1];
        if (nloc == 0u) { xcd_barrier_complete(bar, b.x, nloc, nx); b.st[0] = nloc; b.st[1] = nx; }
        const unsigned old = xb_add(&bar[XB_XSUB(b.x)], 1u);
        const unsigned gen = old / nloc;
        if (old + 1u == (gen + 1u) * nloc) {
            __builtin_amdgcn_fence(__ATOMIC_RELEASE, "agent");
            asm volatile("s_waitcnt vmcnt(0)" ::: "memory");
            const unsigned og = xb_add(&bar[XB_TOP], 1u);
            const unsigned tg = og / nx;
            if (og + 1u == (tg + 1u) * nx) xb_add(&bar[XB_TOPGEN], 1u);
            else XB_SPIN(xb_ld(&bar[XB_TOPGEN]) == tg, bar);
            __builtin_amdgcn_fence(__ATOMIC_ACQUIRE, "agent");
            xb_add(&bar[XB_XGEN(b.x)], 1u);
            asm volatile("s_waitcnt vmcnt(0)" ::: "memory");
        } else {
            XB_SPIN(xb_ld(&bar[XB_XGEN(b.x)]) == gen, bar);
            __builtin_amdgcn_fence(__ATOMIC_ACQUIRE, "agent");
            asm volatile("s_waitcnt vmcnt(0)" ::: "memory");
        }
    }
    __syncthreads();
}

constexpr int NTHR = 512, NWAVE = 8;
constexpr int LDS_BYTES = 163840;
constexpr int LDS_MISC = 163840 - 256;
constexpr int LDS_XTRA = 131072;
struct Args { const void* in[34]; float* out; unsigned char* ws; };
struct Ptrs {
    const float *x, *ln_in_g, *ln_in_b, *w_in, *q_norm_g, *kv_norm_g, *w_uq, *w_ukv, *lambda_re, *lambda_im, *log_step, *b_re, *b_im, *c_re, *c_im, *d_skip, *w_glu, *b_glu;
    const float *attn_out_g, *ssm_out_g, *w_o, *ln1_g, *ln1_b, *w_router, *router_bias, *w_gate, *w_up, *w_down, *ws_gate, *ws_up, *ws_down, *ln2_g, *ln2_b;
    const int* positions; float* out; unsigned char* ws;
};
#define WSP(T_, off) ((T_*)(P.ws + (off)))

__device__ __forceinline__ void ph_ln_in(const Ptrs& P, int bid, int nb) {
    const int tidx = opaque_tid();
    const int lane = tidx & 63, w = tidx >> 6;
    bf16_t* xn = WSP(bf16_t, WS_XN); float* xstat = WSP(float, WS_XSTAT);
    for (int t0 = (bid * NWAVE + w) * 2; t0 < T; t0 += nb * NWAVE * 2) {
        f32x4 q[2][4];
#pragma unroll
        for (int r = 0; r < 2; ++r)
#pragma unroll
            for (int i = 0; i < 4; ++i) q[r][i] = *(const f32x4*)(P.x + (size_t)(t0 + r) * D + i * 256 + lane * 4);
#pragma unroll
        for (int r = 0; r < 2; ++r) {
            const int t = t0 + r;
            float s = 0.f;
#pragma unroll
            for (int i = 0; i < 4; ++i) s += q[r][i][0] + q[r][i][1] + q[r][i][2] + q[r][i][3];
            const float mu = wave_sum(s) * (1.0f / D);
            float ss = 0.f;
#pragma unroll
            for (int i = 0; i < 4; ++i)
#pragma unroll
                for (int e = 0; e < 4; ++e) { const float d = q[r][i][e] - mu; ss += d * d; }
            const float rstd = rsqrtf(wave_sum(ss) * (1.0f / D) + EPS);
            if (lane == 0) { xstat[2 * t] = mu; xstat[2 * t + 1] = rstd; }
#pragma unroll
            for (int i = 0; i < 4; ++i) {
                const int c = i * 256 + lane * 4;
                const f32x4 gg = *(const f32x4*)(P.ln_in_g + c), bb = *(const f32x4*)(P.ln_in_b + c);
                ushort4 o;
                o.x = f2bf((q[r][i][0] - mu) * rstd * gg[0] + bb[0]); o.y = f2bf((q[r][i][1] - mu) * rstd * gg[1] + bb[1]);
                o.z = f2bf((q[r][i][2] - mu) * rstd * gg[2] + bb[2]); o.w = f2bf((q[r][i][3] - mu) * rstd * gg[3] + bb[3]);
                *(ushort4*)(xn + (size_t)t * D + c) = o;
            }
        }
    }
}
__device__ __forceinline__ int wprep_srccol(int mode, int n, int& which) {
    which = 0;
    switch (mode) {
    case 0: if (n < 256) return n; if (n < 768) return 416 + (n - 256); if (n < 896) return 256 + (n - 768); if (n < 928) return 384 + ropeperm(n - 896); return -1;
    case 1: if (n < 512) return (n >> 6) * 96 + (n & 63); { const int m = n - 512; return (m >> 5) * 96 + 64 + ropeperm(m & 31); }
    case 2: if (n < 512) return (n >> 6) * 128 + (n & 63); { const int m = n - 512; return (m >> 6) * 128 + 64 + (m & 63); }
    case 5: { const int pn = n >> 8, w = n & 255; which = w >> 7; return pn * 128 + (w & 127); }
    case 7: return n < 64 ? n : -1;
    default: return n;
    }
}
__device__ __forceinline__ void wprep_tile(LAS float* tile  , const float* s1, const float* s2, const float* ks, const float* ks2, bf16_t* dst,
                                           int mode, int Kd, int ldsrc, int Ksrc, float kmul, int n0, int k0) {
    const int tidx = opaque_tid();
    const int nn = tidx & 63, w = tidx >> 6;
    {
        int which; const int sc = wprep_srccol(mode, n0 + nn, which);
        const float* s = which ? s2 : s1;
        float v[32];
#pragma unroll
        for (int i = 0; i < 32; ++i) { const int k = k0 + w + 8 * i; v[i] = (sc >= 0 && k < Ksrc) ? s[(size_t)k * ldsrc + sc] : 0.f; }
#pragma unroll
        for (int i = 0; i < 32; ++i) { const int kk = w + 8 * i, k = k0 + kk; float x = v[i];
            if (ks && k < Ksrc) x *= (ks2 && k >= 512) ? ks2[k - 512] : ks[k];
            tile[kk * 65 + nn] = x * kmul; }
    }
    __syncthreads();
#pragma unroll
    for (int i = 0; i < 4; ++i) {
        const int kb = (i * 8 + w) * 8;
        u32x4 o;
#pragma unroll
        for (int j = 0; j < 4; ++j) o[j] = (unsigned)f2bf(tile[(kb + 2 * j) * 65 + nn]) | ((unsigned)f2bf(tile[(kb + 2 * j + 1) * 65 + nn]) << 16);
        *(u32x4*)(dst + (size_t)(n0 + nn) * Kd + k0 + kb) = o;
    }
    __syncthreads();
}
__device__ __forceinline__ void wprep_tile_fp8(const float* s1, const float* s2, unsigned char* dst, int mode, int Kd, int ldsrc, float kmul, int n0, int k0) {
    const int tidx = opaque_tid();
    const int nn = tidx & 63, w = tidx >> 6;
    int which; const int sc = wprep_srccol(mode, n0 + nn, which);
    const float* s = which ? s2 : s1;
    float v[2][16];
#pragma unroll
    for (int i = 0; i < 2; ++i)
#pragma unroll
        for (int j = 0; j < 16; ++j) { const int k = k0 + (i * 8 + w) * 16 + j; v[i][j] = s[(size_t)k * ldsrc + sc] * kmul; }
#pragma unroll
    for (int i = 0; i < 2; ++i) {
        u32x4 o;
#pragma unroll
        for (int j = 0; j < 4; ++j) { int p = __builtin_amdgcn_cvt_pk_fp8_f32(v[i][4 * j], v[i][4 * j + 1], 0, false); p = __builtin_amdgcn_cvt_pk_fp8_f32(v[i][4 * j + 2], v[i][4 * j + 3], p, true); o[j] = (unsigned)p; }
        *(u32x4*)(dst + (size_t)(n0 + nn) * Kd + k0 + (i * 8 + w) * 16) = o;
    }
}
__device__ __forceinline__ void ph_wprep(const Ptrs& P, LAS unsigned char* lds, int bid, int nb) {
    LAS float* tile = (LAS float*)lds;
    constexpr int J0 = 64, J1 = J0 + 12, J2 = J1 + 16, J3 = J2 + 16, J4 = J3 + 64, J4b = J4 + 16, J5 = J4b + 65 * 32, J6 = J5 + 65 * 16;
    for (int j = bid; j < J6; j += nb) {
        if (j < J0)      { const int tl = j;      wprep_tile(tile, P.w_in, nullptr, nullptr, nullptr, WSP(bf16_t, WS_WIN), 0, 1024, 928, 1024, 1.0f, (tl / 4) * 64, (tl % 4) * 256); }
        else if (j < J1) { const int tl = j - J0; wprep_tile(tile, P.w_uq, nullptr, P.q_norm_g, nullptr, WSP(bf16_t, WS_WUQ), 1, 256, 768, 256, QSCALE, tl * 64, 0); }
        else if (j < J2) { const int tl = j - J1; wprep_tile(tile, P.w_ukv, nullptr, P.kv_norm_g, nullptr, WSP(bf16_t, WS_WUKV), 2, 256, 1024, 128, 1.0f, tl * 64, 0); }
        else if (j < J3) { const int tl = j - J2; wprep_tile(tile, P.w_glu, nullptr, nullptr, nullptr, WSP(bf16_t, WS_WGLU), 3, 512, 512, 512, 1.0f, (tl / 2) * 64, (tl % 2) * 256); }
        else if (j < J4) { const int tl = j - J3; wprep_tile(tile, P.w_o, nullptr, P.attn_out_g, P.ssm_out_g, WSP(bf16_t, WS_WO), 4, 1024, 1024, 1024, 1.0f, (tl / 4) * 64, (tl % 4) * 256); }
        else if (j < J4b) { const int tl = j - J4; wprep_tile(tile, P.w_router, nullptr, nullptr, nullptr, WSP(bf16_t, WS_WR), 7, 1024, 64, 1024, 1.0f, (tl / 4) * 64, (tl % 4) * 256); }
        else if (j < J5) { const int q = j - J4b, e = q / 32, tl = q % 32;
            const float* g = e < 64 ? P.w_gate + (size_t)e * 1024 * 256 : P.ws_gate; const float* u = e < 64 ? P.w_up + (size_t)e * 1024 * 256 : P.ws_up;
            wprep_tile_fp8(g, u, WSP(unsigned char, WS_WGU) + (size_t)e * 512 * 1024, 5, 1024, 256, WQ_SCALE, (tl / 4) * 64, (tl % 4) * 256); }
        else             { const int q = j - J5, e = q / 16, tl = q % 16;
            const float* d = e < 64 ? P.w_down + (size_t)e * 256 * 1024 : P.ws_down;
            wprep_tile_fp8(d, nullptr, WSP(unsigned char, WS_WD) + (size_t)e * 1024 * 256, 6, 256, 1024, WQ_SCALE, tl * 64, 0); }
    }
}
__device__ __forceinline__ void ph_s5tab1(const Ptrs& P, int bid, int nb) {
    const int tidx = opaque_tid();
    float2* lampow = WSP(float2, WS_LAMPOW); float2* lampow_t = WSP(float2, WS_LAMPOWT); float2* bbar = WSP(float2, WS_BBAR);
    for (int i = bid * NTHR + tidx; i < SG * SP * 65 + SG * SP * SC; i += nb * NTHR) {
        const bool isb = i >= SG * SP * 65;
        const int q = isb ? i - SG * SP * 65 : i;
        const int gp = isb ? q >> 4 : q / 65, tau = isb ? 1 : q % 65, g = gp >> 6, p = gp & 63;
        double lr = (double)P.lambda_re[gp]; if (lr > -1e-4) lr = -1e-4;
        const double li = (double)P.lambda_im[gp];
        double st, dummy; cexp_d((double)P.log_step[g], 0.0, st, dummy);
        double br, bi; cexp_d(lr * st * tau, li * st * tau, br, bi);
        if (!isb) {
            const float2 v = make_float2((float)br, (float)bi);
            lampow[gp * 65 + tau] = v; lampow_t[(g * 65 + tau) * 64 + p] = v;
        } else {
            const int c = q & 15;
            const double nr = br - 1.0, ni = bi, den = lr * lr + li * li;
            const double cr = (nr * lr + ni * li) / den, ci = (ni * lr - nr * li) / den;
            const double xr = (double)P.b_re[gp * SC + c], xi = (double)P.b_im[gp * SC + c];
            bbar[gp * SC + c] = make_float2((float)(cr * xr - ci * xi), (float)(cr * xi + ci * xr));
        }
    }
}
__device__ __forceinline__ void ph_s5tab2(const Ptrs& P, LAS unsigned char* lds, int bid, int nb) {
    const int tidx = opaque_tid();
    const float2* lampow = WSP(float2, WS_LAMPOW); const float2* lampow_t = WSP(float2, WS_LAMPOWT); const float2* bbar = WSP(float2, WS_BBAR);
    bf16_t* ktab = WSP(bf16_t, WS_KTAB); bf16_t* bloc = WSP(bf16_t, WS_BLOC); bf16_t* clam = WSP(bf16_t, WS_CLAM);
    const int lane = tidx & 63, w = tidx >> 6;
    LAS f32x2* Cs = (LAS f32x2*)lds;
    LAS f32x2* Bs = Cs + 1024;
    LAS f32x2* Ls = Bs + 1024;
    for (int un = bid; un < SG * 8; un += nb) {
        const int g = un >> 3, tb = (un & 7) * 8;
        __syncthreads();
        for (int i = tidx; i < 1024; i += NTHR) { const int c = i >> 6, p = i & 63; Cs[i] = (f32x2){P.c_re[(g * SC + c) * SP + p], P.c_im[(g * SC + c) * SP + p]}; { const float2 bq = bbar[g * 1024 + i]; Bs[i] = (f32x2){bq.x, bq.y}; } }
        { const int tl = tidx >> 6, p = tidx & 63; { const float2 lq = lampow_t[(g * 65 + tb + tl) * 64 + p]; Ls[tidx] = (f32x2){lq.x, lq.y}; } }
        __syncthreads();
        const int tl = tidx >> 6, c = (tidx >> 2) & 15, c0 = (tidx & 3) * 4;
        float a0 = 0.f, a1 = 0.f, a2 = 0.f, a3 = 0.f;
        for (int p = 0; p < SP; ++p) {
            const f32x2 l = Ls[tl * 64 + p], cc = Cs[c * 64 + p];
            const float kr = cc.x * l.x - cc.y * l.y, ki = cc.x * l.y + cc.y * l.x;
            const f32x2 b0 = Bs[p * 16 + c0], b1 = Bs[p * 16 + c0 + 1], b2 = Bs[p * 16 + c0 + 2], b3 = Bs[p * 16 + c0 + 3];
            a0 += kr * b0.x - ki * b0.y; a1 += kr * b1.x - ki * b1.y; a2 += kr * b2.x - ki * b2.y; a3 += kr * b3.x - ki * b3.y;
        }
        const int tau = tb + tl;
        if (tau == 0) { const float dsk = P.d_skip[g * SC + c]; if (c == c0) a0 += dsk; if (c == c0 + 1) a1 += dsk; if (c == c0 + 2) a2 += dsk; if (c == c0 + 3) a3 += dsk; }
        ushort4 o; o.x = f2bf(a0); o.y = f2bf(a1); o.z = f2bf(a2); o.w = f2bf(a3);
        *(ushort4*)(ktab + (((size_t)g * 127 + 63 + tau) * 16 + c) * 16 + c0) = o;
    }
    for (int i = bid * NTHR + tidx; i < SG * 63 * 32; i += nb * NTHR) { const int g = i / (63 * 32), r = i % (63 * 32); *(u32x4*)(ktab + (size_t)g * 127 * 256 + (size_t)r * 8) = (u32x4){0u, 0u, 0u, 0u}; }
    for (int row = bid * NWAVE + w; row < SG * 256; row += nb * NWAVE) {
        const int g = row >> 8, n = row & 255;
        u32x4 o0 = (u32x4){0u, 0u, 0u, 0u}, o1 = o0;
        if (n < 128) {
            const int p = n & 63;
            const float2 l = lampow[(g * SP + p) * 65 + (63 - lane)];
            float v[16];
#pragma unroll
            for (int c = 0; c < 16; ++c) { const float2 bb = bbar[(g * SP + p) * SC + c]; v[c] = (n < 64) ? (l.x * bb.x - l.y * bb.y) : (l.x * bb.y + l.y * bb.x); }
#pragma unroll
            for (int j = 0; j < 4; ++j) { o0[j] = (unsigned)f2bf(v[2 * j]) | ((unsigned)f2bf(v[2 * j + 1]) << 16); o1[j] = (unsigned)f2bf(v[8 + 2 * j]) | ((unsigned)f2bf(v[9 + 2 * j]) << 16); }
        }
        bf16_t* d = bloc + (size_t)row * 1024 + lane * 16;
        *(u32x4*)d = o0; *(u32x4*)(d + 8) = o1;
    }
    for (int row = bid * NWAVE + w; row < SG * 1024; row += nb * NWAVE) {
        const int g = row >> 10, n = row & 1023, t = n >> 4, c = n & 15;
        ushort4 o; o.x = 0; o.y = 0; o.z = 0; o.w = 0;
        if (lane < 32) {
            const int p0 = (lane & 15) * 4;
            const f32x4 cr = *(const f32x4*)(P.c_re + (g * SC + c) * SP + p0), ci = *(const f32x4*)(P.c_im + (g * SC + c) * SP + p0);
            const float2* lp = lampow_t + (g * 65 + t + 1) * 64 + p0;
            float v[4];
#pragma unroll
            for (int j = 0; j < 4; ++j) { const float2 l = lp[j]; v[j] = (lane < 16) ? (cr[j] * l.x - ci[j] * l.y) : -(cr[j] * l.y + ci[j] * l.x); }
            o.x = f2bf(v[0]); o.y = f2bf(v[1]); o.z = f2bf(v[2]); o.w = f2bf(v[3]);
        }
        *(ushort4*)(clam + (size_t)row * 256 + lane * 4) = o;
    }
}
__device__ __forceinline__ void ph_ropetab(const Ptrs& P, int bid, int nb) {
    const int tidx = opaque_tid();
    float2* rope = WSP(float2, WS_ROPE);
    const double invf[16] = {0.15915494309189535, 0.08949940160889101, 0.050329212104487035, 0.0283021958306234, 0.015915494309189534, 0.008949940160889102, 0.005032921210448704, 0.00283021958306234,
                             0.0015915494309189536, 0.0008949940160889102, 0.0005032921210448703, 0.00028302195830623395, 0.00015915494309189535, 8.949940160889102e-05, 5.0329212104487035e-05, 2.8302195830623396e-05};
    for (int t = bid * NTHR + tidx; t < T; t += nb * NTHR) {
        const double p = (double)P.positions[t];
#pragma unroll
        for (int j = 0; j < 16; ++j) {
            const double rev = p * invf[j];
            const float fr = (float)(rev - __builtin_rint(rev));
            rope[t * 16 + j] = make_float2(__builtin_amdgcn_cosf(fr), __builtin_amdgcn_sinf(fr));
        }
    }
}

#define GW_LOOP(ntiles) for (int tl = bid * NWAVE + (tidx >> 6); tl < (ntiles); tl += nb * NWAVE)
__device__ __forceinline__ void ph_gemm_win(const Ptrs& P, int bid, int nb) {
    const int tidx = opaque_tid();
    const bf16_t* xn = WSP(bf16_t, WS_XN); const bf16_t* wt = WSP(bf16_t, WS_WIN);
    bf16_t* cq = WSP(bf16_t, WS_CQ); bf16_t* ckv = WSP(bf16_t, WS_CKV); bf16_t* u = WSP(bf16_t, WS_U); float* krraw = WSP(float, WS_KRRAW);
    GW_LOOP((T / 32) * 32) {
        const int m0 = (tl >> 5) * 32, n0 = (tl & 31) * 32;
        sg_tile<false>(m0, n0, D,
            [&](int row) { return xn + (size_t)row * D; },
            [&](int n, int k, int) { return wt + (size_t)n * D + k; },
            [&](int t, int n, float v, float) {
                if (n < 256) cq[(size_t)t * 256 + n] = f2bf(v);
                else if (n < 768) {
                    const int ch = n - 256, g = ch >> 4, c = ch & 15, b = t >> 11, s = t & 2047, j = s >> 6, sl = s & 63;
                    u[((size_t)g * 512 + b * 32 + j) * 1024 + sl * 16 + c] = f2bf(v);
                } else if (n < 896) ckv[(size_t)t * 256 + (n - 768)] = f2bf(v);
                else {
                    ckv[(size_t)t * 256 + (n - 768)] = 0;
                    if (n < 928) krraw[(size_t)t * 32 + ropeperm(n - 896)] = v;
                }
            });
    }
}
__device__ __forceinline__ void ph_rstat(const Ptrs& P, int bid, int nb) {
    const int tidx = opaque_tid();
    const bf16_t* cq = WSP(bf16_t, WS_CQ); const bf16_t* ckv = WSP(bf16_t, WS_CKV); float* rsq = WSP(float, WS_RSQ); float* rskv = WSP(float, WS_RSKV);
    const int lane = tidx & 63, w = tidx >> 6;
    for (int t = bid * NWAVE + w; t < T; t += nb * NWAVE) {
        float s = 0.f, s2 = 0.f;
#pragma unroll
        for (int i = 0; i < 4; ++i) { const float v = bf2f(cq[(size_t)t * 256 + i * 64 + lane]); s += v * v; }
#pragma unroll
        for (int i = 0; i < 2; ++i) { const float v = bf2f(ckv[(size_t)t * 256 + i * 64 + lane]); s2 += v * v; }
        s = wave_sum(s); s2 = wave_sum(s2);
        if (lane == 0) { rsq[t] = rsqrtf(s * (1.0f / 256) + EPS); rskv[t] = rsqrtf(s2 * (1.0f / 128) + EPS); }
    }
}
__device__ __forceinline__ void ph_gemm_q(const Ptrs& P, int bid, int nb) {
    const int tidx = opaque_tid();
    const bf16_t* cq = WSP(bf16_t, WS_CQ); const bf16_t* wt = WSP(bf16_t, WS_WUQ); const float* rsq = WSP(float, WS_RSQ); bf16_t* Q = WSP(bf16_t, WS_Q); float* qrraw = WSP(float, WS_QRRAW);
    GW_LOOP((T / 32) * 24) {
        const int m0 = (tl / 24) * 32, n0 = (tl % 24) * 32;
        sg_tile<false>(m0, n0, 256,
            [&](int row) { return cq + (size_t)row * 256; },
            [&](int n, int k, int) { return wt + (size_t)n * 256 + k; },
            [&](int t, int n, float v, float) {
                v *= rsq[t];
                const int b = t >> 11, s = t & 2047;
                if (n < 512) Q[(((size_t)b * NH + (n >> 6)) * SEQ + s) * QKD + (n & 63)] = f2bf(v);
                else { const int m = n - 512; qrraw[(size_t)t * 256 + (m >> 5) * 32 + ropeperm(m & 31)] = v; }
            });
    }
}
__device__ __forceinline__ void ph_gemm_kv(const Ptrs& P, int bid, int nb) {
    const int tidx = opaque_tid();
    const bf16_t* ckv = WSP(bf16_t, WS_CKV); const bf16_t* wt = WSP(bf16_t, WS_WUKV); const float* rskv = WSP(float, WS_RSKV); bf16_t* Kc = WSP(bf16_t, WS_K); bf16_t* V = WSP(bf16_t, WS_V);
    GW_LOOP((T / 32) * 32) {
        const int m0 = (tl >> 5) * 32, n0 = (tl & 31) * 32;
        sg_tile<false>(m0, n0, 256,
            [&](int row) { return ckv + (size_t)row * 256; },
            [&](int n, int k, int) { return wt + (size_t)n * 256 + k; },
            [&](int t, int n, float v, float) {
                v *= rskv[t];
                const int b = t >> 11, s = t & 2047;
                if (n < 512) Kc[(((size_t)b * NH + (n >> 6)) * SEQ + s) * QKD + (n & 63)] = f2bf(v);
                else { const int m = n - 512; V[(((size_t)b * NH + (m >> 6)) * SEQ + s) * VD + (m & 63)] = f2bf(v); }
            });
    }
}
__device__ __forceinline__ void ph_rope_apply(const Ptrs& P, int bid, int nb) {
    const int tidx = opaque_tid();
    const float* qrraw = WSP(float, WS_QRRAW); const float* krraw = WSP(float, WS_KRRAW); const float2* rope = WSP(float2, WS_ROPE); bf16_t* Q = WSP(bf16_t, WS_Q); bf16_t* Kc = WSP(bf16_t, WS_K);
    for (int i = bid * NTHR + tidx; i < T * 9 * 16; i += nb * NTHR) {
        const int j = i & 15, hh = (i >> 4) % 9, t = (i >> 4) / 9;
        const float2 cs = rope[t * 16 + j];
        const int b = t >> 11, s = t & 2047;
        if (hh < 8) {
            const float x1 = qrraw[(size_t)t * 256 + hh * 32 + j], x2 = qrraw[(size_t)t * 256 + hh * 32 + 16 + j];
            bf16_t* q = Q + (((size_t)b * NH + hh) * SEQ + s) * QKD + 64;
            q[j] = f2bf(x1 * cs.x - x2 * cs.y); q[16 + j] = f2bf(x2 * cs.x + x1 * cs.y);
        } else {
            const float x1 = krraw[(size_t)t * 32 + j], x2 = krraw[(size_t)t * 32 + 16 + j];
            const bf16_t o1 = f2bf(x1 * cs.x - x2 * cs.y), o2 = f2bf(x2 * cs.x + x1 * cs.y);
            for (int h = 0; h < NH; ++h) { bf16_t* k = Kc + (((size_t)b * NH + h) * SEQ + s) * QKD + 64; k[j] = o1; k[16 + j] = o2; }
        }
    }
}
__device__ __forceinline__ void ph_gemm_s5b(const Ptrs& P, int bid, int nb) {
    const int tidx = opaque_tid();
    const bf16_t* u = WSP(bf16_t, WS_U); const bf16_t* bloc = WSP(bf16_t, WS_BLOC); float* xloc = WSP(float, WS_XLOC);
    GW_LOOP(SG * 16 * 4) {
        const int g = tl >> 6, m0 = ((tl >> 2) & 15) * 32, n0 = (tl & 3) * 32;
        sg_tile<false>(m0, n0, 1024,
            [&](int row) { return u + ((size_t)g * 512 + row) * 1024; },
            [&](int n, int k, int) { return bloc + ((size_t)g * 256 + n) * 1024 + k; },
            [&](int row, int n, float v, float) { xloc[((size_t)g * 512 + row) * 128 + n] = v; });
    }
}
__device__ __forceinline__ void ph_gemm_s5a(const Ptrs& P, int bid, int nb) {
    const int tidx = opaque_tid();
    const bf16_t* u = WSP(bf16_t, WS_U); const bf16_t* ktab = WSP(bf16_t, WS_KTAB); bf16_t* yintra = WSP(bf16_t, WS_YINTRA);
    GW_LOOP(SG * 16 * 32) {
        const int g = tl >> 9, m0 = ((tl >> 5) & 15) * 32, n0 = (tl & 31) * 32;
        sg_tile<false>(m0, n0, 1024,
            [&](int row) { return u + ((size_t)g * 512 + row) * 1024; },
            [&](int n, int k, int) { const int t = n >> 4, c = n & 15, s = k >> 4, c0 = k & 15; return ktab + (((size_t)g * 127 + (t - s + 63)) * 16 + c) * 16 + c0; },
            [&](int row, int n, float v, float) {
                const int b = row >> 5, j = row & 31, t = n >> 4, c = n & 15;
                yintra[((size_t)b * SEQ + j * CH + t) * SSMW + g * SC + c] = f2bf(v);
            });
    }
}
__device__ __forceinline__ void ph_attn_simple(const Ptrs& P, LAS unsigned char* lds, int bid, int nb) {
    const int tidx = opaque_tid();
    const bf16_t* Q = WSP(bf16_t, WS_Q); const bf16_t* Kc = WSP(bf16_t, WS_K); const bf16_t* V = WSP(bf16_t, WS_V); bf16_t* AS = WSP(bf16_t, WS_AS);
    const int lane = tidx & 63, w = tidx >> 6;
    LAS float* qs = (LAS float*)lds + w * (QKD + SEQ);
    LAS float* ps = qs + QKD;
    for (int row = bid * NWAVE + w; row < T * NH; row += nb * NWAVE) {
        const int bh = row >> 11, q = row & 2047, b = bh >> 3, h = bh & 7;
        asm volatile("s_waitcnt lgkmcnt(0)" ::: "memory");
        qs[lane] = bf2f(Q[(size_t)row * QKD + lane]);
        if (lane < 32) qs[64 + lane] = bf2f(Q[(size_t)row * QKD + 64 + lane]);
        asm volatile("s_waitcnt lgkmcnt(0)" ::: "memory");
        const int nk = ((q >> 6) + 1) * 64;
        float m = -INFINITY;
        for (int kb = 0; kb < nk; kb += 64) {
            const bf16_t* kp = Kc + ((size_t)bh * SEQ + kb + lane) * QKD;
            float s = 0.f;
#pragma unroll
            for (int c = 0; c < 12; ++c) {
                const bf16x8 kv = *(const bf16x8*)(kp + c * 8);
#pragma unroll
                for (int e = 0; e < 8; ++e) s += qs[c * 8 + e] * bf2f((bf16_t)kv[e]);
            }
            ps[kb + lane] = s; m = fmaxf(m, s);
        }
        m = wave_max(m);
        float l = 0.f;
        for (int kb = 0; kb < nk; kb += 64) { const float p = exp2f(ps[kb + lane] - m); ps[kb + lane] = p; l += p; }
        l = wave_sum(l);
        asm volatile("s_waitcnt lgkmcnt(0)" ::: "memory");
        float o = 0.f;
        const bf16_t* vp = V + (size_t)bh * SEQ * VD + lane;
        for (int k = 0; k < nk; ++k) o += ps[k] * bf2f(vp[(size_t)k * VD]);
        AS[((size_t)b * SEQ + q) * 1024 + h * 64 + lane] = f2bf(o / l);
    }
}
__device__ __forceinline__ void ph_s5scan(const Ptrs& P, int bid, int nb) {
    const int tidx = opaque_tid();
    const float* xloc = WSP(float, WS_XLOC); const float2* lampow = WSP(float2, WS_LAMPOW); bf16_t* xprev = WSP(bf16_t, WS_XPREV);
    for (int i = bid * NTHR + tidx; i < SG * NB * SP; i += nb * NTHR) {
        const int p = i & 63, b = (i >> 6) & 15, g = i >> 10;
        const float2 l64 = lampow[(g * SP + p) * 65 + 64];
        float xr = 0.f, xi = 0.f;
#pragma unroll
        for (int j = 0; j < NCH; ++j) {
            const size_t row = (size_t)g * 512 + b * 32 + j;
            bf16_t* xp = xprev + row * 256;
            xp[p] = f2bf(xr); xp[64 + p] = f2bf(xi); xp[128 + p] = 0; xp[192 + p] = 0;
            const float lr = xloc[row * 128 + p], li = xloc[row * 128 + 64 + p];
            const float nr = l64.x * xr - l64.y * xi + lr, ni = l64.x * xi + l64.y * xr + li;
            xr = nr; xi = ni;
        }
    }
}
__device__ __forceinline__ void ph_gemm_s5d(const Ptrs& P, int bid, int nb) {
    const int tidx = opaque_tid();
    const bf16_t* xprev = WSP(bf16_t, WS_XPREV); const bf16_t* clam = WSP(bf16_t, WS_CLAM); const bf16_t* yintra = WSP(bf16_t, WS_YINTRA); bf16_t* Y = WSP(bf16_t, WS_Y);
    GW_LOOP(SG * 16 * 32) {
        const int g = tl >> 9, m0 = ((tl >> 5) & 15) * 32, n0 = (tl & 31) * 32;
        sg_tile<false>(m0, n0, 256,
            [&](int row) { return xprev + ((size_t)g * 512 + row) * 256; },
            [&](int n, int k, int) { return clam + ((size_t)g * 1024 + n) * 256 + k; },
            [&](int row, int n, float v, float) {
                const int b = row >> 5, j = row & 31, t = n >> 4, c = n & 15;
                const size_t o = ((size_t)b * SEQ + j * CH + t) * SSMW + g * SC + c;
                Y[o] = f2bf(gelu_tanh(v + bf2f(yintra[o])));
            });
    }
}
__device__ __forceinline__ void ph_gemm_glu(const Ptrs& P, int bid, int nb) {
    const int tidx = opaque_tid();
    const bf16_t* Y = WSP(bf16_t, WS_Y); const bf16_t* wt = WSP(bf16_t, WS_WGLU); bf16_t* AS = WSP(bf16_t, WS_AS);
    GW_LOOP((T / 32) * 16) {
        const int m0 = (tl >> 4) * 32, n0 = (tl & 15) * 32;
        sg_tile<false>(m0, n0, 512,
            [&](int row) { return Y + (size_t)row * 512; },
            [&](int n, int k, int) { return wt + (size_t)n * 512 + k; },
            [&](int t, int n, float v, float) {
                const float yv = bf2f(Y[(size_t)t * 512 + n]);
                AS[(size_t)t * 1024 + 512 + n] = f2bf(yv * sigmoidf_(v + P.b_glu[n]));
            });
    }
}
__device__ __forceinline__ void ph_asnorm(const Ptrs& P, int bid, int nb) {
    const int tidx = opaque_tid();
    bf16_t* AS = WSP(bf16_t, WS_AS);
    const int lane = tidx & 63, w = tidx >> 6;
    for (int t = bid * NWAVE + w; t < T; t += nb * NWAVE) {
        bf16_t* r = AS + (size_t)t * 1024;
        float va[8], vs[8]; float sa = 0.f, ss = 0.f;
        const bf16x8 a = *(const bf16x8*)(r + lane * 8), s = *(const bf16x8*)(r + 512 + lane * 8);
#pragma unroll
        for (int i = 0; i < 8; ++i) { va[i] = bf2f((bf16_t)a[i]); vs[i] = bf2f((bf16_t)s[i]); sa += va[i] * va[i]; ss += vs[i] * vs[i]; }
        const float ra = rsqrtf(wave_sum(sa) * (1.0f / 512) + EPS), rs = rsqrtf(wave_sum(ss) * (1.0f / 512) + EPS);
        bf16x8 oa, os;
#pragma unroll
        for (int i = 0; i < 8; ++i) { oa[i] = (short)f2bf(va[i] * ra); os[i] = (short)f2bf(vs[i] * rs); }
        *(bf16x8*)(r + lane * 8) = oa; *(bf16x8*)(r + 512 + lane * 8) = os;
    }
}
__device__ __forceinline__ void ph_gemm_wo(const Ptrs& P, int bid, int nb) {
    const int tidx = opaque_tid();
    const bf16_t* AS = WSP(bf16_t, WS_AS); const bf16_t* wt = WSP(bf16_t, WS_WO); const float* xstat = WSP(float, WS_XSTAT); float* pre1 = P.out;
    GW_LOOP((T / 32) * 32) {
        const int m0 = (tl >> 5) * 32, n0 = (tl & 31) * 32;
        sg_tile<false>(m0, n0, 1024,
            [&](int row) { return AS + (size_t)row * 1024; },
            [&](int n, int k, int) { return wt + (size_t)n * 1024 + k; },
            [&](int t, int n, float v, float) {
                const float xn = (P.x[(size_t)t * D + n] - xstat[2 * t]) * xstat[2 * t + 1] * P.ln_in_g[n] + P.ln_in_b[n];
                pre1[(size_t)t * D + n] = v + ALPHA * xn;
            });
    }
}
__device__ __forceinline__ void ph_ln1(const Ptrs& P, int bid, int nb) {
    const int tidx = opaque_tid();
    const float* pre1 = P.out; bf16_t* x1 = WSP(bf16_t, WS_X1); bf16_t* x1lo = WSP(bf16_t, WS_X1LO);
    const int lane = tidx & 63, w = tidx >> 6;
    for (int t = bid * NWAVE + w; t < T; t += nb * NWAVE) {
        const float* xr = pre1 + (size_t)t * D;
        float v[16]; float s = 0.f;
#pragma unroll
        for (int i = 0; i < 4; ++i) { const f32x4 q = *(const f32x4*)(xr + i * 256 + lane * 4); v[4 * i] = q[0]; v[4 * i + 1] = q[1]; v[4 * i + 2] = q[2]; v[4 * i + 3] = q[3]; s += q[0] + q[1] + q[2] + q[3]; }
        const float mu = wave_sum(s) * (1.0f / D);
        float ss = 0.f;
#pragma unroll
        for (int i = 0; i < 16; ++i) { const float d = v[i] - mu; ss += d * d; }
        const float rstd = rsqrtf(wave_sum(ss) * (1.0f / D) + EPS);
#pragma unroll
        for (int i = 0; i < 4; ++i) {
            const int c = i * 256 + lane * 4;
            const f32x4 gg = *(const f32x4*)(P.ln1_g + c), bb = *(const f32x4*)(P.ln1_b + c);
            ushort4 o, ol;
            float y;
            y = (v[4 * i] - mu) * rstd * gg[0] + bb[0];     o.x = f2bf(y); ol.x = f2bf(y - bf2f(o.x));
            y = (v[4 * i + 1] - mu) * rstd * gg[1] + bb[1]; o.y = f2bf(y); ol.y = f2bf(y - bf2f(o.y));
            y = (v[4 * i + 2] - mu) * rstd * gg[2] + bb[2]; o.z = f2bf(y); ol.z = f2bf(y - bf2f(o.z));
            y = (v[4 * i + 3] - mu) * rstd * gg[3] + bb[3]; o.w = f2bf(y); ol.w = f2bf(y - bf2f(o.w));
            *(ushort4*)(x1 + (size_t)t * D + c) = o; (void)ol; (void)x1lo;
            { int p = __builtin_amdgcn_cvt_pk_fp8_f32(bf2f(o.x) * XQ_SCALE, bf2f(o.y) * XQ_SCALE, 0, false); p = __builtin_amdgcn_cvt_pk_fp8_f32(bf2f(o.z) * XQ_SCALE, bf2f(o.w) * XQ_SCALE, p, true);
              *(int*)(WSP(unsigned char, WS_X1Q) + (size_t)t * D + c) = p; }
        }
    }
}
__device__ __forceinline__ void ph_router(const Ptrs& P, int bid, int nb) {
    const int tidx = opaque_tid();
    const bf16_t* x1 = WSP(bf16_t, WS_X1); const bf16_t* x1lo = WSP(bf16_t, WS_X1LO); float* logits = WSP(float, WS_LOGITS);
    const int e = tidx & 63, w = tidx >> 6;
    for (int t = bid * NWAVE + w; t < T; t += nb * NWAVE) {
        const bf16_t* a = x1 + (size_t)t * D; const bf16_t* al = x1lo + (size_t)t * D;
        float s = 0.f;
        for (int k = 0; k < D; k += 8) {
            const bf16x8 hi = *(const bf16x8*)(a + k), lo = *(const bf16x8*)(al + k);
#pragma unroll
            for (int i = 0; i < 8; ++i) s += (bf2f((bf16_t)hi[i]) + bf2f((bf16_t)lo[i])) * P.w_router[(size_t)(k + i) * NE + e];
        }
        logits[(size_t)t * NE + e] = s;
    }
}
__device__ __forceinline__ void ph_topk(const Ptrs& P, int bid, int nb) {
    const int tidx = opaque_tid();
    const float* logits = WSP(float, WS_LOGITS); int* topi = WSP(int, WS_TOPI); float* topw = WSP(float, WS_TOPW);
    const int lane = tidx & 63, w = tidx >> 6;
    for (int t = bid * NWAVE + w; t < T; t += nb * NWAVE) {
        const float sc = sigmoidf_(logits[(size_t)t * NE + lane]);
        const float sel = sc + P.router_bias[lane];
        const int grp = lane >> 3;
        float m1 = sel;
        m1 = fmaxf(m1, __shfl_xor(m1, 1)); m1 = fmaxf(m1, __shfl_xor(m1, 2)); m1 = fmaxf(m1, __shfl_xor(m1, 4));
        const unsigned long long bal = __ballot(sel == m1) & (0xFFull << (8 * grp));
        const int first = __ffsll((long long)bal) - 1;
        float m2 = (lane == first) ? -INFINITY : sel;
        m2 = fmaxf(m2, __shfl_xor(m2, 1)); m2 = fmaxf(m2, __shfl_xor(m2, 2)); m2 = fmaxf(m2, __shfl_xor(m2, 4));
        const float gs = m1 + m2;
        int cg = 0;
#pragma unroll
        for (int gj = 0; gj < 8; ++gj) { const float sj = __shfl(gs, gj * 8); cg += (sj > gs || (sj == gs && gj < grp)) ? 1 : 0; }
        const bool gsel = cg < 4;
        const float v = gsel ? sel : -INFINITY;
        int rank = 0;
        for (int e2 = 0; e2 < 64; ++e2) { const float ve = __shfl(v, e2); rank += (ve > v || (ve == v && e2 < lane)) ? 1 : 0; }
        const bool chosen = gsel && rank < TOPK;
        const float wsum = wave_sum(chosen ? sc : 0.f);
        if (chosen) { topi[(size_t)t * TOPK + rank] = lane; topw[(size_t)t * TOPK + rank] = sc / wsum * 2.5f; }
    }
}
__device__ __forceinline__ void ph_cnt(const Ptrs& P, int bid, int nb) {
    const int tidx = opaque_tid();
    const int* topi = WSP(int, WS_TOPI); int* cnt = WSP(int, WS_CNT);
    for (int i = bid * NTHR + tidx; i < 256 * 64; i += nb * NTHR) {
        const int tile = i >> 6, e = i & 63;
        int c = 0;
        for (int k = 0; k < 1024; ++k) c += (topi[tile * 1024 + k] == e) ? 1 : 0;
        cnt[i] = c;
    }
}
__device__ __forceinline__ void ph_off(const Ptrs& P, LAS unsigned char* lds, int bid) {
    const int tidx = opaque_tid();
    if (bid != 0) return;
    const int* cnt = WSP(int, WS_CNT); int* toff = WSP(int, WS_TOFF); int* eoff = WSP(int, WS_EOFF); int* ecnt = WSP(int, WS_ECNT);
    LAS int* tot = (LAS int*)lds; LAS int* off = tot + 64;
    const int e = tidx;
    if (e < 64) { int s = 0; for (int tile = 0; tile < 256; ++tile) s += cnt[tile * 64 + e]; tot[e] = s; ecnt[e] = s; }
    __syncthreads();
    if (e == 0) { int o = 0; for (int i = 0; i < 64; ++i) { off[i] = o; o += (tot[i] + 255) & ~255; } off[64] = o; }
    __syncthreads();
    if (e < 64) {
        eoff[e] = off[e]; if (e == 0) eoff[64] = off[64];
        int run = off[e];
        for (int tile = 0; tile < 256; ++tile) { toff[tile * 64 + e] = run; run += cnt[tile * 64 + e]; }
    }
}
__device__ __forceinline__ void ph_lists(const Ptrs& P, int bid, int nb) {
    const int tidx = opaque_tid();
    const int* topi = WSP(int, WS_TOPI); const float* topw = WSP(float, WS_TOPW); const int* toff = WSP(int, WS_TOFF); const int* eoff = WSP(int, WS_EOFF);
    int* rowtok = WSP(int, WS_ROWTOK); float* roww = WSP(float, WS_ROWW);
    for (int i = bid * NTHR + tidx; i < 256 * 64; i += nb * NTHR) {
        const int tile = i >> 6, e = i & 63;
        int pos = toff[tile * 64 + e];
        for (int k = 0; k < 1024; ++k) {
            if (topi[tile * 1024 + k] == e) { rowtok[pos] = tile * 1024 + k; roww[pos] = topw[tile * 1024 + k]; ++pos; }
        }
        if (tile == 255) { const int end = eoff[e + 1]; for (; pos < end; ++pos) { rowtok[pos] = -1; roww[pos] = 0.f; } }
    }
    for (int i = bid * NTHR + tidx; i < T; i += nb * NTHR) rowtok[SH_ROW0 + i] = i * 8;
}
__device__ __forceinline__ void ph_gemm_gu(const Ptrs& P, int bid, int nb) {
    const int tidx = opaque_tid();
    const bf16_t* x1 = WSP(bf16_t, WS_X1); const bf16_t* wgu = WSP(bf16_t, WS_WGU); const int* rowtok = WSP(int, WS_ROWTOK); const float* roww = WSP(float, WS_ROWW);
    const int* eoff = WSP(int, WS_EOFF); bf16_t* H = WSP(bf16_t, WS_H);
    const int nrt = eoff[64] / 32;
    const int ntl = (nrt + T / 32) * 8;
    GW_LOOP(ntl) {
        const int rt = tl >> 3, n0 = (tl & 7) * 32;
        if (rt < nrt) {
            const int m0 = rt * 32;
            int e = 0; while (e < 63 && eoff[e + 1] <= m0) ++e;
            const bf16_t* w = wgu + (size_t)e * 512 * 1024;
            sg_tile<true>(m0, n0, 1024,
                [&](int row) { const int s = rowtok[row]; return x1 + (size_t)(s >= 0 ? (s >> 3) : 0) * D; },
                [&](int f, int k, int which) { return w + (size_t)((f >> 7) * 256 + (f & 127) + which * 128) * 1024 + k; },
                [&](int row, int f, float gv, float uv) { H[(size_t)row * FF + f] = f2bf(gv * sigmoidf_(gv) * uv * roww[row]); });
        } else {
            const int m0 = (rt - nrt) * 32;
            const bf16_t* w = wgu + (size_t)64 * 512 * 1024;
            sg_tile<true>(m0, n0, 1024,
                [&](int row) { return x1 + (size_t)row * D; },
                [&](int f, int k, int which) { return w + (size_t)((f >> 7) * 256 + (f & 127) + which * 128) * 1024 + k; },
                [&](int row, int f, float gv, float uv) { H[(size_t)(SH_ROW0 + row) * FF + f] = f2bf(gv * sigmoidf_(gv) * uv); });
        }
    }
}
__device__ __forceinline__ unsigned char f2fp8(float v) { const int p = __builtin_amdgcn_cvt_pk_fp8_f32(v, v, 0, false); return (unsigned char)(p & 0xff); }
__device__ __forceinline__ void ph_gemm_down(const Ptrs& P, int bid, int nb) {
    const int tidx = opaque_tid();
    const bf16_t* H = WSP(bf16_t, WS_H); const bf16_t* wd = WSP(bf16_t, WS_WD); const int* rowtok = WSP(int, WS_ROWTOK); const int* eoff = WSP(int, WS_EOFF);
    const bf16_t* x1 = WSP(bf16_t, WS_X1); unsigned char* yslot = WSP(unsigned char, WS_YSLOT); float* out = P.out;
    const int nrt = eoff[64] / 32;
    const int ntl = (nrt + T / 32) * 32;
    GW_LOOP(ntl) {
        const int rt = tl >> 5, n0 = (tl & 31) * 32;
        if (rt < nrt) {
            const int m0 = rt * 32;
            int e = 0; while (e < 63 && eoff[e + 1] <= m0) ++e;
            const bf16_t* w = wd + (size_t)e * 1024 * 256;
            sg_tile<false>(m0, n0, 256,
                [&](int row) { return H + (size_t)row * FF; },
                [&](int n, int k, int) { return w + (size_t)n * 256 + k; },
                [&](int row, int n, float v, float) { const int s = rowtok[row]; if (s >= 0) yslot[(size_t)s * D + n] = f2fp8(v * SLOT_SCALE); });
        } else {
            const int m0 = (rt - nrt) * 32;
            const bf16_t* w = wd + (size_t)64 * 1024 * 256;
            sg_tile<false>(m0, n0, 256,
                [&](int row) { return H + (size_t)(SH_ROW0 + row) * FF; },
                [&](int n, int k, int) { return w + (size_t)n * 256 + k; },
                [&](int t, int n, float v, float) { out[(size_t)t * D + n] = v + ALPHA * bf2f(x1[(size_t)t * D + n]); });
        }
    }
}
__device__ __forceinline__ void ph_combine(const Ptrs& P, int bid, int nb) {
    const int tidx = opaque_tid();
    const unsigned char* yslot = WSP(unsigned char, WS_YSLOT); float* out = P.out;
    const int lane = tidx & 63, w = tidx >> 6;
    for (int t = bid * NWAVE + w; t < T; t += nb * NWAVE) {
        float* orow = out + (size_t)t * D + lane * 16;
        float v[16];
        { const bf16_t* xr = WSP(bf16_t, WS_X1) + (size_t)t * D + lane * 16;
          const bf16x8 a = *(const bf16x8*)xr, b = *(const bf16x8*)(xr + 8);
#pragma unroll
          for (int i = 0; i < 8; ++i) { v[i] = bf2f((bf16_t)a[i]); v[8 + i] = bf2f((bf16_t)b[i]); } }
#pragma unroll
        for (int i = 0; i < 16; ++i) v[i] *= ALPHA;
#pragma unroll
        for (int k = 0; k <= TOPK; ++k) {
            const u32x4 q = (k < TOPK) ? *(const u32x4*)(yslot + ((size_t)t * TOPK + k) * D + lane * 16) : *(const u32x4*)(WSP(unsigned char, WS_SHSLOT) + (size_t)t * D + lane * 16);
            const float wk = ((k < TOPK) ? WSP(float, WS_TOPW)[(size_t)t * TOPK + (k < TOPK ? k : 0)] : 1.0f) * (1.0f / SLOT_SCALE);
#pragma unroll
            for (int i = 0; i < 4; ++i) {
                v[4 * i]     += __builtin_amdgcn_cvt_f32_fp8((int)q[i], 0) * wk;
                v[4 * i + 1] += __builtin_amdgcn_cvt_f32_fp8((int)q[i], 1) * wk;
                v[4 * i + 2] += __builtin_amdgcn_cvt_f32_fp8((int)q[i], 2) * wk;
                v[4 * i + 3] += __builtin_amdgcn_cvt_f32_fp8((int)q[i], 3) * wk;
            }
        }
        float s = 0.f;
#pragma unroll
        for (int i = 0; i < 16; ++i) s += v[i];
        const float mu = wave_sum(s) * (1.0f / D);
        float ss = 0.f;
#pragma unroll
        for (int i = 0; i < 16; ++i) { const float d = v[i] - mu; ss += d * d; }
        const float rstd = rsqrtf(wave_sum(ss) * (1.0f / D) + EPS);
#pragma unroll
        for (int i = 0; i < 4; ++i) {
            const int c = lane * 16 + 4 * i;
            const f32x4 gg = *(const f32x4*)(P.ln2_g + c), bb = *(const f32x4*)(P.ln2_b + c);
            f32x4 o;
            o[0] = (v[4 * i] - mu) * rstd * gg[0] + bb[0]; o[1] = (v[4 * i + 1] - mu) * rstd * gg[1] + bb[1];
            o[2] = (v[4 * i + 2] - mu) * rstd * gg[2] + bb[2]; o[3] = (v[4 * i + 3] - mu) * rstd * gg[3] + bb[3];
            *(f32x4*)(orow + 4 * i) = o;
        }
    }
}

namespace g8 {
constexpr int BM = 256, BK = 64, HALF = 128, HTB = HALF * BK * 2, STAGE_BYTES = 8 * HTB;
__device__ __forceinline__ int lds_byte(int r, int c) { const int st = (r >> 4) * 2 + (c >> 5), rr = r & 15, cc = c & 31, ob = rr * 64 + cc * 2; return st * 1024 + (ob ^ (((ob >> 9) & 1) << 5)); }
__device__ __forceinline__ void stage_rc(int b, int& R, int& C) { const int st = b / 1024, sb = b % 1024, swz = sb ^ (((sb >> 9) & 1) << 5); R = (st >> 1) * 16 + swz / 64; C = (st & 1) * 32 + (swz % 64) / 2; }
__device__ __forceinline__ int perm32(int rho) { const int n = rho >> 4, i = rho & 15; return 8 * (i >> 2) + 4 * n + (i & 3); }

struct Unit { const char* A; const char* B; const int* rows; int pm, pn, e, nt; };
struct Geo { int lda_b, ldb_b; long kstepA, kstepB; int toep; };

typedef float f32x4 __attribute__((ext_vector_type(4)));
typedef f32x4 Acc[2][2][4][2];
typedef int v8i_t __attribute__((ext_vector_type(8)));
typedef int v4i_t __attribute__((ext_vector_type(4)));

__device__ __forceinline__ unsigned g8_rowoff(const int* rows, int h, int i, int tid, int lda_b) {
    int t2 = tid; asm volatile("" : "+v"(t2));
    int R, C; stage_rc(t2 * 16 + i * 8192, R, C);
    const int sl = rows[h * HALF + R];
    return (unsigned)((sl < 0 ? 0 : sl >> 3) * lda_b + C * 2);
}
template <class Epi, class Sched, bool GATHER, int DT = 0>
__device__ __forceinline__ void gemm_body(LAS unsigned char* lds, const Geo g, const Sched& S, const Epi& E) {
    const int tid = opaque_tid(), wid = __builtin_amdgcn_readfirstlane(tid >> 6), lane = tid & 63, wr = wid >> 2, wc = wid & 3, fr = lane & 15, fq = lane >> 4;
    unsigned voffB[2], vA[2][2];
#pragma unroll
    for (int i = 0; i < 2; ++i) { int R, C; stage_rc(tid * 16 + i * 8192, R, C); const int Rb = (R & ~31) + perm32(R & 31);
        voffB[i] = g.toep ? (unsigned)(Rb * 32 + 1536 - (C >> 4) * 512 + (C & 15) * 2) : (unsigned)(Rb * g.ldb_b + C * 2);
#pragma unroll
        for (int h = 0; h < 2; ++h) vA[h][i] = (unsigned)((h * HALF + R) * g.lda_b + C * 2); }
    const long kA = g.kstepA, kB = g.kstepB;
    const long hB = (long)HALF * g.ldb_b;
    const unsigned ldsw = (unsigned)wid * 1024u;
    const int aoff = lds_byte(wr * 64 + fr, fq * 8), boff = lds_byte(wc * 32 + fr, fq * 8);
#define G8_SA(b, h) (((b) * 2 + (h)) * HTB)
#define G8_SB(b, h) ((4 + (b) * 2 + (h)) * HTB)
#define G8_STAGE(bufoff, gbase, v0, v1) do { \
        unsigned v0_ = (v0), v1_ = (v1); if (GATHER) asm volatile("" : "+v"(v0_), "+v"(v1_)); \
        __builtin_amdgcn_global_load_lds((const unsigned*)((const char*)(gbase) + v0_), (LAS unsigned*)(lds + (bufoff) + ldsw), 16, 0, 0); \
        __builtin_amdgcn_global_load_lds((const unsigned*)((const char*)(gbase) + v1_), (LAS unsigned*)(lds + (bufoff) + ldsw + 8192), 16, 0, 0); } while (0)
#define G8_STB(bufoff, gbase) G8_STAGE(bufoff, gbase, voffB[0], voffB[1])
#define G8_LDA(dst, b, h) do { if (DT == 0) { _Pragma("unroll") for (int m = 0; m < 4; ++m) _Pragma("unroll") for (int k = 0; k < 2; ++k) dst[m][k] = *(const LAS bf16x8*)(lds + G8_SA(b, h) + aoff + m * 2048 + k * 1024); } \
        else { _Pragma("unroll") for (int m = 0; m < 4; ++m) dst##8[m] = __builtin_shufflevector(*(const LAS v4i_t*)(aBase + G8_SA(b, h) + m * 2048), *(const LAS v4i_t*)(aBase + G8_SA(b, h) + m * 2048 + 1024), 0, 1, 2, 3, 4, 5, 6, 7); } } while (0)
#define G8_LDB(dst, b, h) do { if (DT == 0) { _Pragma("unroll") for (int n = 0; n < 2; ++n) _Pragma("unroll") for (int k = 0; k < 2; ++k) dst[n][k] = *(const LAS bf16x8*)(lds + G8_SB(b, h) + boff + n * 2048 + k * 1024); } \
        else { _Pragma("unroll") for (int n = 0; n < 2; ++n) dst##8[n] = __builtin_shufflevector(*(const LAS v4i_t*)(bBase + (G8_SB(b, h) - 65536) + n * 2048), *(const LAS v4i_t*)(bBase + (G8_SB(b, h) - 65536) + n * 2048 + 1024), 0, 1, 2, 3, 4, 5, 6, 7); } } while (0)
#define G8_MMA(ai, bj, At, Bt) do { __builtin_amdgcn_s_setprio(1); \
        if (DT == 0) { _Pragma("unroll") for (int m = 0; m < 4; ++m) _Pragma("unroll") for (int n = 0; n < 2; ++n) _Pragma("unroll") for (int k = 0; k < 2; ++k) \
            acc[ai][bj][m][n] = __builtin_amdgcn_mfma_f32_16x16x32_bf16(Bt[n][k], At[m][k], acc[ai][bj][m][n], 0, 0, 0); } \
        else { _Pragma("unroll") for (int m = 0; m < 4; ++m) _Pragma("unroll") for (int n = 0; n < 2; ++n) \
            acc[ai][bj][m][n] = __builtin_amdgcn_mfma_scale_f32_16x16x128_f8f6f4(Bt##8[n], At##8[m], acc[ai][bj][m][n], 0, 0, 0, 127, 0, 127); } \
        __builtin_amdgcn_s_setprio(0); } while (0)
#define G8_WAIT_V(n) asm volatile("s_waitcnt vmcnt(" #n ")" ::: "memory")
#define G8_WAIT_L(n) asm volatile("s_waitcnt lgkmcnt(" #n ")" ::: "memory")
#define G8_BAR __builtin_amdgcn_s_barrier()
#define G8_SCHED __builtin_amdgcn_sched_barrier(0)
#define G8_ROWOFF(u_, h_, i_) g8_rowoff((u_).rows, (h_), (i_), tid, g.lda_b)
    Unit cur, nxt; int ui = 0;
    if (!S.next(0, cur)) return;
    Acc acc;
#pragma unroll
    for (int a = 0; a < 2; ++a)
#pragma unroll
        for (int b = 0; b < 2; ++b)
#pragma unroll
            for (int m = 0; m < 4; ++m)
#pragma unroll
                for (int n = 0; n < 2; ++n) acc[a][b][m][n] = (f32x4){0.f, 0.f, 0.f, 0.f};
    bf16x8 At[4][2], B0[2][2], B1[2][2];
    v8i_t At8[4], B08[2], B18[2];
    LAS unsigned char* aBase = lds + aoff; LAS unsigned char* bBase = lds + 65536 + boff;
    asm volatile("" : "+v"(aBase), "+v"(bBase));
    const char* cA = cur.A; const char* cB = cur.B;
    if (GATHER) {
#pragma unroll
        for (int h = 0; h < 2; ++h)
#pragma unroll
            for (int i = 0; i < 2; ++i) vA[h][i] = G8_ROWOFF(cur, h, i);
        asm volatile("" : "+v"(vA[0][0]), "+v"(vA[0][1]), "+v"(vA[1][0]), "+v"(vA[1][1]));
    }
    const long hA = GATHER ? 0 : 0;
    (void)hA;
    G8_STB(G8_SB(0, 0), cB); G8_STB(G8_SB(0, 1), cB + hB); G8_STAGE(G8_SA(0, 0), cA, vA[0][0], vA[0][1]); G8_STAGE(G8_SA(0, 1), cA, vA[1][0], vA[1][1]);
    if (wr == 1) G8_BAR;
    G8_WAIT_V(2); G8_BAR;
    G8_STB(G8_SB(1, 0), cB + kB); G8_STAGE(G8_SA(1, 0), cA + kA, vA[0][0], vA[0][1]); G8_STB(G8_SB(1, 1), cB + hB + kB);
    G8_WAIT_V(6); G8_BAR;
    for (;;) {
        const bool has_next = S.next(ui + 1, nxt);
        const char* nA = has_next ? nxt.A : cA; const char* nB = has_next ? nxt.B : cB;
        const int nt = cur.nt;
        for (int t = 0; t < nt; t += 2) {
            const bool last = (t == nt - 2);
            const char* a1 = cA + (long)(t + 1) * kA;
            const char* a2 = last ? nA : cA + (long)(t + 2) * kA; const char* b2 = last ? nB : cB + (long)(t + 2) * kB;
            const char* a3 = a2 + kA; const char* b3 = b2 + kB;
            G8_LDB(B0, 0, 0); G8_LDB(B1, 0, 1); G8_SCHED; G8_LDA(At, 0, 0); G8_STAGE(G8_SA(1, 1), a1, vA[1][0], vA[1][1]);
            if (GATHER && last && has_next) {
                vA[0][0] = G8_ROWOFF(nxt, 0, 0); vA[0][1] = G8_ROWOFF(nxt, 0, 1); vA[1][0] = G8_ROWOFF(nxt, 1, 0); vA[1][1] = G8_ROWOFF(nxt, 1, 1);
                asm volatile("" : "+v"(vA[0][0]), "+v"(vA[0][1]), "+v"(vA[1][0]), "+v"(vA[1][1]));
            }
            const unsigned w00 = vA[0][0], w01 = vA[0][1], w10 = vA[1][0], w11 = vA[1][1];
            G8_WAIT_V(8); G8_WAIT_L(0); G8_BAR; G8_MMA(0, 0, At, B0); G8_MMA(0, 1, At, B1); G8_BAR; G8_SCHED;
            G8_LDA(At, 0, 1); G8_STB(G8_SB(0, 0), b2); G8_STB(G8_SB(0, 1), b2 + hB); G8_STAGE(G8_SA(0, 0), a2, w00, w01);
            G8_WAIT_V(8); G8_WAIT_L(0); G8_BAR; G8_MMA(1, 0, At, B0); G8_MMA(1, 1, At, B1); G8_BAR; G8_SCHED;
            G8_LDB(B0, 1, 0); G8_LDB(B1, 1, 1); G8_SCHED; G8_LDA(At, 1, 0); G8_STAGE(G8_SA(0, 1), a2, w10, w11);
            G8_WAIT_V(8); G8_WAIT_L(0); G8_BAR; G8_MMA(0, 0, At, B0); G8_MMA(0, 1, At, B1); G8_BAR; G8_SCHED;
            G8_LDA(At, 1, 1); G8_STB(G8_SB(1, 0), b3); G8_STB(G8_SB(1, 1), b3 + hB); G8_STAGE(G8_SA(1, 0), a3, w00, w01);
            G8_WAIT_V(8); G8_WAIT_L(0); G8_BAR; G8_MMA(1, 0, At, B0); G8_MMA(1, 1, At, B1); G8_BAR; G8_SCHED;
        }
        if (wr == 0) G8_BAR;
        { int t3_ = threadIdx.x; asm volatile("" : "+v"(t3_)); E(acc, cur, wr, wc, t3_ & 15, (t3_ >> 4) & 3); }
        if (!has_next) break;
#pragma unroll
        for (int a = 0; a < 2; ++a)
#pragma unroll
            for (int b = 0; b < 2; ++b)
#pragma unroll
                for (int m = 0; m < 4; ++m)
#pragma unroll
                    for (int n = 0; n < 2; ++n) acc[a][b][m][n] = (f32x4){0.f, 0.f, 0.f, 0.f};
        cur = nxt; cA = nA; cB = nB; ++ui;
        if (wr == 1) G8_BAR;
    }
    G8_WAIT_V(0);
    G8_BAR;
#undef G8_SA
#undef G8_SB
#undef G8_STAGE
#undef G8_STB
#undef G8_LDA
#undef G8_LDB
#undef G8_MMA
#undef G8_WAIT_V
#undef G8_WAIT_L
#undef G8_BAR
#undef G8_SCHED
#undef G8_ROWOFF
}
}
namespace g8 {
__device__ __forceinline__ unsigned pk_bf16(float lo, float hi) { return (unsigned)f2bf(lo) | ((unsigned)f2bf(hi) << 16); }
__device__ __forceinline__ u32x4 pack8(const f32x4 a, const f32x4 b) { u32x4 w; w[0] = pk_bf16(a[0], a[1]); w[1] = pk_bf16(a[2], a[3]); w[2] = pk_bf16(b[0], b[1]); w[3] = pk_bf16(b[2], b[3]); return w; }
__device__ __forceinline__ int unit_index(int i, int nunits) {
    const int G = gridDim.x, c = blockIdx.x;
    if ((G & 7) != 0) { const long L = (long)i * G + c; return L < nunits ? (int)L : -1; }
    const int x = c & 7, r = c >> 3, GX = G >> 3;
    const int lo = (int)(((long)nunits * x) >> 3), hi = (int)(((long)nunits * (x + 1)) >> 3);
    const int L = lo + i * GX + r;
    return L < hi ? L : -1;
}
struct SchedReg {
    const char* A; const char* B; int lda_b, ldb_b, nM, nN, nt;
    __device__ __forceinline__ bool next(int i, Unit& u) const {
        const int L = unit_index(i, nM * nN); if (L < 0) return false;
        u.pm = L / nN; u.pn = L % nN; u.e = 0; u.nt = nt; u.rows = nullptr;
        u.A = A + (size_t)u.pm * 256 * lda_b; u.B = B + (size_t)u.pn * 256 * ldb_b; return true;
    }
};
struct SchedS5 {
    const char* A; const char* B; int lda_b, ldb_b, nN, nt; size_t a_gstride, b_gstride; int toep;
    __device__ __forceinline__ bool next(int i, Unit& u) const {
        const int L = unit_index(i, SG * 2 * nN); if (L < 0) return false;
        const int g = L / (2 * nN), r = L % (2 * nN);
        u.pm = r / nN; u.pn = r % nN; u.e = g; u.rows = nullptr;
        u.A = A + (size_t)g * a_gstride + (size_t)u.pm * 256 * lda_b;
        if (toep) { u.B = B + (size_t)g * 127 * 512 + 63 * 512 + (size_t)u.pn * 256 * 32 - 1536; u.nt = 4 * (u.pn + 1); }
        else { u.B = B + (size_t)g * b_gstride + (size_t)u.pn * 256 * ldb_b; u.nt = nt; }
        return true;
    }
};
struct SchedMoe {
    const char* A; const char* B; const int* eoff; const int* rowtok; int lda_b, npn, nt; size_t b_estride; int ldb_b; int gather; const int* tile_e;
    __device__ __forceinline__ bool next(int i, Unit& u) const {
        const int nrt = eoff[64] >> 8;
        const int G = gridDim.x, c = blockIdx.x;
        int rt;
        if ((G & 7) == 0) {
            const int x = c & 7, r = c >> 3, GX = G >> 3;
            const int r0 = (nrt * x) >> 3, r1 = (nrt * (x + 1)) >> 3, nr = r1 - r0;
            const int j = i * GX + r;
            if (j >= (nr + 16) * npn) return false;
            const int tl = j / npn; u.pn = j % npn;
            rt = (tl < nr) ? r0 + tl : nrt + 16 * x + (tl - nr);
        } else {
            const long L = (long)i * G + c; if (L >= (long)(nrt + T / 256) * npn) return false;
            rt = (int)(L / npn); u.pn = (int)(L % npn);
        }
        u.nt = nt;
        int e = 64;
        if (rt < nrt) e = tile_e[rt];
        u.e = e; u.pm = rt;
        u.B = B + (size_t)e * b_estride + (size_t)u.pn * 256 * ldb_b;
        if (gather) {
            u.A = A; u.rows = rowtok + ((e < 64) ? rt * 256 : SH_ROW0 + (rt - nrt) * 256);
        } else {
            const int row0 = (e < 64) ? rt * 256 : SH_ROW0 + (rt - nrt) * 256;
            u.A = A + (size_t)row0 * lda_b; u.rows = nullptr;
        }
        return true;
    }
};

#define EPI_ROWS_BEGIN _Pragma("unroll") for (int ai = 0; ai < 2; ++ai) _Pragma("unroll") for (int m = 0; m < 4; ++m) { const int rloc = ai * 128 + wr * 64 + m * 16 + fr;
#define EPI_ROWS_END }

struct EpiWin {
    bf16_t* cq; bf16_t* ckv; bf16_t* u; bf16_t* Kc; const float2* rope; float* rsqp; float* rskvp;
    __device__ __forceinline__ void operator()(const Acc& acc, const Unit& un, int wr, int wc, int fr, int fq) const {
        const int pn = un.pn;
        if (pn == 0) {
            EPI_ROWS_BEGIN
                const int t = un.pm * 256 + rloc;
                float ss = 0.f;
#pragma unroll
                for (int bj = 0; bj < 2; ++bj) { const f32x4 v0 = acc[ai][bj][m][0], v1 = acc[ai][bj][m][1];
                    *(u32x4*)(cq + (size_t)t * 256 + bj * 128 + wc * 32 + fq * 8) = pack8(v0, v1);
                    ss += v0[0] * v0[0] + v0[1] * v0[1] + v0[2] * v0[2] + v0[3] * v0[3] + v1[0] * v1[0] + v1[1] * v1[1] + v1[2] * v1[2] + v1[3] * v1[3]; }
                ss += __shfl_xor(ss, 16); ss += __shfl_xor(ss, 32);
                if (fq == 0) rsqp[(size_t)t * 4 + wc] = ss;
            EPI_ROWS_END
        } else if (pn <= 2) {
            EPI_ROWS_BEGIN
                const int t = un.pm * 256 + rloc;
                const int b = t >> 11, s = t & 2047, j = s >> 6, sl = s & 63;
#pragma unroll
                for (int bj = 0; bj < 2; ++bj) { const int ch0 = (pn - 1) * 256 + bj * 128 + wc * 32 + fq * 8, gi = ch0 >> 4, c0 = ch0 & 15;
                    *(u32x4*)(u + ((size_t)gi * 512 + b * 32 + j) * 1024 + sl * 16 + c0) = pack8(acc[ai][bj][m][0], acc[ai][bj][m][1]); }
            EPI_ROWS_END
        } else {
            EPI_ROWS_BEGIN
                const int t = un.pm * 256 + rloc;
                const f32x4 v0 = acc[ai][0][m][0], v1 = acc[ai][0][m][1];
                *(u32x4*)(ckv + (size_t)t * 256 + wc * 32 + fq * 8) = pack8(v0, v1);
                float ss = v0[0] * v0[0] + v0[1] * v0[1] + v0[2] * v0[2] + v0[3] * v0[3] + v1[0] * v1[0] + v1[1] * v1[1] + v1[2] * v1[2] + v1[3] * v1[3];
                ss += __shfl_xor(ss, 16); ss += __shfl_xor(ss, 32);
                if (fq == 0) rskvp[(size_t)t * 4 + wc] = ss;
                *(u32x4*)(ckv + (size_t)t * 256 + 128 + wc * 32 + fq * 8) = (u32x4){0u, 0u, 0u, 0u};
            EPI_ROWS_END
            if (wc == 0) {
                EPI_ROWS_BEGIN
                    const int t = un.pm * 256 + rloc;
                    const f32x4 x1 = acc[ai][1][m][0], x2 = acc[ai][1][m][1];
                    const f32x4 ca = *(const f32x4*)(rope + (size_t)t * 16 + fq * 4), cb = *(const f32x4*)(rope + (size_t)t * 16 + fq * 4 + 2);
                    const float o10 = x1[0] * ca[0] - x2[0] * ca[1], o11 = x1[1] * ca[2] - x2[1] * ca[3], o12 = x1[2] * cb[0] - x2[2] * cb[1], o13 = x1[3] * cb[2] - x2[3] * cb[3];
                    const float o20 = x2[0] * ca[0] + x1[0] * ca[1], o21 = x2[1] * ca[2] + x1[1] * ca[3], o22 = x2[2] * cb[0] + x1[2] * cb[1], o23 = x2[3] * cb[2] + x1[3] * cb[3];
                    uint2 w1, w2; w1.x = pk_bf16(o10, o11); w1.y = pk_bf16(o12, o13); w2.x = pk_bf16(o20, o21); w2.y = pk_bf16(o22, o23);
                    const int b = t >> 11, s = t & 2047;
                    bf16_t* kp = Kc + (((size_t)b * NH) * SEQ + s) * QKD + 64 + fq * 4;
#pragma unroll 1
                    for (int h = 0; h < NH; ++h) { *(uint2*)kp = w1; *(uint2*)(kp + 16) = w2; kp += (size_t)SEQ * QKD; }
                EPI_ROWS_END
            }
        }
    }
};
struct EpiQ {
    bf16_t* Q; const float* rsqp; const float2* rope;
    __device__ __forceinline__ void operator()(const Acc& acc, const Unit& un, int wr, int wc, int fr, int fq) const {
        EPI_ROWS_BEGIN
            const int t = un.pm * 256 + rloc, b = t >> 11, s = t & 2047;
            const f32x4 pp = *(const f32x4*)(rsqp + (size_t)t * 4);
            const float rs = rsqrtf((pp[0] + pp[1] + pp[2] + pp[3]) * (1.0f / 256) + EPS);
            if (un.pn < 2) {
#pragma unroll
                for (int bj = 0; bj < 2; ++bj) { const int col = un.pn * 256 + bj * 128 + wc * 32 + fq * 8;
                    *(u32x4*)(Q + (((size_t)b * NH + (col >> 6)) * SEQ + s) * QKD + (col & 63)) = pack8(acc[ai][bj][m][0] * rs, acc[ai][bj][m][1] * rs); }
            } else {
                const f32x4 ca = *(const f32x4*)(rope + (size_t)t * 16 + fq * 4), cb = *(const f32x4*)(rope + (size_t)t * 16 + fq * 4 + 2);
#pragma unroll
                for (int bj = 0; bj < 2; ++bj) { const f32x4 x1 = acc[ai][bj][m][0] * rs, x2 = acc[ai][bj][m][1] * rs;
                    const float o10 = x1[0] * ca[0] - x2[0] * ca[1], o11 = x1[1] * ca[2] - x2[1] * ca[3], o12 = x1[2] * cb[0] - x2[2] * cb[1], o13 = x1[3] * cb[2] - x2[3] * cb[3];
                    const float o20 = x2[0] * ca[0] + x1[0] * ca[1], o21 = x2[1] * ca[2] + x1[1] * ca[3], o22 = x2[2] * cb[0] + x1[2] * cb[1], o23 = x2[3] * cb[2] + x1[3] * cb[3];
                    uint2 w1, w2; w1.x = pk_bf16(o10, o11); w1.y = pk_bf16(o12, o13); w2.x = pk_bf16(o20, o21); w2.y = pk_bf16(o22, o23);
                    bf16_t* qp = Q + (((size_t)b * NH + (bj * 4 + wc)) * SEQ + s) * QKD + 64 + fq * 4; *(uint2*)qp = w1; *(uint2*)(qp + 16) = w2; }
            }
        EPI_ROWS_END
    }
};
struct EpiKV {
    bf16_t* Kc; bf16_t* V; const float* rskvp;
    __device__ __forceinline__ void operator()(const Acc& acc, const Unit& un, int wr, int wc, int fr, int fq) const {
        EPI_ROWS_BEGIN
            const int t = un.pm * 256 + rloc, b = t >> 11, s = t & 2047;
            const f32x4 pp = *(const f32x4*)(rskvp + (size_t)t * 4);
            const float rs = rsqrtf((pp[0] + pp[1] + pp[2] + pp[3]) * (1.0f / 128) + EPS);
#pragma unroll
            for (int bj = 0; bj < 2; ++bj) { const int col = (un.pn & 1) * 256 + bj * 128 + wc * 32 + fq * 8;
                const u32x4 w = pack8(acc[ai][bj][m][0] * rs, acc[ai][bj][m][1] * rs);
                if (un.pn < 2) *(u32x4*)(Kc + (((size_t)b * NH + (col >> 6)) * SEQ + s) * QKD + (col & 63)) = w;
                else *(u32x4*)(V + (((size_t)b * NH + (col >> 6)) * SEQ + s) * VD + (col & 63)) = w; }
        EPI_ROWS_END
    }
};
struct EpiS5b {
    float* xloc;
    __device__ __forceinline__ void operator()(const Acc& acc, const Unit& un, int wr, int wc, int fr, int fq) const {
        EPI_ROWS_BEGIN
            float* o = xloc + ((size_t)un.e * 512 + un.pm * 256 + rloc) * 128 + wc * 32 + fq * 8;
            *(f32x4*)o = acc[ai][0][m][0]; *(f32x4*)(o + 4) = acc[ai][0][m][1];
        EPI_ROWS_END
    }
};
template <int MODE> struct EpiS5y {
    bf16_t* dst; const bf16_t* yintra;
    __device__ __forceinline__ void operator()(const Acc& acc, const Unit& un, int wr, int wc, int fr, int fq) const {
        EPI_ROWS_BEGIN
            const int row = un.pm * 256 + rloc, b = row >> 5, j = row & 31;
#pragma unroll
            for (int bj = 0; bj < 2; ++bj) { const int n = un.pn * 256 + bj * 128 + wc * 32 + fq * 8, tt = n >> 4, c0 = n & 15;
                const size_t o = ((size_t)b * SEQ + j * CH + tt) * SSMW + un.e * SC + c0;
                f32x4 v0 = acc[ai][bj][m][0], v1 = acc[ai][bj][m][1];
                if (MODE == 1) { const bf16x8 yi = *(const bf16x8*)(yintra + o);
#pragma unroll
                    for (int q = 0; q < 4; ++q) { v0[q] = gelu_tanh(v0[q] + bf2f((bf16_t)yi[q])); v1[q] = gelu_tanh(v1[q] + bf2f((bf16_t)yi[4 + q])); } }
                *(u32x4*)(dst + o) = pack8(v0, v1); }
        EPI_ROWS_END
    }
};
struct EpiGlu {
    const bf16_t* Y; const float* bglu; bf16_t* AS;
    __device__ __forceinline__ void operator()(const Acc& acc, const Unit& un, int wr, int wc, int fr, int fq) const {
        EPI_ROWS_BEGIN
            const int t = un.pm * 256 + rloc;
#pragma unroll
            for (int bj = 0; bj < 2; ++bj) { const int col = un.pn * 256 + bj * 128 + wc * 32 + fq * 8;
                const bf16x8 yv = *(const bf16x8*)(Y + (size_t)t * 512 + col);
                const f32x4 b0 = *(const f32x4*)(bglu + col), b1 = *(const f32x4*)(bglu + col + 4);
                f32x4 v0 = acc[ai][bj][m][0], v1 = acc[ai][bj][m][1];
#pragma unroll
                for (int q = 0; q < 4; ++q) { v0[q] = bf2f((bf16_t)yv[q]) * sigmoidf_(v0[q] + b0[q]); v1[q] = bf2f((bf16_t)yv[4 + q]) * sigmoidf_(v1[q] + b1[q]); }
                *(u32x4*)(AS + (size_t)t * 1024 + 512 + col) = pack8(v0, v1); }
        EPI_ROWS_END
    }
};
struct EpiWo {
    const float* x; const float* xstat; const float* g; const float* bt; float* pre1;
    __device__ __forceinline__ void operator()(const Acc& acc, const Unit& un, int wr, int wc, int fr, int fq) const {
        EPI_ROWS_BEGIN
            const int t = un.pm * 256 + rloc;
            const float mu = xstat[2 * t], rstd = xstat[2 * t + 1];
#pragma unroll
            for (int bj = 0; bj < 2; ++bj) { const int col = un.pn * 256 + bj * 128 + wc * 32 + fq * 8;
#pragma unroll
                for (int n = 0; n < 2; ++n) { const f32x4 xv = *(const f32x4*)(x + (size_t)t * D + col + 4 * n), gg = *(const f32x4*)(g + col + 4 * n), bb = *(const f32x4*)(bt + col + 4 * n);
                    f32x4 o;
#pragma unroll
                    for (int q = 0; q < 4; ++q) o[q] = acc[ai][bj][m][n][q] + ALPHA * ((xv[q] - mu) * rstd * gg[q] + bb[q]);
                    *(f32x4*)(pre1 + (size_t)t * D + col + 4 * n) = o; } }
        EPI_ROWS_END
    }
};
struct EpiGU {
    static constexpr float QINV = 1.0f / (XQ_SCALE * WQ_SCALE);
    bf16_t* H; const float* roww; const int* eoff;
    __device__ __forceinline__ void operator()(const Acc& acc, const Unit& un, int wr, int wc, int fr, int fq) const {
        const int nrt = eoff[64] >> 8;
        const bool shared = un.e == 64;
        const int row0 = shared ? SH_ROW0 + (un.pm - nrt) * 256 : un.pm * 256;
        EPI_ROWS_BEGIN
            const int row = row0 + rloc;
            const f32x4 g0 = acc[ai][0][m][0], g1 = acc[ai][0][m][1], u0 = acc[ai][1][m][0], u1 = acc[ai][1][m][1];
            f32x4 h0, h1;
#pragma unroll
            for (int q = 0; q < 4; ++q) { const float ga = g0[q] * QINV, gb = g1[q] * QINV; h0[q] = ga * sigmoidf_(ga) * (u0[q] * QINV); h1[q] = gb * sigmoidf_(gb) * (u1[q] * QINV); }
            { int p0 = __builtin_amdgcn_cvt_pk_fp8_f32(h0[0] * HQ_SCALE, h0[1] * HQ_SCALE, 0, false); p0 = __builtin_amdgcn_cvt_pk_fp8_f32(h0[2] * HQ_SCALE, h0[3] * HQ_SCALE, p0, true);
              int p1 = __builtin_amdgcn_cvt_pk_fp8_f32(h1[0] * HQ_SCALE, h1[1] * HQ_SCALE, 0, false); p1 = __builtin_amdgcn_cvt_pk_fp8_f32(h1[2] * HQ_SCALE, h1[3] * HQ_SCALE, p1, true);
              u32x2 w; w[0] = (unsigned)p0; w[1] = (unsigned)p1;
              *(u32x2*)((unsigned char*)H + (size_t)row * FF + un.pn * 128 + wc * 32 + fq * 8) = w; }
        EPI_ROWS_END
    }
};
struct EpiDown {
    __device__ __forceinline__ void prefetch(const Unit&, int) const {}
    static constexpr float OSC = SLOT_SCALE / (HQ_SCALE * WQ_SCALE);
    unsigned char* yslot; unsigned char* shslot; const int* rowtok; const int* eoff; LAS unsigned char* stg;
    __device__ __forceinline__ void operator()(const Acc& acc, const Unit& un, int wr, int wc, int fr, int fq) const {
        const int nrt = eoff[64] >> 8;
        const bool shared = un.e == 64;
        const int tid = (wr * 4 + wc) * 64 + fq * 16 + fr;
        const int rrow = tid >> 4, rcol = (tid & 15) * 16;
        int slots[8];
#pragma unroll
        for (int q = 0; q < 8; ++q) { const int rloc = (q >> 2) * 128 + (rrow >> 4) * 64 + (q & 3) * 16 + (rrow & 15);
            slots[q] = shared ? (un.pm - nrt) * 256 + rloc : rowtok[un.pm * 256 + rloc]; }
        unsigned char* base = shared ? shslot : yslot;
        int p = 0;
#pragma unroll
        for (int ai = 0; ai < 2; ++ai)
#pragma unroll
            for (int m = 0; m < 4; ++m, ++p) {
                LAS unsigned char* sb = stg + (p & 1) * (32 * 288);
#pragma unroll
                for (int bj = 0; bj < 2; ++bj) {
                    const f32x4 v0 = acc[ai][bj][m][0] * OSC, v1 = acc[ai][bj][m][1] * OSC;
                    int p0 = __builtin_amdgcn_cvt_pk_fp8_f32(v0[0], v0[1], 0, false); p0 = __builtin_amdgcn_cvt_pk_fp8_f32(v0[2], v0[3], p0, true);
                    int p1 = __builtin_amdgcn_cvt_pk_fp8_f32(v1[0], v1[1], 0, false); p1 = __builtin_amdgcn_cvt_pk_fp8_f32(v1[2], v1[3], p1, true);
                    u32x2 w; w[0] = (unsigned)p0; w[1] = (unsigned)p1;
                    *(LAS u32x2*)(sb + (wr * 16 + fr) * 288 + bj * 128 + wc * 32 + fq * 8) = w;
                }
                asm volatile("s_waitcnt lgkmcnt(0)\n\ts_barrier" ::: "memory");
                const int slot = slots[ai * 4 + m];
                const u32x4 v = *(const LAS u32x4*)(sb + rrow * 288 + rcol);
                if (slot >= 0) *(u32x4*)(base + (size_t)slot * D + un.pn * 256 + rcol) = v;
            }
        asm volatile("s_waitcnt lgkmcnt(0)\n\ts_barrier" ::: "memory");
    }
};
}
namespace g8 {
struct EpiRouter {
    float* logits;
    __device__ __forceinline__ void operator()(const Acc& acc, const Unit& un, int wr, int wc, int fr, int fq) const {
        if (wc >= 2) return;
        EPI_ROWS_BEGIN
            float* o = logits + (size_t)(un.pm * 256 + rloc) * NE + wc * 32 + fq * 8;
            *(f32x4*)o = acc[ai][0][m][0]; *(f32x4*)(o + 4) = acc[ai][0][m][1];
        EPI_ROWS_END
    }
};
}
__device__ __forceinline__ void fp_gemm_router(const Ptrs& P, LAS unsigned char* lds) {
    g8::Geo g{2048, 2048, 128, 128, 0};
    g8::SchedReg S{(const char*)WSP(bf16_t, WS_X1), (const char*)WSP(bf16_t, WS_WR), 2048, 2048, T / 256, 1, 16};
    g8::EpiRouter E{WSP(float, WS_LOGITS)};
    g8::gemm_body<g8::EpiRouter, g8::SchedReg, false>(lds, g, S, E);
}
__device__ __forceinline__ void ph_topk_cnt(const Ptrs& P, LAS unsigned char* lds, int bid, int nb) {
    const int tidx = opaque_tid();
    const float* logits = WSP(float, WS_LOGITS); int* topi = WSP(int, WS_TOPI); float* topw = WSP(float, WS_TOPW); int* cnt = WSP(int, WS_CNT);
    LAS int* hist = (LAS int*)lds;
    LAS float* bias = (LAS float*)(lds + 256);
    LAS float* scs = (LAS float*)(lds + 512);
    for (int tile = bid; tile < 256; tile += nb) {
        if (tidx < 64) { hist[tidx] = 0; bias[tidx] = P.router_bias[tidx]; }
        for (int i = tidx; i < 128 * 64; i += NTHR) { const int tk = i >> 6, e = i & 63; scs[e * 128 + tk] = sigmoidf_(logits[(size_t)(tile * 128 + tk) * NE + e]); }
        __syncthreads();
        if (tidx < 128) {
            const int t = tile * 128 + tidx;
            unsigned gmask = 0u;
            {
                float gs[8];
#pragma unroll
                for (int g = 0; g < 8; ++g) { float m1 = -INFINITY, m2 = -INFINITY;
#pragma unroll 1
                    for (int j = 0; j < 8; ++j) { const float v = scs[(8 * g + j) * 128 + tidx] + bias[8 * g + j]; const bool a = v > m1; m2 = a ? m1 : fmaxf(m2, v); m1 = a ? v : m1; }
                    gs[g] = m1 + m2; }
#pragma unroll
                for (int g = 0; g < 8; ++g) { int c = 0;
#pragma unroll
                    for (int h = 0; h < 8; ++h) c += (gs[h] > gs[g] || (gs[h] == gs[g] && h < g)) ? 1 : 0;
                    gmask |= (c < 4) ? (1u << g) : 0u; }
            }
            float tv[8], ts[8]; int te[8];
#pragma unroll
            for (int k = 0; k < 8; ++k) { tv[k] = -INFINITY; ts[k] = 0.f; te[k] = 0; }
#pragma unroll 1
            for (int e = 0; e < 64; ++e) {
                const float s0 = scs[e * 128 + tidx];
                const float v = ((gmask >> (e >> 3)) & 1u) ? s0 + bias[e] : -INFINITY;
                if (v > tv[7]) { tv[7] = v; ts[7] = s0; te[7] = e; }
#pragma unroll
                for (int p = 7; p >= 1; --p) { const bool sw = tv[p] > tv[p - 1];
                    const float a = tv[p], b = tv[p - 1]; tv[p - 1] = sw ? a : b; tv[p] = sw ? b : a;
                    const float c = ts[p], d = ts[p - 1]; ts[p - 1] = sw ? c : d; ts[p] = sw ? d : c;
                    const int x = te[p], y = te[p - 1]; te[p - 1] = sw ? x : y; te[p] = sw ? y : x; }
            }
            float wsum = 0.f;
#pragma unroll
            for (int k = 0; k < 8; ++k) wsum += ts[k];
            const float sc_ = 2.5f / wsum;
            int* ip = topi + (size_t)t * TOPK; float* wp = topw + (size_t)t * TOPK;
            *(int4*)ip = make_int4(te[0], te[1], te[2], te[3]); *(int4*)(ip + 4) = make_int4(te[4], te[5], te[6], te[7]);
            *(f32x4*)wp = (f32x4){ts[0] * sc_, ts[1] * sc_, ts[2] * sc_, ts[3] * sc_}; *(f32x4*)(wp + 4) = (f32x4){ts[4] * sc_, ts[5] * sc_, ts[6] * sc_, ts[7] * sc_};
#pragma unroll
            for (int k = 0; k < 8; ++k) __hip_atomic_fetch_add(hist + te[k], 1, __ATOMIC_RELAXED, __HIP_MEMORY_SCOPE_WORKGROUP);
        }
        __syncthreads();
        if (tidx < 64) cnt[tile * 64 + tidx] = hist[tidx];
        __syncthreads();
    }
}
__device__ __forceinline__ void ph_lists2(const Ptrs& P, LAS unsigned char* lds, int bid, int nb) {
    const int tidx = opaque_tid();
    const int* topi = WSP(int, WS_TOPI); const float* topw = WSP(float, WS_TOPW); const int* cnt = WSP(int, WS_CNT);
    int* eoff = WSP(int, WS_EOFF); int* rowtok = WSP(int, WS_ROWTOK); float* roww = WSP(float, WS_ROWW);
    LAS int* red_tot = (LAS int*)lds;
    LAS int* red_pre = red_tot + 512;
    LAS int* tot = red_pre + 512;
    LAS int* off = tot + 64;
    LAS int* seg = off + 128;
    LAS int* ti = seg + 512;
    LAS float* tw = (LAS float*)(ti + 1024);
    const int e = tidx & 63, part = tidx >> 6;
    for (int tile = bid; tile < 256; tile += nb) {
        int cv[32];
#pragma unroll
        for (int q = 0; q < 32; ++q) cv[q] = cnt[(part * 32 + q) * 64 + e];
        const int i0v = topi[tile * 1024 + tidx], i1v = topi[tile * 1024 + 512 + tidx];
        const float w0v = topw[tile * 1024 + tidx], w1v = topw[tile * 1024 + 512 + tidx];
        int st = 0, sp = 0;
#pragma unroll
        for (int q = 0; q < 32; ++q) { st += cv[q]; sp += (part * 32 + q < tile) ? cv[q] : 0; }
        red_tot[part * 64 + e] = st; red_pre[part * 64 + e] = sp;
        ti[tidx] = i0v; ti[tidx + 512] = i1v; tw[tidx] = w0v; tw[tidx + 512] = w1v;
        __syncthreads();
        int pre_e = 0;
        if (tidx < 64) { int a = 0;
#pragma unroll
            for (int q = 0; q < 8; ++q) { a += red_tot[q * 64 + tidx]; pre_e += red_pre[q * 64 + tidx]; } tot[tidx] = a; }
        int c = 0;
#pragma unroll 16
        for (int k = 0; k < 128; ++k) c += (ti[part * 128 + k] == e) ? 1 : 0;
        seg[part * 64 + e] = c;
        __syncthreads();
        if (tidx == 0) { int o = 0; for (int i = 0; i < 64; ++i) { off[i] = o; o += (tot[i] + 255) & ~255; } off[64] = o; }
        if (tidx < 64) red_pre[tidx] = pre_e;
        __syncthreads();
        int pos = off[e] + red_pre[e];
        for (int q = 0; q < part; ++q) pos += seg[q * 64 + e];
#pragma unroll 8
        for (int k = 0; k < 128; ++k) { const int idx = part * 128 + k; if (ti[idx] == e) { rowtok[pos] = tile * 1024 + idx; roww[pos] = tw[idx]; ++pos; } }
        if (tile == 255 && part == 7) { const int end = off[e + 1]; for (; pos < end; ++pos) { rowtok[pos] = -1; roww[pos] = 0.f; } }
        if (bid == 0 && tidx <= 64) eoff[tidx] = off[tidx];
        if (bid == 0 && tidx < 64) { int* tile_e = WSP(int, WS_TILEE); for (int rt = off[tidx] >> 8; rt < (off[tidx + 1] >> 8); ++rt) tile_e[rt] = tidx; }
        __syncthreads();
    }
    for (int i = bid * NTHR + tidx; i < T; i += nb * NTHR) rowtok[SH_ROW0 + i] = i * 8;
}
__device__ __forceinline__ void fp_gemm_win(const Ptrs& P, LAS unsigned char* lds) {
    g8::Geo g{2048, 2048, 128, 128, 0};
    g8::SchedReg S{(const char*)WSP(bf16_t, WS_XN), (const char*)WSP(bf16_t, WS_WIN), 2048, 2048, T / 256, 4, 16};
    g8::EpiWin E{WSP(bf16_t, WS_CQ), WSP(bf16_t, WS_CKV), WSP(bf16_t, WS_U), WSP(bf16_t, WS_K), WSP(float2, WS_ROPE), WSP(float, WS_RSQ), WSP(float, WS_RSKV)};
    g8::gemm_body<g8::EpiWin, g8::SchedReg, false>(lds, g, S, E);
}
__device__ __forceinline__ void fp_gemm_q(const Ptrs& P, LAS unsigned char* lds) {
    g8::Geo g{512, 512, 128, 128, 0};
    g8::SchedReg S{(const char*)WSP(bf16_t, WS_CQ), (const char*)WSP(bf16_t, WS_WUQ), 512, 512, T / 256, 3, 4};
    g8::EpiQ E{WSP(bf16_t, WS_Q), WSP(float, WS_RSQ), WSP(float2, WS_ROPE)};
    g8::gemm_body<g8::EpiQ, g8::SchedReg, false>(lds, g, S, E);
}
__device__ __forceinline__ void fp_gemm_kv(const Ptrs& P, LAS unsigned char* lds) {
    g8::Geo g{512, 512, 128, 128, 0};
    g8::SchedReg S{(const char*)WSP(bf16_t, WS_CKV), (const char*)WSP(bf16_t, WS_WUKV), 512, 512, T / 256, 4, 4};
    g8::EpiKV E{WSP(bf16_t, WS_K), WSP(bf16_t, WS_V), WSP(float, WS_RSKV)};
    g8::gemm_body<g8::EpiKV, g8::SchedReg, false>(lds, g, S, E);
}
__device__ __forceinline__ void fp_gemm_s5b(const Ptrs& P, LAS unsigned char* lds) {
    g8::Geo g{2048, 2048, 128, 128, 0};
    g8::SchedS5 S{(const char*)WSP(bf16_t, WS_U), (const char*)WSP(bf16_t, WS_BLOC), 2048, 2048, 1, 16, (size_t)512 * 2048, (size_t)256 * 2048, 0};
    g8::EpiS5b E{WSP(float, WS_XLOC)};
    g8::gemm_body<g8::EpiS5b, g8::SchedS5, false>(lds, g, S, E);
}
__device__ __forceinline__ void fp_gemm_s5a(const Ptrs& P, LAS unsigned char* lds) {
    g8::Geo g{2048, 32, 128, -2048, 1};
    g8::SchedS5 S{(const char*)WSP(bf16_t, WS_U), (const char*)WSP(bf16_t, WS_KTAB), 2048, 32, 4, 16, (size_t)512 * 2048, 0, 1};
    g8::EpiS5y<0> E{WSP(bf16_t, WS_YINTRA), nullptr};
    g8::gemm_body<g8::EpiS5y<0>, g8::SchedS5, false>(lds, g, S, E);
}
__device__ __forceinline__ void fp_gemm_s5d(const Ptrs& P, LAS unsigned char* lds) {
    g8::Geo g{512, 512, 128, 128, 0};
    g8::SchedS5 S{(const char*)WSP(bf16_t, WS_XPREV), (const char*)WSP(bf16_t, WS_CLAM), 512, 512, 4, 4, (size_t)512 * 512, (size_t)1024 * 512, 0};
    g8::EpiS5y<1> E{WSP(bf16_t, WS_Y), WSP(bf16_t, WS_YINTRA)};
    g8::gemm_body<g8::EpiS5y<1>, g8::SchedS5, false>(lds, g, S, E);
}
__device__ __forceinline__ void fp_gemm_glu(const Ptrs& P, LAS unsigned char* lds) {
    g8::Geo g{1024, 1024, 128, 128, 0};
    g8::SchedReg S{(const char*)WSP(bf16_t, WS_Y), (const char*)WSP(bf16_t, WS_WGLU), 1024, 1024, T / 256, 2, 8};
    g8::EpiGlu E{WSP(bf16_t, WS_Y), P.b_glu, WSP(bf16_t, WS_AS)};
    g8::gemm_body<g8::EpiGlu, g8::SchedReg, false>(lds, g, S, E);
}
__device__ __forceinline__ void fp_gemm_wo(const Ptrs& P, LAS unsigned char* lds) {
    g8::Geo g{2048, 2048, 128, 128, 0};
    g8::SchedReg S{(const char*)WSP(bf16_t, WS_AS), (const char*)WSP(bf16_t, WS_WO), 2048, 2048, T / 256, 4, 16};
    g8::EpiWo E{P.x, WSP(float, WS_XSTAT), P.ln_in_g, P.ln_in_b, P.out};
    g8::gemm_body<g8::EpiWo, g8::SchedReg, false>(lds, g, S, E);
}
__device__ __forceinline__ void fp_gemm_gu(const Ptrs& P, LAS unsigned char* lds) {
    g8::Geo g{1024, 1024, 128, 128, 0};
    g8::SchedMoe S{(const char*)WSP(unsigned char, WS_X1Q), (const char*)WSP(unsigned char, WS_WGU), WSP(int, WS_EOFF), WSP(int, WS_ROWTOK), 1024, 2, 8, (size_t)512 * 1024, 1024, 1, WSP(int, WS_TILEE)};
    g8::EpiGU E{WSP(bf16_t, WS_H), WSP(float, WS_ROWW), WSP(int, WS_EOFF)};
    g8::gemm_body<g8::EpiGU, g8::SchedMoe, true, 1>(lds, g, S, E);
}
__device__ __forceinline__ void fp_gemm_down(const Ptrs& P, LAS unsigned char* lds) {
    g8::Geo g{256, 256, 128, 128, 0};
    g8::SchedMoe S{(const char*)WSP(unsigned char, WS_H), (const char*)WSP(unsigned char, WS_WD), WSP(int, WS_EOFF), WSP(int, WS_ROWTOK), 256, 4, 2, (size_t)1024 * 256, 256, 0, WSP(int, WS_TILEE)};
    g8::EpiDown E{WSP(unsigned char, WS_YSLOT), WSP(unsigned char, WS_SHSLOT), WSP(int, WS_ROWTOK), WSP(int, WS_EOFF), lds + LDS_XTRA};
    g8::gemm_body<g8::EpiDown, g8::SchedMoe, false, 1>(lds, g, S, E);
}
namespace at8 {
typedef short s16x4 __attribute__((ext_vector_type(4)));
typedef short v4i16_t __attribute__((ext_vector_type(4)));
constexpr int KSLOT = 12288, VSLOT = 8192, NSLOT = 3;
constexpr int L_K = 0, L_V = NSLOT * KSLOT, L_WS = L_V + NSLOT * VSLOT, L_OST = L_WS + 8 * 256, L_END = L_OST + 8 * 4096;
__device__ __forceinline__ int crow(int r, int hi) { return (r & 3) + 8 * (r >> 2) + 4 * hi; }
__device__ __forceinline__ void glds16(const void* gsrc, LAS unsigned char* dst) { __builtin_amdgcn_global_load_lds((const unsigned*)gsrc, (LAS unsigned*)dst, 16, 0, 0); }
__device__ __forceinline__ s16x4 vtr(const LAS unsigned char* p) { return __builtin_bit_cast(s16x4, __builtin_amdgcn_ds_read_tr16_b64_v4i16((LAS v4i16_t*)p)); }
__device__ __forceinline__ unsigned cvtpk(float lo, float hi) { return (unsigned)f2bf(lo) | ((unsigned)f2bf(hi) << 16); }

__device__ __forceinline__ void attn_unit(int b, int h, int qb, const bf16_t* __restrict__ Q, const bf16_t* __restrict__ Kc, const bf16_t* __restrict__ V, bf16_t* __restrict__ AS, LAS unsigned char* lds) {
    const int tid = opaque_tid(), lane = tid & 63, r32 = lane & 31, hi = lane >> 5;
    const int wid = __builtin_amdgcn_readfirstlane(tid >> 6);
    const size_t bh = (size_t)b * NH + h;
    const bf16_t* Kbh = Kc + bh * SEQ * QKD; const bf16_t* Vbh = V + bh * SEQ * VD;
    const int q0 = qb * 256 + wid * 32;
    const int NT = 4 * (qb + 1);
    const int myNT = 4 * qb + (wid >> 1) + 1;
    const bf16_t* ksrc0 = Kbh + (size_t)lane * QKD + wid * 8;
    const bf16_t* ksrc1 = Kbh + (size_t)lane * QKD + (8 + (wid & 3)) * 8;
    const bf16_t* vsrc = Vbh + (size_t)(16 * (wid & 3) + (lane >> 2)) * VD + (wid >> 2) * 32 + (lane & 3) * 8;
#define AT_DMA(t, slot) do { glds16(ksrc0 + (size_t)(t) * 64 * QKD, lds + L_K + (slot) * KSLOT + wid * 1024); \
                             glds16(ksrc1 + (size_t)(t) * 64 * QKD, lds + L_K + (slot) * KSLOT + (8 + (wid & 3)) * 1024); \
                             glds16(vsrc + (size_t)(t) * 64 * VD, lds + L_V + (slot) * VSLOT + wid * 1024); } while (0)
    AT_DMA(0, 0);
    if (NT > 1) AT_DMA(1, 1);
    bf16x8 qr[6];
    const bf16_t* qp = Q + (bh * SEQ + q0 + r32) * QKD + hi * 8;
#pragma unroll
    for (int ks = 0; ks < 6; ++ks) qr[ks] = *(const bf16x8*)(qp + ks * 16);
    f32x16 o0, o1;
#pragma unroll
    for (int i = 0; i < 16; ++i) { o0[i] = 0.f; o1[i] = 0.f; }
    float m_run = -1e30f, l_run = 0.f;
    LAS float* wsf = (LAS float*)(lds + L_WS) + wid * 64;
    const LAS unsigned char* kp0 = lds + L_K + hi * 1024 + r32 * 16;
    const LAS unsigned char* vp0 = lds + L_V + ((lane >> 4) & 1) * 32 + (lane & 3) * 8 + (4 * hi + ((lane & 15) >> 2)) * 64;
    int slot = 0;
    for (int t = 0; t < NT; ++t) {
        if (t + 1 < NT) asm volatile("s_waitcnt vmcnt(3)" ::: "memory"); else asm volatile("s_waitcnt vmcnt(0)" ::: "memory");
        asm volatile("s_waitcnt lgkmcnt(0)\n\ts_barrier" ::: "memory");
        if (t + 2 < NT) { const int s2 = (slot == 0) ? 2 : slot - 1; AT_DMA(t + 2, s2); }
        if (t < myNT) {
            const LAS unsigned char* kp = kp0 + slot * KSLOT; const LAS unsigned char* vp = vp0 + slot * VSLOT;
            f32x16 p0, p1;
#pragma unroll
            for (int i = 0; i < 16; ++i) { p0[i] = 0.f; p1[i] = 0.f; }
#pragma unroll
            for (int ks = 0; ks < 6; ++ks) {
                const bf16x8 a0 = *(const LAS bf16x8*)(kp + ks * 2048), a1 = *(const LAS bf16x8*)(kp + ks * 2048 + 512);
                p0 = __builtin_amdgcn_mfma_f32_32x32x16_bf16(a0, qr[ks], p0, 0, 0, 0);
                p1 = __builtin_amdgcn_mfma_f32_32x32x16_bf16(a1, qr[ks], p1, 0, 0, 0);
            }
            float rm = fmaxf(p0[0], p1[0]);
#pragma unroll
            for (int i = 1; i < 16; ++i) rm = fmaxf(rm, fmaxf(p0[i], p1[i]));
            { auto rr = __builtin_amdgcn_permlane32_swap(__float_as_uint(rm), __float_as_uint(rm), false, false); rm = fmaxf(__uint_as_float(rr[0]), __uint_as_float(rr[1])); }
            if (__any(rm > m_run + 8.0f)) {
                const float m_new = fmaxf(m_run, rm);
                const float alpha = __builtin_amdgcn_exp2f(m_run - m_new);
                l_run *= alpha; m_run = m_new;
                if (hi == 0) wsf[r32] = alpha;
                asm volatile("s_waitcnt lgkmcnt(0)" ::: "memory");
#pragma unroll
                for (int i = 0; i < 16; ++i) { const float a = wsf[crow(i, hi)]; o0[i] *= a; o1[i] *= a; }
            }
            float ls = 0.f;
#pragma unroll
            for (int i = 0; i < 16; ++i) { p0[i] = __builtin_amdgcn_exp2f(p0[i] - m_run); p1[i] = __builtin_amdgcn_exp2f(p1[i] - m_run); ls += p0[i] + p1[i]; }
            l_run += ls;
            u32x4 w0, w1, w2, w3;
            w0 = (u32x4){cvtpk(p0[0], p0[1]), cvtpk(p0[2], p0[3]), cvtpk(p0[4], p0[5]), cvtpk(p0[6], p0[7])};
            w1 = (u32x4){cvtpk(p0[8], p0[9]), cvtpk(p0[10], p0[11]), cvtpk(p0[12], p0[13]), cvtpk(p0[14], p0[15])};
            w2 = (u32x4){cvtpk(p1[0], p1[1]), cvtpk(p1[2], p1[3]), cvtpk(p1[4], p1[5]), cvtpk(p1[6], p1[7])};
            w3 = (u32x4){cvtpk(p1[8], p1[9]), cvtpk(p1[10], p1[11]), cvtpk(p1[12], p1[13]), cvtpk(p1[14], p1[15])};
            const bf16x8 pa[4] = {__builtin_bit_cast(bf16x8, w0), __builtin_bit_cast(bf16x8, w1), __builtin_bit_cast(bf16x8, w2), __builtin_bit_cast(bf16x8, w3)};
#pragma unroll
            for (int k = 0; k < 4; ++k) {
                const s16x4 l0 = vtr(vp + k * 1024), h0 = vtr(vp + k * 1024 + 512), l1 = vtr(vp + 4096 + k * 1024), h1 = vtr(vp + 4096 + k * 1024 + 512);
                const bf16x8 v0 = (bf16x8){l0[0], l0[1], l0[2], l0[3], h0[0], h0[1], h0[2], h0[3]};
                const bf16x8 v1 = (bf16x8){l1[0], l1[1], l1[2], l1[3], h1[0], h1[1], h1[2], h1[3]};
                o0 = __builtin_amdgcn_mfma_f32_32x32x16_bf16(pa[k], v0, o0, 0, 0, 0);
                o1 = __builtin_amdgcn_mfma_f32_32x32x16_bf16(pa[k], v1, o1, 0, 0, 0);
            }
        }
        slot = (slot == 2) ? 0 : slot + 1;
    }
    { auto rr = __builtin_amdgcn_permlane32_swap(__float_as_uint(l_run), __float_as_uint(l_run), false, false); l_run = __uint_as_float(rr[0]) + __uint_as_float(rr[1]); }
    if (hi == 0) wsf[32 + r32] = l_run;
    asm volatile("s_waitcnt lgkmcnt(0)" ::: "memory");
    LAS bf16_t* stg = (LAS bf16_t*)(lds + L_OST) + wid * 2048;
#pragma unroll
    for (int i = 0; i < 16; ++i) { const int orow = crow(i, hi); const float rl = 1.0f / wsf[32 + orow];
        stg[orow * 64 + r32] = f2bf(o0[i] * rl); stg[orow * 64 + 32 + r32] = f2bf(o1[i] * rl); }
    asm volatile("s_waitcnt lgkmcnt(0)" ::: "memory");
    bf16_t* Ow = AS + ((size_t)b * SEQ + q0) * 1024 + h * 64;
#pragma unroll
    for (int i = 0; i < 4; ++i) { const int row = i * 8 + (lane >> 3), ch = lane & 7; const u32x4 v = *(const LAS u32x4*)(stg + row * 64 + ch * 8); *(u32x4*)(Ow + (size_t)row * 1024 + ch * 8) = v; }
    asm volatile("s_waitcnt lgkmcnt(0)\n\ts_barrier" ::: "memory");
#undef AT_DMA
}
__device__ __forceinline__ void attn_phase(const Ptrs& P, LAS unsigned char* lds, int bid, int nb) {
    const bf16_t* Q = WSP(bf16_t, WS_Q); const bf16_t* Kc = WSP(bf16_t, WS_K); const bf16_t* V = WSP(bf16_t, WS_V); bf16_t* AS = WSP(bf16_t, WS_AS);
    const int vcu = ((nb & 7) == 0) ? (bid & 7) * (nb >> 3) + (bid >> 3) : bid;
    for (int p = vcu; p < 512; p += nb) {
        const int bh = p >> 2, s = p & 3;
        attn_unit(bh >> 3, bh & 7, 7 - s, Q, Kc, V, AS, lds);
        attn_unit(bh >> 3, bh & 7, s, Q, Kc, V, AS, lds);
    }
}
}
__global__ void __launch_bounds__(NTHR, 2) mega(Args a) {
    extern __shared__ __attribute__((aligned(16))) unsigned char lds_raw[];
    LAS unsigned char* lds = (LAS unsigned char*)lds_raw;
    Ptrs P;
    P.x = (const float*)a.in[0]; P.positions = (const int*)a.in[1]; P.ln_in_g = (const float*)a.in[2]; P.ln_in_b = (const float*)a.in[3];
    P.w_in = (const float*)a.in[4]; P.q_norm_g = (const float*)a.in[5]; P.kv_norm_g = (const float*)a.in[6]; P.w_uq = (const float*)a.in[7]; P.w_ukv = (const float*)a.in[8];
    P.lambda_re = (const float*)a.in[9]; P.lambda_im = (const float*)a.in[10]; P.log_step = (const float*)a.in[11]; P.b_re = (const float*)a.in[12]; P.b_im = (const float*)a.in[13];
    P.c_re = (const float*)a.in[14]; P.c_im = (const float*)a.in[15]; P.d_skip = (const float*)a.in[16]; P.w_glu = (const float*)a.in[17]; P.b_glu = (const float*)a.in[18];
    P.attn_out_g = (const float*)a.in[19]; P.ssm_out_g = (const float*)a.in[20]; P.w_o = (const float*)a.in[21]; P.ln1_g = (const float*)a.in[22]; P.ln1_b = (const float*)a.in[23];
    P.w_router = (const float*)a.in[24]; P.router_bias = (const float*)a.in[25]; P.w_gate = (const float*)a.in[26]; P.w_up = (const float*)a.in[27]; P.w_down = (const float*)a.in[28];
    P.ws_gate = (const float*)a.in[29]; P.ws_up = (const float*)a.in[30]; P.ws_down = (const float*)a.in[31]; P.ln2_g = (const float*)a.in[32]; P.ln2_b = (const float*)a.in[33];
    P.out = a.out; P.ws = a.ws;
    const int bid = blockIdx.x, nb = gridDim.x;
    volatile LAS unsigned* misc = (volatile LAS unsigned*)(lds + LDS_MISC);
    if (threadIdx.x < 64) misc[threadIdx.x] = 0u;
    __syncthreads();
    XcdBarrier bar = xcd_barrier_post((unsigned*)(P.ws + WS_CTL) + 4096, misc);
#define GRID_BAR() xcd_barrier(bar)

    ph_ln_in(P, bid, nb); ph_wprep(P, lds, bid, nb); ph_s5tab1(P, bid, nb); ph_ropetab(P, bid, nb);
    GRID_BAR();
    ph_s5tab2(P, lds, bid, nb);
#if FAST_WIN
    fp_gemm_win(P, lds);
    GRID_BAR();
#else
    ph_gemm_win(P, bid, nb);
    GRID_BAR();
    ph_rstat(P, bid, nb);
    GRID_BAR();
#endif
#if FAST_QKV
    fp_gemm_q(P, lds); fp_gemm_kv(P, lds);
#else
    ph_gemm_q(P, bid, nb); ph_gemm_kv(P, bid, nb);
#endif
#if FAST_S5
    fp_gemm_s5b(P, lds); fp_gemm_s5a(P, lds);
#else
    ph_gemm_s5b(P, bid, nb); ph_gemm_s5a(P, bid, nb);
#endif
    GRID_BAR();
#if !FAST_QKV || !FAST_WIN
    ph_rope_apply(P, bid, nb);
#endif
    ph_s5scan(P, bid, nb);
#if !FAST_QKV || !FAST_WIN
    GRID_BAR();
#endif
#if FAST_ATTN
    at8::attn_phase(P, lds, bid, nb);
#else
    ph_attn_simple(P, lds, bid, nb);
#endif
    GRID_BAR();
#if FAST_S5
    fp_gemm_s5d(P, lds);
#else
    ph_gemm_s5d(P, bid, nb);
#endif
    GRID_BAR();
#if FAST_GLU
    fp_gemm_glu(P, lds);
#else
    ph_gemm_glu(P, bid, nb);
#endif
    GRID_BAR();
    ph_asnorm(P, bid, nb);
    GRID_BAR();
#if FAST_WO
    fp_gemm_wo(P, lds);
#else
    ph_gemm_wo(P, bid, nb);
#endif
    GRID_BAR();
    ph_ln1(P, bid, nb);
    GRID_BAR();
    fp_gemm_router(P, lds);
    GRID_BAR();
    ph_topk_cnt(P, lds, bid, nb);
    GRID_BAR();
    ph_lists2(P, lds, bid, nb);
    GRID_BAR();
#if FAST_MOE
    fp_gemm_gu(P, lds);
    GRID_BAR();
    fp_gemm_down(P, lds);
#else
    ph_gemm_gu(P, bid, nb);
    GRID_BAR();
    ph_gemm_down(P, bid, nb);
#endif
    GRID_BAR();
    ph_combine(P, bid, nb);
}

extern "C" void kernel_launch(void* const* d_in, const int* in_sizes, int n_in, void* d_out, int out_size, void* d_ws, size_t ws_size, hipStream_t stream) {
    (void)in_sizes; (void)out_size;
    if (ws_size < WS_NEED || n_in != 34) return;
    static int grid = 0;
    if (grid == 0) {
        int dev = 0, cus = 0;
        if (hipGetDevice(&dev) != hipSuccess || hipDeviceGetAttribute(&cus, hipDeviceAttributeMultiprocessorCount, dev) != hipSuccess) { grid = -1; return; }
        if (hipFuncSetAttribute((const void*)mega, hipFuncAttributeMaxDynamicSharedMemorySize, LDS_BYTES) != hipSuccess) { grid = -1; return; }
        int per_cu = 0;
        if (hipOccupancyMaxActiveBlocksPerMultiprocessor(&per_cu, (const void*)mega, NTHR, LDS_BYTES) != hipSuccess || per_cu < 1) { (void)hipGetLastError(); }
        grid = cus;
    }
    if (grid < 0) return;
    (void)hipMemsetAsync((char*)d_ws + WS_CTL, 0, 1 << 20, stream);
    Args a; memset(&a, 0, sizeof(a));
    for (int i = 0; i < 34; ++i) a.in[i] = d_in[i];
    a.out = (float*)d_out; a.ws = (unsigned char*)d_ws;
    hipLaunchKernelGGL(mega, dim3(grid), dim3(NTHR), LDS_BYTES, stream, a);
}
```

```cpp
#include <hip/hip_runtime.h>
#include <stdint.h>
#include <string.h>

typedef unsigned short bf16_t;
typedef short bf16x8 __attribute__((ext_vector_type(8)));
typedef float f32x16 __attribute__((ext_vector_type(16)));
typedef float f32x4 __attribute__((ext_vector_type(4)));
typedef unsigned u32x4 __attribute__((ext_vector_type(4)));
typedef unsigned u32x2 __attribute__((ext_vector_type(2)));
typedef float f32x2 __attribute__((ext_vector_type(2)));

#ifndef FAST_WIN
#define FAST_WIN 1
#endif
#ifndef FAST_QKV
#define FAST_QKV 1
#endif
#ifndef FAST_S5
#define FAST_S5 1
#endif
#ifndef FAST_GLU
#define FAST_GLU 1
#endif
#ifndef FAST_WO
#define FAST_WO 1
#endif
#ifndef FAST_ATTN
#define FAST_ATTN 1
#endif
#ifndef FAST_MOE
#define FAST_MOE 1
#endif
constexpr int T = 32768, D = 1024, SEQ = 2048, NB = 16;
constexpr int NH = 8, QKD = 96, VD = 64;
constexpr int QRANK = 256, KVRANK = 128, ROPE = 32;
constexpr int SSMW = 512, SG = 32, SC = 16, SP = 64, CH = 64, NCH = SEQ / CH;
constexpr int NE = 64, TOPK = 8, FF = 256;
constexpr float ALPHA = 1.189207115002721f;
constexpr float EPS = 1e-5f;
constexpr float QSCALE = 0.10206207261596577f * 1.4426950408889634f;
constexpr float SLOT_SCALE = 16.0f;
constexpr float XQ_SCALE = 16.0f, WQ_SCALE = 256.0f, HQ_SCALE = 8.0f;
constexpr int RROUT = 278528;
constexpr int SH_ROW0 = RROUT;
constexpr int RTOT = RROUT + T;

constexpr size_t MiB = 1ull << 20;
constexpr size_t WS_CTL = 0;
constexpr size_t WS_TOPI = 1 * MiB, WS_TOPW = 2 * MiB, WS_ROWTOK = 3 * MiB, WS_ROWW = 4 * MiB + MiB / 2;
constexpr size_t WS_CNT = 6 * MiB, WS_TOFF = 6 * MiB + 65536, WS_EOFF = 6 * MiB + 131072, WS_ECNT = 6 * MiB + 131072 + 1024;
constexpr size_t WS_TILEE = 6 * MiB + 262144;
constexpr size_t WS_WD = 7 * MiB;
constexpr size_t WS_X1 = 40 * MiB;
constexpr size_t WS_XN = WS_X1, WS_AS = WS_X1;
constexpr size_t WS_H = 104 * MiB;
constexpr size_t WS_CQ = 104 * MiB, WS_CKV = 120 * MiB, WS_U = 136 * MiB, WS_YINTRA = 168 * MiB, WS_Y = 200 * MiB;
constexpr size_t WS_QRRAW = 200 * MiB;
constexpr size_t WS_XLOC = 232 * MiB, WS_XPREV = 240 * MiB, WS_LOGITS = 248 * MiB, WS_KRRAW = 248 * MiB;
constexpr size_t WS_X1LO = 104 * MiB;
constexpr size_t WS_YSLOT = 180 * MiB;
constexpr size_t WS_INVROW = 4 * MiB + MiB / 2;
constexpr size_t WS_WGU = 256 * MiB;
constexpr size_t WS_WIN = 321 * MiB, WS_WO = 323 * MiB, WS_WUQ = 325 * MiB, WS_WUKV = 325 * MiB + MiB / 2, WS_WGLU = 326 * MiB;
constexpr size_t WS_WR = 326 * MiB + MiB / 2;
constexpr size_t WS_BLOC = 327 * MiB, WS_CLAM = 343 * MiB, WS_KTAB = 359 * MiB, WS_LAMPOW = 361 * MiB, WS_BBAR = 363 * MiB;
constexpr size_t WS_ROPE = 364 * MiB, WS_XSTAT = 368 * MiB, WS_RSQ = 368 * MiB + MiB / 2, WS_RSKV = 369 * MiB;
constexpr size_t WS_Q = 370 * MiB, WS_K = 418 * MiB, WS_V = 466 * MiB;
constexpr size_t WS_LAMPOWT = 498 * MiB;
constexpr size_t WS_X1Q = 370 * MiB;
constexpr size_t WS_SHSLOT = 452 * MiB;
constexpr size_t WS_SSA = 499 * MiB + MiB / 2, WS_SSS = 501 * MiB;
constexpr size_t WS_NEED = 512 * MiB;

typedef __bf16 bf16x2_hw __attribute__((ext_vector_type(2)));
__device__ __forceinline__ unsigned pk_bf16_hw(float lo, float hi) { const f32x2 v = {lo, hi}; const bf16x2_hw b = __builtin_convertvector(v, bf16x2_hw); return __builtin_bit_cast(unsigned, b); }
__device__ __forceinline__ bf16_t f2bf(float f) { return (bf16_t)(pk_bf16_hw(f, 0.f) & 0xffffu); }
__device__ __forceinline__ float bf2f(bf16_t b) { return __uint_as_float(((unsigned)b) << 16); }
__device__ __forceinline__ int crow(int i, int h) { return (i & 3) + 8 * (i >> 2) + 4 * h; }
__device__ __forceinline__ float wave_sum(float v) {
#pragma unroll
    for (int o = 32; o > 0; o >>= 1) v += __shfl_xor(v, o);
    return v;
}
__device__ __forceinline__ float wave_max(float v) {
#pragma unroll
    for (int o = 32; o > 0; o >>= 1) v = fmaxf(v, __shfl_xor(v, o));
    return v;
}
__device__ __forceinline__ float sigmoidf_(float z) { return 1.0f / (1.0f + __expf(-z)); }
__device__ __forceinline__ float gelu_tanh(float y) {
    const float z = 0.7978845608028654f * (y + 0.044715f * y * y * y);
    const float th = 1.0f - 2.0f / (1.0f + __expf(2.0f * z));
    return 0.5f * y * (1.0f + th);
}
__host__ __device__ __forceinline__ int ropeperm(int q) { return 16 * ((q >> 2) & 1) + 4 * (q >> 3) + (q & 3); }
__host__ __device__ __forceinline__ int ropepos(int j) { const int n = j >> 4, r = j & 15; return 8 * (r >> 2) + 4 * n + (r & 3); }

__device__ __forceinline__ void cexp_d(double re, double im, double& ore, double& oim) {
    const double s = 1.0 / 1048576.0;
    const double a = re * s, b = im * s;
    double tr = 1.0, ti = 0.0, sr = 1.0, si = 0.0;
#pragma unroll
    for (int n = 1; n <= 8; ++n) {
        const double nr = (tr * a - ti * b) / n, ni = (tr * b + ti * a) / n;
        tr = nr; ti = ni; sr += tr; si += ti;
    }
#pragma unroll
    for (int i = 0; i < 20; ++i) { const double nr = sr * sr - si * si, ni = 2.0 * sr * si; sr = nr; si = ni; }
    ore = sr; oim = si;
}

__device__ __forceinline__ int opaque_tid() { int t = threadIdx.x; asm volatile("" : "+v"(t)); return t; }
template <bool DUAL, class AF, class BF, class EPI>
__device__ __forceinline__ void sg_tile(int m0, int n0, int K, AF arow, BF bptr, EPI epi) {
    const int tidx = opaque_tid();
    const int lane = tidx & 63, r = lane & 31, h = lane >> 5;
    f32x16 acc, acc2;
#pragma unroll
    for (int i = 0; i < 16; ++i) { acc[i] = 0.f; acc2[i] = 0.f; }
    const bf16_t* ap = arow(m0 + r);
    for (int k0 = 0; k0 < K; k0 += 16) {
        const bf16x8 a = *(const bf16x8*)(ap + k0 + 8 * h);
        const bf16x8 b = *(const bf16x8*)(bptr(n0 + r, k0 + 8 * h, 0));
        acc = __builtin_amdgcn_mfma_f32_32x32x16_bf16(a, b, acc, 0, 0, 0);
        if (DUAL) {
            const bf16x8 b2 = *(const bf16x8*)(bptr(n0 + r, k0 + 8 * h, 1));
            acc2 = __builtin_amdgcn_mfma_f32_32x32x16_bf16(a, b2, acc2, 0, 0, 0);
        }
    }
#pragma unroll
    for (int i = 0; i < 16; ++i) epi(m0 + crow(i, h), n0 + r, acc[i], acc2[i]);
}

#define LAS __attribute__((address_space(3)))
#define XB_TMO      128
#define XB_XCNT(j)  (256  + 64 * (j))
#define XB_XSUB(j)  (1280 + 64 * (j))
#define XB_XGEN(j)  (2304 + 64 * (j))
#define XB_TOP      3328
#define XB_TOPGEN   3392
#define XCD_BAR_WORDS 3456
#define XB_SPIN_CAP (1u << 18)
__device__ __forceinline__ unsigned xb_ld(unsigned* p)              { return __hip_atomic_load(p, __ATOMIC_RELAXED, __HIP_MEMORY_SCOPE_AGENT); }
__device__ __forceinline__ unsigned xb_add(unsigned* p, unsigned v) { return __hip_atomic_fetch_add(p, v, __ATOMIC_RELAXED, __HIP_MEMORY_SCOPE_AGENT); }
__device__ __forceinline__ unsigned xb_xcc_id() { return (unsigned)__builtin_amdgcn_s_getreg((3 << 11) | 20) & 0xFu; }
#define XB_SPIN(cond, bar) do { unsigned _sp = 0; while (cond) { __builtin_amdgcn_s_sleep(1); \
    if ((++_sp & 255u) == 0u) { if (xb_ld(&(bar)[XB_TMO])) break; if (_sp > XB_SPIN_CAP) { atomicAdd(&(bar)[XB_TMO], 1u); break; } } } } while (0)
struct XcdBarrier { unsigned* bar; unsigned x; volatile LAS unsigned* st; };
__device__ __forceinline__ XcdBarrier xcd_barrier_post(unsigned* bar, volatile LAS unsigned* st) {
    XcdBarrier b; b.bar = bar; b.x = xb_xcc_id(); b.st = st;
    if (threadIdx.x == 0) (void)xb_add(&bar[XB_XCNT(b.x)], 1u);
    return b;
}
__device__ __forceinline__ void xcd_barrier_complete(unsigned* bar, unsigned x, unsigned& nloc, unsigned& nx) {
    const unsigned G = gridDim.x * gridDim.y * gridDim.z;
    unsigned sum, cnt, mine, sp = 0u;
    for (;;) {
        sum = 0u; cnt = 0u; mine = 0u;
#pragma unroll
        for (unsigned j = 0; j < 16; ++j) { const unsigned c = xb_ld(&bar[XB_XCNT(j)]); sum += c; cnt += (c > 0u) ? 1u : 0u; mine = (j == x) ? c : mine; }
        if (sum == G) break;
        __builtin_amdgcn_s_sleep(1);
        if ((++sp & 255u) == 0u) { if (xb_ld(&bar[XB_TMO])) break; if (sp > XB_SPIN_CAP) { atomicAdd(&bar[XB_TMO], 1u); break; } }
    }
    nloc = mine > 0u ? mine : 1u; nx = cnt > 0u ? cnt : 1u;
}
__device__ __forceinline__ void xcd_barrier(const XcdBarrier& b) {
    asm volatile("s_waitcnt vmcnt(0)" ::: "memory");
    __syncthreads();
    if (threadIdx.x == 0) {
        unsigned* bar = b.bar;
        __builtin_amdgcn_s_waitcnt(0);
        unsigned nloc = b.st[0], nx = b.st[1];
        if (nloc == 0u) { xcd_barrier_complete(bar, b.x, nloc, nx); b.st[0] = nloc; b.st[1] = nx; }
        const unsigned old = xb_add(&bar[XB_XSUB(b.x)], 1u);
        const unsigned gen = old / nloc;
        if (old + 1u == (gen + 1u) * nloc) {
            __builtin_amdgcn_fence(__ATOMIC_RELEASE, "agent");
            asm volatile("s_waitcnt vmcnt(0)" ::: "memory");
            const unsigned og = xb_add(&bar[XB_TOP], 1u);
            const unsigned tg = og / nx;
            if (og + 1u == (tg + 1u) * nx) xb_add(&bar[XB_TOPGEN], 1u);
            else XB_SPIN(xb_ld(&bar[XB_TOPGEN]) == tg, bar);
            __builtin_amdgcn_fence(__ATOMIC_ACQUIRE, "agent");
            xb_add(&bar[XB_XGEN(b.x)], 1u);
            asm volatile("s_waitcnt vmcnt(0)" ::: "memory");
        } else {
            XB_SPIN(xb_ld(&bar[XB_XGEN(b.x)]) == gen, bar);
            __builtin_amdgcn_fence(__ATOMIC_ACQUIRE, "agent");
            asm volatile("s_waitcnt vmcnt(0)" ::: "memory");
        }
    }
    __syncthreads();
}

constexpr int NTHR = 512, NWAVE = 8;
constexpr int LDS_BYTES = 163840;
constexpr int LDS_MISC = 163840 - 256;
constexpr int LDS_XTRA = 131072;
struct Args { const void* in[34]; float* out; unsigned char* ws; };
struct Ptrs {
    const float *x, *ln_in_g, *ln_in_b, *w_in, *q_norm_g, *kv_norm_g, *w_uq, *w_ukv, *lambda_re, *lambda_im, *log_step, *b_re, *b_im, *c_re, *c_im, *d_skip, *w_glu, *b_glu;
    const float *attn_out_g, *ssm_out_g, *w_o, *ln1_g, *ln1_b, *w_router, *router_bias, *w_gate, *w_up, *w_down, *ws_gate, *ws_up, *ws_down, *ln2_g, *ln2_b;
    const int* positions; float* out; unsigned char* ws;
};
#define WSP(T_, off) ((T_*)(P.ws + (off)))

__device__ __forceinline__ void ph_ln_in(const Ptrs& P, int bid, int nb) {
    const int tidx = opaque_tid();
    const int lane = tidx & 63, w = tidx >> 6;
    bf16_t* xn = WSP(bf16_t, WS_XN); float* xstat = WSP(float, WS_XSTAT);
    for (int t0 = (bid * NWAVE + w) * 2; t0 < T; t0 += nb * NWAVE * 2) {
        f32x4 q[2][4];
#pragma unroll
        for (int r = 0; r < 2; ++r)
#pragma unroll
            for (int i = 0; i < 4; ++i) q[r][i] = __builtin_nontemporal_load((const f32x4*)(P.x + (size_t)(t0 + r) * D + i * 256 + lane * 4));
#pragma unroll
        for (int r = 0; r < 2; ++r) {
            const int t = t0 + r;
            float s = 0.f;
#pragma unroll
            for (int i = 0; i < 4; ++i) s += q[r][i][0] + q[r][i][1] + q[r][i][2] + q[r][i][3];
            const float mu = wave_sum(s) * (1.0f / D);
            float ss = 0.f;
#pragma unroll
            for (int i = 0; i < 4; ++i)
#pragma unroll
                for (int e = 0; e < 4; ++e) { const float d = q[r][i][e] - mu; ss += d * d; }
            const float rstd = rsqrtf(wave_sum(ss) * (1.0f / D) + EPS);
            if (lane == 0) { xstat[2 * t] = mu; xstat[2 * t + 1] = rstd; }
#pragma unroll
            for (int i = 0; i < 4; ++i) {
                const int c = i * 256 + lane * 4;
                const f32x4 gg = *(const f32x4*)(P.ln_in_g + c), bb = *(const f32x4*)(P.ln_in_b + c);
                ushort4 o;
                o.x = f2bf((q[r][i][0] - mu) * rstd * gg[0] + bb[0]); o.y = f2bf((q[r][i][1] - mu) * rstd * gg[1] + bb[1]);
                o.z = f2bf((q[r][i][2] - mu) * rstd * gg[2] + bb[2]); o.w = f2bf((q[r][i][3] - mu) * rstd * gg[3] + bb[3]);
                *(ushort4*)(xn + (size_t)t * D + c) = o;
            }
        }
    }
}
__device__ __forceinline__ int wprep_srccol(int mode, int n, int& which) {
    which = 0;
    switch (mode) {
    case 0: if (n < 256) return n; if (n < 768) return 416 + (n - 256); if (n < 896) return 256 + (n - 768); if (n < 928) return 384 + ropeperm(n - 896); return -1;
    case 1: if (n < 512) return (n >> 6) * 96 + (n & 63); { const int m = n - 512; return (m >> 5) * 96 + 64 + ropeperm(m & 31); }
    case 2: if (n < 512) return (n >> 6) * 128 + (n & 63); { const int m = n - 512; return (m >> 6) * 128 + 64 + (m & 63); }
    case 5: { const int pn = n >> 8, w = n & 255; which = w >> 7; return pn * 128 + (w & 127); }
    case 7: return n < 64 ? n : -1;
    default: return n;
    }
}
__device__ __forceinline__ void wprep_tile(LAS float* tile  , const float* s1, const float* s2, const float* ks, const float* ks2, bf16_t* dst,
                                           int mode, int Kd, int ldsrc, int Ksrc, float kmul, int n0, int k0) {
    const int tidx = opaque_tid();
    const int nn = tidx & 63, w = tidx >> 6;
    {
        int which; const int sc = wprep_srccol(mode, n0 + nn, which);
        const float* s = which ? s2 : s1;
        float v[32];
#pragma unroll
        for (int i = 0; i < 32; ++i) { const int k = k0 + w + 8 * i; v[i] = (sc >= 0 && k < Ksrc) ? __builtin_nontemporal_load(s + (size_t)k * ldsrc + sc) : 0.f; }
#pragma unroll
        for (int i = 0; i < 32; ++i) { const int kk = w + 8 * i, k = k0 + kk; float x = v[i];
            if (ks && k < Ksrc) x *= (ks2 && k >= 512) ? ks2[k - 512] : ks[k];
            tile[kk * 65 + nn] = x * kmul; }
    }
    __syncthreads();
#pragma unroll
    for (int i = 0; i < 4; ++i) {
        const int kb = (i * 8 + w) * 8;
        u32x4 o;
#pragma unroll
        for (int j = 0; j < 4; ++j) o[j] = (unsigned)f2bf(tile[(kb + 2 * j) * 65 + nn]) | ((unsigned)f2bf(tile[(kb + 2 * j + 1) * 65 + nn]) << 16);
        *(u32x4*)(dst + (size_t)(n0 + nn) * Kd + k0 + kb) = o;
    }
    __syncthreads();
}
__device__ __forceinline__ void wprep_tile_fp8(const float* s1, const float* s2, unsigned char* dst, int mode, int Kd, int ldsrc, float kmul, int n0, int k0) {
    const int tidx = opaque_tid();
    const int nn = tidx & 63, w = tidx >> 6;
    int which; const int sc = wprep_srccol(mode, n0 + nn, which);
    const float* s = which ? s2 : s1;
    float v[2][16];
#pragma unroll
    for (int i = 0; i < 2; ++i)
#pragma unroll
        for (int j = 0; j < 16; ++j) { const int k = k0 + (i * 8 + w) * 16 + j; v[i][j] = __builtin_nontemporal_load(s + (size_t)k * ldsrc + sc) * kmul; }
#pragma unroll
    for (int i = 0; i < 2; ++i) {
        u32x4 o;
#pragma unroll
        for (int j = 0; j < 4; ++j) { int p = __builtin_amdgcn_cvt_pk_fp8_f32(v[i][4 * j], v[i][4 * j + 1], 0, false); p = __builtin_amdgcn_cvt_pk_fp8_f32(v[i][4 * j + 2], v[i][4 * j + 3], p, true); o[j] = (unsigned)p; }
        *(u32x4*)(dst + (size_t)(n0 + nn) * Kd + k0 + (i * 8 + w) * 16) = o;
    }
}
__device__ __forceinline__ void ph_wprep(const Ptrs& P, LAS unsigned char* lds, int bid, int nb) {
    LAS float* tile = (LAS float*)lds;
    constexpr int J0 = 64, J1 = J0 + 12, J2 = J1 + 16, J3 = J2 + 16, J4 = J3 + 64, J4b = J4 + 16, J5 = J4b + 65 * 32, J6 = J5 + 65 * 16;
    for (int j = bid; j < J6; j += nb) {
        if (j < J0)      { const int tl = j;      wprep_tile(tile, P.w_in, nullptr, nullptr, nullptr, WSP(bf16_t, WS_WIN), 0, 1024, 928, 1024, 1.0f, (tl / 4) * 64, (tl % 4) * 256); }
        else if (j < J1) { const int tl = j - J0; wprep_tile(tile, P.w_uq, nullptr, P.q_norm_g, nullptr, WSP(bf16_t, WS_WUQ), 1, 256, 768, 256, QSCALE, tl * 64, 0); }
        else if (j < J2) { const int tl = j - J1; wprep_tile(tile, P.w_ukv, nullptr, P.kv_norm_g, nullptr, WSP(bf16_t, WS_WUKV), 2, 256, 1024, 128, 1.0f, tl * 64, 0); }
        else if (j < J3) { const int tl = j - J2; wprep_tile(tile, P.w_glu, nullptr, nullptr, nullptr, WSP(bf16_t, WS_WGLU), 3, 512, 512, 512, 1.0f, (tl / 2) * 64, (tl % 2) * 256); }
        else if (j < J4) { const int tl = j - J3; wprep_tile(tile, P.w_o, nullptr, P.attn_out_g, P.ssm_out_g, WSP(bf16_t, WS_WO), 4, 1024, 1024, 1024, 1.0f, (tl / 4) * 64, (tl % 4) * 256); }
        else if (j < J4b) { const int tl = j - J4; wprep_tile(tile, P.w_router, nullptr, nullptr, nullptr, WSP(bf16_t, WS_WR), 7, 1024, 64, 1024, 1.0f, (tl / 4) * 64, (tl % 4) * 256); }
        else if (j < J5) { const int q = j - J4b, e = q / 32, tl = q % 32;
            const float* g = e < 64 ? P.w_gate + (size_t)e * 1024 * 256 : P.ws_gate; const float* u = e < 64 ? P.w_up + (size_t)e * 1024 * 256 : P.ws_up;
            wprep_tile_fp8(g, u, WSP(unsigned char, WS_WGU) + (size_t)e * 512 * 1024, 5, 1024, 256, WQ_SCALE, (tl / 4) * 64, (tl % 4) * 256); }
        else             { const int q = j - J5, e = q / 16, tl = q % 16;
            const float* d = e < 64 ? P.w_down + (size_t)e * 256 * 1024 : P.ws_down;
            wprep_tile_fp8(d, nullptr, WSP(unsigned char, WS_WD) + (size_t)e * 1024 * 256, 6, 256, 1024, WQ_SCALE, tl * 64, 0); }
    }
}
__device__ __forceinline__ void ph_s5tab1(const Ptrs& P, int bid, int nb) {
    const int tidx = opaque_tid();
    float2* lampow = WSP(float2, WS_LAMPOW); float2* lampow_t = WSP(float2, WS_LAMPOWT); float2* bbar = WSP(float2, WS_BBAR);
    for (int i = bid * NTHR + tidx; i < SG * SP * 65 + SG * SP * SC; i += nb * NTHR) {
        const bool isb = i >= SG * SP * 65;
        const int q = isb ? i - SG * SP * 65 : i;
        const int gp = isb ? q >> 4 : q / 65, tau = isb ? 1 : q % 65, g = gp >> 6, p = gp & 63;
        double lr = (double)P.lambda_re[gp]; if (lr > -1e-4) lr = -1e-4;
        const double li = (double)P.lambda_im[gp];
        double st, dummy; cexp_d((double)P.log_step[g], 0.0, st, dummy);
        double br, bi; cexp_d(lr * st * tau, li * st * tau, br, bi);
        if (!isb) {
            const float2 v = make_float2((float)br, (float)bi);
            lampow[gp * 65 + tau] = v; lampow_t[(g * 65 + tau) * 64 + p] = v;
        } else {
            const int c = q & 15;
            const double nr = br - 1.0, ni = bi, den = lr * lr + li * li;
            const double cr = (nr * lr + ni * li) / den, ci = (ni * lr - nr * li) / den;
            const double xr = (double)P.b_re[gp * SC + c], xi = (double)P.b_im[gp * SC + c];
            bbar[gp * SC + c] = make_float2((float)(cr * xr - ci * xi), (float)(cr * xi + ci * xr));
        }
    }
}
__device__ __forceinline__ void ph_s5tab2(const Ptrs& P, LAS unsigned char* lds, int bid, int nb) {
    const int tidx = opaque_tid();
    const float2* lampow = WSP(float2, WS_LAMPOW); const float2* lampow_t = WSP(float2, WS_LAMPOWT); const float2* bbar = WSP(float2, WS_BBAR);
    bf16_t* ktab = WSP(bf16_t, WS_KTAB); bf16_t* bloc = WSP(bf16_t, WS_BLOC); bf16_t* clam = WSP(bf16_t, WS_CLAM);
    const int lane = tidx & 63, w = tidx >> 6;
    LAS f32x2* Cs = (LAS f32x2*)lds;
    LAS f32x2* Bs = Cs + 1024;
    LAS f32x2* Ls = Bs + 1024;
    for (int un = bid; un < SG * 8; un += nb) {
        const int g = un >> 3, tb = (un & 7) * 8;
        __syncthreads();
        for (int i = tidx; i < 1024; i += NTHR) { const int c = i >> 6, p = i & 63; Cs[i] = (f32x2){P.c_re[(g * SC + c) * SP + p], P.c_im[(g * SC + c) * SP + p]}; { const float2 bq = bbar[g * 1024 + i]; Bs[i] = (f32x2){bq.x, bq.y}; } }
        { const int tl = tidx >> 6, p = tidx & 63; { const float2 lq = lampow_t[(g * 65 + tb + tl) * 64 + p]; Ls[tidx] = (f32x2){lq.x, lq.y}; } }
        __syncthreads();
        const int tl = tidx >> 6, c = (tidx >> 2) & 15, c0 = (tidx & 3) * 4;
        float a0 = 0.f, a1 = 0.f, a2 = 0.f, a3 = 0.f;
        for (int p = 0; p < SP; ++p) {
            const f32x2 l = Ls[tl * 64 + p], cc = Cs[c * 64 + p];
            const float kr = cc.x * l.x - cc.y * l.y, ki = cc.x * l.y + cc.y * l.x;
            const f32x2 b0 = Bs[p * 16 + c0], b1 = Bs[p * 16 + c0 + 1], b2 = Bs[p * 16 + c0 + 2], b3 = Bs[p * 16 + c0 + 3];
            a0 += kr * b0.x - ki * b0.y; a1 += kr * b1.x - ki * b1.y; a2 += kr * b2.x - ki * b2.y; a3 += kr * b3.x - ki * b3.y;
        }
        const int tau = tb + tl;
        if (tau == 0) { const float dsk = P.d_skip[g * SC + c]; if (c == c0) a0 += dsk; if (c == c0 + 1) a1 += dsk; if (c == c0 + 2) a2 += dsk; if (c == c0 + 3) a3 += dsk; }
        ushort4 o; o.x = f2bf(a0); o.y = f2bf(a1); o.z = f2bf(a2); o.w = f2bf(a3);
        *(ushort4*)(ktab + (((size_t)g * 127 + 63 + tau) * 16 + c) * 16 + c0) = o;
    }
    for (int i = bid * NTHR + tidx; i < SG * 63 * 32; i += nb * NTHR) { const int g = i / (63 * 32), r = i % (63 * 32); *(u32x4*)(ktab + (size_t)g * 127 * 256 + (size_t)r * 8) = (u32x4){0u, 0u, 0u, 0u}; }
    for (int row = bid * NWAVE + w; row < SG * 256; row += nb * NWAVE) {
        const int g = row >> 8, n = row & 255;
        u32x4 o0 = (u32x4){0u, 0u, 0u, 0u}, o1 = o0;
        if (n < 128) {
            const int p = n & 63;
            const float2 l = lampow[(g * SP + p) * 65 + (63 - lane)];
            float v[16];
#pragma unroll
            for (int c = 0; c < 16; ++c) { const float2 bb = bbar[(g * SP + p) * SC + c]; v[c] = (n < 64) ? (l.x * bb.x - l.y * bb.y) : (l.x * bb.y + l.y * bb.x); }
#pragma unroll
            for (int j = 0; j < 4; ++j) { o0[j] = (unsigned)f2bf(v[2 * j]) | ((unsigned)f2bf(v[2 * j + 1]) << 16); o1[j] = (unsigned)f2bf(v[8 + 2 * j]) | ((unsigned)f2bf(v[9 + 2 * j]) << 16); }
        }
        bf16_t* d = bloc + (size_t)row * 1024 + lane * 16;
        *(u32x4*)d = o0; *(u32x4*)(d + 8) = o1;
    }
    for (int row = bid * NWAVE + w; row < SG * 1024; row += nb * NWAVE) {
        const int g = row >> 10, n = row & 1023, t = n >> 4, c = n & 15;
        ushort4 o; o.x = 0; o.y = 0; o.z = 0; o.w = 0;
        if (lane < 32) {
            const int p0 = (lane & 15) * 4;
            const f32x4 cr = *(const f32x4*)(P.c_re + (g * SC + c) * SP + p0), ci = *(const f32x4*)(P.c_im + (g * SC + c) * SP + p0);
            const float2* lp = lampow_t + (g * 65 + t + 1) * 64 + p0;
            float v[4];
#pragma unroll
            for (int j = 0; j < 4; ++j) { const float2 l = lp[j]; v[j] = (lane < 16) ? (cr[j] * l.x - ci[j] * l.y) : -(cr[j] * l.y + ci[j] * l.x); }
            o.x = f2bf(v[0]); o.y = f2bf(v[1]); o.z = f2bf(v[2]); o.w = f2bf(v[3]);
        }
        *(ushort4*)(clam + (size_t)row * 256 + lane * 4) = o;
    }
}
__device__ __forceinline__ void ph_ropetab(const Ptrs& P, int bid, int nb) {
    const int tidx = opaque_tid();
    float2* rope = WSP(float2, WS_ROPE);
    const double invf[16] = {0.15915494309189535, 0.08949940160889101, 0.050329212104487035, 0.0283021958306234, 0.015915494309189534, 0.008949940160889102, 0.005032921210448704, 0.00283021958306234,
                             0.0015915494309189536, 0.0008949940160889102, 0.0005032921210448703, 0.00028302195830623395, 0.00015915494309189535, 8.949940160889102e-05, 5.0329212104487035e-05, 2.8302195830623396e-05};
    for (int t = bid * NTHR + tidx; t < T; t += nb * NTHR) {
        const double p = (double)P.positions[t];
#pragma unroll
        for (int j = 0; j < 16; ++j) {
            const double rev = p * invf[j];
            const float fr = (float)(rev - __builtin_rint(rev));
            rope[t * 16 + j] = make_float2(__builtin_amdgcn_cosf(fr), __builtin_amdgcn_sinf(fr));
        }
    }
}

#define GW_LOOP(ntiles) for (int tl = bid * NWAVE + (tidx >> 6); tl < (ntiles); tl += nb * NWAVE)
__device__ __forceinline__ void ph_gemm_win(const Ptrs& P, int bid, int nb) {
    const int tidx = opaque_tid();
    const bf16_t* xn = WSP(bf16_t, WS_XN); const bf16_t* wt = WSP(bf16_t, WS_WIN);
    bf16_t* cq = WSP(bf16_t, WS_CQ); bf16_t* ckv = WSP(bf16_t, WS_CKV); bf16_t* u = WSP(bf16_t, WS_U); float* krraw = WSP(float, WS_KRRAW);
    GW_LOOP((T / 32) * 32) {
        const int m0 = (tl >> 5) * 32, n0 = (tl & 31) * 32;
        sg_tile<false>(m0, n0, D,
            [&](int row) { return xn + (size_t)row * D; },
            [&](int n, int k, int) { return wt + (size_t)n * D + k; },
            [&](int t, int n, float v, float) {
                if (n < 256) cq[(size_t)t * 256 + n] = f2bf(v);
                else if (n < 768) {
                    const int ch = n - 256, g = ch >> 4, c = ch & 15, b = t >> 11, s = t & 2047, j = s >> 6, sl = s & 63;
                    u[((size_t)g * 512 + b * 32 + j) * 1024 + sl * 16 + c] = f2bf(v);
                } else if (n < 896) ckv[(size_t)t * 256 + (n - 768)] = f2bf(v);
                else {
                    ckv[(size_t)t * 256 + (n - 768)] = 0;
                    if (n < 928) krraw[(size_t)t * 32 + ropeperm(n - 896)] = v;
                }
            });
    }
}
__device__ __forceinline__ void ph_rstat(const Ptrs& P, int bid, int nb) {
    const int tidx = opaque_tid();
    const bf16_t* cq = WSP(bf16_t, WS_CQ); const bf16_t* ckv = WSP(bf16_t, WS_CKV); float* rsq = WSP(float, WS_RSQ); float* rskv = WSP(float, WS_RSKV);
    const int lane = tidx & 63, w = tidx >> 6;
    for (int t = bid * NWAVE + w; t < T; t += nb * NWAVE) {
        float s = 0.f, s2 = 0.f;
#pragma unroll
        for (int i = 0; i < 4; ++i) { const float v = bf2f(cq[(size_t)t * 256 + i * 64 + lane]); s += v * v; }
#pragma unroll
        for (int i = 0; i < 2; ++i) { const float v = bf2f(ckv[(size_t)t * 256 + i * 64 + lane]); s2 += v * v; }
        s = wave_sum(s); s2 = wave_sum(s2);
        if (lane == 0) { rsq[t] = rsqrtf(s * (1.0f / 256) + EPS); rskv[t] = rsqrtf(s2 * (1.0f / 128) + EPS); }
    }
}
__device__ __forceinline__ void ph_gemm_q(const Ptrs& P, int bid, int nb) {
    const int tidx = opaque_tid();
    const bf16_t* cq = WSP(bf16_t, WS_CQ); const bf16_t* wt = WSP(bf16_t, WS_WUQ); const float* rsq = WSP(float, WS_RSQ); bf16_t* Q = WSP(bf16_t, WS_Q); float* qrraw = WSP(float, WS_QRRAW);
    GW_LOOP((T / 32) * 24) {
        const int m0 = (tl / 24) * 32, n0 = (tl % 24) * 32;
        sg_tile<false>(m0, n0, 256,
            [&](int row) { return cq + (size_t)row * 256; },
            [&](int n, int k, int) { return wt + (size_t)n * 256 + k; },
            [&](int t, int n, float v, float) {
                v *= rsq[t];
                const int b = t >> 11, s = t & 2047;
                if (n < 512) Q[(((size_t)b * NH + (n >> 6)) * SEQ + s) * QKD + (n & 63)] = f2bf(v);
                else { const int m = n - 512; qrraw[(size_t)t * 256 + (m >> 5) * 32 + ropeperm(m & 31)] = v; }
            });
    }
}
__device__ __forceinline__ void ph_gemm_kv(const Ptrs& P, int bid, int nb) {
    const int tidx = opaque_tid();
    const bf16_t* ckv = WSP(bf16_t, WS_CKV); const bf16_t* wt = WSP(bf16_t, WS_WUKV); const float* rskv = WSP(float, WS_RSKV); bf16_t* Kc = WSP(bf16_t, WS_K); bf16_t* V = WSP(bf16_t, WS_V);
    GW_LOOP((T / 32) * 32) {
        const int m0 = (tl >> 5) * 32, n0 = (tl & 31) * 32;
        sg_tile<false>(m0, n0, 256,
            [&](int row) { return ckv + (size_t)row * 256; },
            [&](int n, int k, int) { return wt + (size_t)n * 256 + k; },
            [&](int t, int n, float v, float) {
                v *= rskv[t];
                const int b = t >> 11, s = t & 2047;
                if (n < 512) Kc[(((size_t)b * NH + (n >> 6)) * SEQ + s) * QKD + (n & 63)] = f2bf(v);
                else { const int m = n - 512; V[(((size_t)b * NH + (m >> 6)) * SEQ + s) * VD + (m & 63)] = f2bf(v); }
            });
    }
}
__device__ __forceinline__ void ph_rope_apply(const Ptrs& P, int bid, int nb) {
    const int tidx = opaque_tid();
    const float* qrraw = WSP(float, WS_QRRAW); const float* krraw = WSP(float, WS_KRRAW); const float2* rope = WSP(float2, WS_ROPE); bf16_t* Q = WSP(bf16_t, WS_Q); bf16_t* Kc = WSP(bf16_t, WS_K);
    for (int i = bid * NTHR + tidx; i < T * 9 * 16; i += nb * NTHR) {
        const int j = i & 15, hh = (i >> 4) % 9, t = (i >> 4) / 9;
        const float2 cs = rope[t * 16 + j];
        const int b = t >> 11, s = t & 2047;
        if (hh < 8) {
            const float x1 = qrraw[(size_t)t * 256 + hh * 32 + j], x2 = qrraw[(size_t)t * 256 + hh * 32 + 16 + j];
            bf16_t* q = Q + (((size_t)b * NH + hh) * SEQ + s) * QKD + 64;
            q[j] = f2bf(x1 * cs.x - x2 * cs.y); q[16 + j] = f2bf(x2 * cs.x + x1 * cs.y);
        } else {
            const float x1 = krraw[(size_t)t * 32 + j], x2 = krraw[(size_t)t * 32 + 16 + j];
            const bf16_t o1 = f2bf(x1 * cs.x - x2 * cs.y), o2 = f2bf(x2 * cs.x + x1 * cs.y);
            for (int h = 0; h < NH; ++h) { bf16_t* k = Kc + (((size_t)b * NH + h) * SEQ + s) * QKD + 64; k[j] = o1; k[16 + j] = o2; }
        }
    }
}
__device__ __forceinline__ void ph_gemm_s5b(const Ptrs& P, int bid, int nb) {
    const int tidx = opaque_tid();
    const bf16_t* u = WSP(bf16_t, WS_U); const bf16_t* bloc = WSP(bf16_t, WS_BLOC); float* xloc = WSP(float, WS_XLOC);
    GW_LOOP(SG * 16 * 4) {
        const int g = tl >> 6, m0 = ((tl >> 2) & 15) * 32, n0 = (tl & 3) * 32;
        sg_tile<false>(m0, n0, 1024,
            [&](int row) { return u + ((size_t)g * 512 + row) * 1024; },
            [&](int n, int k, int) { return bloc + ((size_t)g * 256 + n) * 1024 + k; },
            [&](int row, int n, float v, float) { xloc[((size_t)g * 512 + row) * 128 + n] = v; });
    }
}
__device__ __forceinline__ void ph_gemm_s5a(const Ptrs& P, int bid, int nb) {
    const int tidx = opaque_tid();
    const bf16_t* u = WSP(bf16_t, WS_U); const bf16_t* ktab = WSP(bf16_t, WS_KTAB); bf16_t* yintra = WSP(bf16_t, WS_YINTRA);
    GW_LOOP(SG * 16 * 32) {
        const int g = tl >> 9, m0 = ((tl >> 5) & 15) * 32, n0 = (tl & 31) * 32;
        sg_tile<false>(m0, n0, 1024,
            [&](int row) { return u + ((size_t)g * 512 + row) * 1024; },
            [&](int n, int k, int) { const int t = n >> 4, c = n & 15, s = k >> 4, c0 = k & 15; return ktab + (((size_t)g * 127 + (t - s + 63)) * 16 + c) * 16 + c0; },
            [&](int row, int n, float v, float) {
                const int b = row >> 5, j = row & 31, t = n >> 4, c = n & 15;
                yintra[((size_t)b * SEQ + j * CH + t) * SSMW + g * SC + c] = f2bf(v);
            });
    }
}
__device__ __forceinline__ void ph_attn_simple(const Ptrs& P, LAS unsigned char* lds, int bid, int nb) {
    const int tidx = opaque_tid();
    const bf16_t* Q = WSP(bf16_t, WS_Q); const bf16_t* Kc = WSP(bf16_t, WS_K); const bf16_t* V = WSP(bf16_t, WS_V); bf16_t* AS = WSP(bf16_t, WS_AS);
    const int lane = tidx & 63, w = tidx >> 6;
    LAS float* qs = (LAS float*)lds + w * (QKD + SEQ);
    LAS float* ps = qs + QKD;
    for (int row = bid * NWAVE + w; row < T * NH; row += nb * NWAVE) {
        const int bh = row >> 11, q = row & 2047, b = bh >> 3, h = bh & 7;
        asm volatile("s_waitcnt lgkmcnt(0)" ::: "memory");
        qs[lane] = bf2f(Q[(size_t)row * QKD + lane]);
        if (lane < 32) qs[64 + lane] = bf2f(Q[(size_t)row * QKD + 64 + lane]);
        asm volatile("s_waitcnt lgkmcnt(0)" ::: "memory");
        const int nk = ((q >> 6) + 1) * 64;
        float m = -INFINITY;
        for (int kb = 0; kb < nk; kb += 64) {
            const bf16_t* kp = Kc + ((size_t)bh * SEQ + kb + lane) * QKD;
            float s = 0.f;
#pragma unroll
            for (int c = 0; c < 12; ++c) {
                const bf16x8 kv = *(const bf16x8*)(kp + c * 8);
#pragma unroll
                for (int e = 0; e < 8; ++e) s += qs[c * 8 + e] * bf2f((bf16_t)kv[e]);
            }
            ps[kb + lane] = s; m = fmaxf(m, s);
        }
        m = wave_max(m);
        float l = 0.f;
        for (int kb = 0; kb < nk; kb += 64) { const float p = exp2f(ps[kb + lane] - m); ps[kb + lane] = p; l += p; }
        l = wave_sum(l);
        asm volatile("s_waitcnt lgkmcnt(0)" ::: "memory");
        float o = 0.f;
        const bf16_t* vp = V + (size_t)bh * SEQ * VD + lane;
        for (int k = 0; k < nk; ++k) o += ps[k] * bf2f(vp[(size_t)k * VD]);
        AS[((size_t)b * SEQ + q) * 1024 + h * 64 + lane] = f2bf(o / l);
    }
}
__device__ __forceinline__ void ph_s5scan(const Ptrs& P, int bid, int nb) {
    const int tidx = opaque_tid();
    const float* xloc = WSP(float, WS_XLOC); const float2* lampow = WSP(float2, WS_LAMPOW); bf16_t* xprev = WSP(bf16_t, WS_XPREV);
    for (int i = bid * NTHR + tidx; i < SG * NB * SP; i += nb * NTHR) {
        const int p = i & 63, b = (i >> 6) & 15, g = i >> 10;
        const float2 l64 = lampow[(g * SP + p) * 65 + 64];
        float xr = 0.f, xi = 0.f;
#pragma unroll
        for (int j = 0; j < NCH; ++j) {
            const size_t row = (size_t)g * 512 + b * 32 + j;
            bf16_t* xp = xprev + row * 256;
            xp[p] = f2bf(xr); xp[64 + p] = f2bf(xi); xp[128 + p] = 0; xp[192 + p] = 0;
            const float lr = xloc[row * 128 + p], li = xloc[row * 128 + 64 + p];
            const float nr = l64.x * xr - l64.y * xi + lr, ni = l64.x * xi + l64.y * xr + li;
            xr = nr; xi = ni;
        }
    }
}
__device__ __forceinline__ void ph_gemm_s5d(const Ptrs& P, int bid, int nb) {
    const int tidx = opaque_tid();
    const bf16_t* xprev = WSP(bf16_t, WS_XPREV); const bf16_t* clam = WSP(bf16_t, WS_CLAM); const bf16_t* yintra = WSP(bf16_t, WS_YINTRA); bf16_t* Y = WSP(bf16_t, WS_Y);
    GW_LOOP(SG * 16 * 32) {
        const int g = tl >> 9, m0 = ((tl >> 5) & 15) * 32, n0 = (tl & 31) * 32;
        sg_tile<false>(m0, n0, 256,
            [&](int row) { return xprev + ((size_t)g * 512 + row) * 256; },
            [&](int n, int k, int) { return clam + ((size_t)g * 1024 + n) * 256 + k; },
            [&](int row, int n, float v, float) {
                const int b = row >> 5, j = row & 31, t = n >> 4, c = n & 15;
                const size_t o = ((size_t)b * SEQ + j * CH + t) * SSMW + g * SC + c;
                Y[o] = f2bf(gelu_tanh(v + bf2f(yintra[o])));
            });
    }
}
__device__ __forceinline__ void ph_gemm_glu(const Ptrs& P, int bid, int nb) {
    const int tidx = opaque_tid();
    const bf16_t* Y = WSP(bf16_t, WS_Y); const bf16_t* wt = WSP(bf16_t, WS_WGLU); bf16_t* AS = WSP(bf16_t, WS_AS);
    GW_LOOP((T / 32) * 16) {
        const int m0 = (tl >> 4) * 32, n0 = (tl & 15) * 32;
        sg_tile<false>(m0, n0, 512,
            [&](int row) { return Y + (size_t)row * 512; },
            [&](int n, int k, int) { return wt + (size_t)n * 512 + k; },
            [&](int t, int n, float v, float) {
                const float yv = bf2f(Y[(size_t)t * 512 + n]);
                AS[(size_t)t * 1024 + 512 + n] = f2bf(yv * sigmoidf_(v + P.b_glu[n]));
            });
    }
}
__device__ __forceinline__ void ph_asnorm(const Ptrs& P, int bid, int nb) {
    const int tidx = opaque_tid();
    bf16_t* AS = WSP(bf16_t, WS_AS);
    const int lane = tidx & 63, w = tidx >> 6;
    for (int t = bid * NWAVE + w; t < T; t += nb * NWAVE) {
        bf16_t* r = AS + (size_t)t * 1024;
        float va[8], vs[8]; float sa = 0.f, ss = 0.f;
        const bf16x8 a = *(const bf16x8*)(r + lane * 8), s = *(const bf16x8*)(r + 512 + lane * 8);
#pragma unroll
        for (int i = 0; i < 8; ++i) { va[i] = bf2f((bf16_t)a[i]); vs[i] = bf2f((bf16_t)s[i]); sa += va[i] * va[i]; ss += vs[i] * vs[i]; }
        const float ra = rsqrtf(wave_sum(sa) * (1.0f / 512) + EPS), rs = rsqrtf(wave_sum(ss) * (1.0f / 512) + EPS);
        bf16x8 oa, os;
#pragma unroll
        for (int i = 0; i < 8; ++i) { oa[i] = (short)f2bf(va[i] * ra); os[i] = (short)f2bf(vs[i] * rs); }
        *(bf16x8*)(r + lane * 8) = oa; *(bf16x8*)(r + 512 + lane * 8) = os;
    }
}
__device__ __forceinline__ void ph_gemm_wo(const Ptrs& P, int bid, int nb) {
    const int tidx = opaque_tid();
    const bf16_t* AS = WSP(bf16_t, WS_AS); const bf16_t* wt = WSP(bf16_t, WS_WO); const float* xstat = WSP(float, WS_XSTAT); float* pre1 = P.out;
    GW_LOOP((T / 32) * 32) {
        const int m0 = (tl >> 5) * 32, n0 = (tl & 31) * 32;
        sg_tile<false>(m0, n0, 1024,
            [&](int row) { return AS + (size_t)row * 1024; },
            [&](int n, int k, int) { return wt + (size_t)n * 1024 + k; },
            [&](int t, int n, float v, float) {
                const float xn = (P.x[(size_t)t * D + n] - xstat[2 * t]) * xstat[2 * t + 1] * P.ln_in_g[n] + P.ln_in_b[n];
                pre1[(size_t)t * D + n] = v + ALPHA * xn;
            });
    }
}
__device__ __forceinline__ void ph_ln1(const Ptrs& P, int bid, int nb) {
    const int tidx = opaque_tid();
    const float* pre1 = P.out; bf16_t* x1 = WSP(bf16_t, WS_X1); bf16_t* x1lo = WSP(bf16_t, WS_X1LO);
    const int lane = tidx & 63, w = tidx >> 6;
    for (int t = bid * NWAVE + w; t < T; t += nb * NWAVE) {
        const float* xr = pre1 + (size_t)t * D;
        float v[16]; float s = 0.f;
#pragma unroll
        for (int i = 0; i < 4; ++i) { const f32x4 q = *(const f32x4*)(xr + i * 256 + lane * 4); v[4 * i] = q[0]; v[4 * i + 1] = q[1]; v[4 * i + 2] = q[2]; v[4 * i + 3] = q[3]; s += q[0] + q[1] + q[2] + q[3]; }
        const float mu = wave_sum(s) * (1.0f / D);
        float ss = 0.f;
#pragma unroll
        for (int i = 0; i < 16; ++i) { const float d = v[i] - mu; ss += d * d; }
        const float rstd = rsqrtf(wave_sum(ss) * (1.0f / D) + EPS);
#pragma unroll
        for (int i = 0; i < 4; ++i) {
            const int c = i * 256 + lane * 4;
            const f32x4 gg = *(const f32x4*)(P.ln1_g + c), bb = *(const f32x4*)(P.ln1_b + c);
            ushort4 o, ol;
            float y;
            y = (v[4 * i] - mu) * rstd * gg[0] + bb[0];     o.x = f2bf(y); ol.x = f2bf(y - bf2f(o.x));
            y = (v[4 * i + 1] - mu) * rstd * gg[1] + bb[1]; o.y = f2bf(y); ol.y = f2bf(y - bf2f(o.y));
            y = (v[4 * i + 2] - mu) * rstd * gg[2] + bb[2]; o.z = f2bf(y); ol.z = f2bf(y - bf2f(o.z));
            y = (v[4 * i + 3] - mu) * rstd * gg[3] + bb[3]; o.w = f2bf(y); ol.w = f2bf(y - bf2f(o.w));
            *(ushort4*)(x1 + (size_t)t * D + c) = o; (void)ol; (void)x1lo;
            { int p = __builtin_amdgcn_cvt_pk_fp8_f32(bf2f(o.x) * XQ_SCALE, bf2f(o.y) * XQ_SCALE, 0, false); p = __builtin_amdgcn_cvt_pk_fp8_f32(bf2f(o.z) * XQ_SCALE, bf2f(o.w) * XQ_SCALE, p, true);
              *(int*)(WSP(unsigned char, WS_X1Q) + (size_t)t * D + c) = p; }
        }
    }
}
__device__ __forceinline__ void ph_router(const Ptrs& P, int bid, int nb) {
    const int tidx = opaque_tid();
    const bf16_t* x1 = WSP(bf16_t, WS_X1); const bf16_t* x1lo = WSP(bf16_t, WS_X1LO); float* logits = WSP(float, WS_LOGITS);
    const int e = tidx & 63, w = tidx >> 6;
    for (int t = bid * NWAVE + w; t < T; t += nb * NWAVE) {
        const bf16_t* a = x1 + (size_t)t * D; const bf16_t* al = x1lo + (size_t)t * D;
        float s = 0.f;
        for (int k = 0; k < D; k += 8) {
            const bf16x8 hi = *(const bf16x8*)(a + k), lo = *(const bf16x8*)(al + k);
#pragma unroll
            for (int i = 0; i < 8; ++i) s += (bf2f((bf16_t)hi[i]) + bf2f((bf16_t)lo[i])) * P.w_router[(size_t)(k + i) * NE + e];
        }
        logits[(size_t)t * NE + e] = s;
    }
}
__device__ __forceinline__ void ph_topk(const Ptrs& P, int bid, int nb) {
    const int tidx = opaque_tid();
    const float* logits = WSP(float, WS_LOGITS); int* topi = WSP(int, WS_TOPI); float* topw = WSP(float, WS_TOPW);
    const int lane = tidx & 63, w = tidx >> 6;
    for (int t = bid * NWAVE + w; t < T; t += nb * NWAVE) {
        const float sc = sigmoidf_(logits[(size_t)t * NE + lane]);
        const float sel = sc + P.router_bias[lane];
        const int grp = lane >> 3;
        float m1 = sel;
        m1 = fmaxf(m1, __shfl_xor(m1, 1)); m1 = fmaxf(m1, __shfl_xor(m1, 2)); m1 = fmaxf(m1, __shfl_xor(m1, 4));
        const unsigned long long bal = __ballot(sel == m1) & (0xFFull << (8 * grp));
        const int first = __ffsll((long long)bal) - 1;
        float m2 = (lane == first) ? -INFINITY : sel;
        m2 = fmaxf(m2, __shfl_xor(m2, 1)); m2 = fmaxf(m2, __shfl_xor(m2, 2)); m2 = fmaxf(m2, __shfl_xor(m2, 4));
        const float gs = m1 + m2;
        int cg = 0;
#pragma unroll
        for (int gj = 0; gj < 8; ++gj) { const float sj = __shfl(gs, gj * 8); cg += (sj > gs || (sj == gs && gj < grp)) ? 1 : 0; }
        const bool gsel = cg < 4;
        const float v = gsel ? sel : -INFINITY;
        int rank = 0;
        for (int e2 = 0; e2 < 64; ++e2) { const float ve = __shfl(v, e2); rank += (ve > v || (ve == v && e2 < lane)) ? 1 : 0; }
        const bool chosen = gsel && rank < TOPK;
        const float wsum = wave_sum(chosen ? sc : 0.f);
        if (chosen) { topi[(size_t)t * TOPK + rank] = lane; topw[(size_t)t * TOPK + rank] = sc / wsum * 2.5f; }
    }
}
__device__ __forceinline__ void ph_cnt(const Ptrs& P, int bid, int nb) {
    const int tidx = opaque_tid();
    const int* topi = WSP(int, WS_TOPI); int* cnt = WSP(int, WS_CNT);
    for (int i = bid * NTHR + tidx; i < 256 * 64; i += nb * NTHR) {
        const int tile = i >> 6, e = i & 63;
        int c = 0;
        for (int k = 0; k < 1024; ++k) c += (topi[tile * 1024 + k] == e) ? 1 : 0;
        cnt[i] = c;
    }
}
__device__ __forceinline__ void ph_off(const Ptrs& P, LAS unsigned char* lds, int bid) {
    const int tidx = opaque_tid();
    if (bid != 0) return;
    const int* cnt = WSP(int, WS_CNT); int* toff = WSP(int, WS_TOFF); int* eoff = WSP(int, WS_EOFF); int* ecnt = WSP(int, WS_ECNT);
    LAS int* tot = (LAS int*)lds; LAS int* off = tot + 64;
    const int e = tidx;
    if (e < 64) { int s = 0; for (int tile = 0; tile < 256; ++tile) s += cnt[tile * 64 + e]; tot[e] = s; ecnt[e] = s; }
    __syncthreads();
    if (e == 0) { int o = 0; for (int i = 0; i < 64; ++i) { off[i] = o; o += (tot[i] + 255) & ~255; } off[64] = o; }
    __syncthreads();
    if (e < 64) {
        eoff[e] = off[e]; if (e == 0) eoff[64] = off[64];
        int run = off[e];
        for (int tile = 0; tile < 256; ++tile) { toff[tile * 64 + e] = run; run += cnt[tile * 64 + e]; }
    }
}
__device__ __forceinline__ void ph_lists(const Ptrs& P, int bid, int nb) {
    const int tidx = opaque_tid();
    const int* topi = WSP(int, WS_TOPI); const float* topw = WSP(float, WS_TOPW); const int* toff = WSP(int, WS_TOFF); const int* eoff = WSP(int, WS_EOFF);
    int* rowtok = WSP(int, WS_ROWTOK); float* roww = WSP(float, WS_ROWW);
    for (int i = bid * NTHR + tidx; i < 256 * 64; i += nb * NTHR) {
        const int tile = i >> 6, e = i & 63;
        int pos = toff[tile * 64 + e];
        for (int k = 0; k < 1024; ++k) {
            if (topi[tile * 1024 + k] == e) { rowtok[pos] = tile * 1024 + k; roww[pos] = topw[tile * 1024 + k]; ++pos; }
        }
        if (tile == 255) { const int end = eoff[e + 1]; for (; pos < end; ++pos) { rowtok[pos] = -1; roww[pos] = 0.f; } }
    }
    for (int i = bid * NTHR + tidx; i < T; i += nb * NTHR) rowtok[SH_ROW0 + i] = i * 8;
}
__device__ __forceinline__ void ph_gemm_gu(const Ptrs& P, int bid, int nb) {
    const int tidx = opaque_tid();
    const bf16_t* x1 = WSP(bf16_t, WS_X1); const bf16_t* wgu = WSP(bf16_t, WS_WGU); const int* rowtok = WSP(int, WS_ROWTOK); const float* roww = WSP(float, WS_ROWW);
    const int* eoff = WSP(int, WS_EOFF); bf16_t* H = WSP(bf16_t, WS_H);
    const int nrt = eoff[64] / 32;
    const int ntl = (nrt + T / 32) * 8;
    GW_LOOP(ntl) {
        const int rt = tl >> 3, n0 = (tl & 7) * 32;
        if (rt < nrt) {
            const int m0 = rt * 32;
            int e = 0; while (e < 63 && eoff[e + 1] <= m0) ++e;
            const bf16_t* w = wgu + (size_t)e * 512 * 1024;
            sg_tile<true>(m0, n0, 1024,
                [&](int row) { const int s = rowtok[row]; return x1 + (size_t)(s >= 0 ? (s >> 3) : 0) * D; },
                [&](int f, int k, int which) { return w + (size_t)((f >> 7) * 256 + (f & 127) + which * 128) * 1024 + k; },
                [&](int row, int f, float gv, float uv) { H[(size_t)row * FF + f] = f2bf(gv * sigmoidf_(gv) * uv * roww[row]); });
        } else {
            const int m0 = (rt - nrt) * 32;
            const bf16_t* w = wgu + (size_t)64 * 512 * 1024;
            sg_tile<true>(m0, n0, 1024,
                [&](int row) { return x1 + (size_t)row * D; },
                [&](int f, int k, int which) { return w + (size_t)((f >> 7) * 256 + (f & 127) + which * 128) * 1024 + k; },
                [&](int row, int f, float gv, float uv) { H[(size_t)(SH_ROW0 + row) * FF + f] = f2bf(gv * sigmoidf_(gv) * uv); });
        }
    }
}
__device__ __forceinline__ unsigned char f2fp8(float v) { const int p = __builtin_amdgcn_cvt_pk_fp8_f32(v, v, 0, false); return (unsigned char)(p & 0xff); }
__device__ __forceinline__ void ph_gemm_down(const Ptrs& P, int bid, int nb) {
    const int tidx = opaque_tid();
    const bf16_t* H = WSP(bf16_t, WS_H); const bf16_t* wd = WSP(bf16_t, WS_WD); const int* rowtok = WSP(int, WS_ROWTOK); const int* eoff = WSP(int, WS_EOFF);
    const bf16_t* x1 = WSP(bf16_t, WS_X1); unsigned char* yslot = WSP(unsigned char, WS_YSLOT); float* out = P.out;
    const int nrt = eoff[64] / 32;
    const int ntl = (nrt + T / 32) * 32;
    GW_LOOP(ntl) {
        const int rt = tl >> 5, n0 = (tl & 31) * 32;
        if (rt < nrt) {
            const int m0 = rt * 32;
            int e = 0; while (e < 63 && eoff[e + 1] <= m0) ++e;
            const bf16_t* w = wd + (size_t)e * 1024 * 256;
            sg_tile<false>(m0, n0, 256,
                [&](int row) { return H + (size_t)row * FF; },
                [&](int n, int k, int) { return w + (size_t)n * 256 + k; },
                [&](int row, int n, float v, float) { const int s = rowtok[row]; if (s >= 0) yslot[(size_t)s * D + n] = f2fp8(v * SLOT_SCALE); });
        } else {
            const int m0 = (rt - nrt) * 32;
            const bf16_t* w = wd + (size_t)64 * 1024 * 256;
            sg_tile<false>(m0, n0, 256,
                [&](int row) { return H + (size_t)(SH_ROW0 + row) * FF; },
                [&](int n, int k, int) { return w + (size_t)n * 256 + k; },
                [&](int t, int n, float v, float) { out[(size_t)t * D + n] = v + ALPHA * bf2f(x1[(size_t)t * D + n]); });
        }
    }
}
__device__ __forceinline__ void ph_combine(const Ptrs& P, int bid, int nb) {
    const int tidx = opaque_tid();
    const unsigned char* yslot = WSP(unsigned char, WS_YSLOT); const unsigned char* shslot = WSP(unsigned char, WS_SHSLOT); float* out = P.out;
    const int* invrow = WSP(int, WS_INVROW); const float* topw = WSP(float, WS_TOPW); const bf16_t* x1 = WSP(bf16_t, WS_X1);
    const int lane = tidx & 63, w = tidx >> 6;
    const int stride = nb * NWAVE * 2;
    int t0 = (bid * NWAVE + w) * 2;
    int4 ia[2], ib[2];
    if (t0 < T) {
#pragma unroll
        for (int r = 0; r < 2; ++r) { ia[r] = *(const int4*)(invrow + (size_t)(t0 + r) * TOPK); ib[r] = *(const int4*)(invrow + (size_t)(t0 + r) * TOPK + 4); }
    }
    for (; t0 < T; t0 += stride) {
        u32x4 q[2][9]; bf16x8 xa[2], xb[2]; f32x4 wa[2], wb[2];
#pragma unroll
        for (int r = 0; r < 2; ++r) {
            const int t = t0 + r;
            const int rows[8] = {ia[r].x, ia[r].y, ia[r].z, ia[r].w, ib[r].x, ib[r].y, ib[r].z, ib[r].w};
#pragma unroll
            for (int k = 0; k < 8; ++k) q[r][k] = __builtin_nontemporal_load((const u32x4*)(yslot + (size_t)rows[k] * D + lane * 16));
            q[r][8] = __builtin_nontemporal_load((const u32x4*)(shslot + (size_t)t * D + lane * 16));
            xa[r] = __builtin_nontemporal_load((const bf16x8*)(x1 + (size_t)t * D + lane * 16)); xb[r] = __builtin_nontemporal_load((const bf16x8*)(x1 + (size_t)t * D + lane * 16 + 8));
            wa[r] = *(const f32x4*)(topw + (size_t)t * TOPK); wb[r] = *(const f32x4*)(topw + (size_t)t * TOPK + 4);
        }
        const int tn = t0 + stride;
        if (tn < T) {
#pragma unroll
            for (int r = 0; r < 2; ++r) { ia[r] = *(const int4*)(invrow + (size_t)(tn + r) * TOPK); ib[r] = *(const int4*)(invrow + (size_t)(tn + r) * TOPK + 4); }
        }
#pragma unroll
        for (int r = 0; r < 2; ++r) {
            const int t = t0 + r;
            float v[16];
#pragma unroll
            for (int i = 0; i < 8; ++i) { v[i] = ALPHA * bf2f((bf16_t)xa[r][i]); v[8 + i] = ALPHA * bf2f((bf16_t)xb[r][i]); }
#pragma unroll
            for (int k = 0; k <= TOPK; ++k) {
                const float wk = ((k < 4) ? wa[r][k & 3] : (k < 8) ? wb[r][k & 3] : 1.0f) * (1.0f / SLOT_SCALE);
#pragma unroll
                for (int i = 0; i < 4; ++i) {
                    v[4 * i]     += __builtin_amdgcn_cvt_f32_fp8((int)q[r][k][i], 0) * wk;
                    v[4 * i + 1] += __builtin_amdgcn_cvt_f32_fp8((int)q[r][k][i], 1) * wk;
                    v[4 * i + 2] += __builtin_amdgcn_cvt_f32_fp8((int)q[r][k][i], 2) * wk;
                    v[4 * i + 3] += __builtin_amdgcn_cvt_f32_fp8((int)q[r][k][i], 3) * wk;
                }
            }
            float s = 0.f;
#pragma unroll
            for (int i = 0; i < 16; ++i) s += v[i];
            const float mu = wave_sum(s) * (1.0f / D);
            float ss = 0.f;
#pragma unroll
            for (int i = 0; i < 16; ++i) { const float d = v[i] - mu; ss += d * d; }
            const float rstd = rsqrtf(wave_sum(ss) * (1.0f / D) + EPS);
            float* orow = out + (size_t)t * D + lane * 16;
#pragma unroll
            for (int i = 0; i < 4; ++i) {
                const int c = lane * 16 + 4 * i;
                const f32x4 gg = *(const f32x4*)(P.ln2_g + c), bb = *(const f32x4*)(P.ln2_b + c);
                f32x4 o;
                o[0] = (v[4 * i] - mu) * rstd * gg[0] + bb[0]; o[1] = (v[4 * i + 1] - mu) * rstd * gg[1] + bb[1];
                o[2] = (v[4 * i + 2] - mu) * rstd * gg[2] + bb[2]; o[3] = (v[4 * i + 3] - mu) * rstd * gg[3] + bb[3];
                *(f32x4*)(orow + 4 * i) = o;
            }
        }
    }
}

namespace g8 {
constexpr int BM = 256, BK = 64, HALF = 128, HTB = HALF * BK * 2, STAGE_BYTES = 8 * HTB;
__device__ __forceinline__ int lds_byte(int r, int c) { const int st = (r >> 4) * 2 + (c >> 5), rr = r & 15, cc = c & 31, ob = rr * 64 + cc * 2; return st * 1024 + (ob ^ (((ob >> 9) & 1) << 5)); }
__device__ __forceinline__ void stage_rc(int b, int& R, int& C) { const int st = b / 1024, sb = b % 1024, swz = sb ^ (((sb >> 9) & 1) << 5); R = (st >> 1) * 16 + swz / 64; C = (st & 1) * 32 + (swz % 64) / 2; }
__device__ __forceinline__ int perm32(int rho) { const int n = rho >> 4, i = rho & 15; return 8 * (i >> 2) + 4 * n + (i & 3); }

struct Unit { const char* A; const char* B; const int* rows; int pm, pn, e, nt; };
struct Geo { int lda_b, ldb_b; long kstepA, kstepB; int toep; };

typedef float f32x4 __attribute__((ext_vector_type(4)));
typedef f32x4 Acc[2][2][4][2];
typedef int v8i_t __attribute__((ext_vector_type(8)));
typedef int v4i_t __attribute__((ext_vector_type(4)));

__device__ __forceinline__ unsigned g8_rowoff(const int* rows, int h, int i, int tid, int lda_b) {
    int t2 = tid; asm volatile("" : "+v"(t2));
    int R, C; stage_rc(t2 * 16 + i * 8192, R, C);
    const int sl = rows[h * HALF + R];
    return (unsigned)((sl < 0 ? 0 : sl >> 3) * lda_b + C * 2);
}
template <class Epi, class Sched, bool GATHER, int DT = 0>
__device__ __forceinline__ void gemm_body(LAS unsigned char* lds, const Geo g, const Sched& S, const Epi& E) {
    const int tid = opaque_tid(), wid = __builtin_amdgcn_readfirstlane(tid >> 6), lane = tid & 63, wr = wid >> 2, wc = wid & 3, fr = lane & 15, fq = lane >> 4;
    unsigned voffB[2], vA[2][2];
#pragma unroll
    for (int i = 0; i < 2; ++i) { int R, C; stage_rc(tid * 16 + i * 8192, R, C); const int Rb = (R & ~31) + perm32(R & 31);
        voffB[i] = g.toep ? (unsigned)(Rb * 32 + 1536 - (C >> 4) * 512 + (C & 15) * 2) : (unsigned)(Rb * g.ldb_b + C * 2);
#pragma unroll
        for (int h = 0; h < 2; ++h) vA[h][i] = (unsigned)((h * HALF + R) * g.lda_b + C * 2); }
    const long kA = g.kstepA, kB = g.kstepB;
    const long hB = (long)HALF * g.ldb_b;
    const unsigned ldsw = (unsigned)wid * 1024u;
    const int aoff = lds_byte(wr * 64 + fr, fq * 8), boff = lds_byte(wc * 32 + fr, fq * 8);
#define G8_SA(b, h) (((b) * 2 + (h)) * HTB)
#define G8_SB(b, h) ((4 + (b) * 2 + (h)) * HTB)
#define G8_STAGE(bufoff, gbase, v0, v1) do { \
        unsigned v0_ = (v0), v1_ = (v1); if (GATHER) asm volatile("" : "+v"(v0_), "+v"(v1_)); \
        __builtin_amdgcn_global_load_lds((const unsigned*)((const char*)(gbase) + v0_), (LAS unsigned*)(lds + (bufoff) + ldsw), 16, 0, 0); \
        __builtin_amdgcn_global_load_lds((const unsigned*)((const char*)(gbase) + v1_), (LAS unsigned*)(lds + (bufoff) + ldsw + 8192), 16, 0, 0); } while (0)
#define G8_STB(bufoff, gbase) G8_STAGE(bufoff, gbase, voffB[0], voffB[1])
#define G8_LDA(dst, b, h) do { if (DT == 0) { _Pragma("unroll") for (int m = 0; m < 4; ++m) _Pragma("unroll") for (int k = 0; k < 2; ++k) dst[m][k] = *(const LAS bf16x8*)(lds + G8_SA(b, h) + aoff + m * 2048 + k * 1024); } \
        else { _Pragma("unroll") for (int m = 0; m < 4; ++m) dst##8[m] = __builtin_shufflevector(*(const LAS v4i_t*)(aBase + G8_SA(b, h) + m * 2048), *(const LAS v4i_t*)(aBase + G8_SA(b, h) + m * 2048 + 1024), 0, 1, 2, 3, 4, 5, 6, 7); } } while (0)
#define G8_LDB(dst, b, h) do { if (DT == 0) { _Pragma("unroll") for (int n = 0; n < 2; ++n) _Pragma("unroll") for (int k = 0; k < 2; ++k) dst[n][k] = *(const LAS bf16x8*)(lds + G8_SB(b, h) + boff + n * 2048 + k * 1024); } \
        else { _Pragma("unroll") for (int n = 0; n < 2; ++n) dst##8[n] = __builtin_shufflevector(*(const LAS v4i_t*)(bBase + (G8_SB(b, h) - 65536) + n * 2048), *(const LAS v4i_t*)(bBase + (G8_SB(b, h) - 65536) + n * 2048 + 1024), 0, 1, 2, 3, 4, 5, 6, 7); } } while (0)
#define G8_MMA(ai, bj, At, Bt) do { __builtin_amdgcn_s_setprio(1); \
        if (DT == 0) { _Pragma("unroll") for (int m = 0; m < 4; ++m) _Pragma("unroll") for (int n = 0; n < 2; ++n) _Pragma("unroll") for (int k = 0; k < 2; ++k) \
            acc[ai][bj][m][n] = __builtin_amdgcn_mfma_f32_16x16x32_bf16(Bt[n][k], At[m][k], acc[ai][bj][m][n], 0, 0, 0); } \
        else { _Pragma("unroll") for (int m = 0; m < 4; ++m) _Pragma("unroll") for (int n = 0; n < 2; ++n) \
            acc[ai][bj][m][n] = __builtin_amdgcn_mfma_scale_f32_16x16x128_f8f6f4(Bt##8[n], At##8[m], acc[ai][bj][m][n], 0, 0, 0, 127, 0, 127); } \
        __builtin_amdgcn_s_setprio(0); } while (0)
#define G8_WAIT_V(n) asm volatile("s_waitcnt vmcnt(" #n ")" ::: "memory")
#define G8_WAIT_L(n) asm volatile("s_waitcnt lgkmcnt(" #n ")" ::: "memory")
#define G8_BAR __builtin_amdgcn_s_barrier()
#define G8_SCHED __builtin_amdgcn_sched_barrier(0)
#define G8_ROWOFF(u_, h_, i_) g8_rowoff((u_).rows, (h_), (i_), tid, g.lda_b)
    Unit cur, nxt; int ui = 0;
    if (!S.next(0, cur)) return;
    Acc acc;
#pragma unroll
    for (int a = 0; a < 2; ++a)
#pragma unroll
        for (int b = 0; b < 2; ++b)
#pragma unroll
            for (int m = 0; m < 4; ++m)
#pragma unroll
                for (int n = 0; n < 2; ++n) acc[a][b][m][n] = (f32x4){0.f, 0.f, 0.f, 0.f};
    bf16x8 At[4][2], B0[2][2], B1[2][2];
    v8i_t At8[4], B08[2], B18[2];
    LAS unsigned char* aBase = lds + aoff; LAS unsigned char* bBase = lds + 65536 + boff;
    asm volatile("" : "+v"(aBase), "+v"(bBase));
    const char* cA = cur.A; const char* cB = cur.B;
    if (GATHER) {
#pragma unroll
        for (int h = 0; h < 2; ++h)
#pragma unroll
            for (int i = 0; i < 2; ++i) vA[h][i] = G8_ROWOFF(cur, h, i);
        asm volatile("" : "+v"(vA[0][0]), "+v"(vA[0][1]), "+v"(vA[1][0]), "+v"(vA[1][1]));
    }
    const long hA = GATHER ? 0 : 0;
    (void)hA;
    G8_STB(G8_SB(0, 0), cB); G8_STB(G8_SB(0, 1), cB + hB); G8_STAGE(G8_SA(0, 0), cA, vA[0][0], vA[0][1]); G8_STAGE(G8_SA(0, 1), cA, vA[1][0], vA[1][1]);
    if (wr == 1) G8_BAR;
    G8_WAIT_V(2); G8_BAR;
    G8_STB(G8_SB(1, 0), cB + kB); G8_STAGE(G8_SA(1, 0), cA + kA, vA[0][0], vA[0][1]); G8_STB(G8_SB(1, 1), cB + hB + kB);
    G8_WAIT_V(6); G8_BAR;
    for (;;) {
        const bool has_next = S.next(ui + 1, nxt);
        const char* nA = has_next ? nxt.A : cA; const char* nB = has_next ? nxt.B : cB;
        const int nt = cur.nt;
        for (int t = 0; t < nt; t += 2) {
            const bool last = (t == nt - 2);
            const char* a1 = cA + (long)(t + 1) * kA;
            const char* a2 = last ? nA : cA + (long)(t + 2) * kA; const char* b2 = last ? nB : cB + (long)(t + 2) * kB;
            const char* a3 = a2 + kA; const char* b3 = b2 + kB;
            G8_LDB(B0, 0, 0); G8_LDB(B1, 0, 1); G8_SCHED; G8_LDA(At, 0, 0); G8_STAGE(G8_SA(1, 1), a1, vA[1][0], vA[1][1]);
            if (GATHER && last && has_next) {
                vA[0][0] = G8_ROWOFF(nxt, 0, 0); vA[0][1] = G8_ROWOFF(nxt, 0, 1); vA[1][0] = G8_ROWOFF(nxt, 1, 0); vA[1][1] = G8_ROWOFF(nxt, 1, 1);
                asm volatile("" : "+v"(vA[0][0]), "+v"(vA[0][1]), "+v"(vA[1][0]), "+v"(vA[1][1]));
            }
            const unsigned w00 = vA[0][0], w01 = vA[0][1], w10 = vA[1][0], w11 = vA[1][1];
            G8_WAIT_V(8); G8_WAIT_L(0); G8_BAR; G8_MMA(0, 0, At, B0); G8_MMA(0, 1, At, B1); G8_BAR; G8_SCHED;
            G8_LDA(At, 0, 1); G8_STB(G8_SB(0, 0), b2); G8_STB(G8_SB(0, 1), b2 + hB); G8_STAGE(G8_SA(0, 0), a2, w00, w01);
            G8_WAIT_V(8); G8_WAIT_L(0); G8_BAR; G8_MMA(1, 0, At, B0); G8_MMA(1, 1, At, B1); G8_BAR; G8_SCHED;
            G8_LDB(B0, 1, 0); G8_LDB(B1, 1, 1); G8_SCHED; G8_LDA(At, 1, 0); G8_STAGE(G8_SA(0, 1), a2, w10, w11);
            G8_WAIT_V(8); G8_WAIT_L(0); G8_BAR; G8_MMA(0, 0, At, B0); G8_MMA(0, 1, At, B1); G8_BAR; G8_SCHED;
            G8_LDA(At, 1, 1); G8_STB(G8_SB(1, 0), b3); G8_STB(G8_SB(1, 1), b3 + hB); G8_STAGE(G8_SA(1, 0), a3, w00, w01);
            G8_WAIT_V(8); G8_WAIT_L(0); G8_BAR; G8_MMA(1, 0, At, B0); G8_MMA(1, 1, At, B1); G8_BAR; G8_SCHED;
        }
        if (wr == 0) G8_BAR;
        { int t3_ = threadIdx.x; asm volatile("" : "+v"(t3_)); E(acc, cur, wr, wc, t3_ & 15, (t3_ >> 4) & 3); }
        if (!has_next) break;
        if (!Epi::KEEP || cur.e != 0) {
#pragma unroll
        for (int a = 0; a < 2; ++a)
#pragma unroll
            for (int b = 0; b < 2; ++b)
#pragma unroll
                for (int m = 0; m < 4; ++m)
#pragma unroll
                    for (int n = 0; n < 2; ++n) acc[a][b][m][n] = (f32x4){0.f, 0.f, 0.f, 0.f};
        }
        cur = nxt; cA = nA; cB = nB; ++ui;
        if (wr == 1) G8_BAR;
    }
    G8_WAIT_V(0);
    G8_BAR;
#undef G8_SA
#undef G8_SB
#undef G8_STAGE
#undef G8_STB
#undef G8_LDA
#undef G8_LDB
#undef G8_MMA
#undef G8_WAIT_V
#undef G8_WAIT_L
#undef G8_BAR
#undef G8_SCHED
#undef G8_ROWOFF
}
}
namespace g8 {
__device__ __forceinline__ unsigned pk_bf16(float lo, float hi) { return pk_bf16_hw(lo, hi); }
__device__ __forceinline__ u32x4 pack8(const f32x4 a, const f32x4 b) { u32x4 w; w[0] = pk_bf16(a[0], a[1]); w[1] = pk_bf16(a[2], a[3]); w[2] = pk_bf16(b[0], b[1]); w[3] = pk_bf16(b[2], b[3]); return w; }
__device__ __forceinline__ int unit_index(int i, int nunits) {
    const int G = gridDim.x, c = blockIdx.x;
    if ((G & 7) != 0) { const long L = (long)i * G + c; return L < nunits ? (int)L : -1; }
    const int x = c & 7, r = c >> 3, GX = G >> 3;
    const int lo = (int)(((long)nunits * x) >> 3), hi = (int)(((long)nunits * (x + 1)) >> 3);
    const int L = lo + i * GX + r;
    return L < hi ? L : -1;
}
struct SchedReg {
    const char* A; const char* B; int lda_b, ldb_b, nM, nN, nt; int pm0 = 0;
    __device__ __forceinline__ bool next(int i, Unit& u) const {
        const int L = unit_index(i, nM * nN); if (L < 0) return false;
        u.pm = pm0 + L / nN; u.pn = L % nN; u.e = 0; u.nt = nt; u.rows = nullptr;
        u.A = A + (size_t)u.pm * 256 * lda_b; u.B = B + (size_t)u.pn * 256 * ldb_b; return true;
    }
};
struct SchedS5 {
    const char* A; const char* B; int lda_b, ldb_b, nN, nt; size_t a_gstride, b_gstride; int toep;
    __device__ __forceinline__ bool next(int i, Unit& u) const {
        const int L = unit_index(i, SG * 2 * nN); if (L < 0) return false;
        const int g = L / (2 * nN), r = L % (2 * nN);
        u.pm = r / nN; u.pn = r % nN; u.e = g; u.rows = nullptr;
        u.A = A + (size_t)g * a_gstride + (size_t)u.pm * 256 * lda_b;
        if (toep) { u.B = B + (size_t)g * 127 * 512 + 63 * 512 + (size_t)u.pn * 256 * 32 - 1536; u.nt = 4 * (u.pn + 1); }
        else { u.B = B + (size_t)g * b_gstride + (size_t)u.pn * 256 * ldb_b; u.nt = nt; }
        return true;
    }
};
struct SchedMoe {
    const char* A; const char* B; const int* eoff; const int* rowtok; int lda_b, npn, nt; size_t b_estride; int ldb_b; int gather; const int* tile_e;
    __device__ __forceinline__ bool next(int i, Unit& u) const {
        const int nrt = eoff[64] >> 8;
        const int G = gridDim.x, c = blockIdx.x;
        int rt;
        if ((G & 7) == 0) {
            const int x = c & 7, r = c >> 3, GX = G >> 3;
            const int r0 = (nrt * x) >> 3, r1 = (nrt * (x + 1)) >> 3, nr = r1 - r0;
            const int j = i * GX + r;
            if (j >= (nr + 16) * npn) return false;
            const int tl = j / npn; u.pn = j % npn;
            rt = (tl < nr) ? r0 + tl : nrt + 16 * x + (tl - nr);
        } else {
            const long L = (long)i * G + c; if (L >= (long)(nrt + T / 256) * npn) return false;
            rt = (int)(L / npn); u.pn = (int)(L % npn);
        }
        u.nt = nt;
        int e = 64;
        if (rt < nrt) e = tile_e[rt];
        u.e = e; u.pm = rt;
        u.B = B + (size_t)e * b_estride + (size_t)u.pn * 256 * ldb_b;
        if (gather) {
            u.A = A; u.rows = rowtok + ((e < 64) ? rt * 256 : SH_ROW0 + (rt - nrt) * 256);
        } else {
            const int row0 = (e < 64) ? rt * 256 : SH_ROW0 + (rt - nrt) * 256;
            u.A = A + (size_t)row0 * lda_b; u.rows = nullptr;
        }
        return true;
    }
};

#define EPI_ROWS_BEGIN _Pragma("unroll") for (int ai = 0; ai < 2; ++ai) _Pragma("unroll") for (int m = 0; m < 4; ++m) { const int rloc = ai * 128 + wr * 64 + m * 16 + fr;
#define EPI_ROWS_END }

struct EpiWin {
    static constexpr bool KEEP = false;
    bf16_t* cq; bf16_t* ckv; bf16_t* u; bf16_t* Kc; const float2* rope; float* rsqp; float* rskvp;
    __device__ __forceinline__ void operator()(const Acc& acc, const Unit& un, int wr, int wc, int fr, int fq) const {
        const int pn = un.pn;
        if (pn == 0) {
            EPI_ROWS_BEGIN
                const int t = un.pm * 256 + rloc;
                float ss = 0.f;
#pragma unroll
                for (int bj = 0; bj < 2; ++bj) { const f32x4 v0 = acc[ai][bj][m][0], v1 = acc[ai][bj][m][1];
                    *(u32x4*)(cq + (size_t)t * 256 + bj * 128 + wc * 32 + fq * 8) = pack8(v0, v1);
                    ss += v0[0] * v0[0] + v0[1] * v0[1] + v0[2] * v0[2] + v0[3] * v0[3] + v1[0] * v1[0] + v1[1] * v1[1] + v1[2] * v1[2] + v1[3] * v1[3]; }
                ss += __shfl_xor(ss, 16); ss += __shfl_xor(ss, 32);
                if (fq == 0) rsqp[(size_t)t * 4 + wc] = ss;
            EPI_ROWS_END
        } else if (pn <= 2) {
            EPI_ROWS_BEGIN
                const int t = un.pm * 256 + rloc;
                const int b = t >> 11, s = t & 2047, j = s >> 6, sl = s & 63;
#pragma unroll
                for (int bj = 0; bj < 2; ++bj) { const int ch0 = (pn - 1) * 256 + bj * 128 + wc * 32 + fq * 8, gi = ch0 >> 4, c0 = ch0 & 15;
                    *(u32x4*)(u + ((size_t)gi * 512 + b * 32 + j) * 1024 + sl * 16 + c0) = pack8(acc[ai][bj][m][0], acc[ai][bj][m][1]); }
            EPI_ROWS_END
        } else {
            EPI_ROWS_BEGIN
                const int t = un.pm * 256 + rloc;
                const f32x4 v0 = acc[ai][0][m][0], v1 = acc[ai][0][m][1];
                *(u32x4*)(ckv + (size_t)t * 256 + wc * 32 + fq * 8) = pack8(v0, v1);
                float ss = v0[0] * v0[0] + v0[1] * v0[1] + v0[2] * v0[2] + v0[3] * v0[3] + v1[0] * v1[0] + v1[1] * v1[1] + v1[2] * v1[2] + v1[3] * v1[3];
                ss += __shfl_xor(ss, 16); ss += __shfl_xor(ss, 32);
                if (fq == 0) rskvp[(size_t)t * 4 + wc] = ss;
                *(u32x4*)(ckv + (size_t)t * 256 + 128 + wc * 32 + fq * 8) = (u32x4){0u, 0u, 0u, 0u};
            EPI_ROWS_END
            if (wc == 0) {
                EPI_ROWS_BEGIN
                    const int t = un.pm * 256 + rloc;
                    const f32x4 x1 = acc[ai][1][m][0], x2 = acc[ai][1][m][1];
                    const f32x4 ca = *(const f32x4*)(rope + (size_t)t * 16 + fq * 4), cb = *(const f32x4*)(rope + (size_t)t * 16 + fq * 4 + 2);
                    const float o10 = x1[0] * ca[0] - x2[0] * ca[1], o11 = x1[1] * ca[2] - x2[1] * ca[3], o12 = x1[2] * cb[0] - x2[2] * cb[1], o13 = x1[3] * cb[2] - x2[3] * cb[3];
                    const float o20 = x2[0] * ca[0] + x1[0] * ca[1], o21 = x2[1] * ca[2] + x1[1] * ca[3], o22 = x2[2] * cb[0] + x1[2] * cb[1], o23 = x2[3] * cb[2] + x1[3] * cb[3];
                    uint2 w1, w2; w1.x = pk_bf16(o10, o11); w1.y = pk_bf16(o12, o13); w2.x = pk_bf16(o20, o21); w2.y = pk_bf16(o22, o23);
                    const int b = t >> 11, s = t & 2047;
                    bf16_t* kp = Kc + (((size_t)b * NH) * SEQ + s) * QKD + 64 + fq * 4;
#pragma unroll 1
                    for (int h = 0; h < NH; ++h) { *(uint2*)kp = w1; *(uint2*)(kp + 16) = w2; kp += (size_t)SEQ * QKD; }
                EPI_ROWS_END
            }
        }
    }
};
struct EpiQ {
    static constexpr bool KEEP = false;
    bf16_t* Q; const float* rsqp; const float2* rope;
    __device__ __forceinline__ void operator()(const Acc& acc, const Unit& un, int wr, int wc, int fr, int fq) const {
        EPI_ROWS_BEGIN
            const int t = un.pm * 256 + rloc, b = t >> 11, s = t & 2047;
            const f32x4 pp = *(const f32x4*)(rsqp + (size_t)t * 4);
            const float rs = rsqrtf((pp[0] + pp[1] + pp[2] + pp[3]) * (1.0f / 256) + EPS);
            if (un.pn < 2) {
#pragma unroll
                for (int bj = 0; bj < 2; ++bj) { const int col = un.pn * 256 + bj * 128 + wc * 32 + fq * 8;
                    *(u32x4*)(Q + (((size_t)b * NH + (col >> 6)) * SEQ + s) * QKD + (col & 63)) = pack8(acc[ai][bj][m][0] * rs, acc[ai][bj][m][1] * rs); }
            } else {
                const f32x4 ca = *(const f32x4*)(rope + (size_t)t * 16 + fq * 4), cb = *(const f32x4*)(rope + (size_t)t * 16 + fq * 4 + 2);
#pragma unroll
                for (int bj = 0; bj < 2; ++bj) { const f32x4 x1 = acc[ai][bj][m][0] * rs, x2 = acc[ai][bj][m][1] * rs;
                    const float o10 = x1[0] * ca[0] - x2[0] * ca[1], o11 = x1[1] * ca[2] - x2[1] * ca[3], o12 = x1[2] * cb[0] - x2[2] * cb[1], o13 = x1[3] * cb[2] - x2[3] * cb[3];
                    const float o20 = x2[0] * ca[0] + x1[0] * ca[1], o21 = x2[1] * ca[2] + x1[1] * ca[3], o22 = x2[2] * cb[0] + x1[2] * cb[1], o23 = x2[3] * cb[2] + x1[3] * cb[3];
                    uint2 w1, w2; w1.x = pk_bf16(o10, o11); w1.y = pk_bf16(o12, o13); w2.x = pk_bf16(o20, o21); w2.y = pk_bf16(o22, o23);
                    bf16_t* qp = Q + (((size_t)b * NH + (bj * 4 + wc)) * SEQ + s) * QKD + 64 + fq * 4; *(uint2*)qp = w1; *(uint2*)(qp + 16) = w2; }
            }
        EPI_ROWS_END
    }
};
struct EpiKV {
    static constexpr bool KEEP = false;
    bf16_t* Kc; bf16_t* V; const float* rskvp;
    __device__ __forceinline__ void operator()(const Acc& acc, const Unit& un, int wr, int wc, int fr, int fq) const {
        EPI_ROWS_BEGIN
            const int t = un.pm * 256 + rloc, b = t >> 11, s = t & 2047;
            const f32x4 pp = *(const f32x4*)(rskvp + (size_t)t * 4);
            const float rs = rsqrtf((pp[0] + pp[1] + pp[2] + pp[3]) * (1.0f / 128) + EPS);
#pragma unroll
            for (int bj = 0; bj < 2; ++bj) { const int col = (un.pn & 1) * 256 + bj * 128 + wc * 32 + fq * 8;
                const u32x4 w = pack8(acc[ai][bj][m][0] * rs, acc[ai][bj][m][1] * rs);
                if (un.pn < 2) *(u32x4*)(Kc + (((size_t)b * NH + (col >> 6)) * SEQ + s) * QKD + (col & 63)) = w;
                else *(u32x4*)(V + (((size_t)b * NH + (col >> 6)) * SEQ + s) * VD + (col & 63)) = w; }
        EPI_ROWS_END
    }
};
struct EpiS5b {
    static constexpr bool KEEP = false;
    float* xloc;
    __device__ __forceinline__ void operator()(const Acc& acc, const Unit& un, int wr, int wc, int fr, int fq) const {
        EPI_ROWS_BEGIN
            float* o = xloc + ((size_t)un.e * 512 + un.pm * 256 + rloc) * 128 + wc * 32 + fq * 8;
            *(f32x4*)o = acc[ai][0][m][0]; *(f32x4*)(o + 4) = acc[ai][0][m][1];
        EPI_ROWS_END
    }
};
template <int MODE> struct EpiS5y {
    static constexpr bool KEEP = false;
    bf16_t* dst; const bf16_t* yintra;
    __device__ __forceinline__ void operator()(const Acc& acc, const Unit& un, int wr, int wc, int fr, int fq) const {
        EPI_ROWS_BEGIN
            const int row = un.pm * 256 + rloc, b = row >> 5, j = row & 31;
#pragma unroll
            for (int bj = 0; bj < 2; ++bj) { const int n = un.pn * 256 + bj * 128 + wc * 32 + fq * 8, tt = n >> 4, c0 = n & 15;
                const size_t o = ((size_t)b * SEQ + j * CH + tt) * SSMW + un.e * SC + c0;
                f32x4 v0 = acc[ai][bj][m][0], v1 = acc[ai][bj][m][1];
                if (MODE == 1) { const bf16x8 yi = *(const bf16x8*)(yintra + o);
#pragma unroll
                    for (int q = 0; q < 4; ++q) { v0[q] = gelu_tanh(v0[q] + bf2f((bf16_t)yi[q])); v1[q] = gelu_tanh(v1[q] + bf2f((bf16_t)yi[4 + q])); } }
                *(u32x4*)(dst + o) = pack8(v0, v1); }
        EPI_ROWS_END
    }
};
struct EpiGlu {
    static constexpr bool KEEP = false;
    const bf16_t* Y; const float* bglu; bf16_t* AS; float* sss;
    __device__ __forceinline__ void operator()(const Acc& acc, const Unit& un, int wr, int wc, int fr, int fq) const {
        EPI_ROWS_BEGIN
            const int t = un.pm * 256 + rloc;
            float ssq = 0.f;
#pragma unroll
            for (int bj = 0; bj < 2; ++bj) { const int col = un.pn * 256 + bj * 128 + wc * 32 + fq * 8;
                const bf16x8 yv = *(const bf16x8*)(Y + (size_t)t * 512 + col);
                const f32x4 b0 = *(const f32x4*)(bglu + col), b1 = *(const f32x4*)(bglu + col + 4);
                f32x4 v0 = acc[ai][bj][m][0], v1 = acc[ai][bj][m][1];
#pragma unroll
                for (int q = 0; q < 4; ++q) { v0[q] = bf2f((bf16_t)yv[q]) * sigmoidf_(v0[q] + b0[q]); v1[q] = bf2f((bf16_t)yv[4 + q]) * sigmoidf_(v1[q] + b1[q]); }
                const u32x4 pk = pack8(v0, v1);
                *(u32x4*)(AS + (size_t)t * 1024 + 512 + col) = pk;
#pragma unroll
                for (int q = 0; q < 4; ++q) { const float lo = __uint_as_float(pk[q] << 16), hi = __uint_as_float(pk[q] & 0xffff0000u); ssq += lo * lo + hi * hi; } }
            ssq += __shfl_xor(ssq, 16); ssq += __shfl_xor(ssq, 32);
            if (fq == 0) sss[(size_t)t * 8 + un.pn * 4 + wc] = ssq;
        EPI_ROWS_END
    }
};
struct EpiWo {
    static constexpr bool KEEP = false;
    const float* x; const float* xstat; const float* g; const float* bt; float* pre1;
    __device__ __forceinline__ void operator()(const Acc& acc, const Unit& un, int wr, int wc, int fr, int fq) const {
        EPI_ROWS_BEGIN
            const int t = un.pm * 256 + rloc;
            const float mu = xstat[2 * t], rstd = xstat[2 * t + 1];
#pragma unroll
            for (int bj = 0; bj < 2; ++bj) { const int col = un.pn * 256 + bj * 128 + wc * 32 + fq * 8;
#pragma unroll
                for (int n = 0; n < 2; ++n) { const f32x4 xv = *(const f32x4*)(x + (size_t)t * D + col + 4 * n), gg = *(const f32x4*)(g + col + 4 * n), bb = *(const f32x4*)(bt + col + 4 * n);
                    f32x4 o;
#pragma unroll
                    for (int q = 0; q < 4; ++q) o[q] = acc[ai][bj][m][n][q] + ALPHA * ((xv[q] - mu) * rstd * gg[q] + bb[q]);
                    *(f32x4*)(pre1 + (size_t)t * D + col + 4 * n) = o; } }
        EPI_ROWS_END
    }
};
struct EpiWoLn {
    static constexpr bool KEEP = true;
    const float* x; const float* xstat; const float* gi; const float* bi; const float* g1; const float* b1;
    bf16_t* x1; unsigned char* x1q; float* pstat; XcdBarrier bar; const float* ssa; const float* sss;
    __device__ __forceinline__ void prefetch(const Unit&, int) const {}
    __device__ __forceinline__ void operator()(Acc& acc, const Unit& un, int wr, int wc, int fr, int fq) const {
        EPI_ROWS_BEGIN
            const int t = un.pm * 256 + rloc;
            const f32x4 a0 = *(const f32x4*)(ssa + (size_t)t * 8), a1 = *(const f32x4*)(ssa + (size_t)t * 8 + 4), b0 = *(const f32x4*)(sss + (size_t)t * 8), b1 = *(const f32x4*)(sss + (size_t)t * 8 + 4);
            const float ra = rsqrtf((a0[0] + a0[1] + a0[2] + a0[3] + a1[0] + a1[1] + a1[2] + a1[3]) * (1.0f / 512) + EPS);
            const float rs = rsqrtf((b0[0] + b0[1] + b0[2] + b0[3] + b1[0] + b1[1] + b1[2] + b1[3]) * (1.0f / 512) + EPS);
            const float sc = (un.e == 0) ? ra / rs : rs;
#pragma unroll
            for (int bj = 0; bj < 2; ++bj)
#pragma unroll
                for (int n = 0; n < 2; ++n) acc[ai][bj][m][n] *= sc;
        EPI_ROWS_END
        if (un.e == 0) return;
        EPI_ROWS_BEGIN
            const int t = un.pm * 256 + rloc;
            const float mu = xstat[2 * t], rstd = xstat[2 * t + 1];
            float s1 = 0.f, s2 = 0.f;
#pragma unroll
            for (int bj = 0; bj < 2; ++bj) { const int col = un.pn * 256 + bj * 128 + wc * 32 + fq * 8;
#pragma unroll
                for (int n = 0; n < 2; ++n) { const f32x4 xv = __builtin_nontemporal_load((const f32x4*)(x + (size_t)t * D + col + 4 * n)), gg = *(const f32x4*)(gi + col + 4 * n), bb = *(const f32x4*)(bi + col + 4 * n);
#pragma unroll
                    for (int q = 0; q < 4; ++q) { const float v = acc[ai][bj][m][n][q] + ALPHA * ((xv[q] - mu) * rstd * gg[q] + bb[q]); acc[ai][bj][m][n][q] = v; s1 += v; s2 += v * v; } } }
            s1 += __shfl_xor(s1, 16); s1 += __shfl_xor(s1, 32); s2 += __shfl_xor(s2, 16); s2 += __shfl_xor(s2, 32);
            if (fq == 0) { f32x2 o; o[0] = s1; o[1] = s2; *(f32x2*)(pstat + ((size_t)t * 16 + un.pn * 4 + wc) * 2) = o; }
        EPI_ROWS_END
        xcd_barrier(bar);
        EPI_ROWS_BEGIN
            const int t = un.pm * 256 + rloc;
            float s1 = 0.f, s2 = 0.f;
#pragma unroll
            for (int j = 0; j < 8; ++j) { const f32x4 p = *(const f32x4*)(pstat + (size_t)t * 32 + 4 * j); s1 += p[0] + p[2]; s2 += p[1] + p[3]; }
            const float mean = s1 * (1.0f / D), rs = rsqrtf(s2 * (1.0f / D) - mean * mean + EPS);
#pragma unroll
            for (int bj = 0; bj < 2; ++bj) { const int col = un.pn * 256 + bj * 128 + wc * 32 + fq * 8;
                f32x4 o[2];
#pragma unroll
                for (int n = 0; n < 2; ++n) { const f32x4 gg = *(const f32x4*)(g1 + col + 4 * n), bb = *(const f32x4*)(b1 + col + 4 * n);
#pragma unroll
                    for (int q = 0; q < 4; ++q) o[n][q] = (acc[ai][bj][m][n][q] - mean) * rs * gg[q] + bb[q]; }
                *(u32x4*)(x1 + (size_t)t * D + col) = pack8(o[0], o[1]);
                int p0 = __builtin_amdgcn_cvt_pk_fp8_f32(o[0][0] * XQ_SCALE, o[0][1] * XQ_SCALE, 0, false); p0 = __builtin_amdgcn_cvt_pk_fp8_f32(o[0][2] * XQ_SCALE, o[0][3] * XQ_SCALE, p0, true);
                int p1 = __builtin_amdgcn_cvt_pk_fp8_f32(o[1][0] * XQ_SCALE, o[1][1] * XQ_SCALE, 0, false); p1 = __builtin_amdgcn_cvt_pk_fp8_f32(o[1][2] * XQ_SCALE, o[1][3] * XQ_SCALE, p1, true);
                u32x2 w; w[0] = (unsigned)p0; w[1] = (unsigned)p1;
                *(u32x2*)(x1q + (size_t)t * D + col) = w; }
        EPI_ROWS_END
    }
};
struct EpiGU {
    static constexpr bool KEEP = false;
    static constexpr float QINV = 1.0f / (XQ_SCALE * WQ_SCALE);
    bf16_t* H; const float* roww; const int* eoff;
    __device__ __forceinline__ void operator()(const Acc& acc, const Unit& un, int wr, int wc, int fr, int fq) const {
        const int nrt = eoff[64] >> 8;
        const bool shared = un.e == 64;
        const int row0 = shared ? SH_ROW0 + (un.pm - nrt) * 256 : un.pm * 256;
        EPI_ROWS_BEGIN
            const int row = row0 + rloc;
            const f32x4 g0 = acc[ai][0][m][0], g1 = acc[ai][0][m][1], u0 = acc[ai][1][m][0], u1 = acc[ai][1][m][1];
            f32x4 h0, h1;
#pragma unroll
            for (int q = 0; q < 4; ++q) { const float ga = g0[q] * QINV, gb = g1[q] * QINV; h0[q] = ga * sigmoidf_(ga) * (u0[q] * QINV); h1[q] = gb * sigmoidf_(gb) * (u1[q] * QINV); }
            { int p0 = __builtin_amdgcn_cvt_pk_fp8_f32(h0[0] * HQ_SCALE, h0[1] * HQ_SCALE, 0, false); p0 = __builtin_amdgcn_cvt_pk_fp8_f32(h0[2] * HQ_SCALE, h0[3] * HQ_SCALE, p0, true);
              int p1 = __builtin_amdgcn_cvt_pk_fp8_f32(h1[0] * HQ_SCALE, h1[1] * HQ_SCALE, 0, false); p1 = __builtin_amdgcn_cvt_pk_fp8_f32(h1[2] * HQ_SCALE, h1[3] * HQ_SCALE, p1, true);
              u32x2 w; w[0] = (unsigned)p0; w[1] = (unsigned)p1;
              *(u32x2*)((unsigned char*)H + (size_t)row * FF + un.pn * 128 + wc * 32 + fq * 8) = w; }
        EPI_ROWS_END
    }
};
struct EpiDown {
    static constexpr bool KEEP = false;
    __device__ __forceinline__ void prefetch(const Unit&, int) const {}
    static constexpr float OSC = SLOT_SCALE / (HQ_SCALE * WQ_SCALE);
    unsigned char* yslot; unsigned char* shslot; const int* rowtok; const int* eoff; LAS unsigned char* stg;
    __device__ __forceinline__ void operator()(const Acc& acc, const Unit& un, int wr, int wc, int fr, int fq) const {
        const int nrt = eoff[64] >> 8;
        const bool shared = un.e == 64;
        const int tid = (wr * 4 + wc) * 64 + fq * 16 + fr;
        const int rrow = tid >> 4, rcol = (tid & 15) * 16;
        int slots[8];
#pragma unroll
        for (int q = 0; q < 8; ++q) { const int rloc = (q >> 2) * 128 + (rrow >> 4) * 64 + (q & 3) * 16 + (rrow & 15);
            slots[q] = (shared ? (un.pm - nrt) : un.pm) * 256 + rloc; }
        unsigned char* base = shared ? shslot : yslot;
        int p = 0;
#pragma unroll
        for (int ai = 0; ai < 2; ++ai)
#pragma unroll
            for (int m = 0; m < 4; ++m, ++p) {
                LAS unsigned char* sb = stg + (p & 1) * (32 * 288);
#pragma unroll
                for (int bj = 0; bj < 2; ++bj) {
                    const f32x4 v0 = acc[ai][bj][m][0] * OSC, v1 = acc[ai][bj][m][1] * OSC;
                    int p0 = __builtin_amdgcn_cvt_pk_fp8_f32(v0[0], v0[1], 0, false); p0 = __builtin_amdgcn_cvt_pk_fp8_f32(v0[2], v0[3], p0, true);
                    int p1 = __builtin_amdgcn_cvt_pk_fp8_f32(v1[0], v1[1], 0, false); p1 = __builtin_amdgcn_cvt_pk_fp8_f32(v1[2], v1[3], p1, true);
                    u32x2 w; w[0] = (unsigned)p0; w[1] = (unsigned)p1;
                    *(LAS u32x2*)(sb + (wr * 16 + fr) * 288 + bj * 128 + wc * 32 + fq * 8) = w;
                }
                asm volatile("s_waitcnt lgkmcnt(0)\n\ts_barrier" ::: "memory");
                const int slot = slots[ai * 4 + m];
                const u32x4 v = *(const LAS u32x4*)(sb + rrow * 288 + rcol);
                if (slot >= 0) *(u32x4*)(base + (size_t)slot * D + un.pn * 256 + rcol) = v;
            }
        asm volatile("s_waitcnt lgkmcnt(0)\n\ts_barrier" ::: "memory");
    }
};
}
namespace g8 {
struct EpiRouter {
    static constexpr bool KEEP = false;
    float* logits;
    __device__ __forceinline__ void operator()(const Acc& acc, const Unit& un, int wr, int wc, int fr, int fq) const {
        if (wc >= 2) return;
        EPI_ROWS_BEGIN
            float* o = logits + (size_t)(un.pm * 256 + rloc) * NE + wc * 32 + fq * 8;
            *(f32x4*)o = acc[ai][0][m][0]; *(f32x4*)(o + 4) = acc[ai][0][m][1];
        EPI_ROWS_END
    }
};
}
__device__ __forceinline__ void fp_gemm_router(const Ptrs& P, LAS unsigned char* lds) {
    g8::Geo g{2048, 2048, 128, 128, 0};
    g8::SchedReg S{(const char*)WSP(bf16_t, WS_X1), (const char*)WSP(bf16_t, WS_WR), 2048, 2048, T / 256, 1, 16};
    g8::EpiRouter E{WSP(float, WS_LOGITS)};
    g8::gemm_body<g8::EpiRouter, g8::SchedReg, false>(lds, g, S, E);
}
__device__ __forceinline__ void ph_topk_cnt(const Ptrs& P, LAS unsigned char* lds, int bid, int nb) {
    const int tidx = opaque_tid();
    const float* logits = WSP(float, WS_LOGITS); int* topi = WSP(int, WS_TOPI); float* topw = WSP(float, WS_TOPW); int* cnt = WSP(int, WS_CNT);
    LAS int* hist = (LAS int*)lds;
    LAS float* bias = (LAS float*)(lds + 256);
    LAS float* scs = (LAS float*)(lds + 512);
    for (int tile = bid; tile < 256; tile += nb) {
        if (tidx < 64) { hist[tidx] = 0; bias[tidx] = P.router_bias[tidx]; }
        for (int i = tidx; i < 128 * 64; i += NTHR) { const int tk = i >> 6, e = i & 63; scs[e * 128 + tk] = sigmoidf_(logits[(size_t)(tile * 128 + tk) * NE + e]); }
        __syncthreads();
        if (tidx < 128) {
            const int t = tile * 128 + tidx;
            unsigned gmask = 0u;
            {
                float gs[8];
#pragma unroll
                for (int g = 0; g < 8; ++g) { float m1 = -INFINITY, m2 = -INFINITY;
#pragma unroll 1
                    for (int j = 0; j < 8; ++j) { const float v = scs[(8 * g + j) * 128 + tidx] + bias[8 * g + j]; const bool a = v > m1; m2 = a ? m1 : fmaxf(m2, v); m1 = a ? v : m1; }
                    gs[g] = m1 + m2; }
#pragma unroll
                for (int g = 0; g < 8; ++g) { int c = 0;
#pragma unroll
                    for (int h = 0; h < 8; ++h) c += (gs[h] > gs[g] || (gs[h] == gs[g] && h < g)) ? 1 : 0;
                    gmask |= (c < 4) ? (1u << g) : 0u; }
            }
            float tv[8], ts[8]; int te[8];
#pragma unroll
            for (int k = 0; k < 8; ++k) { tv[k] = -INFINITY; ts[k] = 0.f; te[k] = 0; }
#pragma unroll 1
            for (int e = 0; e < 64; ++e) {
                const float s0 = scs[e * 128 + tidx];
                const float v = ((gmask >> (e >> 3)) & 1u) ? s0 + bias[e] : -INFINITY;
                if (v > tv[7]) { tv[7] = v; ts[7] = s0; te[7] = e; }
#pragma unroll
                for (int p = 7; p >= 1; --p) { const bool sw = tv[p] > tv[p - 1];
                    const float a = tv[p], b = tv[p - 1]; tv[p - 1] = sw ? a : b; tv[p] = sw ? b : a;
                    const float c = ts[p], d = ts[p - 1]; ts[p - 1] = sw ? c : d; ts[p] = sw ? d : c;
                    const int x = te[p], y = te[p - 1]; te[p - 1] = sw ? x : y; te[p] = sw ? y : x; }
            }
            float wsum = 0.f;
#pragma unroll
            for (int k = 0; k < 8; ++k) wsum += ts[k];
            const float sc_ = 2.5f / wsum;
            int* ip = topi + (size_t)t * TOPK; float* wp = topw + (size_t)t * TOPK;
            *(int4*)ip = make_int4(te[0], te[1], te[2], te[3]); *(int4*)(ip + 4) = make_int4(te[4], te[5], te[6], te[7]);
            *(f32x4*)wp = (f32x4){ts[0] * sc_, ts[1] * sc_, ts[2] * sc_, ts[3] * sc_}; *(f32x4*)(wp + 4) = (f32x4){ts[4] * sc_, ts[5] * sc_, ts[6] * sc_, ts[7] * sc_};
#pragma unroll
            for (int k = 0; k < 8; ++k) __hip_atomic_fetch_add(hist + te[k], 1, __ATOMIC_RELAXED, __HIP_MEMORY_SCOPE_WORKGROUP);
        }
        __syncthreads();
        if (tidx < 64) cnt[tile * 64 + tidx] = hist[tidx];
        __syncthreads();
    }
}
__device__ __forceinline__ void ph_lists2(const Ptrs& P, LAS unsigned char* lds, int bid, int nb) {
    const int tidx = opaque_tid();
    const int* topi = WSP(int, WS_TOPI); const float* topw = WSP(float, WS_TOPW); const int* cnt = WSP(int, WS_CNT);
    int* eoff = WSP(int, WS_EOFF); int* rowtok = WSP(int, WS_ROWTOK); int* invrow = WSP(int, WS_INVROW);
    LAS int* red_tot = (LAS int*)lds;
    LAS int* red_pre = red_tot + 512;
    LAS int* tot = red_pre + 512;
    LAS int* off = tot + 64;
    LAS int* seg = off + 128;
    LAS int* ti = seg + 512;
    LAS float* tw = (LAS float*)(ti + 1024);
    const int e = tidx & 63, part = tidx >> 6;
    for (int tile = bid; tile < 256; tile += nb) {
        int cv[32];
#pragma unroll
        for (int q = 0; q < 32; ++q) cv[q] = cnt[(part * 32 + q) * 64 + e];
        const int i0v = topi[tile * 1024 + tidx], i1v = topi[tile * 1024 + 512 + tidx];
        const float w0v = topw[tile * 1024 + tidx], w1v = topw[tile * 1024 + 512 + tidx];
        int st = 0, sp = 0;
#pragma unroll
        for (int q = 0; q < 32; ++q) { st += cv[q]; sp += (part * 32 + q < tile) ? cv[q] : 0; }
        red_tot[part * 64 + e] = st; red_pre[part * 64 + e] = sp;
        ti[tidx] = i0v; ti[tidx + 512] = i1v; tw[tidx] = w0v; tw[tidx + 512] = w1v;
        __syncthreads();
        int pre_e = 0;
        if (tidx < 64) { int a = 0;
#pragma unroll
            for (int q = 0; q < 8; ++q) { a += red_tot[q * 64 + tidx]; pre_e += red_pre[q * 64 + tidx]; } tot[tidx] = a; }
        int c = 0;
#pragma unroll 16
        for (int k = 0; k < 128; ++k) c += (ti[part * 128 + k] == e) ? 1 : 0;
        seg[part * 64 + e] = c;
        __syncthreads();
        if (tidx == 0) { int o = 0; for (int i = 0; i < 64; ++i) { off[i] = o; o += (tot[i] + 255) & ~255; } off[64] = o; }
        if (tidx < 64) red_pre[tidx] = pre_e;
        __syncthreads();
        int pos = off[e] + red_pre[e];
        for (int q = 0; q < part; ++q) pos += seg[q * 64 + e];
#pragma unroll 8
        for (int k = 0; k < 128; ++k) { const int idx = part * 128 + k; if (ti[idx] == e) { rowtok[pos] = tile * 1024 + idx; invrow[tile * 1024 + idx] = pos; ++pos; } }
        if (tile == 255 && part == 7) { const int end = off[e + 1]; for (; pos < end; ++pos) rowtok[pos] = -1; }
        if (bid == 0 && tidx <= 64) eoff[tidx] = off[tidx];
        if (bid == 0 && tidx < 64) { int* tile_e = WSP(int, WS_TILEE); for (int rt = off[tidx] >> 8; rt < (off[tidx + 1] >> 8); ++rt) tile_e[rt] = tidx; }
        __syncthreads();
    }
    for (int i = bid * NTHR + tidx; i < T; i += nb * NTHR) rowtok[SH_ROW0 + i] = i * 8;
}
__device__ __forceinline__ void fp_gemm_win(const Ptrs& P, LAS unsigned char* lds) {
    g8::Geo g{2048, 2048, 128, 128, 0};
    g8::SchedReg S{(const char*)WSP(bf16_t, WS_XN), (const char*)WSP(bf16_t, WS_WIN), 2048, 2048, T / 256, 4, 16};
    g8::EpiWin E{WSP(bf16_t, WS_CQ), WSP(bf16_t, WS_CKV), WSP(bf16_t, WS_U), WSP(bf16_t, WS_K), WSP(float2, WS_ROPE), WSP(float, WS_RSQ), WSP(float, WS_RSKV)};
    g8::gemm_body<g8::EpiWin, g8::SchedReg, false>(lds, g, S, E);
}
__device__ __forceinline__ void fp_gemm_q(const Ptrs& P, LAS unsigned char* lds) {
    g8::Geo g{512, 512, 128, 128, 0};
    g8::SchedReg S{(const char*)WSP(bf16_t, WS_CQ), (const char*)WSP(bf16_t, WS_WUQ), 512, 512, T / 256, 3, 4};
    g8::EpiQ E{WSP(bf16_t, WS_Q), WSP(float, WS_RSQ), WSP(float2, WS_ROPE)};
    g8::gemm_body<g8::EpiQ, g8::SchedReg, false>(lds, g, S, E);
}
__device__ __forceinline__ void fp_gemm_kv(const Ptrs& P, LAS unsigned char* lds) {
    g8::Geo g{512, 512, 128, 128, 0};
    g8::SchedReg S{(const char*)WSP(bf16_t, WS_CKV), (const char*)WSP(bf16_t, WS_WUKV), 512, 512, T / 256, 4, 4};
    g8::EpiKV E{WSP(bf16_t, WS_K), WSP(bf16_t, WS_V), WSP(float, WS_RSKV)};
    g8::gemm_body<g8::EpiKV, g8::SchedReg, false>(lds, g, S, E);
}
__device__ __forceinline__ void fp_gemm_s5b(const Ptrs& P, LAS unsigned char* lds) {
    g8::Geo g{2048, 2048, 128, 128, 0};
    g8::SchedS5 S{(const char*)WSP(bf16_t, WS_U), (const char*)WSP(bf16_t, WS_BLOC), 2048, 2048, 1, 16, (size_t)512 * 2048, (size_t)256 * 2048, 0};
    g8::EpiS5b E{WSP(float, WS_XLOC)};
    g8::gemm_body<g8::EpiS5b, g8::SchedS5, false>(lds, g, S, E);
}
__device__ __forceinline__ void fp_gemm_s5a(const Ptrs& P, LAS unsigned char* lds) {
    g8::Geo g{2048, 32, 128, -2048, 1};
    g8::SchedS5 S{(const char*)WSP(bf16_t, WS_U), (const char*)WSP(bf16_t, WS_KTAB), 2048, 32, 4, 16, (size_t)512 * 2048, 0, 1};
    g8::EpiS5y<0> E{WSP(bf16_t, WS_YINTRA), nullptr};
    g8::gemm_body<g8::EpiS5y<0>, g8::SchedS5, false>(lds, g, S, E);
}
__device__ __forceinline__ void fp_gemm_s5d(const Ptrs& P, LAS unsigned char* lds) {
    g8::Geo g{512, 512, 128, 128, 0};
    g8::SchedS5 S{(const char*)WSP(bf16_t, WS_XPREV), (const char*)WSP(bf16_t, WS_CLAM), 512, 512, 4, 4, (size_t)512 * 512, (size_t)1024 * 512, 0};
    g8::EpiS5y<1> E{WSP(bf16_t, WS_Y), WSP(bf16_t, WS_YINTRA)};
    g8::gemm_body<g8::EpiS5y<1>, g8::SchedS5, false>(lds, g, S, E);
}
__device__ __forceinline__ void fp_gemm_glu(const Ptrs& P, LAS unsigned char* lds) {
    g8::Geo g{1024, 1024, 128, 128, 0};
    g8::SchedReg S{(const char*)WSP(bf16_t, WS_Y), (const char*)WSP(bf16_t, WS_WGLU), 1024, 1024, T / 256, 2, 8};
    g8::EpiGlu E{WSP(bf16_t, WS_Y), P.b_glu, WSP(bf16_t, WS_AS), WSP(float, WS_SSS)};
    g8::gemm_body<g8::EpiGlu, g8::SchedReg, false>(lds, g, S, E);
}
__device__ __forceinline__ void fp_gemm_wo(const Ptrs& P, LAS unsigned char* lds) {
    g8::Geo g{2048, 2048, 128, 128, 0};
    g8::SchedReg S{(const char*)WSP(bf16_t, WS_AS), (const char*)WSP(bf16_t, WS_WO), 2048, 2048, T / 256, 4, 16};
    g8::EpiWo E{P.x, WSP(float, WS_XSTAT), P.ln_in_g, P.ln_in_b, P.out};
    g8::gemm_body<g8::EpiWo, g8::SchedReg, false>(lds, g, S, E);
}
namespace g8 {
struct SchedWo2 {
    const char* A; const char* B; int pm0;
    __device__ __forceinline__ bool next(int i, Unit& u) const {
        if (i >= 2) return false;
        const int L = unit_index(0, 256); if (L < 0) return false;
        u.pm = pm0 + L / 4; u.pn = L % 4; u.e = i; u.nt = 8; u.rows = nullptr;
        u.A = A + (size_t)u.pm * 256 * 2048 + (size_t)i * 1024; u.B = B + (size_t)u.pn * 256 * 2048 + (size_t)i * 1024;
        return true;
    }
};
}
__device__ __forceinline__ void fp_gemm_wo_ln(const Ptrs& P, LAS unsigned char* lds, const XcdBarrier& bar, int call) {
    g8::Geo g{2048, 2048, 128, 128, 0};
    g8::SchedWo2 S{(const char*)WSP(bf16_t, WS_AS), (const char*)WSP(bf16_t, WS_WO), call * 64};
    g8::EpiWoLn E{P.x, WSP(float, WS_XSTAT), P.ln_in_g, P.ln_in_b, P.ln1_g, P.ln1_b, WSP(bf16_t, WS_X1), WSP(unsigned char, WS_X1Q), WSP(float, WS_XLOC), bar, WSP(float, WS_SSA), WSP(float, WS_SSS)};
    g8::gemm_body<g8::EpiWoLn, g8::SchedWo2, false>(lds, g, S, E);
}
__device__ __forceinline__ void fp_gemm_gu(const Ptrs& P, LAS unsigned char* lds) {
    g8::Geo g{1024, 1024, 128, 128, 0};
    g8::SchedMoe S{(const char*)WSP(unsigned char, WS_X1Q), (const char*)WSP(unsigned char, WS_WGU), WSP(int, WS_EOFF), WSP(int, WS_ROWTOK), 1024, 2, 8, (size_t)512 * 1024, 1024, 1, WSP(int, WS_TILEE)};
    g8::EpiGU E{WSP(bf16_t, WS_H), WSP(float, WS_ROWW), WSP(int, WS_EOFF)};
    g8::gemm_body<g8::EpiGU, g8::SchedMoe, true, 1>(lds, g, S, E);
}
__device__ __forceinline__ void fp_gemm_down(const Ptrs& P, LAS unsigned char* lds) {
    g8::Geo g{256, 256, 128, 128, 0};
    g8::SchedMoe S{(const char*)WSP(unsigned char, WS_H), (const char*)WSP(unsigned char, WS_WD), WSP(int, WS_EOFF), WSP(int, WS_ROWTOK), 256, 4, 2, (size_t)1024 * 256, 256, 0, WSP(int, WS_TILEE)};
    g8::EpiDown E{WSP(unsigned char, WS_YSLOT), WSP(unsigned char, WS_SHSLOT), WSP(int, WS_ROWTOK), WSP(int, WS_EOFF), lds + LDS_XTRA};
    g8::gemm_body<g8::EpiDown, g8::SchedMoe, false, 1>(lds, g, S, E);
}
namespace at8 {
typedef short s16x4 __attribute__((ext_vector_type(4)));
typedef short v4i16_t __attribute__((ext_vector_type(4)));
constexpr int KSLOT = 12288, VSLOT = 8192, NSLOT = 3;
constexpr int L_K = 0, L_V = NSLOT * KSLOT, L_WS = L_V + NSLOT * VSLOT, L_OST = L_WS + 8 * 256, L_END = L_OST + 8 * 4096;
__device__ __forceinline__ int crow(int r, int hi) { return (r & 3) + 8 * (r >> 2) + 4 * hi; }
__device__ __forceinline__ void glds16(const void* gsrc, LAS unsigned char* dst) { __builtin_amdgcn_global_load_lds((const unsigned*)gsrc, (LAS unsigned*)dst, 16, 0, 0); }
__device__ __forceinline__ s16x4 vtr(const LAS unsigned char* p) { return __builtin_bit_cast(s16x4, __builtin_amdgcn_ds_read_tr16_b64_v4i16((LAS v4i16_t*)p)); }
__device__ __forceinline__ unsigned cvtpk(float lo, float hi) { return pk_bf16_hw(lo, hi); }

__device__ __forceinline__ void attn_unit(int b, int h, int qb, const bf16_t* __restrict__ Q, const bf16_t* __restrict__ Kc, const bf16_t* __restrict__ V, bf16_t* __restrict__ AS, float* __restrict__ ssa, LAS unsigned char* lds) {
    const int tid = opaque_tid(), lane = tid & 63, r32 = lane & 31, hi = lane >> 5;
    const int wid = __builtin_amdgcn_readfirstlane(tid >> 6);
    const size_t bh = (size_t)b * NH + h;
    const bf16_t* Kbh = Kc + bh * SEQ * QKD; const bf16_t* Vbh = V + bh * SEQ * VD;
    const int q0 = qb * 256 + wid * 32;
    const int NT = 4 * (qb + 1);
    const int myNT = 4 * qb + (wid >> 1) + 1;
    const bf16_t* ksrc0 = Kbh + (size_t)lane * QKD + wid * 8;
    const bf16_t* ksrc1 = Kbh + (size_t)lane * QKD + (8 + (wid & 3)) * 8;
    const bf16_t* vsrc = Vbh + (size_t)(16 * (wid & 3) + (lane >> 2)) * VD + (wid >> 2) * 32 + (lane & 3) * 8;
#define AT_DMA(t, slot) do { glds16(ksrc0 + (size_t)(t) * 64 * QKD, lds + L_K + (slot) * KSLOT + wid * 1024); \
                             glds16(ksrc1 + (size_t)(t) * 64 * QKD, lds + L_K + (slot) * KSLOT + (8 + (wid & 3)) * 1024); \
                             glds16(vsrc + (size_t)(t) * 64 * VD, lds + L_V + (slot) * VSLOT + wid * 1024); } while (0)
    AT_DMA(0, 0);
    if (NT > 1) AT_DMA(1, 1);
    bf16x8 qr[6];
    const bf16_t* qp = Q + (bh * SEQ + q0 + r32) * QKD + hi * 8;
#pragma unroll
    for (int ks = 0; ks < 6; ++ks) qr[ks] = *(const bf16x8*)(qp + ks * 16);
    f32x16 o0, o1;
#pragma unroll
    for (int i = 0; i < 16; ++i) { o0[i] = 0.f; o1[i] = 0.f; }
    float m_run = 0.f, l_run = 0.f;
    LAS float* wsf = (LAS float*)(lds + L_WS) + wid * 64;
    const LAS unsigned char* kp0 = lds + L_K + hi * 1024 + r32 * 16;
    const LAS unsigned char* vp0 = lds + L_V + ((lane >> 4) & 1) * 32 + (lane & 3) * 8 + (4 * hi + ((lane & 15) >> 2)) * 64;
    int slot = 0;
    for (int t = 0; t < NT; ++t) {
        if (t + 1 < NT) asm volatile("s_waitcnt vmcnt(3)" ::: "memory"); else asm volatile("s_waitcnt vmcnt(0)" ::: "memory");
        asm volatile("s_waitcnt lgkmcnt(0)\n\ts_barrier" ::: "memory");
        if (t + 2 < NT) { const int s2 = (slot == 0) ? 2 : slot - 1; AT_DMA(t + 2, s2); }
        if (t < myNT) {
            const LAS unsigned char* kp = kp0 + slot * KSLOT; const LAS unsigned char* vp = vp0 + slot * VSLOT;
            f32x16 p0, p1;
#pragma unroll
            for (int i = 0; i < 16; ++i) { p0[i] = -m_run; p1[i] = -m_run; }
#pragma unroll
            for (int ks = 0; ks < 6; ++ks) {
                const bf16x8 a0 = *(const LAS bf16x8*)(kp + ks * 2048), a1 = *(const LAS bf16x8*)(kp + ks * 2048 + 512);
                p0 = __builtin_amdgcn_mfma_f32_32x32x16_bf16(a0, qr[ks], p0, 0, 0, 0);
                p1 = __builtin_amdgcn_mfma_f32_32x32x16_bf16(a1, qr[ks], p1, 0, 0, 0);
            }
            float rm = fmaxf(p0[0], p1[0]);
#pragma unroll
            for (int i = 1; i < 16; ++i) rm = fmaxf(rm, fmaxf(p0[i], p1[i]));
            { auto rr = __builtin_amdgcn_permlane32_swap(__float_as_uint(rm), __float_as_uint(rm), false, false); rm = fmaxf(__uint_as_float(rr[0]), __uint_as_float(rr[1])); }
            if (__any(rm > 8.0f)) {
                const float dl = fmaxf(rm, 0.f);
                const float alpha = __builtin_amdgcn_exp2f(-dl);
                l_run *= alpha; m_run += dl;
#pragma unroll
                for (int i = 0; i < 16; ++i) { p0[i] -= dl; p1[i] -= dl; }
                if (hi == 0) wsf[r32] = alpha;
                asm volatile("s_waitcnt lgkmcnt(0)" ::: "memory");
#pragma unroll
                for (int i = 0; i < 16; ++i) { const float a = wsf[crow(i, hi)]; o0[i] *= a; o1[i] *= a; }
            }
            float ls = 0.f;
#pragma unroll
            for (int i = 0; i < 16; ++i) { p0[i] = __builtin_amdgcn_exp2f(p0[i]); p1[i] = __builtin_amdgcn_exp2f(p1[i]); ls += p0[i] + p1[i]; }
            l_run += ls;
            u32x4 w0, w1, w2, w3;
            w0 = (u32x4){cvtpk(p0[0], p0[1]), cvtpk(p0[2], p0[3]), cvtpk(p0[4], p0[5]), cvtpk(p0[6], p0[7])};
            w1 = (u32x4){cvtpk(p0[8], p0[9]), cvtpk(p0[10], p0[11]), cvtpk(p0[12], p0[13]), cvtpk(p0[14], p0[15])};
            w2 = (u32x4){cvtpk(p1[0], p1[1]), cvtpk(p1[2], p1[3]), cvtpk(p1[4], p1[5]), cvtpk(p1[6], p1[7])};
            w3 = (u32x4){cvtpk(p1[8], p1[9]), cvtpk(p1[10], p1[11]), cvtpk(p1[12], p1[13]), cvtpk(p1[14], p1[15])};
            const bf16x8 pa[4] = {__builtin_bit_cast(bf16x8, w0), __builtin_bit_cast(bf16x8, w1), __builtin_bit_cast(bf16x8, w2), __builtin_bit_cast(bf16x8, w3)};
#pragma unroll
            for (int k = 0; k < 4; ++k) {
                const s16x4 l0 = vtr(vp + k * 1024), h0 = vtr(vp + k * 1024 + 512), l1 = vtr(vp + 4096 + k * 1024), h1 = vtr(vp + 4096 + k * 1024 + 512);
                const bf16x8 v0 = (bf16x8){l0[0], l0[1], l0[2], l0[3], h0[0], h0[1], h0[2], h0[3]};
                const bf16x8 v1 = (bf16x8){l1[0], l1[1], l1[2], l1[3], h1[0], h1[1], h1[2], h1[3]};
                o0 = __builtin_amdgcn_mfma_f32_32x32x16_bf16(pa[k], v0, o0, 0, 0, 0);
                o1 = __builtin_amdgcn_mfma_f32_32x32x16_bf16(pa[k], v1, o1, 0, 0, 0);
            }
        }
        slot = (slot == 2) ? 0 : slot + 1;
    }
    { auto rr = __builtin_amdgcn_permlane32_swap(__float_as_uint(l_run), __float_as_uint(l_run), false, false); l_run = __uint_as_float(rr[0]) + __uint_as_float(rr[1]); }
    if (hi == 0) wsf[32 + r32] = l_run;
    asm volatile("s_waitcnt lgkmcnt(0)" ::: "memory");
    LAS bf16_t* stg = (LAS bf16_t*)(lds + L_OST) + wid * 2048;
#pragma unroll
    for (int i = 0; i < 16; ++i) { const int orow = crow(i, hi); const float rl = 1.0f / wsf[32 + orow];
        stg[orow * 64 + r32] = f2bf(o0[i] * rl); stg[orow * 64 + 32 + r32] = f2bf(o1[i] * rl); }
    asm volatile("s_waitcnt lgkmcnt(0)" ::: "memory");
    if (lane < 32) { float ssq = 0.f;
#pragma unroll
        for (int c = 0; c < 8; ++c) { const u32x4 v = *(const LAS u32x4*)(stg + lane * 64 + c * 8);
#pragma unroll
            for (int q = 0; q < 4; ++q) { const float lo = __uint_as_float(v[q] << 16), hi = __uint_as_float(v[q] & 0xffff0000u); ssq += lo * lo + hi * hi; } }
        ssa[((size_t)b * SEQ + q0 + lane) * 8 + h] = ssq; }
    bf16_t* Ow = AS + ((size_t)b * SEQ + q0) * 1024 + h * 64;
#pragma unroll
    for (int i = 0; i < 4; ++i) { const int row = i * 8 + (lane >> 3), ch = lane & 7; const u32x4 v = *(const LAS u32x4*)(stg + row * 64 + ch * 8); *(u32x4*)(Ow + (size_t)row * 1024 + ch * 8) = v; }
    asm volatile("s_waitcnt lgkmcnt(0)\n\ts_barrier" ::: "memory");
#undef AT_DMA
}
__device__ __forceinline__ void attn_phase(const Ptrs& P, LAS unsigned char* lds, int bid, int nb) {
    const bf16_t* Q = WSP(bf16_t, WS_Q); const bf16_t* Kc = WSP(bf16_t, WS_K); const bf16_t* V = WSP(bf16_t, WS_V); bf16_t* AS = WSP(bf16_t, WS_AS);
    const int vcu = ((nb & 7) == 0) ? (bid & 7) * (nb >> 3) + (bid >> 3) : bid;
    for (int p = vcu; p < 512; p += nb) {
        const int bh = p >> 2, s = p & 3;
        attn_unit(bh >> 3, bh & 7, 7 - s, Q, Kc, V, AS, WSP(float, WS_SSA), lds);
        attn_unit(bh >> 3, bh & 7, s, Q, Kc, V, AS, WSP(float, WS_SSA), lds);
    }
}
}
__global__ void __launch_bounds__(NTHR, 2) mega(Args a) {
    extern __shared__ __attribute__((aligned(16))) unsigned char lds_raw[];
    LAS unsigned char* lds = (LAS unsigned char*)lds_raw;
    Ptrs P;
    P.x = (const float*)a.in[0]; P.positions = (const int*)a.in[1]; P.ln_in_g = (const float*)a.in[2]; P.ln_in_b = (const float*)a.in[3];
    P.w_in = (const float*)a.in[4]; P.q_norm_g = (const float*)a.in[5]; P.kv_norm_g = (const float*)a.in[6]; P.w_uq = (const float*)a.in[7]; P.w_ukv = (const float*)a.in[8];
    P.lambda_re = (const float*)a.in[9]; P.lambda_im = (const float*)a.in[10]; P.log_step = (const float*)a.in[11]; P.b_re = (const float*)a.in[12]; P.b_im = (const float*)a.in[13];
    P.c_re = (const float*)a.in[14]; P.c_im = (const float*)a.in[15]; P.d_skip = (const float*)a.in[16]; P.w_glu = (const float*)a.in[17]; P.b_glu = (const float*)a.in[18];
    P.attn_out_g = (const float*)a.in[19]; P.ssm_out_g = (const float*)a.in[20]; P.w_o = (const float*)a.in[21]; P.ln1_g = (const float*)a.in[22]; P.ln1_b = (const float*)a.in[23];
    P.w_router = (const float*)a.in[24]; P.router_bias = (const float*)a.in[25]; P.w_gate = (const float*)a.in[26]; P.w_up = (const float*)a.in[27]; P.w_down = (const float*)a.in[28];
    P.ws_gate = (const float*)a.in[29]; P.ws_up = (const float*)a.in[30]; P.ws_down = (const float*)a.in[31]; P.ln2_g = (const float*)a.in[32]; P.ln2_b = (const float*)a.in[33];
    P.out = a.out; P.ws = a.ws;
    const int bid = blockIdx.x, nb = gridDim.x;
    volatile LAS unsigned* misc = (volatile LAS unsigned*)(lds + LDS_MISC);
    if (threadIdx.x < 64) misc[threadIdx.x] = 0u;
    __syncthreads();
    XcdBarrier bar = xcd_barrier_post((unsigned*)(P.ws + WS_CTL) + 4096, misc);
#define GRID_BAR() xcd_barrier(bar)

    ph_ln_in(P, bid, nb); ph_wprep(P, lds, bid, nb); ph_s5tab1(P, bid, nb); ph_ropetab(P, bid, nb);
    GRID_BAR();
    ph_s5tab2(P, lds, bid, nb);
#if FAST_WIN
    fp_gemm_win(P, lds);
    GRID_BAR();
#else
    ph_gemm_win(P, bid, nb);
    GRID_BAR();
    ph_rstat(P, bid, nb);
    GRID_BAR();
#endif
#if FAST_QKV
    fp_gemm_q(P, lds); fp_gemm_kv(P, lds);
#else
    ph_gemm_q(P, bid, nb); ph_gemm_kv(P, bid, nb);
#endif
#if FAST_S5
    fp_gemm_s5b(P, lds); fp_gemm_s5a(P, lds);
#else
    ph_gemm_s5b(P, bid, nb); ph_gemm_s5a(P, bid, nb);
#endif
    GRID_BAR();
#if !FAST_QKV || !FAST_WIN
    ph_rope_apply(P, bid, nb);
#endif
    ph_s5scan(P, bid, nb);
#if !FAST_QKV || !FAST_WIN
    GRID_BAR();
#endif
#if FAST_ATTN
    at8::attn_phase(P, lds, bid, nb);
#else
    ph_attn_simple(P, lds, bid, nb);
#endif
    GRID_BAR();
#if FAST_S5
    fp_gemm_s5d(P, lds);
#else
    ph_gemm_s5d(P, bid, nb);
#endif
    GRID_BAR();
#if FAST_GLU
    fp_gemm_glu(P, lds);
#else
    ph_gemm_glu(P, bid, nb);
#endif
    GRID_BAR();
    if (nb != 256) { ph_asnorm(P, bid, nb); GRID_BAR(); }
#if FAST_WO
    if (nb == 256) { fp_gemm_wo_ln(P, lds, bar, 0); fp_gemm_wo_ln(P, lds, bar, 1); }
    else {
    fp_gemm_wo(P, lds);
    GRID_BAR();
    ph_ln1(P, bid, nb);
    }
#else
    ph_gemm_wo(P, bid, nb);
    GRID_BAR();
    ph_ln1(P, bid, nb);
#endif
    GRID_BAR();
    fp_gemm_router(P, lds);
    GRID_BAR();
    ph_topk_cnt(P, lds, bid, nb);
    GRID_BAR();
    ph_lists2(P, lds, bid, nb);
    GRID_BAR();
#if FAST_MOE
    fp_gemm_gu(P, lds);
    GRID_BAR();
    fp_gemm_down(P, lds);
#else
    ph_gemm_gu(P, bid, nb);
    GRID_BAR();
    ph_gemm_down(P, bid, nb);
#endif
    GRID_BAR();
    ph_combine(P, bid, nb);
}

extern "C" void kernel_launch(void* const* d_in, const int* in_sizes, int n_in, void* d_out, int out_size, void* d_ws, size_t ws_size, hipStream_t stream) {
    (void)in_sizes; (void)out_size;
    if (ws_size < WS_NEED || n_in != 34) return;
    static int grid = 0;
    if (grid == 0) {
        int dev = 0, cus = 0;
        if (hipGetDevice(&dev) != hipSuccess || hipDeviceGetAttribute(&cus, hipDeviceAttributeMultiprocessorCount, dev) != hipSuccess) { grid = -1; return; }
        if (hipFuncSetAttribute((const void*)mega, hipFuncAttributeMaxDynamicSharedMemorySize, LDS_BYTES) != hipSuccess) { grid = -1; return; }
        int per_cu = 0;
        if (hipOccupancyMaxActiveBlocksPerMultiprocessor(&per_cu, (const void*)mega, NTHR, LDS_BYTES) != hipSuccess || per_cu < 1) { (void)hipGetLastError(); }
        grid = cus;
    }
    if (grid < 0) return;
    (void)hipMemsetAsync((char*)d_ws + WS_CTL, 0, 1 << 20, stream);
    Args a; memset(&a, 0, sizeof(a));
    for (int i = 0; i < 34; ++i) a.in[i] = d_in[i];
    a.out = (float*)d_out; a.ws = (unsigned char*)d_ws;
    hipLaunchKernelGGL(mega, dim3(grid), dim3(NTHR), LDS_BYTES, stream, a);
}
```

```cpp
#include <hip/hip_runtime.h>
#include <stdint.h>
#include <string.h>

typedef unsigned short bf16_t;
typedef short bf16x8 __attribute__((ext_vector_type(8)));
typedef float f32x16 __attribute__((ext_vector_type(16)));
typedef float f32x4 __attribute__((ext_vector_type(4)));
typedef unsigned u32x4 __attribute__((ext_vector_type(4)));
typedef unsigned u32x2 __attribute__((ext_vector_type(2)));
typedef float f32x2 __attribute__((ext_vector_type(2)));

#ifndef FAST_WIN
#define FAST_WIN 1
#endif
#ifndef FAST_QKV
#define FAST_QKV 1
#endif
#ifndef FAST_S5
#define FAST_S5 1
#endif
#ifndef FAST_GLU
#define FAST_GLU 1
#endif
#ifndef FAST_WO
#define FAST_WO 1
#endif
#ifndef FAST_ATTN
#define FAST_ATTN 1
#endif
#ifndef FAST_MOE
#define FAST_MOE 1
#endif
constexpr int T = 32768, D = 1024, SEQ = 2048, NB = 16;
constexpr int NH = 8, QKD = 96, VD = 64;
constexpr int QRANK = 256, KVRANK = 128, ROPE = 32;
constexpr int SSMW = 512, SG = 32, SC = 16, SP = 64, CH = 64, NCH = SEQ / CH;
constexpr int NE = 64, TOPK = 8, FF = 256;
constexpr float ALPHA = 1.189207115002721f;
constexpr float EPS = 1e-5f;
constexpr float QSCALE = 0.10206207261596577f * 1.4426950408889634f;
constexpr float SLOT_SCALE = 16.0f;
constexpr float XQ_SCALE = 16.0f, WQ_SCALE = 256.0f, HQ_SCALE = 8.0f;
constexpr int RROUT = 278528;
constexpr int SH_ROW0 = RROUT;
constexpr int RTOT = RROUT + T;

constexpr size_t MiB = 1ull << 20;
constexpr size_t WS_CTL = 0;
constexpr size_t WS_TOPI = 1 * MiB, WS_TOPW = 2 * MiB, WS_ROWTOK = 3 * MiB, WS_ROWW = 4 * MiB + MiB / 2;
constexpr size_t WS_CNT = 6 * MiB, WS_TOFF = 6 * MiB + 65536, WS_EOFF = 6 * MiB + 131072, WS_ECNT = 6 * MiB + 131072 + 1024;
constexpr size_t WS_TILEE = 6 * MiB + 262144;
constexpr size_t WS_WD = 7 * MiB;
constexpr size_t WS_X1 = 40 * MiB;
constexpr size_t WS_XN = WS_X1, WS_AS = WS_X1;
constexpr size_t WS_H = 104 * MiB;
constexpr size_t WS_CQ = 104 * MiB, WS_CKV = 120 * MiB, WS_U = 136 * MiB, WS_YINTRA = 168 * MiB, WS_Y = 200 * MiB;
constexpr size_t WS_QRRAW = 200 * MiB;
constexpr size_t WS_XLOC = 232 * MiB, WS_XPREV = 240 * MiB, WS_LOGITS = 248 * MiB, WS_KRRAW = 248 * MiB;
constexpr size_t WS_X1LO = 104 * MiB;
constexpr size_t WS_YSLOT = 180 * MiB;
constexpr size_t WS_INVROW = 4 * MiB + MiB / 2;
constexpr size_t WS_WGU = 256 * MiB;
constexpr size_t WS_WIN = 321 * MiB, WS_WO = 323 * MiB, WS_WUQ = 325 * MiB, WS_WUKV = 325 * MiB + MiB / 2, WS_WGLU = 326 * MiB;
constexpr size_t WS_WR = 326 * MiB + MiB / 2;
constexpr size_t WS_BLOC = 327 * MiB, WS_CLAM = 343 * MiB, WS_KTAB = 359 * MiB, WS_LAMPOW = 361 * MiB, WS_BBAR = 363 * MiB;
constexpr size_t WS_ROPE = 364 * MiB, WS_XSTAT = 368 * MiB, WS_RSQ = 368 * MiB + MiB / 2, WS_RSKV = 369 * MiB;
constexpr size_t WS_Q = 370 * MiB, WS_K = 418 * MiB, WS_V = 466 * MiB;
constexpr size_t WS_LAMPOWT = 498 * MiB;
constexpr size_t WS_X1Q = 370 * MiB;
constexpr size_t WS_SHSLOT = 452 * MiB;
constexpr size_t WS_SSA = 499 * MiB + MiB / 2, WS_SSS = 501 * MiB;
constexpr size_t WS_KROPE = 503 * MiB;
constexpr size_t WS_NEED = 512 * MiB;

typedef __bf16 bf16x2_hw __attribute__((ext_vector_type(2)));
__device__ __forceinline__ unsigned pk_bf16_hw(float lo, float hi) { const f32x2 v = {lo, hi}; const bf16x2_hw b = __builtin_convertvector(v, bf16x2_hw); return __builtin_bit_cast(unsigned, b); }
__device__ __forceinline__ bf16_t f2bf(float f) { return (bf16_t)(pk_bf16_hw(f, 0.f) & 0xffffu); }
__device__ __forceinline__ float bf2f(bf16_t b) { return __uint_as_float(((unsigned)b) << 16); }
__device__ __forceinline__ int crow(int i, int h) { return (i & 3) + 8 * (i >> 2) + 4 * h; }
__device__ __forceinline__ float wave_sum(float v) {
#pragma unroll
    for (int o = 32; o > 0; o >>= 1) v += __shfl_xor(v, o);
    return v;
}
__device__ __forceinline__ float wave_max(float v) {
#pragma unroll
    for (int o = 32; o > 0; o >>= 1) v = fmaxf(v, __shfl_xor(v, o));
    return v;
}
__device__ __forceinline__ float sigmoidf_(float z) { return 1.0f / (1.0f + __expf(-z)); }
__device__ __forceinline__ float gelu_tanh(float y) {
    const float z = 0.7978845608028654f * (y + 0.044715f * y * y * y);
    const float th = 1.0f - 2.0f / (1.0f + __expf(2.0f * z));
    return 0.5f * y * (1.0f + th);
}
__host__ __device__ __forceinline__ int ropeperm(int q) { return 16 * ((q >> 2) & 1) + 4 * (q >> 3) + (q & 3); }
__host__ __device__ __forceinline__ int ropepos(int j) { const int n = j >> 4, r = j & 15; return 8 * (r >> 2) + 4 * n + (r & 3); }

__device__ __forceinline__ void cexp_d(double re, double im, double& ore, double& oim) {
    const double s = 1.0 / 1048576.0;
    const double a = re * s, b = im * s;
    double tr = 1.0, ti = 0.0, sr = 1.0, si = 0.0;
#pragma unroll
    for (int n = 1; n <= 8; ++n) {
        const double nr = (tr * a - ti * b) / n, ni = (tr * b + ti * a) / n;
        tr = nr; ti = ni; sr += tr; si += ti;
    }
#pragma unroll
    for (int i = 0; i < 20; ++i) { const double nr = sr * sr - si * si, ni = 2.0 * sr * si; sr = nr; si = ni; }
    ore = sr; oim = si;
}

__device__ __forceinline__ int opaque_tid() { int t = threadIdx.x; asm volatile("" : "+v"(t)); return t; }
template <bool DUAL, class AF, class BF, class EPI>
__device__ __forceinline__ void sg_tile(int m0, int n0, int K, AF arow, BF bptr, EPI epi) {
    const int tidx = opaque_tid();
    const int lane = tidx & 63, r = lane & 31, h = lane >> 5;
    f32x16 acc, acc2;
#pragma unroll
    for (int i = 0; i < 16; ++i) { acc[i] = 0.f; acc2[i] = 0.f; }
    const bf16_t* ap = arow(m0 + r);
    for (int k0 = 0; k0 < K; k0 += 16) {
        const bf16x8 a = *(const bf16x8*)(ap + k0 + 8 * h);
        const bf16x8 b = *(const bf16x8*)(bptr(n0 + r, k0 + 8 * h, 0));
        acc = __builtin_amdgcn_mfma_f32_32x32x16_bf16(a, b, acc, 0, 0, 0);
        if (DUAL) {
            const bf16x8 b2 = *(const bf16x8*)(bptr(n0 + r, k0 + 8 * h, 1));
            acc2 = __builtin_amdgcn_mfma_f32_32x32x16_bf16(a, b2, acc2, 0, 0, 0);
        }
    }
#pragma unroll
    for (int i = 0; i < 16; ++i) epi(m0 + crow(i, h), n0 + r, acc[i], acc2[i]);
}

#define LAS __attribute__((address_space(3)))
#define XB_TMO      128
#define XB_XCNT(j)  (256  + 64 * (j))
#define XB_XSUB(j)  (1280 + 64 * (j))
#define XB_XGEN(j)  (2304 + 64 * (j))
#define XB_TOP      3328
#define XB_TOPGEN   3392
#define XCD_BAR_WORDS 3456
#define XB_SPIN_CAP (1u << 18)
__device__ __forceinline__ unsigned xb_ld(unsigned* p)              { return __hip_atomic_load(p, __ATOMIC_RELAXED, __HIP_MEMORY_SCOPE_AGENT); }
__device__ __forceinline__ unsigned xb_add(unsigned* p, unsigned v) { return __hip_atomic_fetch_add(p, v, __ATOMIC_RELAXED, __HIP_MEMORY_SCOPE_AGENT); }
__device__ __forceinline__ unsigned xb_xcc_id() { return (unsigned)__builtin_amdgcn_s_getreg((3 << 11) | 20) & 0xFu; }
#define XB_SPIN(cond, bar) do { unsigned _sp = 0; while (cond) { __builtin_amdgcn_s_sleep(1); \
    if ((++_sp & 255u) == 0u) { if (xb_ld(&(bar)[XB_TMO])) break; if (_sp > XB_SPIN_CAP) { atomicAdd(&(bar)[XB_TMO], 1u); break; } } } } while (0)
struct XcdBarrier { unsigned* bar; unsigned x; volatile LAS unsigned* st; };
__device__ __forceinline__ XcdBarrier xcd_barrier_post(unsigned* bar, volatile LAS unsigned* st) {
    XcdBarrier b; b.bar = bar; b.x = xb_xcc_id(); b.st = st;
    if (threadIdx.x == 0) (void)xb_add(&bar[XB_XCNT(b.x)], 1u);
    return b;
}
__device__ __forceinline__ void xcd_barrier_complete(unsigned* bar, unsigned x, unsigned& nloc, unsigned& nx) {
    const unsigned G = gridDim.x * gridDim.y * gridDim.z;
    unsigned sum, cnt, mine, sp = 0u;
    for (;;) {
        sum = 0u; cnt = 0u; mine = 0u;
#pragma unroll
        for (unsigned j = 0; j < 16; ++j) { const unsigned c = xb_ld(&bar[XB_XCNT(j)]); sum += c; cnt += (c > 0u) ? 1u : 0u; mine = (j == x) ? c : mine; }
        if (sum == G) break;
        __builtin_amdgcn_s_sleep(1);
        if ((++sp & 255u) == 0u) { if (xb_ld(&bar[XB_TMO])) break; if (sp > XB_SPIN_CAP) { atomicAdd(&bar[XB_TMO], 1u); break; } }
    }
    nloc = mine > 0u ? mine : 1u; nx = cnt > 0u ? cnt : 1u;
}
__device__ __forceinline__ void xcd_barrier(const XcdBarrier& b) {
    asm volatile("s_waitcnt vmcnt(0)" ::: "memory");
    __syncthreads();
    if (threadIdx.x == 0) {
        unsigned* bar = b.bar;
        __builtin_amdgcn_s_waitcnt(0);
        unsigned nloc = b.st[0], nx = b.st[1];
        if (nloc == 0u) { xcd_barrier_complete(bar, b.x, nloc, nx); b.st[0] = nloc; b.st[1] = nx; }
        const unsigned old = xb_add(&bar[XB_XSUB(b.x)], 1u);
        const unsigned gen = old / nloc;
        if (old + 1u == (gen + 1u) * nloc) {
            __builtin_amdgcn_fence(__ATOMIC_RELEASE, "agent");
            asm volatile("s_waitcnt vmcnt(0)" ::: "memory");
            const unsigned og = xb_add(&bar[XB_TOP], 1u);
            const unsigned tg = og / nx;
            if (og + 1u == (tg + 1u) * nx) xb_add(&bar[XB_TOPGEN], 1u);
            else XB_SPIN(xb_ld(&bar[XB_TOPGEN]) == tg, bar);
            __builtin_amdgcn_fence(__ATOMIC_ACQUIRE, "agent");
            xb_add(&bar[XB_XGEN(b.x)], 1u);
            asm volatile("s_waitcnt vmcnt(0)" ::: "memory");
        } else {
            XB_SPIN(xb_ld(&bar[XB_XGEN(b.x)]) == gen, bar);
            __builtin_amdgcn_fence(__ATOMIC_ACQUIRE, "agent");
            asm volatile("s_waitcnt vmcnt(0)" ::: "memory");
        }
    }
    __syncthreads();
}

constexpr int NTHR = 512, NWAVE = 8;
constexpr int LDS_BYTES = 163840;
constexpr int LDS_MISC = 163840 - 256;
constexpr int LDS_XTRA = 131072;
struct Args { const void* in[34]; float* out; unsigned char* ws; };
struct Ptrs {
    const float *x, *ln_in_g, *ln_in_b, *w_in, *q_norm_g, *kv_norm_g, *w_uq, *w_ukv, *lambda_re, *lambda_im, *log_step, *b_re, *b_im, *c_re, *c_im, *d_skip, *w_glu, *b_glu;
    const float *attn_out_g, *ssm_out_g, *w_o, *ln1_g, *ln1_b, *w_router, *router_bias, *w_gate, *w_up, *w_down, *ws_gate, *ws_up, *ws_down, *ln2_g, *ln2_b;
    const int* positions; float* out; unsigned char* ws;
};
#define WSP(T_, off) ((T_*)(P.ws + (off)))

__device__ __forceinline__ void ph_ln_in(const Ptrs& P, int bid, int nb) {
    const int tidx = opaque_tid();
    const int lane = tidx & 63, w = tidx >> 6;
    bf16_t* xn = WSP(bf16_t, WS_XN); float* xstat = WSP(float, WS_XSTAT);
    for (int t0 = (bid * NWAVE + w) * 2; t0 < T; t0 += nb * NWAVE * 2) {
        f32x4 q[2][4];
#pragma unroll
        for (int r = 0; r < 2; ++r)
#pragma unroll
            for (int i = 0; i < 4; ++i) q[r][i] = __builtin_nontemporal_load((const f32x4*)(P.x + (size_t)(t0 + r) * D + i * 256 + lane * 4));
#pragma unroll
        for (int r = 0; r < 2; ++r) {
            const int t = t0 + r;
            float s = 0.f;
#pragma unroll
            for (int i = 0; i < 4; ++i) s += q[r][i][0] + q[r][i][1] + q[r][i][2] + q[r][i][3];
            const float mu = wave_sum(s) * (1.0f / D);
            float ss = 0.f;
#pragma unroll
            for (int i = 0; i < 4; ++i)
#pragma unroll
                for (int e = 0; e < 4; ++e) { const float d = q[r][i][e] - mu; ss += d * d; }
            const float rstd = rsqrtf(wave_sum(ss) * (1.0f / D) + EPS);
            if (lane == 0) { xstat[2 * t] = mu; xstat[2 * t + 1] = rstd; }
#pragma unroll
            for (int i = 0; i < 4; ++i) {
                const int c = i * 256 + lane * 4;
                const f32x4 gg = *(const f32x4*)(P.ln_in_g + c), bb = *(const f32x4*)(P.ln_in_b + c);
                ushort4 o;
                o.x = f2bf((q[r][i][0] - mu) * rstd * gg[0] + bb[0]); o.y = f2bf((q[r][i][1] - mu) * rstd * gg[1] + bb[1]);
                o.z = f2bf((q[r][i][2] - mu) * rstd * gg[2] + bb[2]); o.w = f2bf((q[r][i][3] - mu) * rstd * gg[3] + bb[3]);
                *(ushort4*)(xn + (size_t)t * D + c) = o;
            }
        }
    }
}
__device__ __forceinline__ int wprep_srccol(int mode, int n, int& which) {
    which = 0;
    switch (mode) {
    case 0: if (n < 256) return n; if (n < 768) return 416 + (n - 256); if (n < 896) return 256 + (n - 768); if (n < 928) return 384 + ropeperm(n - 896); return -1;
    case 1: if (n < 512) return (n >> 6) * 96 + (n & 63); { const int m = n - 512; return (m >> 5) * 96 + 64 + ropeperm(m & 31); }
    case 2: if (n < 512) return (n >> 6) * 128 + (n & 63); { const int m = n - 512; return (m >> 6) * 128 + 64 + (m & 63); }
    case 5: { const int pn = n >> 8, w = n & 255; which = w >> 7; return pn * 128 + (w & 127); }
    case 7: return n < 64 ? n : -1;
    default: return n;
    }
}
__device__ __forceinline__ void wprep_tile(LAS float* tile  , const float* s1, const float* s2, const float* ks, const float* ks2, bf16_t* dst,
                                           int mode, int Kd, int ldsrc, int Ksrc, float kmul, int n0, int k0) {
    const int tidx = opaque_tid();
    const int nn = tidx & 63, w = tidx >> 6;
    {
        int which; const int sc = wprep_srccol(mode, n0 + nn, which);
        const float* s = which ? s2 : s1;
        float v[32];
#pragma unroll
        for (int i = 0; i < 32; ++i) { const int k = k0 + w + 8 * i; v[i] = (sc >= 0 && k < Ksrc) ? __builtin_nontemporal_load(s + (size_t)k * ldsrc + sc) : 0.f; }
#pragma unroll
        for (int i = 0; i < 32; ++i) { const int kk = w + 8 * i, k = k0 + kk; float x = v[i];
            if (ks && k < Ksrc) x *= (ks2 && k >= 512) ? ks2[k - 512] : ks[k];
            tile[kk * 65 + nn] = x * kmul; }
    }
    __syncthreads();
#pragma unroll
    for (int i = 0; i < 4; ++i) {
        const int kb = (i * 8 + w) * 8;
        u32x4 o;
#pragma unroll
        for (int j = 0; j < 4; ++j) o[j] = (unsigned)f2bf(tile[(kb + 2 * j) * 65 + nn]) | ((unsigned)f2bf(tile[(kb + 2 * j + 1) * 65 + nn]) << 16);
        *(u32x4*)(dst + (size_t)(n0 + nn) * Kd + k0 + kb) = o;
    }
    __syncthreads();
}
__device__ __forceinline__ void wprep_tile_fp8(const float* s1, const float* s2, unsigned char* dst, int mode, int Kd, int ldsrc, float kmul, int n0, int k0) {
    const int tidx = opaque_tid();
    const int nn = tidx & 63, w = tidx >> 6;
    int which; const int sc = wprep_srccol(mode, n0 + nn, which);
    const float* s = which ? s2 : s1;
    float v[2][16];
#pragma unroll
    for (int i = 0; i < 2; ++i)
#pragma unroll
        for (int j = 0; j < 16; ++j) { const int k = k0 + (i * 8 + w) * 16 + j; v[i][j] = __builtin_nontemporal_load(s + (size_t)k * ldsrc + sc) * kmul; }
#pragma unroll
    for (int i = 0; i < 2; ++i) {
        u32x4 o;
#pragma unroll
        for (int j = 0; j < 4; ++j) { int p = __builtin_amdgcn_cvt_pk_fp8_f32(v[i][4 * j], v[i][4 * j + 1], 0, false); p = __builtin_amdgcn_cvt_pk_fp8_f32(v[i][4 * j + 2], v[i][4 * j + 3], p, true); o[j] = (unsigned)p; }
        *(u32x4*)(dst + (size_t)(n0 + nn) * Kd + k0 + (i * 8 + w) * 16) = o;
    }
}
__device__ __forceinline__ void ph_wprep(const Ptrs& P, LAS unsigned char* lds, int bid, int nb) {
    LAS float* tile = (LAS float*)lds;
    constexpr int J0 = 64, J1 = J0 + 12, J2 = J1 + 16, J3 = J2 + 16, J4 = J3 + 64, J4b = J4 + 16, J5 = J4b + 65 * 32, J6 = J5 + 65 * 16;
    for (int j = bid; j < J6; j += nb) {
        if (j < J0)      { const int tl = j;      wprep_tile(tile, P.w_in, nullptr, nullptr, nullptr, WSP(bf16_t, WS_WIN), 0, 1024, 928, 1024, 1.0f, (tl / 4) * 64, (tl % 4) * 256); }
        else if (j < J1) { const int tl = j - J0; wprep_tile(tile, P.w_uq, nullptr, P.q_norm_g, nullptr, WSP(bf16_t, WS_WUQ), 1, 256, 768, 256, QSCALE, tl * 64, 0); }
        else if (j < J2) { const int tl = j - J1; wprep_tile(tile, P.w_ukv, nullptr, P.kv_norm_g, nullptr, WSP(bf16_t, WS_WUKV), 2, 256, 1024, 128, 1.0f, tl * 64, 0); }
        else if (j < J3) { const int tl = j - J2; wprep_tile(tile, P.w_glu, nullptr, nullptr, nullptr, WSP(bf16_t, WS_WGLU), 3, 512, 512, 512, 1.0f, (tl / 2) * 64, (tl % 2) * 256); }
        else if (j < J4) { const int tl = j - J3; wprep_tile(tile, P.w_o, nullptr, P.attn_out_g, P.ssm_out_g, WSP(bf16_t, WS_WO), 4, 1024, 1024, 1024, 1.0f, (tl / 4) * 64, (tl % 4) * 256); }
        else if (j < J4b) { const int tl = j - J4; wprep_tile(tile, P.w_router, nullptr, nullptr, nullptr, WSP(bf16_t, WS_WR), 7, 1024, 64, 1024, 1.0f, (tl / 4) * 64, (tl % 4) * 256); }
        else if (j < J5) { const int q = j - J4b, e = q / 32, tl = q % 32;
            const float* g = e < 64 ? P.w_gate + (size_t)e * 1024 * 256 : P.ws_gate; const float* u = e < 64 ? P.w_up + (size_t)e * 1024 * 256 : P.ws_up;
            wprep_tile_fp8(g, u, WSP(unsigned char, WS_WGU) + (size_t)e * 512 * 1024, 5, 1024, 256, WQ_SCALE, (tl / 4) * 64, (tl % 4) * 256); }
        else             { const int q = j - J5, e = q / 16, tl = q % 16;
            const float* d = e < 64 ? P.w_down + (size_t)e * 256 * 1024 : P.ws_down;
            wprep_tile_fp8(d, nullptr, WSP(unsigned char, WS_WD) + (size_t)e * 1024 * 256, 6, 256, 1024, WQ_SCALE, tl * 64, 0); }
    }
}
__device__ __forceinline__ void ph_s5tab1(const Ptrs& P, int bid, int nb) {
    const int tidx = opaque_tid();
    float2* lampow = WSP(float2, WS_LAMPOW); float2* lampow_t = WSP(float2, WS_LAMPOWT); float2* bbar = WSP(float2, WS_BBAR);
    for (int i = bid * NTHR + tidx; i < SG * SP * 65 + SG * SP * SC; i += nb * NTHR) {
        const bool isb = i >= SG * SP * 65;
        const int q = isb ? i - SG * SP * 65 : i;
        const int gp = isb ? q >> 4 : q / 65, tau = isb ? 1 : q % 65, g = gp >> 6, p = gp & 63;
        double lr = (double)P.lambda_re[gp]; if (lr > -1e-4) lr = -1e-4;
        const double li = (double)P.lambda_im[gp];
        double st, dummy; cexp_d((double)P.log_step[g], 0.0, st, dummy);
        double br, bi; cexp_d(lr * st * tau, li * st * tau, br, bi);
        if (!isb) {
            const float2 v = make_float2((float)br, (float)bi);
            lampow[gp * 65 + tau] = v; lampow_t[(g * 65 + tau) * 64 + p] = v;
        } else {
            const int c = q & 15;
            const double nr = br - 1.0, ni = bi, den = lr * lr + li * li;
            const double cr = (nr * lr + ni * li) / den, ci = (ni * lr - nr * li) / den;
            const double xr = (double)P.b_re[gp * SC + c], xi = (double)P.b_im[gp * SC + c];
            bbar[gp * SC + c] = make_float2((float)(cr * xr - ci * xi), (float)(cr * xi + ci * xr));
        }
    }
}
__device__ __forceinline__ void ph_s5tab2(const Ptrs& P, LAS unsigned char* lds, int bid, int nb) {
    const int tidx = opaque_tid();
    const float2* lampow = WSP(float2, WS_LAMPOW); const float2* lampow_t = WSP(float2, WS_LAMPOWT); const float2* bbar = WSP(float2, WS_BBAR);
    bf16_t* ktab = WSP(bf16_t, WS_KTAB); bf16_t* bloc = WSP(bf16_t, WS_BLOC); bf16_t* clam = WSP(bf16_t, WS_CLAM);
    const int lane = tidx & 63, w = tidx >> 6;
    LAS f32x2* Cs = (LAS f32x2*)lds;
    LAS f32x2* Bs = Cs + 1024;
    LAS f32x2* Ls = Bs + 1024;
    for (int un = bid; un < SG * 8; un += nb) {
        const int g = un >> 3, tb = (un & 7) * 8;
        __syncthreads();
        for (int i = tidx; i < 1024; i += NTHR) { const int c = i >> 6, p = i & 63; Cs[i] = (f32x2){P.c_re[(g * SC + c) * SP + p], P.c_im[(g * SC + c) * SP + p]}; { const float2 bq = bbar[g * 1024 + i]; Bs[i] = (f32x2){bq.x, bq.y}; } }
        { const int tl = tidx >> 6, p = tidx & 63; { const float2 lq = lampow_t[(g * 65 + tb + tl) * 64 + p]; Ls[tidx] = (f32x2){lq.x, lq.y}; } }
        __syncthreads();
        const int tl = tidx >> 6, c = (tidx >> 2) & 15, c0 = (tidx & 3) * 4;
        float a0 = 0.f, a1 = 0.f, a2 = 0.f, a3 = 0.f;
        for (int p = 0; p < SP; ++p) {
            const f32x2 l = Ls[tl * 64 + p], cc = Cs[c * 64 + p];
            const float kr = cc.x * l.x - cc.y * l.y, ki = cc.x * l.y + cc.y * l.x;
            const f32x2 b0 = Bs[p * 16 + c0], b1 = Bs[p * 16 + c0 + 1], b2 = Bs[p * 16 + c0 + 2], b3 = Bs[p * 16 + c0 + 3];
            a0 += kr * b0.x - ki * b0.y; a1 += kr * b1.x - ki * b1.y; a2 += kr * b2.x - ki * b2.y; a3 += kr * b3.x - ki * b3.y;
        }
        const int tau = tb + tl;
        if (tau == 0) { const float dsk = P.d_skip[g * SC + c]; if (c == c0) a0 += dsk; if (c == c0 + 1) a1 += dsk; if (c == c0 + 2) a2 += dsk; if (c == c0 + 3) a3 += dsk; }
        ushort4 o; o.x = f2bf(a0); o.y = f2bf(a1); o.z = f2bf(a2); o.w = f2bf(a3);
        *(ushort4*)(ktab + (((size_t)g * 127 + 63 + tau) * 16 + c) * 16 + c0) = o;
    }
    for (int i = bid * NTHR + tidx; i < SG * 63 * 32; i += nb * NTHR) { const int g = i / (63 * 32), r = i % (63 * 32); *(u32x4*)(ktab + (size_t)g * 127 * 256 + (size_t)r * 8) = (u32x4){0u, 0u, 0u, 0u}; }
    for (int row = bid * NWAVE + w; row < SG * 256; row += nb * NWAVE) {
        const int g = row >> 8, n = row & 255;
        u32x4 o0 = (u32x4){0u, 0u, 0u, 0u}, o1 = o0;
        if (n < 128) {
            const int p = n & 63;
            const float2 l = lampow[(g * SP + p) * 65 + (63 - lane)];
            float v[16];
#pragma unroll
            for (int c = 0; c < 16; ++c) { const float2 bb = bbar[(g * SP + p) * SC + c]; v[c] = (n < 64) ? (l.x * bb.x - l.y * bb.y) : (l.x * bb.y + l.y * bb.x); }
#pragma unroll
            for (int j = 0; j < 4; ++j) { o0[j] = (unsigned)f2bf(v[2 * j]) | ((unsigned)f2bf(v[2 * j + 1]) << 16); o1[j] = (unsigned)f2bf(v[8 + 2 * j]) | ((unsigned)f2bf(v[9 + 2 * j]) << 16); }
        }
        bf16_t* d = bloc + (size_t)row * 1024 + lane * 16;
        *(u32x4*)d = o0; *(u32x4*)(d + 8) = o1;
    }
    for (int row = bid * NWAVE + w; row < SG * 1024; row += nb * NWAVE) {
        const int g = row >> 10, n = row & 1023, t = n >> 4, c = n & 15;
        ushort4 o; o.x = 0; o.y = 0; o.z = 0; o.w = 0;
        if (lane < 32) {
            const int p0 = (lane & 15) * 4;
            const f32x4 cr = *(const f32x4*)(P.c_re + (g * SC + c) * SP + p0), ci = *(const f32x4*)(P.c_im + (g * SC + c) * SP + p0);
            const float2* lp = lampow_t + (g * 65 + t + 1) * 64 + p0;
            float v[4];
#pragma unroll
            for (int j = 0; j < 4; ++j) { const float2 l = lp[j]; v[j] = (lane < 16) ? (cr[j] * l.x - ci[j] * l.y) : -(cr[j] * l.y + ci[j] * l.x); }
            o.x = f2bf(v[0]); o.y = f2bf(v[1]); o.z = f2bf(v[2]); o.w = f2bf(v[3]);
        }
        *(ushort4*)(clam + (size_t)row * 256 + lane * 4) = o;
    }
}
__device__ __forceinline__ void ph_ropetab(const Ptrs& P, int bid, int nb) {
    const int tidx = opaque_tid();
    float2* rope = WSP(float2, WS_ROPE);
    const double invf[16] = {0.15915494309189535, 0.08949940160889101, 0.050329212104487035, 0.0283021958306234, 0.015915494309189534, 0.008949940160889102, 0.005032921210448704, 0.00283021958306234,
                             0.0015915494309189536, 0.0008949940160889102, 0.0005032921210448703, 0.00028302195830623395, 0.00015915494309189535, 8.949940160889102e-05, 5.0329212104487035e-05, 2.8302195830623396e-05};
    for (int t = bid * NTHR + tidx; t < T; t += nb * NTHR) {
        const double p = (double)P.positions[t];
#pragma unroll
        for (int j = 0; j < 16; ++j) {
            const double rev = p * invf[j];
            const float fr = (float)(rev - __builtin_rint(rev));
            rope[t * 16 + j] = make_float2(__builtin_amdgcn_cosf(fr), __builtin_amdgcn_sinf(fr));
        }
    }
}

#define GW_LOOP(ntiles) for (int tl = bid * NWAVE + (tidx >> 6); tl < (ntiles); tl += nb * NWAVE)
__device__ __forceinline__ void ph_gemm_win(const Ptrs& P, int bid, int nb) {
    const int tidx = opaque_tid();
    const bf16_t* xn = WSP(bf16_t, WS_XN); const bf16_t* wt = WSP(bf16_t, WS_WIN);
    bf16_t* cq = WSP(bf16_t, WS_CQ); bf16_t* ckv = WSP(bf16_t, WS_CKV); bf16_t* u = WSP(bf16_t, WS_U); float* krraw = WSP(float, WS_KRRAW);
    GW_LOOP((T / 32) * 32) {
        const int m0 = (tl >> 5) * 32, n0 = (tl & 31) * 32;
        sg_tile<false>(m0, n0, D,
            [&](int row) { return xn + (size_t)row * D; },
            [&](int n, int k, int) { return wt + (size_t)n * D + k; },
            [&](int t, int n, float v, float) {
                if (n < 256) cq[(size_t)t * 256 + n] = f2bf(v);
                else if (n < 768) {
                    const int ch = n - 256, g = ch >> 4, c = ch & 15, b = t >> 11, s = t & 2047, j = s >> 6, sl = s & 63;
                    u[((size_t)g * 512 + b * 32 + j) * 1024 + sl * 16 + c] = f2bf(v);
                } else if (n < 896) ckv[(size_t)t * 256 + (n - 768)] = f2bf(v);
                else {
                    ckv[(size_t)t * 256 + (n - 768)] = 0;
                    if (n < 928) krraw[(size_t)t * 32 + ropeperm(n - 896)] = v;
                }
            });
    }
}
__device__ __forceinline__ void ph_rstat(const Ptrs& P, int bid, int nb) {
    const int tidx = opaque_tid();
    const bf16_t* cq = WSP(bf16_t, WS_CQ); const bf16_t* ckv = WSP(bf16_t, WS_CKV); float* rsq = WSP(float, WS_RSQ); float* rskv = WSP(float, WS_RSKV);
    const int lane = tidx & 63, w = tidx >> 6;
    for (int t = bid * NWAVE + w; t < T; t += nb * NWAVE) {
        float s = 0.f, s2 = 0.f;
#pragma unroll
        for (int i = 0; i < 4; ++i) { const float v = bf2f(cq[(size_t)t * 256 + i * 64 + lane]); s += v * v; }
#pragma unroll
        for (int i = 0; i < 2; ++i) { const float v = bf2f(ckv[(size_t)t * 256 + i * 64 + lane]); s2 += v * v; }
        s = wave_sum(s); s2 = wave_sum(s2);
        if (lane == 0) { rsq[t] = rsqrtf(s * (1.0f / 256) + EPS); rskv[t] = rsqrtf(s2 * (1.0f / 128) + EPS); }
    }
}
__device__ __forceinline__ void ph_gemm_q(const Ptrs& P, int bid, int nb) {
    const int tidx = opaque_tid();
    const bf16_t* cq = WSP(bf16_t, WS_CQ); const bf16_t* wt = WSP(bf16_t, WS_WUQ); const float* rsq = WSP(float, WS_RSQ); bf16_t* Q = WSP(bf16_t, WS_Q); float* qrraw = WSP(float, WS_QRRAW);
    GW_LOOP((T / 32) * 24) {
        const int m0 = (tl / 24) * 32, n0 = (tl % 24) * 32;
        sg_tile<false>(m0, n0, 256,
            [&](int row) { return cq + (size_t)row * 256; },
            [&](int n, int k, int) { return wt + (size_t)n * 256 + k; },
            [&](int t, int n, float v, float) {
                v *= rsq[t];
                const int b = t >> 11, s = t & 2047;
                if (n < 512) Q[(((size_t)b * NH + (n >> 6)) * SEQ + s) * QKD + (n & 63)] = f2bf(v);
                else { const int m = n - 512; qrraw[(size_t)t * 256 + (m >> 5) * 32 + ropeperm(m & 31)] = v; }
            });
    }
}
__device__ __forceinline__ void ph_gemm_kv(const Ptrs& P, int bid, int nb) {
    const int tidx = opaque_tid();
    const bf16_t* ckv = WSP(bf16_t, WS_CKV); const bf16_t* wt = WSP(bf16_t, WS_WUKV); const float* rskv = WSP(float, WS_RSKV); bf16_t* Kc = WSP(bf16_t, WS_K); bf16_t* V = WSP(bf16_t, WS_V);
    GW_LOOP((T / 32) * 32) {
        const int m0 = (tl >> 5) * 32, n0 = (tl & 31) * 32;
        sg_tile<false>(m0, n0, 256,
            [&](int row) { return ckv + (size_t)row * 256; },
            [&](int n, int k, int) { return wt + (size_t)n * 256 + k; },
            [&](int t, int n, float v, float) {
                v *= rskv[t];
                const int b = t >> 11, s = t & 2047;
                if (n < 512) Kc[(((size_t)b * NH + (n >> 6)) * SEQ + s) * QKD + (n & 63)] = f2bf(v);
                else { const int m = n - 512; V[(((size_t)b * NH + (m >> 6)) * SEQ + s) * VD + (m & 63)] = f2bf(v); }
            });
    }
}
__device__ __forceinline__ void ph_rope_apply(const Ptrs& P, int bid, int nb) {
    const int tidx = opaque_tid();
    const float* qrraw = WSP(float, WS_QRRAW); const float* krraw = WSP(float, WS_KRRAW); const float2* rope = WSP(float2, WS_ROPE); bf16_t* Q = WSP(bf16_t, WS_Q); bf16_t* Kc = WSP(bf16_t, WS_K);
    for (int i = bid * NTHR + tidx; i < T * 9 * 16; i += nb * NTHR) {
        const int j = i & 15, hh = (i >> 4) % 9, t = (i >> 4) / 9;
        const float2 cs = rope[t * 16 + j];
        const int b = t >> 11, s = t & 2047;
        if (hh < 8) {
            const float x1 = qrraw[(size_t)t * 256 + hh * 32 + j], x2 = qrraw[(size_t)t * 256 + hh * 32 + 16 + j];
            bf16_t* q = Q + (((size_t)b * NH + hh) * SEQ + s) * QKD + 64;
            q[j] = f2bf(x1 * cs.x - x2 * cs.y); q[16 + j] = f2bf(x2 * cs.x + x1 * cs.y);
        } else {
            const float x1 = krraw[(size_t)t * 32 + j], x2 = krraw[(size_t)t * 32 + 16 + j];
            const bf16_t o1 = f2bf(x1 * cs.x - x2 * cs.y), o2 = f2bf(x2 * cs.x + x1 * cs.y);
            for (int h = 0; h < NH; ++h) { bf16_t* k = Kc + (((size_t)b * NH + h) * SEQ + s) * QKD + 64; k[j] = o1; k[16 + j] = o2; }
        }
    }
}
__device__ __forceinline__ void ph_gemm_s5b(const Ptrs& P, int bid, int nb) {
    const int tidx = opaque_tid();
    const bf16_t* u = WSP(bf16_t, WS_U); const bf16_t* bloc = WSP(bf16_t, WS_BLOC); float* xloc = WSP(float, WS_XLOC);
    GW_LOOP(SG * 16 * 4) {
        const int g = tl >> 6, m0 = ((tl >> 2) & 15) * 32, n0 = (tl & 3) * 32;
        sg_tile<false>(m0, n0, 1024,
            [&](int row) { return u + ((size_t)g * 512 + row) * 1024; },
            [&](int n, int k, int) { return bloc + ((size_t)g * 256 + n) * 1024 + k; },
            [&](int row, int n, float v, float) { xloc[((size_t)g * 512 + row) * 128 + n] = v; });
    }
}
__device__ __forceinline__ void ph_gemm_s5a(const Ptrs& P, int bid, int nb) {
    const int tidx = opaque_tid();
    const bf16_t* u = WSP(bf16_t, WS_U); const bf16_t* ktab = WSP(bf16_t, WS_KTAB); bf16_t* yintra = WSP(bf16_t, WS_YINTRA);
    GW_LOOP(SG * 16 * 32) {
        const int g = tl >> 9, m0 = ((tl >> 5) & 15) * 32, n0 = (tl & 31) * 32;
        sg_tile<false>(m0, n0, 1024,
            [&](int row) { return u + ((size_t)g * 512 + row) * 1024; },
            [&](int n, int k, int) { const int t = n >> 4, c = n & 15, s = k >> 4, c0 = k & 15; return ktab + (((size_t)g * 127 + (t - s + 63)) * 16 + c) * 16 + c0; },
            [&](int row, int n, float v, float) {
                const int b = row >> 5, j = row & 31, t = n >> 4, c = n & 15;
                yintra[((size_t)b * SEQ + j * CH + t) * SSMW + g * SC + c] = f2bf(v);
            });
    }
}
__device__ __forceinline__ void ph_attn_simple(const Ptrs& P, LAS unsigned char* lds, int bid, int nb) {
    const int tidx = opaque_tid();
    const bf16_t* Q = WSP(bf16_t, WS_Q); const bf16_t* Kc = WSP(bf16_t, WS_K); const bf16_t* V = WSP(bf16_t, WS_V); bf16_t* AS = WSP(bf16_t, WS_AS);
    const int lane = tidx & 63, w = tidx >> 6;
    LAS float* qs = (LAS float*)lds + w * (QKD + SEQ);
    LAS float* ps = qs + QKD;
    for (int row = bid * NWAVE + w; row < T * NH; row += nb * NWAVE) {
        const int bh = row >> 11, q = row & 2047, b = bh >> 3, h = bh & 7;
        asm volatile("s_waitcnt lgkmcnt(0)" ::: "memory");
        qs[lane] = bf2f(Q[(size_t)row * QKD + lane]);
        if (lane < 32) qs[64 + lane] = bf2f(Q[(size_t)row * QKD + 64 + lane]);
        asm volatile("s_waitcnt lgkmcnt(0)" ::: "memory");
        const int nk = ((q >> 6) + 1) * 64;
        float m = -INFINITY;
        for (int kb = 0; kb < nk; kb += 64) {
            const bf16_t* kp = Kc + ((size_t)bh * SEQ + kb + lane) * QKD;
            float s = 0.f;
#pragma unroll
            for (int c = 0; c < 12; ++c) {
                const bf16x8 kv = *(const bf16x8*)(kp + c * 8);
#pragma unroll
                for (int e = 0; e < 8; ++e) s += qs[c * 8 + e] * bf2f((bf16_t)kv[e]);
            }
            ps[kb + lane] = s; m = fmaxf(m, s);
        }
        m = wave_max(m);
        float l = 0.f;
        for (int kb = 0; kb < nk; kb += 64) { const float p = exp2f(ps[kb + lane] - m); ps[kb + lane] = p; l += p; }
        l = wave_sum(l);
        asm volatile("s_waitcnt lgkmcnt(0)" ::: "memory");
        float o = 0.f;
        const bf16_t* vp = V + (size_t)bh * SEQ * VD + lane;
        for (int k = 0; k < nk; ++k) o += ps[k] * bf2f(vp[(size_t)k * VD]);
        AS[((size_t)b * SEQ + q) * 1024 + h * 64 + lane] = f2bf(o / l);
    }
}
__device__ __forceinline__ void ph_s5scan(const Ptrs& P, int bid, int nb) {
    const int tidx = opaque_tid();
    const float* xloc = WSP(float, WS_XLOC); const float2* lampow = WSP(float2, WS_LAMPOW); bf16_t* xprev = WSP(bf16_t, WS_XPREV);
    for (int i = bid * NTHR + tidx; i < SG * NB * SP; i += nb * NTHR) {
        const int p = i & 63, b = (i >> 6) & 15, g = i >> 10;
        const float2 l64 = lampow[(g * SP + p) * 65 + 64];
        float xr = 0.f, xi = 0.f;
#pragma unroll
        for (int j = 0; j < NCH; ++j) {
            const size_t row = (size_t)g * 512 + b * 32 + j;
            bf16_t* xp = xprev + row * 256;
            xp[p] = f2bf(xr); xp[64 + p] = f2bf(xi); xp[128 + p] = 0; xp[192 + p] = 0;
            const float lr = xloc[row * 128 + p], li = xloc[row * 128 + 64 + p];
            const float nr = l64.x * xr - l64.y * xi + lr, ni = l64.x * xi + l64.y * xr + li;
            xr = nr; xi = ni;
        }
    }
}
__device__ __forceinline__ void ph_gemm_s5d(const Ptrs& P, int bid, int nb) {
    const int tidx = opaque_tid();
    const bf16_t* xprev = WSP(bf16_t, WS_XPREV); const bf16_t* clam = WSP(bf16_t, WS_CLAM); const bf16_t* yintra = WSP(bf16_t, WS_YINTRA); bf16_t* Y = WSP(bf16_t, WS_Y);
    GW_LOOP(SG * 16 * 32) {
        const int g = tl >> 9, m0 = ((tl >> 5) & 15) * 32, n0 = (tl & 31) * 32;
        sg_tile<false>(m0, n0, 256,
            [&](int row) { return xprev + ((size_t)g * 512 + row) * 256; },
            [&](int n, int k, int) { return clam + ((size_t)g * 1024 + n) * 256 + k; },
            [&](int row, int n, float v, float) {
                const int b = row >> 5, j = row & 31, t = n >> 4, c = n & 15;
                const size_t o = ((size_t)b * SEQ + j * CH + t) * SSMW + g * SC + c;
                Y[o] = f2bf(gelu_tanh(v + bf2f(yintra[o])));
            });
    }
}
__device__ __forceinline__ void ph_gemm_glu(const Ptrs& P, int bid, int nb) {
    const int tidx = opaque_tid();
    const bf16_t* Y = WSP(bf16_t, WS_Y); const bf16_t* wt = WSP(bf16_t, WS_WGLU); bf16_t* AS = WSP(bf16_t, WS_AS);
    GW_LOOP((T / 32) * 16) {
        const int m0 = (tl >> 4) * 32, n0 = (tl & 15) * 32;
        sg_tile<false>(m0, n0, 512,
            [&](int row) { return Y + (size_t)row * 512; },
            [&](int n, int k, int) { return wt + (size_t)n * 512 + k; },
            [&](int t, int n, float v, float) {
                const float yv = bf2f(Y[(size_t)t * 512 + n]);
                AS[(size_t)t * 1024 + 512 + n] = f2bf(yv * sigmoidf_(v + P.b_glu[n]));
            });
    }
}
__device__ __forceinline__ void ph_asnorm(const Ptrs& P, int bid, int nb) {
    const int tidx = opaque_tid();
    bf16_t* AS = WSP(bf16_t, WS_AS);
    const int lane = tidx & 63, w = tidx >> 6;
    for (int t = bid * NWAVE + w; t < T; t += nb * NWAVE) {
        bf16_t* r = AS + (size_t)t * 1024;
        float va[8], vs[8]; float sa = 0.f, ss = 0.f;
        const bf16x8 a = *(const bf16x8*)(r + lane * 8), s = *(const bf16x8*)(r + 512 + lane * 8);
#pragma unroll
        for (int i = 0; i < 8; ++i) { va[i] = bf2f((bf16_t)a[i]); vs[i] = bf2f((bf16_t)s[i]); sa += va[i] * va[i]; ss += vs[i] * vs[i]; }
        const float ra = rsqrtf(wave_sum(sa) * (1.0f / 512) + EPS), rs = rsqrtf(wave_sum(ss) * (1.0f / 512) + EPS);
        bf16x8 oa, os;
#pragma unroll
        for (int i = 0; i < 8; ++i) { oa[i] = (short)f2bf(va[i] * ra); os[i] = (short)f2bf(vs[i] * rs); }
        *(bf16x8*)(r + lane * 8) = oa; *(bf16x8*)(r + 512 + lane * 8) = os;
    }
}
__device__ __forceinline__ void ph_gemm_wo(const Ptrs& P, int bid, int nb) {
    const int tidx = opaque_tid();
    const bf16_t* AS = WSP(bf16_t, WS_AS); const bf16_t* wt = WSP(bf16_t, WS_WO); const float* xstat = WSP(float, WS_XSTAT); float* pre1 = P.out;
    GW_LOOP((T / 32) * 32) {
        const int m0 = (tl >> 5) * 32, n0 = (tl & 31) * 32;
        sg_tile<false>(m0, n0, 1024,
            [&](int row) { return AS + (size_t)row * 1024; },
            [&](int n, int k, int) { return wt + (size_t)n * 1024 + k; },
            [&](int t, int n, float v, float) {
                const float xn = (P.x[(size_t)t * D + n] - xstat[2 * t]) * xstat[2 * t + 1] * P.ln_in_g[n] + P.ln_in_b[n];
                pre1[(size_t)t * D + n] = v + ALPHA * xn;
            });
    }
}
__device__ __forceinline__ void ph_ln1(const Ptrs& P, int bid, int nb) {
    const int tidx = opaque_tid();
    const float* pre1 = P.out; bf16_t* x1 = WSP(bf16_t, WS_X1); bf16_t* x1lo = WSP(bf16_t, WS_X1LO);
    const int lane = tidx & 63, w = tidx >> 6;
    for (int t = bid * NWAVE + w; t < T; t += nb * NWAVE) {
        const float* xr = pre1 + (size_t)t * D;
        float v[16]; float s = 0.f;
#pragma unroll
        for (int i = 0; i < 4; ++i) { const f32x4 q = *(const f32x4*)(xr + i * 256 + lane * 4); v[4 * i] = q[0]; v[4 * i + 1] = q[1]; v[4 * i + 2] = q[2]; v[4 * i + 3] = q[3]; s += q[0] + q[1] + q[2] + q[3]; }
        const float mu = wave_sum(s) * (1.0f / D);
        float ss = 0.f;
#pragma unroll
        for (int i = 0; i < 16; ++i) { const float d = v[i] - mu; ss += d * d; }
        const float rstd = rsqrtf(wave_sum(ss) * (1.0f / D) + EPS);
#pragma unroll
        for (int i = 0; i < 4; ++i) {
            const int c = i * 256 + lane * 4;
            const f32x4 gg = *(const f32x4*)(P.ln1_g + c), bb = *(const f32x4*)(P.ln1_b + c);
            ushort4 o, ol;
            float y;
            y = (v[4 * i] - mu) * rstd * gg[0] + bb[0];     o.x = f2bf(y); ol.x = f2bf(y - bf2f(o.x));
            y = (v[4 * i + 1] - mu) * rstd * gg[1] + bb[1]; o.y = f2bf(y); ol.y = f2bf(y - bf2f(o.y));
            y = (v[4 * i + 2] - mu) * rstd * gg[2] + bb[2]; o.z = f2bf(y); ol.z = f2bf(y - bf2f(o.z));
            y = (v[4 * i + 3] - mu) * rstd * gg[3] + bb[3]; o.w = f2bf(y); ol.w = f2bf(y - bf2f(o.w));
            *(ushort4*)(x1 + (size_t)t * D + c) = o; (void)ol; (void)x1lo;
            { int p = __builtin_amdgcn_cvt_pk_fp8_f32(bf2f(o.x) * XQ_SCALE, bf2f(o.y) * XQ_SCALE, 0, false); p = __builtin_amdgcn_cvt_pk_fp8_f32(bf2f(o.z) * XQ_SCALE, bf2f(o.w) * XQ_SCALE, p, true);
              *(int*)(WSP(unsigned char, WS_X1Q) + (size_t)t * D + c) = p; }
        }
    }
}
__device__ __forceinline__ void ph_router(const Ptrs& P, int bid, int nb) {
    const int tidx = opaque_tid();
    const bf16_t* x1 = WSP(bf16_t, WS_X1); const bf16_t* x1lo = WSP(bf16_t, WS_X1LO); float* logits = WSP(float, WS_LOGITS);
    const int e = tidx & 63, w = tidx >> 6;
    for (int t = bid * NWAVE + w; t < T; t += nb * NWAVE) {
        const bf16_t* a = x1 + (size_t)t * D; const bf16_t* al = x1lo + (size_t)t * D;
        float s = 0.f;
        for (int k = 0; k < D; k += 8) {
            const bf16x8 hi = *(const bf16x8*)(a + k), lo = *(const bf16x8*)(al + k);
#pragma unroll
            for (int i = 0; i < 8; ++i) s += (bf2f((bf16_t)hi[i]) + bf2f((bf16_t)lo[i])) * P.w_router[(size_t)(k + i) * NE + e];
        }
        logits[(size_t)t * NE + e] = s;
    }
}
__device__ __forceinline__ void ph_topk(const Ptrs& P, int bid, int nb) {
    const int tidx = opaque_tid();
    const float* logits = WSP(float, WS_LOGITS); int* topi = WSP(int, WS_TOPI); float* topw = WSP(float, WS_TOPW);
    const int lane = tidx & 63, w = tidx >> 6;
    for (int t = bid * NWAVE + w; t < T; t += nb * NWAVE) {
        const float sc = sigmoidf_(logits[(size_t)t * NE + lane]);
        const float sel = sc + P.router_bias[lane];
        const int grp = lane >> 3;
        float m1 = sel;
        m1 = fmaxf(m1, __shfl_xor(m1, 1)); m1 = fmaxf(m1, __shfl_xor(m1, 2)); m1 = fmaxf(m1, __shfl_xor(m1, 4));
        const unsigned long long bal = __ballot(sel == m1) & (0xFFull << (8 * grp));
        const int first = __ffsll((long long)bal) - 1;
        float m2 = (lane == first) ? -INFINITY : sel;
        m2 = fmaxf(m2, __shfl_xor(m2, 1)); m2 = fmaxf(m2, __shfl_xor(m2, 2)); m2 = fmaxf(m2, __shfl_xor(m2, 4));
        const float gs = m1 + m2;
        int cg = 0;
#pragma unroll
        for (int gj = 0; gj < 8; ++gj) { const float sj = __shfl(gs, gj * 8); cg += (sj > gs || (sj == gs && gj < grp)) ? 1 : 0; }
        const bool gsel = cg < 4;
        const float v = gsel ? sel : -INFINITY;
        int rank = 0;
        for (int e2 = 0; e2 < 64; ++e2) { const float ve = __shfl(v, e2); rank += (ve > v || (ve == v && e2 < lane)) ? 1 : 0; }
        const bool chosen = gsel && rank < TOPK;
        const float wsum = wave_sum(chosen ? sc : 0.f);
        if (chosen) { topi[(size_t)t * TOPK + rank] = lane; topw[(size_t)t * TOPK + rank] = sc / wsum * 2.5f; }
    }
}
__device__ __forceinline__ void ph_cnt(const Ptrs& P, int bid, int nb) {
    const int tidx = opaque_tid();
    const int* topi = WSP(int, WS_TOPI); int* cnt = WSP(int, WS_CNT);
    for (int i = bid * NTHR + tidx; i < 256 * 64; i += nb * NTHR) {
        const int tile = i >> 6, e = i & 63;
        int c = 0;
        for (int k = 0; k < 1024; ++k) c += (topi[tile * 1024 + k] == e) ? 1 : 0;
        cnt[i] = c;
    }
}
__device__ __forceinline__ void ph_off(const Ptrs& P, LAS unsigned char* lds, int bid) {
    const int tidx = opaque_tid();
    if (bid != 0) return;
    const int* cnt = WSP(int, WS_CNT); int* toff = WSP(int, WS_TOFF); int* eoff = WSP(int, WS_EOFF); int* ecnt = WSP(int, WS_ECNT);
    LAS int* tot = (LAS int*)lds; LAS int* off = tot + 64;
    const int e = tidx;
    if (e < 64) { int s = 0; for (int tile = 0; tile < 256; ++tile) s += cnt[tile * 64 + e]; tot[e] = s; ecnt[e] = s; }
    __syncthreads();
    if (e == 0) { int o = 0; for (int i = 0; i < 64; ++i) { off[i] = o; o += (tot[i] + 255) & ~255; } off[64] = o; }
    __syncthreads();
    if (e < 64) {
        eoff[e] = off[e]; if (e == 0) eoff[64] = off[64];
        int run = off[e];
        for (int tile = 0; tile < 256; ++tile) { toff[tile * 64 + e] = run; run += cnt[tile * 64 + e]; }
    }
}
__device__ __forceinline__ void ph_lists(const Ptrs& P, int bid, int nb) {
    const int tidx = opaque_tid();
    const int* topi = WSP(int, WS_TOPI); const float* topw = WSP(float, WS_TOPW); const int* toff = WSP(int, WS_TOFF); const int* eoff = WSP(int, WS_EOFF);
    int* rowtok = WSP(int, WS_ROWTOK); float* roww = WSP(float, WS_ROWW);
    for (int i = bid * NTHR + tidx; i < 256 * 64; i += nb * NTHR) {
        const int tile = i >> 6, e = i & 63;
        int pos = toff[tile * 64 + e];
        for (int k = 0; k < 1024; ++k) {
            if (topi[tile * 1024 + k] == e) { rowtok[pos] = tile * 1024 + k; roww[pos] = topw[tile * 1024 + k]; ++pos; }
        }
        if (tile == 255) { const int end = eoff[e + 1]; for (; pos < end; ++pos) { rowtok[pos] = -1; roww[pos] = 0.f; } }
    }
    for (int i = bid * NTHR + tidx; i < T; i += nb * NTHR) rowtok[SH_ROW0 + i] = i * 8;
}
__device__ __forceinline__ void ph_gemm_gu(const Ptrs& P, int bid, int nb) {
    const int tidx = opaque_tid();
    const bf16_t* x1 = WSP(bf16_t, WS_X1); const bf16_t* wgu = WSP(bf16_t, WS_WGU); const int* rowtok = WSP(int, WS_ROWTOK); const float* roww = WSP(float, WS_ROWW);
    const int* eoff = WSP(int, WS_EOFF); bf16_t* H = WSP(bf16_t, WS_H);
    const int nrt = eoff[64] / 32;
    const int ntl = (nrt + T / 32) * 8;
    GW_LOOP(ntl) {
        const int rt = tl >> 3, n0 = (tl & 7) * 32;
        if (rt < nrt) {
            const int m0 = rt * 32;
            int e = 0; while (e < 63 && eoff[e + 1] <= m0) ++e;
            const bf16_t* w = wgu + (size_t)e * 512 * 1024;
            sg_tile<true>(m0, n0, 1024,
                [&](int row) { const int s = rowtok[row]; return x1 + (size_t)(s >= 0 ? (s >> 3) : 0) * D; },
                [&](int f, int k, int which) { return w + (size_t)((f >> 7) * 256 + (f & 127) + which * 128) * 1024 + k; },
                [&](int row, int f, float gv, float uv) { H[(size_t)row * FF + f] = f2bf(gv * sigmoidf_(gv) * uv * roww[row]); });
        } else {
            const int m0 = (rt - nrt) * 32;
            const bf16_t* w = wgu + (size_t)64 * 512 * 1024;
            sg_tile<true>(m0, n0, 1024,
                [&](int row) { return x1 + (size_t)row * D; },
                [&](int f, int k, int which) { return w + (size_t)((f >> 7) * 256 + (f & 127) + which * 128) * 1024 + k; },
                [&](int row, int f, float gv, float uv) { H[(size_t)(SH_ROW0 + row) * FF + f] = f2bf(gv * sigmoidf_(gv) * uv); });
        }
    }
}
__device__ __forceinline__ unsigned char f2fp8(float v) { const int p = __builtin_amdgcn_cvt_pk_fp8_f32(v, v, 0, false); return (unsigned char)(p & 0xff); }
__device__ __forceinline__ void ph_gemm_down(const Ptrs& P, int bid, int nb) {
    const int tidx = opaque_tid();
    const bf16_t* H = WSP(bf16_t, WS_H); const bf16_t* wd = WSP(bf16_t, WS_WD); const int* rowtok = WSP(int, WS_ROWTOK); const int* eoff = WSP(int, WS_EOFF);
    const bf16_t* x1 = WSP(bf16_t, WS_X1); unsigned char* yslot = WSP(unsigned char, WS_YSLOT); float* out = P.out;
    const int nrt = eoff[64] / 32;
    const int ntl = (nrt + T / 32) * 32;
    GW_LOOP(ntl) {
        const int rt = tl >> 5, n0 = (tl & 31) * 32;
        if (rt < nrt) {
            const int m0 = rt * 32;
            int e = 0; while (e < 63 && eoff[e + 1] <= m0) ++e;
            const bf16_t* w = wd + (size_t)e * 1024 * 256;
            sg_tile<false>(m0, n0, 256,
                [&](int row) { return H + (size_t)row * FF; },
                [&](int n, int k, int) { return w + (size_t)n * 256 + k; },
                [&](int row, int n, float v, float) { const int s = rowtok[row]; if (s >= 0) yslot[(size_t)s * D + n] = f2fp8(v * SLOT_SCALE); });
        } else {
            const int m0 = (rt - nrt) * 32;
            const bf16_t* w = wd + (size_t)64 * 1024 * 256;
            sg_tile<false>(m0, n0, 256,
                [&](int row) { return H + (size_t)(SH_ROW0 + row) * FF; },
                [&](int n, int k, int) { return w + (size_t)n * 256 + k; },
                [&](int t, int n, float v, float) { out[(size_t)t * D + n] = v + ALPHA * bf2f(x1[(size_t)t * D + n]); });
        }
    }
}
__device__ __forceinline__ void ph_combine(const Ptrs& P, int bid, int nb) {
    const int tidx = opaque_tid();
    const unsigned char* yslot = WSP(unsigned char, WS_YSLOT); const unsigned char* shslot = WSP(unsigned char, WS_SHSLOT); float* out = P.out;
    const int* invrow = WSP(int, WS_INVROW); const float* topw = WSP(float, WS_TOPW); const bf16_t* x1 = WSP(bf16_t, WS_X1);
    const int lane = tidx & 63, w = tidx >> 6;
    const int stride = nb * NWAVE * 2;
    int t0 = (bid * NWAVE + w) * 2;
    int4 ia[2], ib[2];
    if (t0 < T) {
#pragma unroll
        for (int r = 0; r < 2; ++r) { ia[r] = *(const int4*)(invrow + (size_t)(t0 + r) * TOPK); ib[r] = *(const int4*)(invrow + (size_t)(t0 + r) * TOPK + 4); }
    }
    for (; t0 < T; t0 += stride) {
        u32x4 q[2][9]; bf16x8 xa[2], xb[2]; f32x4 wa[2], wb[2];
#pragma unroll
        for (int r = 0; r < 2; ++r) {
            const int t = t0 + r;
            const int rows[8] = {ia[r].x, ia[r].y, ia[r].z, ia[r].w, ib[r].x, ib[r].y, ib[r].z, ib[r].w};
#pragma unroll
            for (int k = 0; k < 8; ++k) q[r][k] = __builtin_nontemporal_load((const u32x4*)(yslot + (size_t)rows[k] * D + lane * 16));
            q[r][8] = __builtin_nontemporal_load((const u32x4*)(shslot + (size_t)t * D + lane * 16));
            xa[r] = __builtin_nontemporal_load((const bf16x8*)(x1 + (size_t)t * D + lane * 16)); xb[r] = __builtin_nontemporal_load((const bf16x8*)(x1 + (size_t)t * D + lane * 16 + 8));
            wa[r] = *(const f32x4*)(topw + (size_t)t * TOPK); wb[r] = *(const f32x4*)(topw + (size_t)t * TOPK + 4);
        }
        const int tn = t0 + stride;
        if (tn < T) {
#pragma unroll
            for (int r = 0; r < 2; ++r) { ia[r] = *(const int4*)(invrow + (size_t)(tn + r) * TOPK); ib[r] = *(const int4*)(invrow + (size_t)(tn + r) * TOPK + 4); }
        }
#pragma unroll
        for (int r = 0; r < 2; ++r) {
            const int t = t0 + r;
            float v[16];
#pragma unroll
            for (int i = 0; i < 8; ++i) { v[i] = ALPHA * bf2f((bf16_t)xa[r][i]); v[8 + i] = ALPHA * bf2f((bf16_t)xb[r][i]); }
#pragma unroll
            for (int k = 0; k <= TOPK; ++k) {
                const float wk = ((k < 4) ? wa[r][k & 3] : (k < 8) ? wb[r][k & 3] : 1.0f) * (1.0f / SLOT_SCALE);
#pragma unroll
                for (int i = 0; i < 4; ++i) {
                    v[4 * i]     += __builtin_amdgcn_cvt_f32_fp8((int)q[r][k][i], 0) * wk;
                    v[4 * i + 1] += __builtin_amdgcn_cvt_f32_fp8((int)q[r][k][i], 1) * wk;
                    v[4 * i + 2] += __builtin_amdgcn_cvt_f32_fp8((int)q[r][k][i], 2) * wk;
                    v[4 * i + 3] += __builtin_amdgcn_cvt_f32_fp8((int)q[r][k][i], 3) * wk;
                }
            }
            float s = 0.f;
#pragma unroll
            for (int i = 0; i < 16; ++i) s += v[i];
            const float mu = wave_sum(s) * (1.0f / D);
            float ss = 0.f;
#pragma unroll
            for (int i = 0; i < 16; ++i) { const float d = v[i] - mu; ss += d * d; }
            const float rstd = rsqrtf(wave_sum(ss) * (1.0f / D) + EPS);
            float* orow = out + (size_t)t * D + lane * 16;
#pragma unroll
            for (int i = 0; i < 4; ++i) {
                const int c = lane * 16 + 4 * i;
                const f32x4 gg = *(const f32x4*)(P.ln2_g + c), bb = *(const f32x4*)(P.ln2_b + c);
                f32x4 o;
                o[0] = (v[4 * i] - mu) * rstd * gg[0] + bb[0]; o[1] = (v[4 * i + 1] - mu) * rstd * gg[1] + bb[1];
                o[2] = (v[4 * i + 2] - mu) * rstd * gg[2] + bb[2]; o[3] = (v[4 * i + 3] - mu) * rstd * gg[3] + bb[3];
                *(f32x4*)(orow + 4 * i) = o;
            }
        }
    }
}

namespace g8 {
constexpr int BM = 256, BK = 64, HALF = 128, HTB = HALF * BK * 2, STAGE_BYTES = 8 * HTB;
__device__ __forceinline__ int lds_byte(int r, int c) { const int st = (r >> 4) * 2 + (c >> 5), rr = r & 15, cc = c & 31, ob = rr * 64 + cc * 2; return st * 1024 + (ob ^ (((ob >> 9) & 1) << 5)); }
__device__ __forceinline__ void stage_rc(int b, int& R, int& C) { const int st = b / 1024, sb = b % 1024, swz = sb ^ (((sb >> 9) & 1) << 5); R = (st >> 1) * 16 + swz / 64; C = (st & 1) * 32 + (swz % 64) / 2; }
__device__ __forceinline__ int perm32(int rho) { const int n = rho >> 4, i = rho & 15; return 8 * (i >> 2) + 4 * n + (i & 3); }

struct Unit { const char* A; const char* B; const int* rows; int pm, pn, e, nt; };
struct Geo { int lda_b, ldb_b; long kstepA, kstepB; int toep; };

typedef float f32x4 __attribute__((ext_vector_type(4)));
typedef f32x4 Acc[2][2][4][2];
typedef int v8i_t __attribute__((ext_vector_type(8)));
typedef int v4i_t __attribute__((ext_vector_type(4)));

__device__ __forceinline__ unsigned g8_rowoff(const int* rows, int h, int i, int tid, int lda_b) {
    int t2 = tid; asm volatile("" : "+v"(t2));
    int R, C; stage_rc(t2 * 16 + i * 8192, R, C);
    const int sl = rows[h * HALF + R];
    return (unsigned)((sl < 0 ? 0 : sl >> 3) * lda_b + C * 2);
}
template <class Epi, class Sched, bool GATHER, int DT = 0>
__device__ __forceinline__ void gemm_body(LAS unsigned char* lds, const Geo g, const Sched& S, const Epi& E) {
    const int tid = opaque_tid(), wid = __builtin_amdgcn_readfirstlane(tid >> 6), lane = tid & 63, wr = wid >> 2, wc = wid & 3, fr = lane & 15, fq = lane >> 4;
    unsigned voffB[2], vA[2][2];
#pragma unroll
    for (int i = 0; i < 2; ++i) { int R, C; stage_rc(tid * 16 + i * 8192, R, C); const int Rb = (R & ~31) + perm32(R & 31);
        voffB[i] = g.toep ? (unsigned)(Rb * 32 + 1536 - (C >> 4) * 512 + (C & 15) * 2) : (unsigned)(Rb * g.ldb_b + C * 2);
#pragma unroll
        for (int h = 0; h < 2; ++h) vA[h][i] = (unsigned)((h * HALF + R) * g.lda_b + C * 2); }
    const long kA = g.kstepA, kB = g.kstepB;
    const long hB = (long)HALF * g.ldb_b;
    const unsigned ldsw = (unsigned)wid * 1024u;
    const int aoff = lds_byte(wr * 64 + fr, fq * 8), boff = lds_byte(wc * 32 + fr, fq * 8);
#define G8_SA(b, h) (((b) * 2 + (h)) * HTB)
#define G8_SB(b, h) ((4 + (b) * 2 + (h)) * HTB)
#define G8_STAGE(bufoff, gbase, v0, v1) do { \
        unsigned v0_ = (v0), v1_ = (v1); if (GATHER) asm volatile("" : "+v"(v0_), "+v"(v1_)); \
        __builtin_amdgcn_global_load_lds((const unsigned*)((const char*)(gbase) + v0_), (LAS unsigned*)(lds + (bufoff) + ldsw), 16, 0, 0); \
        __builtin_amdgcn_global_load_lds((const unsigned*)((const char*)(gbase) + v1_), (LAS unsigned*)(lds + (bufoff) + ldsw + 8192), 16, 0, 0); } while (0)
#define G8_STB(bufoff, gbase) G8_STAGE(bufoff, gbase, voffB[0], voffB[1])
#define G8_LDA(dst, b, h) do { if (DT == 0) { _Pragma("unroll") for (int m = 0; m < 4; ++m) _Pragma("unroll") for (int k = 0; k < 2; ++k) dst[m][k] = *(const LAS bf16x8*)(lds + G8_SA(b, h) + aoff + m * 2048 + k * 1024); } \
        else { _Pragma("unroll") for (int m = 0; m < 4; ++m) dst##8[m] = __builtin_shufflevector(*(const LAS v4i_t*)(aBase + G8_SA(b, h) + m * 2048), *(const LAS v4i_t*)(aBase + G8_SA(b, h) + m * 2048 + 1024), 0, 1, 2, 3, 4, 5, 6, 7); } } while (0)
#define G8_LDB(dst, b, h) do { if (DT == 0) { _Pragma("unroll") for (int n = 0; n < 2; ++n) _Pragma("unroll") for (int k = 0; k < 2; ++k) dst[n][k] = *(const LAS bf16x8*)(lds + G8_SB(b, h) + boff + n * 2048 + k * 1024); } \
        else { _Pragma("unroll") for (int n = 0; n < 2; ++n) dst##8[n] = __builtin_shufflevector(*(const LAS v4i_t*)(bBase + (G8_SB(b, h) - 65536) + n * 2048), *(const LAS v4i_t*)(bBase + (G8_SB(b, h) - 65536) + n * 2048 + 1024), 0, 1, 2, 3, 4, 5, 6, 7); } } while (0)
#define G8_MMA(ai, bj, At, Bt) do { __builtin_amdgcn_s_setprio(1); \
        if (DT == 0) { _Pragma("unroll") for (int m = 0; m < 4; ++m) _Pragma("unroll") for (int n = 0; n < 2; ++n) _Pragma("unroll") for (int k = 0; k < 2; ++k) \
            acc[ai][bj][m][n] = __builtin_amdgcn_mfma_f32_16x16x32_bf16(Bt[n][k], At[m][k], acc[ai][bj][m][n], 0, 0, 0); } \
        else { _Pragma("unroll") for (int m = 0; m < 4; ++m) _Pragma("unroll") for (int n = 0; n < 2; ++n) \
            acc[ai][bj][m][n] = __builtin_amdgcn_mfma_scale_f32_16x16x128_f8f6f4(Bt##8[n], At##8[m], acc[ai][bj][m][n], 0, 0, 0, 127, 0, 127); } \
        __builtin_amdgcn_s_setprio(0); } while (0)
#define G8_WAIT_V(n) asm volatile("s_waitcnt vmcnt(" #n ")" ::: "memory")
#define G8_WAIT_L(n) asm volatile("s_waitcnt lgkmcnt(" #n ")" ::: "memory")
#define G8_BAR __builtin_amdgcn_s_barrier()
#define G8_SCHED __builtin_amdgcn_sched_barrier(0)
#define G8_ROWOFF(u_, h_, i_) g8_rowoff((u_).rows, (h_), (i_), tid, g.lda_b)
    Unit cur, nxt; int ui = 0;
    if (!S.next(0, cur)) return;
    Acc acc;
#pragma unroll
    for (int a = 0; a < 2; ++a)
#pragma unroll
        for (int b = 0; b < 2; ++b)
#pragma unroll
            for (int m = 0; m < 4; ++m)
#pragma unroll
                for (int n = 0; n < 2; ++n) acc[a][b][m][n] = (f32x4){0.f, 0.f, 0.f, 0.f};
    bf16x8 At[4][2], B0[2][2], B1[2][2];
    v8i_t At8[4], B08[2], B18[2];
    LAS unsigned char* aBase = lds + aoff; LAS unsigned char* bBase = lds + 65536 + boff;
    asm volatile("" : "+v"(aBase), "+v"(bBase));
    const char* cA = cur.A; const char* cB = cur.B;
    if (GATHER) {
#pragma unroll
        for (int h = 0; h < 2; ++h)
#pragma unroll
            for (int i = 0; i < 2; ++i) vA[h][i] = G8_ROWOFF(cur, h, i);
        asm volatile("" : "+v"(vA[0][0]), "+v"(vA[0][1]), "+v"(vA[1][0]), "+v"(vA[1][1]));
    }
    const long hA = GATHER ? 0 : 0;
    (void)hA;
    G8_STB(G8_SB(0, 0), cB); G8_STB(G8_SB(0, 1), cB + hB); G8_STAGE(G8_SA(0, 0), cA, vA[0][0], vA[0][1]); G8_STAGE(G8_SA(0, 1), cA, vA[1][0], vA[1][1]);
    if (wr == 1) G8_BAR;
    G8_WAIT_V(2); G8_BAR;
    G8_STB(G8_SB(1, 0), cB + kB); G8_STAGE(G8_SA(1, 0), cA + kA, vA[0][0], vA[0][1]); G8_STB(G8_SB(1, 1), cB + hB + kB);
    G8_WAIT_V(6); G8_BAR;
    for (;;) {
        const bool has_next = S.next(ui + 1, nxt);
        const char* nA = has_next ? nxt.A : cA; const char* nB = has_next ? nxt.B : cB;
        const int nt = cur.nt;
        for (int t = 0; t < nt; t += 2) {
            const bool last = (t == nt - 2);
            const char* a1 = cA + (long)(t + 1) * kA;
            const char* a2 = last ? nA : cA + (long)(t + 2) * kA; const char* b2 = last ? nB : cB + (long)(t + 2) * kB;
            const char* a3 = a2 + kA; const char* b3 = b2 + kB;
            G8_LDB(B0, 0, 0); G8_LDB(B1, 0, 1); G8_SCHED; G8_LDA(At, 0, 0); G8_STAGE(G8_SA(1, 1), a1, vA[1][0], vA[1][1]);
            if (GATHER && last && has_next) {
                vA[0][0] = G8_ROWOFF(nxt, 0, 0); vA[0][1] = G8_ROWOFF(nxt, 0, 1); vA[1][0] = G8_ROWOFF(nxt, 1, 0); vA[1][1] = G8_ROWOFF(nxt, 1, 1);
                asm volatile("" : "+v"(vA[0][0]), "+v"(vA[0][1]), "+v"(vA[1][0]), "+v"(vA[1][1]));
            }
            const unsigned w00 = vA[0][0], w01 = vA[0][1], w10 = vA[1][0], w11 = vA[1][1];
            G8_WAIT_V(8); G8_WAIT_L(0); G8_BAR; G8_MMA(0, 0, At, B0); G8_MMA(0, 1, At, B1); G8_BAR; G8_SCHED;
            G8_LDA(At, 0, 1); G8_STB(G8_SB(0, 0), b2); G8_STB(G8_SB(0, 1), b2 + hB); G8_STAGE(G8_SA(0, 0), a2, w00, w01);
            G8_WAIT_V(8); G8_WAIT_L(0); G8_BAR; G8_MMA(1, 0, At, B0); G8_MMA(1, 1, At, B1); G8_BAR; G8_SCHED;
            G8_LDB(B0, 1, 0); G8_LDB(B1, 1, 1); G8_SCHED; G8_LDA(At, 1, 0); G8_STAGE(G8_SA(0, 1), a2, w10, w11);
            G8_WAIT_V(8); G8_WAIT_L(0); G8_BAR; G8_MMA(0, 0, At, B0); G8_MMA(0, 1, At, B1); G8_BAR; G8_SCHED;
            G8_LDA(At, 1, 1); G8_STB(G8_SB(1, 0), b3); G8_STB(G8_SB(1, 1), b3 + hB); G8_STAGE(G8_SA(1, 0), a3, w00, w01);
            G8_WAIT_V(8); G8_WAIT_L(0); G8_BAR; G8_MMA(1, 0, At, B0); G8_MMA(1, 1, At, B1); G8_BAR; G8_SCHED;
        }
        if (wr == 0) G8_BAR;
        { int t3_ = threadIdx.x; asm volatile("" : "+v"(t3_)); E(acc, cur, wr, wc, t3_ & 15, (t3_ >> 4) & 3); }
        if (!has_next) break;
        if (!Epi::KEEP || cur.e != 0) {
#pragma unroll
        for (int a = 0; a < 2; ++a)
#pragma unroll
            for (int b = 0; b < 2; ++b)
#pragma unroll
                for (int m = 0; m < 4; ++m)
#pragma unroll
                    for (int n = 0; n < 2; ++n) acc[a][b][m][n] = (f32x4){0.f, 0.f, 0.f, 0.f};
        }
        cur = nxt; cA = nA; cB = nB; ++ui;
        if (wr == 1) G8_BAR;
    }
    G8_WAIT_V(0);
    G8_BAR;
#undef G8_SA
#undef G8_SB
#undef G8_STAGE
#undef G8_STB
#undef G8_LDA
#undef G8_LDB
#undef G8_MMA
#undef G8_WAIT_V
#undef G8_WAIT_L
#undef G8_BAR
#undef G8_SCHED
#undef G8_ROWOFF
}
}
namespace g8 {
__device__ __forceinline__ unsigned pk_bf16(float lo, float hi) { return pk_bf16_hw(lo, hi); }
__device__ __forceinline__ u32x4 pack8(const f32x4 a, const f32x4 b) { u32x4 w; w[0] = pk_bf16(a[0], a[1]); w[1] = pk_bf16(a[2], a[3]); w[2] = pk_bf16(b[0], b[1]); w[3] = pk_bf16(b[2], b[3]); return w; }
__device__ __forceinline__ int unit_index(int i, int nunits) {
    const int G = gridDim.x, c = blockIdx.x;
    if ((G & 7) != 0) { const long L = (long)i * G + c; return L < nunits ? (int)L : -1; }
    const int x = c & 7, r = c >> 3, GX = G >> 3;
    const int lo = (int)(((long)nunits * x) >> 3), hi = (int)(((long)nunits * (x + 1)) >> 3);
    const int L = lo + i * GX + r;
    return L < hi ? L : -1;
}
struct SchedReg {
    const char* A; const char* B; int lda_b, ldb_b, nM, nN, nt; int pm0 = 0;
    __device__ __forceinline__ bool next(int i, Unit& u) const {
        const int L = unit_index(i, nM * nN); if (L < 0) return false;
        u.pm = pm0 + L / nN; u.pn = L % nN; u.e = 0; u.nt = nt; u.rows = nullptr;
        u.A = A + (size_t)u.pm * 256 * lda_b; u.B = B + (size_t)u.pn * 256 * ldb_b; return true;
    }
};
struct SchedS5 {
    const char* A; const char* B; int lda_b, ldb_b, nN, nt; size_t a_gstride, b_gstride; int toep; int pair_light = 0;
    __device__ __forceinline__ bool next(int i, Unit& u) const {
        int L;
        if (pair_light && gridDim.x == 256) {
            if (i > 0) return false;
            const int La = unit_index(0, 256); if ((La & 3) != 0) return false;
            L = La >> 2;
        } else { L = unit_index(i, SG * 2 * nN); if (L < 0) return false; }
        const int g = L / (2 * nN), r = L % (2 * nN);
        u.pm = r / nN; u.pn = r % nN; u.e = g; u.rows = nullptr;
        u.A = A + (size_t)g * a_gstride + (size_t)u.pm * 256 * lda_b;
        if (toep) { u.B = B + (size_t)g * 127 * 512 + 63 * 512 + (size_t)u.pn * 256 * 32 - 1536; u.nt = 4 * (u.pn + 1); }
        else { u.B = B + (size_t)g * b_gstride + (size_t)u.pn * 256 * ldb_b; u.nt = nt; }
        return true;
    }
};
struct SchedMoe {
    const char* A; const char* B; const int* eoff; const int* rowtok; int lda_b, npn, nt; size_t b_estride; int ldb_b; int gather; const int* tile_e;
    __device__ __forceinline__ bool next(int i, Unit& u) const {
        const int nrt = eoff[64] >> 8;
        const int G = gridDim.x, c = blockIdx.x;
        int rt;
        if ((G & 7) == 0) {
            const int x = c & 7, r = c >> 3, GX = G >> 3;
            const int r0 = (nrt * x) >> 3, r1 = (nrt * (x + 1)) >> 3, nr = r1 - r0;
            const int j = i * GX + r;
            if (j >= (nr + 16) * npn) return false;
            const int tl = j / npn; u.pn = j % npn;
            rt = (tl < nr) ? r0 + tl : nrt + 16 * x + (tl - nr);
        } else {
            const long L = (long)i * G + c; if (L >= (long)(nrt + T / 256) * npn) return false;
            rt = (int)(L / npn); u.pn = (int)(L % npn);
        }
        u.nt = nt;
        int e = 64;
        if (rt < nrt) e = tile_e[rt];
        u.e = e; u.pm = rt;
        u.B = B + (size_t)e * b_estride + (size_t)u.pn * 256 * ldb_b;
        if (gather) {
            u.A = A; u.rows = rowtok + ((e < 64) ? rt * 256 : SH_ROW0 + (rt - nrt) * 256);
        } else {
            const int row0 = (e < 64) ? rt * 256 : SH_ROW0 + (rt - nrt) * 256;
            u.A = A + (size_t)row0 * lda_b; u.rows = nullptr;
        }
        return true;
    }
};

#define EPI_ROWS_BEGIN _Pragma("unroll") for (int ai = 0; ai < 2; ++ai) _Pragma("unroll") for (int m = 0; m < 4; ++m) { const int rloc = ai * 128 + wr * 64 + m * 16 + fr;
#define EPI_ROWS_END }

struct EpiWin {
    static constexpr bool KEEP = false;
    bf16_t* cq; bf16_t* ckv; bf16_t* u; bf16_t* Kc; const float2* rope; float* rsqp; float* rskvp;
    __device__ __forceinline__ void operator()(const Acc& acc, const Unit& un, int wr, int wc, int fr, int fq) const {
        const int pn = un.pn;
        if (pn == 0) {
            EPI_ROWS_BEGIN
                const int t = un.pm * 256 + rloc;
                float ss = 0.f;
#pragma unroll
                for (int bj = 0; bj < 2; ++bj) { const f32x4 v0 = acc[ai][bj][m][0], v1 = acc[ai][bj][m][1];
                    *(u32x4*)(cq + (size_t)t * 256 + bj * 128 + wc * 32 + fq * 8) = pack8(v0, v1);
                    ss += v0[0] * v0[0] + v0[1] * v0[1] + v0[2] * v0[2] + v0[3] * v0[3] + v1[0] * v1[0] + v1[1] * v1[1] + v1[2] * v1[2] + v1[3] * v1[3]; }
                ss += __shfl_xor(ss, 16); ss += __shfl_xor(ss, 32);
                if (fq == 0) rsqp[(size_t)t * 4 + wc] = ss;
            EPI_ROWS_END
        } else if (pn <= 2) {
            EPI_ROWS_BEGIN
                const int t = un.pm * 256 + rloc;
                const int b = t >> 11, s = t & 2047, j = s >> 6, sl = s & 63;
#pragma unroll
                for (int bj = 0; bj < 2; ++bj) { const int ch0 = (pn - 1) * 256 + bj * 128 + wc * 32 + fq * 8, gi = ch0 >> 4, c0 = ch0 & 15;
                    *(u32x4*)(u + ((size_t)gi * 512 + b * 32 + j) * 1024 + sl * 16 + c0) = pack8(acc[ai][bj][m][0], acc[ai][bj][m][1]); }
            EPI_ROWS_END
        } else {
            EPI_ROWS_BEGIN
                const int t = un.pm * 256 + rloc;
                const f32x4 v0 = acc[ai][0][m][0], v1 = acc[ai][0][m][1];
                *(u32x4*)(ckv + (size_t)t * 256 + wc * 32 + fq * 8) = pack8(v0, v1);
                float ss = v0[0] * v0[0] + v0[1] * v0[1] + v0[2] * v0[2] + v0[3] * v0[3] + v1[0] * v1[0] + v1[1] * v1[1] + v1[2] * v1[2] + v1[3] * v1[3];
                ss += __shfl_xor(ss, 16); ss += __shfl_xor(ss, 32);
                if (fq == 0) rskvp[(size_t)t * 4 + wc] = ss;
                *(u32x4*)(ckv + (size_t)t * 256 + 128 + wc * 32 + fq * 8) = (u32x4){0u, 0u, 0u, 0u};
            EPI_ROWS_END
            if (wc == 0) {
                EPI_ROWS_BEGIN
                    const int t = un.pm * 256 + rloc;
                    const f32x4 x1 = acc[ai][1][m][0], x2 = acc[ai][1][m][1];
                    const f32x4 ca = *(const f32x4*)(rope + (size_t)t * 16 + fq * 4), cb = *(const f32x4*)(rope + (size_t)t * 16 + fq * 4 + 2);
                    const float o10 = x1[0] * ca[0] - x2[0] * ca[1], o11 = x1[1] * ca[2] - x2[1] * ca[3], o12 = x1[2] * cb[0] - x2[2] * cb[1], o13 = x1[3] * cb[2] - x2[3] * cb[3];
                    const float o20 = x2[0] * ca[0] + x1[0] * ca[1], o21 = x2[1] * ca[2] + x1[1] * ca[3], o22 = x2[2] * cb[0] + x1[2] * cb[1], o23 = x2[3] * cb[2] + x1[3] * cb[3];
                    uint2 w1, w2; w1.x = pk_bf16(o10, o11); w1.y = pk_bf16(o12, o13); w2.x = pk_bf16(o20, o21); w2.y = pk_bf16(o22, o23);
                    const int b = t >> 11, s = t & 2047;
                    bf16_t* kp = Kc + (size_t)t * 32 + fq * 4;
                    *(uint2*)kp = w1; *(uint2*)(kp + 16) = w2; (void)b; (void)s;
                EPI_ROWS_END
            }
        }
    }
};
struct EpiQ {
    static constexpr bool KEEP = false;
    bf16_t* Q; const float* rsqp; const float2* rope;
    __device__ __forceinline__ void operator()(const Acc& acc, const Unit& un, int wr, int wc, int fr, int fq) const {
        EPI_ROWS_BEGIN
            const int t = un.pm * 256 + rloc, b = t >> 11, s = t & 2047;
            const f32x4 pp = *(const f32x4*)(rsqp + (size_t)t * 4);
            const float rs = rsqrtf((pp[0] + pp[1] + pp[2] + pp[3]) * (1.0f / 256) + EPS);
            if (un.pn < 2) {
#pragma unroll
                for (int bj = 0; bj < 2; ++bj) { const int col = un.pn * 256 + bj * 128 + wc * 32 + fq * 8;
                    *(u32x4*)(Q + (((size_t)b * NH + (col >> 6)) * SEQ + s) * QKD + (col & 63)) = pack8(acc[ai][bj][m][0] * rs, acc[ai][bj][m][1] * rs); }
            } else {
                const f32x4 ca = *(const f32x4*)(rope + (size_t)t * 16 + fq * 4), cb = *(const f32x4*)(rope + (size_t)t * 16 + fq * 4 + 2);
#pragma unroll
                for (int bj = 0; bj < 2; ++bj) { const f32x4 x1 = acc[ai][bj][m][0] * rs, x2 = acc[ai][bj][m][1] * rs;
                    const float o10 = x1[0] * ca[0] - x2[0] * ca[1], o11 = x1[1] * ca[2] - x2[1] * ca[3], o12 = x1[2] * cb[0] - x2[2] * cb[1], o13 = x1[3] * cb[2] - x2[3] * cb[3];
                    const float o20 = x2[0] * ca[0] + x1[0] * ca[1], o21 = x2[1] * ca[2] + x1[1] * ca[3], o22 = x2[2] * cb[0] + x1[2] * cb[1], o23 = x2[3] * cb[2] + x1[3] * cb[3];
                    uint2 w1, w2; w1.x = pk_bf16(o10, o11); w1.y = pk_bf16(o12, o13); w2.x = pk_bf16(o20, o21); w2.y = pk_bf16(o22, o23);
                    bf16_t* qp = Q + (((size_t)b * NH + (bj * 4 + wc)) * SEQ + s) * QKD + 64 + fq * 4; *(uint2*)qp = w1; *(uint2*)(qp + 16) = w2; }
            }
        EPI_ROWS_END
    }
};
struct EpiKV {
    static constexpr bool KEEP = false;
    bf16_t* Kc; bf16_t* V; const float* rskvp;
    __device__ __forceinline__ void operator()(const Acc& acc, const Unit& un, int wr, int wc, int fr, int fq) const {
        EPI_ROWS_BEGIN
            const int t = un.pm * 256 + rloc, b = t >> 11, s = t & 2047;
            const f32x4 pp = *(const f32x4*)(rskvp + (size_t)t * 4);
            const float rs = rsqrtf((pp[0] + pp[1] + pp[2] + pp[3]) * (1.0f / 128) + EPS);
#pragma unroll
            for (int bj = 0; bj < 2; ++bj) { const int col = (un.pn & 1) * 256 + bj * 128 + wc * 32 + fq * 8;
                const u32x4 w = pack8(acc[ai][bj][m][0] * rs, acc[ai][bj][m][1] * rs);
                if (un.pn < 2) *(u32x4*)(Kc + (((size_t)b * NH + (col >> 6)) * SEQ + s) * QKD + (col & 63)) = w;
                else *(u32x4*)(V + (((size_t)b * NH + (col >> 6)) * SEQ + s) * VD + (col & 63)) = w; }
        EPI_ROWS_END
    }
};
struct EpiS5b {
    static constexpr bool KEEP = false;
    float* xloc;
    __device__ __forceinline__ void operator()(const Acc& acc, const Unit& un, int wr, int wc, int fr, int fq) const {
        EPI_ROWS_BEGIN
            float* o = xloc + ((size_t)un.e * 512 + un.pm * 256 + rloc) * 128 + wc * 32 + fq * 8;
            *(f32x4*)o = acc[ai][0][m][0]; *(f32x4*)(o + 4) = acc[ai][0][m][1];
        EPI_ROWS_END
    }
};
template <int MODE> struct EpiS5y {
    static constexpr bool KEEP = false;
    bf16_t* dst; const bf16_t* yintra;
    __device__ __forceinline__ void operator()(const Acc& acc, const Unit& un, int wr, int wc, int fr, int fq) const {
        EPI_ROWS_BEGIN
            const int row = un.pm * 256 + rloc, b = row >> 5, j = row & 31;
#pragma unroll
            for (int bj = 0; bj < 2; ++bj) { const int n = un.pn * 256 + bj * 128 + wc * 32 + fq * 8, tt = n >> 4, c0 = n & 15;
                const size_t o = ((size_t)b * SEQ + j * CH + tt) * SSMW + un.e * SC + c0;
                f32x4 v0 = acc[ai][bj][m][0], v1 = acc[ai][bj][m][1];
                if (MODE == 1) { const bf16x8 yi = *(const bf16x8*)(yintra + o);
#pragma unroll
                    for (int q = 0; q < 4; ++q) { v0[q] = gelu_tanh(v0[q] + bf2f((bf16_t)yi[q])); v1[q] = gelu_tanh(v1[q] + bf2f((bf16_t)yi[4 + q])); } }
                *(u32x4*)(dst + o) = pack8(v0, v1); }
        EPI_ROWS_END
    }
};
struct EpiGlu {
    static constexpr bool KEEP = false;
    const bf16_t* Y; const float* bglu; bf16_t* AS; float* sss;
    __device__ __forceinline__ void operator()(const Acc& acc, const Unit& un, int wr, int wc, int fr, int fq) const {
        EPI_ROWS_BEGIN
            const int t = un.pm * 256 + rloc;
            float ssq = 0.f;
#pragma unroll
            for (int bj = 0; bj < 2; ++bj) { const int col = un.pn * 256 + bj * 128 + wc * 32 + fq * 8;
                const bf16x8 yv = *(const bf16x8*)(Y + (size_t)t * 512 + col);
                const f32x4 b0 = *(const f32x4*)(bglu + col), b1 = *(const f32x4*)(bglu + col + 4);
                f32x4 v0 = acc[ai][bj][m][0], v1 = acc[ai][bj][m][1];
#pragma unroll
                for (int q = 0; q < 4; ++q) { v0[q] = bf2f((bf16_t)yv[q]) * sigmoidf_(v0[q] + b0[q]); v1[q] = bf2f((bf16_t)yv[4 + q]) * sigmoidf_(v1[q] + b1[q]); }
                const u32x4 pk = pack8(v0, v1);
                *(u32x4*)(AS + (size_t)t * 1024 + 512 + col) = pk;
#pragma unroll
                for (int q = 0; q < 4; ++q) { const float lo = __uint_as_float(pk[q] << 16), hi = __uint_as_float(pk[q] & 0xffff0000u); ssq += lo * lo + hi * hi; } }
            ssq += __shfl_xor(ssq, 16); ssq += __shfl_xor(ssq, 32);
            if (fq == 0) sss[(size_t)t * 8 + un.pn * 4 + wc] = ssq;
        EPI_ROWS_END
    }
};
struct EpiWo {
    static constexpr bool KEEP = false;
    const float* x; const float* xstat; const float* g; const float* bt; float* pre1;
    __device__ __forceinline__ void operator()(const Acc& acc, const Unit& un, int wr, int wc, int fr, int fq) const {
        EPI_ROWS_BEGIN
            const int t = un.pm * 256 + rloc;
            const float mu = xstat[2 * t], rstd = xstat[2 * t + 1];
#pragma unroll
            for (int bj = 0; bj < 2; ++bj) { const int col = un.pn * 256 + bj * 128 + wc * 32 + fq * 8;
#pragma unroll
                for (int n = 0; n < 2; ++n) { const f32x4 xv = *(const f32x4*)(x + (size_t)t * D + col + 4 * n), gg = *(const f32x4*)(g + col + 4 * n), bb = *(const f32x4*)(bt + col + 4 * n);
                    f32x4 o;
#pragma unroll
                    for (int q = 0; q < 4; ++q) o[q] = acc[ai][bj][m][n][q] + ALPHA * ((xv[q] - mu) * rstd * gg[q] + bb[q]);
                    *(f32x4*)(pre1 + (size_t)t * D + col + 4 * n) = o; } }
        EPI_ROWS_END
    }
};
struct EpiWoLn {
    static constexpr bool KEEP = true;
    const float* x; const float* xstat; const float* gi; const float* bi; const float* g1; const float* b1;
    bf16_t* x1; unsigned char* x1q; float* pstat; XcdBarrier bar; const float* ssa; const float* sss;
    __device__ __forceinline__ void prefetch(const Unit&, int) const {}
    __device__ __forceinline__ void operator()(Acc& acc, const Unit& un, int wr, int wc, int fr, int fq) const {
        EPI_ROWS_BEGIN
            const int t = un.pm * 256 + rloc;
            const f32x4 a0 = *(const f32x4*)(ssa + (size_t)t * 8), a1 = *(const f32x4*)(ssa + (size_t)t * 8 + 4), b0 = *(const f32x4*)(sss + (size_t)t * 8), b1 = *(const f32x4*)(sss + (size_t)t * 8 + 4);
            const float ra = rsqrtf((a0[0] + a0[1] + a0[2] + a0[3] + a1[0] + a1[1] + a1[2] + a1[3]) * (1.0f / 512) + EPS);
            const float rs = rsqrtf((b0[0] + b0[1] + b0[2] + b0[3] + b1[0] + b1[1] + b1[2] + b1[3]) * (1.0f / 512) + EPS);
            const float sc = (un.e == 0) ? ra / rs : rs;
#pragma unroll
            for (int bj = 0; bj < 2; ++bj)
#pragma unroll
                for (int n = 0; n < 2; ++n) acc[ai][bj][m][n] *= sc;
        EPI_ROWS_END
        if (un.e == 0) return;
        EPI_ROWS_BEGIN
            const int t = un.pm * 256 + rloc;
            const float mu = xstat[2 * t], rstd = xstat[2 * t + 1];
            float s1 = 0.f, s2 = 0.f;
#pragma unroll
            for (int bj = 0; bj < 2; ++bj) { const int col = un.pn * 256 + bj * 128 + wc * 32 + fq * 8;
#pragma unroll
                for (int n = 0; n < 2; ++n) { const f32x4 xv = __builtin_nontemporal_load((const f32x4*)(x + (size_t)t * D + col + 4 * n)), gg = *(const f32x4*)(gi + col + 4 * n), bb = *(const f32x4*)(bi + col + 4 * n);
#pragma unroll
                    for (int q = 0; q < 4; ++q) { const float v = acc[ai][bj][m][n][q] + ALPHA * ((xv[q] - mu) * rstd * gg[q] + bb[q]); acc[ai][bj][m][n][q] = v; s1 += v; s2 += v * v; } } }
            s1 += __shfl_xor(s1, 16); s1 += __shfl_xor(s1, 32); s2 += __shfl_xor(s2, 16); s2 += __shfl_xor(s2, 32);
            if (fq == 0) { f32x2 o; o[0] = s1; o[1] = s2; *(f32x2*)(pstat + ((size_t)t * 16 + un.pn * 4 + wc) * 2) = o; }
        EPI_ROWS_END
        xcd_barrier(bar);
        EPI_ROWS_BEGIN
            const int t = un.pm * 256 + rloc;
            float s1 = 0.f, s2 = 0.f;
#pragma unroll
            for (int j = 0; j < 8; ++j) { const f32x4 p = *(const f32x4*)(pstat + (size_t)t * 32 + 4 * j); s1 += p[0] + p[2]; s2 += p[1] + p[3]; }
            const float mean = s1 * (1.0f / D), rs = rsqrtf(s2 * (1.0f / D) - mean * mean + EPS);
#pragma unroll
            for (int bj = 0; bj < 2; ++bj) { const int col = un.pn * 256 + bj * 128 + wc * 32 + fq * 8;
                f32x4 o[2];
#pragma unroll
                for (int n = 0; n < 2; ++n) { const f32x4 gg = *(const f32x4*)(g1 + col + 4 * n), bb = *(const f32x4*)(b1 + col + 4 * n);
#pragma unroll
                    for (int q = 0; q < 4; ++q) o[n][q] = (acc[ai][bj][m][n][q] - mean) * rs * gg[q] + bb[q]; }
                *(u32x4*)(x1 + (size_t)t * D + col) = pack8(o[0], o[1]);
                int p0 = __builtin_amdgcn_cvt_pk_fp8_f32(o[0][0] * XQ_SCALE, o[0][1] * XQ_SCALE, 0, false); p0 = __builtin_amdgcn_cvt_pk_fp8_f32(o[0][2] * XQ_SCALE, o[0][3] * XQ_SCALE, p0, true);
                int p1 = __builtin_amdgcn_cvt_pk_fp8_f32(o[1][0] * XQ_SCALE, o[1][1] * XQ_SCALE, 0, false); p1 = __builtin_amdgcn_cvt_pk_fp8_f32(o[1][2] * XQ_SCALE, o[1][3] * XQ_SCALE, p1, true);
                u32x2 w; w[0] = (unsigned)p0; w[1] = (unsigned)p1;
                *(u32x2*)(x1q + (size_t)t * D + col) = w; }
        EPI_ROWS_END
    }
};
struct EpiGU {
    static constexpr bool KEEP = false;
    static constexpr float QINV = 1.0f / (XQ_SCALE * WQ_SCALE);
    bf16_t* H; const float* roww; const int* eoff;
    __device__ __forceinline__ void operator()(const Acc& acc, const Unit& un, int wr, int wc, int fr, int fq) const {
        const int nrt = eoff[64] >> 8;
        const bool shared = un.e == 64;
        const int row0 = shared ? SH_ROW0 + (un.pm - nrt) * 256 : un.pm * 256;
        EPI_ROWS_BEGIN
            const int row = row0 + rloc;
            const f32x4 g0 = acc[ai][0][m][0], g1 = acc[ai][0][m][1], u0 = acc[ai][1][m][0], u1 = acc[ai][1][m][1];
            f32x4 h0, h1;
#pragma unroll
            for (int q = 0; q < 4; ++q) { const float ga = g0[q] * QINV, gb = g1[q] * QINV; h0[q] = ga * sigmoidf_(ga) * (u0[q] * QINV); h1[q] = gb * sigmoidf_(gb) * (u1[q] * QINV); }
            { int p0 = __builtin_amdgcn_cvt_pk_fp8_f32(h0[0] * HQ_SCALE, h0[1] * HQ_SCALE, 0, false); p0 = __builtin_amdgcn_cvt_pk_fp8_f32(h0[2] * HQ_SCALE, h0[3] * HQ_SCALE, p0, true);
              int p1 = __builtin_amdgcn_cvt_pk_fp8_f32(h1[0] * HQ_SCALE, h1[1] * HQ_SCALE, 0, false); p1 = __builtin_amdgcn_cvt_pk_fp8_f32(h1[2] * HQ_SCALE, h1[3] * HQ_SCALE, p1, true);
              u32x2 w; w[0] = (unsigned)p0; w[1] = (unsigned)p1;
              *(u32x2*)((unsigned char*)H + (size_t)row * FF + un.pn * 128 + wc * 32 + fq * 8) = w; }
        EPI_ROWS_END
    }
};
struct EpiDown {
    static constexpr bool KEEP = false;
    __device__ __forceinline__ void prefetch(const Unit&, int) const {}
    static constexpr float OSC = SLOT_SCALE / (HQ_SCALE * WQ_SCALE);
    unsigned char* yslot; unsigned char* shslot; const int* rowtok; const int* eoff; LAS unsigned char* stg;
    __device__ __forceinline__ void operator()(const Acc& acc, const Unit& un, int wr, int wc, int fr, int fq) const {
        const int nrt = eoff[64] >> 8;
        const bool shared = un.e == 64;
        const int tid = (wr * 4 + wc) * 64 + fq * 16 + fr;
        const int rrow = tid >> 4, rcol = (tid & 15) * 16;
        int slots[8];
#pragma unroll
        for (int q = 0; q < 8; ++q) { const int rloc = (q >> 2) * 128 + (rrow >> 4) * 64 + (q & 3) * 16 + (rrow & 15);
            slots[q] = (shared ? (un.pm - nrt) : un.pm) * 256 + rloc; }
        unsigned char* base = shared ? shslot : yslot;
        int p = 0;
#pragma unroll
        for (int ai = 0; ai < 2; ++ai)
#pragma unroll
            for (int m = 0; m < 4; ++m, ++p) {
                LAS unsigned char* sb = stg + (p & 1) * (32 * 288);
#pragma unroll
                for (int bj = 0; bj < 2; ++bj) {
                    const f32x4 v0 = acc[ai][bj][m][0] * OSC, v1 = acc[ai][bj][m][1] * OSC;
                    int p0 = __builtin_amdgcn_cvt_pk_fp8_f32(v0[0], v0[1], 0, false); p0 = __builtin_amdgcn_cvt_pk_fp8_f32(v0[2], v0[3], p0, true);
                    int p1 = __builtin_amdgcn_cvt_pk_fp8_f32(v1[0], v1[1], 0, false); p1 = __builtin_amdgcn_cvt_pk_fp8_f32(v1[2], v1[3], p1, true);
                    u32x2 w; w[0] = (unsigned)p0; w[1] = (unsigned)p1;
                    *(LAS u32x2*)(sb + (wr * 16 + fr) * 288 + bj * 128 + wc * 32 + fq * 8) = w;
                }
                asm volatile("s_waitcnt lgkmcnt(0)\n\ts_barrier" ::: "memory");
                const int slot = slots[ai * 4 + m];
                const u32x4 v = *(const LAS u32x4*)(sb + rrow * 288 + rcol);
                if (slot >= 0) *(u32x4*)(base + (size_t)slot * D + un.pn * 256 + rcol) = v;
            }
        asm volatile("s_waitcnt lgkmcnt(0)\n\ts_barrier" ::: "memory");
    }
};
}
namespace g8 {
struct EpiRouter {
    static constexpr bool KEEP = false;
    float* logits;
    __device__ __forceinline__ void operator()(const Acc& acc, const Unit& un, int wr, int wc, int fr, int fq) const {
        if (wc >= 2) return;
        EPI_ROWS_BEGIN
            float* o = logits + (size_t)(un.pm * 256 + rloc) * NE + wc * 32 + fq * 8;
            *(f32x4*)o = acc[ai][0][m][0]; *(f32x4*)(o + 4) = acc[ai][0][m][1];
        EPI_ROWS_END
    }
};
}
__device__ __forceinline__ void fp_gemm_router(const Ptrs& P, LAS unsigned char* lds) {
    g8::Geo g{2048, 2048, 128, 128, 0};
    g8::SchedReg S{(const char*)WSP(bf16_t, WS_X1), (const char*)WSP(bf16_t, WS_WR), 2048, 2048, T / 256, 1, 16};
    g8::EpiRouter E{WSP(float, WS_LOGITS)};
    g8::gemm_body<g8::EpiRouter, g8::SchedReg, false>(lds, g, S, E);
}
#define TK_GT(va, ea, vb, eb) ((va) > (vb) || ((va) == (vb) && (ea) < (eb)))
#define TK_CSWAP(i, j) do { const bool sw_ = TK_GT(av[j], ae[j], av[i], ae[i]); const float v0_ = av[i], s0_ = as_[i]; const int e0_ = ae[i]; \
    av[i] = sw_ ? av[j] : av[i]; as_[i] = sw_ ? as_[j] : as_[i]; ae[i] = sw_ ? ae[j] : ae[i]; av[j] = sw_ ? v0_ : av[j]; as_[j] = sw_ ? s0_ : as_[j]; ae[j] = sw_ ? e0_ : ae[j]; } while (0)
#define TK_MERGE(xmask) do { \
    float bv_[8], bs_[8]; int be_[8]; \
    _Pragma("unroll") for (int i = 0; i < 8; ++i) { bv_[i] = __shfl_xor(av[7 - i], xmask); bs_[i] = __shfl_xor(as_[7 - i], xmask); be_[i] = __shfl_xor(ae[7 - i], xmask); } \
    _Pragma("unroll") for (int i = 0; i < 8; ++i) { const bool ka_ = TK_GT(av[i], ae[i], bv_[i], be_[i]); av[i] = ka_ ? av[i] : bv_[i]; as_[i] = ka_ ? as_[i] : bs_[i]; ae[i] = ka_ ? ae[i] : be_[i]; } \
    TK_CSWAP(0, 4); TK_CSWAP(1, 5); TK_CSWAP(2, 6); TK_CSWAP(3, 7); TK_CSWAP(0, 2); TK_CSWAP(1, 3); TK_CSWAP(4, 6); TK_CSWAP(5, 7); TK_CSWAP(0, 1); TK_CSWAP(2, 3); TK_CSWAP(4, 5); TK_CSWAP(6, 7); } while (0)
__device__ __forceinline__ void ph_topk_cnt(const Ptrs& P, LAS unsigned char* lds, int bid, int nb) {
    const int tidx = opaque_tid();
    const float* logits = WSP(float, WS_LOGITS); int* topi = WSP(int, WS_TOPI); float* topw = WSP(float, WS_TOPW); int* cnt = WSP(int, WS_CNT);
    LAS int* hist = (LAS int*)lds;
    LAS float* bias = (LAS float*)(lds + 256);
    LAS float* scs = (LAS float*)(lds + 512);
    for (int tile = bid; tile < 256; tile += nb) {
        if (tidx < 64) { hist[tidx] = 0; bias[tidx] = P.router_bias[tidx]; }
        for (int i = tidx; i < 128 * 64; i += NTHR) { const int tk = i >> 6, e = i & 63; scs[e * 129 + tk] = sigmoidf_(logits[(size_t)(tile * 128 + tk) * NE + e]); }
        __syncthreads();
        {
            const int tk = tidx >> 2, q = tidx & 3, t = tile * 128 + tk;
            float ga, gb;
            {
                float m1 = -INFINITY, m2 = -INFINITY, n1 = -INFINITY, n2 = -INFINITY;
#pragma unroll
                for (int j = 0; j < 8; ++j) {
                    const float v = scs[(16 * q + j) * 129 + tk] + bias[16 * q + j]; const bool a = v > m1; m2 = a ? m1 : fmaxf(m2, v); m1 = a ? v : m1;
                    const float w = scs[(16 * q + 8 + j) * 129 + tk] + bias[16 * q + 8 + j]; const bool b = w > n1; n2 = b ? n1 : fmaxf(n2, w); n1 = b ? w : n1; }
                ga = m1 + m2; gb = n1 + n2;
            }
            float gs[8];
            const int qb = (tidx & 63) & ~3;
#pragma unroll
            for (int g = 0; g < 8; ++g) gs[g] = __shfl((g & 1) ? gb : ga, qb + (g >> 1));
            int mygrp = 0, nsel = 0;
#pragma unroll
            for (int g = 0; g < 8; ++g) { int c = 0;
#pragma unroll
                for (int h = 0; h < 8; ++h) c += (gs[h] > gs[g] || (gs[h] == gs[g] && h < g)) ? 1 : 0;
                const bool sel = c < 4; mygrp = (sel && nsel == q) ? g : mygrp; nsel += sel ? 1 : 0; }
            float av[8], as_[8]; int ae[8];
#pragma unroll
            for (int j = 0; j < 8; ++j) { const int e = mygrp * 8 + j; const float s0 = scs[e * 129 + tk]; as_[j] = s0; av[j] = s0 + bias[e]; ae[j] = e; }
            TK_CSWAP(0, 1); TK_CSWAP(2, 3); TK_CSWAP(4, 5); TK_CSWAP(6, 7); TK_CSWAP(1, 2); TK_CSWAP(3, 4); TK_CSWAP(5, 6);
            TK_CSWAP(0, 1); TK_CSWAP(2, 3); TK_CSWAP(4, 5); TK_CSWAP(6, 7); TK_CSWAP(1, 2); TK_CSWAP(3, 4); TK_CSWAP(5, 6);
            TK_CSWAP(0, 1); TK_CSWAP(2, 3); TK_CSWAP(4, 5); TK_CSWAP(6, 7); TK_CSWAP(1, 2); TK_CSWAP(3, 4); TK_CSWAP(5, 6);
            TK_CSWAP(0, 1); TK_CSWAP(2, 3); TK_CSWAP(4, 5); TK_CSWAP(6, 7); TK_CSWAP(1, 2); TK_CSWAP(3, 4); TK_CSWAP(5, 6);
            TK_MERGE(1); TK_MERGE(2);
            float wsum = 0.f;
#pragma unroll
            for (int k = 0; k < 8; ++k) wsum += as_[k];
            const float sc_ = 2.5f / wsum;
            const int e0 = (q == 0) ? ae[0] : (q == 1) ? ae[2] : (q == 2) ? ae[4] : ae[6], e1 = (q == 0) ? ae[1] : (q == 1) ? ae[3] : (q == 2) ? ae[5] : ae[7];
            const float w0 = ((q == 0) ? as_[0] : (q == 1) ? as_[2] : (q == 2) ? as_[4] : as_[6]) * sc_, w1 = ((q == 0) ? as_[1] : (q == 1) ? as_[3] : (q == 2) ? as_[5] : as_[7]) * sc_;
            *(int2*)(topi + (size_t)t * TOPK + 2 * q) = make_int2(e0, e1);
            *(float2*)(topw + (size_t)t * TOPK + 2 * q) = make_float2(w0, w1);
            __hip_atomic_fetch_add(hist + e0, 1, __ATOMIC_RELAXED, __HIP_MEMORY_SCOPE_WORKGROUP);
            __hip_atomic_fetch_add(hist + e1, 1, __ATOMIC_RELAXED, __HIP_MEMORY_SCOPE_WORKGROUP);
        }
        __syncthreads();
        if (tidx < 64) cnt[tile * 64 + tidx] = hist[tidx];
        __syncthreads();
    }
}
__device__ __forceinline__ void ph_lists2(const Ptrs& P, LAS unsigned char* lds, int bid, int nb) {
    const int tidx = opaque_tid();
    const int* topi = WSP(int, WS_TOPI); const float* topw = WSP(float, WS_TOPW); const int* cnt = WSP(int, WS_CNT);
    int* eoff = WSP(int, WS_EOFF); int* rowtok = WSP(int, WS_ROWTOK); int* invrow = WSP(int, WS_INVROW);
    LAS int* red_tot = (LAS int*)lds;
    LAS int* red_pre = red_tot + 512;
    LAS int* tot = red_pre + 512;
    LAS int* off = tot + 64;
    LAS int* seg = off + 128;
    LAS int* ti = seg + 512;
    LAS float* tw = (LAS float*)(ti + 1024);
    const int e = tidx & 63, part = tidx >> 6;
    for (int tile = bid; tile < 256; tile += nb) {
        int cv[32];
#pragma unroll
        for (int q = 0; q < 32; ++q) cv[q] = cnt[(part * 32 + q) * 64 + e];
        const int i0v = topi[tile * 1024 + tidx], i1v = topi[tile * 1024 + 512 + tidx];
        const float w0v = topw[tile * 1024 + tidx], w1v = topw[tile * 1024 + 512 + tidx];
        int st = 0, sp = 0;
#pragma unroll
        for (int q = 0; q < 32; ++q) { st += cv[q]; sp += (part * 32 + q < tile) ? cv[q] : 0; }
        red_tot[part * 64 + e] = st; red_pre[part * 64 + e] = sp;
        ti[tidx] = i0v; ti[tidx + 512] = i1v; tw[tidx] = w0v; tw[tidx + 512] = w1v;
        __syncthreads();
        int pre_e = 0;
        if (tidx < 64) { int a = 0;
#pragma unroll
            for (int q = 0; q < 8; ++q) { a += red_tot[q * 64 + tidx]; pre_e += red_pre[q * 64 + tidx]; } tot[tidx] = a; }
        int c = 0;
#pragma unroll 16
        for (int k = 0; k < 128; ++k) c += (ti[part * 128 + k] == e) ? 1 : 0;
        seg[part * 64 + e] = c;
        __syncthreads();
        if (tidx == 0) { int o = 0; for (int i = 0; i < 64; ++i) { off[i] = o; o += (tot[i] + 255) & ~255; } off[64] = o; }
        if (tidx < 64) red_pre[tidx] = pre_e;
        __syncthreads();
        int pos = off[e] + red_pre[e];
        for (int q = 0; q < part; ++q) pos += seg[q * 64 + e];
#pragma unroll 8
        for (int k = 0; k < 128; ++k) { const int idx = part * 128 + k; if (ti[idx] == e) { rowtok[pos] = tile * 1024 + idx; invrow[tile * 1024 + idx] = pos; ++pos; } }
        if (tile == 255 && part == 7) { const int end = off[e + 1]; for (; pos < end; ++pos) rowtok[pos] = -1; }
        if (bid == 0 && tidx <= 64) eoff[tidx] = off[tidx];
        if (bid == 0 && tidx < 64) { int* tile_e = WSP(int, WS_TILEE); for (int rt = off[tidx] >> 8; rt < (off[tidx + 1] >> 8); ++rt) tile_e[rt] = tidx; }
        __syncthreads();
    }
    for (int i = bid * NTHR + tidx; i < T; i += nb * NTHR) rowtok[SH_ROW0 + i] = i * 8;
}
__device__ __forceinline__ void fp_gemm_win(const Ptrs& P, LAS unsigned char* lds) {
    g8::Geo g{2048, 2048, 128, 128, 0};
    g8::SchedReg S{(const char*)WSP(bf16_t, WS_XN), (const char*)WSP(bf16_t, WS_WIN), 2048, 2048, T / 256, 4, 16};
    g8::EpiWin E{WSP(bf16_t, WS_CQ), WSP(bf16_t, WS_CKV), WSP(bf16_t, WS_U), WSP(bf16_t, WS_KROPE), WSP(float2, WS_ROPE), WSP(float, WS_RSQ), WSP(float, WS_RSKV)};
    g8::gemm_body<g8::EpiWin, g8::SchedReg, false>(lds, g, S, E);
}
__device__ __forceinline__ void fp_gemm_q(const Ptrs& P, LAS unsigned char* lds) {
    g8::Geo g{512, 512, 128, 128, 0};
    g8::SchedReg S{(const char*)WSP(bf16_t, WS_CQ), (const char*)WSP(bf16_t, WS_WUQ), 512, 512, T / 256, 3, 4};
    g8::EpiQ E{WSP(bf16_t, WS_Q), WSP(float, WS_RSQ), WSP(float2, WS_ROPE)};
    g8::gemm_body<g8::EpiQ, g8::SchedReg, false>(lds, g, S, E);
}
__device__ __forceinline__ void fp_gemm_kv(const Ptrs& P, LAS unsigned char* lds) {
    g8::Geo g{512, 512, 128, 128, 0};
    g8::SchedReg S{(const char*)WSP(bf16_t, WS_CKV), (const char*)WSP(bf16_t, WS_WUKV), 512, 512, T / 256, 4, 2};
    g8::EpiKV E{WSP(bf16_t, WS_K), WSP(bf16_t, WS_V), WSP(float, WS_RSKV)};
    g8::gemm_body<g8::EpiKV, g8::SchedReg, false>(lds, g, S, E);
}
__device__ __forceinline__ void fp_gemm_s5b(const Ptrs& P, LAS unsigned char* lds) {
    g8::Geo g{2048, 2048, 128, 128, 0};
    g8::SchedS5 S{(const char*)WSP(bf16_t, WS_U), (const char*)WSP(bf16_t, WS_BLOC), 2048, 2048, 1, 16, (size_t)512 * 2048, (size_t)256 * 2048, 0, 1};
    g8::EpiS5b E{WSP(float, WS_XLOC)};
    g8::gemm_body<g8::EpiS5b, g8::SchedS5, false>(lds, g, S, E);
}
__device__ __forceinline__ void fp_gemm_s5a(const Ptrs& P, LAS unsigned char* lds) {
    g8::Geo g{2048, 32, 128, -2048, 1};
    g8::SchedS5 S{(const char*)WSP(bf16_t, WS_U), (const char*)WSP(bf16_t, WS_KTAB), 2048, 32, 4, 16, (size_t)512 * 2048, 0, 1};
    g8::EpiS5y<0> E{WSP(bf16_t, WS_YINTRA), nullptr};
    g8::gemm_body<g8::EpiS5y<0>, g8::SchedS5, false>(lds, g, S, E);
}
__device__ __forceinline__ void fp_gemm_s5d(const Ptrs& P, LAS unsigned char* lds) {
    g8::Geo g{512, 512, 128, 128, 0};
    g8::SchedS5 S{(const char*)WSP(bf16_t, WS_XPREV), (const char*)WSP(bf16_t, WS_CLAM), 512, 512, 4, 2, (size_t)512 * 512, (size_t)1024 * 512, 0};
    g8::EpiS5y<1> E{WSP(bf16_t, WS_Y), WSP(bf16_t, WS_YINTRA)};
    g8::gemm_body<g8::EpiS5y<1>, g8::SchedS5, false>(lds, g, S, E);
}
__device__ __forceinline__ void fp_gemm_glu(const Ptrs& P, LAS unsigned char* lds) {
    g8::Geo g{1024, 1024, 128, 128, 0};
    g8::SchedReg S{(const char*)WSP(bf16_t, WS_Y), (const char*)WSP(bf16_t, WS_WGLU), 1024, 1024, T / 256, 2, 8};
    g8::EpiGlu E{WSP(bf16_t, WS_Y), P.b_glu, WSP(bf16_t, WS_AS), WSP(float, WS_SSS)};
    g8::gemm_body<g8::EpiGlu, g8::SchedReg, false>(lds, g, S, E);
}
__device__ __forceinline__ void fp_gemm_wo(const Ptrs& P, LAS unsigned char* lds) {
    g8::Geo g{2048, 2048, 128, 128, 0};
    g8::SchedReg S{(const char*)WSP(bf16_t, WS_AS), (const char*)WSP(bf16_t, WS_WO), 2048, 2048, T / 256, 4, 16};
    g8::EpiWo E{P.x, WSP(float, WS_XSTAT), P.ln_in_g, P.ln_in_b, P.out};
    g8::gemm_body<g8::EpiWo, g8::SchedReg, false>(lds, g, S, E);
}
namespace g8 {
struct SchedWo2 {
    const char* A; const char* B; int pm0;
    __device__ __forceinline__ bool next(int i, Unit& u) const {
        if (i >= 2) return false;
        const int L = unit_index(0, 256); if (L < 0) return false;
        u.pm = pm0 + L / 4; u.pn = L % 4; u.e = i; u.nt = 8; u.rows = nullptr;
        u.A = A + (size_t)u.pm * 256 * 2048 + (size_t)i * 1024; u.B = B + (size_t)u.pn * 256 * 2048 + (size_t)i * 1024;
        return true;
    }
};
}
__device__ __forceinline__ void fp_gemm_wo_ln(const Ptrs& P, LAS unsigned char* lds, const XcdBarrier& bar, int call) {
    g8::Geo g{2048, 2048, 128, 128, 0};
    g8::SchedWo2 S{(const char*)WSP(bf16_t, WS_AS), (const char*)WSP(bf16_t, WS_WO), call * 64};
    g8::EpiWoLn E{P.x, WSP(float, WS_XSTAT), P.ln_in_g, P.ln_in_b, P.ln1_g, P.ln1_b, WSP(bf16_t, WS_X1), WSP(unsigned char, WS_X1Q), WSP(float, WS_XLOC), bar, WSP(float, WS_SSA), WSP(float, WS_SSS)};
    g8::gemm_body<g8::EpiWoLn, g8::SchedWo2, false>(lds, g, S, E);
}
__device__ __forceinline__ void fp_gemm_gu(const Ptrs& P, LAS unsigned char* lds) {
    g8::Geo g{1024, 1024, 128, 128, 0};
    g8::SchedMoe S{(const char*)WSP(unsigned char, WS_X1Q), (const char*)WSP(unsigned char, WS_WGU), WSP(int, WS_EOFF), WSP(int, WS_ROWTOK), 1024, 2, 8, (size_t)512 * 1024, 1024, 1, WSP(int, WS_TILEE)};
    g8::EpiGU E{WSP(bf16_t, WS_H), WSP(float, WS_ROWW), WSP(int, WS_EOFF)};
    g8::gemm_body<g8::EpiGU, g8::SchedMoe, true, 1>(lds, g, S, E);
}
__device__ __forceinline__ void fp_gemm_down(const Ptrs& P, LAS unsigned char* lds) {
    g8::Geo g{256, 256, 128, 128, 0};
    g8::SchedMoe S{(const char*)WSP(unsigned char, WS_H), (const char*)WSP(unsigned char, WS_WD), WSP(int, WS_EOFF), WSP(int, WS_ROWTOK), 256, 4, 2, (size_t)1024 * 256, 256, 0, WSP(int, WS_TILEE)};
    g8::EpiDown E{WSP(unsigned char, WS_YSLOT), WSP(unsigned char, WS_SHSLOT), WSP(int, WS_ROWTOK), WSP(int, WS_EOFF), lds + LDS_XTRA};
    g8::gemm_body<g8::EpiDown, g8::SchedMoe, false, 1>(lds, g, S, E);
}
namespace at8 {
typedef short s16x4 __attribute__((ext_vector_type(4)));
typedef short v4i16_t __attribute__((ext_vector_type(4)));
constexpr int KSLOT = 12288, VSLOT = 8192, NSLOT = 3;
constexpr int L_K = 0, L_V = NSLOT * KSLOT, L_WS = L_V + NSLOT * VSLOT, L_OST = L_WS + 8 * 256, L_END = L_OST + 8 * 4096;
__device__ __forceinline__ int crow(int r, int hi) { return (r & 3) + 8 * (r >> 2) + 4 * hi; }
__device__ __forceinline__ void glds16(const void* gsrc, LAS unsigned char* dst) { __builtin_amdgcn_global_load_lds((const unsigned*)gsrc, (LAS unsigned*)dst, 16, 0, 0); }
__device__ __forceinline__ s16x4 vtr(const LAS unsigned char* p) { return __builtin_bit_cast(s16x4, __builtin_amdgcn_ds_read_tr16_b64_v4i16((LAS v4i16_t*)p)); }
__device__ __forceinline__ unsigned cvtpk(float lo, float hi) { return pk_bf16_hw(lo, hi); }

__device__ __forceinline__ void attn_unit(int b, int h, int qb, const bf16_t* __restrict__ Q, const bf16_t* __restrict__ Kc, const bf16_t* __restrict__ V, bf16_t* __restrict__ AS, float* __restrict__ ssa, const bf16_t* __restrict__ krope, LAS unsigned char* lds) {
    const int tid = opaque_tid(), lane = tid & 63, r32 = lane & 31, hi = lane >> 5;
    const int wid = __builtin_amdgcn_readfirstlane(tid >> 6);
    const size_t bh = (size_t)b * NH + h;
    const bf16_t* Kbh = Kc + bh * SEQ * QKD; const bf16_t* Vbh = V + bh * SEQ * VD;
    const int q0 = qb * 256 + wid * 32;
    const int NT = 4 * (qb + 1);
    const int myNT = 4 * qb + (wid >> 1) + 1;
    const bf16_t* ksrc0 = Kbh + (size_t)lane * QKD + wid * 8;
    const bf16_t* ksrc1 = krope + ((size_t)b * SEQ + lane) * 32 + (wid & 3) * 8;
    const bf16_t* vsrc = Vbh + (size_t)(16 * (wid & 3) + (lane >> 2)) * VD + (wid >> 2) * 32 + (lane & 3) * 8;
#define AT_DMA(t, slot) do { glds16(ksrc0 + (size_t)(t) * 64 * QKD, lds + L_K + (slot) * KSLOT + wid * 1024); \
                             glds16(ksrc1 + (size_t)(t) * 64 * 32, lds + L_K + (slot) * KSLOT + (8 + (wid & 3)) * 1024); \
                             glds16(vsrc + (size_t)(t) * 64 * VD, lds + L_V + (slot) * VSLOT + wid * 1024); } while (0)
    AT_DMA(0, 0);
    if (NT > 1) AT_DMA(1, 1);
    bf16x8 qr[6];
    const bf16_t* qp = Q + (bh * SEQ + q0 + r32) * QKD + hi * 8;
#pragma unroll
    for (int ks = 0; ks < 6; ++ks) qr[ks] = *(const bf16x8*)(qp + ks * 16);
    f32x16 o0, o1;
#pragma unroll
    for (int i = 0; i < 16; ++i) { o0[i] = 0.f; o1[i] = 0.f; }
    float m_run = 0.f, l_run = 0.f;
    LAS float* wsf = (LAS float*)(lds + L_WS) + wid * 64;
    const LAS unsigned char* kp0 = lds + L_K + hi * 1024 + r32 * 16;
    const LAS unsigned char* vp0 = lds + L_V + ((lane >> 4) & 1) * 32 + (lane & 3) * 8 + (4 * hi + ((lane & 15) >> 2)) * 64;
    int slot = 0;
    for (int t = 0; t < NT; ++t) {
        if (t + 1 < NT) asm volatile("s_waitcnt vmcnt(3)" ::: "memory"); else asm volatile("s_waitcnt vmcnt(0)" ::: "memory");
        asm volatile("s_waitcnt lgkmcnt(0)\n\ts_barrier" ::: "memory");
        if (t + 2 < NT) { const int s2 = (slot == 0) ? 2 : slot - 1; AT_DMA(t + 2, s2); }
        if (t < myNT) {
            const LAS unsigned char* kp = kp0 + slot * KSLOT; const LAS unsigned char* vp = vp0 + slot * VSLOT;
            f32x16 p0, p1;
#pragma unroll
            for (int i = 0; i < 16; ++i) { p0[i] = -m_run; p1[i] = -m_run; }
#pragma unroll
            for (int ks = 0; ks < 6; ++ks) {
                const bf16x8 a0 = *(const LAS bf16x8*)(kp + ks * 2048), a1 = *(const LAS bf16x8*)(kp + ks * 2048 + 512);
                p0 = __builtin_amdgcn_mfma_f32_32x32x16_bf16(a0, qr[ks], p0, 0, 0, 0);
                p1 = __builtin_amdgcn_mfma_f32_32x32x16_bf16(a1, qr[ks], p1, 0, 0, 0);
            }
            float rm = fmaxf(p0[0], p1[0]);
#pragma unroll
            for (int i = 1; i < 16; ++i) rm = fmaxf(rm, fmaxf(p0[i], p1[i]));
            { auto rr = __builtin_amdgcn_permlane32_swap(__float_as_uint(rm), __float_as_uint(rm), false, false); rm = fmaxf(__uint_as_float(rr[0]), __uint_as_float(rr[1])); }
            if (__any(rm > 8.0f)) {
                const float dl = fmaxf(rm, 0.f);
                const float alpha = __builtin_amdgcn_exp2f(-dl);
                l_run *= alpha; m_run += dl;
#pragma unroll
                for (int i = 0; i < 16; ++i) { p0[i] -= dl; p1[i] -= dl; }
                if (hi == 0) wsf[r32] = alpha;
                asm volatile("s_waitcnt lgkmcnt(0)" ::: "memory");
#pragma unroll
                for (int i = 0; i < 16; ++i) { const float a = wsf[crow(i, hi)]; o0[i] *= a; o1[i] *= a; }
            }
            float ls = 0.f;
#pragma unroll
            for (int i = 0; i < 16; ++i) { p0[i] = __builtin_amdgcn_exp2f(p0[i]); p1[i] = __builtin_amdgcn_exp2f(p1[i]); ls += p0[i] + p1[i]; }
            l_run += ls;
            u32x4 w0, w1, w2, w3;
            w0 = (u32x4){cvtpk(p0[0], p0[1]), cvtpk(p0[2], p0[3]), cvtpk(p0[4], p0[5]), cvtpk(p0[6], p0[7])};
            w1 = (u32x4){cvtpk(p0[8], p0[9]), cvtpk(p0[10], p0[11]), cvtpk(p0[12], p0[13]), cvtpk(p0[14], p0[15])};
            w2 = (u32x4){cvtpk(p1[0], p1[1]), cvtpk(p1[2], p1[3]), cvtpk(p1[4], p1[5]), cvtpk(p1[6], p1[7])};
            w3 = (u32x4){cvtpk(p1[8], p1[9]), cvtpk(p1[10], p1[11]), cvtpk(p1[12], p1[13]), cvtpk(p1[14], p1[15])};
            const bf16x8 pa[4] = {__builtin_bit_cast(bf16x8, w0), __builtin_bit_cast(bf16x8, w1), __builtin_bit_cast(bf16x8, w2), __builtin_bit_cast(bf16x8, w3)};
#pragma unroll
            for (int k = 0; k < 4; ++k) {
                const s16x4 l0 = vtr(vp + k * 1024), h0 = vtr(vp + k * 1024 + 512), l1 = vtr(vp + 4096 + k * 1024), h1 = vtr(vp + 4096 + k * 1024 + 512);
                const bf16x8 v0 = (bf16x8){l0[0], l0[1], l0[2], l0[3], h0[0], h0[1], h0[2], h0[3]};
                const bf16x8 v1 = (bf16x8){l1[0], l1[1], l1[2], l1[3], h1[0], h1[1], h1[2], h1[3]};
                o0 = __builtin_amdgcn_mfma_f32_32x32x16_bf16(pa[k], v0, o0, 0, 0, 0);
                o1 = __builtin_amdgcn_mfma_f32_32x32x16_bf16(pa[k], v1, o1, 0, 0, 0);
            }
        }
        slot = (slot == 2) ? 0 : slot + 1;
    }
    { auto rr = __builtin_amdgcn_permlane32_swap(__float_as_uint(l_run), __float_as_uint(l_run), false, false); l_run = __uint_as_float(rr[0]) + __uint_as_float(rr[1]); }
    if (hi == 0) wsf[32 + r32] = l_run;
    asm volatile("s_waitcnt lgkmcnt(0)" ::: "memory");
    LAS bf16_t* stg = (LAS bf16_t*)(lds + L_OST) + wid * 2048;
#pragma unroll
    for (int i = 0; i < 16; ++i) { const int orow = crow(i, hi); const float rl = 1.0f / wsf[32 + orow];
        stg[orow * 64 + r32] = f2bf(o0[i] * rl); stg[orow * 64 + 32 + r32] = f2bf(o1[i] * rl); }
    asm volatile("s_waitcnt lgkmcnt(0)" ::: "memory");
    if (lane < 32) { float ssq = 0.f;
#pragma unroll
        for (int c = 0; c < 8; ++c) { const u32x4 v = *(const LAS u32x4*)(stg + lane * 64 + c * 8);
#pragma unroll
            for (int q = 0; q < 4; ++q) { const float lo = __uint_as_float(v[q] << 16), hi = __uint_as_float(v[q] & 0xffff0000u); ssq += lo * lo + hi * hi; } }
        ssa[((size_t)b * SEQ + q0 + lane) * 8 + h] = ssq; }
    bf16_t* Ow = AS + ((size_t)b * SEQ + q0) * 1024 + h * 64;
#pragma unroll
    for (int i = 0; i < 4; ++i) { const int row = i * 8 + (lane >> 3), ch = lane & 7; const u32x4 v = *(const LAS u32x4*)(stg + row * 64 + ch * 8); *(u32x4*)(Ow + (size_t)row * 1024 + ch * 8) = v; }
    asm volatile("s_waitcnt lgkmcnt(0)\n\ts_barrier" ::: "memory");
#undef AT_DMA
}
__device__ __forceinline__ void attn_phase(const Ptrs& P, LAS unsigned char* lds, int bid, int nb) {
    const bf16_t* Q = WSP(bf16_t, WS_Q); const bf16_t* Kc = WSP(bf16_t, WS_K); const bf16_t* V = WSP(bf16_t, WS_V); bf16_t* AS = WSP(bf16_t, WS_AS);
    const int vcu = ((nb & 7) == 0) ? (bid & 7) * (nb >> 3) + (bid >> 3) : bid;
    for (int p = vcu; p < 512; p += nb) {
        const int bh = p >> 2, s = p & 3;
        attn_unit(bh >> 3, bh & 7, 7 - s, Q, Kc, V, AS, WSP(float, WS_SSA), WSP(bf16_t, WS_KROPE), lds);
        attn_unit(bh >> 3, bh & 7, s, Q, Kc, V, AS, WSP(float, WS_SSA), WSP(bf16_t, WS_KROPE), lds);
    }
}
}
__global__ void __launch_bounds__(NTHR, 2) mega(Args a) {
    extern __shared__ __attribute__((aligned(16))) unsigned char lds_raw[];
    LAS unsigned char* lds = (LAS unsigned char*)lds_raw;
    Ptrs P;
    P.x = (const float*)a.in[0]; P.positions = (const int*)a.in[1]; P.ln_in_g = (const float*)a.in[2]; P.ln_in_b = (const float*)a.in[3];
    P.w_in = (const float*)a.in[4]; P.q_norm_g = (const float*)a.in[5]; P.kv_norm_g = (const float*)a.in[6]; P.w_uq = (const float*)a.in[7]; P.w_ukv = (const float*)a.in[8];
    P.lambda_re = (const float*)a.in[9]; P.lambda_im = (const float*)a.in[10]; P.log_step = (const float*)a.in[11]; P.b_re = (const float*)a.in[12]; P.b_im = (const float*)a.in[13];
    P.c_re = (const float*)a.in[14]; P.c_im = (const float*)a.in[15]; P.d_skip = (const float*)a.in[16]; P.w_glu = (const float*)a.in[17]; P.b_glu = (const float*)a.in[18];
    P.attn_out_g = (const float*)a.in[19]; P.ssm_out_g = (const float*)a.in[20]; P.w_o = (const float*)a.in[21]; P.ln1_g = (const float*)a.in[22]; P.ln1_b = (const float*)a.in[23];
    P.w_router = (const float*)a.in[24]; P.router_bias = (const float*)a.in[25]; P.w_gate = (const float*)a.in[26]; P.w_up = (const float*)a.in[27]; P.w_down = (const float*)a.in[28];
    P.ws_gate = (const float*)a.in[29]; P.ws_up = (const float*)a.in[30]; P.ws_down = (const float*)a.in[31]; P.ln2_g = (const float*)a.in[32]; P.ln2_b = (const float*)a.in[33];
    P.out = a.out; P.ws = a.ws;
    const int bid = blockIdx.x, nb = gridDim.x;
    volatile LAS unsigned* misc = (volatile LAS unsigned*)(lds + LDS_MISC);
    if (threadIdx.x < 64) misc[threadIdx.x] = 0u;
    __syncthreads();
    XcdBarrier bar = xcd_barrier_post((unsigned*)(P.ws + WS_CTL) + 4096, misc);
#define GRID_BAR() xcd_barrier(bar)

    ph_ln_in(P, bid, nb); ph_wprep(P, lds, bid, nb); ph_s5tab1(P, bid, nb); ph_ropetab(P, bid, nb);
    GRID_BAR();
    ph_s5tab2(P, lds, bid, nb);
#if FAST_WIN
    fp_gemm_win(P, lds);
    GRID_BAR();
#else
    ph_gemm_win(P, bid, nb);
    GRID_BAR();
    ph_rstat(P, bid, nb);
    GRID_BAR();
#endif
#if FAST_QKV
    fp_gemm_q(P, lds); fp_gemm_kv(P, lds);
#else
    ph_gemm_q(P, bid, nb); ph_gemm_kv(P, bid, nb);
#endif
#if FAST_S5
    fp_gemm_s5b(P, lds); fp_gemm_s5a(P, lds);
#else
    ph_gemm_s5b(P, bid, nb); ph_gemm_s5a(P, bid, nb);
#endif
    GRID_BAR();
#if !FAST_QKV || !FAST_WIN
    ph_rope_apply(P, bid, nb);
#endif
    ph_s5scan(P, bid, nb);
#if !FAST_QKV || !FAST_WIN
    GRID_BAR();
#endif
#if FAST_ATTN
    at8::attn_phase(P, lds, bid, nb);
#else
    ph_attn_simple(P, lds, bid, nb);
#endif
    GRID_BAR();
#if FAST_S5
    fp_gemm_s5d(P, lds);
#else
    ph_gemm_s5d(P, bid, nb);
#endif
    GRID_BAR();
#if FAST_GLU
    fp_gemm_glu(P, lds);
#else
    ph_gemm_glu(P, bid, nb);
#endif
    GRID_BAR();
    if (nb != 256) { ph_asnorm(P, bid, nb); GRID_BAR(); }
#if FAST_WO
    if (nb == 256) { fp_gemm_wo_ln(P, lds, bar, 0); fp_gemm_wo_ln(P, lds, bar, 1); }
    else {
    fp_gemm_wo(P, lds);
    GRID_BAR();
    ph_ln1(P, bid, nb);
    }
#else
    ph_gemm_wo(P, bid, nb);
    GRID_BAR();
    ph_ln1(P, bid, nb);
#endif
    GRID_BAR();
    fp_gemm_router(P, lds);
    GRID_BAR();
    ph_topk_cnt(P, lds, bid, nb);
    GRID_BAR();
    ph_lists2(P, lds, bid, nb);
    GRID_BAR();
#if FAST_MOE
    fp_gemm_gu(P, lds);
    GRID_BAR();
    fp_gemm_down(P, lds);
#else
    ph_gemm_gu(P, bid, nb);
    GRID_BAR();
    ph_gemm_down(P, bid, nb);
#endif
    GRID_BAR();
    ph_combine(P, bid, nb);
}

extern "C" void kernel_launch(void* const* d_in, const int* in_sizes, int n_in, void* d_out, int out_size, void* d_ws, size_t ws_size, hipStream_t stream) {
    (void)in_sizes; (void)out_size;
    if (ws_size < WS_NEED || n_in != 34) return;
    static int grid = 0;
    if (grid == 0) {
        int dev = 0, cus = 0;
        if (hipGetDevice(&dev) != hipSuccess || hipDeviceGetAttribute(&cus, hipDeviceAttributeMultiprocessorCount, dev) != hipSuccess) { grid = -1; return; }
        if (hipFuncSetAttribute((const void*)mega, hipFuncAttributeMaxDynamicSharedMemorySize, LDS_BYTES) != hipSuccess) { grid = -1; return; }
        int per_cu = 0;
        if (hipOccupancyMaxActiveBlocksPerMultiprocessor(&per_cu, (const void*)mega, NTHR, LDS_BYTES) != hipSuccess || per_cu < 1) { (void)hipGetLastError(); }
        grid = cus;
    }
    if (grid < 0) return;
    (void)hipMemsetAsync((char*)d_ws + WS_CTL, 0, 1 << 20, stream);
    Args a; memset(&a, 0, sizeof(a));
    for (int i = 0; i < 34; ++i) a.in[i] = d_in[i];
    a.out = (float*)d_out; a.ws = (unsigned char*)d_ws;
    hipLaunchKernelGGL(mega, dim3(grid), dim3(NTHR), LDS_BYTES, stream, a);
}
```

```cpp
#include <hip/hip_runtime.h>
#include <stdint.h>
#include <string.h>

typedef unsigned short bf16_t;
typedef short bf16x8 __attribute__((ext_vector_type(8)));
typedef float f32x16 __attribute__((ext_vector_type(16)));
typedef float f32x4 __attribute__((ext_vector_type(4)));
typedef unsigned u32x4 __attribute__((ext_vector_type(4)));
typedef unsigned u32x2 __attribute__((ext_vector_type(2)));
typedef float f32x2 __attribute__((ext_vector_type(2)));

#ifndef FAST_WIN
#define FAST_WIN 1
#endif
#ifndef FAST_QKV
#define FAST_QKV 1
#endif
#ifndef FAST_S5
#define FAST_S5 1
#endif
#ifndef FAST_GLU
#define FAST_GLU 1
#endif
#ifndef FAST_WO
#define FAST_WO 1
#endif
#ifndef FAST_ATTN
#define FAST_ATTN 1
#endif
#ifndef FAST_MOE
#define FAST_MOE 1
#endif
constexpr int T = 32768, D = 1024, SEQ = 2048, NB = 16;
constexpr int NH = 8, QKD = 96, VD = 64;
constexpr int QRANK = 256, KVRANK = 128, ROPE = 32;
constexpr int SSMW = 512, SG = 32, SC = 16, SP = 64, CH = 64, NCH = SEQ / CH;
constexpr int NE = 64, TOPK = 8, FF = 256;
constexpr float ALPHA = 1.189207115002721f;
constexpr float EPS = 1e-5f;
constexpr float QSCALE = 0.10206207261596577f * 1.4426950408889634f;
constexpr float SLOT_SCALE = 16.0f;
constexpr float XQ_SCALE = 16.0f, WQ_SCALE = 256.0f, HQ_SCALE = 8.0f;
constexpr int RROUT = 278528;
constexpr int SH_ROW0 = RROUT;
constexpr int RTOT = RROUT + T;

constexpr size_t MiB = 1ull << 20;
constexpr size_t WS_CTL = 0;
constexpr size_t WS_TOPI = 1 * MiB, WS_TOPW = 2 * MiB, WS_ROWTOK = 3 * MiB, WS_ROWW = 4 * MiB + MiB / 2;
constexpr size_t WS_CNT = 6 * MiB, WS_TOFF = 6 * MiB + 65536, WS_EOFF = 6 * MiB + 131072, WS_ECNT = 6 * MiB + 131072 + 1024;
constexpr size_t WS_TILEE = 6 * MiB + 262144;
constexpr size_t WS_WD = 7 * MiB;
constexpr size_t WS_X1 = 40 * MiB;
constexpr size_t WS_XN = WS_X1, WS_AS = 104 * MiB;
constexpr size_t WS_H = 104 * MiB;
constexpr size_t WS_CQ = 104 * MiB, WS_CKV = 120 * MiB, WS_U = 136 * MiB, WS_YINTRA = 168 * MiB, WS_Y = 200 * MiB;
constexpr size_t WS_QRRAW = 200 * MiB;
constexpr size_t WS_XLOC = 232 * MiB, WS_XPREV = 240 * MiB, WS_LOGITS = 248 * MiB, WS_KRRAW = 248 * MiB;
constexpr size_t WS_X1LO = 104 * MiB;
constexpr size_t WS_YSLOT = 180 * MiB;
constexpr size_t WS_INVROW = 4 * MiB + MiB / 2;
constexpr size_t WS_WGU = 256 * MiB;
constexpr size_t WS_WIN = 321 * MiB, WS_WO = 323 * MiB, WS_WUQ = 325 * MiB, WS_WUKV = 325 * MiB + MiB / 2, WS_WGLU = 326 * MiB;
constexpr size_t WS_WR = 326 * MiB + MiB / 2;
constexpr size_t WS_BLOC = 327 * MiB, WS_CLAM = 343 * MiB, WS_KTAB = 359 * MiB, WS_LAMPOW = 361 * MiB, WS_BBAR = 363 * MiB;
constexpr size_t WS_ROPE = 364 * MiB, WS_XSTAT = 368 * MiB, WS_RSQ = 368 * MiB + MiB / 2, WS_RSKV = 369 * MiB;
constexpr size_t WS_Q = 370 * MiB, WS_K = 418 * MiB, WS_V = 466 * MiB;
constexpr size_t WS_LAMPOWT = 498 * MiB;
constexpr size_t WS_X1Q = 370 * MiB;
constexpr size_t WS_SHSLOT = 452 * MiB;
constexpr size_t WS_SSA = 499 * MiB + MiB / 2, WS_SSS = 501 * MiB;
constexpr size_t WS_KROPE = 503 * MiB;
constexpr size_t WS_NEED = 512 * MiB;

typedef __bf16 bf16x2_hw __attribute__((ext_vector_type(2)));
__device__ __forceinline__ unsigned pk_bf16_hw(float lo, float hi) { const f32x2 v = {lo, hi}; const bf16x2_hw b = __builtin_convertvector(v, bf16x2_hw); return __builtin_bit_cast(unsigned, b); }
__device__ __forceinline__ bf16_t f2bf(float f) { return (bf16_t)(pk_bf16_hw(f, 0.f) & 0xffffu); }
__device__ __forceinline__ float bf2f(bf16_t b) { return __uint_as_float(((unsigned)b) << 16); }
__device__ __forceinline__ int crow(int i, int h) { return (i & 3) + 8 * (i >> 2) + 4 * h; }
__device__ __forceinline__ float wave_sum(float v) {
#pragma unroll
    for (int o = 32; o > 0; o >>= 1) v += __shfl_xor(v, o);
    return v;
}
__device__ __forceinline__ float wave_max(float v) {
#pragma unroll
    for (int o = 32; o > 0; o >>= 1) v = fmaxf(v, __shfl_xor(v, o));
    return v;
}
__device__ __forceinline__ float sigmoidf_(float z) { return 1.0f / (1.0f + __expf(-z)); }
__device__ __forceinline__ float gelu_tanh(float y) {
    const float z = 0.7978845608028654f * (y + 0.044715f * y * y * y);
    const float th = 1.0f - 2.0f / (1.0f + __expf(2.0f * z));
    return 0.5f * y * (1.0f + th);
}
__host__ __device__ __forceinline__ int ropeperm(int q) { return 16 * ((q >> 2) & 1) + 4 * (q >> 3) + (q & 3); }
__host__ __device__ __forceinline__ int ropepos(int j) { const int n = j >> 4, r = j & 15; return 8 * (r >> 2) + 4 * n + (r & 3); }

__device__ __forceinline__ void cexp_d(double re, double im, double& ore, double& oim) {
    const double s = 1.0 / 1048576.0;
    const double a = re * s, b = im * s;
    double tr = 1.0, ti = 0.0, sr = 1.0, si = 0.0;
#pragma unroll
    for (int n = 1; n <= 8; ++n) {
        const double nr = (tr * a - ti * b) / n, ni = (tr * b + ti * a) / n;
        tr = nr; ti = ni; sr += tr; si += ti;
    }
#pragma unroll
    for (int i = 0; i < 20; ++i) { const double nr = sr * sr - si * si, ni = 2.0 * sr * si; sr = nr; si = ni; }
    ore = sr; oim = si;
}

__device__ __forceinline__ int opaque_tid() { int t = threadIdx.x; asm volatile("" : "+v"(t)); return t; }
template <bool DUAL, class AF, class BF, class EPI>
__device__ __forceinline__ void sg_tile(int m0, int n0, int K, AF arow, BF bptr, EPI epi) {
    const int tidx = opaque_tid();
    const int lane = tidx & 63, r = lane & 31, h = lane >> 5;
    f32x16 acc, acc2;
#pragma unroll
    for (int i = 0; i < 16; ++i) { acc[i] = 0.f; acc2[i] = 0.f; }
    const bf16_t* ap = arow(m0 + r);
    for (int k0 = 0; k0 < K; k0 += 16) {
        const bf16x8 a = *(const bf16x8*)(ap + k0 + 8 * h);
        const bf16x8 b = *(const bf16x8*)(bptr(n0 + r, k0 + 8 * h, 0));
        acc = __builtin_amdgcn_mfma_f32_32x32x16_bf16(a, b, acc, 0, 0, 0);
        if (DUAL) {
            const bf16x8 b2 = *(const bf16x8*)(bptr(n0 + r, k0 + 8 * h, 1));
            acc2 = __builtin_amdgcn_mfma_f32_32x32x16_bf16(a, b2, acc2, 0, 0, 0);
        }
    }
#pragma unroll
    for (int i = 0; i < 16; ++i) epi(m0 + crow(i, h), n0 + r, acc[i], acc2[i]);
}

#define LAS __attribute__((address_space(3)))
#define XB_TMO      128
#define XB_XCNT(j)  (256  + 64 * (j))
#define XB_XSUB(j)  (1280 + 64 * (j))
#define XB_XGEN(j)  (2304 + 64 * (j))
#define XB_TOP      3328
#define XB_TOPGEN   3392
#define XCD_BAR_WORDS 3456
#define XB_SPIN_CAP (1u << 18)
__device__ __forceinline__ unsigned xb_ld(unsigned* p)              { return __hip_atomic_load(p, __ATOMIC_RELAXED, __HIP_MEMORY_SCOPE_AGENT); }
__device__ __forceinline__ unsigned xb_add(unsigned* p, unsigned v) { return __hip_atomic_fetch_add(p, v, __ATOMIC_RELAXED, __HIP_MEMORY_SCOPE_AGENT); }
__device__ __forceinline__ unsigned xb_xcc_id() { return (unsigned)__builtin_amdgcn_s_getreg((3 << 11) | 20) & 0xFu; }
#define XB_SPIN(cond, bar) do { unsigned _sp = 0; while (cond) { __builtin_amdgcn_s_sleep(1); \
    if ((++_sp & 255u) == 0u) { if (xb_ld(&(bar)[XB_TMO])) break; if (_sp > XB_SPIN_CAP) { atomicAdd(&(bar)[XB_TMO], 1u); break; } } } } while (0)
struct XcdBarrier { unsigned* bar; unsigned x; volatile LAS unsigned* st; };
__device__ __forceinline__ XcdBarrier xcd_barrier_post(unsigned* bar, volatile LAS unsigned* st) {
    XcdBarrier b; b.bar = bar; b.x = xb_xcc_id(); b.st = st;
    if (threadIdx.x == 0) (void)xb_add(&bar[XB_XCNT(b.x)], 1u);
    return b;
}
__device__ __forceinline__ void xcd_barrier_complete(unsigned* bar, unsigned x, unsigned& nloc, unsigned& nx) {
    const unsigned G = gridDim.x * gridDim.y * gridDim.z;
    unsigned sum, cnt, mine, sp = 0u;
    for (;;) {
        sum = 0u; cnt = 0u; mine = 0u;
#pragma unroll
        for (unsigned j = 0; j < 16; ++j) { const unsigned c = xb_ld(&bar[XB_XCNT(j)]); sum += c; cnt += (c > 0u) ? 1u : 0u; mine = (j == x) ? c : mine; }
        if (sum == G) break;
        __builtin_amdgcn_s_sleep(1);
        if ((++sp & 255u) == 0u) { if (xb_ld(&bar[XB_TMO])) break; if (sp > XB_SPIN_CAP) { atomicAdd(&bar[XB_TMO], 1u); break; } }
    }
    nloc = mine > 0u ? mine : 1u; nx = cnt > 0u ? cnt : 1u;
}
__device__ __forceinline__ void xcd_barrier(const XcdBarrier& b) {
    asm volatile("s_waitcnt vmcnt(0)" ::: "memory");
    __syncthreads();
    if (threadIdx.x == 0) {
        unsigned* bar = b.bar;
        __builtin_amdgcn_s_waitcnt(0);
        unsigned nloc = b.st[0], nx = b.st[1];
        if (nloc == 0u) { xcd_barrier_complete(bar, b.x, nloc, nx); b.st[0] = nloc; b.st[1] = nx; }
        const unsigned old = xb_add(&bar[XB_XSUB(b.x)], 1u);
        const unsigned gen = old / nloc;
        if (old + 1u == (gen + 1u) * nloc) {
            __builtin_amdgcn_fence(__ATOMIC_RELEASE, "agent");
            asm volatile("s_waitcnt vmcnt(0)" ::: "memory");
            const unsigned og = xb_add(&bar[XB_TOP], 1u);
            const unsigned tg = og / nx;
            if (og + 1u == (tg + 1u) * nx) xb_add(&bar[XB_TOPGEN], 1u);
            else XB_SPIN(xb_ld(&bar[XB_TOPGEN]) == tg, bar);
            __builtin_amdgcn_fence(__ATOMIC_ACQUIRE, "agent");
            xb_add(&bar[XB_XGEN(b.x)], 1u);
            asm volatile("s_waitcnt vmcnt(0)" ::: "memory");
        } else {
            XB_SPIN(xb_ld(&bar[XB_XGEN(b.x)]) == gen, bar);
            __builtin_amdgcn_fence(__ATOMIC_ACQUIRE, "agent");
            asm volatile("s_waitcnt vmcnt(0)" ::: "memory");
        }
    }
    __syncthreads();
}

constexpr int NTHR = 512, NWAVE = 8;
constexpr int LDS_BYTES = 163840;
constexpr int LDS_MISC = 163840 - 256;
constexpr int LDS_XTRA = 131072;
struct Args { const void* in[34]; float* out; unsigned char* ws; };
struct Ptrs {
    const float *x, *ln_in_g, *ln_in_b, *w_in, *q_norm_g, *kv_norm_g, *w_uq, *w_ukv, *lambda_re, *lambda_im, *log_step, *b_re, *b_im, *c_re, *c_im, *d_skip, *w_glu, *b_glu;
    const float *attn_out_g, *ssm_out_g, *w_o, *ln1_g, *ln1_b, *w_router, *router_bias, *w_gate, *w_up, *w_down, *ws_gate, *ws_up, *ws_down, *ln2_g, *ln2_b;
    const int* positions; float* out; unsigned char* ws;
};
#define WSP(T_, off) ((T_*)(P.ws + (off)))

__device__ __forceinline__ void ph_ln_in(const Ptrs& P, int bid, int nb) {
    const int tidx = opaque_tid();
    const int lane = tidx & 63, w = tidx >> 6;
    bf16_t* xn = WSP(bf16_t, WS_XN); float* xstat = WSP(float, WS_XSTAT);
    for (int t0 = (bid * NWAVE + w) * 2; t0 < T; t0 += nb * NWAVE * 2) {
        f32x4 q[2][4];
#pragma unroll
        for (int r = 0; r < 2; ++r)
#pragma unroll
            for (int i = 0; i < 4; ++i) q[r][i] = __builtin_nontemporal_load((const f32x4*)(P.x + (size_t)(t0 + r) * D + i * 256 + lane * 4));
#pragma unroll
        for (int r = 0; r < 2; ++r) {
            const int t = t0 + r;
            float s = 0.f;
#pragma unroll
            for (int i = 0; i < 4; ++i) s += q[r][i][0] + q[r][i][1] + q[r][i][2] + q[r][i][3];
            const float mu = wave_sum(s) * (1.0f / D);
            float ss = 0.f;
#pragma unroll
            for (int i = 0; i < 4; ++i)
#pragma unroll
                for (int e = 0; e < 4; ++e) { const float d = q[r][i][e] - mu; ss += d * d; }
            const float rstd = rsqrtf(wave_sum(ss) * (1.0f / D) + EPS);
            if (lane == 0) { xstat[2 * t] = mu; xstat[2 * t + 1] = rstd; }
#pragma unroll
            for (int i = 0; i < 4; ++i) {
                const int c = i * 256 + lane * 4;
                const f32x4 gg = *(const f32x4*)(P.ln_in_g + c), bb = *(const f32x4*)(P.ln_in_b + c);
                ushort4 o;
                o.x = f2bf((q[r][i][0] - mu) * rstd * gg[0] + bb[0]); o.y = f2bf((q[r][i][1] - mu) * rstd * gg[1] + bb[1]);
                o.z = f2bf((q[r][i][2] - mu) * rstd * gg[2] + bb[2]); o.w = f2bf((q[r][i][3] - mu) * rstd * gg[3] + bb[3]);
                *(ushort4*)(xn + (size_t)t * D + c) = o;
            }
        }
    }
}
__device__ __forceinline__ int wprep_srccol(int mode, int n, int& which) {
    which = 0;
    switch (mode) {
    case 0: if (n < 256) return n; if (n < 768) return 416 + (n - 256); if (n < 896) return 256 + (n - 768); if (n < 928) return 384 + ropeperm(n - 896); return -1;
    case 1: if (n < 512) return (n >> 6) * 96 + (n & 63); { const int m = n - 512; return (m >> 5) * 96 + 64 + ropeperm(m & 31); }
    case 2: if (n < 512) return (n >> 6) * 128 + (n & 63); { const int m = n - 512; return (m >> 6) * 128 + 64 + (m & 63); }
    case 5: { const int pn = n >> 8, w = n & 255; which = w >> 7; return pn * 128 + (w & 127); }
    case 7: return n < 64 ? n : -1;
    default: return n;
    }
}
__device__ __forceinline__ void wprep_tile(LAS float* tile  , const float* s1, const float* s2, const float* ks, const float* ks2, bf16_t* dst,
                                           int mode, int Kd, int ldsrc, int Ksrc, float kmul, int n0, int k0) {
    const int tidx = opaque_tid();
    const int nn = tidx & 63, w = tidx >> 6;
    {
        int which; const int sc = wprep_srccol(mode, n0 + nn, which);
        const float* s = which ? s2 : s1;
        float v[32];
#pragma unroll
        for (int i = 0; i < 32; ++i) { const int k = k0 + w + 8 * i; v[i] = (sc >= 0 && k < Ksrc) ? __builtin_nontemporal_load(s + (size_t)k * ldsrc + sc) : 0.f; }
#pragma unroll
        for (int i = 0; i < 32; ++i) { const int kk = w + 8 * i, k = k0 + kk; float x = v[i];
            if (ks && k < Ksrc) x *= (ks2 && k >= 512) ? ks2[k - 512] : ks[k];
            tile[kk * 65 + nn] = x * kmul; }
    }
    __syncthreads();
#pragma unroll
    for (int i = 0; i < 4; ++i) {
        const int kb = (i * 8 + w) * 8;
        u32x4 o;
#pragma unroll
        for (int j = 0; j < 4; ++j) o[j] = (unsigned)f2bf(tile[(kb + 2 * j) * 65 + nn]) | ((unsigned)f2bf(tile[(kb + 2 * j + 1) * 65 + nn]) << 16);
        *(u32x4*)(dst + (size_t)(n0 + nn) * Kd + k0 + kb) = o;
    }
    __syncthreads();
}
__device__ __forceinline__ void wprep_tile_fp8(const float* s1, const float* s2, unsigned char* dst, int mode, int Kd, int ldsrc, float kmul, int n0, int k0) {
    const int tidx = opaque_tid();
    const int nn = tidx & 63, w = tidx >> 6;
    int which; const int sc = wprep_srccol(mode, n0 + nn, which);
    const float* s = which ? s2 : s1;
    float v[2][16];
#pragma unroll
    for (int i = 0; i < 2; ++i)
#pragma unroll
        for (int j = 0; j < 16; ++j) { const int k = k0 + (i * 8 + w) * 16 + j; v[i][j] = __builtin_nontemporal_load(s + (size_t)k * ldsrc + sc) * kmul; }
#pragma unroll
    for (int i = 0; i < 2; ++i) {
        u32x4 o;
#pragma unroll
        for (int j = 0; j < 4; ++j) { int p = __builtin_amdgcn_cvt_pk_fp8_f32(v[i][4 * j], v[i][4 * j + 1], 0, false); p = __builtin_amdgcn_cvt_pk_fp8_f32(v[i][4 * j + 2], v[i][4 * j + 3], p, true); o[j] = (unsigned)p; }
        *(u32x4*)(dst + (size_t)(n0 + nn) * Kd + k0 + (i * 8 + w) * 16) = o;
    }
}
__device__ __forceinline__ void ph_wprep(const Ptrs& P, LAS unsigned char* lds, int bid, int nb) {
    LAS float* tile = (LAS float*)lds;
    constexpr int J0 = 64, J1 = J0 + 12, J2 = J1 + 16, J3 = J2 + 16, J4 = J3 + 64, J4b = J4 + 16, J5 = J4b + 65 * 32, J6 = J5 + 65 * 16;
    for (int j = bid; j < J6; j += nb) {
        if (j < J0)      { const int tl = j;      wprep_tile(tile, P.w_in, nullptr, nullptr, nullptr, WSP(bf16_t, WS_WIN), 0, 1024, 928, 1024, 1.0f, (tl / 4) * 64, (tl % 4) * 256); }
        else if (j < J1) { const int tl = j - J0; wprep_tile(tile, P.w_uq, nullptr, P.q_norm_g, nullptr, WSP(bf16_t, WS_WUQ), 1, 256, 768, 256, QSCALE, tl * 64, 0); }
        else if (j < J2) { const int tl = j - J1; wprep_tile(tile, P.w_ukv, nullptr, P.kv_norm_g, nullptr, WSP(bf16_t, WS_WUKV), 2, 256, 1024, 128, 1.0f, tl * 64, 0); }
        else if (j < J3) { const int tl = j - J2; wprep_tile(tile, P.w_glu, nullptr, nullptr, nullptr, WSP(bf16_t, WS_WGLU), 3, 512, 512, 512, 1.0f, (tl / 2) * 64, (tl % 2) * 256); }
        else if (j < J4) { const int tl = j - J3; wprep_tile(tile, P.w_o, nullptr, P.attn_out_g, P.ssm_out_g, WSP(bf16_t, WS_WO), 4, 1024, 1024, 1024, 1.0f, (tl / 4) * 64, (tl % 4) * 256); }
        else if (j < J4b) { const int tl = j - J4; wprep_tile(tile, P.w_router, nullptr, nullptr, nullptr, WSP(bf16_t, WS_WR), 7, 1024, 64, 1024, 1.0f, (tl / 4) * 64, (tl % 4) * 256); }
        else if (j < J5) { const int q = j - J4b, e = q / 32, tl = q % 32;
            const float* g = e < 64 ? P.w_gate + (size_t)e * 1024 * 256 : P.ws_gate; const float* u = e < 64 ? P.w_up + (size_t)e * 1024 * 256 : P.ws_up;
            wprep_tile_fp8(g, u, WSP(unsigned char, WS_WGU) + (size_t)e * 512 * 1024, 5, 1024, 256, WQ_SCALE, (tl / 4) * 64, (tl % 4) * 256); }
        else             { const int q = j - J5, e = q / 16, tl = q % 16;
            const float* d = e < 64 ? P.w_down + (size_t)e * 256 * 1024 : P.ws_down;
            wprep_tile_fp8(d, nullptr, WSP(unsigned char, WS_WD) + (size_t)e * 1024 * 256, 6, 256, 1024, WQ_SCALE, tl * 64, 0); }
    }
}
__device__ __forceinline__ void ph_s5tab1(const Ptrs& P, int bid, int nb) {
    const int tidx = opaque_tid();
    float2* lampow = WSP(float2, WS_LAMPOW); float2* lampow_t = WSP(float2, WS_LAMPOWT); float2* bbar = WSP(float2, WS_BBAR);
    for (int i = bid * NTHR + tidx; i < SG * SP * 65 + SG * SP * SC; i += nb * NTHR) {
        const bool isb = i >= SG * SP * 65;
        const int q = isb ? i - SG * SP * 65 : i;
        const int gp = isb ? q >> 4 : q / 65, tau = isb ? 1 : q % 65, g = gp >> 6, p = gp & 63;
        double lr = (double)P.lambda_re[gp]; if (lr > -1e-4) lr = -1e-4;
        const double li = (double)P.lambda_im[gp];
        double st, dummy; cexp_d((double)P.log_step[g], 0.0, st, dummy);
        double br, bi; cexp_d(lr * st * tau, li * st * tau, br, bi);
        if (!isb) {
            const float2 v = make_float2((float)br, (float)bi);
            lampow[gp * 65 + tau] = v; lampow_t[(g * 65 + tau) * 64 + p] = v;
        } else {
            const int c = q & 15;
            const double nr = br - 1.0, ni = bi, den = lr * lr + li * li;
            const double cr = (nr * lr + ni * li) / den, ci = (ni * lr - nr * li) / den;
            const double xr = (double)P.b_re[gp * SC + c], xi = (double)P.b_im[gp * SC + c];
            bbar[gp * SC + c] = make_float2((float)(cr * xr - ci * xi), (float)(cr * xi + ci * xr));
        }
    }
}
__device__ __forceinline__ void ph_s5tab2(const Ptrs& P, LAS unsigned char* lds, int bid, int nb) {
    const int tidx = opaque_tid();
    const float2* lampow = WSP(float2, WS_LAMPOW); const float2* lampow_t = WSP(float2, WS_LAMPOWT); const float2* bbar = WSP(float2, WS_BBAR);
    bf16_t* ktab = WSP(bf16_t, WS_KTAB); bf16_t* bloc = WSP(bf16_t, WS_BLOC); bf16_t* clam = WSP(bf16_t, WS_CLAM);
    const int lane = tidx & 63, w = tidx >> 6;
    LAS f32x2* Cs = (LAS f32x2*)lds;
    LAS f32x2* Bs = Cs + 1024;
    LAS f32x2* Ls = Bs + 1024;
    for (int un = bid; un < SG * 8; un += nb) {
        const int g = un >> 3, tb = (un & 7) * 8;
        __syncthreads();
        for (int i = tidx; i < 1024; i += NTHR) { const int c = i >> 6, p = i & 63; Cs[i] = (f32x2){P.c_re[(g * SC + c) * SP + p], P.c_im[(g * SC + c) * SP + p]}; { const float2 bq = bbar[g * 1024 + i]; Bs[i] = (f32x2){bq.x, bq.y}; } }
        { const int tl = tidx >> 6, p = tidx & 63; { const float2 lq = lampow_t[(g * 65 + tb + tl) * 64 + p]; Ls[tidx] = (f32x2){lq.x, lq.y}; } }
        __syncthreads();
        const int tl = tidx >> 6, c = (tidx >> 2) & 15, c0 = (tidx & 3) * 4;
        float a0 = 0.f, a1 = 0.f, a2 = 0.f, a3 = 0.f;
        for (int p = 0; p < SP; ++p) {
            const f32x2 l = Ls[tl * 64 + p], cc = Cs[c * 64 + p];
            const float kr = cc.x * l.x - cc.y * l.y, ki = cc.x * l.y + cc.y * l.x;
            const f32x2 b0 = Bs[p * 16 + c0], b1 = Bs[p * 16 + c0 + 1], b2 = Bs[p * 16 + c0 + 2], b3 = Bs[p * 16 + c0 + 3];
            a0 += kr * b0.x - ki * b0.y; a1 += kr * b1.x - ki * b1.y; a2 += kr * b2.x - ki * b2.y; a3 += kr * b3.x - ki * b3.y;
        }
        const int tau = tb + tl;
        if (tau == 0) { const float dsk = P.d_skip[g * SC + c]; if (c == c0) a0 += dsk; if (c == c0 + 1) a1 += dsk; if (c == c0 + 2) a2 += dsk; if (c == c0 + 3) a3 += dsk; }
        ushort4 o; o.x = f2bf(a0); o.y = f2bf(a1); o.z = f2bf(a2); o.w = f2bf(a3);
        *(ushort4*)(ktab + (((size_t)g * 127 + 63 + tau) * 16 + c) * 16 + c0) = o;
    }
    for (int i = bid * NTHR + tidx; i < SG * 63 * 32; i += nb * NTHR) { const int g = i / (63 * 32), r = i % (63 * 32); *(u32x4*)(ktab + (size_t)g * 127 * 256 + (size_t)r * 8) = (u32x4){0u, 0u, 0u, 0u}; }
    for (int row0 = bid * NWAVE + w; row0 < SG * 128; row0 += nb * NWAVE) {
        const int g = row0 >> 7, n = row0 & 127, row = g * 256 + n;
        u32x4 o0 = (u32x4){0u, 0u, 0u, 0u}, o1 = o0;
        if (n < 128) {
            const int p = n & 63;
            const float2 l = lampow[(g * SP + p) * 65 + (63 - lane)];
            float v[16];
#pragma unroll
            for (int c = 0; c < 16; ++c) { const float2 bb = bbar[(g * SP + p) * SC + c]; v[c] = (n < 64) ? (l.x * bb.x - l.y * bb.y) : (l.x * bb.y + l.y * bb.x); }
#pragma unroll
            for (int j = 0; j < 4; ++j) { o0[j] = (unsigned)f2bf(v[2 * j]) | ((unsigned)f2bf(v[2 * j + 1]) << 16); o1[j] = (unsigned)f2bf(v[8 + 2 * j]) | ((unsigned)f2bf(v[9 + 2 * j]) << 16); }
        }
        bf16_t* d = bloc + (size_t)row * 1024 + lane * 16;
        *(u32x4*)d = o0; *(u32x4*)(d + 8) = o1;
    }
    for (int row = bid * NWAVE + w; row < SG * 1024; row += nb * NWAVE) {
        const int g = row >> 10, n = row & 1023, t = n >> 4, c = n & 15;
        ushort4 o; o.x = 0; o.y = 0; o.z = 0; o.w = 0;
        if (lane < 32) {
            const int p0 = (lane & 15) * 4;
            const f32x4 cr = *(const f32x4*)(P.c_re + (g * SC + c) * SP + p0), ci = *(const f32x4*)(P.c_im + (g * SC + c) * SP + p0);
            const float2* lp = lampow_t + (g * 65 + t + 1) * 64 + p0;
            float v[4];
#pragma unroll
            for (int j = 0; j < 4; ++j) { const float2 l = lp[j]; v[j] = (lane < 16) ? (cr[j] * l.x - ci[j] * l.y) : -(cr[j] * l.y + ci[j] * l.x); }
            o.x = f2bf(v[0]); o.y = f2bf(v[1]); o.z = f2bf(v[2]); o.w = f2bf(v[3]);
        }
        if (lane < 32) *(ushort4*)(clam + (size_t)row * 256 + lane * 4) = o;
    }
}
__device__ __forceinline__ void ph_ropetab(const Ptrs& P, int bid, int nb) {
    const int tidx = opaque_tid();
    float2* rope = WSP(float2, WS_ROPE);
    const double invf[16] = {0.15915494309189535, 0.08949940160889101, 0.050329212104487035, 0.0283021958306234, 0.015915494309189534, 0.008949940160889102, 0.005032921210448704, 0.00283021958306234,
                             0.0015915494309189536, 0.0008949940160889102, 0.0005032921210448703, 0.00028302195830623395, 0.00015915494309189535, 8.949940160889102e-05, 5.0329212104487035e-05, 2.8302195830623396e-05};
    for (int t = bid * NTHR + tidx; t < T; t += nb * NTHR) {
        const double p = (double)P.positions[t];
#pragma unroll
        for (int j = 0; j < 16; ++j) {
            const double rev = p * invf[j];
            const float fr = (float)(rev - __builtin_rint(rev));
            rope[t * 16 + j] = make_float2(__builtin_amdgcn_cosf(fr), __builtin_amdgcn_sinf(fr));
        }
    }
}

#define GW_LOOP(ntiles) for (int tl = bid * NWAVE + (tidx >> 6); tl < (ntiles); tl += nb * NWAVE)
__device__ __forceinline__ void ph_gemm_win(const Ptrs& P, int bid, int nb) {
    const int tidx = opaque_tid();
    const bf16_t* xn = WSP(bf16_t, WS_XN); const bf16_t* wt = WSP(bf16_t, WS_WIN);
    bf16_t* cq = WSP(bf16_t, WS_CQ); bf16_t* ckv = WSP(bf16_t, WS_CKV); bf16_t* u = WSP(bf16_t, WS_U); float* krraw = WSP(float, WS_KRRAW);
    GW_LOOP((T / 32) * 32) {
        const int m0 = (tl >> 5) * 32, n0 = (tl & 31) * 32;
        sg_tile<false>(m0, n0, D,
            [&](int row) { return xn + (size_t)row * D; },
            [&](int n, int k, int) { return wt + (size_t)n * D + k; },
            [&](int t, int n, float v, float) {
                if (n < 256) cq[(size_t)t * 256 + n] = f2bf(v);
                else if (n < 768) {
                    const int ch = n - 256, g = ch >> 4, c = ch & 15, b = t >> 11, s = t & 2047, j = s >> 6, sl = s & 63;
                    u[((size_t)g * 512 + b * 32 + j) * 1024 + sl * 16 + c] = f2bf(v);
                } else if (n < 896) ckv[(size_t)t * 256 + (n - 768)] = f2bf(v);
                else {
                    ckv[(size_t)t * 256 + (n - 768)] = 0;
                    if (n < 928) krraw[(size_t)t * 32 + ropeperm(n - 896)] = v;
                }
            });
    }
}
__device__ __forceinline__ void ph_rstat(const Ptrs& P, int bid, int nb) {
    const int tidx = opaque_tid();
    const bf16_t* cq = WSP(bf16_t, WS_CQ); const bf16_t* ckv = WSP(bf16_t, WS_CKV); float* rsq = WSP(float, WS_RSQ); float* rskv = WSP(float, WS_RSKV);
    const int lane = tidx & 63, w = tidx >> 6;
    for (int t = bid * NWAVE + w; t < T; t += nb * NWAVE) {
        float s = 0.f, s2 = 0.f;
#pragma unroll
        for (int i = 0; i < 4; ++i) { const float v = bf2f(cq[(size_t)t * 256 + i * 64 + lane]); s += v * v; }
#pragma unroll
        for (int i = 0; i < 2; ++i) { const float v = bf2f(ckv[(size_t)t * 256 + i * 64 + lane]); s2 += v * v; }
        s = wave_sum(s); s2 = wave_sum(s2);
        if (lane == 0) { rsq[t] = rsqrtf(s * (1.0f / 256) + EPS); rskv[t] = rsqrtf(s2 * (1.0f / 128) + EPS); }
    }
}
__device__ __forceinline__ void ph_gemm_q(const Ptrs& P, int bid, int nb) {
    const int tidx = opaque_tid();
    const bf16_t* cq = WSP(bf16_t, WS_CQ); const bf16_t* wt = WSP(bf16_t, WS_WUQ); const float* rsq = WSP(float, WS_RSQ); bf16_t* Q = WSP(bf16_t, WS_Q); float* qrraw = WSP(float, WS_QRRAW);
    GW_LOOP((T / 32) * 24) {
        const int m0 = (tl / 24) * 32, n0 = (tl % 24) * 32;
        sg_tile<false>(m0, n0, 256,
            [&](int row) { return cq + (size_t)row * 256; },
            [&](int n, int k, int) { return wt + (size_t)n * 256 + k; },
            [&](int t, int n, float v, float) {
                v *= rsq[t];
                const int b = t >> 11, s = t & 2047;
                if (n < 512) Q[(((size_t)b * NH + (n >> 6)) * SEQ + s) * QKD + (n & 63)] = f2bf(v);
                else { const int m = n - 512; qrraw[(size_t)t * 256 + (m >> 5) * 32 + ropeperm(m & 31)] = v; }
            });
    }
}
__device__ __forceinline__ void ph_gemm_kv(const Ptrs& P, int bid, int nb) {
    const int tidx = opaque_tid();
    const bf16_t* ckv = WSP(bf16_t, WS_CKV); const bf16_t* wt = WSP(bf16_t, WS_WUKV); const float* rskv = WSP(float, WS_RSKV); bf16_t* Kc = WSP(bf16_t, WS_K); bf16_t* V = WSP(bf16_t, WS_V);
    GW_LOOP((T / 32) * 32) {
        const int m0 = (tl >> 5) * 32, n0 = (tl & 31) * 32;
        sg_tile<false>(m0, n0, 256,
            [&](int row) { return ckv + (size_t)row * 256; },
            [&](int n, int k, int) { return wt + (size_t)n * 256 + k; },
            [&](int t, int n, float v, float) {
                v *= rskv[t];
                const int b = t >> 11, s = t & 2047;
                if (n < 512) Kc[(((size_t)b * NH + (n >> 6)) * SEQ + s) * QKD + (n & 63)] = f2bf(v);
                else { const int m = n - 512; V[(((size_t)b * NH + (m >> 6)) * SEQ + s) * VD + (m & 63)] = f2bf(v); }
            });
    }
}
__device__ __forceinline__ void ph_rope_apply(const Ptrs& P, int bid, int nb) {
    const int tidx = opaque_tid();
    const float* qrraw = WSP(float, WS_QRRAW); const float* krraw = WSP(float, WS_KRRAW); const float2* rope = WSP(float2, WS_ROPE); bf16_t* Q = WSP(bf16_t, WS_Q); bf16_t* Kc = WSP(bf16_t, WS_K);
    for (int i = bid * NTHR + tidx; i < T * 9 * 16; i += nb * NTHR) {
        const int j = i & 15, hh = (i >> 4) % 9, t = (i >> 4) / 9;
        const float2 cs = rope[t * 16 + j];
        const int b = t >> 11, s = t & 2047;
        if (hh < 8) {
            const float x1 = qrraw[(size_t)t * 256 + hh * 32 + j], x2 = qrraw[(size_t)t * 256 + hh * 32 + 16 + j];
            bf16_t* q = Q + (((size_t)b * NH + hh) * SEQ + s) * QKD + 64;
            q[j] = f2bf(x1 * cs.x - x2 * cs.y); q[16 + j] = f2bf(x2 * cs.x + x1 * cs.y);
        } else {
            const float x1 = krraw[(size_t)t * 32 + j], x2 = krraw[(size_t)t * 32 + 16 + j];
            const bf16_t o1 = f2bf(x1 * cs.x - x2 * cs.y), o2 = f2bf(x2 * cs.x + x1 * cs.y);
            for (int h = 0; h < NH; ++h) { bf16_t* k = Kc + (((size_t)b * NH + h) * SEQ + s) * QKD + 64; k[j] = o1; k[16 + j] = o2; }
        }
    }
}
__device__ __forceinline__ void ph_gemm_s5b(const Ptrs& P, int bid, int nb) {
    const int tidx = opaque_tid();
    const bf16_t* u = WSP(bf16_t, WS_U); const bf16_t* bloc = WSP(bf16_t, WS_BLOC); float* xloc = WSP(float, WS_XLOC);
    GW_LOOP(SG * 16 * 4) {
        const int g = tl >> 6, m0 = ((tl >> 2) & 15) * 32, n0 = (tl & 3) * 32;
        sg_tile<false>(m0, n0, 1024,
            [&](int row) { return u + ((size_t)g * 512 + row) * 1024; },
            [&](int n, int k, int) { return bloc + ((size_t)g * 256 + n) * 1024 + k; },
            [&](int row, int n, float v, float) { xloc[((size_t)g * 512 + row) * 128 + n] = v; });
    }
}
__device__ __forceinline__ void ph_gemm_s5a(const Ptrs& P, int bid, int nb) {
    const int tidx = opaque_tid();
    const bf16_t* u = WSP(bf16_t, WS_U); const bf16_t* ktab = WSP(bf16_t, WS_KTAB); bf16_t* yintra = WSP(bf16_t, WS_YINTRA);
    GW_LOOP(SG * 16 * 32) {
        const int g = tl >> 9, m0 = ((tl >> 5) & 15) * 32, n0 = (tl & 31) * 32;
        sg_tile<false>(m0, n0, 1024,
            [&](int row) { return u + ((size_t)g * 512 + row) * 1024; },
            [&](int n, int k, int) { const int t = n >> 4, c = n & 15, s = k >> 4, c0 = k & 15; return ktab + (((size_t)g * 127 + (t - s + 63)) * 16 + c) * 16 + c0; },
            [&](int row, int n, float v, float) {
                const int b = row >> 5, j = row & 31, t = n >> 4, c = n & 15;
                yintra[((size_t)b * SEQ + j * CH + t) * SSMW + g * SC + c] = f2bf(v);
            });
    }
}
__device__ __forceinline__ void ph_attn_simple(const Ptrs& P, LAS unsigned char* lds, int bid, int nb) {
    const int tidx = opaque_tid();
    const bf16_t* Q = WSP(bf16_t, WS_Q); const bf16_t* Kc = WSP(bf16_t, WS_K); const bf16_t* V = WSP(bf16_t, WS_V); bf16_t* AS = WSP(bf16_t, WS_AS);
    const int lane = tidx & 63, w = tidx >> 6;
    LAS float* qs = (LAS float*)lds + w * (QKD + SEQ);
    LAS float* ps = qs + QKD;
    for (int row = bid * NWAVE + w; row < T * NH; row += nb * NWAVE) {
        const int bh = row >> 11, q = row & 2047, b = bh >> 3, h = bh & 7;
        asm volatile("s_waitcnt lgkmcnt(0)" ::: "memory");
        qs[lane] = bf2f(Q[(size_t)row * QKD + lane]);
        if (lane < 32) qs[64 + lane] = bf2f(Q[(size_t)row * QKD + 64 + lane]);
        asm volatile("s_waitcnt lgkmcnt(0)" ::: "memory");
        const int nk = ((q >> 6) + 1) * 64;
        float m = -INFINITY;
        for (int kb = 0; kb < nk; kb += 64) {
            const bf16_t* kp = Kc + ((size_t)bh * SEQ + kb + lane) * QKD;
            float s = 0.f;
#pragma unroll
            for (int c = 0; c < 12; ++c) {
                const bf16x8 kv = *(const bf16x8*)(kp + c * 8);
#pragma unroll
                for (int e = 0; e < 8; ++e) s += qs[c * 8 + e] * bf2f((bf16_t)kv[e]);
            }
            ps[kb + lane] = s; m = fmaxf(m, s);
        }
        m = wave_max(m);
        float l = 0.f;
        for (int kb = 0; kb < nk; kb += 64) { const float p = exp2f(ps[kb + lane] - m); ps[kb + lane] = p; l += p; }
        l = wave_sum(l);
        asm volatile("s_waitcnt lgkmcnt(0)" ::: "memory");
        float o = 0.f;
        const bf16_t* vp = V + (size_t)bh * SEQ * VD + lane;
        for (int k = 0; k < nk; ++k) o += ps[k] * bf2f(vp[(size_t)k * VD]);
        AS[((size_t)b * SEQ + q) * 1024 + h * 64 + lane] = f2bf(o / l);
    }
}
__device__ __forceinline__ void ph_s5scan(const Ptrs& P, int bid, int nb) {
    const int tidx = opaque_tid();
    const float* xloc = WSP(float, WS_XLOC); const float2* lampow = WSP(float2, WS_LAMPOW); bf16_t* xprev = WSP(bf16_t, WS_XPREV);
    for (int i = bid * NTHR + tidx; i < SG * NB * SP; i += nb * NTHR) {
        const int p = i & 63, b = (i >> 6) & 15, g = i >> 10;
        const float2 l64 = lampow[(g * SP + p) * 65 + 64];
        float xr = 0.f, xi = 0.f;
#pragma unroll
        for (int j = 0; j < NCH; ++j) {
            const size_t row = (size_t)g * 512 + b * 32 + j;
            bf16_t* xp = xprev + row * 256;
            xp[p] = f2bf(xr); xp[64 + p] = f2bf(xi);
            const float lr = xloc[row * 128 + p], li = xloc[row * 128 + 64 + p];
            const float nr = l64.x * xr - l64.y * xi + lr, ni = l64.x * xi + l64.y * xr + li;
            xr = nr; xi = ni;
        }
    }
}
__device__ __forceinline__ void ph_gemm_s5d(const Ptrs& P, int bid, int nb) {
    const int tidx = opaque_tid();
    const bf16_t* xprev = WSP(bf16_t, WS_XPREV); const bf16_t* clam = WSP(bf16_t, WS_CLAM); const bf16_t* yintra = WSP(bf16_t, WS_YINTRA); bf16_t* Y = WSP(bf16_t, WS_Y);
    GW_LOOP(SG * 16 * 32) {
        const int g = tl >> 9, m0 = ((tl >> 5) & 15) * 32, n0 = (tl & 31) * 32;
        sg_tile<false>(m0, n0, 256,
            [&](int row) { return xprev + ((size_t)g * 512 + row) * 256; },
            [&](int n, int k, int) { return clam + ((size_t)g * 1024 + n) * 256 + k; },
            [&](int row, int n, float v, float) {
                const int b = row >> 5, j = row & 31, t = n >> 4, c = n & 15;
                const size_t o = ((size_t)b * SEQ + j * CH + t) * SSMW + g * SC + c;
                Y[o] = f2bf(gelu_tanh(v + bf2f(yintra[o])));
            });
    }
}
__device__ __forceinline__ void ph_gemm_glu(const Ptrs& P, int bid, int nb) {
    const int tidx = opaque_tid();
    const bf16_t* Y = WSP(bf16_t, WS_Y); const bf16_t* wt = WSP(bf16_t, WS_WGLU); bf16_t* AS = WSP(bf16_t, WS_AS);
    GW_LOOP((T / 32) * 16) {
        const int m0 = (tl >> 4) * 32, n0 = (tl & 15) * 32;
        sg_tile<false>(m0, n0, 512,
            [&](int row) { return Y + (size_t)row * 512; },
            [&](int n, int k, int) { return wt + (size_t)n * 512 + k; },
            [&](int t, int n, float v, float) {
                const float yv = bf2f(Y[(size_t)t * 512 + n]);
                AS[(size_t)t * 1024 + 512 + n] = f2bf(yv * sigmoidf_(v + P.b_glu[n]));
            });
    }
}
__device__ __forceinline__ void ph_asnorm(const Ptrs& P, int bid, int nb) {
    const int tidx = opaque_tid();
    bf16_t* AS = WSP(bf16_t, WS_AS);
    const int lane = tidx & 63, w = tidx >> 6;
    for (int t = bid * NWAVE + w; t < T; t += nb * NWAVE) {
        bf16_t* r = AS + (size_t)t * 1024;
        float va[8], vs[8]; float sa = 0.f, ss = 0.f;
        const bf16x8 a = *(const bf16x8*)(r + lane * 8), s = *(const bf16x8*)(r + 512 + lane * 8);
#pragma unroll
        for (int i = 0; i < 8; ++i) { va[i] = bf2f((bf16_t)a[i]); vs[i] = bf2f((bf16_t)s[i]); sa += va[i] * va[i]; ss += vs[i] * vs[i]; }
        const float ra = rsqrtf(wave_sum(sa) * (1.0f / 512) + EPS), rs = rsqrtf(wave_sum(ss) * (1.0f / 512) + EPS);
        bf16x8 oa, os;
#pragma unroll
        for (int i = 0; i < 8; ++i) { oa[i] = (short)f2bf(va[i] * ra); os[i] = (short)f2bf(vs[i] * rs); }
        *(bf16x8*)(r + lane * 8) = oa; *(bf16x8*)(r + 512 + lane * 8) = os;
    }
}
__device__ __forceinline__ void ph_gemm_wo(const Ptrs& P, int bid, int nb) {
    const int tidx = opaque_tid();
    const bf16_t* AS = WSP(bf16_t, WS_AS); const bf16_t* wt = WSP(bf16_t, WS_WO); const float* xstat = WSP(float, WS_XSTAT); float* pre1 = P.out;
    GW_LOOP((T / 32) * 32) {
        const int m0 = (tl >> 5) * 32, n0 = (tl & 31) * 32;
        sg_tile<false>(m0, n0, 1024,
            [&](int row) { return AS + (size_t)row * 1024; },
            [&](int n, int k, int) { return wt + (size_t)n * 1024 + k; },
            [&](int t, int n, float v, float) {
                const float xn = (P.x[(size_t)t * D + n] - xstat[2 * t]) * xstat[2 * t + 1] * P.ln_in_g[n] + P.ln_in_b[n];
                pre1[(size_t)t * D + n] = v + ALPHA * xn;
            });
    }
}
__device__ __forceinline__ void ph_ln1(const Ptrs& P, int bid, int nb) {
    const int tidx = opaque_tid();
    const float* pre1 = P.out; bf16_t* x1 = WSP(bf16_t, WS_X1); bf16_t* x1lo = WSP(bf16_t, WS_X1LO);
    const int lane = tidx & 63, w = tidx >> 6;
    for (int t = bid * NWAVE + w; t < T; t += nb * NWAVE) {
        const float* xr = pre1 + (size_t)t * D;
        float v[16]; float s = 0.f;
#pragma unroll
        for (int i = 0; i < 4; ++i) { const f32x4 q = *(const f32x4*)(xr + i * 256 + lane * 4); v[4 * i] = q[0]; v[4 * i + 1] = q[1]; v[4 * i + 2] = q[2]; v[4 * i + 3] = q[3]; s += q[0] + q[1] + q[2] + q[3]; }
        const float mu = wave_sum(s) * (1.0f / D);
        float ss = 0.f;
#pragma unroll
        for (int i = 0; i < 16; ++i) { const float d = v[i] - mu; ss += d * d; }
        const float rstd = rsqrtf(wave_sum(ss) * (1.0f / D) + EPS);
#pragma unroll
        for (int i = 0; i < 4; ++i) {
            const int c = i * 256 + lane * 4;
            const f32x4 gg = *(const f32x4*)(P.ln1_g + c), bb = *(const f32x4*)(P.ln1_b + c);
            ushort4 o, ol;
            float y;
            y = (v[4 * i] - mu) * rstd * gg[0] + bb[0];     o.x = f2bf(y); ol.x = f2bf(y - bf2f(o.x));
            y = (v[4 * i + 1] - mu) * rstd * gg[1] + bb[1]; o.y = f2bf(y); ol.y = f2bf(y - bf2f(o.y));
            y = (v[4 * i + 2] - mu) * rstd * gg[2] + bb[2]; o.z = f2bf(y); ol.z = f2bf(y - bf2f(o.z));
            y = (v[4 * i + 3] - mu) * rstd * gg[3] + bb[3]; o.w = f2bf(y); ol.w = f2bf(y - bf2f(o.w));
            *(ushort4*)(x1 + (size_t)t * D + c) = o; (void)ol; (void)x1lo;
            { int p = __builtin_amdgcn_cvt_pk_fp8_f32(bf2f(o.x) * XQ_SCALE, bf2f(o.y) * XQ_SCALE, 0, false); p = __builtin_amdgcn_cvt_pk_fp8_f32(bf2f(o.z) * XQ_SCALE, bf2f(o.w) * XQ_SCALE, p, true);
              *(int*)(WSP(unsigned char, WS_X1Q) + (size_t)t * D + c) = p; }
        }
    }
}
__device__ __forceinline__ void ph_router(const Ptrs& P, int bid, int nb) {
    const int tidx = opaque_tid();
    const bf16_t* x1 = WSP(bf16_t, WS_X1); const bf16_t* x1lo = WSP(bf16_t, WS_X1LO); float* logits = WSP(float, WS_LOGITS);
    const int e = tidx & 63, w = tidx >> 6;
    for (int t = bid * NWAVE + w; t < T; t += nb * NWAVE) {
        const bf16_t* a = x1 + (size_t)t * D; const bf16_t* al = x1lo + (size_t)t * D;
        float s = 0.f;
        for (int k = 0; k < D; k += 8) {
            const bf16x8 hi = *(const bf16x8*)(a + k), lo = *(const bf16x8*)(al + k);
#pragma unroll
            for (int i = 0; i < 8; ++i) s += (bf2f((bf16_t)hi[i]) + bf2f((bf16_t)lo[i])) * P.w_router[(size_t)(k + i) * NE + e];
        }
        logits[(size_t)t * NE + e] = s;
    }
}
__device__ __forceinline__ void ph_topk(const Ptrs& P, int bid, int nb) {
    const int tidx = opaque_tid();
    const float* logits = WSP(float, WS_LOGITS); int* topi = WSP(int, WS_TOPI); float* topw = WSP(float, WS_TOPW);
    const int lane = tidx & 63, w = tidx >> 6;
    for (int t = bid * NWAVE + w; t < T; t += nb * NWAVE) {
        const float sc = sigmoidf_(logits[(size_t)t * NE + lane]);
        const float sel = sc + P.router_bias[lane];
        const int grp = lane >> 3;
        float m1 = sel;
        m1 = fmaxf(m1, __shfl_xor(m1, 1)); m1 = fmaxf(m1, __shfl_xor(m1, 2)); m1 = fmaxf(m1, __shfl_xor(m1, 4));
        const unsigned long long bal = __ballot(sel == m1) & (0xFFull << (8 * grp));
        const int first = __ffsll((long long)bal) - 1;
        float m2 = (lane == first) ? -INFINITY : sel;
        m2 = fmaxf(m2, __shfl_xor(m2, 1)); m2 = fmaxf(m2, __shfl_xor(m2, 2)); m2 = fmaxf(m2, __shfl_xor(m2, 4));
        const float gs = m1 + m2;
        int cg = 0;
#pragma unroll
        for (int gj = 0; gj < 8; ++gj) { const float sj = __shfl(gs, gj * 8); cg += (sj > gs || (sj == gs && gj < grp)) ? 1 : 0; }
        const bool gsel = cg < 4;
        const float v = gsel ? sel : -INFINITY;
        int rank = 0;
        for (int e2 = 0; e2 < 64; ++e2) { const float ve = __shfl(v, e2); rank += (ve > v || (ve == v && e2 < lane)) ? 1 : 0; }
        const bool chosen = gsel && rank < TOPK;
        const float wsum = wave_sum(chosen ? sc : 0.f);
        if (chosen) { topi[(size_t)t * TOPK + rank] = lane; topw[(size_t)t * TOPK + rank] = sc / wsum * 2.5f; }
    }
}
__device__ __forceinline__ void ph_cnt(const Ptrs& P, int bid, int nb) {
    const int tidx = opaque_tid();
    const int* topi = WSP(int, WS_TOPI); int* cnt = WSP(int, WS_CNT);
    for (int i = bid * NTHR + tidx; i < 256 * 64; i += nb * NTHR) {
        const int tile = i >> 6, e = i & 63;
        int c = 0;
        for (int k = 0; k < 1024; ++k) c += (topi[tile * 1024 + k] == e) ? 1 : 0;
        cnt[i] = c;
    }
}
__device__ __forceinline__ void ph_off(const Ptrs& P, LAS unsigned char* lds, int bid) {
    const int tidx = opaque_tid();
    if (bid != 0) return;
    const int* cnt = WSP(int, WS_CNT); int* toff = WSP(int, WS_TOFF); int* eoff = WSP(int, WS_EOFF); int* ecnt = WSP(int, WS_ECNT);
    LAS int* tot = (LAS int*)lds; LAS int* off = tot + 64;
    const int e = tidx;
    if (e < 64) { int s = 0; for (int tile = 0; tile < 256; ++tile) s += cnt[tile * 64 + e]; tot[e] = s; ecnt[e] = s; }
    __syncthreads();
    if (e == 0) { int o = 0; for (int i = 0; i < 64; ++i) { off[i] = o; o += (tot[i] + 255) & ~255; } off[64] = o; }
    __syncthreads();
    if (e < 64) {
        eoff[e] = off[e]; if (e == 0) eoff[64] = off[64];
        int run = off[e];
        for (int tile = 0; tile < 256; ++tile) { toff[tile * 64 + e] = run; run += cnt[tile * 64 + e]; }
    }
}
__device__ __forceinline__ void ph_lists(const Ptrs& P, int bid, int nb) {
    const int tidx = opaque_tid();
    const int* topi = WSP(int, WS_TOPI); const float* topw = WSP(float, WS_TOPW); const int* toff = WSP(int, WS_TOFF); const int* eoff = WSP(int, WS_EOFF);
    int* rowtok = WSP(int, WS_ROWTOK); float* roww = WSP(float, WS_ROWW);
    for (int i = bid * NTHR + tidx; i < 256 * 64; i += nb * NTHR) {
        const int tile = i >> 6, e = i & 63;
        int pos = toff[tile * 64 + e];
        for (int k = 0; k < 1024; ++k) {
            if (topi[tile * 1024 + k] == e) { rowtok[pos] = tile * 1024 + k; roww[pos] = topw[tile * 1024 + k]; ++pos; }
        }
        if (tile == 255) { const int end = eoff[e + 1]; for (; pos < end; ++pos) { rowtok[pos] = -1; roww[pos] = 0.f; } }
    }
    for (int i = bid * NTHR + tidx; i < T; i += nb * NTHR) rowtok[SH_ROW0 + i] = i * 8;
}
__device__ __forceinline__ void ph_gemm_gu(const Ptrs& P, int bid, int nb) {
    const int tidx = opaque_tid();
    const bf16_t* x1 = WSP(bf16_t, WS_X1); const bf16_t* wgu = WSP(bf16_t, WS_WGU); const int* rowtok = WSP(int, WS_ROWTOK); const float* roww = WSP(float, WS_ROWW);
    const int* eoff = WSP(int, WS_EOFF); bf16_t* H = WSP(bf16_t, WS_H);
    const int nrt = eoff[64] / 32;
    const int ntl = (nrt + T / 32) * 8;
    GW_LOOP(ntl) {
        const int rt = tl >> 3, n0 = (tl & 7) * 32;
        if (rt < nrt) {
            const int m0 = rt * 32;
            int e = 0; while (e < 63 && eoff[e + 1] <= m0) ++e;
            const bf16_t* w = wgu + (size_t)e * 512 * 1024;
            sg_tile<true>(m0, n0, 1024,
                [&](int row) { const int s = rowtok[row]; return x1 + (size_t)(s >= 0 ? (s >> 3) : 0) * D; },
                [&](int f, int k, int which) { return w + (size_t)((f >> 7) * 256 + (f & 127) + which * 128) * 1024 + k; },
                [&](int row, int f, float gv, float uv) { H[(size_t)row * FF + f] = f2bf(gv * sigmoidf_(gv) * uv * roww[row]); });
        } else {
            const int m0 = (rt - nrt) * 32;
            const bf16_t* w = wgu + (size_t)64 * 512 * 1024;
            sg_tile<true>(m0, n0, 1024,
                [&](int row) { return x1 + (size_t)row * D; },
                [&](int f, int k, int which) { return w + (size_t)((f >> 7) * 256 + (f & 127) + which * 128) * 1024 + k; },
                [&](int row, int f, float gv, float uv) { H[(size_t)(SH_ROW0 + row) * FF + f] = f2bf(gv * sigmoidf_(gv) * uv); });
        }
    }
}
__device__ __forceinline__ unsigned char f2fp8(float v) { const int p = __builtin_amdgcn_cvt_pk_fp8_f32(v, v, 0, false); return (unsigned char)(p & 0xff); }
__device__ __forceinline__ void ph_gemm_down(const Ptrs& P, int bid, int nb) {
    const int tidx = opaque_tid();
    const bf16_t* H = WSP(bf16_t, WS_H); const bf16_t* wd = WSP(bf16_t, WS_WD); const int* rowtok = WSP(int, WS_ROWTOK); const int* eoff = WSP(int, WS_EOFF);
    const bf16_t* x1 = WSP(bf16_t, WS_X1); unsigned char* yslot = WSP(unsigned char, WS_YSLOT); float* out = P.out;
    const int nrt = eoff[64] / 32;
    const int ntl = (nrt + T / 32) * 32;
    GW_LOOP(ntl) {
        const int rt = tl >> 5, n0 = (tl & 31) * 32;
        if (rt < nrt) {
            const int m0 = rt * 32;
            int e = 0; while (e < 63 && eoff[e + 1] <= m0) ++e;
            const bf16_t* w = wd + (size_t)e * 1024 * 256;
            sg_tile<false>(m0, n0, 256,
                [&](int row) { return H + (size_t)row * FF; },
                [&](int n, int k, int) { return w + (size_t)n * 256 + k; },
                [&](int row, int n, float v, float) { const int s = rowtok[row]; if (s >= 0) yslot[(size_t)s * D + n] = f2fp8(v * SLOT_SCALE); });
        } else {
            const int m0 = (rt - nrt) * 32;
            const bf16_t* w = wd + (size_t)64 * 1024 * 256;
            sg_tile<false>(m0, n0, 256,
                [&](int row) { return H + (size_t)(SH_ROW0 + row) * FF; },
                [&](int n, int k, int) { return w + (size_t)n * 256 + k; },
                [&](int t, int n, float v, float) { out[(size_t)t * D + n] = v + ALPHA * bf2f(x1[(size_t)t * D + n]); });
        }
    }
}
__device__ __forceinline__ void ph_combine(const Ptrs& P, int bid, int nb) {
    const int tidx = opaque_tid();
    const unsigned char* yslot = WSP(unsigned char, WS_YSLOT); const unsigned char* shslot = WSP(unsigned char, WS_SHSLOT); float* out = P.out;
    const int* invrow = WSP(int, WS_INVROW); const float* topw = WSP(float, WS_TOPW); const bf16_t* x1 = WSP(bf16_t, WS_X1);
    const int lane = tidx & 63, w = tidx >> 6;
    const int stride = nb * NWAVE * 2;
    int t0 = (bid * NWAVE + w) * 2;
    int4 ia[2], ib[2];
    if (t0 < T) {
#pragma unroll
        for (int r = 0; r < 2; ++r) { ia[r] = *(const int4*)(invrow + (size_t)(t0 + r) * TOPK); ib[r] = *(const int4*)(invrow + (size_t)(t0 + r) * TOPK + 4); }
    }
    for (; t0 < T; t0 += stride) {
        u32x4 q[2][9]; bf16x8 xa[2], xb[2]; f32x4 wa[2], wb[2];
#pragma unroll
        for (int r = 0; r < 2; ++r) {
            const int t = t0 + r;
            const int rows[8] = {ia[r].x, ia[r].y, ia[r].z, ia[r].w, ib[r].x, ib[r].y, ib[r].z, ib[r].w};
#pragma unroll
            for (int k = 0; k < 8; ++k) q[r][k] = __builtin_nontemporal_load((const u32x4*)(yslot + (size_t)rows[k] * D + lane * 16));
            q[r][8] = __builtin_nontemporal_load((const u32x4*)(shslot + (size_t)t * D + lane * 16));
            xa[r] = __builtin_nontemporal_load((const bf16x8*)(x1 + (size_t)t * D + lane * 16)); xb[r] = __builtin_nontemporal_load((const bf16x8*)(x1 + (size_t)t * D + lane * 16 + 8));
            wa[r] = *(const f32x4*)(topw + (size_t)t * TOPK); wb[r] = *(const f32x4*)(topw + (size_t)t * TOPK + 4);
        }
        const int tn = t0 + stride;
        if (tn < T) {
#pragma unroll
            for (int r = 0; r < 2; ++r) { ia[r] = *(const int4*)(invrow + (size_t)(tn + r) * TOPK); ib[r] = *(const int4*)(invrow + (size_t)(tn + r) * TOPK + 4); }
        }
#pragma unroll
        for (int r = 0; r < 2; ++r) {
            const int t = t0 + r;
            float v[16];
#pragma unroll
            for (int i = 0; i < 8; ++i) { v[i] = ALPHA * bf2f((bf16_t)xa[r][i]); v[8 + i] = ALPHA * bf2f((bf16_t)xb[r][i]); }
#pragma unroll
            for (int k = 0; k <= TOPK; ++k) {
                const float wk = ((k < 4) ? wa[r][k & 3] : (k < 8) ? wb[r][k & 3] : 1.0f) * (1.0f / SLOT_SCALE);
#pragma unroll
                for (int i = 0; i < 4; ++i) {
                    v[4 * i]     += __builtin_amdgcn_cvt_f32_fp8((int)q[r][k][i], 0) * wk;
                    v[4 * i + 1] += __builtin_amdgcn_cvt_f32_fp8((int)q[r][k][i], 1) * wk;
                    v[4 * i + 2] += __builtin_amdgcn_cvt_f32_fp8((int)q[r][k][i], 2) * wk;
                    v[4 * i + 3] += __builtin_amdgcn_cvt_f32_fp8((int)q[r][k][i], 3) * wk;
                }
            }
            float s = 0.f;
#pragma unroll
            for (int i = 0; i < 16; ++i) s += v[i];
            const float mu = wave_sum(s) * (1.0f / D);
            float ss = 0.f;
#pragma unroll
            for (int i = 0; i < 16; ++i) { const float d = v[i] - mu; ss += d * d; }
            const float rstd = rsqrtf(wave_sum(ss) * (1.0f / D) + EPS);
            float* orow = out + (size_t)t * D + lane * 16;
#pragma unroll
            for (int i = 0; i < 4; ++i) {
                const int c = lane * 16 + 4 * i;
                const f32x4 gg = *(const f32x4*)(P.ln2_g + c), bb = *(const f32x4*)(P.ln2_b + c);
                f32x4 o;
                o[0] = (v[4 * i] - mu) * rstd * gg[0] + bb[0]; o[1] = (v[4 * i + 1] - mu) * rstd * gg[1] + bb[1];
                o[2] = (v[4 * i + 2] - mu) * rstd * gg[2] + bb[2]; o[3] = (v[4 * i + 3] - mu) * rstd * gg[3] + bb[3];
                *(f32x4*)(orow + 4 * i) = o;
            }
        }
    }
}

namespace g8 {
constexpr int BM = 256, BK = 64, HALF = 128, HTB = HALF * BK * 2, STAGE_BYTES = 8 * HTB;
__device__ __forceinline__ int lds_byte(int r, int c) { const int st = (r >> 4) * 2 + (c >> 5), rr = r & 15, cc = c & 31, ob = rr * 64 + cc * 2; return st * 1024 + (ob ^ (((ob >> 9) & 1) << 5)); }
__device__ __forceinline__ void stage_rc(int b, int& R, int& C) { const int st = b / 1024, sb = b % 1024, swz = sb ^ (((sb >> 9) & 1) << 5); R = (st >> 1) * 16 + swz / 64; C = (st & 1) * 32 + (swz % 64) / 2; }
__device__ __forceinline__ int perm32(int rho) { const int n = rho >> 4, i = rho & 15; return 8 * (i >> 2) + 4 * n + (i & 3); }

struct Unit { const char* A; const char* B; const int* rows; int pm, pn, e, nt; };
struct Geo { int lda_b, ldb_b; long kstepA, kstepB; int toep; };

typedef float f32x4 __attribute__((ext_vector_type(4)));
typedef f32x4 Acc[2][2][4][2];
typedef int v8i_t __attribute__((ext_vector_type(8)));
typedef int v4i_t __attribute__((ext_vector_type(4)));

__device__ __forceinline__ unsigned g8_rowoff(const int* rows, int h, int i, int tid, int lda_b) {
    int t2 = tid; asm volatile("" : "+v"(t2));
    int R, C; stage_rc(t2 * 16 + i * 8192, R, C);
    const int sl = rows[h * HALF + R];
    return (unsigned)((sl < 0 ? 0 : sl >> 3) * lda_b + C * 2);
}
template <class Epi, class Sched, bool GATHER, int DT = 0>
__device__ __forceinline__ void gemm_body(LAS unsigned char* lds, const Geo g, const Sched& S, const Epi& E) {
    const int tid = opaque_tid(), wid = __builtin_amdgcn_readfirstlane(tid >> 6), lane = tid & 63, wr = wid >> 2, wc = wid & 3, fr = lane & 15, fq = lane >> 4;
    unsigned voffB[2], vA[2][2];
#pragma unroll
    for (int i = 0; i < 2; ++i) { int R, C; stage_rc(tid * 16 + i * 8192, R, C); const int Rb = (R & ~31) + perm32(R & 31);
        voffB[i] = g.toep ? (unsigned)(Rb * 32 + 1536 - (C >> 4) * 512 + (C & 15) * 2) : (unsigned)(Rb * g.ldb_b + C * 2);
#pragma unroll
        for (int h = 0; h < 2; ++h) vA[h][i] = (unsigned)((h * HALF + R) * g.lda_b + C * 2); }
    const long kA = g.kstepA, kB = g.kstepB;
    const long hB = (long)HALF * g.ldb_b;
    const unsigned ldsw = (unsigned)wid * 1024u;
    const int aoff = lds_byte(wr * 64 + fr, fq * 8), boff = lds_byte(wc * 32 + fr, fq * 8);
#define G8_SA(b, h) (((b) * 2 + (h)) * HTB)
#define G8_SB(b, h) ((4 + (b) * 2 + (h)) * HTB)
#define G8_STAGE(bufoff, gbase, v0, v1) do { \
        unsigned v0_ = (v0), v1_ = (v1); if (GATHER) asm volatile("" : "+v"(v0_), "+v"(v1_)); \
        __builtin_amdgcn_global_load_lds((const unsigned*)((const char*)(gbase) + v0_), (LAS unsigned*)(lds + (bufoff) + ldsw), 16, 0, 0); \
        __builtin_amdgcn_global_load_lds((const unsigned*)((const char*)(gbase) + v1_), (LAS unsigned*)(lds + (bufoff) + ldsw + 8192), 16, 0, 0); } while (0)
#define G8_STB(bufoff, gbase) G8_STAGE(bufoff, gbase, voffB[0], voffB[1])
#define G8_LDA(dst, b, h) do { if (DT == 0) { _Pragma("unroll") for (int m = 0; m < 4; ++m) _Pragma("unroll") for (int k = 0; k < 2; ++k) dst[m][k] = *(const LAS bf16x8*)(lds + G8_SA(b, h) + aoff + m * 2048 + k * 1024); } \
        else { _Pragma("unroll") for (int m = 0; m < 4; ++m) dst##8[m] = __builtin_shufflevector(*(const LAS v4i_t*)(aBase + G8_SA(b, h) + m * 2048), *(const LAS v4i_t*)(aBase + G8_SA(b, h) + m * 2048 + 1024), 0, 1, 2, 3, 4, 5, 6, 7); } } while (0)
#define G8_LDB(dst, b, h) do { if (DT == 0) { _Pragma("unroll") for (int n = 0; n < 2; ++n) _Pragma("unroll") for (int k = 0; k < 2; ++k) dst[n][k] = *(const LAS bf16x8*)(lds + G8_SB(b, h) + boff + n * 2048 + k * 1024); } \
        else { _Pragma("unroll") for (int n = 0; n < 2; ++n) dst##8[n] = __builtin_shufflevector(*(const LAS v4i_t*)(bBase + (G8_SB(b, h) - 65536) + n * 2048), *(const LAS v4i_t*)(bBase + (G8_SB(b, h) - 65536) + n * 2048 + 1024), 0, 1, 2, 3, 4, 5, 6, 7); } } while (0)
#define G8_MMA(ai, bj, At, Bt) do { __builtin_amdgcn_s_setprio(1); \
        if (DT == 0) { _Pragma("unroll") for (int m = 0; m < 4; ++m) _Pragma("unroll") for (int n = 0; n < 2; ++n) _Pragma("unroll") for (int k = 0; k < 2; ++k) \
            acc[ai][bj][m][n] = __builtin_amdgcn_mfma_f32_16x16x32_bf16(Bt[n][k], At[m][k], acc[ai][bj][m][n], 0, 0, 0); } \
        else { _Pragma("unroll") for (int m = 0; m < 4; ++m) _Pragma("unroll") for (int n = 0; n < 2; ++n) \
            acc[ai][bj][m][n] = __builtin_amdgcn_mfma_scale_f32_16x16x128_f8f6f4(Bt##8[n], At##8[m], acc[ai][bj][m][n], 0, 0, 0, 127, 0, 127); } \
        __builtin_amdgcn_s_setprio(0); } while (0)
#define G8_WAIT_V(n) asm volatile("s_waitcnt vmcnt(" #n ")" ::: "memory")
#define G8_WAIT_L(n) asm volatile("s_waitcnt lgkmcnt(" #n ")" ::: "memory")
#define G8_BAR __builtin_amdgcn_s_barrier()
#define G8_SCHED __builtin_amdgcn_sched_barrier(0)
#define G8_ROWOFF(u_, h_, i_) g8_rowoff((u_).rows, (h_), (i_), tid, g.lda_b)
    Unit cur, nxt; int ui = 0;
    if (!S.next(0, cur)) return;
    Acc acc;
#pragma unroll
    for (int a = 0; a < 2; ++a)
#pragma unroll
        for (int b = 0; b < 2; ++b)
#pragma unroll
            for (int m = 0; m < 4; ++m)
#pragma unroll
                for (int n = 0; n < 2; ++n) acc[a][b][m][n] = (f32x4){0.f, 0.f, 0.f, 0.f};
    bf16x8 At[4][2], B0[2][2], B1[2][2];
    v8i_t At8[4], B08[2], B18[2];
    LAS unsigned char* aBase = lds + aoff; LAS unsigned char* bBase = lds + 65536 + boff;
    asm volatile("" : "+v"(aBase), "+v"(bBase));
    const char* cA = cur.A; const char* cB = cur.B;
    if (GATHER) {
#pragma unroll
        for (int h = 0; h < 2; ++h)
#pragma unroll
            for (int i = 0; i < 2; ++i) vA[h][i] = G8_ROWOFF(cur, h, i);
        asm volatile("" : "+v"(vA[0][0]), "+v"(vA[0][1]), "+v"(vA[1][0]), "+v"(vA[1][1]));
    }
    const long hA = GATHER ? 0 : 0;
    (void)hA;
    G8_STB(G8_SB(0, 0), cB); G8_STB(G8_SB(0, 1), cB + hB); G8_STAGE(G8_SA(0, 0), cA, vA[0][0], vA[0][1]); G8_STAGE(G8_SA(0, 1), cA, vA[1][0], vA[1][1]);
    if (wr == 1) G8_BAR;
    G8_WAIT_V(2); G8_BAR;
    G8_STB(G8_SB(1, 0), cB + kB); G8_STAGE(G8_SA(1, 0), cA + kA, vA[0][0], vA[0][1]); G8_STB(G8_SB(1, 1), cB + hB + kB);
    G8_WAIT_V(6); G8_BAR;
    for (;;) {
        const bool has_next = S.next(ui + 1, nxt);
        const char* nA = has_next ? nxt.A : cA; const char* nB = has_next ? nxt.B : cB;
        const int nt = cur.nt;
        for (int t = 0; t < nt; t += 2) {
            const bool last = (t == nt - 2);
            const char* a1 = cA + (long)(t + 1) * kA;
            const char* a2 = last ? nA : cA + (long)(t + 2) * kA; const char* b2 = last ? nB : cB + (long)(t + 2) * kB;
            const char* a3 = a2 + kA; const char* b3 = b2 + kB;
            G8_LDB(B0, 0, 0); G8_LDB(B1, 0, 1); G8_SCHED; G8_LDA(At, 0, 0); G8_STAGE(G8_SA(1, 1), a1, vA[1][0], vA[1][1]);
            if (GATHER && last && has_next) {
                vA[0][0] = G8_ROWOFF(nxt, 0, 0); vA[0][1] = G8_ROWOFF(nxt, 0, 1); vA[1][0] = G8_ROWOFF(nxt, 1, 0); vA[1][1] = G8_ROWOFF(nxt, 1, 1);
                asm volatile("" : "+v"(vA[0][0]), "+v"(vA[0][1]), "+v"(vA[1][0]), "+v"(vA[1][1]));
            }
            const unsigned w00 = vA[0][0], w01 = vA[0][1], w10 = vA[1][0], w11 = vA[1][1];
            G8_WAIT_V(8); G8_WAIT_L(0); G8_BAR; G8_MMA(0, 0, At, B0); G8_MMA(0, 1, At, B1); G8_BAR; G8_SCHED;
            G8_LDA(At, 0, 1); G8_STB(G8_SB(0, 0), b2); G8_STB(G8_SB(0, 1), b2 + hB); G8_STAGE(G8_SA(0, 0), a2, w00, w01);
            G8_WAIT_V(8); G8_WAIT_L(0); G8_BAR; G8_MMA(1, 0, At, B0); G8_MMA(1, 1, At, B1); G8_BAR; G8_SCHED;
            G8_LDB(B0, 1, 0); G8_LDB(B1, 1, 1); G8_SCHED; G8_LDA(At, 1, 0); G8_STAGE(G8_SA(0, 1), a2, w10, w11);
            G8_WAIT_V(8); G8_WAIT_L(0); G8_BAR; G8_MMA(0, 0, At, B0); G8_MMA(0, 1, At, B1); G8_BAR; G8_SCHED;
            G8_LDA(At, 1, 1); G8_STB(G8_SB(1, 0), b3); G8_STB(G8_SB(1, 1), b3 + hB); G8_STAGE(G8_SA(1, 0), a3, w00, w01);
            G8_WAIT_V(8); G8_WAIT_L(0); G8_BAR; G8_MMA(1, 0, At, B0); G8_MMA(1, 1, At, B1); G8_BAR; G8_SCHED;
        }
        if (wr == 0) G8_BAR;
        { int t3_ = threadIdx.x; asm volatile("" : "+v"(t3_)); E(acc, cur, wr, wc, t3_ & 15, (t3_ >> 4) & 3); }
        if (!has_next) break;
        if (!Epi::KEEP || cur.e != 0) {
#pragma unroll
        for (int a = 0; a < 2; ++a)
#pragma unroll
            for (int b = 0; b < 2; ++b)
#pragma unroll
                for (int m = 0; m < 4; ++m)
#pragma unroll
                    for (int n = 0; n < 2; ++n) acc[a][b][m][n] = (f32x4){0.f, 0.f, 0.f, 0.f};
        }
        cur = nxt; cA = nA; cB = nB; ++ui;
        if (wr == 1) G8_BAR;
    }
    G8_WAIT_V(0);
    G8_BAR;
#undef G8_SA
#undef G8_SB
#undef G8_STAGE
#undef G8_STB
#undef G8_LDA
#undef G8_LDB
#undef G8_MMA
#undef G8_WAIT_V
#undef G8_WAIT_L
#undef G8_BAR
#undef G8_SCHED
#undef G8_ROWOFF
}
}
namespace g8 {
__device__ __forceinline__ unsigned pk_bf16(float lo, float hi) { return pk_bf16_hw(lo, hi); }
__device__ __forceinline__ u32x4 pack8(const f32x4 a, const f32x4 b) { u32x4 w; w[0] = pk_bf16(a[0], a[1]); w[1] = pk_bf16(a[2], a[3]); w[2] = pk_bf16(b[0], b[1]); w[3] = pk_bf16(b[2], b[3]); return w; }
__device__ __forceinline__ int unit_index(int i, int nunits) {
    const int G = gridDim.x, c = blockIdx.x;
    if ((G & 7) != 0) { const long L = (long)i * G + c; return L < nunits ? (int)L : -1; }
    const int x = c & 7, r = c >> 3, GX = G >> 3;
    const int lo = (int)(((long)nunits * x) >> 3), hi = (int)(((long)nunits * (x + 1)) >> 3);
    const int L = lo + i * GX + r;
    return L < hi ? L : -1;
}
struct SchedReg {
    const char* A; const char* B; int lda_b, ldb_b, nM, nN, nt; int pm0 = 0;
    __device__ __forceinline__ bool next(int i, Unit& u) const {
        const int L = unit_index(i, nM * nN); if (L < 0) return false;
        u.pm = pm0 + L / nN; u.pn = L % nN; u.e = 0; u.nt = nt; u.rows = nullptr;
        u.A = A + (size_t)u.pm * 256 * lda_b; u.B = B + (size_t)u.pn * 256 * ldb_b; return true;
    }
};
struct SchedS5 {
    const char* A; const char* B; int lda_b, ldb_b, nN, nt; size_t a_gstride, b_gstride; int toep; int pair_light = 0;
    __device__ __forceinline__ bool next(int i, Unit& u) const {
        int L;
        if (pair_light && gridDim.x == 256) {
            if (i > 0) return false;
            const int La = unit_index(0, 256); if ((La & 3) != 0) return false;
            L = La >> 2;
        } else { L = unit_index(i, SG * 2 * nN); if (L < 0) return false; }
        const int g = L / (2 * nN), r = L % (2 * nN);
        u.pm = r / nN; u.pn = r % nN; u.e = g; u.rows = nullptr;
        u.A = A + (size_t)g * a_gstride + (size_t)u.pm * 256 * lda_b;
        if (toep) { u.B = B + (size_t)g * 127 * 512 + 63 * 512 + (size_t)u.pn * 256 * 32 - 1536; u.nt = 4 * (u.pn + 1); }
        else { u.B = B + (size_t)g * b_gstride + (size_t)u.pn * 256 * ldb_b; u.nt = nt; }
        return true;
    }
};
struct SchedMoe {
    const char* A; const char* B; const int* eoff; const int* rowtok; int lda_b, npn, nt; size_t b_estride; int ldb_b; int gather; const int* tile_e;
    __device__ __forceinline__ bool next(int i, Unit& u) const {
        const int nrt = eoff[64] >> 8;
        const int G = gridDim.x, c = blockIdx.x;
        int rt;
        if ((G & 7) == 0) {
            const int x = c & 7, r = c >> 3, GX = G >> 3;
            const int r0 = (nrt * x) >> 3, r1 = (nrt * (x + 1)) >> 3, nr = r1 - r0;
            const int j = i * GX + r;
            if (j >= (nr + 16) * npn) return false;
            const int tl = j / npn; u.pn = j % npn;
            rt = (tl < nr) ? r0 + tl : nrt + 16 * x + (tl - nr);
        } else {
            const long L = (long)i * G + c; if (L >= (long)(nrt + T / 256) * npn) return false;
            rt = (int)(L / npn); u.pn = (int)(L % npn);
        }
        u.nt = nt;
        int e = 64;
        if (rt < nrt) e = tile_e[rt];
        u.e = e; u.pm = rt;
        u.B = B + (size_t)e * b_estride + (size_t)u.pn * 256 * ldb_b;
        if (gather) {
            u.A = A; u.rows = rowtok + ((e < 64) ? rt * 256 : SH_ROW0 + (rt - nrt) * 256);
        } else {
            const int row0 = (e < 64) ? rt * 256 : SH_ROW0 + (rt - nrt) * 256;
            u.A = A + (size_t)row0 * lda_b; u.rows = nullptr;
        }
        return true;
    }
};

#define EPI_ROWS_BEGIN _Pragma("unroll") for (int ai = 0; ai < 2; ++ai) _Pragma("unroll") for (int m = 0; m < 4; ++m) { const int rloc = ai * 128 + wr * 64 + m * 16 + fr;
#define EPI_ROWS_END }

struct EpiWin {
    static constexpr bool KEEP = false;
    bf16_t* cq; bf16_t* ckv; bf16_t* u; bf16_t* Kc; const float2* rope; float* rsqp; float* rskvp;
    __device__ __forceinline__ void operator()(const Acc& acc, const Unit& un, int wr, int wc, int fr, int fq) const {
        const int pn = un.pn;
        if (pn == 0) {
            EPI_ROWS_BEGIN
                const int t = un.pm * 256 + rloc;
                float ss = 0.f;
#pragma unroll
                for (int bj = 0; bj < 2; ++bj) { const f32x4 v0 = acc[ai][bj][m][0], v1 = acc[ai][bj][m][1];
                    *(u32x4*)(cq + (size_t)t * 256 + bj * 128 + wc * 32 + fq * 8) = pack8(v0, v1);
                    ss += v0[0] * v0[0] + v0[1] * v0[1] + v0[2] * v0[2] + v0[3] * v0[3] + v1[0] * v1[0] + v1[1] * v1[1] + v1[2] * v1[2] + v1[3] * v1[3]; }
                ss += __shfl_xor(ss, 16); ss += __shfl_xor(ss, 32);
                if (fq == 0) rsqp[(size_t)t * 4 + wc] = ss;
            EPI_ROWS_END
        } else if (pn <= 2) {
            EPI_ROWS_BEGIN
                const int t = un.pm * 256 + rloc;
                const int b = t >> 11, s = t & 2047, j = s >> 6, sl = s & 63;
#pragma unroll
                for (int bj = 0; bj < 2; ++bj) { const int ch0 = (pn - 1) * 256 + bj * 128 + wc * 32 + fq * 8, gi = ch0 >> 4, c0 = ch0 & 15;
                    *(u32x4*)(u + ((size_t)gi * 512 + b * 32 + j) * 1024 + sl * 16 + c0) = pack8(acc[ai][bj][m][0], acc[ai][bj][m][1]); }
            EPI_ROWS_END
        } else {
            EPI_ROWS_BEGIN
                const int t = un.pm * 256 + rloc;
                const f32x4 v0 = acc[ai][0][m][0], v1 = acc[ai][0][m][1];
                *(u32x4*)(ckv + (size_t)t * 256 + wc * 32 + fq * 8) = pack8(v0, v1);
                float ss = v0[0] * v0[0] + v0[1] * v0[1] + v0[2] * v0[2] + v0[3] * v0[3] + v1[0] * v1[0] + v1[1] * v1[1] + v1[2] * v1[2] + v1[3] * v1[3];
                ss += __shfl_xor(ss, 16); ss += __shfl_xor(ss, 32);
                if (fq == 0) rskvp[(size_t)t * 4 + wc] = ss;
            EPI_ROWS_END
            if (wc == 0) {
                EPI_ROWS_BEGIN
                    const int t = un.pm * 256 + rloc;
                    const f32x4 x1 = acc[ai][1][m][0], x2 = acc[ai][1][m][1];
                    const f32x4 ca = *(const f32x4*)(rope + (size_t)t * 16 + fq * 4), cb = *(const f32x4*)(rope + (size_t)t * 16 + fq * 4 + 2);
                    const float o10 = x1[0] * ca[0] - x2[0] * ca[1], o11 = x1[1] * ca[2] - x2[1] * ca[3], o12 = x1[2] * cb[0] - x2[2] * cb[1], o13 = x1[3] * cb[2] - x2[3] * cb[3];
                    const float o20 = x2[0] * ca[0] + x1[0] * ca[1], o21 = x2[1] * ca[2] + x1[1] * ca[3], o22 = x2[2] * cb[0] + x1[2] * cb[1], o23 = x2[3] * cb[2] + x1[3] * cb[3];
                    uint2 w1, w2; w1.x = pk_bf16(o10, o11); w1.y = pk_bf16(o12, o13); w2.x = pk_bf16(o20, o21); w2.y = pk_bf16(o22, o23);
                    const int b = t >> 11, s = t & 2047;
                    bf16_t* kp = Kc + (size_t)t * 32 + fq * 4;
                    *(uint2*)kp = w1; *(uint2*)(kp + 16) = w2; (void)b; (void)s;
                EPI_ROWS_END
            }
        }
    }
};
struct EpiQ {
    static constexpr bool KEEP = false;
    bf16_t* Q; const float* rsqp; const float2* rope;
    __device__ __forceinline__ void operator()(const Acc& acc, const Unit& un, int wr, int wc, int fr, int fq) const {
        EPI_ROWS_BEGIN
            const int t = un.pm * 256 + rloc, b = t >> 11, s = t & 2047;
            const f32x4 pp = *(const f32x4*)(rsqp + (size_t)t * 4);
            const float rs = rsqrtf((pp[0] + pp[1] + pp[2] + pp[3]) * (1.0f / 256) + EPS);
            if (un.pn < 2) {
#pragma unroll
                for (int bj = 0; bj < 2; ++bj) { const int col = un.pn * 256 + bj * 128 + wc * 32 + fq * 8;
                    *(u32x4*)(Q + (((size_t)b * NH + (col >> 6)) * SEQ + s) * QKD + (col & 63)) = pack8(acc[ai][bj][m][0] * rs, acc[ai][bj][m][1] * rs); }
            } else {
                const f32x4 ca = *(const f32x4*)(rope + (size_t)t * 16 + fq * 4), cb = *(const f32x4*)(rope + (size_t)t * 16 + fq * 4 + 2);
#pragma unroll
                for (int bj = 0; bj < 2; ++bj) { const f32x4 x1 = acc[ai][bj][m][0] * rs, x2 = acc[ai][bj][m][1] * rs;
                    const float o10 = x1[0] * ca[0] - x2[0] * ca[1], o11 = x1[1] * ca[2] - x2[1] * ca[3], o12 = x1[2] * cb[0] - x2[2] * cb[1], o13 = x1[3] * cb[2] - x2[3] * cb[3];
                    const float o20 = x2[0] * ca[0] + x1[0] * ca[1], o21 = x2[1] * ca[2] + x1[1] * ca[3], o22 = x2[2] * cb[0] + x1[2] * cb[1], o23 = x2[3] * cb[2] + x1[3] * cb[3];
                    uint2 w1, w2; w1.x = pk_bf16(o10, o11); w1.y = pk_bf16(o12, o13); w2.x = pk_bf16(o20, o21); w2.y = pk_bf16(o22, o23);
                    bf16_t* qp = Q + (((size_t)b * NH + (bj * 4 + wc)) * SEQ + s) * QKD + 64 + fq * 4; *(uint2*)qp = w1; *(uint2*)(qp + 16) = w2; }
            }
        EPI_ROWS_END
    }
};
struct EpiKV {
    static constexpr bool KEEP = false;
    bf16_t* Kc; bf16_t* V; const float* rskvp;
    __device__ __forceinline__ void operator()(const Acc& acc, const Unit& un, int wr, int wc, int fr, int fq) const {
        EPI_ROWS_BEGIN
            const int t = un.pm * 256 + rloc, b = t >> 11, s = t & 2047;
            const f32x4 pp = *(const f32x4*)(rskvp + (size_t)t * 4);
            const float rs = rsqrtf((pp[0] + pp[1] + pp[2] + pp[3]) * (1.0f / 128) + EPS);
#pragma unroll
            for (int bj = 0; bj < 2; ++bj) { const int col = (un.pn & 1) * 256 + bj * 128 + wc * 32 + fq * 8;
                const u32x4 w = pack8(acc[ai][bj][m][0] * rs, acc[ai][bj][m][1] * rs);
                if (un.pn < 2) *(u32x4*)(Kc + (((size_t)b * NH + (col >> 6)) * SEQ + s) * QKD + (col & 63)) = w;
                else *(u32x4*)(V + (((size_t)b * NH + (col >> 6)) * SEQ + s) * VD + (col & 63)) = w; }
        EPI_ROWS_END
    }
};
struct EpiS5b {
    static constexpr bool KEEP = false;
    float* xloc;
    __device__ __forceinline__ void operator()(const Acc& acc, const Unit& un, int wr, int wc, int fr, int fq) const {
        EPI_ROWS_BEGIN
            float* o = xloc + ((size_t)un.e * 512 + un.pm * 256 + rloc) * 128 + wc * 32 + fq * 8;
            *(f32x4*)o = acc[ai][0][m][0]; *(f32x4*)(o + 4) = acc[ai][0][m][1];
        EPI_ROWS_END
    }
};
template <int MODE> struct EpiS5y {
    static constexpr bool KEEP = false;
    bf16_t* dst; const bf16_t* yintra;
    __device__ __forceinline__ void operator()(const Acc& acc, const Unit& un, int wr, int wc, int fr, int fq) const {
        EPI_ROWS_BEGIN
            const int row = un.pm * 256 + rloc, b = row >> 5, j = row & 31;
#pragma unroll
            for (int bj = 0; bj < 2; ++bj) { const int n = un.pn * 256 + bj * 128 + wc * 32 + fq * 8, tt = n >> 4, c0 = n & 15;
                const size_t o = ((size_t)b * SEQ + j * CH + tt) * SSMW + un.e * SC + c0;
                f32x4 v0 = acc[ai][bj][m][0], v1 = acc[ai][bj][m][1];
                if (MODE == 1) { const bf16x8 yi = *(const bf16x8*)(yintra + o);
#pragma unroll
                    for (int q = 0; q < 4; ++q) { v0[q] = gelu_tanh(v0[q] + bf2f((bf16_t)yi[q])); v1[q] = gelu_tanh(v1[q] + bf2f((bf16_t)yi[4 + q])); } }
                *(u32x4*)(dst + o) = pack8(v0, v1); }
        EPI_ROWS_END
    }
};
struct EpiGlu {
    static constexpr bool KEEP = false;
    const bf16_t* Y; const float* bglu; bf16_t* AS; float* sss;
    __device__ __forceinline__ void operator()(const Acc& acc, const Unit& un, int wr, int wc, int fr, int fq) const {
        EPI_ROWS_BEGIN
            const int t = un.pm * 256 + rloc;
            float ssq = 0.f;
#pragma unroll
            for (int bj = 0; bj < 2; ++bj) { const int col = un.pn * 256 + bj * 128 + wc * 32 + fq * 8;
                const bf16x8 yv = *(const bf16x8*)(Y + (size_t)t * 512 + col);
                const f32x4 b0 = *(const f32x4*)(bglu + col), b1 = *(const f32x4*)(bglu + col + 4);
                f32x4 v0 = acc[ai][bj][m][0], v1 = acc[ai][bj][m][1];
#pragma unroll
                for (int q = 0; q < 4; ++q) { v0[q] = bf2f((bf16_t)yv[q]) * sigmoidf_(v0[q] + b0[q]); v1[q] = bf2f((bf16_t)yv[4 + q]) * sigmoidf_(v1[q] + b1[q]); }
                const u32x4 pk = pack8(v0, v1);
                *(u32x4*)(AS + (size_t)t * 1024 + 512 + col) = pk;
#pragma unroll
                for (int q = 0; q < 4; ++q) { const float lo = __uint_as_float(pk[q] << 16), hi = __uint_as_float(pk[q] & 0xffff0000u); ssq += lo * lo + hi * hi; } }
            ssq += __shfl_xor(ssq, 16); ssq += __shfl_xor(ssq, 32);
            if (fq == 0) sss[(size_t)t * 8 + un.pn * 4 + wc] = ssq;
        EPI_ROWS_END
    }
};
struct EpiWo {
    static constexpr bool KEEP = false;
    const float* x; const float* xstat; const float* g; const float* bt; float* pre1;
    __device__ __forceinline__ void operator()(const Acc& acc, const Unit& un, int wr, int wc, int fr, int fq) const {
        EPI_ROWS_BEGIN
            const int t = un.pm * 256 + rloc;
            const float mu = xstat[2 * t], rstd = xstat[2 * t + 1];
#pragma unroll
            for (int bj = 0; bj < 2; ++bj) { const int col = un.pn * 256 + bj * 128 + wc * 32 + fq * 8;
#pragma unroll
                for (int n = 0; n < 2; ++n) { const f32x4 xv = *(const f32x4*)(x + (size_t)t * D + col + 4 * n), gg = *(const f32x4*)(g + col + 4 * n), bb = *(const f32x4*)(bt + col + 4 * n);
                    f32x4 o;
#pragma unroll
                    for (int q = 0; q < 4; ++q) o[q] = acc[ai][bj][m][n][q] + ALPHA * ((xv[q] - mu) * rstd * gg[q] + bb[q]);
                    *(f32x4*)(pre1 + (size_t)t * D + col + 4 * n) = o; } }
        EPI_ROWS_END
    }
};
struct EpiWoLn {
    static constexpr bool KEEP = true;
    const bf16_t* xn; const float* g1; const float* b1;
    bf16_t* x1; unsigned char* x1q; float* pstat; XcdBarrier bar; const float* ssa; const float* sss;
    __device__ __forceinline__ void prefetch(const Unit&, int) const {}
    __device__ __forceinline__ void operator()(Acc& acc, const Unit& un, int wr, int wc, int fr, int fq) const {
        EPI_ROWS_BEGIN
            const int t = un.pm * 256 + rloc;
            const f32x4 a0 = *(const f32x4*)(ssa + (size_t)t * 8), a1 = *(const f32x4*)(ssa + (size_t)t * 8 + 4), b0 = *(const f32x4*)(sss + (size_t)t * 8), b1 = *(const f32x4*)(sss + (size_t)t * 8 + 4);
            const float ra = rsqrtf((a0[0] + a0[1] + a0[2] + a0[3] + a1[0] + a1[1] + a1[2] + a1[3]) * (1.0f / 512) + EPS);
            const float rs = rsqrtf((b0[0] + b0[1] + b0[2] + b0[3] + b1[0] + b1[1] + b1[2] + b1[3]) * (1.0f / 512) + EPS);
            const float sc = (un.e == 0) ? ra / rs : rs;
#pragma unroll
            for (int bj = 0; bj < 2; ++bj)
#pragma unroll
                for (int n = 0; n < 2; ++n) acc[ai][bj][m][n] *= sc;
        EPI_ROWS_END
        if (un.e == 0) return;
        EPI_ROWS_BEGIN
            const int t = un.pm * 256 + rloc;
            float s1 = 0.f, s2 = 0.f;
#pragma unroll
            for (int bj = 0; bj < 2; ++bj) { const int col = un.pn * 256 + bj * 128 + wc * 32 + fq * 8;
                const bf16x8 xv = __builtin_nontemporal_load((const bf16x8*)(xn + (size_t)t * D + col));
#pragma unroll
                for (int n = 0; n < 2; ++n)
#pragma unroll
                    for (int q = 0; q < 4; ++q) { const float v = acc[ai][bj][m][n][q] + ALPHA * bf2f((bf16_t)xv[4 * n + q]); acc[ai][bj][m][n][q] = v; s1 += v; s2 += v * v; } }
            s1 += __shfl_xor(s1, 16); s1 += __shfl_xor(s1, 32); s2 += __shfl_xor(s2, 16); s2 += __shfl_xor(s2, 32);
            if (fq == 0) { f32x2 o; o[0] = s1; o[1] = s2; *(f32x2*)(pstat + ((size_t)t * 16 + un.pn * 4 + wc) * 2) = o; }
        EPI_ROWS_END
        xcd_barrier(bar);
        EPI_ROWS_BEGIN
            const int t = un.pm * 256 + rloc;
            float s1 = 0.f, s2 = 0.f;
#pragma unroll
            for (int j = 0; j < 8; ++j) { const f32x4 p = *(const f32x4*)(pstat + (size_t)t * 32 + 4 * j); s1 += p[0] + p[2]; s2 += p[1] + p[3]; }
            const float mean = s1 * (1.0f / D), rs = rsqrtf(s2 * (1.0f / D) - mean * mean + EPS);
#pragma unroll
            for (int bj = 0; bj < 2; ++bj) { const int col = un.pn * 256 + bj * 128 + wc * 32 + fq * 8;
                f32x4 o[2];
#pragma unroll
                for (int n = 0; n < 2; ++n) { const f32x4 gg = *(const f32x4*)(g1 + col + 4 * n), bb = *(const f32x4*)(b1 + col + 4 * n);
#pragma unroll
                    for (int q = 0; q < 4; ++q) o[n][q] = (acc[ai][bj][m][n][q] - mean) * rs * gg[q] + bb[q]; }
                *(u32x4*)(x1 + (size_t)t * D + col) = pack8(o[0], o[1]);
                int p0 = __builtin_amdgcn_cvt_pk_fp8_f32(o[0][0] * XQ_SCALE, o[0][1] * XQ_SCALE, 0, false); p0 = __builtin_amdgcn_cvt_pk_fp8_f32(o[0][2] * XQ_SCALE, o[0][3] * XQ_SCALE, p0, true);
                int p1 = __builtin_amdgcn_cvt_pk_fp8_f32(o[1][0] * XQ_SCALE, o[1][1] * XQ_SCALE, 0, false); p1 = __builtin_amdgcn_cvt_pk_fp8_f32(o[1][2] * XQ_SCALE, o[1][3] * XQ_SCALE, p1, true);
                u32x2 w; w[0] = (unsigned)p0; w[1] = (unsigned)p1;
                *(u32x2*)(x1q + (size_t)t * D + col) = w; }
        EPI_ROWS_END
    }
};
struct EpiGU {
    static constexpr bool KEEP = false;
    static constexpr float QINV = 1.0f / (XQ_SCALE * WQ_SCALE);
    bf16_t* H; const float* roww; const int* eoff;
    __device__ __forceinline__ void operator()(const Acc& acc, const Unit& un, int wr, int wc, int fr, int fq) const {
        const int nrt = eoff[64] >> 8;
        const bool shared = un.e == 64;
        const int row0 = shared ? SH_ROW0 + (un.pm - nrt) * 256 : un.pm * 256;
        EPI_ROWS_BEGIN
            const int row = row0 + rloc;
            const f32x4 g0 = acc[ai][0][m][0], g1 = acc[ai][0][m][1], u0 = acc[ai][1][m][0], u1 = acc[ai][1][m][1];
            f32x4 h0, h1;
#pragma unroll
            for (int q = 0; q < 4; ++q) { const float ga = g0[q] * QINV, gb = g1[q] * QINV; h0[q] = ga * sigmoidf_(ga) * (u0[q] * QINV); h1[q] = gb * sigmoidf_(gb) * (u1[q] * QINV); }
            { int p0 = __builtin_amdgcn_cvt_pk_fp8_f32(h0[0] * HQ_SCALE, h0[1] * HQ_SCALE, 0, false); p0 = __builtin_amdgcn_cvt_pk_fp8_f32(h0[2] * HQ_SCALE, h0[3] * HQ_SCALE, p0, true);
              int p1 = __builtin_amdgcn_cvt_pk_fp8_f32(h1[0] * HQ_SCALE, h1[1] * HQ_SCALE, 0, false); p1 = __builtin_amdgcn_cvt_pk_fp8_f32(h1[2] * HQ_SCALE, h1[3] * HQ_SCALE, p1, true);
              u32x2 w; w[0] = (unsigned)p0; w[1] = (unsigned)p1;
              *(u32x2*)((unsigned char*)H + (size_t)row * FF + un.pn * 128 + wc * 32 + fq * 8) = w; }
        EPI_ROWS_END
    }
};
struct EpiDown {
    static constexpr bool KEEP = false;
    __device__ __forceinline__ void prefetch(const Unit&, int) const {}
    static constexpr float OSC = SLOT_SCALE / (HQ_SCALE * WQ_SCALE);
    unsigned char* yslot; unsigned char* shslot; const int* rowtok; const int* eoff; LAS unsigned char* stg;
    __device__ __forceinline__ void operator()(const Acc& acc, const Unit& un, int wr, int wc, int fr, int fq) const {
        const int nrt = eoff[64] >> 8;
        const bool shared = un.e == 64;
        const int tid = (wr * 4 + wc) * 64 + fq * 16 + fr;
        const int rrow = tid >> 4, rcol = (tid & 15) * 16;
        int slots[8];
#pragma unroll
        for (int q = 0; q < 8; ++q) { const int rloc = (q >> 2) * 128 + (rrow >> 4) * 64 + (q & 3) * 16 + (rrow & 15);
            slots[q] = (shared ? (un.pm - nrt) : un.pm) * 256 + rloc; }
        unsigned char* base = shared ? shslot : yslot;
        int p = 0;
#pragma unroll
        for (int ai = 0; ai < 2; ++ai)
#pragma unroll
            for (int m = 0; m < 4; ++m, ++p) {
                LAS unsigned char* sb = stg + (p & 1) * (32 * 288);
#pragma unroll
                for (int bj = 0; bj < 2; ++bj) {
                    const f32x4 v0 = acc[ai][bj][m][0] * OSC, v1 = acc[ai][bj][m][1] * OSC;
                    int p0 = __builtin_amdgcn_cvt_pk_fp8_f32(v0[0], v0[1], 0, false); p0 = __builtin_amdgcn_cvt_pk_fp8_f32(v0[2], v0[3], p0, true);
                    int p1 = __builtin_amdgcn_cvt_pk_fp8_f32(v1[0], v1[1], 0, false); p1 = __builtin_amdgcn_cvt_pk_fp8_f32(v1[2], v1[3], p1, true);
                    u32x2 w; w[0] = (unsigned)p0; w[1] = (unsigned)p1;
                    *(LAS u32x2*)(sb + (wr * 16 + fr) * 288 + bj * 128 + wc * 32 + fq * 8) = w;
                }
                asm volatile("s_waitcnt lgkmcnt(0)\n\ts_barrier" ::: "memory");
                const int slot = slots[ai * 4 + m];
                const u32x4 v = *(const LAS u32x4*)(sb + rrow * 288 + rcol);
                if (slot >= 0) *(u32x4*)(base + (size_t)slot * D + un.pn * 256 + rcol) = v;
            }
        asm volatile("s_waitcnt lgkmcnt(0)\n\ts_barrier" ::: "memory");
    }
};
}
namespace g8 {
struct EpiRouter {
    static constexpr bool KEEP = false;
    float* logits;
    __device__ __forceinline__ void operator()(const Acc& acc, const Unit& un, int wr, int wc, int fr, int fq) const {
        if (wc >= 2) return;
        EPI_ROWS_BEGIN
            float* o = logits + (size_t)(un.pm * 256 + rloc) * NE + wc * 32 + fq * 8;
            *(f32x4*)o = acc[ai][0][m][0]; *(f32x4*)(o + 4) = acc[ai][0][m][1];
        EPI_ROWS_END
    }
};
}
__device__ __forceinline__ void fp_gemm_router(const Ptrs& P, LAS unsigned char* lds) {
    g8::Geo g{2048, 2048, 128, 128, 0};
    g8::SchedReg S{(const char*)WSP(bf16_t, WS_X1), (const char*)WSP(bf16_t, WS_WR), 2048, 2048, T / 256, 1, 16};
    g8::EpiRouter E{WSP(float, WS_LOGITS)};
    g8::gemm_body<g8::EpiRouter, g8::SchedReg, false>(lds, g, S, E);
}
#define TK_GT(va, ea, vb, eb) ((va) > (vb) || ((va) == (vb) && (ea) < (eb)))
#define TK_CSWAP(i, j) do { const bool sw_ = TK_GT(av[j], ae[j], av[i], ae[i]); const float v0_ = av[i], s0_ = as_[i]; const int e0_ = ae[i]; \
    av[i] = sw_ ? av[j] : av[i]; as_[i] = sw_ ? as_[j] : as_[i]; ae[i] = sw_ ? ae[j] : ae[i]; av[j] = sw_ ? v0_ : av[j]; as_[j] = sw_ ? s0_ : as_[j]; ae[j] = sw_ ? e0_ : ae[j]; } while (0)
#define TK_MERGE(xmask) do { \
    float bv_[8], bs_[8]; int be_[8]; \
    _Pragma("unroll") for (int i = 0; i < 8; ++i) { bv_[i] = __shfl_xor(av[7 - i], xmask); bs_[i] = __shfl_xor(as_[7 - i], xmask); be_[i] = __shfl_xor(ae[7 - i], xmask); } \
    _Pragma("unroll") for (int i = 0; i < 8; ++i) { const bool ka_ = TK_GT(av[i], ae[i], bv_[i], be_[i]); av[i] = ka_ ? av[i] : bv_[i]; as_[i] = ka_ ? as_[i] : bs_[i]; ae[i] = ka_ ? ae[i] : be_[i]; } \
    TK_CSWAP(0, 4); TK_CSWAP(1, 5); TK_CSWAP(2, 6); TK_CSWAP(3, 7); TK_CSWAP(0, 2); TK_CSWAP(1, 3); TK_CSWAP(4, 6); TK_CSWAP(5, 7); TK_CSWAP(0, 1); TK_CSWAP(2, 3); TK_CSWAP(4, 5); TK_CSWAP(6, 7); } while (0)
__device__ __forceinline__ void ph_topk_cnt(const Ptrs& P, LAS unsigned char* lds, int bid, int nb) {
    const int tidx = opaque_tid();
    const float* logits = WSP(float, WS_LOGITS); int* topi = WSP(int, WS_TOPI); float* topw = WSP(float, WS_TOPW); int* cnt = WSP(int, WS_CNT);
    LAS int* hist = (LAS int*)lds;
    LAS float* bias = (LAS float*)(lds + 256);
    LAS float* scs = (LAS float*)(lds + 512);
    for (int tile = bid; tile < 256; tile += nb) {
        if (tidx < 64) { hist[tidx] = 0; bias[tidx] = P.router_bias[tidx]; }
        for (int i = tidx; i < 128 * 64; i += NTHR) { const int tk = i >> 6, e = i & 63; scs[e * 129 + tk] = sigmoidf_(logits[(size_t)(tile * 128 + tk) * NE + e]); }
        __syncthreads();
        {
            const int tk = tidx >> 2, q = tidx & 3, t = tile * 128 + tk;
            float ga, gb;
            {
                float m1 = -INFINITY, m2 = -INFINITY, n1 = -INFINITY, n2 = -INFINITY;
#pragma unroll
                for (int j = 0; j < 8; ++j) {
                    const float v = scs[(16 * q + j) * 129 + tk] + bias[16 * q + j]; const bool a = v > m1; m2 = a ? m1 : fmaxf(m2, v); m1 = a ? v : m1;
                    const float w = scs[(16 * q + 8 + j) * 129 + tk] + bias[16 * q + 8 + j]; const bool b = w > n1; n2 = b ? n1 : fmaxf(n2, w); n1 = b ? w : n1; }
                ga = m1 + m2; gb = n1 + n2;
            }
            float gs[8];
            const int qb = (tidx & 63) & ~3;
#pragma unroll
            for (int g = 0; g < 8; ++g) gs[g] = __shfl((g & 1) ? gb : ga, qb + (g >> 1));
            int mygrp = 0, nsel = 0;
#pragma unroll
            for (int g = 0; g < 8; ++g) { int c = 0;
#pragma unroll
                for (int h = 0; h < 8; ++h) c += (gs[h] > gs[g] || (gs[h] == gs[g] && h < g)) ? 1 : 0;
                const bool sel = c < 4; mygrp = (sel && nsel == q) ? g : mygrp; nsel += sel ? 1 : 0; }
            float av[8], as_[8]; int ae[8];
#pragma unroll
            for (int j = 0; j < 8; ++j) { const int e = mygrp * 8 + j; const float s0 = scs[e * 129 + tk]; as_[j] = s0; av[j] = s0 + bias[e]; ae[j] = e; }
            TK_CSWAP(0, 1); TK_CSWAP(2, 3); TK_CSWAP(4, 5); TK_CSWAP(6, 7); TK_CSWAP(1, 2); TK_CSWAP(3, 4); TK_CSWAP(5, 6);
            TK_CSWAP(0, 1); TK_CSWAP(2, 3); TK_CSWAP(4, 5); TK_CSWAP(6, 7); TK_CSWAP(1, 2); TK_CSWAP(3, 4); TK_CSWAP(5, 6);
            TK_CSWAP(0, 1); TK_CSWAP(2, 3); TK_CSWAP(4, 5); TK_CSWAP(6, 7); TK_CSWAP(1, 2); TK_CSWAP(3, 4); TK_CSWAP(5, 6);
            TK_CSWAP(0, 1); TK_CSWAP(2, 3); TK_CSWAP(4, 5); TK_CSWAP(6, 7); TK_CSWAP(1, 2); TK_CSWAP(3, 4); TK_CSWAP(5, 6);
            TK_MERGE(1); TK_MERGE(2);
            float wsum = 0.f;
#pragma unroll
            for (int k = 0; k < 8; ++k) wsum += as_[k];
            const float sc_ = 2.5f / wsum;
            const int e0 = (q == 0) ? ae[0] : (q == 1) ? ae[2] : (q == 2) ? ae[4] : ae[6], e1 = (q == 0) ? ae[1] : (q == 1) ? ae[3] : (q == 2) ? ae[5] : ae[7];
            const float w0 = ((q == 0) ? as_[0] : (q == 1) ? as_[2] : (q == 2) ? as_[4] : as_[6]) * sc_, w1 = ((q == 0) ? as_[1] : (q == 1) ? as_[3] : (q == 2) ? as_[5] : as_[7]) * sc_;
            *(int2*)(topi + (size_t)t * TOPK + 2 * q) = make_int2(e0, e1);
            *(float2*)(topw + (size_t)t * TOPK + 2 * q) = make_float2(w0, w1);
            __hip_atomic_fetch_add(hist + e0, 1, __ATOMIC_RELAXED, __HIP_MEMORY_SCOPE_WORKGROUP);
            __hip_atomic_fetch_add(hist + e1, 1, __ATOMIC_RELAXED, __HIP_MEMORY_SCOPE_WORKGROUP);
        }
        __syncthreads();
        if (tidx < 64) cnt[tile * 64 + tidx] = hist[tidx];
        __syncthreads();
    }
}
__device__ __forceinline__ void ph_lists2(const Ptrs& P, LAS unsigned char* lds, int bid, int nb) {
    const int tidx = opaque_tid();
    const int* topi = WSP(int, WS_TOPI); const float* topw = WSP(float, WS_TOPW); const int* cnt = WSP(int, WS_CNT);
    int* eoff = WSP(int, WS_EOFF); int* rowtok = WSP(int, WS_ROWTOK); int* invrow = WSP(int, WS_INVROW);
    LAS int* red_tot = (LAS int*)lds;
    LAS int* red_pre = red_tot + 512;
    LAS int* tot = red_pre + 512;
    LAS int* off = tot + 64;
    LAS int* seg = off + 128;
    LAS int* ti = seg + 512;
    LAS float* tw = (LAS float*)(ti + 1024);
    const int e = tidx & 63, part = tidx >> 6;
    for (int tile = bid; tile < 256; tile += nb) {
        int cv[32];
#pragma unroll
        for (int q = 0; q < 32; ++q) cv[q] = cnt[(part * 32 + q) * 64 + e];
        const int i0v = topi[tile * 1024 + tidx], i1v = topi[tile * 1024 + 512 + tidx];
        const float w0v = topw[tile * 1024 + tidx], w1v = topw[tile * 1024 + 512 + tidx];
        int st = 0, sp = 0;
#pragma unroll
        for (int q = 0; q < 32; ++q) { st += cv[q]; sp += (part * 32 + q < tile) ? cv[q] : 0; }
        red_tot[part * 64 + e] = st; red_pre[part * 64 + e] = sp;
        ti[tidx] = i0v; ti[tidx + 512] = i1v; tw[tidx] = w0v; tw[tidx + 512] = w1v;
        __syncthreads();
        int pre_e = 0;
        if (tidx < 64) { int a = 0;
#pragma unroll
            for (int q = 0; q < 8; ++q) { a += red_tot[q * 64 + tidx]; pre_e += red_pre[q * 64 + tidx]; } tot[tidx] = a; }
        int c = 0;
#pragma unroll 16
        for (int k = 0; k < 128; ++k) c += (ti[part * 128 + k] == e) ? 1 : 0;
        seg[part * 64 + e] = c;
        __syncthreads();
        if (tidx == 0) { int o = 0; for (int i = 0; i < 64; ++i) { off[i] = o; o += (tot[i] + 255) & ~255; } off[64] = o; }
        if (tidx < 64) red_pre[tidx] = pre_e;
        __syncthreads();
        int pos = off[e] + red_pre[e];
        for (int q = 0; q < part; ++q) pos += seg[q * 64 + e];
#pragma unroll 8
        for (int k = 0; k < 128; ++k) { const int idx = part * 128 + k; if (ti[idx] == e) { rowtok[pos] = tile * 1024 + idx; invrow[tile * 1024 + idx] = pos; ++pos; } }
        if (tile == 255 && part == 7) { const int end = off[e + 1]; for (; pos < end; ++pos) rowtok[pos] = -1; }
        if (bid == 0 && tidx <= 64) eoff[tidx] = off[tidx];
        if (bid == 0 && tidx < 64) { int* tile_e = WSP(int, WS_TILEE); for (int rt = off[tidx] >> 8; rt < (off[tidx + 1] >> 8); ++rt) tile_e[rt] = tidx; }
        __syncthreads();
    }
    for (int i = bid * NTHR + tidx; i < T; i += nb * NTHR) rowtok[SH_ROW0 + i] = i * 8;
}
__device__ __forceinline__ void fp_gemm_win(const Ptrs& P, LAS unsigned char* lds) {
    g8::Geo g{2048, 2048, 128, 128, 0};
    g8::SchedReg S{(const char*)WSP(bf16_t, WS_XN), (const char*)WSP(bf16_t, WS_WIN), 2048, 2048, T / 256, 4, 16};
    g8::EpiWin E{WSP(bf16_t, WS_CQ), WSP(bf16_t, WS_CKV), WSP(bf16_t, WS_U), WSP(bf16_t, WS_KROPE), WSP(float2, WS_ROPE), WSP(float, WS_RSQ), WSP(float, WS_RSKV)};
    g8::gemm_body<g8::EpiWin, g8::SchedReg, false>(lds, g, S, E);
}
__device__ __forceinline__ void fp_gemm_q(const Ptrs& P, LAS unsigned char* lds) {
    g8::Geo g{512, 512, 128, 128, 0};
    g8::SchedReg S{(const char*)WSP(bf16_t, WS_CQ), (const char*)WSP(bf16_t, WS_WUQ), 512, 512, T / 256, 3, 4};
    g8::EpiQ E{WSP(bf16_t, WS_Q), WSP(float, WS_RSQ), WSP(float2, WS_ROPE)};
    g8::gemm_body<g8::EpiQ, g8::SchedReg, false>(lds, g, S, E);
}
__device__ __forceinline__ void fp_gemm_kv(const Ptrs& P, LAS unsigned char* lds) {
    g8::Geo g{512, 512, 128, 128, 0};
    g8::SchedReg S{(const char*)WSP(bf16_t, WS_CKV), (const char*)WSP(bf16_t, WS_WUKV), 512, 512, T / 256, 4, 2};
    g8::EpiKV E{WSP(bf16_t, WS_K), WSP(bf16_t, WS_V), WSP(float, WS_RSKV)};
    g8::gemm_body<g8::EpiKV, g8::SchedReg, false>(lds, g, S, E);
}
__device__ __forceinline__ void fp_gemm_s5b(const Ptrs& P, LAS unsigned char* lds) {
    g8::Geo g{2048, 2048, 128, 128, 0};
    g8::SchedS5 S{(const char*)WSP(bf16_t, WS_U), (const char*)WSP(bf16_t, WS_BLOC), 2048, 2048, 1, 16, (size_t)512 * 2048, (size_t)256 * 2048, 0, 1};
    g8::EpiS5b E{WSP(float, WS_XLOC)};
    g8::gemm_body<g8::EpiS5b, g8::SchedS5, false>(lds, g, S, E);
}
__device__ __forceinline__ void fp_gemm_s5a(const Ptrs& P, LAS unsigned char* lds) {
    g8::Geo g{2048, 32, 128, -2048, 1};
    g8::SchedS5 S{(const char*)WSP(bf16_t, WS_U), (const char*)WSP(bf16_t, WS_KTAB), 2048, 32, 4, 16, (size_t)512 * 2048, 0, 1};
    g8::EpiS5y<0> E{WSP(bf16_t, WS_YINTRA), nullptr};
    g8::gemm_body<g8::EpiS5y<0>, g8::SchedS5, false>(lds, g, S, E);
}
__device__ __forceinline__ void fp_gemm_s5d(const Ptrs& P, LAS unsigned char* lds) {
    g8::Geo g{512, 512, 128, 128, 0};
    g8::SchedS5 S{(const char*)WSP(bf16_t, WS_XPREV), (const char*)WSP(bf16_t, WS_CLAM), 512, 512, 4, 2, (size_t)512 * 512, (size_t)1024 * 512, 0};
    g8::EpiS5y<1> E{WSP(bf16_t, WS_Y), WSP(bf16_t, WS_YINTRA)};
    g8::gemm_body<g8::EpiS5y<1>, g8::SchedS5, false>(lds, g, S, E);
}
__device__ __forceinline__ void fp_gemm_glu(const Ptrs& P, LAS unsigned char* lds) {
    g8::Geo g{1024, 1024, 128, 128, 0};
    g8::SchedReg S{(const char*)WSP(bf16_t, WS_Y), (const char*)WSP(bf16_t, WS_WGLU), 1024, 1024, T / 256, 2, 8};
    g8::EpiGlu E{WSP(bf16_t, WS_Y), P.b_glu, WSP(bf16_t, WS_AS), WSP(float, WS_SSS)};
    g8::gemm_body<g8::EpiGlu, g8::SchedReg, false>(lds, g, S, E);
}
__device__ __forceinline__ void fp_gemm_wo(const Ptrs& P, LAS unsigned char* lds) {
    g8::Geo g{2048, 2048, 128, 128, 0};
    g8::SchedReg S{(const char*)WSP(bf16_t, WS_AS), (const char*)WSP(bf16_t, WS_WO), 2048, 2048, T / 256, 4, 16};
    g8::EpiWo E{P.x, WSP(float, WS_XSTAT), P.ln_in_g, P.ln_in_b, P.out};
    g8::gemm_body<g8::EpiWo, g8::SchedReg, false>(lds, g, S, E);
}
namespace g8 {
struct SchedWo2 {
    const char* A; const char* B; int pm0;
    __device__ __forceinline__ bool next(int i, Unit& u) const {
        if (i >= 2) return false;
        const int L = unit_index(0, 256); if (L < 0) return false;
        u.pm = pm0 + L / 4; u.pn = L % 4; u.e = i; u.nt = 8; u.rows = nullptr;
        u.A = A + (size_t)u.pm * 256 * 2048 + (size_t)i * 1024; u.B = B + (size_t)u.pn * 256 * 2048 + (size_t)i * 1024;
        return true;
    }
};
}
__device__ __forceinline__ void fp_gemm_wo_ln(const Ptrs& P, LAS unsigned char* lds, const XcdBarrier& bar, int call) {
    g8::Geo g{2048, 2048, 128, 128, 0};
    g8::SchedWo2 S{(const char*)WSP(bf16_t, WS_AS), (const char*)WSP(bf16_t, WS_WO), call * 64};
    g8::EpiWoLn E{WSP(bf16_t, WS_XN), P.ln1_g, P.ln1_b, WSP(bf16_t, WS_X1), WSP(unsigned char, WS_X1Q), WSP(float, WS_XLOC), bar, WSP(float, WS_SSA), WSP(float, WS_SSS)};
    g8::gemm_body<g8::EpiWoLn, g8::SchedWo2, false>(lds, g, S, E);
}
__device__ __forceinline__ void fp_gemm_gu(const Ptrs& P, LAS unsigned char* lds) {
    g8::Geo g{1024, 1024, 128, 128, 0};
    g8::SchedMoe S{(const char*)WSP(unsigned char, WS_X1Q), (const char*)WSP(unsigned char, WS_WGU), WSP(int, WS_EOFF), WSP(int, WS_ROWTOK), 1024, 2, 8, (size_t)512 * 1024, 1024, 1, WSP(int, WS_TILEE)};
    g8::EpiGU E{WSP(bf16_t, WS_H), WSP(float, WS_ROWW), WSP(int, WS_EOFF)};
    g8::gemm_body<g8::EpiGU, g8::SchedMoe, true, 1>(lds, g, S, E);
}
__device__ __forceinline__ void fp_gemm_down(const Ptrs& P, LAS unsigned char* lds) {
    g8::Geo g{256, 256, 128, 128, 0};
    g8::SchedMoe S{(const char*)WSP(unsigned char, WS_H), (const char*)WSP(unsigned char, WS_WD), WSP(int, WS_EOFF), WSP(int, WS_ROWTOK), 256, 4, 2, (size_t)1024 * 256, 256, 0, WSP(int, WS_TILEE)};
    g8::EpiDown E{WSP(unsigned char, WS_YSLOT), WSP(unsigned char, WS_SHSLOT), WSP(int, WS_ROWTOK), WSP(int, WS_EOFF), lds + LDS_XTRA};
    g8::gemm_body<g8::EpiDown, g8::SchedMoe, false, 1>(lds, g, S, E);
}
namespace at8 {
typedef short s16x4 __attribute__((ext_vector_type(4)));
typedef short v4i16_t __attribute__((ext_vector_type(4)));
constexpr int KSLOT = 12288, VSLOT = 8192, NSLOT = 3;
constexpr int L_K = 0, L_V = NSLOT * KSLOT, L_WS = L_V + NSLOT * VSLOT, L_OST = L_WS + 8 * 256, L_END = L_OST + 8 * 4096;
__device__ __forceinline__ int crow(int r, int hi) { return (r & 3) + 8 * (r >> 2) + 4 * hi; }
__device__ __forceinline__ void glds16(const void* gsrc, LAS unsigned char* dst) { __builtin_amdgcn_global_load_lds((const unsigned*)gsrc, (LAS unsigned*)dst, 16, 0, 0); }
__device__ __forceinline__ s16x4 vtr(const LAS unsigned char* p) { return __builtin_bit_cast(s16x4, __builtin_amdgcn_ds_read_tr16_b64_v4i16((LAS v4i16_t*)p)); }
__device__ __forceinline__ unsigned cvtpk(float lo, float hi) { return pk_bf16_hw(lo, hi); }

__device__ __forceinline__ void attn_unit(int b, int h, int qb, const bf16_t* __restrict__ Q, const bf16_t* __restrict__ Kc, const bf16_t* __restrict__ V, bf16_t* __restrict__ AS, float* __restrict__ ssa, const bf16_t* __restrict__ krope, LAS unsigned char* lds) {
    const int tid = opaque_tid(), lane = tid & 63, r32 = lane & 31, hi = lane >> 5;
    const int wid = __builtin_amdgcn_readfirstlane(tid >> 6);
    const size_t bh = (size_t)b * NH + h;
    const bf16_t* Kbh = Kc + bh * SEQ * QKD; const bf16_t* Vbh = V + bh * SEQ * VD;
    const int q0 = qb * 256 + wid * 32;
    const int NT = 4 * (qb + 1);
    const int myNT = 4 * qb + (wid >> 1) + 1;
    const bf16_t* ksrc0 = Kbh + (size_t)lane * QKD + wid * 8;
    const bf16_t* ksrc1 = krope + ((size_t)b * SEQ + lane) * 32 + (wid & 3) * 8;
    const bf16_t* vsrc = Vbh + (size_t)(16 * (wid & 3) + (lane >> 2)) * VD + (wid >> 2) * 32 + (lane & 3) * 8;
#define AT_DMA(t, slot) do { glds16(ksrc0 + (size_t)(t) * 64 * QKD, lds + L_K + (slot) * KSLOT + wid * 1024); \
                             glds16(ksrc1 + (size_t)(t) * 64 * 32, lds + L_K + (slot) * KSLOT + (8 + (wid & 3)) * 1024); \
                             glds16(vsrc + (size_t)(t) * 64 * VD, lds + L_V + (slot) * VSLOT + wid * 1024); } while (0)
    AT_DMA(0, 0);
    if (NT > 1) AT_DMA(1, 1);
    bf16x8 qr[6];
    const bf16_t* qp = Q + (bh * SEQ + q0 + r32) * QKD + hi * 8;
#pragma unroll
    for (int ks = 0; ks < 6; ++ks) qr[ks] = *(const bf16x8*)(qp + ks * 16);
    f32x16 o0, o1;
#pragma unroll
    for (int i = 0; i < 16; ++i) { o0[i] = 0.f; o1[i] = 0.f; }
    float m_run = 0.f, l_run = 0.f;
    LAS float* wsf = (LAS float*)(lds + L_WS) + wid * 64;
    const LAS unsigned char* kp0 = lds + L_K + hi * 1024 + r32 * 16;
    const LAS unsigned char* vp0 = lds + L_V + ((lane >> 4) & 1) * 32 + (lane & 3) * 8 + (4 * hi + ((lane & 15) >> 2)) * 64;
    int slot = 0;
    for (int t = 0; t < NT; ++t) {
        if (t + 1 < NT) asm volatile("s_waitcnt vmcnt(3)" ::: "memory"); else asm volatile("s_waitcnt vmcnt(0)" ::: "memory");
        asm volatile("s_waitcnt lgkmcnt(0)\n\ts_barrier" ::: "memory");
        if (t + 2 < NT) { const int s2 = (slot == 0) ? 2 : slot - 1; AT_DMA(t + 2, s2); }
        if (t < myNT) {
            const LAS unsigned char* kp = kp0 + slot * KSLOT; const LAS unsigned char* vp = vp0 + slot * VSLOT;
            f32x16 p0, p1;
#pragma unroll
            for (int i = 0; i < 16; ++i) { p0[i] = -m_run; p1[i] = -m_run; }
#pragma unroll
            for (int ks = 0; ks < 6; ++ks) {
                const bf16x8 a0 = *(const LAS bf16x8*)(kp + ks * 2048), a1 = *(const LAS bf16x8*)(kp + ks * 2048 + 512);
                p0 = __builtin_amdgcn_mfma_f32_32x32x16_bf16(a0, qr[ks], p0, 0, 0, 0);
                p1 = __builtin_amdgcn_mfma_f32_32x32x16_bf16(a1, qr[ks], p1, 0, 0, 0);
            }
            float rm = fmaxf(p0[0], p1[0]);
#pragma unroll
            for (int i = 1; i < 16; ++i) rm = fmaxf(rm, fmaxf(p0[i], p1[i]));
            { auto rr = __builtin_amdgcn_permlane32_swap(__float_as_uint(rm), __float_as_uint(rm), false, false); rm = fmaxf(__uint_as_float(rr[0]), __uint_as_float(rr[1])); }
            if (__any(rm > 8.0f)) {
                const float dl = fmaxf(rm, 0.f);
                const float alpha = __builtin_amdgcn_exp2f(-dl);
                l_run *= alpha; m_run += dl;
#pragma unroll
                for (int i = 0; i < 16; ++i) { p0[i] -= dl; p1[i] -= dl; }
                if (hi == 0) wsf[r32] = alpha;
                asm volatile("s_waitcnt lgkmcnt(0)" ::: "memory");
#pragma unroll
                for (int i = 0; i < 16; ++i) { const float a = wsf[crow(i, hi)]; o0[i] *= a; o1[i] *= a; }
            }
            float ls = 0.f;
#pragma unroll
            for (int i = 0; i < 16; ++i) { p0[i] = __builtin_amdgcn_exp2f(p0[i]); p1[i] = __builtin_amdgcn_exp2f(p1[i]); ls += p0[i] + p1[i]; }
            l_run += ls;
            u32x4 w0, w1, w2, w3;
            w0 = (u32x4){cvtpk(p0[0], p0[1]), cvtpk(p0[2], p0[3]), cvtpk(p0[4], p0[5]), cvtpk(p0[6], p0[7])};
            w1 = (u32x4){cvtpk(p0[8], p0[9]), cvtpk(p0[10], p0[11]), cvtpk(p0[12], p0[13]), cvtpk(p0[14], p0[15])};
            w2 = (u32x4){cvtpk(p1[0], p1[1]), cvtpk(p1[2], p1[3]), cvtpk(p1[4], p1[5]), cvtpk(p1[6], p1[7])};
            w3 = (u32x4){cvtpk(p1[8], p1[9]), cvtpk(p1[10], p1[11]), cvtpk(p1[12], p1[13]), cvtpk(p1[14], p1[15])};
            const bf16x8 pa[4] = {__builtin_bit_cast(bf16x8, w0), __builtin_bit_cast(bf16x8, w1), __builtin_bit_cast(bf16x8, w2), __builtin_bit_cast(bf16x8, w3)};
#pragma unroll
            for (int k = 0; k < 4; ++k) {
                const s16x4 l0 = vtr(vp + k * 1024), h0 = vtr(vp + k * 1024 + 512), l1 = vtr(vp + 4096 + k * 1024), h1 = vtr(vp + 4096 + k * 1024 + 512);
                const bf16x8 v0 = (bf16x8){l0[0], l0[1], l0[2], l0[3], h0[0], h0[1], h0[2], h0[3]};
                const bf16x8 v1 = (bf16x8){l1[0], l1[1], l1[2], l1[3], h1[0], h1[1], h1[2], h1[3]};
                o0 = __builtin_amdgcn_mfma_f32_32x32x16_bf16(pa[k], v0, o0, 0, 0, 0);
                o1 = __builtin_amdgcn_mfma_f32_32x32x16_bf16(pa[k], v1, o1, 0, 0, 0);
            }
        }
        slot = (slot == 2) ? 0 : slot + 1;
    }
    { auto rr = __builtin_amdgcn_permlane32_swap(__float_as_uint(l_run), __float_as_uint(l_run), false, false); l_run = __uint_as_float(rr[0]) + __uint_as_float(rr[1]); }
    if (hi == 0) wsf[32 + r32] = l_run;
    asm volatile("s_waitcnt lgkmcnt(0)" ::: "memory");
    LAS bf16_t* stg = (LAS bf16_t*)(lds + L_OST) + wid * 2048;
#pragma unroll
    for (int i = 0; i < 16; ++i) { const int orow = crow(i, hi); const float rl = 1.0f / wsf[32 + orow];
        stg[orow * 64 + r32] = f2bf(o0[i] * rl); stg[orow * 64 + 32 + r32] = f2bf(o1[i] * rl); }
    asm volatile("s_waitcnt lgkmcnt(0)" ::: "memory");
    if (lane < 32) { float ssq = 0.f;
#pragma unroll
        for (int c = 0; c < 8; ++c) { const u32x4 v = *(const LAS u32x4*)(stg + lane * 64 + c * 8);
#pragma unroll
            for (int q = 0; q < 4; ++q) { const float lo = __uint_as_float(v[q] << 16), hi = __uint_as_float(v[q] & 0xffff0000u); ssq += lo * lo + hi * hi; } }
        ssa[((size_t)b * SEQ + q0 + lane) * 8 + h] = ssq; }
    bf16_t* Ow = AS + ((size_t)b * SEQ + q0) * 1024 + h * 64;
#pragma unroll
    for (int i = 0; i < 4; ++i) { const int row = i * 8 + (lane >> 3), ch = lane & 7; const u32x4 v = *(const LAS u32x4*)(stg + row * 64 + ch * 8); *(u32x4*)(Ow + (size_t)row * 1024 + ch * 8) = v; }
    asm volatile("s_waitcnt lgkmcnt(0)\n\ts_barrier" ::: "memory");
#undef AT_DMA
}
__device__ __forceinline__ void attn_phase(const Ptrs& P, LAS unsigned char* lds, int bid, int nb) {
    const bf16_t* Q = WSP(bf16_t, WS_Q); const bf16_t* Kc = WSP(bf16_t, WS_K); const bf16_t* V = WSP(bf16_t, WS_V); bf16_t* AS = WSP(bf16_t, WS_AS);
    const int vcu = ((nb & 7) == 0) ? (bid & 7) * (nb >> 3) + (bid >> 3) : bid;
    for (int p = vcu; p < 512; p += nb) {
        const int bh = p >> 2, s = p & 3;
        attn_unit(bh >> 3, bh & 7, 7 - s, Q, Kc, V, AS, WSP(float, WS_SSA), WSP(bf16_t, WS_KROPE), lds);
        attn_unit(bh >> 3, bh & 7, s, Q, Kc, V, AS, WSP(float, WS_SSA), WSP(bf16_t, WS_KROPE), lds);
    }
}
}
__global__ void __launch_bounds__(NTHR, 2) mega(Args a) {
    extern __shared__ __attribute__((aligned(16))) unsigned char lds_raw[];
    LAS unsigned char* lds = (LAS unsigned char*)lds_raw;
    Ptrs P;
    P.x = (const float*)a.in[0]; P.positions = (const int*)a.in[1]; P.ln_in_g = (const float*)a.in[2]; P.ln_in_b = (const float*)a.in[3];
    P.w_in = (const float*)a.in[4]; P.q_norm_g = (const float*)a.in[5]; P.kv_norm_g = (const float*)a.in[6]; P.w_uq = (const float*)a.in[7]; P.w_ukv = (const float*)a.in[8];
    P.lambda_re = (const float*)a.in[9]; P.lambda_im = (const float*)a.in[10]; P.log_step = (const float*)a.in[11]; P.b_re = (const float*)a.in[12]; P.b_im = (const float*)a.in[13];
    P.c_re = (const float*)a.in[14]; P.c_im = (const float*)a.in[15]; P.d_skip = (const float*)a.in[16]; P.w_glu = (const float*)a.in[17]; P.b_glu = (const float*)a.in[18];
    P.attn_out_g = (const float*)a.in[19]; P.ssm_out_g = (const float*)a.in[20]; P.w_o = (const float*)a.in[21]; P.ln1_g = (const float*)a.in[22]; P.ln1_b = (const float*)a.in[23];
    P.w_router = (const float*)a.in[24]; P.router_bias = (const float*)a.in[25]; P.w_gate = (const float*)a.in[26]; P.w_up = (const float*)a.in[27]; P.w_down = (const float*)a.in[28];
    P.ws_gate = (const float*)a.in[29]; P.ws_up = (const float*)a.in[30]; P.ws_down = (const float*)a.in[31]; P.ln2_g = (const float*)a.in[32]; P.ln2_b = (const float*)a.in[33];
    P.out = a.out; P.ws = a.ws;
    const int bid = blockIdx.x, nb = gridDim.x;
    volatile LAS unsigned* misc = (volatile LAS unsigned*)(lds + LDS_MISC);
    if (threadIdx.x < 64) misc[threadIdx.x] = 0u;
    __syncthreads();
    XcdBarrier bar = xcd_barrier_post((unsigned*)(P.ws + WS_CTL) + 4096, misc);
#define GRID_BAR() xcd_barrier(bar)

    ph_ln_in(P, bid, nb); ph_wprep(P, lds, bid, nb); ph_s5tab1(P, bid, nb); ph_ropetab(P, bid, nb);
    GRID_BAR();
    ph_s5tab2(P, lds, bid, nb);
#if FAST_WIN
    fp_gemm_win(P, lds);
    GRID_BAR();
#else
    ph_gemm_win(P, bid, nb);
    GRID_BAR();
    ph_rstat(P, bid, nb);
    GRID_BAR();
#endif
#if FAST_QKV
    fp_gemm_q(P, lds); fp_gemm_kv(P, lds);
#else
    ph_gemm_q(P, bid, nb); ph_gemm_kv(P, bid, nb);
#endif
#if FAST_S5
    fp_gemm_s5b(P, lds); fp_gemm_s5a(P, lds);
#else
    ph_gemm_s5b(P, bid, nb); ph_gemm_s5a(P, bid, nb);
#endif
    GRID_BAR();
#if !FAST_QKV || !FAST_WIN
    ph_rope_apply(P, bid, nb);
#endif
    ph_s5scan(P, bid, nb);
#if !FAST_QKV || !FAST_WIN
    GRID_BAR();
#endif
#if FAST_ATTN
    at8::attn_phase(P, lds, bid, nb);
#else
    ph_attn_simple(P, lds, bid, nb);
#endif
    GRID_BAR();
#if FAST_S5
    fp_gemm_s5d(P, lds);
#else
    ph_gemm_s5d(P, bid, nb);
#endif
    GRID_BAR();
#if FAST_GLU
    fp_gemm_glu(P, lds);
#else
    ph_gemm_glu(P, bid, nb);
#endif
    GRID_BAR();
    if (nb != 256) { ph_asnorm(P, bid, nb); GRID_BAR(); }
#if FAST_WO
    if (nb == 256) { fp_gemm_wo_ln(P, lds, bar, 0); fp_gemm_wo_ln(P, lds, bar, 1); }
    else {
    fp_gemm_wo(P, lds);
    GRID_BAR();
    ph_ln1(P, bid, nb);
    }
#else
    ph_gemm_wo(P, bid, nb);
    GRID_BAR();
    ph_ln1(P, bid, nb);
#endif
    GRID_BAR();
    fp_gemm_router(P, lds);
    GRID_BAR();
    ph_topk_cnt(P, lds, bid, nb);
    GRID_BAR();
    ph_lists2(P, lds, bid, nb);
    GRID_BAR();
#if FAST_MOE
    fp_gemm_gu(P, lds);
    GRID_BAR();
    fp_gemm_down(P, lds);
#else
    ph_gemm_gu(P, bid, nb);
    GRID_BAR();
    ph_gemm_down(P, bid, nb);
#endif
    GRID_BAR();
    ph_combine(P, bid, nb);
}

extern "C" void kernel_launch(void* const* d_in, const int* in_sizes, int n_in, void* d_out, int out_size, void* d_ws, size_t ws_size, hipStream_t stream) {
    (void)in_sizes; (void)out_size;
    if (ws_size < WS_NEED || n_in != 34) return;
    static int grid = 0;
    if (grid == 0) {
        int dev = 0, cus = 0;
        if (hipGetDevice(&dev) != hipSuccess || hipDeviceGetAttribute(&cus, hipDeviceAttributeMultiprocessorCount, dev) != hipSuccess) { grid = -1; return; }
        if (hipFuncSetAttribute((const void*)mega, hipFuncAttributeMaxDynamicSharedMemorySize, LDS_BYTES) != hipSuccess) { grid = -1; return; }
        int per_cu = 0;
        if (hipOccupancyMaxActiveBlocksPerMultiprocessor(&per_cu, (const void*)mega, NTHR, LDS_BYTES) != hipSuccess || per_cu < 1) { (void)hipGetLastError(); }
        grid = cus;
    }
    if (grid < 0) return;
    (void)hipMemsetAsync((char*)d_ws + WS_CTL, 0, 1 << 20, stream);
    Args a; memset(&a, 0, sizeof(a));
    for (int i = 0; i < 34; ++i) a.in[i] = d_in[i];
    a.out = (float*)d_out; a.ws = (unsigned char*)d_ws;
    hipLaunchKernelGGL(mega, dim3(grid), dim3(NTHR), LDS_BYTES, stream, a);
}
```
